# Optimizing an MI355X kernel written in HIP

```python
import jax, jax.numpy as jnp
from jax import lax
import numpy as np

D_MODEL = 1024
BATCH = 8
SEQ = 2048
DEPTH = 1
DEC_BATCH = 128
DEC_SEQ = 1
PAST_LEN = 16384
PAGE_SIZE = 128

MIX_WIDTH = D_MODEL
HGRN_WIDTH = MIX_WIDTH // 2
HGRN_HEADS = 4
HGRN_DK = HGRN_WIDTH // HGRN_HEADS
HGRN_DV = HGRN_WIDTH // HGRN_HEADS
HGRN_CHUNK = 64
POOL_WIDTH = MIX_WIDTH - HGRN_WIDTH
POOL_WINDOWS = (2, 4, 8, 16)
POOL_GROUPS = len(POOL_WINDOWS)
POOL_GROUP_DIM = POOL_WIDTH // POOL_GROUPS
POOL_STATE = max(POOL_WINDOWS) - 1
IN_PROJ = 4 * HGRN_WIDTH + POOL_WIDTH
MEM_LEN = 256
X_HEADS = 4
X_HEAD_DIM = D_MODEL // X_HEADS
D_FF = -(-8 * D_MODEL // (3 * 256)) * 256
EPS = 1e-6

kernel_name = "hgrn2_pool_hybrid_decode_step"


def rmsnorm(x, g):
    xf = x.astype(jnp.float32)
    y = xf * lax.rsqrt(jnp.mean(xf * xf, axis=-1, keepdims=True) + EPS)
    return (y * g.astype(jnp.float32)).astype(x.dtype)


def hgrn2_chunked(q, k, v, logf, s0):
    B, L, H, DK = q.shape
    DV = v.shape[-1]
    C = HGRN_CHUNK if L % HGRN_CHUNK == 0 else L
    n = L // C

    def chunks(a):
        return a.reshape(B, n, C, H, a.shape[-1]).transpose(1, 0, 3, 2, 4)

    causal = jnp.tril(jnp.ones((C, C), dtype=bool))
    mid = (C - 1) // 2

    def step(S, inp):
        qc, kc, vc, lc = inp
        b = jnp.cumsum(lc, axis=2)
        m = b[:, :, mid:mid + 1, :]
        inter = jnp.einsum('bhck,bhkv->bhcv', qc * jnp.exp(b), S)
        a = jnp.einsum('bhck,bhsk->bhcs', qc * jnp.exp(b - m), kc * jnp.exp(m - b))
        intra = jnp.einsum('bhcs,bhsv->bhcv', jnp.where(causal, a, 0.0), vc)
        b_end = b[:, :, -1:, :]
        S = jnp.exp(b_end[:, :, 0, :])[..., None] * S + jnp.einsum(
            'bhck,bhcv->bhkv', kc * jnp.exp(b_end - b), vc)
        return S, inter + intra

    S, o = lax.scan(step, s0, (chunks(q), chunks(k), chunks(v), chunks(logf)))
    return o.transpose(1, 0, 3, 2, 4).reshape(B, L, H, DV), S


def multiscale_pool(u, past, start_pos):
    B, L, _ = u.shape
    P = POOL_STATE
    ext = jnp.concatenate([past.astype(jnp.float32), u.astype(jnp.float32)], axis=1)
    cs = jnp.concatenate([jnp.zeros((B, 1, POOL_WIDTH), jnp.float32),
                          jnp.cumsum(ext, axis=1)], axis=1)
    pos = start_pos + jnp.arange(L)
    outs = []
    for g, w in enumerate(POOL_WINDOWS):
        sl = slice(g * POOL_GROUP_DIM, (g + 1) * POOL_GROUP_DIM)
        hi = cs[:, P + 1:P + 1 + L, sl]
        lo = cs[:, P + 1 - w:P + 1 - w + L, sl]
        cnt = jnp.minimum(pos + 1, w).astype(jnp.float32)[None, :, None]
        outs.append((hi - lo) / cnt)
    return jnp.concatenate(outs, axis=-1) - u.astype(jnp.float32)


def mem_kv(mem, g, w_kv):
    B, M, _ = mem.shape
    kv = rmsnorm(mem, g) @ w_kv
    k, v = jnp.split(kv, 2, axis=-1)
    return (k.reshape(B, M, X_HEADS, X_HEAD_DIM), v.reshape(B, M, X_HEADS, X_HEAD_DIM))


def cross_attend(h, mk, mv, w_q, w_o):
    B, L, _ = h.shape
    q = (h @ w_q).reshape(B, L, X_HEADS, X_HEAD_DIM)
    s = jnp.einsum('blhd,bmhd->bhlm', q.astype(jnp.float32), mk.astype(jnp.float32)) * (X_HEAD_DIM ** -0.5)
    p = jax.nn.softmax(s, axis=-1)
    o = jnp.einsum('bhlm,bmhd->blhd', p, mv.astype(jnp.float32))
    return o.reshape(B, L, D_MODEL).astype(h.dtype) @ w_o


def run_trunk(x, s_hgrn, s_pool, mem_k, mem_v, start_pos, lb_all, g_mix, w_in, hgrn_norm,
              pool_mix, pool_scale, w_out, g_cross, w_cq, w_co, g_ffn, w_ffn_in, w_ffn_out, g_final):
    B, L, _ = x.shape
    new_h, new_p = [], []
    for l in range(DEPTH):
        h = rmsnorm(x, g_mix[l])
        proj = h @ w_in[l]
        qr, fr, ir, gr, u = jnp.split(
            proj, [HGRN_WIDTH, 2 * HGRN_WIDTH, 3 * HGRN_WIDTH, 4 * HGRN_WIDTH], axis=-1)
        lb = lb_all[l]
        zf = fr.astype(jnp.float32)
        logf = jnp.log(lb + (1.0 - lb) * jax.nn.sigmoid(zf))
        kk = (1.0 - lb) * jax.nn.sigmoid(-zf)
        qq = jax.nn.silu(qr.astype(jnp.float32))
        shp = (B, L, HGRN_HEADS, HGRN_DK)
        o, S = hgrn2_chunked(qq.reshape(shp), kk.reshape(shp),
                             ir.astype(jnp.float32).reshape(B, L, HGRN_HEADS, HGRN_DV),
                             logf.reshape(shp), s_hgrn[l].astype(jnp.float32))
        o = o * lax.rsqrt(jnp.mean(o * o, axis=-1, keepdims=True) + EPS)
        o = o * hgrn_norm[l].astype(jnp.float32).reshape(HGRN_HEADS, HGRN_DV)
        y_a = o.reshape(B, L, HGRN_WIDTH) * jax.nn.sigmoid(gr.astype(jnp.float32))
        new_h.append(S.astype(x.dtype))
        past = s_pool[l].astype(u.dtype)
        pooled = multiscale_pool(u, past, start_pos)
        y_b = jnp.einsum('blgc,gcd->blgd',
                         pooled.reshape(B, L, POOL_GROUPS, POOL_GROUP_DIM),
                         pool_mix[l].astype(jnp.float32)).reshape(B, L, POOL_WIDTH)
        y_b = y_b * pool_scale[l].astype(jnp.float32)
        new_p.append(jnp.concatenate([past, u], axis=1)[:, -POOL_STATE:].astype(x.dtype))
        x = x + jnp.concatenate([y_a, y_b], axis=-1).astype(x.dtype) @ w_out[l]
        x = x + cross_attend(rmsnorm(x, g_cross[l]), mem_k[l], mem_v[l], w_cq[l], w_co[l])
        a, bgate = jnp.split(rmsnorm(x, g_ffn[l]) @ w_ffn_in[l], 2, axis=-1)
        x = x + (jax.nn.silu(a) * bgate) @ w_ffn_out[l]
    return rmsnorm(x, g_final), jnp.stack(new_h), jnp.stack(new_p)


def setup_inputs(seed: int = 0) -> dict:
    key = jax.random.key(seed)
    ks = jax.random.split(key, 24)
    f32 = jnp.float32
    nrm = lambda k, s, sc: jax.random.normal(k, s, f32) * sc
    gain = lambda k, s: 1.0 + 0.02 * jax.random.normal(k, s, f32)
    return {
        "x_prompt": nrm(ks[0], (BATCH, SEQ, D_MODEL), 1.0),
        "x_sample": nrm(ks[1], (DEC_BATCH, DEC_SEQ, D_MODEL), 1.0),
        "mem_prompt": nrm(ks[2], (BATCH, MEM_LEN, D_MODEL), 1.0),
        "state_hgrn": nrm(ks[3], (DEPTH, DEC_BATCH, HGRN_HEADS, HGRN_DK, HGRN_DV), 0.3),
        "state_pool": nrm(ks[4], (DEPTH, DEC_BATCH, POOL_STATE, POOL_WIDTH), 1.0),
        "cache_mem_k": nrm(ks[5], (DEPTH, DEC_BATCH, MEM_LEN, X_HEADS, X_HEAD_DIM), 1.0),
        "cache_mem_v": nrm(ks[6], (DEPTH, DEC_BATCH, MEM_LEN, X_HEADS, X_HEAD_DIM), 1.0),
        "g_mix": gain(ks[7], (DEPTH, D_MODEL)),
        "w_in": nrm(ks[8], (DEPTH, D_MODEL, IN_PROJ), D_MODEL ** -0.5),
        "hgrn_lb": nrm(ks[9], (DEPTH + 1, HGRN_WIDTH), 0.1),
        "hgrn_norm": gain(ks[10], (DEPTH, HGRN_WIDTH)),
        "pool_mix": nrm(ks[11], (DEPTH, POOL_GROUPS, POOL_GROUP_DIM, POOL_GROUP_DIM), POOL_GROUP_DIM ** -0.5),
        "pool_scale": gain(ks[12], (DEPTH, POOL_WIDTH)),
        "w_out": nrm(ks[13], (DEPTH, MIX_WIDTH, D_MODEL), MIX_WIDTH ** -0.5),
        "g_mem": gain(ks[14], (DEPTH, D_MODEL)),
        "w_mem_kv": nrm(ks[15], (DEPTH, D_MODEL, 2 * D_MODEL), D_MODEL ** -0.5),
        "g_cross": gain(ks[16], (DEPTH, D_MODEL)),
        "w_cq": nrm(ks[17], (DEPTH, D_MODEL, D_MODEL), D_MODEL ** -0.5),
        "w_co": nrm(ks[18], (DEPTH, D_MODEL, D_MODEL), D_MODEL ** -0.5),
        "g_ffn": gain(ks[19], (DEPTH, D_MODEL)),
        "w_ffn_in": nrm(ks[20], (DEPTH, D_MODEL, 2 * D_FF), D_MODEL ** -0.5),
        "w_ffn_out": nrm(ks[21], (DEPTH, D_FF, D_MODEL), D_FF ** -0.5),
        "g_final": gain(ks[22], (D_MODEL,)),
    }


def reference(x_prompt, x_sample, mem_prompt, state_hgrn, state_pool, cache_mem_k, cache_mem_v,
              g_mix, w_in, hgrn_lb, hgrn_norm, pool_mix, pool_scale, w_out, g_mem, w_mem_kv,
              g_cross, w_cq, w_co, g_ffn, w_ffn_in, w_ffn_out, g_final):
    lb_all = jnp.cumsum(jax.nn.softmax(hgrn_lb.astype(jnp.float32), axis=0), axis=0)
    kv = [mem_kv(mem_prompt, g_mem[l], w_mem_kv[l]) for l in range(DEPTH)]
    new_mem_k = jnp.stack([p[0] for p in kv])
    new_mem_v = jnp.stack([p[1] for p in kv])
    s0_hgrn = jnp.zeros((DEPTH, BATCH, HGRN_HEADS, HGRN_DK, HGRN_DV), x_prompt.dtype)
    s0_pool = jnp.zeros((DEPTH, BATCH, POOL_STATE, POOL_WIDTH), x_prompt.dtype)
    y_prompt, hgrn_p, pool_p = run_trunk(
        x_prompt, s0_hgrn, s0_pool, new_mem_k, new_mem_v, 0, lb_all, g_mix, w_in, hgrn_norm,
        pool_mix, pool_scale, w_out, g_cross, w_cq, w_co, g_ffn, w_ffn_in, w_ffn_out, g_final)
    y_sample, hgrn_s, pool_s = run_trunk(
        x_sample, state_hgrn, state_pool, cache_mem_k, cache_mem_v, PAST_LEN, lb_all, g_mix, w_in,
        hgrn_norm, pool_mix, pool_scale, w_out, g_cross, w_cq, w_co, g_ffn, w_ffn_in, w_ffn_out, g_final)
    return (y_prompt, y_sample, hgrn_p, pool_p, new_mem_k, new_mem_v, hgrn_s, pool_s)
```

```cpp
#include <hip/hip_runtime.h>
#include <hip/hip_cooperative_groups.h>
#include <cstdio>
#include <cstdint>
namespace cg = cooperative_groups;
namespace pg8 {
#define PG8_LAS __attribute__((address_space(3)))
typedef unsigned short bf16_t;
typedef short bf16x8 __attribute__((ext_vector_type(8)));
typedef float f32x4 __attribute__((ext_vector_type(4)));
typedef unsigned u32x4 __attribute__((ext_vector_type(4)));
constexpr int BM = 256, BK = 64, HALF = 128, HTB = HALF * BK * 2  , STAGE_BYTES = 8 * HTB, NXCD = 8, WGM = 8;

__host__ __device__ __forceinline__ int lds_byte(int r, int c) { const int st = (r >> 4) * 2 + (c >> 5), rr = r & 15, cc = c & 31, ob = rr * 64 + cc * 2; return st * 1024 + (ob ^ (((ob >> 9) & 1) << 5)); }
__host__ __device__ __forceinline__ void stage_rc(int b, int& R, int& C) { const int st = b / 1024, sb = b % 1024, swz = sb ^ (((sb >> 9) & 1) << 5); R = (st >> 1) * 16 + swz / 64; C = (st & 1) * 32 + (swz % 64) / 2; }
__host__ __device__ __forceinline__ int perm32(int rho) { const int n = rho >> 4, i = rho & 15; return 8 * (i >> 2) + 4 * n + (i & 3); }

struct Unit { int pm, pn; };
struct Gemm { const bf16_t* A; const bf16_t* Bt; int M, N, K; };

struct StaticOrder {
    int nM, nN, nwg, G, c;
    __host__ __device__ void init(int M, int N, int G_, int c_) { nM = M / BM; nN = N / BM; nwg = nM * nN; G = G_; c = c_; }
    __host__ __device__ bool next(int i, Unit& u) const {
        const long L = (long)i * G + c; if (L >= nwg) return false;
        int wgid = (int)L; { const int q = nwg / NXCD, r = nwg % NXCD, xcd = wgid % NXCD, off = wgid / NXCD; wgid = (xcd < r ? xcd * (q + 1) : r * (q + 1) + (xcd - r) * q) + off; }
        const int nig = WGM * nN, gid = wgid / nig, fm = gid * WGM, gsz = (nM - fm) < WGM ? (nM - fm) : WGM;
        u.pm = fm + ((wgid % nig) % gsz); u.pn = (wgid % nig) / gsz; return true;
    }
    __device__ __forceinline__ void a_ready(const Unit&) const {}
    __device__ __forceinline__ void done(const Unit&) const {}
};

__device__ __forceinline__ unsigned cvt_pk_bf16(float lo, float hi) { unsigned r; asm volatile("v_cvt_pk_bf16_f32 %0, %1, %2" : "=v"(r) : "v"(lo), "v"(hi)); return r; }
typedef unsigned u32x2 __attribute__((ext_vector_type(2)));
__device__ __forceinline__ float sigm(float z) { return 1.0f / (1.0f + __expf(-z)); }
constexpr float RMS_EPS = 1e-6f;

struct EpiInProj {
    static constexpr bool PERM = true, AFTER_DRAIN = false;
    bf16_t *QQ, *KK, *VV, *GG; float *LF, *UU; const float* lbraw;
    __device__ __forceinline__ void operator()(const f32x4 (&acc)[2][2][4][2], const Unit& u, int wr, int wc, int fr, int fq) const {
        const int seg = u.pn >> 1, colt = (u.pn & 1) * 256;
        const int row0 = u.pm * BM + wr * 64 + fr;
#pragma unroll
        for (int bj = 0; bj < 2; ++bj) {
            const int cs = colt + bj * HALF + wc * 32 + 8 * fq;
            float lb[8];
            if (seg == 1) {
#pragma unroll
                for (int j = 0; j < 8; ++j) { const float l0 = lbraw[cs + j], l1 = lbraw[512 + cs + j]; lb[j] = 1.0f / (1.0f + __expf(l1 - l0)); }
            } else {
#pragma unroll
                for (int j = 0; j < 8; ++j) lb[j] = 0.f;
            }
#pragma unroll
            for (int ai = 0; ai < 2; ++ai)
#pragma unroll
                for (int m = 0; m < 4; ++m) {
                    const size_t off = (size_t)(row0 + ai * HALF + m * 16) * 512 + cs;
                    const f32x4 v0 = acc[ai][bj][m][0], v1 = acc[ai][bj][m][1];
                    float z[8] = {v0[0], v0[1], v0[2], v0[3], v1[0], v1[1], v1[2], v1[3]};
                    if (seg == 0) {
#pragma unroll
                        for (int j = 0; j < 8; ++j) z[j] = z[j] * sigm(z[j]);
                        u32x4 w; w.x = cvt_pk_bf16(z[0], z[1]); w.y = cvt_pk_bf16(z[2], z[3]); w.z = cvt_pk_bf16(z[4], z[5]); w.w = cvt_pk_bf16(z[6], z[7]);
                        *(u32x4*)(QQ + off) = w;
                    } else if (seg == 1) {
                        float lf[8], kk[8];
#pragma unroll
                        for (int j = 0; j < 8; ++j) { const float e = __expf(-z[j]); const float sg = 1.0f / (1.0f + e); const float sgn = e / (1.0f + e);
                            lf[j] = __logf(lb[j] + (1.0f - lb[j]) * sg); kk[j] = (1.0f - lb[j]) * sgn; }
                        *(f32x4*)(LF + off) = (f32x4){lf[0], lf[1], lf[2], lf[3]}; *(f32x4*)(LF + off + 4) = (f32x4){lf[4], lf[5], lf[6], lf[7]};
                        u32x4 w; w.x = cvt_pk_bf16(kk[0], kk[1]); w.y = cvt_pk_bf16(kk[2], kk[3]); w.z = cvt_pk_bf16(kk[4], kk[5]); w.w = cvt_pk_bf16(kk[6], kk[7]);
                        *(u32x4*)(KK + off) = w;
                    } else if (seg == 2) {
                        u32x4 w; w.x = cvt_pk_bf16(z[0], z[1]); w.y = cvt_pk_bf16(z[2], z[3]); w.z = cvt_pk_bf16(z[4], z[5]); w.w = cvt_pk_bf16(z[6], z[7]);
                        *(u32x4*)(VV + off) = w;
                    } else if (seg == 3) {
#pragma unroll
                        for (int j = 0; j < 8; ++j) z[j] = sigm(z[j]);
                        u32x4 w; w.x = cvt_pk_bf16(z[0], z[1]); w.y = cvt_pk_bf16(z[2], z[3]); w.z = cvt_pk_bf16(z[4], z[5]); w.w = cvt_pk_bf16(z[6], z[7]);
                        *(u32x4*)(GG + off) = w;
                    } else {
                        *(f32x4*)(UU + off) = v0; *(f32x4*)(UU + off + 4) = v1;
                    }
                }
        }
    }
};

struct EpiMemKV {
    static constexpr bool PERM = true, AFTER_DRAIN = false;
    float *outK, *outV; bf16_t* KB;
    __device__ __forceinline__ void operator()(const f32x4 (&acc)[2][2][4][2], const Unit& u, int wr, int wc, int fr, int fq) const {
        const bool isk = u.pn < 4; float* o = isk ? outK : outV; const int colt = (u.pn & 3) * 256;
        const int row0 = u.pm * BM + wr * 64 + fr;
#pragma unroll
        for (int ai = 0; ai < 2; ++ai)
#pragma unroll
            for (int m = 0; m < 4; ++m)
#pragma unroll
                for (int bj = 0; bj < 2; ++bj) {
                    const size_t off = (size_t)(row0 + ai * HALF + m * 16) * 1024 + colt + bj * HALF + wc * 32 + 8 * fq;
                    const f32x4 v0 = acc[ai][bj][m][0], v1 = acc[ai][bj][m][1];
                    *(f32x4*)(o + off) = v0; *(f32x4*)(o + off + 4) = v1;
                    if (isk) { u32x4 w; w.x = cvt_pk_bf16(v0[0], v0[1]); w.y = cvt_pk_bf16(v0[2], v0[3]); w.z = cvt_pk_bf16(v1[0], v1[1]); w.w = cvt_pk_bf16(v1[2], v1[3]); *(u32x4*)(KB + off) = w; }
                }
    }
};

struct EpiBf16Scale {
    static constexpr bool PERM = true, AFTER_DRAIN = false;
    bf16_t* O; int ldc; const float* ss; float scale;
    __device__ __forceinline__ void operator()(const f32x4 (&acc)[2][2][4][2], const Unit& u, int wr, int wc, int fr, int fq) const {
        const int row0 = u.pm * BM + wr * 64 + fr;
#pragma unroll
        for (int ai = 0; ai < 2; ++ai)
#pragma unroll
            for (int m = 0; m < 4; ++m) {
                const int row = row0 + ai * HALF + m * 16;
                const float sc = ss ? scale * __builtin_amdgcn_rsqf(ss[row] * (1.0f / 1024.0f) + RMS_EPS) : scale;
#pragma unroll
                for (int bj = 0; bj < 2; ++bj) {
                    const size_t off = (size_t)row * ldc + u.pn * BM + bj * HALF + wc * 32 + 8 * fq;
                    const f32x4 v0 = acc[ai][bj][m][0] * sc, v1 = acc[ai][bj][m][1] * sc;
                    u32x4 w; w.x = cvt_pk_bf16(v0[0], v0[1]); w.y = cvt_pk_bf16(v0[2], v0[3]); w.z = cvt_pk_bf16(v1[0], v1[1]); w.w = cvt_pk_bf16(v1[2], v1[3]);
                    *(u32x4*)(O + off) = w;
                }
            }
    }
};

struct EpiResid {
    static constexpr bool PERM = true, AFTER_DRAIN = false;
    const float* baseP; const float* baseS; int base_rows;
    float* out; int out_rows;
    bf16_t* outb; float* ss;
    __device__ __forceinline__ void operator()(const f32x4 (&acc)[2][2][4][2], const Unit& u, int wr, int wc, int fr, int fq) const {
        const int row0 = u.pm * BM + wr * 64 + fr;
#pragma unroll
        for (int ai = 0; ai < 2; ++ai)
#pragma unroll
            for (int m = 0; m < 4; ++m) {
                const int row = row0 + ai * HALF + m * 16;
                const float* bp = row < 16384 ? baseP + (size_t)row * 1024 : baseS + (size_t)(row - 16384) * 1024;
                const bool bok = row < base_rows, ook = row < out_rows;
                float s = 0.f;
#pragma unroll
                for (int bj = 0; bj < 2; ++bj) {
                    const int col = u.pn * BM + bj * HALF + wc * 32 + 8 * fq;
                    f32x4 b0 = (f32x4){0.f, 0.f, 0.f, 0.f}, b1 = b0;
                    if (bok) { b0 = *(const f32x4*)(bp + col); b1 = *(const f32x4*)(bp + col + 4); }
                    const f32x4 v0 = acc[ai][bj][m][0] + b0, v1 = acc[ai][bj][m][1] + b1;
                    s += (v0[0] * v0[0] + v0[1] * v0[1]) + (v0[2] * v0[2] + v0[3] * v0[3]) + (v1[0] * v1[0] + v1[1] * v1[1]) + (v1[2] * v1[2] + v1[3] * v1[3]);
                    if (ook) { *(f32x4*)(out + (size_t)row * 1024 + col) = v0; *(f32x4*)(out + (size_t)row * 1024 + col + 4) = v1; }
                    if (outb) { u32x4 w; w.x = cvt_pk_bf16(v0[0], v0[1]); w.y = cvt_pk_bf16(v0[2], v0[3]); w.z = cvt_pk_bf16(v1[0], v1[1]); w.w = cvt_pk_bf16(v1[2], v1[3]); *(u32x4*)(outb + (size_t)row * 1024 + col) = w; }
                }
                s += __shfl_xor(s, 16); s += __shfl_xor(s, 32);
                if (fq == 0) atomicAdd(ss + row, s);
            }
    }
};

struct EpiSwiGLU {
    static constexpr bool PERM = true, AFTER_DRAIN = false;
    bf16_t* ACT; const float* ss;
    __device__ __forceinline__ void operator()(const f32x4 (&acc)[2][2][4][2], const Unit& u, int wr, int wc, int fr, int fq) const {
        const int row0 = u.pm * BM + wr * 64 + fr;
#pragma unroll
        for (int ai = 0; ai < 2; ++ai)
#pragma unroll
            for (int m = 0; m < 4; ++m) {
                const int row = row0 + ai * HALF + m * 16;
                const float r = __builtin_amdgcn_rsqf(ss[row] * (1.0f / 1024.0f) + RMS_EPS);
#pragma unroll
                for (int bj = 0; bj < 2; ++bj) {
                    const int J = u.pn * 128 + bj * 64 + wc * 16 + 4 * fq;
                    const f32x4 a = acc[ai][bj][m][0] * r, b = acc[ai][bj][m][1] * r;
                    float o[4];
#pragma unroll
                    for (int j = 0; j < 4; ++j) o[j] = a[j] * sigm(a[j]) * b[j];
                    u32x2 w; w.x = cvt_pk_bf16(o[0], o[1]); w.y = cvt_pk_bf16(o[2], o[3]);
                    *(u32x2*)(ACT + (size_t)row * 2816 + J) = w;
                }
            }
    }
};

template <class Epi, class Sched, bool ALIGN_EPI = false, bool SP2 = false>
__device__ __forceinline__ void gemm_phase(PG8_LAS unsigned char* lds, const Gemm g, const Sched& S, const Epi& E) {
    const int tid = threadIdx.x, wid = __builtin_amdgcn_readfirstlane(tid >> 6), lane = tid & 63, wr = wid >> 2, wc = wid & 3, fr = lane & 15, fq = lane >> 4;
    const int K = g.K, nt = K / BK;
    unsigned voffA[2], voffB[2];
#pragma unroll
    for (int i = 0; i < 2; ++i) { int R, C; stage_rc(tid * 16 + i * 8192, R, C); const int Rb = Epi::PERM ? ((R & ~31) + perm32(R & 31)) : R;
        voffA[i] = (unsigned)(R * K + C) * 2u; voffB[i] = (unsigned)(Rb * K + C) * 2u; }
    const size_t kstep = (size_t)(BK * 2);
    const size_t hstep = (size_t)HALF * K * 2;
    const size_t tstep = 2 * hstep;
    const unsigned ldsw = (unsigned)wid * 1024u;
    const int aoff = lds_byte(wr * 64 + fr, fq * 8), boff = lds_byte(wc * 32 + fr, fq * 8);
#define PG8_SA(b, h) (((b) * 2 + (h)) * HTB)
#define PG8_SB(b, h) ((4 + (b) * 2 + (h)) * HTB)
#define PG8_STAGE(bufoff, gbase, voff) do { _Pragma("unroll") for (int _i = 0; _i < 2; ++_i) \
        __builtin_amdgcn_global_load_lds((const unsigned*)((const char*)(gbase) + (voff)[_i]), (PG8_LAS unsigned*)(lds + (bufoff) + ldsw + _i * 8192), 16, 0, 0); } while (0)
#define PG8_LDA(dst, b, h) do { _Pragma("unroll") for (int m = 0; m < 4; ++m) _Pragma("unroll") for (int k = 0; k < 2; ++k) dst[m][k] = *(const PG8_LAS bf16x8*)(lds + PG8_SA(b, h) + aoff + m * 2048 + k * 1024); } while (0)
#define PG8_LDB(dst, b, h) do { _Pragma("unroll") for (int n = 0; n < 2; ++n) _Pragma("unroll") for (int k = 0; k < 2; ++k) dst[n][k] = *(const PG8_LAS bf16x8*)(lds + PG8_SB(b, h) + boff + n * 2048 + k * 1024); } while (0)
#define PG8_MMA(ai, bj, At, Bt) do { __builtin_amdgcn_s_setprio(1); _Pragma("unroll") for (int m = 0; m < 4; ++m) _Pragma("unroll") for (int n = 0; n < 2; ++n) _Pragma("unroll") for (int k = 0; k < 2; ++k) \
        acc[ai][bj][m][n] = __builtin_amdgcn_mfma_f32_16x16x32_bf16(Bt[n][k], At[m][k], acc[ai][bj][m][n], 0, 0, 0); __builtin_amdgcn_s_setprio(0); } while (0)
#define PG8_WAIT_V(n) asm volatile("s_waitcnt vmcnt(" #n ")" ::: "memory")
#define PG8_WAIT_L(n) asm volatile("s_waitcnt lgkmcnt(" #n ")" ::: "memory")
#define PG8_BAR __builtin_amdgcn_s_barrier()
#define PG8_SCHED __builtin_amdgcn_sched_barrier(0)
    Unit cur, nxt; int ui = 0;
    if (!S.next(0, cur)) return;
    f32x4 acc[2][2][4][2];
#pragma unroll
    for (int a = 0; a < 2; ++a)
#pragma unroll
        for (int b = 0; b < 2; ++b)
#pragma unroll
            for (int m = 0; m < 4; ++m)
#pragma unroll
                for (int n = 0; n < 2; ++n) acc[a][b][m][n] = (f32x4){0.f, 0.f, 0.f, 0.f};
    bf16x8 At[4][2], B0[2][2], B1[2][2];
    const char* cA = (const char*)g.A + (size_t)cur.pm * tstep; const char* cB = (const char*)g.Bt + (size_t)cur.pn * tstep;
    S.a_ready(cur);
    if constexpr (SP2) {
        PG8_STAGE(PG8_SB(0, 0), cB, voffB); PG8_STAGE(PG8_SB(0, 1), cB + hstep, voffB); PG8_STAGE(PG8_SA(0, 0), cA, voffA); PG8_STAGE(PG8_SA(0, 1), cA + hstep, voffA);
        if (wr == 1) PG8_BAR;
        PG8_WAIT_V(2); PG8_BAR;
        PG8_STAGE(PG8_SB(1, 0), cB + kstep, voffB); PG8_STAGE(PG8_SA(1, 0), cA + kstep, voffA); PG8_STAGE(PG8_SB(1, 1), cB + hstep + kstep, voffB);
        PG8_WAIT_V(6); PG8_BAR;
    } else {
        PG8_STAGE(PG8_SB(0, 0), cB, voffB); PG8_STAGE(PG8_SA(0, 0), cA, voffA); PG8_STAGE(PG8_SB(0, 1), cB + hstep, voffB); PG8_STAGE(PG8_SA(0, 1), cA + hstep, voffA);
        if (wr == 1) PG8_BAR;
        PG8_WAIT_V(4); PG8_BAR;
        PG8_STAGE(PG8_SB(1, 0), cB + kstep, voffB); PG8_STAGE(PG8_SA(1, 0), cA + kstep, voffA); PG8_STAGE(PG8_SB(1, 1), cB + hstep + kstep, voffB);
        PG8_WAIT_V(6); PG8_BAR;
    }
    for (;;) {
        const bool has_next = S.next(ui + 1, nxt);
        const char* nA = has_next ? (const char*)g.A + (size_t)nxt.pm * tstep : cA; const char* nB = has_next ? (const char*)g.Bt + (size_t)nxt.pn * tstep : cB;
        for (int t = 0; t < nt; t += 2) {
            const bool last = (t == nt - 2);
            const char* a1 = cA + (size_t)(t + 1) * kstep;
            const char* a2 = last ? nA : cA + (size_t)(t + 2) * kstep; const char* b2 = last ? nB : cB + (size_t)(t + 2) * kstep;
            const char* a3 = a2 + kstep; const char* b3 = b2 + kstep;
            if (last && has_next) S.a_ready(nxt);
            if constexpr (SP2) {
            PG8_LDB(B0, 0, 0); PG8_LDB(B1, 0, 1); PG8_SCHED; PG8_LDA(At, 0, 0); PG8_STAGE(PG8_SA(1, 1), a1 + hstep, voffA);
            PG8_WAIT_V(8); PG8_WAIT_L(0); PG8_BAR; PG8_MMA(0, 0, At, B0); PG8_MMA(0, 1, At, B1); PG8_BAR; PG8_SCHED;
            PG8_LDA(At, 0, 1); PG8_STAGE(PG8_SB(0, 0), b2, voffB); PG8_STAGE(PG8_SB(0, 1), b2 + hstep, voffB); PG8_STAGE(PG8_SA(0, 0), a2, voffA);
            PG8_WAIT_V(8); PG8_WAIT_L(0); PG8_BAR; PG8_MMA(1, 0, At, B0); PG8_MMA(1, 1, At, B1); PG8_BAR; PG8_SCHED;
            PG8_LDB(B0, 1, 0); PG8_LDB(B1, 1, 1); PG8_SCHED; PG8_LDA(At, 1, 0); PG8_STAGE(PG8_SA(0, 1), a2 + hstep, voffA);
            PG8_WAIT_V(8); PG8_WAIT_L(0); PG8_BAR; PG8_MMA(0, 0, At, B0); PG8_MMA(0, 1, At, B1); PG8_BAR; PG8_SCHED;
            PG8_LDA(At, 1, 1); PG8_STAGE(PG8_SB(1, 0), b3, voffB); PG8_STAGE(PG8_SB(1, 1), b3 + hstep, voffB); PG8_STAGE(PG8_SA(1, 0), a3, voffA);
            PG8_WAIT_V(8); PG8_WAIT_L(0); PG8_BAR; PG8_MMA(1, 0, At, B0); PG8_MMA(1, 1, At, B1); PG8_BAR; PG8_SCHED;
            } else {
            PG8_LDB(B0, 0, 0); PG8_SCHED; PG8_LDA(At, 0, 0); PG8_STAGE(PG8_SA(1, 1), a1 + hstep, voffA);
            PG8_WAIT_L(8); PG8_BAR; PG8_WAIT_L(0); PG8_MMA(0, 0, At, B0); PG8_BAR; PG8_SCHED;
            PG8_LDB(B1, 0, 1); PG8_STAGE(PG8_SB(0, 0), b2, voffB);
            PG8_BAR; PG8_WAIT_L(0); PG8_MMA(0, 1, At, B1); PG8_BAR;
            PG8_LDA(At, 0, 1); PG8_STAGE(PG8_SA(0, 0), a2, voffA);
            PG8_BAR; PG8_WAIT_L(0); PG8_MMA(1, 0, At, B0); PG8_BAR; PG8_SCHED;
            PG8_STAGE(PG8_SB(0, 1), b2 + hstep, voffB);
            PG8_WAIT_V(6); PG8_BAR; PG8_MMA(1, 1, At, B1); PG8_BAR;
            PG8_LDB(B0, 1, 0); PG8_SCHED; PG8_LDA(At, 1, 0); PG8_STAGE(PG8_SA(0, 1), a2 + hstep, voffA);
            PG8_WAIT_L(8); PG8_BAR; PG8_WAIT_L(0); PG8_MMA(0, 0, At, B0); PG8_BAR; PG8_SCHED;
            PG8_LDB(B1, 1, 1); PG8_STAGE(PG8_SB(1, 0), b3, voffB);
            PG8_BAR; PG8_WAIT_L(0); PG8_MMA(0, 1, At, B1); PG8_BAR;
            PG8_LDA(At, 1, 1); PG8_STAGE(PG8_SA(1, 0), a3, voffA);
            PG8_BAR; PG8_WAIT_L(0); PG8_MMA(1, 0, At, B0); PG8_BAR; PG8_SCHED;
            PG8_STAGE(PG8_SB(1, 1), b3 + hstep, voffB);
            PG8_WAIT_V(6); PG8_BAR; PG8_MMA(1, 1, At, B1); PG8_BAR;
            }
        }
        if constexpr (ALIGN_EPI) { if (wr == 0) PG8_BAR; }
        if constexpr (!Epi::AFTER_DRAIN) { E(acc, cur, wr, wc, fr, fq); S.done(cur); }
        if (!has_next) break;
#pragma unroll
        for (int a = 0; a < 2; ++a)
#pragma unroll
            for (int b = 0; b < 2; ++b)
#pragma unroll
                for (int m = 0; m < 4; ++m)
#pragma unroll
                    for (int n = 0; n < 2; ++n) acc[a][b][m][n] = (f32x4){0.f, 0.f, 0.f, 0.f};
        cur = nxt; cA = nA; cB = nB; ++ui;
        if constexpr (ALIGN_EPI) { if (wr == 1) PG8_BAR; }
    }
    PG8_WAIT_V(0);
    if constexpr (!ALIGN_EPI) { if (wr == 0) PG8_BAR; }
    PG8_BAR;
    if constexpr (Epi::AFTER_DRAIN) { E.fused(acc, cur, wr, wc, fr, fq, lds, wid, lane); S.done(cur); }
#undef PG8_SA
#undef PG8_SB
#undef PG8_STAGE
#undef PG8_LDA
#undef PG8_LDB
#undef PG8_MMA
#undef PG8_WAIT_V
#undef PG8_WAIT_L
#undef PG8_BAR
#undef PG8_SCHED
}
}

using pg8::bf16_t; using pg8::f32x4; using pg8::u32x4; using pg8::bf16x8;
typedef unsigned u32x2v __attribute__((ext_vector_type(2)));
constexpr int DM = 1024, NPR = 16384, NSM = 128, MT = 16640, NVALID = 16512, SEQ = 2048;
constexpr int HW = 512, NIN = 2560, DFF = 2816, NFF2 = 5632, MEMR = 2048;
constexpr float EPS = 1e-6f;
constexpr int NTHREADS = 512;
constexpr int LDS_BYTES = 147456;

constexpr size_t O_YP = 0, O_YS = 16777216, O_HP = 16908288, O_PP = 17432576, O_MK = 17494016, O_MV = 19591168, O_HS = 21688320, O_PS = 30076928;

constexpr size_t MiB = 1u << 20;
constexpr size_t WS_SS1 = 0, WS_SS2 = 128 * 1024, WS_SS3 = 256 * 1024;
constexpr size_t WS_WIN = 1 * MiB, WS_WOUT = 6 * MiB, WS_WCQ = 8 * MiB, WS_WCO = 10 * MiB, WS_WFFI = 12 * MiB, WS_WFFO = 23 * MiB, WS_WKV = 29 * MiB, WS_PMIX = 33 * MiB;
constexpr size_t WS_MEMH = 34 * MiB, WS_KB = 38 * MiB, WS_VT = 42 * MiB, WS_DEC = 46 * MiB;
constexpr size_t WS_H0 = 47 * MiB;
constexpr size_t WS_MIX = 80 * MiB;
constexpr size_t WS_X1 = 113 * MiB;
constexpr size_t WS_Q = 178 * MiB;
constexpr size_t WS_O = 211 * MiB;
constexpr size_t WS_SL = 244 * MiB;
constexpr size_t WS_A = 309 * MiB;
constexpr size_t WS_QQ = WS_A, WS_KK = WS_A + 17 * MiB, WS_VV = WS_A + 34 * MiB, WS_GG = WS_A + 51 * MiB, WS_LF = WS_A + 68 * MiB, WS_UU = WS_A + 101 * MiB;
constexpr size_t WS_END = 443 * MiB;

struct Args { const float* in[23]; float* out; unsigned char* ws; int ph_lo, ph_hi; };

__device__ __forceinline__ unsigned f2bf(float f) { unsigned u = __builtin_bit_cast(unsigned, f); return (u + 0x7fffu + ((u >> 16) & 1u)) >> 16; }
__device__ __forceinline__ unsigned pk2(float lo, float hi) { return f2bf(lo) | (f2bf(hi) << 16); }
__device__ __forceinline__ float bf2f(unsigned h) { return __uint_as_float(h << 16); }
__device__ __forceinline__ float bfe(const u32x4& v, int j) { const unsigned w = v[j >> 1]; return (j & 1) ? __uint_as_float(w & 0xffff0000u) : __uint_as_float(w << 16); }
__device__ __forceinline__ unsigned short bfr(const u32x4& v, int j) { const unsigned w = v[j >> 1]; return (unsigned short)((j & 1) ? (w >> 16) : (w & 0xffffu)); }
__device__ __forceinline__ float wave_sum(float v) {
#pragma unroll
    for (int o = 1; o < 64; o <<= 1) v += __shfl_xor(v, o);
    return v;
}
#define MFMA16(a, b, c) __builtin_amdgcn_mfma_f32_16x16x32_bf16((a), (b), (c), 0, 0, 0)

template <int MODE>
__device__ __forceinline__ void tr_item(const float* W, int K, int N, bf16_t* WT, const float* gk, float* scr, int item, int lane) {
    const int nblk = N / 32, kb = item / nblk, nb = item % nblk, k0 = 64 * kb, n0 = 32 * nb;
#pragma unroll 8
    for (int i = 0; i < 32; ++i) { const int kk = 2 * i + (lane >> 5); scr[kk * 33 + (lane & 31)] = W[(size_t)(k0 + kk) * N + n0 + (lane & 31)]; }
    asm volatile("s_waitcnt lgkmcnt(0)" ::: "memory");
    const int c = lane & 7;
    float g8[8];
#pragma unroll
    for (int i = 0; i < 8; ++i) g8[i] = gk ? gk[k0 + 8 * c + i] : 1.0f;
#pragma unroll
    for (int j = 0; j < 4; ++j) { const int n = (lane >> 3) + 8 * j; const float* s = scr + (8 * c) * 33 + n;
        u32x4 o; o.x = pk2(s[0 * 33] * g8[0], s[1 * 33] * g8[1]); o.y = pk2(s[2 * 33] * g8[2], s[3 * 33] * g8[3]); o.z = pk2(s[4 * 33] * g8[4], s[5 * 33] * g8[5]); o.w = pk2(s[6 * 33] * g8[6], s[7 * 33] * g8[7]);
        int row = n0 + n;
        if (MODE == 1) { const int half = row >= DFF ? 1 : 0; const int J = row - half * DFF;
            row = 256 * (J >> 7) + 128 * ((J >> 6) & 1) + 32 * ((J >> 4) & 3) + 8 * ((J >> 2) & 3) + 4 * half + (J & 3); }
        *(u32x4*)(WT + (size_t)row * K + k0 + 8 * c) = o; }
    asm volatile("s_waitcnt lgkmcnt(0)" ::: "memory");
}
__device__ __forceinline__ void rms_row_to_bf16(const float* xrow, const float* g, bf16_t* orow, int lane) {
    const f32x4* xr = (const f32x4*)xrow + lane; const f32x4* gr = (const f32x4*)g + lane;
    f32x4 v[4]; float s = 0.f;
#pragma unroll
    for (int j = 0; j < 4; ++j) { v[j] = xr[64 * j]; s += (v[j].x * v[j].x + v[j].y * v[j].y) + (v[j].z * v[j].z + v[j].w * v[j].w); }
    const float rstd = 1.0f / sqrtf(wave_sum(s) * (1.f / DM) + EPS);
    unsigned long long* o8 = (unsigned long long*)orow + lane;
#pragma unroll
    for (int j = 0; j < 4; ++j) { const f32x4 gg = gr[64 * j];
        o8[64 * j] = (unsigned long long)pk2(v[j].x * rstd * gg.x, v[j].y * rstd * gg.y) | ((unsigned long long)pk2(v[j].z * rstd * gg.z, v[j].w * rstd * gg.w) << 32); }
}
__device__ __forceinline__ void p0_prologue(const Args& A, unsigned char* lds, int G) {
    const int tid = threadIdx.x, lane = tid & 63, wave = tid >> 6;
    float* scr = (float*)(lds + wave * 16384);
    unsigned char* ws = A.ws;
    const int gw = blockIdx.x * 8 + wave, NGW = G * 8;
    constexpr int I_IN = 16 * 80, I_OUT = 16 * 32, I_CQ = 16 * 32, I_CO = 16 * 32, I_FFI = 16 * 176, I_FFO = 44 * 32, I_KV = 16 * 64, I_PM = 4 * 8;
    constexpr int NITEMS = I_IN + I_OUT + I_CQ + I_CO + I_FFI + I_FFO + I_KV + I_PM;
    for (int it = gw; it < NITEMS; it += NGW) {
        int r = it;
        if (r < I_IN) { tr_item<0>(A.in[8], DM, NIN, (bf16_t*)(ws + WS_WIN), nullptr, scr, r, lane); continue; } r -= I_IN;
        if (r < I_OUT) { tr_item<0>(A.in[13], DM, DM, (bf16_t*)(ws + WS_WOUT), nullptr, scr, r, lane); continue; } r -= I_OUT;
        if (r < I_CQ) { tr_item<0>(A.in[17], DM, DM, (bf16_t*)(ws + WS_WCQ), A.in[16], scr, r, lane); continue; } r -= I_CQ;
        if (r < I_CO) { tr_item<0>(A.in[18], DM, DM, (bf16_t*)(ws + WS_WCO), nullptr, scr, r, lane); continue; } r -= I_CO;
        if (r < I_FFI) { tr_item<1>(A.in[20], DM, NFF2, (bf16_t*)(ws + WS_WFFI), A.in[19], scr, r, lane); continue; } r -= I_FFI;
        if (r < I_FFO) { tr_item<0>(A.in[21], DFF, DM, (bf16_t*)(ws + WS_WFFO), nullptr, scr, r, lane); continue; } r -= I_FFO;
        if (r < I_KV) { tr_item<0>(A.in[15], DM, 2 * DM, (bf16_t*)(ws + WS_WKV), nullptr, scr, r, lane); continue; } r -= I_KV;
        { const int g = r >> 3; tr_item<0>(A.in[11] + (size_t)g * 128 * 128, 128, 128, (bf16_t*)(ws + WS_PMIX) + (size_t)g * 128 * 128, nullptr, scr, r & 7, lane); }
    }
    bf16_t* H0 = (bf16_t*)(ws + WS_H0);
    for (int m = gw; m < NVALID; m += NGW) { const float* xr = m < NPR ? A.in[0] + (size_t)m * DM : A.in[1] + (size_t)(m - NPR) * DM; rms_row_to_bf16(xr, A.in[7], H0 + (size_t)m * DM, lane); }
    bf16_t* MEMH = (bf16_t*)(ws + WS_MEMH);
    for (int m = gw; m < MEMR; m += NGW) rms_row_to_bf16(A.in[2] + (size_t)m * DM, A.in[14], MEMH + (size_t)m * DM, lane);
    const int gt = blockIdx.x * NTHREADS + tid, NGT = G * NTHREADS;
    for (int i = gt; i < (MT - NVALID) * DM / 8; i += NGT) { const u32x4 z = {0u, 0u, 0u, 0u};
        ((u32x4*)(ws + WS_H0) + (size_t)NVALID * DM / 8)[i] = z; ((u32x4*)(ws + WS_MIX) + (size_t)NVALID * DM / 8)[i] = z; ((u32x4*)(ws + WS_O) + (size_t)NVALID * DM / 8)[i] = z; }
    for (int i = gt; i < MT; i += NGT) { ((float*)(ws + WS_SS1))[i] = 0.f; ((float*)(ws + WS_SS2))[i] = 0.f; ((float*)(ws + WS_SS3))[i] = 0.f; }
}

constexpr int L_BC = 0, L_TOT = 32768, L_QM = 34816, L_KM = 52224, L_VT = 69632, L_SP = 88064, L_AL = 122880, L_PART = 132096;
__device__ __forceinline__ void hgrn_cumsum(const float* LF, int R0, int C0, float* Bc, float* tot, int t) {
#pragma unroll
    for (int i = 0; i < 4; ++i) { const int idx = i * 512 + t, s = idx >> 5, k4 = idx & 31; *(f32x4*)(Bc + s * 128 + k4 * 4) = *(const f32x4*)(LF + (size_t)(R0 + s) * HW + C0 + k4 * 4); }
    __syncthreads();
    const int seg = t >> 7, k = t & 127; float run = 0.f;
#pragma unroll
    for (int i = 0; i < 16; ++i) { run += Bc[(seg * 16 + i) * 128 + k]; Bc[(seg * 16 + i) * 128 + k] = run; }
    tot[seg * 128 + k] = run;
    __syncthreads();
    float off = 0.f;
#pragma unroll
    for (int j = 0; j < 3; ++j) off += (j < seg) ? tot[j * 128 + k] : 0.f;
#pragma unroll
    for (int i = 0; i < 16; ++i) Bc[(seg * 16 + i) * 128 + k] += off;
    __syncthreads();
}
__device__ __forceinline__ void hgrn_local_unit(const Args& A, unsigned char* lds, int unit) {
    const int t = threadIdx.x, w = t >> 6, l = t & 63, lr = l & 15, lq = l >> 4;
    const int bh = unit >> 5, c = unit & 31, b = bh >> 2, h = bh & 3, R0 = b * SEQ + c * 64, C0 = h * 128;
    unsigned char* ws = A.ws;
    float* Bc = (float*)(lds + L_BC); float* tot = (float*)(lds + L_TOT);
    bf16_t* kdT = (bf16_t*)(lds + L_QM); bf16_t* vT = (bf16_t*)(lds + L_VT);
    hgrn_cumsum((const float*)(ws + WS_LF), R0, C0, Bc, tot, t);
    const bf16_t* KK = (const bf16_t*)(ws + WS_KK); const bf16_t* VV = (const bf16_t*)(ws + WS_VV);
#pragma unroll
    for (int i = 0; i < 2; ++i) { const int idx = (i * 512 + t) * 8, s = idx >> 7, k0 = idx & 127;
        const u32x4 kk = *(const u32x4*)(KK + (size_t)(R0 + s) * HW + C0 + k0), vv = *(const u32x4*)(VV + (size_t)(R0 + s) * HW + C0 + k0);
#pragma unroll
        for (int j = 0; j < 8; ++j) { const float e = __expf(Bc[63 * 128 + k0 + j] - Bc[s * 128 + k0 + j]);
            kdT[(k0 + j) * 72 + s] = (bf16_t)f2bf(bfe(kk, j) * e); vT[(k0 + j) * 72 + s] = bfr(vv, j); } }
    __syncthreads();
    f32x4 acc[8];
#pragma unroll
    for (int i = 0; i < 8; ++i) acc[i] = (f32x4){0.f, 0.f, 0.f, 0.f};
#pragma unroll
    for (int ks = 0; ks < 2; ++ks) { const bf16x8 a = *(const bf16x8*)(kdT + (16 * w + lr) * 72 + ks * 32 + lq * 8);
#pragma unroll
        for (int vt = 0; vt < 8; ++vt) { const bf16x8 bb = *(const bf16x8*)(vT + (16 * vt + lr) * 72 + ks * 32 + lq * 8); acc[vt] = MFMA16(a, bb, acc[vt]); } }
    float* SL = (float*)(ws + WS_SL) + (size_t)unit * 16384;
#pragma unroll
    for (int vt = 0; vt < 8; ++vt)
#pragma unroll
        for (int r = 0; r < 4; ++r) SL[(16 * w + lq * 4 + r) * 128 + 16 * vt + lr] = acc[vt][r];
    if (t < 128) ((float*)(ws + WS_DEC))[unit * 128 + t] = __expf(Bc[63 * 128 + t]);
    __syncthreads();
}
__device__ __forceinline__ void hgrn_out_unit(const Args& A, unsigned char* lds, int unit) {
    const int t = threadIdx.x, w = t >> 6, l = t & 63, lr = l & 15, lq = l >> 4;
    const int bh = unit >> 5, c = unit & 31, b = bh >> 2, h = bh & 3, R0 = b * SEQ + c * 64, C0 = h * 128;
    unsigned char* ws = A.ws;
    float* Bc = (float*)(lds + L_BC); float* tot = (float*)(lds + L_TOT); float* part = (float*)(lds + L_PART);
    bf16_t* qm = (bf16_t*)(lds + L_QM); bf16_t* km = (bf16_t*)(lds + L_KM); bf16_t* vT = (bf16_t*)(lds + L_VT); bf16_t* spT = (bf16_t*)(lds + L_SP); bf16_t* aL = (bf16_t*)(lds + L_AL);
    hgrn_cumsum((const float*)(ws + WS_LF), R0, C0, Bc, tot, t);
    const bf16_t* QQ = (const bf16_t*)(ws + WS_QQ); const bf16_t* KK = (const bf16_t*)(ws + WS_KK); const bf16_t* VV = (const bf16_t*)(ws + WS_VV);
#pragma unroll
    for (int i = 0; i < 2; ++i) { const int idx = (i * 512 + t) * 8, s = idx >> 7, k0 = idx & 127;
        const size_t go = (size_t)(R0 + s) * HW + C0 + k0;
        const u32x4 qq = *(const u32x4*)(QQ + go), kk = *(const u32x4*)(KK + go), vv = *(const u32x4*)(VV + go);
        float qv[8], kv[8];
#pragma unroll
        for (int j = 0; j < 8; ++j) { const float d = Bc[s * 128 + k0 + j] - Bc[31 * 128 + k0 + j];
            qv[j] = bfe(qq, j) * __expf(d); kv[j] = bfe(kk, j) * __expf(-d); vT[(k0 + j) * 72 + s] = bfr(vv, j); }
        u32x4 o; o.x = pk2(qv[0], qv[1]); o.y = pk2(qv[2], qv[3]); o.z = pk2(qv[4], qv[5]); o.w = pk2(qv[6], qv[7]); *(u32x4*)(qm + s * 136 + k0) = o;
        o.x = pk2(kv[0], kv[1]); o.y = pk2(kv[2], kv[3]); o.z = pk2(kv[4], kv[5]); o.w = pk2(kv[6], kv[7]); *(u32x4*)(km + s * 136 + k0) = o; }
    const float* SL = (const float*)(ws + WS_SL) + (size_t)unit * 16384;
#pragma unroll
    for (int i = 0; i < 8; ++i) { const int idx = i * 512 + t, k = idx >> 5, v4 = idx & 31; const f32x4 sv = *(const f32x4*)(SL + k * 128 + v4 * 4); const float em = __expf(Bc[31 * 128 + k]);
#pragma unroll
        for (int j = 0; j < 4; ++j) spT[(v4 * 4 + j) * 136 + k] = (bf16_t)f2bf(sv[j] * em); }
    __syncthreads();
    {
        const int ct = w & 3;
        f32x4 a2[2]; a2[0] = (f32x4){0.f, 0.f, 0.f, 0.f}; a2[1] = a2[0];
#pragma unroll
        for (int ks = 0; ks < 4; ++ks) { const bf16x8 a = *(const bf16x8*)(qm + (16 * ct + lr) * 136 + ks * 32 + lq * 8);
#pragma unroll
            for (int i = 0; i < 2; ++i) { const int st = (w >> 2) * 2 + i; const bf16x8 bb = *(const bf16x8*)(km + (16 * st + lr) * 136 + ks * 32 + lq * 8); a2[i] = MFMA16(a, bb, a2[i]); } }
#pragma unroll
        for (int i = 0; i < 2; ++i) { const int st = (w >> 2) * 2 + i, s = 16 * st + lr;
#pragma unroll
            for (int r = 0; r < 4; ++r) { const int cc = 16 * ct + lq * 4 + r; aL[cc * 72 + s] = (bf16_t)f2bf(s <= cc ? a2[i][r] : 0.f); } }
    }
    __syncthreads();
    const int ct = w & 3, vh = w >> 2;
    f32x4 o4[4];
#pragma unroll
    for (int i = 0; i < 4; ++i) o4[i] = (f32x4){0.f, 0.f, 0.f, 0.f};
#pragma unroll
    for (int ks = 0; ks < 4; ++ks) { const bf16x8 a = *(const bf16x8*)(qm + (16 * ct + lr) * 136 + ks * 32 + lq * 8);
#pragma unroll
        for (int i = 0; i < 4; ++i) { const int vt = vh * 4 + i; const bf16x8 bb = *(const bf16x8*)(spT + (16 * vt + lr) * 136 + ks * 32 + lq * 8); o4[i] = MFMA16(a, bb, o4[i]); } }
#pragma unroll
    for (int ks = 0; ks < 2; ++ks) { const bf16x8 a = *(const bf16x8*)(aL + (16 * ct + lr) * 72 + ks * 32 + lq * 8);
#pragma unroll
        for (int i = 0; i < 4; ++i) { const int vt = vh * 4 + i; const bf16x8 bb = *(const bf16x8*)(vT + (16 * vt + lr) * 72 + ks * 32 + lq * 8); o4[i] = MFMA16(a, bb, o4[i]); } }
#pragma unroll
    for (int r = 0; r < 4; ++r) { float s = 0.f;
#pragma unroll
        for (int i = 0; i < 4; ++i) s += o4[i][r] * o4[i][r];
        s += __shfl_xor(s, 1); s += __shfl_xor(s, 2); s += __shfl_xor(s, 4); s += __shfl_xor(s, 8);
        if (lr == 0) part[vh * 64 + 16 * ct + lq * 4 + r] = s; }
    __syncthreads();
    const float* hn = A.in[10]; const bf16_t* GG = (const bf16_t*)(ws + WS_GG); bf16_t* MIX = (bf16_t*)(ws + WS_MIX);
#pragma unroll
    for (int r = 0; r < 4; ++r) { const int cc = 16 * ct + lq * 4 + r; const float rstd = __builtin_amdgcn_rsqf((part[cc] + part[64 + cc]) * (1.0f / 128.0f) + EPS);
#pragma unroll
        for (int i = 0; i < 4; ++i) { const int v = (vh * 4 + i) * 16 + lr; const float g = bf2f(GG[(size_t)(R0 + cc) * HW + C0 + v]);
            MIX[(size_t)(R0 + cc) * DM + C0 + v] = (bf16_t)f2bf(o4[i][r] * rstd * hn[C0 + v] * g); } }
    __syncthreads();
}
__device__ __forceinline__ void hgrn_scan(const Args& A, int G) {
    float* SLb = (float*)(A.ws + WS_SL); const float* DEC = (const float*)(A.ws + WS_DEC); float* outp = A.out + O_HP;
    for (int e = blockIdx.x * NTHREADS + threadIdx.x; e < 32 * 4096; e += G * NTHREADS) { const int bh = e >> 12, i4 = e & 4095, k = i4 >> 5;
        f32x4 S = (f32x4){0.f, 0.f, 0.f, 0.f};
        f32x4* p = (f32x4*)(SLb + (size_t)bh * 32 * 16384) + i4;
        f32x4 cur = p[0];
#pragma unroll 4
        for (int c = 0; c < 32; ++c) { const f32x4 nxt = (c < 31) ? p[(size_t)(c + 1) * 4096] : cur; const float d = DEC[(bh * 32 + c) * 128 + k];
            p[(size_t)c * 4096] = S; S = S * d + cur; cur = nxt; }
        *((f32x4*)(outp + (size_t)bh * 16384) + i4) = S; }
}
__device__ __forceinline__ void pool_states(const Args& A, int G) {
    const float* UU = (const float*)(A.ws + WS_UU);
    const int gt = blockIdx.x * NTHREADS + threadIdx.x, NGT = G * NTHREADS;
    for (int i = gt; i < 8 * 15 * 512; i += NGT) { const int cch = i & 511, j = (i >> 9) % 15, b = i / (15 * 512); A.out[O_PP + i] = UU[(size_t)(b * SEQ + 2033 + j) * HW + cch]; }
    for (int i = gt; i < 128 * 15 * 512; i += NGT) { const int cch = i & 511, j = (i >> 9) % 15, b = i / (15 * 512);
        A.out[O_PS + i] = (j < 14) ? A.in[4][(size_t)(b * 15 + j + 1) * 512 + cch] : UU[(size_t)(NPR + b) * HW + cch]; }
}
__device__ __forceinline__ void hgrn_sample_unit(const Args& A, unsigned char* lds, int unit) {
    const int t = threadIdx.x, b = unit >> 2, h = unit & 3, row = NPR + b, C0 = h * 128;
    unsigned char* ws = A.ws;
    float* qs = (float*)lds; float* ks = qs + 128; float* fs = ks + 128; float* vs = fs + 128; float* po = vs + 128;
    float* red = po + 16 * 128;
    if (t < 128) { const size_t go = (size_t)row * HW + C0 + t;
        qs[t] = bf2f(((const bf16_t*)(ws + WS_QQ))[go]); ks[t] = bf2f(((const bf16_t*)(ws + WS_KK))[go]); fs[t] = __expf(((const float*)(ws + WS_LF))[go]); vs[t] = bf2f(((const bf16_t*)(ws + WS_VV))[go]); }
    __syncthreads();
    const int v4 = t & 31, kg = t >> 5;
    const float* S0 = A.in[3] + (size_t)unit * 16384; float* S1 = A.out + O_HS + (size_t)unit * 16384;
    const f32x4 vv = *(const f32x4*)(vs + v4 * 4);
    f32x4 o = (f32x4){0.f, 0.f, 0.f, 0.f};
#pragma unroll
    for (int i = 0; i < 8; ++i) { const int k = kg * 8 + i; const f32x4 s = *(const f32x4*)(S0 + k * 128 + v4 * 4); const f32x4 sn = s * fs[k] + vv * ks[k]; *(f32x4*)(S1 + k * 128 + v4 * 4) = sn; o += sn * qs[k]; }
    *(f32x4*)(po + kg * 128 + v4 * 4) = o;
    __syncthreads();
    float ov = 0.f;
    if (t < 128) {
#pragma unroll
        for (int i = 0; i < 16; ++i) ov += po[i * 128 + t];
        const float sq = wave_sum(ov * ov); if ((t & 63) == 0) red[t >> 6] = sq; }
    __syncthreads();
    if (t < 128) { const float rstd = __builtin_amdgcn_rsqf((red[0] + red[1]) * (1.0f / 128.0f) + EPS); const float g = bf2f(((const bf16_t*)(ws + WS_GG))[(size_t)row * HW + C0 + t]);
        ((bf16_t*)(ws + WS_MIX))[(size_t)row * DM + C0 + t] = (bf16_t)f2bf(ov * rstd * A.in[10][C0 + t] * g); }
    __syncthreads();
}

constexpr int LP_EXT = 0, LP_PL = 40448, LP_MX = 57856;
__device__ __forceinline__ void pool_unit(const Args& A, unsigned char* lds, int unit) {
    const int t = threadIdx.x, w = t >> 6, l = t & 63, lr = l & 15, lq = l >> 4;
    const int tt = unit >> 2, g = unit & 3, win = 2 << g;
    unsigned char* ws = A.ws;
    float* ext = (float*)(lds + LP_EXT); bf16_t* pl = (bf16_t*)(lds + LP_PL); bf16_t* mx = (bf16_t*)(lds + LP_MX);
    const float* UU = (const float*)(ws + WS_UU);
    {
        const bf16_t* PM = (const bf16_t*)(ws + WS_PMIX) + (size_t)g * 16384;
#pragma unroll
        for (int i = 0; i < 4; ++i) { const int idx = i * 512 + t, d = idx >> 4, c8 = idx & 15; *(u32x4*)(mx + d * 136 + c8 * 8) = *(const u32x4*)(PM + d * 128 + c8 * 8); }
    }
    int rowbase;
    if (tt < 256) {
        const int b = tt >> 5, t0 = (tt & 31) * 64; rowbase = b * SEQ + t0;
        for (int idx = t; idx < 79 * 32; idx += NTHREADS) { const int i = idx >> 5, c4 = idx & 31; const int tp = t0 - 15 + i;
            f32x4 v = (f32x4){0.f, 0.f, 0.f, 0.f}; if (tp >= 0) v = *(const f32x4*)(UU + (size_t)(b * SEQ + tp) * HW + g * 128 + c4 * 4);
            *(f32x4*)(ext + i * 128 + c4 * 4) = v; }
        __syncthreads();
        const int cch = t & 127, tg = t >> 7;
#pragma unroll 4
        for (int i = 0; i < 16; ++i) { const int tok = tg * 16 + i; float s = 0.f;
            for (int j = 0; j < win; ++j) s += ext[(15 + tok - j) * 128 + cch];
            const int cnt = min(t0 + tok + 1, win);
            pl[tok * 136 + cch] = (bf16_t)f2bf(s / (float)cnt - ext[(15 + tok) * 128 + cch]); }
    } else {
        const int sb0 = (tt - 256) * 64; rowbase = NPR + sb0;
        const int cch = t & 127, tg = t >> 7;
        for (int i = 0; i < 16; ++i) { const int tok = tg * 16 + i, sb = sb0 + tok; const float uv = UU[(size_t)(NPR + sb) * HW + g * 128 + cch]; float s = uv;
            for (int j = 16 - win; j < 15; ++j) s += A.in[4][(size_t)(sb * 15 + j) * 512 + g * 128 + cch];
            pl[tok * 136 + cch] = (bf16_t)f2bf(s / (float)win - uv); }
    }
    __syncthreads();
    const int ct = w & 3, dh = w >> 2;
    f32x4 o4[4];
#pragma unroll
    for (int i = 0; i < 4; ++i) o4[i] = (f32x4){0.f, 0.f, 0.f, 0.f};
#pragma unroll
    for (int ks = 0; ks < 4; ++ks) { const bf16x8 a = *(const bf16x8*)(pl + (16 * ct + lr) * 136 + ks * 32 + lq * 8);
#pragma unroll
        for (int i = 0; i < 4; ++i) { const int dt = dh * 4 + i; const bf16x8 bb = *(const bf16x8*)(mx + (16 * dt + lr) * 136 + ks * 32 + lq * 8); o4[i] = MFMA16(a, bb, o4[i]); } }
    bf16_t* MIX = (bf16_t*)(ws + WS_MIX); const float* psc = A.in[12];
#pragma unroll
    for (int i = 0; i < 4; ++i) { const int d = (dh * 4 + i) * 16 + lr; const float sc = psc[g * 128 + d];
#pragma unroll
        for (int r = 0; r < 4; ++r) { const int tok = 16 * ct + lq * 4 + r; MIX[(size_t)(rowbase + tok) * DM + 512 + g * 128 + d] = (bf16_t)f2bf(o4[i][r] * sc); } }
    __syncthreads();
}

__device__ __forceinline__ void attn_prompt_unit(const Args& A, unsigned char* lds, int unit) {
    const int t = threadIdx.x, w = t >> 6, l = t & 63, lr = l & 15, lq = l >> 4;
    const int qt = unit & 15, h = (unit >> 4) & 3, b = unit >> 6;
    unsigned char* ws = A.ws;
    const bf16_t* Q = (const bf16_t*)(ws + WS_Q); const bf16_t* KB = (const bf16_t*)(ws + WS_KB); const bf16_t* VT = (const bf16_t*)(ws + WS_VT); bf16_t* O = (bf16_t*)(ws + WS_O);
    const int R0 = b * SEQ + qt * 128 + 16 * w;
    bf16_t* Pw = (bf16_t*)lds + w * (16 * 264);
    bf16x8 qa[8];
#pragma unroll
    for (int ks = 0; ks < 8; ++ks) qa[ks] = *(const bf16x8*)(Q + (size_t)(R0 + lr) * DM + h * 256 + ks * 32 + lq * 8);
    f32x4 sacc[16];
#pragma unroll
    for (int nt = 0; nt < 16; ++nt) { f32x4 acc = (f32x4){0.f, 0.f, 0.f, 0.f}; const bf16_t* kp = KB + (size_t)(b * 256 + nt * 16 + lr) * DM + h * 256 + lq * 8;
#pragma unroll
        for (int ks = 0; ks < 8; ++ks) { const bf16x8 bb = *(const bf16x8*)(kp + ks * 32); acc = MFMA16(qa[ks], bb, acc); }
        sacc[nt] = acc; }
    float rinv[4];
#pragma unroll
    for (int r = 0; r < 4; ++r) { float mx = sacc[0][r];
#pragma unroll
        for (int nt = 1; nt < 16; ++nt) mx = fmaxf(mx, sacc[nt][r]);
        mx = fmaxf(mx, __shfl_xor(mx, 1)); mx = fmaxf(mx, __shfl_xor(mx, 2)); mx = fmaxf(mx, __shfl_xor(mx, 4)); mx = fmaxf(mx, __shfl_xor(mx, 8));
        float sum = 0.f;
#pragma unroll
        for (int nt = 0; nt < 16; ++nt) { const float p = __builtin_amdgcn_exp2f(sacc[nt][r] - mx); sum += p; Pw[(lq * 4 + r) * 264 + nt * 16 + lr] = (bf16_t)f2bf(p); }
        sum += __shfl_xor(sum, 1); sum += __shfl_xor(sum, 2); sum += __shfl_xor(sum, 4); sum += __shfl_xor(sum, 8);
        rinv[r] = 1.0f / sum; }
    asm volatile("s_waitcnt lgkmcnt(0)" ::: "memory");
    bf16x8 pa[8];
#pragma unroll
    for (int ks = 0; ks < 8; ++ks) pa[ks] = *(const bf16x8*)(Pw + lr * 264 + ks * 32 + lq * 8);
#pragma unroll 2
    for (int dt = 0; dt < 16; ++dt) { f32x4 acc = (f32x4){0.f, 0.f, 0.f, 0.f}; const bf16_t* vp = VT + (size_t)(h * 256 + dt * 16 + lr) * MEMR + b * 256 + lq * 8;
#pragma unroll
        for (int ks = 0; ks < 8; ++ks) { const bf16x8 bb = *(const bf16x8*)(vp + ks * 32); acc = MFMA16(pa[ks], bb, acc); }
#pragma unroll
        for (int r = 0; r < 4; ++r) O[(size_t)(R0 + lq * 4 + r) * DM + h * 256 + dt * 16 + lr] = (bf16_t)f2bf(acc[r] * rinv[r]); }
    asm volatile("s_waitcnt lgkmcnt(0)" ::: "memory");
}
__device__ __forceinline__ void attn_sample_unit(const Args& A, unsigned char* lds, int unit) {
    const int t = threadIdx.x, w = t >> 6, l = t & 63;
    const int b = unit >> 2, h = unit & 3;
    unsigned char* ws = A.ws;
    float* qs = (float*)lds; float* sc = qs + 256; float* red = sc + 256; float* po = red + 16;
    if (t < 256) qs[t] = bf2f(((const bf16_t*)(ws + WS_Q))[(size_t)(NPR + b) * DM + h * 256 + t]);
    __syncthreads();
    const float* Kc = A.in[5] + (size_t)b * 256 * 1024 + h * 256; const float* Vc = A.in[6] + (size_t)b * 256 * 1024 + h * 256;
    {
        const int rl = l >> 4, c16 = l & 15;
        f32x4 q4[4];
#pragma unroll
        for (int i = 0; i < 4; ++i) q4[i] = *(const f32x4*)(qs + i * 64 + c16 * 4);
#pragma unroll 2
        for (int p = 0; p < 8; ++p) { const int m = p * 32 + w * 4 + rl; const float* kr = Kc + (size_t)m * 1024; float s = 0.f;
#pragma unroll
            for (int i = 0; i < 4; ++i) { const f32x4 kv = *(const f32x4*)(kr + i * 64 + c16 * 4); s += (kv[0] * q4[i][0] + kv[1] * q4[i][1]) + (kv[2] * q4[i][2] + kv[3] * q4[i][3]); }
            s += __shfl_xor(s, 1); s += __shfl_xor(s, 2); s += __shfl_xor(s, 4); s += __shfl_xor(s, 8);
            if (c16 == 0) sc[m] = s; }
    }
    __syncthreads();
    if (t < 256) { float v = sc[t]; float mx = v;
#pragma unroll
        for (int o = 1; o < 64; o <<= 1) mx = fmaxf(mx, __shfl_xor(mx, o));
        if (l == 0) red[w] = mx; }
    __syncthreads();
    const float gmx = fmaxf(fmaxf(red[0], red[1]), fmaxf(red[2], red[3]));
    float pv = 0.f;
    if (t < 256) { pv = __builtin_amdgcn_exp2f(sc[t] - gmx); const float s = wave_sum(pv); if (l == 0) red[8 + w] = s; }
    __syncthreads();
    if (t < 256) sc[t] = pv;
    const float inv = 1.0f / ((red[8] + red[9]) + (red[10] + red[11]));
    __syncthreads();
    {
        f32x4 o = (f32x4){0.f, 0.f, 0.f, 0.f};
#pragma unroll 8
        for (int i = 0; i < 32; ++i) { const int m = w * 32 + i; const f32x4 vv = *(const f32x4*)(Vc + (size_t)m * 1024 + l * 4); o += vv * sc[m]; }
        *(f32x4*)(po + w * 256 + l * 4) = o;
    }
    __syncthreads();
    if (t < 256) { float o = 0.f;
#pragma unroll
        for (int i = 0; i < 8; ++i) o += po[i * 256 + t];
        ((bf16_t*)(ws + WS_O))[(size_t)(NPR + b) * DM + h * 256 + t] = (bf16_t)f2bf(o * inv); }
    __syncthreads();
}

__device__ __forceinline__ void final_norm(const Args& A, int G) {
    const int lane = threadIdx.x & 63, gw = blockIdx.x * 8 + (threadIdx.x >> 6), NGW = G * 8;
    const float* ss = (const float*)(A.ws + WS_SS3); const f32x4* gr = (const f32x4*)A.in[22] + lane;
    for (int m = gw; m < NVALID; m += NGW) { const float rstd = 1.0f / sqrtf(ss[m] * (1.f / DM) + EPS); f32x4* xr = (f32x4*)(A.out + (size_t)m * DM) + lane;
#pragma unroll
        for (int j = 0; j < 4; ++j) { const f32x4 v = xr[64 * j], gg = gr[64 * j]; xr[64 * j] = v * rstd * gg; } }
}

constexpr int NPHASES = 12;
__global__ void __launch_bounds__(NTHREADS, 2) fwd_megakernel(Args args) {
    extern __shared__ __attribute__((aligned(16))) unsigned char lds[];
    cg::grid_group grid = cg::this_grid();
    const int G = gridDim.x, bx = blockIdx.x;
    unsigned char* ws = args.ws;
    PG8_LAS unsigned char* lds3 = (PG8_LAS unsigned char*)lds;
    const int lo = args.ph_lo, hi = args.ph_hi;
#define IN(k) (lo <= (k) && (k) < hi)
#define SEAM(k) do { if (IN(k) && IN((k) + 1)) grid.sync(); } while (0)
    if (IN(0)) { p0_prologue(args, lds, G); }
    SEAM(0);
    if (IN(1)) {
        {   pg8::Gemm g{(const bf16_t*)(ws + WS_H0), (const bf16_t*)(ws + WS_WIN), MT, NIN, DM}; pg8::StaticOrder S; S.init(MT, NIN, G, bx);
            pg8::EpiInProj E{(bf16_t*)(ws + WS_QQ), (bf16_t*)(ws + WS_KK), (bf16_t*)(ws + WS_VV), (bf16_t*)(ws + WS_GG), (float*)(ws + WS_LF), (float*)(ws + WS_UU), args.in[9]};
            pg8::gemm_phase<pg8::EpiInProj, pg8::StaticOrder, true, true>(lds3, g, S, E); }
        {   pg8::Gemm g{(const bf16_t*)(ws + WS_MEMH), (const bf16_t*)(ws + WS_WKV), MEMR, 2 * DM, DM}; pg8::StaticOrder S; S.init(MEMR, 2 * DM, G, (bx + G - (650 % G)) % G);
            pg8::EpiMemKV E{args.out + O_MK, args.out + O_MV, (bf16_t*)(ws + WS_KB)};
            pg8::gemm_phase<pg8::EpiMemKV, pg8::StaticOrder, true, true>(lds3, g, S, E); }
        {   pg8::Gemm g{(const bf16_t*)(ws + WS_WKV) + (size_t)DM * DM, (const bf16_t*)(ws + WS_MEMH), DM, MEMR, DM}; pg8::StaticOrder S; S.init(DM, MEMR, G, (bx + 2 * G - ((650 + 64) % G)) % G);
            pg8::EpiBf16Scale E{(bf16_t*)(ws + WS_VT), MEMR, nullptr, 1.0f};
            pg8::gemm_phase<pg8::EpiBf16Scale, pg8::StaticOrder, true, true>(lds3, g, S, E); }
    }
    SEAM(1);
    if (IN(2)) {
        for (int u = bx; u < 512 + 1024; u += G) { if (u < 512) hgrn_sample_unit(args, lds, u); else hgrn_local_unit(args, lds, u - 512); }
    }
    SEAM(2);
    if (IN(3)) { hgrn_scan(args, G); pool_states(args, G); }
    SEAM(3);
    if (IN(4)) {
        for (int u = bx; u < 1024 + 1032; u += G) { if (u < 1024) hgrn_out_unit(args, lds, u); else pool_unit(args, lds, u - 1024); }
    }
    SEAM(4);
    if (IN(5)) {
        pg8::Gemm g{(const bf16_t*)(ws + WS_MIX), (const bf16_t*)(ws + WS_WOUT), MT, DM, DM}; pg8::StaticOrder S; S.init(MT, DM, G, bx);
        pg8::EpiResid E{args.in[0], args.in[1], NVALID, (float*)(ws + WS_X1), MT, (bf16_t*)(ws + WS_H0), (float*)(ws + WS_SS1)};
        pg8::gemm_phase<pg8::EpiResid, pg8::StaticOrder, true, true>(lds3, g, S, E);
    }
    SEAM(5);
    if (IN(6)) {
        pg8::Gemm g{(const bf16_t*)(ws + WS_H0), (const bf16_t*)(ws + WS_WCQ), MT, DM, DM}; pg8::StaticOrder S; S.init(MT, DM, G, bx);
        pg8::EpiBf16Scale E{(bf16_t*)(ws + WS_Q), DM, (const float*)(ws + WS_SS1), 0.0625f * 1.4426950408889634f};
        pg8::gemm_phase<pg8::EpiBf16Scale, pg8::StaticOrder, true, true>(lds3, g, S, E);
    }
    SEAM(6);
    if (IN(7)) {
        for (int u = bx; u < 1024; u += G) { if (u < 512) attn_sample_unit(args, lds, u); else attn_prompt_unit(args, lds, u - 512); }
    }
    SEAM(7);
    if (IN(8)) {
        const float* X1 = (const float*)(ws + WS_X1);
        pg8::Gemm g{(const bf16_t*)(ws + WS_O), (const bf16_t*)(ws + WS_WCO), MT, DM, DM}; pg8::StaticOrder S; S.init(MT, DM, G, bx);
        pg8::EpiResid E{X1, X1 + (size_t)NPR * DM, MT, (float*)(ws + WS_SL), MT, (bf16_t*)(ws + WS_MIX), (float*)(ws + WS_SS2)};
        pg8::gemm_phase<pg8::EpiResid, pg8::StaticOrder, true, true>(lds3, g, S, E);
    }
    SEAM(8);
    if (IN(9)) {
        pg8::Gemm g{(const bf16_t*)(ws + WS_MIX), (const bf16_t*)(ws + WS_WFFI), MT, NFF2, DM}; pg8::StaticOrder S; S.init(MT, NFF2, G, bx);
        pg8::EpiSwiGLU E{(bf16_t*)(ws + WS_A), (const float*)(ws + WS_SS2)};
        pg8::gemm_phase<pg8::EpiSwiGLU, pg8::StaticOrder, true, true>(lds3, g, S, E);
    }
    SEAM(9);
    if (IN(10)) {
        const float* X2 = (const float*)(ws + WS_SL);
        pg8::Gemm g{(const bf16_t*)(ws + WS_A), (const bf16_t*)(ws + WS_WFFO), MT, DM, DFF}; pg8::StaticOrder S; S.init(MT, DM, G, bx);
        pg8::EpiResid E{X2, X2 + (size_t)NPR * DM, MT, args.out, NVALID, nullptr, (float*)(ws + WS_SS3)};
        pg8::gemm_phase<pg8::EpiResid, pg8::StaticOrder, true, true>(lds3, g, S, E);
    }
    SEAM(10);
    if (IN(11)) { final_norm(args, G); }
#undef IN
#undef SEAM
}

#ifndef MK_MULTI
#define MK_MULTI 0
#endif
extern "C" void kernel_launch(void* const* d_in, const int* in_sizes, int n_in, void* d_out, int out_size, void* d_ws, size_t ws_size, hipStream_t stream) {
    static int grid = 0;
    if (grid == 0) {
        if (n_in != 23 || ws_size < WS_END) { fprintf(stderr, "kernel_launch: unexpected n_in %d / ws_size %zu\n", n_in, ws_size); grid = -1; return; }
        int dev = 0, cus = 0, per_cu = 0;
        hipGetDevice(&dev); hipDeviceGetAttribute(&cus, hipDeviceAttributeMultiprocessorCount, dev);
        if (hipFuncSetAttribute((const void*)fwd_megakernel, hipFuncAttributeMaxDynamicSharedMemorySize, LDS_BYTES) != hipSuccess) { fprintf(stderr, "kernel_launch: hipFuncSetAttribute failed\n"); grid = -1; return; }
        hipOccupancyMaxActiveBlocksPerMultiprocessor(&per_cu, (const void*)fwd_megakernel, NTHREADS, LDS_BYTES);
        (void)hipGetLastError();
        if (per_cu < 1) { fprintf(stderr, "kernel_launch: occupancy query says %d blocks/CU\n", per_cu); per_cu = 1; }
        grid = cus;
    }
    if (grid < 0) return;
    Args a{};
    for (int i = 0; i < 23; ++i) a.in[i] = (const float*)d_in[i];
    a.out = (float*)d_out; a.ws = (unsigned char*)d_ws;
#if MK_MULTI
    for (int p = 0; p < NPHASES; ++p) { a.ph_lo = p; a.ph_hi = p + 1; hipLaunchKernelGGL(fwd_megakernel, dim3(grid), dim3(NTHREADS), LDS_BYTES, stream, a); }
#else
    a.ph_lo = 0; a.ph_hi = NPHASES;
    void* kargs[] = {&a};
    hipError_t e = hipLaunchCooperativeKernel((const void*)fwd_megakernel, dim3(grid), dim3(NTHREADS), kargs, LDS_BYTES, stream);
    if (e != hipSuccess) fprintf(stderr, "kernel_launch: cooperative launch failed: %s (grid %d)\n", hipGetErrorString(e), grid);
#endif
}
```

```cpp
#include <hip/hip_runtime.h>
#include <hip/hip_cooperative_groups.h>
#include <cstdio>
#include <cstdint>
namespace cg = cooperative_groups;
namespace pg8 {
#define PG8_LAS __attribute__((address_space(3)))
typedef unsigned short bf16_t;
typedef short bf16x8 __attribute__((ext_vector_type(8)));
typedef float f32x4 __attribute__((ext_vector_type(4)));
typedef unsigned u32x4 __attribute__((ext_vector_type(4)));
constexpr int BM = 256, BK = 64, HALF = 128, HTB = HALF * BK * 2  , STAGE_BYTES = 8 * HTB, NXCD = 8, WGM = 8;

__host__ __device__ __forceinline__ int lds_byte(int r, int c) { const int st = (r >> 4) * 2 + (c >> 5), rr = r & 15, cc = c & 31, ob = rr * 64 + cc * 2; return st * 1024 + (ob ^ (((ob >> 9) & 1) << 5)); }
__host__ __device__ __forceinline__ void stage_rc(int b, int& R, int& C) { const int st = b / 1024, sb = b % 1024, swz = sb ^ (((sb >> 9) & 1) << 5); R = (st >> 1) * 16 + swz / 64; C = (st & 1) * 32 + (swz % 64) / 2; }
__host__ __device__ __forceinline__ int perm32(int rho) { const int n = rho >> 4, i = rho & 15; return 8 * (i >> 2) + 4 * n + (i & 3); }

struct Unit { int pm, pn; };
struct Gemm { const bf16_t* A; const bf16_t* Bt; int M, N, K; };

struct StaticOrder {
    int nM, nN, nwg, G, c;
    __host__ __device__ void init(int M, int N, int G_, int c_) { nM = M / BM; nN = N / BM; nwg = nM * nN; G = G_; c = c_; }
    __host__ __device__ bool next(int i, Unit& u) const {
        const long L = (long)i * G + c; if (L >= nwg) return false;
        int wgid = (int)L; { const int q = nwg / NXCD, r = nwg % NXCD, xcd = wgid % NXCD, off = wgid / NXCD; wgid = (xcd < r ? xcd * (q + 1) : r * (q + 1) + (xcd - r) * q) + off; }
        const int nig = WGM * nN, gid = wgid / nig, fm = gid * WGM, gsz = (nM - fm) < WGM ? (nM - fm) : WGM;
        u.pm = fm + ((wgid % nig) % gsz); u.pn = (wgid % nig) / gsz; return true;
    }
    __device__ __forceinline__ void a_ready(const Unit&) const {}
    __device__ __forceinline__ void done(const Unit&) const {}
};

__device__ __forceinline__ unsigned cvt_pk_bf16(float lo, float hi) { unsigned r; asm volatile("v_cvt_pk_bf16_f32 %0, %1, %2" : "=v"(r) : "v"(lo), "v"(hi)); return r; }
typedef unsigned u32x2 __attribute__((ext_vector_type(2)));
__device__ __forceinline__ float sigm(float z) { return 1.0f / (1.0f + __expf(-z)); }
constexpr float RMS_EPS = 1e-6f;

struct EpiInProj {
    static constexpr bool PERM = true, AFTER_DRAIN = false;
    bf16_t *QQ, *KK, *VV, *GG; float *LF, *UU; const float* lbraw;
    __device__ __forceinline__ void operator()(const f32x4 (&acc)[2][2][4][2], const Unit& u, int wr, int wc, int fr, int fq) const {
        const int seg = u.pn >> 1, colt = (u.pn & 1) * 256;
        const int row0 = u.pm * BM + wr * 64 + fr;
#pragma unroll
        for (int bj = 0; bj < 2; ++bj) {
            const int cs = colt + bj * HALF + wc * 32 + 8 * fq;
            float lb[8];
            if (seg == 1) {
#pragma unroll
                for (int j = 0; j < 8; ++j) { const float l0 = lbraw[cs + j], l1 = lbraw[512 + cs + j]; lb[j] = 1.0f / (1.0f + __expf(l1 - l0)); }
            } else {
#pragma unroll
                for (int j = 0; j < 8; ++j) lb[j] = 0.f;
            }
#pragma unroll
            for (int ai = 0; ai < 2; ++ai)
#pragma unroll
                for (int m = 0; m < 4; ++m) {
                    const size_t off = (size_t)(row0 + ai * HALF + m * 16) * 512 + cs;
                    const f32x4 v0 = acc[ai][bj][m][0], v1 = acc[ai][bj][m][1];
                    float z[8] = {v0[0], v0[1], v0[2], v0[3], v1[0], v1[1], v1[2], v1[3]};
                    if (seg == 0) {
#pragma unroll
                        for (int j = 0; j < 8; ++j) z[j] = z[j] * sigm(z[j]);
                        u32x4 w; w.x = cvt_pk_bf16(z[0], z[1]); w.y = cvt_pk_bf16(z[2], z[3]); w.z = cvt_pk_bf16(z[4], z[5]); w.w = cvt_pk_bf16(z[6], z[7]);
                        *(u32x4*)(QQ + off) = w;
                    } else if (seg == 1) {
                        float lf[8], kk[8];
#pragma unroll
                        for (int j = 0; j < 8; ++j) { const float e = __expf(-z[j]); const float sg = 1.0f / (1.0f + e); const float sgn = e / (1.0f + e);
                            lf[j] = __logf(lb[j] + (1.0f - lb[j]) * sg); kk[j] = (1.0f - lb[j]) * sgn; }
                        *(f32x4*)(LF + off) = (f32x4){lf[0], lf[1], lf[2], lf[3]}; *(f32x4*)(LF + off + 4) = (f32x4){lf[4], lf[5], lf[6], lf[7]};
                        u32x4 w; w.x = cvt_pk_bf16(kk[0], kk[1]); w.y = cvt_pk_bf16(kk[2], kk[3]); w.z = cvt_pk_bf16(kk[4], kk[5]); w.w = cvt_pk_bf16(kk[6], kk[7]);
                        *(u32x4*)(KK + off) = w;
                    } else if (seg == 2) {
                        u32x4 w; w.x = cvt_pk_bf16(z[0], z[1]); w.y = cvt_pk_bf16(z[2], z[3]); w.z = cvt_pk_bf16(z[4], z[5]); w.w = cvt_pk_bf16(z[6], z[7]);
                        *(u32x4*)(VV + off) = w;
                    } else if (seg == 3) {
#pragma unroll
                        for (int j = 0; j < 8; ++j) z[j] = sigm(z[j]);
                        u32x4 w; w.x = cvt_pk_bf16(z[0], z[1]); w.y = cvt_pk_bf16(z[2], z[3]); w.z = cvt_pk_bf16(z[4], z[5]); w.w = cvt_pk_bf16(z[6], z[7]);
                        *(u32x4*)(GG + off) = w;
                    } else {
                        *(f32x4*)(UU + off) = v0; *(f32x4*)(UU + off + 4) = v1;
                    }
                }
        }
    }
};

struct EpiMemKV {
    static constexpr bool PERM = true, AFTER_DRAIN = false;
    float *outK, *outV; bf16_t* KB;
    __device__ __forceinline__ void operator()(const f32x4 (&acc)[2][2][4][2], const Unit& u, int wr, int wc, int fr, int fq) const {
        const bool isk = u.pn < 4; float* o = isk ? outK : outV; const int colt = (u.pn & 3) * 256;
        const int row0 = u.pm * BM + wr * 64 + fr;
#pragma unroll
        for (int ai = 0; ai < 2; ++ai)
#pragma unroll
            for (int m = 0; m < 4; ++m)
#pragma unroll
                for (int bj = 0; bj < 2; ++bj) {
                    const size_t off = (size_t)(row0 + ai * HALF + m * 16) * 1024 + colt + bj * HALF + wc * 32 + 8 * fq;
                    const f32x4 v0 = acc[ai][bj][m][0], v1 = acc[ai][bj][m][1];
                    *(f32x4*)(o + off) = v0; *(f32x4*)(o + off + 4) = v1;
                    if (isk) { u32x4 w; w.x = cvt_pk_bf16(v0[0], v0[1]); w.y = cvt_pk_bf16(v0[2], v0[3]); w.z = cvt_pk_bf16(v1[0], v1[1]); w.w = cvt_pk_bf16(v1[2], v1[3]); *(u32x4*)(KB + off) = w; }
                }
    }
};

struct EpiBf16Scale {
    static constexpr bool PERM = true, AFTER_DRAIN = false;
    bf16_t* O; int ldc; const float* ss; float scale;
    __device__ __forceinline__ void operator()(const f32x4 (&acc)[2][2][4][2], const Unit& u, int wr, int wc, int fr, int fq) const {
        const int row0 = u.pm * BM + wr * 64 + fr;
#pragma unroll
        for (int ai = 0; ai < 2; ++ai)
#pragma unroll
            for (int m = 0; m < 4; ++m) {
                const int row = row0 + ai * HALF + m * 16;
                const float sc = ss ? scale * __builtin_amdgcn_rsqf(ss[row] * (1.0f / 1024.0f) + RMS_EPS) : scale;
#pragma unroll
                for (int bj = 0; bj < 2; ++bj) {
                    const size_t off = (size_t)row * ldc + u.pn * BM + bj * HALF + wc * 32 + 8 * fq;
                    const f32x4 v0 = acc[ai][bj][m][0] * sc, v1 = acc[ai][bj][m][1] * sc;
                    u32x4 w; w.x = cvt_pk_bf16(v0[0], v0[1]); w.y = cvt_pk_bf16(v0[2], v0[3]); w.z = cvt_pk_bf16(v1[0], v1[1]); w.w = cvt_pk_bf16(v1[2], v1[3]);
                    *(u32x4*)(O + off) = w;
                }
            }
    }
};

struct EpiResid {
    static constexpr bool PERM = true, AFTER_DRAIN = false;
    const float* baseP; const float* baseS; int base_rows;
    float* out; int out_rows;
    bf16_t* outb; float* ss;
    __device__ __forceinline__ void operator()(const f32x4 (&acc)[2][2][4][2], const Unit& u, int wr, int wc, int fr, int fq) const {
        const int row0 = u.pm * BM + wr * 64 + fr;
#pragma unroll
        for (int ai = 0; ai < 2; ++ai)
#pragma unroll
            for (int m = 0; m < 4; ++m) {
                const int row = row0 + ai * HALF + m * 16;
                const float* bp = row < 16384 ? baseP + (size_t)row * 1024 : baseS + (size_t)(row - 16384) * 1024;
                const bool bok = row < base_rows, ook = row < out_rows;
                float s = 0.f;
#pragma unroll
                for (int bj = 0; bj < 2; ++bj) {
                    const int col = u.pn * BM + bj * HALF + wc * 32 + 8 * fq;
                    f32x4 b0 = (f32x4){0.f, 0.f, 0.f, 0.f}, b1 = b0;
                    if (bok) { b0 = *(const f32x4*)(bp + col); b1 = *(const f32x4*)(bp + col + 4); }
                    const f32x4 v0 = acc[ai][bj][m][0] + b0, v1 = acc[ai][bj][m][1] + b1;
                    s += (v0[0] * v0[0] + v0[1] * v0[1]) + (v0[2] * v0[2] + v0[3] * v0[3]) + (v1[0] * v1[0] + v1[1] * v1[1]) + (v1[2] * v1[2] + v1[3] * v1[3]);
                    if (ook) { *(f32x4*)(out + (size_t)row * 1024 + col) = v0; *(f32x4*)(out + (size_t)row * 1024 + col + 4) = v1; }
                    if (outb) { u32x4 w; w.x = cvt_pk_bf16(v0[0], v0[1]); w.y = cvt_pk_bf16(v0[2], v0[3]); w.z = cvt_pk_bf16(v1[0], v1[1]); w.w = cvt_pk_bf16(v1[2], v1[3]); *(u32x4*)(outb + (size_t)row * 1024 + col) = w; }
                }
                s += __shfl_xor(s, 16); s += __shfl_xor(s, 32);
                if (fq == 0) atomicAdd(ss + row, s);
            }
    }
};

struct EpiSwiGLU {
    static constexpr bool PERM = true, AFTER_DRAIN = false;
    bf16_t* ACT; const float* ss;
    __device__ __forceinline__ void operator()(const f32x4 (&acc)[2][2][4][2], const Unit& u, int wr, int wc, int fr, int fq) const {
        const int row0 = u.pm * BM + wr * 64 + fr;
#pragma unroll
        for (int ai = 0; ai < 2; ++ai)
#pragma unroll
            for (int m = 0; m < 4; ++m) {
                const int row = row0 + ai * HALF + m * 16;
                const float r = __builtin_amdgcn_rsqf(ss[row] * (1.0f / 1024.0f) + RMS_EPS);
#pragma unroll
                for (int bj = 0; bj < 2; ++bj) {
                    const int J = u.pn * 128 + bj * 64 + wc * 16 + 4 * fq;
                    const f32x4 a = acc[ai][bj][m][0] * r, b = acc[ai][bj][m][1] * r;
                    float o[4];
#pragma unroll
                    for (int j = 0; j < 4; ++j) o[j] = a[j] * sigm(a[j]) * b[j];
                    u32x2 w; w.x = cvt_pk_bf16(o[0], o[1]); w.y = cvt_pk_bf16(o[2], o[3]);
                    *(u32x2*)(ACT + (size_t)row * 2816 + J) = w;
                }
            }
    }
};

template <class Epi, class Sched, bool ALIGN_EPI = false, bool SP2 = false>
__device__ __forceinline__ void gemm_phase(PG8_LAS unsigned char* lds, const Gemm g, const Sched& S, const Epi& E) {
    const int tid = threadIdx.x, wid = __builtin_amdgcn_readfirstlane(tid >> 6), lane = tid & 63, wr = wid >> 2, wc = wid & 3, fr = lane & 15, fq = lane >> 4;
    const int K = g.K, nt = K / BK;
    unsigned voffA[2], voffB[2];
#pragma unroll
    for (int i = 0; i < 2; ++i) { int R, C; stage_rc(tid * 16 + i * 8192, R, C); const int Rb = Epi::PERM ? ((R & ~31) + perm32(R & 31)) : R;
        voffA[i] = (unsigned)(R * K + C) * 2u; voffB[i] = (unsigned)(Rb * K + C) * 2u; }
    const size_t kstep = (size_t)(BK * 2);
    const size_t hstep = (size_t)HALF * K * 2;
    const size_t tstep = 2 * hstep;
    const unsigned ldsw = (unsigned)wid * 1024u;
    const int aoff = lds_byte(wr * 64 + fr, fq * 8), boff = lds_byte(wc * 32 + fr, fq * 8);
#define PG8_SA(b, h) (((b) * 2 + (h)) * HTB)
#define PG8_SB(b, h) ((4 + (b) * 2 + (h)) * HTB)
#define PG8_STAGE(bufoff, gbase, voff) do { _Pragma("unroll") for (int _i = 0; _i < 2; ++_i) \
        __builtin_amdgcn_global_load_lds((const unsigned*)((const char*)(gbase) + (voff)[_i]), (PG8_LAS unsigned*)(lds + (bufoff) + ldsw + _i * 8192), 16, 0, 0); } while (0)
#define PG8_LDA(dst, b, h) do { _Pragma("unroll") for (int m = 0; m < 4; ++m) _Pragma("unroll") for (int k = 0; k < 2; ++k) dst[m][k] = *(const PG8_LAS bf16x8*)(lds + PG8_SA(b, h) + aoff + m * 2048 + k * 1024); } while (0)
#define PG8_LDB(dst, b, h) do { _Pragma("unroll") for (int n = 0; n < 2; ++n) _Pragma("unroll") for (int k = 0; k < 2; ++k) dst[n][k] = *(const PG8_LAS bf16x8*)(lds + PG8_SB(b, h) + boff + n * 2048 + k * 1024); } while (0)
#define PG8_MMA(ai, bj, At, Bt) do { __builtin_amdgcn_s_setprio(1); _Pragma("unroll") for (int m = 0; m < 4; ++m) _Pragma("unroll") for (int n = 0; n < 2; ++n) _Pragma("unroll") for (int k = 0; k < 2; ++k) \
        acc[ai][bj][m][n] = __builtin_amdgcn_mfma_f32_16x16x32_bf16(Bt[n][k], At[m][k], acc[ai][bj][m][n], 0, 0, 0); __builtin_amdgcn_s_setprio(0); } while (0)
#define PG8_WAIT_V(n) asm volatile("s_waitcnt vmcnt(" #n ")" ::: "memory")
#define PG8_WAIT_L(n) asm volatile("s_waitcnt lgkmcnt(" #n ")" ::: "memory")
#define PG8_BAR __builtin_amdgcn_s_barrier()
#define PG8_SCHED __builtin_amdgcn_sched_barrier(0)
    Unit cur, nxt; int ui = 0;
    if (!S.next(0, cur)) return;
    f32x4 acc[2][2][4][2];
#pragma unroll
    for (int a = 0; a < 2; ++a)
#pragma unroll
        for (int b = 0; b < 2; ++b)
#pragma unroll
            for (int m = 0; m < 4; ++m)
#pragma unroll
                for (int n = 0; n < 2; ++n) acc[a][b][m][n] = (f32x4){0.f, 0.f, 0.f, 0.f};
    bf16x8 At[4][2], B0[2][2], B1[2][2];
    const char* cA = (const char*)g.A + (size_t)cur.pm * tstep; const char* cB = (const char*)g.Bt + (size_t)cur.pn * tstep;
    S.a_ready(cur);
    if constexpr (SP2) {
        PG8_STAGE(PG8_SB(0, 0), cB, voffB); PG8_STAGE(PG8_SB(0, 1), cB + hstep, voffB); PG8_STAGE(PG8_SA(0, 0), cA, voffA); PG8_STAGE(PG8_SA(0, 1), cA + hstep, voffA);
        if (wr == 1) PG8_BAR;
        PG8_WAIT_V(2); PG8_BAR;
        PG8_STAGE(PG8_SB(1, 0), cB + kstep, voffB); PG8_STAGE(PG8_SA(1, 0), cA + kstep, voffA); PG8_STAGE(PG8_SB(1, 1), cB + hstep + kstep, voffB);
        PG8_WAIT_V(6); PG8_BAR;
    } else {
        PG8_STAGE(PG8_SB(0, 0), cB, voffB); PG8_STAGE(PG8_SA(0, 0), cA, voffA); PG8_STAGE(PG8_SB(0, 1), cB + hstep, voffB); PG8_STAGE(PG8_SA(0, 1), cA + hstep, voffA);
        if (wr == 1) PG8_BAR;
        PG8_WAIT_V(4); PG8_BAR;
        PG8_STAGE(PG8_SB(1, 0), cB + kstep, voffB); PG8_STAGE(PG8_SA(1, 0), cA + kstep, voffA); PG8_STAGE(PG8_SB(1, 1), cB + hstep + kstep, voffB);
        PG8_WAIT_V(6); PG8_BAR;
    }
    for (;;) {
        const bool has_next = S.next(ui + 1, nxt);
        const char* nA = has_next ? (const char*)g.A + (size_t)nxt.pm * tstep : cA; const char* nB = has_next ? (const char*)g.Bt + (size_t)nxt.pn * tstep : cB;
        for (int t = 0; t < nt; t += 2) {
            const bool last = (t == nt - 2);
            const char* a1 = cA + (size_t)(t + 1) * kstep;
            const char* a2 = last ? nA : cA + (size_t)(t + 2) * kstep; const char* b2 = last ? nB : cB + (size_t)(t + 2) * kstep;
            const char* a3 = a2 + kstep; const char* b3 = b2 + kstep;
            if (last && has_next) S.a_ready(nxt);
            if constexpr (SP2) {
            PG8_LDB(B0, 0, 0); PG8_LDB(B1, 0, 1); PG8_SCHED; PG8_LDA(At, 0, 0); PG8_STAGE(PG8_SA(1, 1), a1 + hstep, voffA);
            PG8_WAIT_V(8); PG8_WAIT_L(0); PG8_BAR; PG8_MMA(0, 0, At, B0); PG8_MMA(0, 1, At, B1); PG8_BAR; PG8_SCHED;
            PG8_LDA(At, 0, 1); PG8_STAGE(PG8_SB(0, 0), b2, voffB); PG8_STAGE(PG8_SB(0, 1), b2 + hstep, voffB); PG8_STAGE(PG8_SA(0, 0), a2, voffA);
            PG8_WAIT_V(8); PG8_WAIT_L(0); PG8_BAR; PG8_MMA(1, 0, At, B0); PG8_MMA(1, 1, At, B1); PG8_BAR; PG8_SCHED;
            PG8_LDB(B0, 1, 0); PG8_LDB(B1, 1, 1); PG8_SCHED; PG8_LDA(At, 1, 0); PG8_STAGE(PG8_SA(0, 1), a2 + hstep, voffA);
            PG8_WAIT_V(8); PG8_WAIT_L(0); PG8_BAR; PG8_MMA(0, 0, At, B0); PG8_MMA(0, 1, At, B1); PG8_BAR; PG8_SCHED;
            PG8_LDA(At, 1, 1); PG8_STAGE(PG8_SB(1, 0), b3, voffB); PG8_STAGE(PG8_SB(1, 1), b3 + hstep, voffB); PG8_STAGE(PG8_SA(1, 0), a3, voffA);
            PG8_WAIT_V(8); PG8_WAIT_L(0); PG8_BAR; PG8_MMA(1, 0, At, B0); PG8_MMA(1, 1, At, B1); PG8_BAR; PG8_SCHED;
            } else {
            PG8_LDB(B0, 0, 0); PG8_SCHED; PG8_LDA(At, 0, 0); PG8_STAGE(PG8_SA(1, 1), a1 + hstep, voffA);
            PG8_WAIT_L(8); PG8_BAR; PG8_WAIT_L(0); PG8_MMA(0, 0, At, B0); PG8_BAR; PG8_SCHED;
            PG8_LDB(B1, 0, 1); PG8_STAGE(PG8_SB(0, 0), b2, voffB);
            PG8_BAR; PG8_WAIT_L(0); PG8_MMA(0, 1, At, B1); PG8_BAR;
            PG8_LDA(At, 0, 1); PG8_STAGE(PG8_SA(0, 0), a2, voffA);
            PG8_BAR; PG8_WAIT_L(0); PG8_MMA(1, 0, At, B0); PG8_BAR; PG8_SCHED;
            PG8_STAGE(PG8_SB(0, 1), b2 + hstep, voffB);
            PG8_WAIT_V(6); PG8_BAR; PG8_MMA(1, 1, At, B1); PG8_BAR;
            PG8_LDB(B0, 1, 0); PG8_SCHED; PG8_LDA(At, 1, 0); PG8_STAGE(PG8_SA(0, 1), a2 + hstep, voffA);
            PG8_WAIT_L(8); PG8_BAR; PG8_WAIT_L(0); PG8_MMA(0, 0, At, B0); PG8_BAR; PG8_SCHED;
            PG8_LDB(B1, 1, 1); PG8_STAGE(PG8_SB(1, 0), b3, voffB);
            PG8_BAR; PG8_WAIT_L(0); PG8_MMA(0, 1, At, B1); PG8_BAR;
            PG8_LDA(At, 1, 1); PG8_STAGE(PG8_SA(1, 0), a3, voffA);
            PG8_BAR; PG8_WAIT_L(0); PG8_MMA(1, 0, At, B0); PG8_BAR; PG8_SCHED;
            PG8_STAGE(PG8_SB(1, 1), b3 + hstep, voffB);
            PG8_WAIT_V(6); PG8_BAR; PG8_MMA(1, 1, At, B1); PG8_BAR;
            }
        }
        if constexpr (ALIGN_EPI) { if (wr == 0) PG8_BAR; }
        if constexpr (!Epi::AFTER_DRAIN) { E(acc, cur, wr, wc, fr, fq); S.done(cur); }
        if (!has_next) break;
#pragma unroll
        for (int a = 0; a < 2; ++a)
#pragma unroll
            for (int b = 0; b < 2; ++b)
#pragma unroll
                for (int m = 0; m < 4; ++m)
#pragma unroll
                    for (int n = 0; n < 2; ++n) acc[a][b][m][n] = (f32x4){0.f, 0.f, 0.f, 0.f};
        cur = nxt; cA = nA; cB = nB; ++ui;
        if constexpr (ALIGN_EPI) { if (wr == 1) PG8_BAR; }
    }
    PG8_WAIT_V(0);
    if constexpr (!ALIGN_EPI) { if (wr == 0) PG8_BAR; }
    PG8_BAR;
    if constexpr (Epi::AFTER_DRAIN) { E.fused(acc, cur, wr, wc, fr, fq, lds, wid, lane); S.done(cur); }
#undef PG8_SA
#undef PG8_SB
#undef PG8_STAGE
#undef PG8_LDA
#undef PG8_LDB
#undef PG8_MMA
#undef PG8_WAIT_V
#undef PG8_WAIT_L
#undef PG8_BAR
#undef PG8_SCHED
}
}
#define LAS __attribute__((address_space(3)))
#define XB_TMO      128
#define XB_XCNT(j)  (256  + 64 * (j))
#define XB_XSUB(j)  (1280 + 64 * (j))
#define XB_XGEN(j)  (2304 + 64 * (j))
#define XB_TOP      3328
#define XB_TOPGEN   3392
#define XCD_BAR_WORDS 3456
#define XB_SPIN_CAP (1u << 18)

__device__ __forceinline__ unsigned xb_ld(unsigned* p)              { return __hip_atomic_load(p, __ATOMIC_RELAXED, __HIP_MEMORY_SCOPE_AGENT); }
__device__ __forceinline__ unsigned xb_add(unsigned* p, unsigned v) { return __hip_atomic_fetch_add(p, v, __ATOMIC_RELAXED, __HIP_MEMORY_SCOPE_AGENT); }
__device__ __forceinline__ unsigned xb_xcc_id() { return (unsigned)__builtin_amdgcn_s_getreg((3 << 11) | 20) & 0xFu; }
#define XB_SPIN(cond, bar) do { unsigned _sp = 0; while (cond) { __builtin_amdgcn_s_sleep(1); \
    if ((++_sp & 255u) == 0u) { if (xb_ld(&(bar)[XB_TMO])) break; if (_sp > XB_SPIN_CAP) { atomicAdd(&(bar)[XB_TMO], 1u); break; } } } } while (0)

struct XcdBarrier {
    unsigned* bar; unsigned x;
    volatile LAS unsigned* st;
};

__device__ __forceinline__ XcdBarrier xcd_barrier_post(unsigned* bar, volatile LAS unsigned* st) {
    XcdBarrier b; b.bar = bar; b.x = xb_xcc_id(); b.st = st;
    if (threadIdx.x == 0) (void)xb_add(&bar[XB_XCNT(b.x)], 1u);
    return b;
}
__device__ __forceinline__ void xcd_barrier_complete(unsigned* bar, unsigned x, unsigned& nloc, unsigned& nx) {
    const unsigned G = gridDim.x * gridDim.y * gridDim.z;
    unsigned sum, cnt, mine, sp = 0u;
    for (;;) {
        sum = 0u; cnt = 0u; mine = 0u;
#pragma unroll
        for (unsigned j = 0; j < 16; ++j) { const unsigned c = xb_ld(&bar[XB_XCNT(j)]); sum += c; cnt += (c > 0u) ? 1u : 0u; mine = (j == x) ? c : mine; }
        if (sum == G) break;
        __builtin_amdgcn_s_sleep(1);
        if ((++sp & 255u) == 0u) { if (xb_ld(&bar[XB_TMO])) break; if (sp > XB_SPIN_CAP) { atomicAdd(&bar[XB_TMO], 1u); break; } }
    }
    nloc = mine > 0u ? mine : 1u; nx = cnt > 0u ? cnt : 1u;
}

__device__ __forceinline__ void xcd_barrier(const XcdBarrier& b) {
    asm volatile("s_waitcnt vmcnt(0)" ::: "memory");
    __syncthreads();
    if (threadIdx.x == 0) {
        unsigned* bar = b.bar;
        __builtin_amdgcn_s_waitcnt(0);
        unsigned nloc = b.st[0], nx = b.st[1];
        if (nloc == 0u) { xcd_barrier_complete(bar, b.x, nloc, nx); b.st[0] = nloc; b.st[1] = nx; }
        const unsigned old = xb_add(&bar[XB_XSUB(b.x)], 1u);
        const unsigned gen = old / nloc;
        if (old + 1u == (gen + 1u) * nloc) {
            __builtin_amdgcn_fence(__ATOMIC_RELEASE, "agent");
            asm volatile("s_waitcnt vmcnt(0)" ::: "memory");
            const unsigned og = xb_add(&bar[XB_TOP], 1u);
            const unsigned tg = og / nx;
            if (og + 1u == (tg + 1u) * nx) xb_add(&bar[XB_TOPGEN], 1u);
            else XB_SPIN(xb_ld(&bar[XB_TOPGEN]) == tg, bar);
            __builtin_amdgcn_fence(__ATOMIC_ACQUIRE, "agent");
            xb_add(&bar[XB_XGEN(b.x)], 1u);
            asm volatile("s_waitcnt vmcnt(0)" ::: "memory");
        } else {
            XB_SPIN(xb_ld(&bar[XB_XGEN(b.x)]) == gen, bar);
            __builtin_amdgcn_fence(__ATOMIC_ACQUIRE, "agent");
            asm volatile("s_waitcnt vmcnt(0)" ::: "memory");
        }
    }
    __syncthreads();
}

using pg8::bf16_t; using pg8::f32x4; using pg8::u32x4; using pg8::bf16x8;
typedef unsigned u32x2v __attribute__((ext_vector_type(2)));
constexpr int DM = 1024, NPR = 16384, NSM = 128, MT = 16640, NVALID = 16512, SEQ = 2048;
constexpr int HW = 512, NIN = 2560, DFF = 2816, NFF2 = 5632, MEMR = 2048;
constexpr float EPS = 1e-6f;
constexpr int NTHREADS = 512;
constexpr int LDS_BYTES = 147456;

constexpr size_t O_YP = 0, O_YS = 16777216, O_HP = 16908288, O_PP = 17432576, O_MK = 17494016, O_MV = 19591168, O_HS = 21688320, O_PS = 30076928;

constexpr size_t MiB = 1u << 20;
constexpr size_t WS_SS1 = 0, WS_SS2 = 128 * 1024, WS_SS3 = 256 * 1024, WS_BAR = 512 * 1024, BAR_BYTES = 16384;
constexpr size_t WS_WIN = 1 * MiB, WS_WOUT = 6 * MiB, WS_WCQ = 8 * MiB, WS_WCO = 10 * MiB, WS_WFFI = 12 * MiB, WS_WFFO = 23 * MiB, WS_WKV = 29 * MiB, WS_PMIX = 33 * MiB;
constexpr size_t WS_MEMH = 34 * MiB, WS_KB = 38 * MiB, WS_VT = 42 * MiB, WS_DEC = 46 * MiB;
constexpr size_t WS_H0 = 47 * MiB;
constexpr size_t WS_MIX = 80 * MiB;
constexpr size_t WS_X1 = 113 * MiB;
constexpr size_t WS_Q = 178 * MiB;
constexpr size_t WS_O = 211 * MiB;
constexpr size_t WS_SL = 244 * MiB;
constexpr size_t WS_A = 309 * MiB;
constexpr size_t WS_QQ = WS_A, WS_KK = WS_A + 17 * MiB, WS_VV = WS_A + 34 * MiB, WS_GG = WS_A + 51 * MiB, WS_LF = WS_A + 68 * MiB, WS_UU = WS_A + 101 * MiB;
constexpr size_t WS_END = 443 * MiB;

struct Args { const float* in[23]; float* out; unsigned char* ws; int ph_lo, ph_hi; };

__device__ __forceinline__ unsigned f2bf(float f) { unsigned u = __builtin_bit_cast(unsigned, f); return (u + 0x7fffu + ((u >> 16) & 1u)) >> 16; }
__device__ __forceinline__ unsigned pk2(float lo, float hi) { return f2bf(lo) | (f2bf(hi) << 16); }
__device__ __forceinline__ float bf2f(unsigned h) { return __uint_as_float(h << 16); }
__device__ __forceinline__ float bfe(const u32x4& v, int j) { const unsigned w = v[j >> 1]; return (j & 1) ? __uint_as_float(w & 0xffff0000u) : __uint_as_float(w << 16); }
__device__ __forceinline__ unsigned short bfr(const u32x4& v, int j) { const unsigned w = v[j >> 1]; return (unsigned short)((j & 1) ? (w >> 16) : (w & 0xffffu)); }
__device__ __forceinline__ float wave_sum(float v) {
#pragma unroll
    for (int o = 1; o < 64; o <<= 1) v += __shfl_xor(v, o);
    return v;
}
#define MFMA16(a, b, c) __builtin_amdgcn_mfma_f32_16x16x32_bf16((a), (b), (c), 0, 0, 0)

template <int MODE>
__device__ __forceinline__ void tr_item(const float* W, int K, int N, bf16_t* WT, const float* gk, float* scr, int item, int lane) {
    const int nblk = N / 32, kb = item / nblk, nb = item % nblk, k0 = 64 * kb, n0 = 32 * nb;
#pragma unroll 8
    for (int i = 0; i < 32; ++i) { const int kk = 2 * i + (lane >> 5); scr[kk * 33 + (lane & 31)] = W[(size_t)(k0 + kk) * N + n0 + (lane & 31)]; }
    asm volatile("s_waitcnt lgkmcnt(0)" ::: "memory");
    const int c = lane & 7;
    float g8[8];
#pragma unroll
    for (int i = 0; i < 8; ++i) g8[i] = gk ? gk[k0 + 8 * c + i] : 1.0f;
#pragma unroll
    for (int j = 0; j < 4; ++j) { const int n = (lane >> 3) + 8 * j; const float* s = scr + (8 * c) * 33 + n;
        u32x4 o; o.x = pk2(s[0 * 33] * g8[0], s[1 * 33] * g8[1]); o.y = pk2(s[2 * 33] * g8[2], s[3 * 33] * g8[3]); o.z = pk2(s[4 * 33] * g8[4], s[5 * 33] * g8[5]); o.w = pk2(s[6 * 33] * g8[6], s[7 * 33] * g8[7]);
        int row = n0 + n;
        if (MODE == 1) { const int half = row >= DFF ? 1 : 0; const int J = row - half * DFF;
            row = 256 * (J >> 7) + 128 * ((J >> 6) & 1) + 32 * ((J >> 4) & 3) + 8 * ((J >> 2) & 3) + 4 * half + (J & 3); }
        *(u32x4*)(WT + (size_t)row * K + k0 + 8 * c) = o; }
    asm volatile("s_waitcnt lgkmcnt(0)" ::: "memory");
}
__device__ __forceinline__ void rms_row_to_bf16(const float* xrow, const float* g, bf16_t* orow, int lane) {
    const f32x4* xr = (const f32x4*)xrow + lane; const f32x4* gr = (const f32x4*)g + lane;
    f32x4 v[4]; float s = 0.f;
#pragma unroll
    for (int j = 0; j < 4; ++j) { v[j] = xr[64 * j]; s += (v[j].x * v[j].x + v[j].y * v[j].y) + (v[j].z * v[j].z + v[j].w * v[j].w); }
    const float rstd = 1.0f / sqrtf(wave_sum(s) * (1.f / DM) + EPS);
    unsigned long long* o8 = (unsigned long long*)orow + lane;
#pragma unroll
    for (int j = 0; j < 4; ++j) { const f32x4 gg = gr[64 * j];
        o8[64 * j] = (unsigned long long)pk2(v[j].x * rstd * gg.x, v[j].y * rstd * gg.y) | ((unsigned long long)pk2(v[j].z * rstd * gg.z, v[j].w * rstd * gg.w) << 32); }
}
__device__ __forceinline__ void p0_prologue(const Args& A, unsigned char* lds, int G) {
    const int tid = threadIdx.x, lane = tid & 63, wave = tid >> 6;
    float* scr = (float*)(lds + wave * 16384);
    unsigned char* ws = A.ws;
    const int gw = blockIdx.x * 8 + wave, NGW = G * 8;
    constexpr int I_IN = 16 * 80, I_OUT = 16 * 32, I_CQ = 16 * 32, I_CO = 16 * 32, I_FFI = 16 * 176, I_FFO = 44 * 32, I_KV = 16 * 64, I_PM = 4 * 8;
    constexpr int NITEMS = I_IN + I_OUT + I_CQ + I_CO + I_FFI + I_FFO + I_KV + I_PM;
    for (int it = gw; it < NITEMS; it += NGW) {
        int r = it;
        if (r < I_IN) { tr_item<0>(A.in[8], DM, NIN, (bf16_t*)(ws + WS_WIN), nullptr, scr, r, lane); continue; } r -= I_IN;
        if (r < I_OUT) { tr_item<0>(A.in[13], DM, DM, (bf16_t*)(ws + WS_WOUT), nullptr, scr, r, lane); continue; } r -= I_OUT;
        if (r < I_CQ) { tr_item<0>(A.in[17], DM, DM, (bf16_t*)(ws + WS_WCQ), A.in[16], scr, r, lane); continue; } r -= I_CQ;
        if (r < I_CO) { tr_item<0>(A.in[18], DM, DM, (bf16_t*)(ws + WS_WCO), nullptr, scr, r, lane); continue; } r -= I_CO;
        if (r < I_FFI) { tr_item<1>(A.in[20], DM, NFF2, (bf16_t*)(ws + WS_WFFI), A.in[19], scr, r, lane); continue; } r -= I_FFI;
        if (r < I_FFO) { tr_item<0>(A.in[21], DFF, DM, (bf16_t*)(ws + WS_WFFO), nullptr, scr, r, lane); continue; } r -= I_FFO;
        if (r < I_KV) { tr_item<0>(A.in[15], DM, 2 * DM, (bf16_t*)(ws + WS_WKV), nullptr, scr, r, lane); continue; } r -= I_KV;
        { const int g = r >> 3; tr_item<0>(A.in[11] + (size_t)g * 128 * 128, 128, 128, (bf16_t*)(ws + WS_PMIX) + (size_t)g * 128 * 128, nullptr, scr, r & 7, lane); }
    }
    bf16_t* H0 = (bf16_t*)(ws + WS_H0);
    for (int m = gw; m < NVALID; m += NGW) { const float* xr = m < NPR ? A.in[0] + (size_t)m * DM : A.in[1] + (size_t)(m - NPR) * DM; rms_row_to_bf16(xr, A.in[7], H0 + (size_t)m * DM, lane); }
    bf16_t* MEMH = (bf16_t*)(ws + WS_MEMH);
    for (int m = gw; m < MEMR; m += NGW) rms_row_to_bf16(A.in[2] + (size_t)m * DM, A.in[14], MEMH + (size_t)m * DM, lane);
    const int gt = blockIdx.x * NTHREADS + tid, NGT = G * NTHREADS;
    for (int i = gt; i < (MT - NVALID) * DM / 8; i += NGT) { const u32x4 z = {0u, 0u, 0u, 0u};
        ((u32x4*)(ws + WS_H0) + (size_t)NVALID * DM / 8)[i] = z; ((u32x4*)(ws + WS_MIX) + (size_t)NVALID * DM / 8)[i] = z; ((u32x4*)(ws + WS_O) + (size_t)NVALID * DM / 8)[i] = z; }
    for (int i = gt; i < MT; i += NGT) { ((float*)(ws + WS_SS1))[i] = 0.f; ((float*)(ws + WS_SS2))[i] = 0.f; ((float*)(ws + WS_SS3))[i] = 0.f; }
}

constexpr int L_BC = 0, L_TOT = 32768, L_QM = 34816, L_KM = 52224, L_VT = 69632, L_SP = 88064, L_AL = 122880, L_PART = 132096;
__device__ __forceinline__ void hgrn_cumsum(const float* LF, int R0, int C0, float* Bc, float* tot, int t) {
#pragma unroll
    for (int i = 0; i < 4; ++i) { const int idx = i * 512 + t, s = idx >> 5, k4 = idx & 31; *(f32x4*)(Bc + s * 128 + k4 * 4) = *(const f32x4*)(LF + (size_t)(R0 + s) * HW + C0 + k4 * 4); }
    __syncthreads();
    const int seg = t >> 7, k = t & 127; float run = 0.f;
#pragma unroll
    for (int i = 0; i < 16; ++i) { run += Bc[(seg * 16 + i) * 128 + k]; Bc[(seg * 16 + i) * 128 + k] = run; }
    tot[seg * 128 + k] = run;
    __syncthreads();
    float off = 0.f;
#pragma unroll
    for (int j = 0; j < 3; ++j) off += (j < seg) ? tot[j * 128 + k] : 0.f;
#pragma unroll
    for (int i = 0; i < 16; ++i) Bc[(seg * 16 + i) * 128 + k] += off;
    __syncthreads();
}
__device__ __forceinline__ void hgrn_local_unit(const Args& A, unsigned char* lds, int unit) {
    const int t = threadIdx.x, w = t >> 6, l = t & 63, lr = l & 15, lq = l >> 4;
    const int bh = unit >> 5, c = unit & 31, b = bh >> 2, h = bh & 3, R0 = b * SEQ + c * 64, C0 = h * 128;
    unsigned char* ws = A.ws;
    float* Bc = (float*)(lds + L_BC); float* tot = (float*)(lds + L_TOT);
    bf16_t* kdT = (bf16_t*)(lds + L_QM); bf16_t* vT = (bf16_t*)(lds + L_VT);
    hgrn_cumsum((const float*)(ws + WS_LF), R0, C0, Bc, tot, t);
    const bf16_t* KK = (const bf16_t*)(ws + WS_KK); const bf16_t* VV = (const bf16_t*)(ws + WS_VV);
#pragma unroll
    for (int i = 0; i < 2; ++i) { const int idx = (i * 512 + t) * 8, s = idx >> 7, k0 = idx & 127;
        const u32x4 kk = *(const u32x4*)(KK + (size_t)(R0 + s) * HW + C0 + k0), vv = *(const u32x4*)(VV + (size_t)(R0 + s) * HW + C0 + k0);
#pragma unroll
        for (int j = 0; j < 8; ++j) { const float e = __expf(Bc[63 * 128 + k0 + j] - Bc[s * 128 + k0 + j]);
            kdT[(k0 + j) * 72 + s] = (bf16_t)f2bf(bfe(kk, j) * e); vT[(k0 + j) * 72 + s] = bfr(vv, j); } }
    __syncthreads();
    f32x4 acc[8];
#pragma unroll
    for (int i = 0; i < 8; ++i) acc[i] = (f32x4){0.f, 0.f, 0.f, 0.f};
#pragma unroll
    for (int ks = 0; ks < 2; ++ks) { const bf16x8 a = *(const bf16x8*)(kdT + (16 * w + lr) * 72 + ks * 32 + lq * 8);
#pragma unroll
        for (int vt = 0; vt < 8; ++vt) { const bf16x8 bb = *(const bf16x8*)(vT + (16 * vt + lr) * 72 + ks * 32 + lq * 8); acc[vt] = MFMA16(a, bb, acc[vt]); } }
    float* SL = (float*)(ws + WS_SL) + (size_t)unit * 16384;
#pragma unroll
    for (int vt = 0; vt < 8; ++vt)
#pragma unroll
        for (int r = 0; r < 4; ++r) SL[(16 * w + lq * 4 + r) * 128 + 16 * vt + lr] = acc[vt][r];
    if (t < 128) ((float*)(ws + WS_DEC))[unit * 128 + t] = __expf(Bc[63 * 128 + t]);
    __syncthreads();
}
__device__ __forceinline__ void hgrn_out_unit(const Args& A, unsigned char* lds, int unit) {
    const int t = threadIdx.x, w = t >> 6, l = t & 63, lr = l & 15, lq = l >> 4;
    const int bh = unit >> 5, c = unit & 31, b = bh >> 2, h = bh & 3, R0 = b * SEQ + c * 64, C0 = h * 128;
    unsigned char* ws = A.ws;
    float* Bc = (float*)(lds + L_BC); float* tot = (float*)(lds + L_TOT); float* part = (float*)(lds + L_PART);
    bf16_t* qm = (bf16_t*)(lds + L_QM); bf16_t* km = (bf16_t*)(lds + L_KM); bf16_t* vT = (bf16_t*)(lds + L_VT); bf16_t* spT = (bf16_t*)(lds + L_SP); bf16_t* aL = (bf16_t*)(lds + L_AL);
    hgrn_cumsum((const float*)(ws + WS_LF), R0, C0, Bc, tot, t);
    const bf16_t* QQ = (const bf16_t*)(ws + WS_QQ); const bf16_t* KK = (const bf16_t*)(ws + WS_KK); const bf16_t* VV = (const bf16_t*)(ws + WS_VV);
#pragma unroll
    for (int i = 0; i < 2; ++i) { const int idx = (i * 512 + t) * 8, s = idx >> 7, k0 = idx & 127;
        const size_t go = (size_t)(R0 + s) * HW + C0 + k0;
        const u32x4 qq = *(const u32x4*)(QQ + go), kk = *(const u32x4*)(KK + go), vv = *(const u32x4*)(VV + go);
        float qv[8], kv[8];
#pragma unroll
        for (int j = 0; j < 8; ++j) { const float d = Bc[s * 128 + k0 + j] - Bc[31 * 128 + k0 + j];
            qv[j] = bfe(qq, j) * __expf(d); kv[j] = bfe(kk, j) * __expf(-d); vT[(k0 + j) * 72 + s] = bfr(vv, j); }
        u32x4 o; o.x = pk2(qv[0], qv[1]); o.y = pk2(qv[2], qv[3]); o.z = pk2(qv[4], qv[5]); o.w = pk2(qv[6], qv[7]); *(u32x4*)(qm + s * 136 + k0) = o;
        o.x = pk2(kv[0], kv[1]); o.y = pk2(kv[2], kv[3]); o.z = pk2(kv[4], kv[5]); o.w = pk2(kv[6], kv[7]); *(u32x4*)(km + s * 136 + k0) = o; }
    const float* SL = (const float*)(ws + WS_SL) + (size_t)unit * 16384;
#pragma unroll
    for (int i = 0; i < 8; ++i) { const int idx = i * 512 + t, k = idx >> 5, v4 = idx & 31; const f32x4 sv = *(const f32x4*)(SL + k * 128 + v4 * 4); const float em = __expf(Bc[31 * 128 + k]);
#pragma unroll
        for (int j = 0; j < 4; ++j) spT[(v4 * 4 + j) * 136 + k] = (bf16_t)f2bf(sv[j] * em); }
    __syncthreads();
    {
        const int ct = w & 3;
        f32x4 a2[2]; a2[0] = (f32x4){0.f, 0.f, 0.f, 0.f}; a2[1] = a2[0];
#pragma unroll
        for (int ks = 0; ks < 4; ++ks) { const bf16x8 a = *(const bf16x8*)(qm + (16 * ct + lr) * 136 + ks * 32 + lq * 8);
#pragma unroll
            for (int i = 0; i < 2; ++i) { const int st = (w >> 2) * 2 + i; const bf16x8 bb = *(const bf16x8*)(km + (16 * st + lr) * 136 + ks * 32 + lq * 8); a2[i] = MFMA16(a, bb, a2[i]); } }
#pragma unroll
        for (int i = 0; i < 2; ++i) { const int st = (w >> 2) * 2 + i, s = 16 * st + lr;
#pragma unroll
            for (int r = 0; r < 4; ++r) { const int cc = 16 * ct + lq * 4 + r; aL[cc * 72 + s] = (bf16_t)f2bf(s <= cc ? a2[i][r] : 0.f); } }
    }
    __syncthreads();
    const int ct = w & 3, vh = w >> 2;
    f32x4 o4[4];
#pragma unroll
    for (int i = 0; i < 4; ++i) o4[i] = (f32x4){0.f, 0.f, 0.f, 0.f};
#pragma unroll
    for (int ks = 0; ks < 4; ++ks) { const bf16x8 a = *(const bf16x8*)(qm + (16 * ct + lr) * 136 + ks * 32 + lq * 8);
#pragma unroll
        for (int i = 0; i < 4; ++i) { const int vt = vh * 4 + i; const bf16x8 bb = *(const bf16x8*)(spT + (16 * vt + lr) * 136 + ks * 32 + lq * 8); o4[i] = MFMA16(a, bb, o4[i]); } }
#pragma unroll
    for (int ks = 0; ks < 2; ++ks) { const bf16x8 a = *(const bf16x8*)(aL + (16 * ct + lr) * 72 + ks * 32 + lq * 8);
#pragma unroll
        for (int i = 0; i < 4; ++i) { const int vt = vh * 4 + i; const bf16x8 bb = *(const bf16x8*)(vT + (16 * vt + lr) * 72 + ks * 32 + lq * 8); o4[i] = MFMA16(a, bb, o4[i]); } }
#pragma unroll
    for (int r = 0; r < 4; ++r) { float s = 0.f;
#pragma unroll
        for (int i = 0; i < 4; ++i) s += o4[i][r] * o4[i][r];
        s += __shfl_xor(s, 1); s += __shfl_xor(s, 2); s += __shfl_xor(s, 4); s += __shfl_xor(s, 8);
        if (lr == 0) part[vh * 64 + 16 * ct + lq * 4 + r] = s; }
    __syncthreads();
    const float* hn = A.in[10]; const bf16_t* GG = (const bf16_t*)(ws + WS_GG); bf16_t* MIX = (bf16_t*)(ws + WS_MIX);
#pragma unroll
    for (int r = 0; r < 4; ++r) { const int cc = 16 * ct + lq * 4 + r; const float rstd = __builtin_amdgcn_rsqf((part[cc] + part[64 + cc]) * (1.0f / 128.0f) + EPS);
#pragma unroll
        for (int i = 0; i < 4; ++i) { const int v = (vh * 4 + i) * 16 + lr; const float g = bf2f(GG[(size_t)(R0 + cc) * HW + C0 + v]);
            MIX[(size_t)(R0 + cc) * DM + C0 + v] = (bf16_t)f2bf(o4[i][r] * rstd * hn[C0 + v] * g); } }
    __syncthreads();
}
__device__ __forceinline__ void hgrn_scan(const Args& A, int G) {
    float* SLb = (float*)(A.ws + WS_SL); const float* DEC = (const float*)(A.ws + WS_DEC); float* outp = A.out + O_HP;
    for (int e = blockIdx.x * NTHREADS + threadIdx.x; e < 32 * 4096; e += G * NTHREADS) { const int bh = e >> 12, i4 = e & 4095, k = i4 >> 5;
        f32x4 S = (f32x4){0.f, 0.f, 0.f, 0.f};
        f32x4* p = (f32x4*)(SLb + (size_t)bh * 32 * 16384) + i4;
        f32x4 cur = p[0];
#pragma unroll 4
        for (int c = 0; c < 32; ++c) { const f32x4 nxt = (c < 31) ? p[(size_t)(c + 1) * 4096] : cur; const float d = DEC[(bh * 32 + c) * 128 + k];
            p[(size_t)c * 4096] = S; S = S * d + cur; cur = nxt; }
        *((f32x4*)(outp + (size_t)bh * 16384) + i4) = S; }
}
__device__ __forceinline__ void pool_states(const Args& A, int G) {
    const float* UU = (const float*)(A.ws + WS_UU);
    const int gt = blockIdx.x * NTHREADS + threadIdx.x, NGT = G * NTHREADS;
    for (int i = gt; i < 8 * 15 * 512; i += NGT) { const int cch = i & 511, j = (i >> 9) % 15, b = i / (15 * 512); A.out[O_PP + i] = UU[(size_t)(b * SEQ + 2033 + j) * HW + cch]; }
    for (int i = gt; i < 128 * 15 * 512; i += NGT) { const int cch = i & 511, j = (i >> 9) % 15, b = i / (15 * 512);
        A.out[O_PS + i] = (j < 14) ? A.in[4][(size_t)(b * 15 + j + 1) * 512 + cch] : UU[(size_t)(NPR + b) * HW + cch]; }
}
__device__ __forceinline__ void hgrn_sample_unit(const Args& A, unsigned char* lds, int unit) {
    const int t = threadIdx.x, b = unit >> 2, h = unit & 3, row = NPR + b, C0 = h * 128;
    unsigned char* ws = A.ws;
    float* qs = (float*)lds; float* ks = qs + 128; float* fs = ks + 128; float* vs = fs + 128; float* po = vs + 128;
    float* red = po + 16 * 128;
    if (t < 128) { const size_t go = (size_t)row * HW + C0 + t;
        qs[t] = bf2f(((const bf16_t*)(ws + WS_QQ))[go]); ks[t] = bf2f(((const bf16_t*)(ws + WS_KK))[go]); fs[t] = __expf(((const float*)(ws + WS_LF))[go]); vs[t] = bf2f(((const bf16_t*)(ws + WS_VV))[go]); }
    __syncthreads();
    const int v4 = t & 31, kg = t >> 5;
    const float* S0 = A.in[3] + (size_t)unit * 16384; float* S1 = A.out + O_HS + (size_t)unit * 16384;
    const f32x4 vv = *(const f32x4*)(vs + v4 * 4);
    f32x4 o = (f32x4){0.f, 0.f, 0.f, 0.f};
#pragma unroll
    for (int i = 0; i < 8; ++i) { const int k = kg * 8 + i; const f32x4 s = *(const f32x4*)(S0 + k * 128 + v4 * 4); const f32x4 sn = s * fs[k] + vv * ks[k]; *(f32x4*)(S1 + k * 128 + v4 * 4) = sn; o += sn * qs[k]; }
    *(f32x4*)(po + kg * 128 + v4 * 4) = o;
    __syncthreads();
    float ov = 0.f;
    if (t < 128) {
#pragma unroll
        for (int i = 0; i < 16; ++i) ov += po[i * 128 + t];
        const float sq = wave_sum(ov * ov); if ((t & 63) == 0) red[t >> 6] = sq; }
    __syncthreads();
    if (t < 128) { const float rstd = __builtin_amdgcn_rsqf((red[0] + red[1]) * (1.0f / 128.0f) + EPS); const float g = bf2f(((const bf16_t*)(ws + WS_GG))[(size_t)row * HW + C0 + t]);
        ((bf16_t*)(ws + WS_MIX))[(size_t)row * DM + C0 + t] = (bf16_t)f2bf(ov * rstd * A.in[10][C0 + t] * g); }
    __syncthreads();
}

constexpr int LP_EXT = 0, LP_PL = 40448, LP_MX = 57856;
__device__ __forceinline__ void pool_unit(const Args& A, unsigned char* lds, int unit) {
    const int t = threadIdx.x, w = t >> 6, l = t & 63, lr = l & 15, lq = l >> 4;
    const int tt = unit >> 2, g = unit & 3, win = 2 << g;
    unsigned char* ws = A.ws;
    float* ext = (float*)(lds + LP_EXT); bf16_t* pl = (bf16_t*)(lds + LP_PL); bf16_t* mx = (bf16_t*)(lds + LP_MX);
    const float* UU = (const float*)(ws + WS_UU);
    {
        const bf16_t* PM = (const bf16_t*)(ws + WS_PMIX) + (size_t)g * 16384;
#pragma unroll
        for (int i = 0; i < 4; ++i) { const int idx = i * 512 + t, d = idx >> 4, c8 = idx & 15; *(u32x4*)(mx + d * 136 + c8 * 8) = *(const u32x4*)(PM + d * 128 + c8 * 8); }
    }
    int rowbase;
    if (tt < 256) {
        const int b = tt >> 5, t0 = (tt & 31) * 64; rowbase = b * SEQ + t0;
        for (int idx = t; idx < 79 * 32; idx += NTHREADS) { const int i = idx >> 5, c4 = idx & 31; const int tp = t0 - 15 + i;
            f32x4 v = (f32x4){0.f, 0.f, 0.f, 0.f}; if (tp >= 0) v = *(const f32x4*)(UU + (size_t)(b * SEQ + tp) * HW + g * 128 + c4 * 4);
            *(f32x4*)(ext + i * 128 + c4 * 4) = v; }
        __syncthreads();
        const int cch = t & 127, tg = t >> 7;
#pragma unroll 4
        for (int i = 0; i < 16; ++i) { const int tok = tg * 16 + i; float s = 0.f;
            for (int j = 0; j < win; ++j) s += ext[(15 + tok - j) * 128 + cch];
            const int cnt = min(t0 + tok + 1, win);
            pl[tok * 136 + cch] = (bf16_t)f2bf(s / (float)cnt - ext[(15 + tok) * 128 + cch]); }
    } else {
        const int sb0 = (tt - 256) * 64; rowbase = NPR + sb0;
        const int cch = t & 127, tg = t >> 7;
        for (int i = 0; i < 16; ++i) { const int tok = tg * 16 + i, sb = sb0 + tok; const float uv = UU[(size_t)(NPR + sb) * HW + g * 128 + cch]; float s = uv;
            for (int j = 16 - win; j < 15; ++j) s += A.in[4][(size_t)(sb * 15 + j) * 512 + g * 128 + cch];
            pl[tok * 136 + cch] = (bf16_t)f2bf(s / (float)win - uv); }
    }
    __syncthreads();
    const int ct = w & 3, dh = w >> 2;
    f32x4 o4[4];
#pragma unroll
    for (int i = 0; i < 4; ++i) o4[i] = (f32x4){0.f, 0.f, 0.f, 0.f};
#pragma unroll
    for (int ks = 0; ks < 4; ++ks) { const bf16x8 a = *(const bf16x8*)(pl + (16 * ct + lr) * 136 + ks * 32 + lq * 8);
#pragma unroll
        for (int i = 0; i < 4; ++i) { const int dt = dh * 4 + i; const bf16x8 bb = *(const bf16x8*)(mx + (16 * dt + lr) * 136 + ks * 32 + lq * 8); o4[i] = MFMA16(a, bb, o4[i]); } }
    bf16_t* MIX = (bf16_t*)(ws + WS_MIX); const float* psc = A.in[12];
#pragma unroll
    for (int i = 0; i < 4; ++i) { const int d = (dh * 4 + i) * 16 + lr; const float sc = psc[g * 128 + d];
#pragma unroll
        for (int r = 0; r < 4; ++r) { const int tok = 16 * ct + lq * 4 + r; MIX[(size_t)(rowbase + tok) * DM + 512 + g * 128 + d] = (bf16_t)f2bf(o4[i][r] * sc); } }
    __syncthreads();
}

__device__ __forceinline__ void attn_prompt_unit(const Args& A, unsigned char* lds, int unit) {
    const int t = threadIdx.x, w = t >> 6, l = t & 63, lr = l & 15, lq = l >> 4;
    const int qt = unit & 15, h = (unit >> 4) & 3, b = unit >> 6;
    unsigned char* ws = A.ws;
    const bf16_t* Q = (const bf16_t*)(ws + WS_Q); const bf16_t* KB = (const bf16_t*)(ws + WS_KB); const bf16_t* VT = (const bf16_t*)(ws + WS_VT); bf16_t* O = (bf16_t*)(ws + WS_O);
    const int R0 = b * SEQ + qt * 128 + 16 * w;
    bf16_t* CB = (bf16_t*)lds;
    bf16_t* Pw = (bf16_t*)(lds + 73728) + w * (16 * 264);
    const bf16_t* kg = KB + (size_t)(b * 256) * DM + h * 256;
    const bf16_t* vg = VT + (size_t)(h * 256) * MEMR + b * 256;
    u32x4 stg[4];
#define AT_LOADK(c) _Pragma("unroll") for (int i_ = 0; i_ < 4; ++i_) { const int idx_ = i_ * 512 + t; stg[i_] = *(const u32x4*)(kg + (size_t)((c) * 64 + (idx_ >> 5)) * DM + (idx_ & 31) * 8); }
#define AT_LOADV(c) _Pragma("unroll") for (int i_ = 0; i_ < 4; ++i_) { const int idx_ = i_ * 512 + t; stg[i_] = *(const u32x4*)(vg + (size_t)(idx_ >> 3) * MEMR + (c) * 64 + (idx_ & 7) * 8); }
#define AT_STOREK(bf) _Pragma("unroll") for (int i_ = 0; i_ < 4; ++i_) { const int idx_ = i_ * 512 + t; *(u32x4*)(CB + (bf) * 18432 + (idx_ >> 5) * 264 + (idx_ & 31) * 8) = stg[i_]; }
#define AT_STOREV(bf) _Pragma("unroll") for (int i_ = 0; i_ < 4; ++i_) { const int idx_ = i_ * 512 + t; *(u32x4*)(CB + (bf) * 18432 + (idx_ >> 3) * 72 + (idx_ & 7) * 8) = stg[i_]; }
    AT_LOADK(0);
    bf16x8 qa[8];
#pragma unroll
    for (int ks = 0; ks < 8; ++ks) qa[ks] = *(const bf16x8*)(Q + (size_t)(R0 + lr) * DM + h * 256 + ks * 32 + lq * 8);
    AT_STOREK(0);
    __syncthreads();
    f32x4 sacc[16]; f32x4 oacc[16]; bf16x8 pa[8]; float rinv[4];
#pragma unroll
    for (int st = 0; st < 8; ++st) {
        if (st + 1 < 4) { AT_LOADK(st + 1); } else if (st + 1 < 8) { AT_LOADV(st - 3); }
        const bf16_t* cb = CB + (st & 1) * 18432;
        if (st < 4) {
#pragma unroll
            for (int nt = 0; nt < 4; ++nt) { f32x4 acc = (f32x4){0.f, 0.f, 0.f, 0.f};
#pragma unroll
                for (int ks = 0; ks < 8; ++ks) { const bf16x8 bb = *(const bf16x8*)(cb + (nt * 16 + lr) * 264 + ks * 32 + lq * 8); acc = MFMA16(qa[ks], bb, acc); }
                sacc[st * 4 + nt] = acc; __builtin_amdgcn_sched_barrier(0); }
        } else {
            if (st == 4) {
#pragma unroll
                for (int r = 0; r < 4; ++r) { float mx = sacc[0][r];
#pragma unroll
                    for (int nt = 1; nt < 16; ++nt) mx = fmaxf(mx, sacc[nt][r]);
                    mx = fmaxf(mx, __shfl_xor(mx, 1)); mx = fmaxf(mx, __shfl_xor(mx, 2)); mx = fmaxf(mx, __shfl_xor(mx, 4)); mx = fmaxf(mx, __shfl_xor(mx, 8));
                    float sum = 0.f;
#pragma unroll
                    for (int nt = 0; nt < 16; ++nt) { const float p = __builtin_amdgcn_exp2f(sacc[nt][r] - mx); sum += p; Pw[(lq * 4 + r) * 264 + nt * 16 + lr] = (bf16_t)f2bf(p); }
                    sum += __shfl_xor(sum, 1); sum += __shfl_xor(sum, 2); sum += __shfl_xor(sum, 4); sum += __shfl_xor(sum, 8);
                    rinv[r] = 1.0f / sum; }
                asm volatile("s_waitcnt lgkmcnt(0)" ::: "memory");
#pragma unroll
                for (int ks = 0; ks < 8; ++ks) pa[ks] = *(const bf16x8*)(Pw + lr * 264 + ks * 32 + lq * 8);
#pragma unroll
                for (int dt = 0; dt < 16; ++dt) oacc[dt] = (f32x4){0.f, 0.f, 0.f, 0.f};
            }
            const int c = st - 4;
#pragma unroll
            for (int dt = 0; dt < 16; ++dt)
#pragma unroll
                for (int k2 = 0; k2 < 2; ++k2) { const bf16x8 bb = *(const bf16x8*)(cb + (dt * 16 + lr) * 72 + k2 * 32 + lq * 8); oacc[dt] = MFMA16(pa[c * 2 + k2], bb, oacc[dt]); if (k2 == 1 && (dt & 1)) __builtin_amdgcn_sched_barrier(0); }
        }
        if (st + 1 < 4) { AT_STOREK((st + 1) & 1); } else if (st + 1 < 8) { AT_STOREV((st + 1) & 1); }
        __syncthreads();
    }
#pragma unroll
    for (int dt = 0; dt < 16; ++dt)
#pragma unroll
        for (int r = 0; r < 4; ++r) Pw[(lq * 4 + r) * 264 + dt * 16 + lr] = (bf16_t)f2bf(oacc[dt][r] * rinv[r]);
    asm volatile("s_waitcnt lgkmcnt(0)" ::: "memory");
#pragma unroll
    for (int i = 0; i < 8; ++i) { const int idx = i * 64 + l, row = idx >> 5, c8 = idx & 31; *(u32x4*)(O + (size_t)(R0 + row) * DM + h * 256 + c8 * 8) = *(const u32x4*)(Pw + row * 264 + c8 * 8); }
    asm volatile("s_waitcnt lgkmcnt(0)" ::: "memory");
#undef AT_LOADK
#undef AT_LOADV
#undef AT_STOREK
#undef AT_STOREV
}
__device__ __forceinline__ void attn_sample_unit(const Args& A, unsigned char* lds, int unit) {
    const int t = threadIdx.x, w = t >> 6, l = t & 63;
    const int b = unit >> 2, h = unit & 3;
    unsigned char* ws = A.ws;
    float* qs = (float*)lds; float* sc = qs + 256; float* red = sc + 256; float* po = red + 16;
    if (t < 256) qs[t] = bf2f(((const bf16_t*)(ws + WS_Q))[(size_t)(NPR + b) * DM + h * 256 + t]);
    __syncthreads();
    const float* Kc = A.in[5] + (size_t)b * 256 * 1024 + h * 256; const float* Vc = A.in[6] + (size_t)b * 256 * 1024 + h * 256;
    {
        const int rl = l >> 4, c16 = l & 15;
        f32x4 q4[4];
#pragma unroll
        for (int i = 0; i < 4; ++i) q4[i] = *(const f32x4*)(qs + i * 64 + c16 * 4);
#pragma unroll 4
        for (int p = 0; p < 8; ++p) { const int m = p * 32 + w * 4 + rl; const float* kr = Kc + (size_t)m * 1024; float s = 0.f;
#pragma unroll
            for (int i = 0; i < 4; ++i) { const f32x4 kv = *(const f32x4*)(kr + i * 64 + c16 * 4); s += (kv[0] * q4[i][0] + kv[1] * q4[i][1]) + (kv[2] * q4[i][2] + kv[3] * q4[i][3]); }
            s += __shfl_xor(s, 1); s += __shfl_xor(s, 2); s += __shfl_xor(s, 4); s += __shfl_xor(s, 8);
            if (c16 == 0) sc[m] = s; }
    }
    __syncthreads();
    if (t < 256) { float v = sc[t]; float mx = v;
#pragma unroll
        for (int o = 1; o < 64; o <<= 1) mx = fmaxf(mx, __shfl_xor(mx, o));
        if (l == 0) red[w] = mx; }
    __syncthreads();
    const float gmx = fmaxf(fmaxf(red[0], red[1]), fmaxf(red[2], red[3]));
    float pv = 0.f;
    if (t < 256) { pv = __builtin_amdgcn_exp2f(sc[t] - gmx); const float s = wave_sum(pv); if (l == 0) red[8 + w] = s; }
    __syncthreads();
    if (t < 256) sc[t] = pv;
    const float inv = 1.0f / ((red[8] + red[9]) + (red[10] + red[11]));
    __syncthreads();
    {
        f32x4 o = (f32x4){0.f, 0.f, 0.f, 0.f};
#pragma unroll 8
        for (int i = 0; i < 32; ++i) { const int m = w * 32 + i; const f32x4 vv = *(const f32x4*)(Vc + (size_t)m * 1024 + l * 4); o += vv * sc[m]; }
        *(f32x4*)(po + w * 256 + l * 4) = o;
    }
    __syncthreads();
    if (t < 256) { float o = 0.f;
#pragma unroll
        for (int i = 0; i < 8; ++i) o += po[i * 256 + t];
        ((bf16_t*)(ws + WS_O))[(size_t)(NPR + b) * DM + h * 256 + t] = (bf16_t)f2bf(o * inv); }
    __syncthreads();
}

template <int KIND>
__device__ __forceinline__ void sample_gemm(unsigned char* lds, const bf16_t* Asm, int lda, const bf16_t* Bt, int K, int unit, const float* base, float* out, bf16_t* outb, float* ss, float scale) {
    const int t = threadIdx.x, w = t >> 6, l = t & 63, lr = l & 15, lq = l >> 4;
    const int rb = unit & 3, cb = unit >> 2, kw = K >> 3, k0 = w * kw, nks = kw >> 5;
    f32x4 acc[2]; acc[0] = (f32x4){0.f, 0.f, 0.f, 0.f}; acc[1] = acc[0];
    const bf16_t* bp = Bt + (size_t)(cb * 16 + lr) * K + k0 + lq * 8;
    const bf16_t* ap = Asm + (size_t)(rb * 32 + lr) * lda + k0 + lq * 8;
#pragma unroll 2
    for (int ks = 0; ks < nks; ++ks) { const bf16x8 bb = *(const bf16x8*)(bp + ks * 32); const bf16x8 a0 = *(const bf16x8*)(ap + ks * 32), a1 = *(const bf16x8*)(ap + (size_t)16 * lda + ks * 32);
        acc[0] = MFMA16(a0, bb, acc[0]); acc[1] = MFMA16(a1, bb, acc[1]); }
    float* red = (float*)lds;
#pragma unroll
    for (int i = 0; i < 2; ++i)
#pragma unroll
        for (int r = 0; r < 4; ++r) red[(w * 32 + i * 16 + lq * 4 + r) * 16 + lr] = acc[i][r];
    __syncthreads();
    const int row = t >> 4, col = t & 15, grow = rb * 32 + row, gcol = cb * 16 + col;
    float v = 0.f;
#pragma unroll
    for (int i = 0; i < 8; ++i) v += red[(i * 32 + row) * 16 + col];
    if (KIND == 0) { const float val = base[(size_t)grow * DM + gcol] + v; out[(size_t)grow * DM + gcol] = val; if (outb) outb[(size_t)grow * DM + gcol] = (bf16_t)f2bf(val);
        float sq = val * val; sq += __shfl_xor(sq, 1); sq += __shfl_xor(sq, 2); sq += __shfl_xor(sq, 4); sq += __shfl_xor(sq, 8);
        if (col == 0) atomicAdd(ss + grow, sq);
    } else { const float rstd = __builtin_amdgcn_rsqf(ss[grow] * (1.0f / DM) + EPS); outb[(size_t)grow * DM + gcol] = (bf16_t)f2bf(v * rstd * scale); }
    __syncthreads();
}

__device__ __forceinline__ void final_norm(const Args& A, int G) {
    const int lane = threadIdx.x & 63, gw = blockIdx.x * 8 + (threadIdx.x >> 6), NGW = G * 8;
    const float* ss = (const float*)(A.ws + WS_SS3); const f32x4* gr = (const f32x4*)A.in[22] + lane;
    for (int m = gw; m < NVALID; m += NGW) { const float rstd = 1.0f / sqrtf(ss[m] * (1.f / DM) + EPS); f32x4* xr = (f32x4*)(A.out + (size_t)m * DM) + lane;
#pragma unroll
        for (int j = 0; j < 4; ++j) { const f32x4 v = xr[64 * j], gg = gr[64 * j]; xr[64 * j] = v * rstd * gg; } }
}

constexpr int NPHASES = 12;
#ifndef REPMASK
#define REPMASK 0
#endif
#define REPS(k) for (int rep_ = 0; rep_ < 1 + ((REPMASK >> (k)) & 1); ++rep_)
__global__ void __launch_bounds__(NTHREADS, 2) fwd_megakernel(Args args) {
    extern __shared__ __attribute__((aligned(16))) unsigned char lds[];
    cg::grid_group grid = cg::this_grid();
    const int G = gridDim.x, bx = blockIdx.x;
    unsigned char* ws = args.ws;
    PG8_LAS unsigned char* lds3 = (PG8_LAS unsigned char*)lds;
    const int lo = args.ph_lo, hi = args.ph_hi;
#define IN(k) (lo <= (k) && (k) < hi)
#define SEAM(k) do { if (IN(k) && IN((k) + 1)) xcd_barrier(bar); } while (0)
    if (lo < 0) grid.sync();
    volatile LAS unsigned* MISC = (volatile LAS unsigned*)(lds3 + LDS_BYTES - 64);
    if (threadIdx.x < 16) MISC[threadIdx.x] = 0u;
    __syncthreads();
    XcdBarrier bar = xcd_barrier_post((unsigned*)(ws + WS_BAR), MISC);
    if (IN(0)) REPS(0) { p0_prologue(args, lds, G); }
    SEAM(0);
    if (IN(1)) REPS(1) {
        {   pg8::Gemm g{(const bf16_t*)(ws + WS_H0), (const bf16_t*)(ws + WS_WIN), MT, NIN, DM}; pg8::StaticOrder S; S.init(MT, NIN, G, bx);
            pg8::EpiInProj E{(bf16_t*)(ws + WS_QQ), (bf16_t*)(ws + WS_KK), (bf16_t*)(ws + WS_VV), (bf16_t*)(ws + WS_GG), (float*)(ws + WS_LF), (float*)(ws + WS_UU), args.in[9]};
            pg8::gemm_phase<pg8::EpiInProj, pg8::StaticOrder, true, true>(lds3, g, S, E); }
        {   pg8::Gemm g{(const bf16_t*)(ws + WS_MEMH), (const bf16_t*)(ws + WS_WKV), MEMR, 2 * DM, DM}; pg8::StaticOrder S; S.init(MEMR, 2 * DM, G, (bx + G - (650 % G)) % G);
            pg8::EpiMemKV E{args.out + O_MK, args.out + O_MV, (bf16_t*)(ws + WS_KB)};
            pg8::gemm_phase<pg8::EpiMemKV, pg8::StaticOrder, true, true>(lds3, g, S, E); }
        {   pg8::Gemm g{(const bf16_t*)(ws + WS_WKV) + (size_t)DM * DM, (const bf16_t*)(ws + WS_MEMH), DM, MEMR, DM}; pg8::StaticOrder S; S.init(DM, MEMR, G, (bx + 2 * G - ((650 + 64) % G)) % G);
            pg8::EpiBf16Scale E{(bf16_t*)(ws + WS_VT), MEMR, nullptr, 1.0f};
            pg8::gemm_phase<pg8::EpiBf16Scale, pg8::StaticOrder, true, true>(lds3, g, S, E); }
    }
    SEAM(1);
    if (IN(2)) REPS(2) {
        for (int u = bx; u < 512 + 1024; u += G) { if (u < 512) hgrn_sample_unit(args, lds, u); else hgrn_local_unit(args, lds, u - 512); }
    }
    SEAM(2);
    if (IN(3)) { hgrn_scan(args, G); pool_states(args, G); }
    SEAM(3);
    if (IN(4)) REPS(4) {
        for (int u = bx; u < 1024 + 1032; u += G) { if (u < 1024) hgrn_out_unit(args, lds, u); else pool_unit(args, lds, u - 1024); }
    }
    SEAM(4);
    if (IN(5)) {
        pg8::Gemm g{(const bf16_t*)(ws + WS_MIX), (const bf16_t*)(ws + WS_WOUT), NPR, DM, DM}; pg8::StaticOrder S; S.init(NPR, DM, G, bx);
        pg8::EpiResid E{args.in[0], args.in[1], NPR, (float*)(ws + WS_X1), NPR, (bf16_t*)(ws + WS_H0), (float*)(ws + WS_SS1)};
        pg8::gemm_phase<pg8::EpiResid, pg8::StaticOrder, true, true>(lds3, g, S, E);
        for (int u = bx; u < 256; u += G) sample_gemm<0>(lds, (const bf16_t*)(ws + WS_MIX) + (size_t)NPR * DM, DM, (const bf16_t*)(ws + WS_WOUT), DM, u, args.in[1], (float*)(ws + WS_X1) + (size_t)NPR * DM, (bf16_t*)(ws + WS_H0) + (size_t)NPR * DM, (float*)(ws + WS_SS1) + NPR, 1.0f);
    }
    SEAM(5);
    if (IN(6)) REPS(6) {
        pg8::Gemm g{(const bf16_t*)(ws + WS_H0), (const bf16_t*)(ws + WS_WCQ), NPR, DM, DM}; pg8::StaticOrder S; S.init(NPR, DM, G, bx);
        pg8::EpiBf16Scale E{(bf16_t*)(ws + WS_Q), DM, (const float*)(ws + WS_SS1), 0.0625f * 1.4426950408889634f};
        pg8::gemm_phase<pg8::EpiBf16Scale, pg8::StaticOrder, true, true>(lds3, g, S, E);
        for (int u = bx; u < 256; u += G) sample_gemm<1>(lds, (const bf16_t*)(ws + WS_H0) + (size_t)NPR * DM, DM, (const bf16_t*)(ws + WS_WCQ), DM, u, nullptr, nullptr, (bf16_t*)(ws + WS_Q) + (size_t)NPR * DM, (float*)(ws + WS_SS1) + NPR, 0.0625f * 1.4426950408889634f);
    }
    SEAM(6);
    if (IN(7)) REPS(7) {
        for (int u = bx; u < 1024; u += G) { if (u < 512) attn_sample_unit(args, lds, u); else attn_prompt_unit(args, lds, u - 512); }
    }
    SEAM(7);
    if (IN(8)) {
        const float* X1 = (const float*)(ws + WS_X1);
        pg8::Gemm g{(const bf16_t*)(ws + WS_O), (const bf16_t*)(ws + WS_WCO), NPR, DM, DM}; pg8::StaticOrder S; S.init(NPR, DM, G, bx);
        pg8::EpiResid E{X1, X1 + (size_t)NPR * DM, NPR, (float*)(ws + WS_SL), NPR, (bf16_t*)(ws + WS_MIX), (float*)(ws + WS_SS2)};
        pg8::gemm_phase<pg8::EpiResid, pg8::StaticOrder, true, true>(lds3, g, S, E);
        for (int u = bx; u < 256; u += G) sample_gemm<0>(lds, (const bf16_t*)(ws + WS_O) + (size_t)NPR * DM, DM, (const bf16_t*)(ws + WS_WCO), DM, u, X1 + (size_t)NPR * DM, (float*)(ws + WS_SL) + (size_t)NPR * DM, (bf16_t*)(ws + WS_MIX) + (size_t)NPR * DM, (float*)(ws + WS_SS2) + NPR, 1.0f);
    }
    SEAM(8);
    if (IN(9)) REPS(9) {
        pg8::Gemm g{(const bf16_t*)(ws + WS_MIX), (const bf16_t*)(ws + WS_WFFI), MT, NFF2, DM}; pg8::StaticOrder S; S.init(MT, NFF2, G, bx);
        pg8::EpiSwiGLU E{(bf16_t*)(ws + WS_A), (const float*)(ws + WS_SS2)};
        pg8::gemm_phase<pg8::EpiSwiGLU, pg8::StaticOrder, true, true>(lds3, g, S, E);
    }
    SEAM(9);
    if (IN(10)) {
        const float* X2 = (const float*)(ws + WS_SL);
        pg8::Gemm g{(const bf16_t*)(ws + WS_A), (const bf16_t*)(ws + WS_WFFO), NPR, DM, DFF}; pg8::StaticOrder S; S.init(NPR, DM, G, bx);
        pg8::EpiResid E{X2, X2 + (size_t)NPR * DM, NPR, args.out, NPR, nullptr, (float*)(ws + WS_SS3)};
        pg8::gemm_phase<pg8::EpiResid, pg8::StaticOrder, true, true>(lds3, g, S, E);
        for (int u = bx; u < 256; u += G) sample_gemm<0>(lds, (const bf16_t*)(ws + WS_A) + (size_t)NPR * DFF, DFF, (const bf16_t*)(ws + WS_WFFO), DFF, u, X2 + (size_t)NPR * DM, args.out + O_YS, nullptr, (float*)(ws + WS_SS3) + NPR, 1.0f);
    }
    SEAM(10);
#ifdef EXTRA_SYNCS
    for (int i_ = 0; i_ < EXTRA_SYNCS; ++i_) xcd_barrier(bar);
#endif
    if (IN(11)) { final_norm(args, G); }
#undef IN
#undef SEAM
}

#ifndef MK_MULTI
#define MK_MULTI 0
#endif
extern "C" void kernel_launch(void* const* d_in, const int* in_sizes, int n_in, void* d_out, int out_size, void* d_ws, size_t ws_size, hipStream_t stream) {
    static int grid = 0;
    if (grid == 0) {
        if (n_in != 23 || ws_size < WS_END) { fprintf(stderr, "kernel_launch: unexpected n_in %d / ws_size %zu\n", n_in, ws_size); grid = -1; return; }
        int dev = 0, cus = 0, per_cu = 0;
        hipGetDevice(&dev); hipDeviceGetAttribute(&cus, hipDeviceAttributeMultiprocessorCount, dev);
        if (hipFuncSetAttribute((const void*)fwd_megakernel, hipFuncAttributeMaxDynamicSharedMemorySize, LDS_BYTES) != hipSuccess) { fprintf(stderr, "kernel_launch: hipFuncSetAttribute failed\n"); grid = -1; return; }
        hipOccupancyMaxActiveBlocksPerMultiprocessor(&per_cu, (const void*)fwd_megakernel, NTHREADS, LDS_BYTES);
        (void)hipGetLastError();
        if (per_cu < 1) { fprintf(stderr, "kernel_launch: occupancy query says %d blocks/CU\n", per_cu); per_cu = 1; }
        grid = cus;
    }
    if (grid < 0) return;
    Args a{};
    for (int i = 0; i < 23; ++i) a.in[i] = (const float*)d_in[i];
    a.out = (float*)d_out; a.ws = (unsigned char*)d_ws;
#if MK_MULTI
    for (int p = 0; p < NPHASES; ++p) { a.ph_lo = p; a.ph_hi = p + 1; hipLaunchKernelGGL(fwd_megakernel, dim3(grid), dim3(NTHREADS), LDS_BYTES, stream, a); }
#else
    a.ph_lo = 0; a.ph_hi = NPHASES;
    if (hipMemsetAsync((char*)d_ws + WS_BAR, 0, BAR_BYTES, stream) != hipSuccess) { fprintf(stderr, "kernel_launch: memset failed\n"); return; }
    void* kargs[] = {&a};
    hipError_t e = hipLaunchCooperativeKernel((const void*)fwd_megakernel, dim3(grid), dim3(NTHREADS), kargs, LDS_BYTES, stream);
    if (e != hipSuccess) fprintf(stderr, "kernel_launch: cooperative launch failed: %s (grid %d)\n", hipGetErrorString(e), grid);
#endif
}
```

```cpp
#include <hip/hip_runtime.h>
#include <hip/hip_cooperative_groups.h>
#include <cstdio>
#include <cstdint>
namespace cg = cooperative_groups;
namespace pg8 {
#define PG8_LAS __attribute__((address_space(3)))
typedef unsigned short bf16_t;
typedef short bf16x8 __attribute__((ext_vector_type(8)));
typedef float f32x4 __attribute__((ext_vector_type(4)));
typedef unsigned u32x4 __attribute__((ext_vector_type(4)));
constexpr int BM = 256, BK = 64, HALF = 128, HTB = HALF * BK * 2  , STAGE_BYTES = 8 * HTB, NXCD = 8, WGM = 8;

__host__ __device__ __forceinline__ int lds_byte(int r, int c) { const int st = (r >> 4) * 2 + (c >> 5), rr = r & 15, cc = c & 31, ob = rr * 64 + cc * 2; return st * 1024 + (ob ^ (((ob >> 9) & 1) << 5)); }
__host__ __device__ __forceinline__ void stage_rc(int b, int& R, int& C) { const int st = b / 1024, sb = b % 1024, swz = sb ^ (((sb >> 9) & 1) << 5); R = (st >> 1) * 16 + swz / 64; C = (st & 1) * 32 + (swz % 64) / 2; }
__host__ __device__ __forceinline__ int perm32(int rho) { const int n = rho >> 4, i = rho & 15; return 8 * (i >> 2) + 4 * n + (i & 3); }

struct Unit { int pm, pn; };
struct Gemm { const bf16_t* A; const bf16_t* Bt; int M, N, K; };

struct StaticOrder {
    int nM, nN, nwg, G, c;
    __host__ __device__ void init(int M, int N, int G_, int c_) { nM = M / BM; nN = N / BM; nwg = nM * nN; G = G_; c = c_; }
    __host__ __device__ bool next(int i, Unit& u) const {
        const long L = (long)i * G + c; if (L >= nwg) return false;
        int wgid = (int)L; { const int q = nwg / NXCD, r = nwg % NXCD, xcd = wgid % NXCD, off = wgid / NXCD; wgid = (xcd < r ? xcd * (q + 1) : r * (q + 1) + (xcd - r) * q) + off; }
        const int nig = WGM * nN, gid = wgid / nig, fm = gid * WGM, gsz = (nM - fm) < WGM ? (nM - fm) : WGM;
        u.pm = fm + ((wgid % nig) % gsz); u.pn = (wgid % nig) / gsz; return true;
    }
    __device__ __forceinline__ void a_ready(const Unit&) const {}
    __device__ __forceinline__ void done(const Unit&) const {}
};

__device__ __forceinline__ unsigned cvt_pk_bf16(float lo, float hi) { unsigned r; asm volatile("v_cvt_pk_bf16_f32 %0, %1, %2" : "=v"(r) : "v"(lo), "v"(hi)); return r; }
typedef unsigned u32x2 __attribute__((ext_vector_type(2)));
__device__ __forceinline__ float sigm(float z) { return 1.0f / (1.0f + __expf(-z)); }
constexpr float RMS_EPS = 1e-6f;

struct EpiInProj {
    static constexpr bool PERM = true, AFTER_DRAIN = false;
    bf16_t *QQ, *KK, *VV, *GG; float *LF, *UU; const float* lbraw;
    __device__ __forceinline__ void operator()(const f32x4 (&acc)[2][2][4][2], const Unit& u, int wr, int wc, int fr, int fq) const {
        const int seg = u.pn >> 1, colt = (u.pn & 1) * 256;
        const int row0 = u.pm * BM + wr * 64 + fr;
#pragma unroll
        for (int bj = 0; bj < 2; ++bj) {
            const int cs = colt + bj * HALF + wc * 32 + 8 * fq;
            float lb[8];
            if (seg == 1) {
#pragma unroll
                for (int j = 0; j < 8; ++j) { const float l0 = lbraw[cs + j], l1 = lbraw[512 + cs + j]; lb[j] = 1.0f / (1.0f + __expf(l1 - l0)); }
            } else {
#pragma unroll
                for (int j = 0; j < 8; ++j) lb[j] = 0.f;
            }
#pragma unroll
            for (int ai = 0; ai < 2; ++ai)
#pragma unroll
                for (int m = 0; m < 4; ++m) {
                    const size_t off = (size_t)(row0 + ai * HALF + m * 16) * 512 + cs;
                    const f32x4 v0 = acc[ai][bj][m][0], v1 = acc[ai][bj][m][1];
                    float z[8] = {v0[0], v0[1], v0[2], v0[3], v1[0], v1[1], v1[2], v1[3]};
                    if (seg == 0) {
#pragma unroll
                        for (int j = 0; j < 8; ++j) z[j] = z[j] * sigm(z[j]);
                        u32x4 w; w.x = cvt_pk_bf16(z[0], z[1]); w.y = cvt_pk_bf16(z[2], z[3]); w.z = cvt_pk_bf16(z[4], z[5]); w.w = cvt_pk_bf16(z[6], z[7]);
                        *(u32x4*)(QQ + off) = w;
                    } else if (seg == 1) {
                        float lf[8], kk[8];
#pragma unroll
                        for (int j = 0; j < 8; ++j) { const float e = __expf(-z[j]); const float sg = 1.0f / (1.0f + e); const float sgn = e / (1.0f + e);
                            lf[j] = __logf(lb[j] + (1.0f - lb[j]) * sg); kk[j] = (1.0f - lb[j]) * sgn; }
                        *(f32x4*)(LF + off) = (f32x4){lf[0], lf[1], lf[2], lf[3]}; *(f32x4*)(LF + off + 4) = (f32x4){lf[4], lf[5], lf[6], lf[7]};
                        u32x4 w; w.x = cvt_pk_bf16(kk[0], kk[1]); w.y = cvt_pk_bf16(kk[2], kk[3]); w.z = cvt_pk_bf16(kk[4], kk[5]); w.w = cvt_pk_bf16(kk[6], kk[7]);
                        *(u32x4*)(KK + off) = w;
                    } else if (seg == 2) {
                        u32x4 w; w.x = cvt_pk_bf16(z[0], z[1]); w.y = cvt_pk_bf16(z[2], z[3]); w.z = cvt_pk_bf16(z[4], z[5]); w.w = cvt_pk_bf16(z[6], z[7]);
                        *(u32x4*)(VV + off) = w;
                    } else if (seg == 3) {
#pragma unroll
                        for (int j = 0; j < 8; ++j) z[j] = sigm(z[j]);
                        u32x4 w; w.x = cvt_pk_bf16(z[0], z[1]); w.y = cvt_pk_bf16(z[2], z[3]); w.z = cvt_pk_bf16(z[4], z[5]); w.w = cvt_pk_bf16(z[6], z[7]);
                        *(u32x4*)(GG + off) = w;
                    } else {
                        *(f32x4*)(UU + off) = v0; *(f32x4*)(UU + off + 4) = v1;
                    }
                }
        }
    }
};

struct EpiMemKV {
    static constexpr bool PERM = true, AFTER_DRAIN = false;
    float *outK, *outV; bf16_t* KB;
    __device__ __forceinline__ void operator()(const f32x4 (&acc)[2][2][4][2], const Unit& u, int wr, int wc, int fr, int fq) const {
        const bool isk = u.pn < 4; float* o = isk ? outK : outV; const int colt = (u.pn & 3) * 256;
        const int row0 = u.pm * BM + wr * 64 + fr;
#pragma unroll
        for (int ai = 0; ai < 2; ++ai)
#pragma unroll
            for (int m = 0; m < 4; ++m)
#pragma unroll
                for (int bj = 0; bj < 2; ++bj) {
                    const size_t off = (size_t)(row0 + ai * HALF + m * 16) * 1024 + colt + bj * HALF + wc * 32 + 8 * fq;
                    const f32x4 v0 = acc[ai][bj][m][0], v1 = acc[ai][bj][m][1];
                    *(f32x4*)(o + off) = v0; *(f32x4*)(o + off + 4) = v1;
                    if (isk) { u32x4 w; w.x = cvt_pk_bf16(v0[0], v0[1]); w.y = cvt_pk_bf16(v0[2], v0[3]); w.z = cvt_pk_bf16(v1[0], v1[1]); w.w = cvt_pk_bf16(v1[2], v1[3]); *(u32x4*)(KB + off) = w; }
                }
    }
};

struct EpiBf16Scale {
    static constexpr bool PERM = true, AFTER_DRAIN = false;
    bf16_t* O; int ldc; const float* ss; float scale;
    __device__ __forceinline__ void operator()(const f32x4 (&acc)[2][2][4][2], const Unit& u, int wr, int wc, int fr, int fq) const {
        const int row0 = u.pm * BM + wr * 64 + fr;
        float ssv[2][4];
#pragma unroll
        for (int ai = 0; ai < 2; ++ai)
#pragma unroll
            for (int m = 0; m < 4; ++m) ssv[ai][m] = ss ? ss[row0 + ai * HALF + m * 16] : 0.f;
#pragma unroll
        for (int ai = 0; ai < 2; ++ai)
#pragma unroll
            for (int m = 0; m < 4; ++m) {
                const int row = row0 + ai * HALF + m * 16;
                const float sc = ss ? scale * __builtin_amdgcn_rsqf(ssv[ai][m] * (1.0f / 1024.0f) + RMS_EPS) : scale;
#pragma unroll
                for (int bj = 0; bj < 2; ++bj) {
                    const size_t off = (size_t)row * ldc + u.pn * BM + bj * HALF + wc * 32 + 8 * fq;
                    const f32x4 v0 = acc[ai][bj][m][0] * sc, v1 = acc[ai][bj][m][1] * sc;
                    u32x4 w; w.x = cvt_pk_bf16(v0[0], v0[1]); w.y = cvt_pk_bf16(v0[2], v0[3]); w.z = cvt_pk_bf16(v1[0], v1[1]); w.w = cvt_pk_bf16(v1[2], v1[3]);
                    *(u32x4*)(O + off) = w;
                }
            }
    }
};

struct EpiResid {
    static constexpr bool PERM = true, AFTER_DRAIN = false;
    const float* baseP; const float* baseS; int base_rows;
    float* out; int out_rows;
    bf16_t* outb; float* ss;
    __device__ __forceinline__ void operator()(const f32x4 (&acc)[2][2][4][2], const Unit& u, int wr, int wc, int fr, int fq) const {
        const int row0 = u.pm * BM + wr * 64 + fr;
#pragma unroll
        for (int ai = 0; ai < 2; ++ai) {
            f32x4 pre[4][2][2];
#pragma unroll
            for (int m = 0; m < 4; ++m) { const int row = row0 + ai * HALF + m * 16;
                const float* bp = row < 16384 ? baseP + (size_t)row * 1024 : baseS + (size_t)(row - 16384) * 1024; const bool bok = row < base_rows;
#pragma unroll
                for (int bj = 0; bj < 2; ++bj) { const int col = u.pn * BM + bj * HALF + wc * 32 + 8 * fq;
                    pre[m][bj][0] = (f32x4){0.f, 0.f, 0.f, 0.f}; pre[m][bj][1] = pre[m][bj][0];
                    if (bok) { pre[m][bj][0] = *(const f32x4*)(bp + col); pre[m][bj][1] = *(const f32x4*)(bp + col + 4); } } }
#pragma unroll
            for (int m = 0; m < 4; ++m) {
                const int row = row0 + ai * HALF + m * 16; const bool ook = row < out_rows;
                float s = 0.f;
#pragma unroll
                for (int bj = 0; bj < 2; ++bj) {
                    const int col = u.pn * BM + bj * HALF + wc * 32 + 8 * fq;
                    const f32x4 v0 = acc[ai][bj][m][0] + pre[m][bj][0], v1 = acc[ai][bj][m][1] + pre[m][bj][1];
                    s += (v0[0] * v0[0] + v0[1] * v0[1]) + (v0[2] * v0[2] + v0[3] * v0[3]) + (v1[0] * v1[0] + v1[1] * v1[1]) + (v1[2] * v1[2] + v1[3] * v1[3]);
                    if (ook) { *(f32x4*)(out + (size_t)row * 1024 + col) = v0; *(f32x4*)(out + (size_t)row * 1024 + col + 4) = v1; }
                    if (outb) { u32x4 w; w.x = cvt_pk_bf16(v0[0], v0[1]); w.y = cvt_pk_bf16(v0[2], v0[3]); w.z = cvt_pk_bf16(v1[0], v1[1]); w.w = cvt_pk_bf16(v1[2], v1[3]); *(u32x4*)(outb + (size_t)row * 1024 + col) = w; }
                }
                s += __shfl_xor(s, 16); s += __shfl_xor(s, 32);
                if (fq == 0) atomicAdd(ss + row, s);
            }
        }
    }
};

struct EpiSwiGLU {
    static constexpr bool PERM = true, AFTER_DRAIN = false;
    bf16_t* ACT; const float* ss;
    __device__ __forceinline__ void operator()(const f32x4 (&acc)[2][2][4][2], const Unit& u, int wr, int wc, int fr, int fq) const {
        const int row0 = u.pm * BM + wr * 64 + fr;
        float ssv[2][4];
#pragma unroll
        for (int ai = 0; ai < 2; ++ai)
#pragma unroll
            for (int m = 0; m < 4; ++m) ssv[ai][m] = ss[row0 + ai * HALF + m * 16];
#pragma unroll
        for (int ai = 0; ai < 2; ++ai)
#pragma unroll
            for (int m = 0; m < 4; ++m) {
                const int row = row0 + ai * HALF + m * 16;
                const float r = __builtin_amdgcn_rsqf(ssv[ai][m] * (1.0f / 1024.0f) + RMS_EPS);
#pragma unroll
                for (int bj = 0; bj < 2; ++bj) {
                    const int J = u.pn * 128 + bj * 64 + wc * 16 + 4 * fq;
                    const f32x4 a = acc[ai][bj][m][0] * r, b = acc[ai][bj][m][1] * r;
                    float o[4];
#pragma unroll
                    for (int j = 0; j < 4; ++j) o[j] = a[j] * sigm(a[j]) * b[j];
                    u32x2 w; w.x = cvt_pk_bf16(o[0], o[1]); w.y = cvt_pk_bf16(o[2], o[3]);
                    *(u32x2*)(ACT + (size_t)row * 2816 + J) = w;
                }
            }
    }
};

template <class Epi, class Sched, bool ALIGN_EPI = false, bool SP2 = false>
__device__ __forceinline__ void gemm_phase(PG8_LAS unsigned char* lds, const Gemm g, const Sched& S, const Epi& E) {
    const int tid = threadIdx.x, wid = __builtin_amdgcn_readfirstlane(tid >> 6), lane = tid & 63, wr = wid >> 2, wc = wid & 3, fr = lane & 15, fq = lane >> 4;
    const int K = g.K, nt = K / BK;
    unsigned voffA[2], voffB[2];
#pragma unroll
    for (int i = 0; i < 2; ++i) { int R, C; stage_rc(tid * 16 + i * 8192, R, C); const int Rb = Epi::PERM ? ((R & ~31) + perm32(R & 31)) : R;
        voffA[i] = (unsigned)(R * K + C) * 2u; voffB[i] = (unsigned)(Rb * K + C) * 2u; }
    const size_t kstep = (size_t)(BK * 2);
    const size_t hstep = (size_t)HALF * K * 2;
    const size_t tstep = 2 * hstep;
    const unsigned ldsw = (unsigned)wid * 1024u;
    const int aoff = lds_byte(wr * 64 + fr, fq * 8), boff = lds_byte(wc * 32 + fr, fq * 8);
#define PG8_SA(b, h) (((b) * 2 + (h)) * HTB)
#define PG8_SB(b, h) ((4 + (b) * 2 + (h)) * HTB)
#define PG8_STAGE(bufoff, gbase, voff) do { _Pragma("unroll") for (int _i = 0; _i < 2; ++_i) \
        __builtin_amdgcn_global_load_lds((const unsigned*)((const char*)(gbase) + (voff)[_i]), (PG8_LAS unsigned*)(lds + (bufoff) + ldsw + _i * 8192), 16, 0, 0); } while (0)
#define PG8_LDA(dst, b, h) do { _Pragma("unroll") for (int m = 0; m < 4; ++m) _Pragma("unroll") for (int k = 0; k < 2; ++k) dst[m][k] = *(const PG8_LAS bf16x8*)(lds + PG8_SA(b, h) + aoff + m * 2048 + k * 1024); } while (0)
#define PG8_LDB(dst, b, h) do { _Pragma("unroll") for (int n = 0; n < 2; ++n) _Pragma("unroll") for (int k = 0; k < 2; ++k) dst[n][k] = *(const PG8_LAS bf16x8*)(lds + PG8_SB(b, h) + boff + n * 2048 + k * 1024); } while (0)
#define PG8_MMA(ai, bj, At, Bt) do { __builtin_amdgcn_s_setprio(1); _Pragma("unroll") for (int m = 0; m < 4; ++m) _Pragma("unroll") for (int n = 0; n < 2; ++n) _Pragma("unroll") for (int k = 0; k < 2; ++k) \
        acc[ai][bj][m][n] = __builtin_amdgcn_mfma_f32_16x16x32_bf16(Bt[n][k], At[m][k], acc[ai][bj][m][n], 0, 0, 0); __builtin_amdgcn_s_setprio(0); } while (0)
#define PG8_WAIT_V(n) asm volatile("s_waitcnt vmcnt(" #n ")" ::: "memory")
#define PG8_WAIT_L(n) asm volatile("s_waitcnt lgkmcnt(" #n ")" ::: "memory")
#define PG8_BAR __builtin_amdgcn_s_barrier()
#define PG8_SCHED __builtin_amdgcn_sched_barrier(0)
    Unit cur, nxt; int ui = 0;
    if (!S.next(0, cur)) return;
    f32x4 acc[2][2][4][2];
#pragma unroll
    for (int a = 0; a < 2; ++a)
#pragma unroll
        for (int b = 0; b < 2; ++b)
#pragma unroll
            for (int m = 0; m < 4; ++m)
#pragma unroll
                for (int n = 0; n < 2; ++n) acc[a][b][m][n] = (f32x4){0.f, 0.f, 0.f, 0.f};
    bf16x8 At[4][2], B0[2][2], B1[2][2];
    const char* cA = (const char*)g.A + (size_t)cur.pm * tstep; const char* cB = (const char*)g.Bt + (size_t)cur.pn * tstep;
    S.a_ready(cur);
    if constexpr (SP2) {
        PG8_STAGE(PG8_SB(0, 0), cB, voffB); PG8_STAGE(PG8_SB(0, 1), cB + hstep, voffB); PG8_STAGE(PG8_SA(0, 0), cA, voffA); PG8_STAGE(PG8_SA(0, 1), cA + hstep, voffA);
        if (wr == 1) PG8_BAR;
        PG8_WAIT_V(2); PG8_BAR;
        PG8_STAGE(PG8_SB(1, 0), cB + kstep, voffB); PG8_STAGE(PG8_SA(1, 0), cA + kstep, voffA); PG8_STAGE(PG8_SB(1, 1), cB + hstep + kstep, voffB);
        PG8_WAIT_V(6); PG8_BAR;
    } else {
        PG8_STAGE(PG8_SB(0, 0), cB, voffB); PG8_STAGE(PG8_SA(0, 0), cA, voffA); PG8_STAGE(PG8_SB(0, 1), cB + hstep, voffB); PG8_STAGE(PG8_SA(0, 1), cA + hstep, voffA);
        if (wr == 1) PG8_BAR;
        PG8_WAIT_V(4); PG8_BAR;
        PG8_STAGE(PG8_SB(1, 0), cB + kstep, voffB); PG8_STAGE(PG8_SA(1, 0), cA + kstep, voffA); PG8_STAGE(PG8_SB(1, 1), cB + hstep + kstep, voffB);
        PG8_WAIT_V(6); PG8_BAR;
    }
    for (;;) {
        const bool has_next = S.next(ui + 1, nxt);
        const char* nA = has_next ? (const char*)g.A + (size_t)nxt.pm * tstep : cA; const char* nB = has_next ? (const char*)g.Bt + (size_t)nxt.pn * tstep : cB;
        for (int t = 0; t < nt; t += 2) {
            const bool last = (t == nt - 2);
            const char* a1 = cA + (size_t)(t + 1) * kstep;
            const char* a2 = last ? nA : cA + (size_t)(t + 2) * kstep; const char* b2 = last ? nB : cB + (size_t)(t + 2) * kstep;
            const char* a3 = a2 + kstep; const char* b3 = b2 + kstep;
            if (last && has_next) S.a_ready(nxt);
            if constexpr (SP2) {
            PG8_LDB(B0, 0, 0); PG8_LDB(B1, 0, 1); PG8_SCHED; PG8_LDA(At, 0, 0); PG8_STAGE(PG8_SA(1, 1), a1 + hstep, voffA);
            PG8_WAIT_V(8); PG8_WAIT_L(0); PG8_BAR; PG8_MMA(0, 0, At, B0); PG8_MMA(0, 1, At, B1); PG8_BAR; PG8_SCHED;
            PG8_LDA(At, 0, 1); PG8_STAGE(PG8_SB(0, 0), b2, voffB); PG8_STAGE(PG8_SB(0, 1), b2 + hstep, voffB); PG8_STAGE(PG8_SA(0, 0), a2, voffA);
            PG8_WAIT_V(8); PG8_WAIT_L(0); PG8_BAR; PG8_MMA(1, 0, At, B0); PG8_MMA(1, 1, At, B1); PG8_BAR; PG8_SCHED;
            PG8_LDB(B0, 1, 0); PG8_LDB(B1, 1, 1); PG8_SCHED; PG8_LDA(At, 1, 0); PG8_STAGE(PG8_SA(0, 1), a2 + hstep, voffA);
            PG8_WAIT_V(8); PG8_WAIT_L(0); PG8_BAR; PG8_MMA(0, 0, At, B0); PG8_MMA(0, 1, At, B1); PG8_BAR; PG8_SCHED;
            PG8_LDA(At, 1, 1); PG8_STAGE(PG8_SB(1, 0), b3, voffB); PG8_STAGE(PG8_SB(1, 1), b3 + hstep, voffB); PG8_STAGE(PG8_SA(1, 0), a3, voffA);
            PG8_WAIT_V(8); PG8_WAIT_L(0); PG8_BAR; PG8_MMA(1, 0, At, B0); PG8_MMA(1, 1, At, B1); PG8_BAR; PG8_SCHED;
            } else {
            PG8_LDB(B0, 0, 0); PG8_SCHED; PG8_LDA(At, 0, 0); PG8_STAGE(PG8_SA(1, 1), a1 + hstep, voffA);
            PG8_WAIT_L(8); PG8_BAR; PG8_WAIT_L(0); PG8_MMA(0, 0, At, B0); PG8_BAR; PG8_SCHED;
            PG8_LDB(B1, 0, 1); PG8_STAGE(PG8_SB(0, 0), b2, voffB);
            PG8_BAR; PG8_WAIT_L(0); PG8_MMA(0, 1, At, B1); PG8_BAR;
            PG8_LDA(At, 0, 1); PG8_STAGE(PG8_SA(0, 0), a2, voffA);
            PG8_BAR; PG8_WAIT_L(0); PG8_MMA(1, 0, At, B0); PG8_BAR; PG8_SCHED;
            PG8_STAGE(PG8_SB(0, 1), b2 + hstep, voffB);
            PG8_WAIT_V(6); PG8_BAR; PG8_MMA(1, 1, At, B1); PG8_BAR;
            PG8_LDB(B0, 1, 0); PG8_SCHED; PG8_LDA(At, 1, 0); PG8_STAGE(PG8_SA(0, 1), a2 + hstep, voffA);
            PG8_WAIT_L(8); PG8_BAR; PG8_WAIT_L(0); PG8_MMA(0, 0, At, B0); PG8_BAR; PG8_SCHED;
            PG8_LDB(B1, 1, 1); PG8_STAGE(PG8_SB(1, 0), b3, voffB);
            PG8_BAR; PG8_WAIT_L(0); PG8_MMA(0, 1, At, B1); PG8_BAR;
            PG8_LDA(At, 1, 1); PG8_STAGE(PG8_SA(1, 0), a3, voffA);
            PG8_BAR; PG8_WAIT_L(0); PG8_MMA(1, 0, At, B0); PG8_BAR; PG8_SCHED;
            PG8_STAGE(PG8_SB(1, 1), b3 + hstep, voffB);
            PG8_WAIT_V(6); PG8_BAR; PG8_MMA(1, 1, At, B1); PG8_BAR;
            }
        }
        if constexpr (ALIGN_EPI) { if (wr == 0) PG8_BAR; }
        if constexpr (!Epi::AFTER_DRAIN) { E(acc, cur, wr, wc, fr, fq); S.done(cur); }
        if (!has_next) break;
#pragma unroll
        for (int a = 0; a < 2; ++a)
#pragma unroll
            for (int b = 0; b < 2; ++b)
#pragma unroll
                for (int m = 0; m < 4; ++m)
#pragma unroll
                    for (int n = 0; n < 2; ++n) acc[a][b][m][n] = (f32x4){0.f, 0.f, 0.f, 0.f};
        cur = nxt; cA = nA; cB = nB; ++ui;
        if constexpr (ALIGN_EPI) { if (wr == 1) PG8_BAR; }
    }
    PG8_WAIT_V(0);
    if constexpr (!ALIGN_EPI) { if (wr == 0) PG8_BAR; }
    PG8_BAR;
    if constexpr (Epi::AFTER_DRAIN) { E.fused(acc, cur, wr, wc, fr, fq, lds, wid, lane); S.done(cur); }
#undef PG8_SA
#undef PG8_SB
#undef PG8_STAGE
#undef PG8_LDA
#undef PG8_LDB
#undef PG8_MMA
#undef PG8_WAIT_V
#undef PG8_WAIT_L
#undef PG8_BAR
#undef PG8_SCHED
}
}
#define LAS __attribute__((address_space(3)))
#define XB_TMO      128
#define XB_XCNT(j)  (256  + 64 * (j))
#define XB_XSUB(j)  (1280 + 64 * (j))
#define XB_XGEN(j)  (2304 + 64 * (j))
#define XB_TOP      3328
#define XB_TOPGEN   3392
#define XCD_BAR_WORDS 3456
#define XB_SPIN_CAP (1u << 18)

__device__ __forceinline__ unsigned xb_ld(unsigned* p)              { return __hip_atomic_load(p, __ATOMIC_RELAXED, __HIP_MEMORY_SCOPE_AGENT); }
__device__ __forceinline__ unsigned xb_add(unsigned* p, unsigned v) { return __hip_atomic_fetch_add(p, v, __ATOMIC_RELAXED, __HIP_MEMORY_SCOPE_AGENT); }
__device__ __forceinline__ unsigned xb_xcc_id() { return (unsigned)__builtin_amdgcn_s_getreg((3 << 11) | 20) & 0xFu; }
#define XB_SPIN(cond, bar) do { unsigned _sp = 0; while (cond) { __builtin_amdgcn_s_sleep(1); \
    if ((++_sp & 255u) == 0u) { if (xb_ld(&(bar)[XB_TMO])) break; if (_sp > XB_SPIN_CAP) { atomicAdd(&(bar)[XB_TMO], 1u); break; } } } } while (0)

struct XcdBarrier {
    unsigned* bar; unsigned x;
    volatile LAS unsigned* st;
};

__device__ __forceinline__ XcdBarrier xcd_barrier_post(unsigned* bar, volatile LAS unsigned* st) {
    XcdBarrier b; b.bar = bar; b.x = xb_xcc_id(); b.st = st;
    if (threadIdx.x == 0) (void)xb_add(&bar[XB_XCNT(b.x)], 1u);
    return b;
}
__device__ __forceinline__ void xcd_barrier_complete(unsigned* bar, unsigned x, unsigned& nloc, unsigned& nx) {
    const unsigned G = gridDim.x * gridDim.y * gridDim.z;
    unsigned sum, cnt, mine, sp = 0u;
    for (;;) {
        sum = 0u; cnt = 0u; mine = 0u;
#pragma unroll
        for (unsigned j = 0; j < 16; ++j) { const unsigned c = xb_ld(&bar[XB_XCNT(j)]); sum += c; cnt += (c > 0u) ? 1u : 0u; mine = (j == x) ? c : mine; }
        if (sum == G) break;
        __builtin_amdgcn_s_sleep(1);
        if ((++sp & 255u) == 0u) { if (xb_ld(&bar[XB_TMO])) break; if (sp > XB_SPIN_CAP) { atomicAdd(&bar[XB_TMO], 1u); break; } }
    }
    nloc = mine > 0u ? mine : 1u; nx = cnt > 0u ? cnt : 1u;
}

__device__ __forceinline__ void xcd_barrier(const XcdBarrier& b) {
    asm volatile("s_waitcnt vmcnt(0)" ::: "memory");
    __syncthreads();
    if (threadIdx.x == 0) {
        unsigned* bar = b.bar;
        __builtin_amdgcn_s_waitcnt(0);
        unsigned nloc = b.st[0], nx = b.st[1];
        if (nloc == 0u) { xcd_barrier_complete(bar, b.x, nloc, nx); b.st[0] = nloc; b.st[1] = nx; }
        const unsigned old = xb_add(&bar[XB_XSUB(b.x)], 1u);
        const unsigned gen = old / nloc;
        if (old + 1u == (gen + 1u) * nloc) {
            __builtin_amdgcn_fence(__ATOMIC_RELEASE, "agent");
            asm volatile("s_waitcnt vmcnt(0)" ::: "memory");
            const unsigned og = xb_add(&bar[XB_TOP], 1u);
            const unsigned tg = og / nx;
            if (og + 1u == (tg + 1u) * nx) xb_add(&bar[XB_TOPGEN], 1u);
            else XB_SPIN(xb_ld(&bar[XB_TOPGEN]) == tg, bar);
            __builtin_amdgcn_fence(__ATOMIC_ACQUIRE, "agent");
            xb_add(&bar[XB_XGEN(b.x)], 1u);
            asm volatile("s_waitcnt vmcnt(0)" ::: "memory");
        } else {
            XB_SPIN(xb_ld(&bar[XB_XGEN(b.x)]) == gen, bar);
            __builtin_amdgcn_fence(__ATOMIC_ACQUIRE, "agent");
            asm volatile("s_waitcnt vmcnt(0)" ::: "memory");
        }
    }
    __syncthreads();
}

using pg8::bf16_t; using pg8::f32x4; using pg8::u32x4; using pg8::bf16x8;
typedef unsigned u32x2v __attribute__((ext_vector_type(2)));
constexpr int DM = 1024, NPR = 16384, NSM = 128, MT = 16640, NVALID = 16512, SEQ = 2048;
constexpr int HW = 512, NIN = 2560, DFF = 2816, NFF2 = 5632, MEMR = 2048;
constexpr float EPS = 1e-6f;
constexpr int NTHREADS = 512;
constexpr int LDS_BYTES = 147456;

constexpr size_t O_YP = 0, O_YS = 16777216, O_HP = 16908288, O_PP = 17432576, O_MK = 17494016, O_MV = 19591168, O_HS = 21688320, O_PS = 30076928;

constexpr size_t MiB = 1u << 20;
constexpr size_t WS_SS1 = 0, WS_SS2 = 128 * 1024, WS_SS3 = 256 * 1024, WS_BAR = 512 * 1024, BAR_BYTES = 16384;
constexpr size_t WS_WIN = 1 * MiB, WS_WOUT = 6 * MiB, WS_WCQ = 8 * MiB, WS_WCO = 10 * MiB, WS_WFFI = 12 * MiB, WS_WFFO = 23 * MiB, WS_WKV = 29 * MiB, WS_PMIX = 33 * MiB;
constexpr size_t WS_MEMH = 34 * MiB, WS_KB = 38 * MiB, WS_VT = 42 * MiB, WS_DEC = 46 * MiB;
constexpr size_t WS_H0 = 47 * MiB;
constexpr size_t WS_MIX = 80 * MiB;
constexpr size_t WS_X1 = 113 * MiB;
constexpr size_t WS_Q = 178 * MiB;
constexpr size_t WS_O = 211 * MiB;
constexpr size_t WS_SL = 244 * MiB;
constexpr size_t WS_A = 309 * MiB;
constexpr size_t WS_QQ = WS_A, WS_KK = WS_A + 17 * MiB, WS_VV = WS_A + 34 * MiB, WS_GG = WS_A + 51 * MiB, WS_LF = WS_A + 68 * MiB, WS_UU = WS_A + 101 * MiB;
constexpr size_t WS_END = 443 * MiB;

struct Args { const float* in[23]; float* out; unsigned char* ws; int ph_lo, ph_hi; };

__device__ __forceinline__ unsigned f2bf(float f) { unsigned u = __builtin_bit_cast(unsigned, f); return (u + 0x7fffu + ((u >> 16) & 1u)) >> 16; }
__device__ __forceinline__ unsigned pk2(float lo, float hi) { return f2bf(lo) | (f2bf(hi) << 16); }
__device__ __forceinline__ float bf2f(unsigned h) { return __uint_as_float(h << 16); }
__device__ __forceinline__ float bfe(const u32x4& v, int j) { const unsigned w = v[j >> 1]; return (j & 1) ? __uint_as_float(w & 0xffff0000u) : __uint_as_float(w << 16); }
__device__ __forceinline__ unsigned short bfr(const u32x4& v, int j) { const unsigned w = v[j >> 1]; return (unsigned short)((j & 1) ? (w >> 16) : (w & 0xffffu)); }
__device__ __forceinline__ float wave_sum(float v) {
#pragma unroll
    for (int o = 1; o < 64; o <<= 1) v += __shfl_xor(v, o);
    return v;
}
#define MFMA16(a, b, c) __builtin_amdgcn_mfma_f32_16x16x32_bf16((a), (b), (c), 0, 0, 0)

template <int MODE>
__device__ __forceinline__ void tr_item(const float* W, int K, int N, bf16_t* WT, const float* gk, float* scr, int item, int lane) {
    const int nblk = N / 32, kb = item / nblk, nb = item % nblk, k0 = 64 * kb, n0 = 32 * nb;
    float wv[32];
#pragma unroll
    for (int i = 0; i < 32; ++i) { const int kk = 2 * i + (lane >> 5); wv[i] = W[(size_t)(k0 + kk) * N + n0 + (lane & 31)]; }
#pragma unroll
    for (int i = 0; i < 32; ++i) { const int kk = 2 * i + (lane >> 5); scr[kk * 33 + (lane & 31)] = wv[i]; }
    asm volatile("s_waitcnt lgkmcnt(0)" ::: "memory");
    const int c = lane & 7;
    float g8[8];
#pragma unroll
    for (int i = 0; i < 8; ++i) g8[i] = gk ? gk[k0 + 8 * c + i] : 1.0f;
#pragma unroll
    for (int j = 0; j < 4; ++j) { const int n = (lane >> 3) + 8 * j; const float* s = scr + (8 * c) * 33 + n;
        u32x4 o; o.x = pk2(s[0 * 33] * g8[0], s[1 * 33] * g8[1]); o.y = pk2(s[2 * 33] * g8[2], s[3 * 33] * g8[3]); o.z = pk2(s[4 * 33] * g8[4], s[5 * 33] * g8[5]); o.w = pk2(s[6 * 33] * g8[6], s[7 * 33] * g8[7]);
        int row = n0 + n;
        if (MODE == 1) { const int half = row >= DFF ? 1 : 0; const int J = row - half * DFF;
            row = 256 * (J >> 7) + 128 * ((J >> 6) & 1) + 32 * ((J >> 4) & 3) + 8 * ((J >> 2) & 3) + 4 * half + (J & 3); }
        *(u32x4*)(WT + (size_t)row * K + k0 + 8 * c) = o; }
    asm volatile("s_waitcnt lgkmcnt(0)" ::: "memory");
}
__device__ __forceinline__ void rms_row_to_bf16(const float* xrow, const float* g, bf16_t* orow, int lane) {
    const f32x4* xr = (const f32x4*)xrow + lane; const f32x4* gr = (const f32x4*)g + lane;
    f32x4 v[4]; float s = 0.f;
#pragma unroll
    for (int j = 0; j < 4; ++j) { v[j] = xr[64 * j]; s += (v[j].x * v[j].x + v[j].y * v[j].y) + (v[j].z * v[j].z + v[j].w * v[j].w); }
    const float rstd = 1.0f / sqrtf(wave_sum(s) * (1.f / DM) + EPS);
    unsigned long long* o8 = (unsigned long long*)orow + lane;
#pragma unroll
    for (int j = 0; j < 4; ++j) { const f32x4 gg = gr[64 * j];
        o8[64 * j] = (unsigned long long)pk2(v[j].x * rstd * gg.x, v[j].y * rstd * gg.y) | ((unsigned long long)pk2(v[j].z * rstd * gg.z, v[j].w * rstd * gg.w) << 32); }
}
__device__ __forceinline__ void rms_row2_to_bf16(const float* xrow, const float* g, bf16_t* orow, int lane) {
    const f32x4* xr = (const f32x4*)xrow + lane; const f32x4* gr = (const f32x4*)g + lane;
    f32x4 v[2][4]; float s[2] = {0.f, 0.f};
#pragma unroll
    for (int r = 0; r < 2; ++r)
#pragma unroll
        for (int j = 0; j < 4; ++j) v[r][j] = xr[r * 256 + 64 * j];
#pragma unroll
    for (int r = 0; r < 2; ++r)
#pragma unroll
        for (int j = 0; j < 4; ++j) s[r] += (v[r][j].x * v[r][j].x + v[r][j].y * v[r][j].y) + (v[r][j].z * v[r][j].z + v[r][j].w * v[r][j].w);
#pragma unroll
    for (int r = 0; r < 2; ++r) { const float rstd = 1.0f / sqrtf(wave_sum(s[r]) * (1.f / DM) + EPS); unsigned long long* o8 = (unsigned long long*)(orow + (size_t)r * DM) + lane;
#pragma unroll
        for (int j = 0; j < 4; ++j) { const f32x4 gg = gr[64 * j];
            o8[64 * j] = (unsigned long long)pk2(v[r][j].x * rstd * gg.x, v[r][j].y * rstd * gg.y) | ((unsigned long long)pk2(v[r][j].z * rstd * gg.z, v[r][j].w * rstd * gg.w) << 32); } }
}
__device__ __forceinline__ void p0_prologue(const Args& A, unsigned char* lds, int G) {
    const int tid = threadIdx.x, lane = tid & 63, wave = tid >> 6;
    float* scr = (float*)(lds + wave * 16384);
    unsigned char* ws = A.ws;
    const int gw = blockIdx.x * 8 + wave, NGW = G * 8;
    constexpr int I_IN = 16 * 80, I_OUT = 16 * 32, I_CQ = 16 * 32, I_CO = 16 * 32, I_FFI = 16 * 176, I_FFO = 44 * 32, I_KV = 16 * 64, I_PM = 4 * 8;
    constexpr int NITEMS = I_IN + I_OUT + I_CQ + I_CO + I_FFI + I_FFO + I_KV + I_PM;
    for (int it = gw; it < NITEMS; it += NGW) {
        int r = it;
        if (r < I_IN) { tr_item<0>(A.in[8], DM, NIN, (bf16_t*)(ws + WS_WIN), nullptr, scr, r, lane); continue; } r -= I_IN;
        if (r < I_OUT) { tr_item<0>(A.in[13], DM, DM, (bf16_t*)(ws + WS_WOUT), nullptr, scr, r, lane); continue; } r -= I_OUT;
        if (r < I_CQ) { tr_item<0>(A.in[17], DM, DM, (bf16_t*)(ws + WS_WCQ), A.in[16], scr, r, lane); continue; } r -= I_CQ;
        if (r < I_CO) { tr_item<0>(A.in[18], DM, DM, (bf16_t*)(ws + WS_WCO), nullptr, scr, r, lane); continue; } r -= I_CO;
        if (r < I_FFI) { tr_item<1>(A.in[20], DM, NFF2, (bf16_t*)(ws + WS_WFFI), A.in[19], scr, r, lane); continue; } r -= I_FFI;
        if (r < I_FFO) { tr_item<0>(A.in[21], DFF, DM, (bf16_t*)(ws + WS_WFFO), nullptr, scr, r, lane); continue; } r -= I_FFO;
        if (r < I_KV) { tr_item<0>(A.in[15], DM, 2 * DM, (bf16_t*)(ws + WS_WKV), nullptr, scr, r, lane); continue; } r -= I_KV;
        { const int g = r >> 3; tr_item<0>(A.in[11] + (size_t)g * 128 * 128, 128, 128, (bf16_t*)(ws + WS_PMIX) + (size_t)g * 128 * 128, nullptr, scr, r & 7, lane); }
    }
    bf16_t* H0 = (bf16_t*)(ws + WS_H0);
    for (int m = gw * 2; m < NVALID; m += NGW * 2) { const float* xr = m < NPR ? A.in[0] + (size_t)m * DM : A.in[1] + (size_t)(m - NPR) * DM; rms_row2_to_bf16(xr, A.in[7], H0 + (size_t)m * DM, lane); }
    bf16_t* MEMH = (bf16_t*)(ws + WS_MEMH);
    for (int m = gw; m < MEMR; m += NGW) rms_row_to_bf16(A.in[2] + (size_t)m * DM, A.in[14], MEMH + (size_t)m * DM, lane);
    const int gt = blockIdx.x * NTHREADS + tid, NGT = G * NTHREADS;
    for (int i = gt; i < (MT - NVALID) * DM / 8; i += NGT) { const u32x4 z = {0u, 0u, 0u, 0u};
        ((u32x4*)(ws + WS_H0) + (size_t)NVALID * DM / 8)[i] = z; ((u32x4*)(ws + WS_MIX) + (size_t)NVALID * DM / 8)[i] = z; ((u32x4*)(ws + WS_O) + (size_t)NVALID * DM / 8)[i] = z; }
    for (int i = gt; i < MT; i += NGT) { ((float*)(ws + WS_SS1))[i] = 0.f; ((float*)(ws + WS_SS2))[i] = 0.f; ((float*)(ws + WS_SS3))[i] = 0.f; }
}

constexpr int BS = 129;
constexpr int L_BC = 0, L_TOT = 33024, L_QM = 35072, L_KM = 52480, L_VT = 69888, L_SP = 88320, L_AL = 123136, L_PART = 132352, L_EM = 132864;
constexpr size_t WS_SPT = WS_X1;
__device__ __forceinline__ void hgrn_lf_load(f32x4 (&lf)[4], const float* LF, int R0, int C0, int t) {
#pragma unroll
    for (int i = 0; i < 4; ++i) { const int idx = i * 512 + t, s = idx >> 5, k4 = idx & 31; lf[i] = *(const f32x4*)(LF + (size_t)(R0 + s) * HW + C0 + k4 * 4); }
}
__device__ __forceinline__ void hgrn_cumsum(const f32x4 (&lf)[4], float* Bc, float* tot, int t) {
#pragma unroll
    for (int i = 0; i < 4; ++i) { const int idx = i * 512 + t, s = idx >> 5, k4 = idx & 31; const f32x4 v = lf[i];
        float* d = Bc + s * BS + k4 * 4; d[0] = v[0]; d[1] = v[1]; d[2] = v[2]; d[3] = v[3]; }
    __syncthreads();
    const int seg = t >> 7, k = t & 127; float run = 0.f;
#pragma unroll
    for (int i = 0; i < 16; ++i) { run += Bc[(seg * 16 + i) * BS + k]; Bc[(seg * 16 + i) * BS + k] = run; }
    tot[seg * 128 + k] = run;
    __syncthreads();
    float off = 0.f;
#pragma unroll
    for (int j = 0; j < 3; ++j) off += (j < seg) ? tot[j * 128 + k] : 0.f;
#pragma unroll
    for (int i = 0; i < 16; ++i) Bc[(seg * 16 + i) * BS + k] += off;
    __syncthreads();
}
__device__ __forceinline__ void hgrn_local_unit(const Args& A, unsigned char* lds, int unit) {
    const int t = threadIdx.x, w = t >> 6, l = t & 63, lr = l & 15, lq = l >> 4;
    const int bh = unit >> 5, c = unit & 31, b = bh >> 2, h = bh & 3, R0 = b * SEQ + c * 64, C0 = h * 128;
    unsigned char* ws = A.ws;
    float* Bc = (float*)(lds + L_BC); float* tot = (float*)(lds + L_TOT);
    bf16_t* kdT = (bf16_t*)(lds + L_QM); bf16_t* vT = (bf16_t*)(lds + L_VT);
    const bf16_t* KK = (const bf16_t*)(ws + WS_KK); const bf16_t* VV = (const bf16_t*)(ws + WS_VV);
    f32x4 lf[4]; u32x4 kkr[2], vvr[2];
    hgrn_lf_load(lf, (const float*)(ws + WS_LF), R0, C0, t);
#pragma unroll
    for (int i = 0; i < 2; ++i) { const int k0 = (w + 8 * i) * 8; kkr[i] = *(const u32x4*)(KK + (size_t)(R0 + l) * HW + C0 + k0); vvr[i] = *(const u32x4*)(VV + (size_t)(R0 + l) * HW + C0 + k0); }
    hgrn_cumsum(lf, Bc, tot, t);
#pragma unroll
    for (int i = 0; i < 2; ++i) { const int s = l, k0 = (w + 8 * i) * 8;
        const u32x4 kk = kkr[i], vv = vvr[i];
#pragma unroll
        for (int j = 0; j < 8; ++j) { const float e = __expf(Bc[63 * BS + k0 + j] - Bc[s * BS + k0 + j]);
            kdT[(k0 + j) * 72 + s] = (bf16_t)f2bf(bfe(kk, j) * e); vT[(k0 + j) * 72 + s] = bfr(vv, j); } }
    __syncthreads();
    f32x4 acc[8];
#pragma unroll
    for (int i = 0; i < 8; ++i) acc[i] = (f32x4){0.f, 0.f, 0.f, 0.f};
#pragma unroll
    for (int ks = 0; ks < 2; ++ks) { const bf16x8 a = *(const bf16x8*)(kdT + (16 * w + lr) * 72 + ks * 32 + lq * 8);
#pragma unroll
        for (int vt = 0; vt < 8; ++vt) { const bf16x8 bb = *(const bf16x8*)(vT + (16 * vt + lr) * 72 + ks * 32 + lq * 8); acc[vt] = MFMA16(a, bb, acc[vt]); } }
    float* SLT = (float*)(ws + WS_SL) + (size_t)unit * 16384;
#pragma unroll
    for (int vt = 0; vt < 8; ++vt) *(f32x4*)(SLT + (16 * vt + lr) * 128 + 16 * w + lq * 4) = acc[vt];
    if (t < 128) ((float*)(ws + WS_DEC))[unit * 128 + t] = __expf(Bc[63 * BS + t]);
    __syncthreads();
}
__device__ __forceinline__ void hgrn_out_unit(const Args& A, unsigned char* lds, int unit) {
    const int t = threadIdx.x, w = t >> 6, l = t & 63, lr = l & 15, lq = l >> 4;
    const int bh = unit >> 5, c = unit & 31, b = bh >> 2, h = bh & 3, R0 = b * SEQ + c * 64, C0 = h * 128;
    unsigned char* ws = A.ws;
    float* Bc = (float*)(lds + L_BC); float* tot = (float*)(lds + L_TOT); float* part = (float*)(lds + L_PART); float* em = (float*)(lds + L_EM);
    bf16_t* qm = (bf16_t*)(lds + L_QM); bf16_t* km = (bf16_t*)(lds + L_KM); bf16_t* vT = (bf16_t*)(lds + L_VT); bf16_t* spT = (bf16_t*)(lds + L_SP); bf16_t* aL = (bf16_t*)(lds + L_AL);
    const bf16_t* QQ = (const bf16_t*)(ws + WS_QQ); const bf16_t* KK = (const bf16_t*)(ws + WS_KK); const bf16_t* VV = (const bf16_t*)(ws + WS_VV);
    f32x4 lf[4]; u32x4 qqr[2], kkr[2], vvr[2], spr[4], ggr[2];
    hgrn_lf_load(lf, (const float*)(ws + WS_LF), R0, C0, t);
#pragma unroll
    for (int i = 0; i < 2; ++i) { const int idx = (i * 512 + t) * 8, s = idx >> 7, k0 = idx & 127; const size_t go = (size_t)(R0 + s) * HW + C0 + k0; qqr[i] = *(const u32x4*)(QQ + go); kkr[i] = *(const u32x4*)(KK + go);
        vvr[i] = *(const u32x4*)(VV + (size_t)(R0 + l) * HW + C0 + (w + 8 * i) * 8); }
    {   const bf16_t* SPT = (const bf16_t*)(ws + WS_SPT) + (size_t)unit * 16384;
#pragma unroll
        for (int i = 0; i < 4; ++i) { const int idx = i * 512 + t; spr[i] = *(const u32x4*)(SPT + (idx >> 4) * 128 + (idx & 15) * 8); }
#pragma unroll
        for (int hh = 0; hh < 2; ++hh) ggr[hh] = *(const u32x4*)((const bf16_t*)(ws + WS_GG) + (size_t)(R0 + (t >> 3)) * HW + C0 + (t & 7) * 16 + hh * 8); }
    hgrn_cumsum(lf, Bc, tot, t);
    if (t < 128) em[t] = __expf(Bc[31 * BS + t]);
#pragma unroll
    for (int i = 0; i < 2; ++i) { const int idx = (i * 512 + t) * 8, s = idx >> 7, k0 = idx & 127;
        const u32x4 qq = qqr[i], kk = kkr[i];
        float qv[8], kv[8];
#pragma unroll
        for (int j = 0; j < 8; ++j) { const float d = Bc[s * BS + k0 + j] - Bc[31 * BS + k0 + j]; qv[j] = bfe(qq, j) * __expf(d); kv[j] = bfe(kk, j) * __expf(-d); }
        u32x4 o; o.x = pk2(qv[0], qv[1]); o.y = pk2(qv[2], qv[3]); o.z = pk2(qv[4], qv[5]); o.w = pk2(qv[6], qv[7]); *(u32x4*)(qm + s * 136 + k0) = o;
        o.x = pk2(kv[0], kv[1]); o.y = pk2(kv[2], kv[3]); o.z = pk2(kv[4], kv[5]); o.w = pk2(kv[6], kv[7]); *(u32x4*)(km + s * 136 + k0) = o; }
#pragma unroll
    for (int i = 0; i < 2; ++i) { const int s = l, k0 = (w + 8 * i) * 8; const u32x4 vv = vvr[i];
#pragma unroll
        for (int j = 0; j < 8; ++j) vT[(k0 + j) * 72 + s] = bfr(vv, j); }
    __syncthreads();
    {
#pragma unroll
        for (int i = 0; i < 4; ++i) { const int idx = i * 512 + t, v = idx >> 4, k0 = (idx & 15) * 8; const u32x4 sv = spr[i];
            u32x4 o; o.x = pk2(bfe(sv, 0) * em[k0], bfe(sv, 1) * em[k0 + 1]); o.y = pk2(bfe(sv, 2) * em[k0 + 2], bfe(sv, 3) * em[k0 + 3]); o.z = pk2(bfe(sv, 4) * em[k0 + 4], bfe(sv, 5) * em[k0 + 5]); o.w = pk2(bfe(sv, 6) * em[k0 + 6], bfe(sv, 7) * em[k0 + 7]);
            *(u32x4*)(spT + v * 136 + k0) = o; } }
    {
        const int ct = w & 3;
        f32x4 a2[2]; a2[0] = (f32x4){0.f, 0.f, 0.f, 0.f}; a2[1] = a2[0];
#pragma unroll
        for (int ks = 0; ks < 4; ++ks) { const bf16x8 a = *(const bf16x8*)(qm + (16 * ct + lr) * 136 + ks * 32 + lq * 8);
#pragma unroll
            for (int i = 0; i < 2; ++i) { const int st = (w >> 2) * 2 + i; const bf16x8 bb = *(const bf16x8*)(km + (16 * st + lr) * 136 + ks * 32 + lq * 8); a2[i] = MFMA16(a, bb, a2[i]); } }
#pragma unroll
        for (int i = 0; i < 2; ++i) { const int st = (w >> 2) * 2 + i, s = 16 * st + lr;
#pragma unroll
            for (int r = 0; r < 4; ++r) { const int cc = 16 * ct + lq * 4 + r; aL[cc * 72 + s] = (bf16_t)f2bf(s <= cc ? a2[i][r] : 0.f); } }
    }
    __syncthreads();
    const int ct = w & 3, vh = w >> 2;
    f32x4 o4[4];
#pragma unroll
    for (int i = 0; i < 4; ++i) o4[i] = (f32x4){0.f, 0.f, 0.f, 0.f};
#pragma unroll
    for (int ks = 0; ks < 4; ++ks) { const bf16x8 a = *(const bf16x8*)(qm + (16 * ct + lr) * 136 + ks * 32 + lq * 8);
#pragma unroll
        for (int i = 0; i < 4; ++i) { const int vt = vh * 4 + i; const bf16x8 bb = *(const bf16x8*)(spT + (16 * vt + lr) * 136 + ks * 32 + lq * 8); o4[i] = MFMA16(a, bb, o4[i]); } }
#pragma unroll
    for (int ks = 0; ks < 2; ++ks) { const bf16x8 a = *(const bf16x8*)(aL + (16 * ct + lr) * 72 + ks * 32 + lq * 8);
#pragma unroll
        for (int i = 0; i < 4; ++i) { const int vt = vh * 4 + i; const bf16x8 bb = *(const bf16x8*)(vT + (16 * vt + lr) * 72 + ks * 32 + lq * 8); o4[i] = MFMA16(a, bb, o4[i]); } }
    float* ost = (float*)(lds + L_BC);
#pragma unroll
    for (int r = 0; r < 4; ++r) { float s = 0.f;
#pragma unroll
        for (int i = 0; i < 4; ++i) { s += o4[i][r] * o4[i][r]; ost[(16 * ct + lq * 4 + r) * 132 + (vh * 4 + i) * 16 + lr] = o4[i][r]; }
        s += __shfl_xor(s, 1); s += __shfl_xor(s, 2); s += __shfl_xor(s, 4); s += __shfl_xor(s, 8);
        if (lr == 0) part[vh * 64 + 16 * ct + lq * 4 + r] = s; }
    __syncthreads();
    {   const float* hn = A.in[10]; bf16_t* MIX = (bf16_t*)(ws + WS_MIX);
        const int cc = t >> 3, v0 = (t & 7) * 16; const float rstd = __builtin_amdgcn_rsqf((part[cc] + part[64 + cc]) * (1.0f / 128.0f) + EPS);
#pragma unroll
        for (int hh = 0; hh < 2; ++hh) { const int v = v0 + hh * 8; const u32x4 g8 = ggr[hh];
            const f32x4 oa = *(const f32x4*)(ost + cc * 132 + v), ob = *(const f32x4*)(ost + cc * 132 + v + 4), na = *(const f32x4*)(hn + C0 + v), nb = *(const f32x4*)(hn + C0 + v + 4);
            u32x4 o; o.x = pk2(oa[0] * rstd * na[0] * bfe(g8, 0), oa[1] * rstd * na[1] * bfe(g8, 1)); o.y = pk2(oa[2] * rstd * na[2] * bfe(g8, 2), oa[3] * rstd * na[3] * bfe(g8, 3));
            o.z = pk2(ob[0] * rstd * nb[0] * bfe(g8, 4), ob[1] * rstd * nb[1] * bfe(g8, 5)); o.w = pk2(ob[2] * rstd * nb[2] * bfe(g8, 6), ob[3] * rstd * nb[3] * bfe(g8, 7));
            *(u32x4*)(MIX + (size_t)(R0 + cc) * DM + C0 + v) = o; } }
    __syncthreads();
}
__device__ __forceinline__ void hgrn_scan(const Args& A, int G) {
    const f32x4* SLT = (const f32x4*)(A.ws + WS_SL); const f32x4* DEC4 = (const f32x4*)(A.ws + WS_DEC); u32x2v* SPT = (u32x2v*)(A.ws + WS_SPT); float* outp = A.out + O_HP;
    for (int e = blockIdx.x * NTHREADS + threadIdx.x; e < 32 * 4096; e += G * NTHREADS) { const int bh = e >> 12, i4 = e & 4095, v = i4 >> 5, k4 = i4 & 31;
        f32x4 S = (f32x4){0.f, 0.f, 0.f, 0.f};
        const f32x4* p = SLT + (size_t)bh * 32 * 4096 + i4; u32x2v* q = SPT + (size_t)bh * 32 * 4096 + i4; const f32x4* dp = DEC4 + (size_t)bh * 32 * 32 + k4;
#pragma unroll
        for (int hf = 0; hf < 2; ++hf) { f32x4 loc[16], dd[16];
#pragma unroll
            for (int c = 0; c < 16; ++c) { loc[c] = p[(size_t)(hf * 16 + c) * 4096]; dd[c] = dp[(hf * 16 + c) * 32]; }
#pragma unroll
            for (int c = 0; c < 16; ++c) { u32x2v o; o.x = pk2(S[0], S[1]); o.y = pk2(S[2], S[3]); q[(size_t)(hf * 16 + c) * 4096] = o; S = S * dd[c] + loc[c]; } }
        float* ob = outp + (size_t)bh * 16384 + (k4 * 4) * 128 + v; ob[0] = S[0]; ob[128] = S[1]; ob[256] = S[2]; ob[384] = S[3]; }
}
__device__ __forceinline__ void pool_states(const Args& A, int G) {
    const float* UU = (const float*)(A.ws + WS_UU);
    const int gt = blockIdx.x * NTHREADS + threadIdx.x, NGT = G * NTHREADS;
    for (int i = gt; i < 8 * 15 * 512; i += NGT) { const int cch = i & 511, j = (i >> 9) % 15, b = i / (15 * 512); A.out[O_PP + i] = UU[(size_t)(b * SEQ + 2033 + j) * HW + cch]; }
    for (int i = gt; i < 128 * 15 * 512; i += NGT) { const int cch = i & 511, j = (i >> 9) % 15, b = i / (15 * 512);
        A.out[O_PS + i] = (j < 14) ? A.in[4][(size_t)(b * 15 + j + 1) * 512 + cch] : UU[(size_t)(NPR + b) * HW + cch]; }
}
__device__ __forceinline__ void hgrn_sample_unit(const Args& A, unsigned char* lds, int unit) {
    const int t = threadIdx.x, b = unit >> 2, h = unit & 3, row = NPR + b, C0 = h * 128;
    unsigned char* ws = A.ws;
    float* qs = (float*)lds; float* ks = qs + 128; float* fs = ks + 128; float* vs = fs + 128; float* po = vs + 128;
    float* red = po + 16 * 128;
    const float* S0 = A.in[3] + (size_t)unit * 16384; float* S1 = A.out + O_HS + (size_t)unit * 16384;
    f32x4 sreg[8];
#pragma unroll
    for (int i = 0; i < 8; ++i) sreg[i] = *(const f32x4*)(S0 + ((t >> 5) * 8 + i) * 128 + (t & 31) * 4);
    if (t < 128) { const size_t go = (size_t)row * HW + C0 + t;
        qs[t] = bf2f(((const bf16_t*)(ws + WS_QQ))[go]); ks[t] = bf2f(((const bf16_t*)(ws + WS_KK))[go]); fs[t] = __expf(((const float*)(ws + WS_LF))[go]); vs[t] = bf2f(((const bf16_t*)(ws + WS_VV))[go]); }
    __syncthreads();
    const int v4 = t & 31, kg = t >> 5;
    const f32x4 vv = *(const f32x4*)(vs + v4 * 4);
    f32x4 o = (f32x4){0.f, 0.f, 0.f, 0.f};
#pragma unroll
    for (int i = 0; i < 8; ++i) { const int k = kg * 8 + i; const f32x4 s = sreg[i]; const f32x4 sn = s * fs[k] + vv * ks[k]; *(f32x4*)(S1 + k * 128 + v4 * 4) = sn; o += sn * qs[k]; }
    *(f32x4*)(po + kg * 128 + v4 * 4) = o;
    __syncthreads();
    float ov = 0.f;
    if (t < 128) {
#pragma unroll
        for (int i = 0; i < 16; ++i) ov += po[i * 128 + t];
        const float sq = wave_sum(ov * ov); if ((t & 63) == 0) red[t >> 6] = sq; }
    __syncthreads();
    if (t < 128) { const float rstd = __builtin_amdgcn_rsqf((red[0] + red[1]) * (1.0f / 128.0f) + EPS); const float g = bf2f(((const bf16_t*)(ws + WS_GG))[(size_t)row * HW + C0 + t]);
        ((bf16_t*)(ws + WS_MIX))[(size_t)row * DM + C0 + t] = (bf16_t)f2bf(ov * rstd * A.in[10][C0 + t] * g); }
    __syncthreads();
}

constexpr int LP_EXT = 0, LP_PL = 40448, LP_MX = 57856;
__device__ __forceinline__ void pool_unit(const Args& A, unsigned char* lds, int unit) {
    const int t = threadIdx.x, w = t >> 6, l = t & 63, lr = l & 15, lq = l >> 4;
    const int tt = unit >> 2, g = unit & 3, win = 2 << g;
    unsigned char* ws = A.ws;
    float* ext = (float*)(lds + LP_EXT); bf16_t* pl = (bf16_t*)(lds + LP_PL); bf16_t* mx = (bf16_t*)(lds + LP_MX);
    const float* UU = (const float*)(ws + WS_UU);
    u32x4 mreg[4]; f32x4 ereg[5];
    {
        const bf16_t* PM = (const bf16_t*)(ws + WS_PMIX) + (size_t)g * 16384;
#pragma unroll
        for (int i = 0; i < 4; ++i) { const int idx = i * 512 + t, d = idx >> 4, c8 = idx & 15; mreg[i] = *(const u32x4*)(PM + d * 128 + c8 * 8); }
        { const int b = tt >> 5, t0 = (tt & 31) * 64;
#pragma unroll
            for (int i5 = 0; i5 < 5; ++i5) { const int idx = i5 * 512 + t, i = idx >> 5, c4 = idx & 31; const int tp = t0 - 15 + i;
                ereg[i5] = (f32x4){0.f, 0.f, 0.f, 0.f}; if (idx < 79 * 32 && tp >= 0) ereg[i5] = *(const f32x4*)(UU + (size_t)(b * SEQ + tp) * HW + g * 128 + c4 * 4); } }
#pragma unroll
        for (int i = 0; i < 4; ++i) { const int idx = i * 512 + t, d = idx >> 4, c8 = idx & 15; *(u32x4*)(mx + d * 136 + c8 * 8) = mreg[i]; }
    }
    int rowbase;
    {
        const int b = tt >> 5, t0 = (tt & 31) * 64; rowbase = b * SEQ + t0;
#pragma unroll
        for (int i5 = 0; i5 < 5; ++i5) { const int idx = i5 * 512 + t, i = idx >> 5, c4 = idx & 31; if (idx < 79 * 32) *(f32x4*)(ext + i * 128 + c4 * 4) = ereg[i5]; }
        __syncthreads();
        const int cch = t & 127, tg = t >> 7;
#pragma unroll 4
        for (int i = 0; i < 16; ++i) { const int tok = tg * 16 + i; float s = 0.f;
            for (int j = 0; j < win; ++j) s += ext[(15 + tok - j) * 128 + cch];
            const int cnt = min(t0 + tok + 1, win);
            pl[tok * 136 + cch] = (bf16_t)f2bf(s / (float)cnt - ext[(15 + tok) * 128 + cch]); }
    }
    __syncthreads();
    const int ct = w & 3, dh = w >> 2;
    f32x4 o4[4];
#pragma unroll
    for (int i = 0; i < 4; ++i) o4[i] = (f32x4){0.f, 0.f, 0.f, 0.f};
#pragma unroll
    for (int ks = 0; ks < 4; ++ks) { const bf16x8 a = *(const bf16x8*)(pl + (16 * ct + lr) * 136 + ks * 32 + lq * 8);
#pragma unroll
        for (int i = 0; i < 4; ++i) { const int dt = dh * 4 + i; const bf16x8 bb = *(const bf16x8*)(mx + (16 * dt + lr) * 136 + ks * 32 + lq * 8); o4[i] = MFMA16(a, bb, o4[i]); } }
    bf16_t* MIX = (bf16_t*)(ws + WS_MIX); const float* psc = A.in[12];
    float* ost = (float*)(lds + LP_EXT);
#pragma unroll
    for (int i = 0; i < 4; ++i) { const int d = (dh * 4 + i) * 16 + lr; const float sc = psc[g * 128 + d];
#pragma unroll
        for (int r = 0; r < 4; ++r) ost[(16 * ct + lq * 4 + r) * 132 + d] = o4[i][r] * sc; }
    __syncthreads();
    {   const int tok = t >> 3, d0 = (t & 7) * 16;
#pragma unroll
        for (int hh = 0; hh < 2; ++hh) { const f32x4 oa = *(const f32x4*)(ost + tok * 132 + d0 + hh * 8), ob = *(const f32x4*)(ost + tok * 132 + d0 + hh * 8 + 4);
            u32x4 o; o.x = pk2(oa[0], oa[1]); o.y = pk2(oa[2], oa[3]); o.z = pk2(ob[0], ob[1]); o.w = pk2(ob[2], ob[3]);
            *(u32x4*)(MIX + (size_t)(rowbase + tok) * DM + 512 + g * 128 + d0 + hh * 8) = o; } }
    __syncthreads();
}

__device__ __forceinline__ void pool_sample_unit(const Args& A, unsigned char* lds, int unit) {
    const int t = threadIdx.x, w = t >> 6, l = t & 63, lr = l & 15, lq = l >> 4;
    const int su = unit >> 2, g = unit & 3, win = 2 << g;
    unsigned char* ws = A.ws;
    bf16_t* pl = (bf16_t*)(lds + LP_PL); bf16_t* mx = (bf16_t*)(lds + LP_MX);
    const float* UU = (const float*)(ws + WS_UU);
    const bf16_t* PM = (const bf16_t*)(ws + WS_PMIX) + (size_t)g * 16384;
    u32x4 mreg[4];
#pragma unroll
    for (int i = 0; i < 4; ++i) { const int idx = i * 512 + t, d = idx >> 4, c8 = idx & 15; mreg[i] = *(const u32x4*)(PM + d * 128 + c8 * 8); }
    const int cch = t & 127, sq = t >> 7;
    const float psc_w = A.in[12][g * 128 + 16 * w + lr];
#pragma unroll
    for (int i = 0; i < 4; ++i) { const int tok = sq * 4 + i, sb = su * 16 + tok; const float uv = UU[(size_t)(NPR + sb) * HW + g * 128 + cch];
        float pv[15];
#pragma unroll
        for (int j = 0; j < 15; ++j) pv[j] = A.in[4][(size_t)(sb * 15 + j) * 512 + g * 128 + cch];
        float sacc = uv;
#pragma unroll
        for (int j = 0; j < 15; ++j) sacc += (j >= 16 - win) ? pv[j] : 0.f;
        pl[tok * 136 + cch] = (bf16_t)f2bf(sacc / (float)win - uv); }
#pragma unroll
    for (int i = 0; i < 4; ++i) { const int idx = i * 512 + t, d = idx >> 4, c8 = idx & 15; *(u32x4*)(mx + d * 136 + c8 * 8) = mreg[i]; }
    __syncthreads();
    f32x4 acc = (f32x4){0.f, 0.f, 0.f, 0.f};
#pragma unroll
    for (int ks = 0; ks < 4; ++ks) { const bf16x8 a = *(const bf16x8*)(pl + lr * 136 + ks * 32 + lq * 8); const bf16x8 bb = *(const bf16x8*)(mx + (16 * w + lr) * 136 + ks * 32 + lq * 8); acc = MFMA16(a, bb, acc); }
    bf16_t* MIX = (bf16_t*)(ws + WS_MIX);
#pragma unroll
    for (int r = 0; r < 4; ++r) MIX[(size_t)(NPR + su * 16 + lq * 4 + r) * DM + 512 + g * 128 + 16 * w + lr] = (bf16_t)f2bf(acc[r] * psc_w);
    __syncthreads();
}

__device__ __forceinline__ void attn_prompt_unit(const Args& A, unsigned char* lds, int unit) {
    const int t = threadIdx.x, w = t >> 6, l = t & 63, lr = l & 15, lq = l >> 4;
    const int qt = unit & 15, h = (unit >> 4) & 3, b = unit >> 6;
    unsigned char* ws = A.ws;
    const bf16_t* Q = (const bf16_t*)(ws + WS_Q); const bf16_t* KB = (const bf16_t*)(ws + WS_KB); const bf16_t* VT = (const bf16_t*)(ws + WS_VT); bf16_t* O = (bf16_t*)(ws + WS_O);
    const int R0 = b * SEQ + qt * 128 + 16 * w;
    bf16_t* CB = (bf16_t*)lds;
    bf16_t* Pw = (bf16_t*)(lds + 73728) + w * (16 * 264);
    const bf16_t* kg = KB + (size_t)(b * 256) * DM + h * 256;
    const bf16_t* vg = VT + (size_t)(h * 256) * MEMR + b * 256;
    u32x4 stg[4];
#define AT_LOADK(c) _Pragma("unroll") for (int i_ = 0; i_ < 4; ++i_) { const int idx_ = i_ * 512 + t; stg[i_] = *(const u32x4*)(kg + (size_t)((c) * 64 + (idx_ >> 5)) * DM + (idx_ & 31) * 8); }
#define AT_LOADV(c) _Pragma("unroll") for (int i_ = 0; i_ < 4; ++i_) { const int idx_ = i_ * 512 + t; stg[i_] = *(const u32x4*)(vg + (size_t)(idx_ >> 3) * MEMR + (c) * 64 + (idx_ & 7) * 8); }
#define AT_STOREK(bf) _Pragma("unroll") for (int i_ = 0; i_ < 4; ++i_) { const int idx_ = i_ * 512 + t; *(u32x4*)(CB + (bf) * 18432 + (idx_ >> 5) * 264 + (idx_ & 31) * 8) = stg[i_]; }
#define AT_STOREV(bf) _Pragma("unroll") for (int i_ = 0; i_ < 4; ++i_) { const int idx_ = i_ * 512 + t; *(u32x4*)(CB + (bf) * 18432 + (idx_ >> 3) * 72 + (idx_ & 7) * 8) = stg[i_]; }
    AT_LOADK(0);
    bf16x8 qa[8];
#pragma unroll
    for (int ks = 0; ks < 8; ++ks) qa[ks] = *(const bf16x8*)(Q + (size_t)(R0 + lr) * DM + h * 256 + ks * 32 + lq * 8);
    AT_STOREK(0);
    __syncthreads();
    f32x4 sacc[16]; f32x4 oacc[16]; bf16x8 pa[8]; float rinv[4];
#pragma unroll
    for (int st = 0; st < 8; ++st) {
        if (st + 1 < 4) { AT_LOADK(st + 1); } else if (st + 1 < 8) { AT_LOADV(st - 3); }
        const bf16_t* cb = CB + (st & 1) * 18432;
        if (st < 4) {
#pragma unroll
            for (int nt = 0; nt < 4; ++nt) { f32x4 acc = (f32x4){0.f, 0.f, 0.f, 0.f};
#pragma unroll
                for (int ks = 0; ks < 8; ++ks) { const bf16x8 bb = *(const bf16x8*)(cb + (nt * 16 + lr) * 264 + ks * 32 + lq * 8); acc = MFMA16(qa[ks], bb, acc); }
                sacc[st * 4 + nt] = acc; __builtin_amdgcn_sched_barrier(0); }
        } else {
            if (st == 4) {
#pragma unroll
                for (int r = 0; r < 4; ++r) { float mx = sacc[0][r];
#pragma unroll
                    for (int nt = 1; nt < 16; ++nt) mx = fmaxf(mx, sacc[nt][r]);
                    mx = fmaxf(mx, __shfl_xor(mx, 1)); mx = fmaxf(mx, __shfl_xor(mx, 2)); mx = fmaxf(mx, __shfl_xor(mx, 4)); mx = fmaxf(mx, __shfl_xor(mx, 8));
                    float sum = 0.f;
#pragma unroll
                    for (int nt = 0; nt < 16; ++nt) { const float p = __builtin_amdgcn_exp2f(sacc[nt][r] - mx); sum += p; Pw[(lq * 4 + r) * 264 + nt * 16 + lr] = (bf16_t)f2bf(p); }
                    sum += __shfl_xor(sum, 1); sum += __shfl_xor(sum, 2); sum += __shfl_xor(sum, 4); sum += __shfl_xor(sum, 8);
                    rinv[r] = 1.0f / sum; }
                asm volatile("s_waitcnt lgkmcnt(0)" ::: "memory");
#pragma unroll
                for (int ks = 0; ks < 8; ++ks) pa[ks] = *(const bf16x8*)(Pw + lr * 264 + ks * 32 + lq * 8);
#pragma unroll
                for (int dt = 0; dt < 16; ++dt) oacc[dt] = (f32x4){0.f, 0.f, 0.f, 0.f};
            }
            const int c = st - 4;
#pragma unroll
            for (int dt = 0; dt < 16; ++dt)
#pragma unroll
                for (int k2 = 0; k2 < 2; ++k2) { const bf16x8 bb = *(const bf16x8*)(cb + (dt * 16 + lr) * 72 + k2 * 32 + lq * 8); oacc[dt] = MFMA16(pa[c * 2 + k2], bb, oacc[dt]); if (k2 == 1 && (dt & 1)) __builtin_amdgcn_sched_barrier(0); }
        }
        if (st + 1 < 4) { AT_STOREK((st + 1) & 1); } else if (st + 1 < 8) { AT_STOREV((st + 1) & 1); }
        __syncthreads();
    }
#pragma unroll
    for (int dt = 0; dt < 16; ++dt)
#pragma unroll
        for (int r = 0; r < 4; ++r) Pw[(lq * 4 + r) * 264 + dt * 16 + lr] = (bf16_t)f2bf(oacc[dt][r] * rinv[r]);
    asm volatile("s_waitcnt lgkmcnt(0)" ::: "memory");
#pragma unroll
    for (int i = 0; i < 8; ++i) { const int idx = i * 64 + l, row = idx >> 5, c8 = idx & 31; *(u32x4*)(O + (size_t)(R0 + row) * DM + h * 256 + c8 * 8) = *(const u32x4*)(Pw + row * 264 + c8 * 8); }
    asm volatile("s_waitcnt lgkmcnt(0)" ::: "memory");
#undef AT_LOADK
#undef AT_LOADV
#undef AT_STOREK
#undef AT_STOREV
}
__device__ __forceinline__ void attn_sample_unit(const Args& A, unsigned char* lds, int unit) {
    const int t = threadIdx.x, w = t >> 6, l = t & 63;
    const int b = unit >> 2, h = unit & 3;
    unsigned char* ws = A.ws;
    float* qs = (float*)lds; float* sc = qs + 256; float* red = sc + 256; float* po = red + 16;
    if (t < 256) qs[t] = bf2f(((const bf16_t*)(ws + WS_Q))[(size_t)(NPR + b) * DM + h * 256 + t]);
    __syncthreads();
    const float* Kc = A.in[5] + (size_t)b * 256 * 1024 + h * 256; const float* Vc = A.in[6] + (size_t)b * 256 * 1024 + h * 256;
    {
        const int rl = l >> 4, c16 = l & 15;
        f32x4 q4[4];
#pragma unroll
        for (int i = 0; i < 4; ++i) q4[i] = *(const f32x4*)(qs + i * 64 + c16 * 4);
#pragma unroll 4
        for (int p = 0; p < 8; ++p) { const int m = p * 32 + w * 4 + rl; const float* kr = Kc + (size_t)m * 1024; float s = 0.f;
#pragma unroll
            for (int i = 0; i < 4; ++i) { const f32x4 kv = *(const f32x4*)(kr + i * 64 + c16 * 4); s += (kv[0] * q4[i][0] + kv[1] * q4[i][1]) + (kv[2] * q4[i][2] + kv[3] * q4[i][3]); }
            s += __shfl_xor(s, 1); s += __shfl_xor(s, 2); s += __shfl_xor(s, 4); s += __shfl_xor(s, 8);
            if (c16 == 0) sc[m] = s; }
    }
    __syncthreads();
    if (t < 256) { float v = sc[t]; float mx = v;
#pragma unroll
        for (int o = 1; o < 64; o <<= 1) mx = fmaxf(mx, __shfl_xor(mx, o));
        if (l == 0) red[w] = mx; }
    __syncthreads();
    const float gmx = fmaxf(fmaxf(red[0], red[1]), fmaxf(red[2], red[3]));
    float pv = 0.f;
    if (t < 256) { pv = __builtin_amdgcn_exp2f(sc[t] - gmx); const float s = wave_sum(pv); if (l == 0) red[8 + w] = s; }
    __syncthreads();
    if (t < 256) sc[t] = pv;
    const float inv = 1.0f / ((red[8] + red[9]) + (red[10] + red[11]));
    __syncthreads();
    {
        f32x4 o = (f32x4){0.f, 0.f, 0.f, 0.f};
#pragma unroll 8
        for (int i = 0; i < 32; ++i) { const int m = w * 32 + i; const f32x4 vv = *(const f32x4*)(Vc + (size_t)m * 1024 + l * 4); o += vv * sc[m]; }
        *(f32x4*)(po + w * 256 + l * 4) = o;
    }
    __syncthreads();
    if (t < 256) { float o = 0.f;
#pragma unroll
        for (int i = 0; i < 8; ++i) o += po[i * 256 + t];
        ((bf16_t*)(ws + WS_O))[(size_t)(NPR + b) * DM + h * 256 + t] = (bf16_t)f2bf(o * inv); }
    __syncthreads();
}

template <int KIND>
__device__ __forceinline__ void sample_gemm(unsigned char* lds, const bf16_t* Asm, int lda, const bf16_t* Bt, int K, int unit, const float* base, float* out, bf16_t* outb, float* ss, float scale) {
    const int t = threadIdx.x, w = t >> 6, l = t & 63, lr = l & 15, lq = l >> 4;
    const int rb = unit & 3, cb = unit >> 2, kw = K >> 3, k0 = w * kw, nks = kw >> 5;
    f32x4 acc[2]; acc[0] = (f32x4){0.f, 0.f, 0.f, 0.f}; acc[1] = acc[0];
    const bf16_t* bp = Bt + (size_t)(cb * 16 + lr) * K + k0 + lq * 8;
    const bf16_t* ap = Asm + (size_t)(rb * 32 + lr) * lda + k0 + lq * 8;
#pragma unroll 2
    for (int ks = 0; ks < nks; ++ks) { const bf16x8 bb = *(const bf16x8*)(bp + ks * 32); const bf16x8 a0 = *(const bf16x8*)(ap + ks * 32), a1 = *(const bf16x8*)(ap + (size_t)16 * lda + ks * 32);
        acc[0] = MFMA16(a0, bb, acc[0]); acc[1] = MFMA16(a1, bb, acc[1]); }
    float* red = (float*)lds;
#pragma unroll
    for (int i = 0; i < 2; ++i)
#pragma unroll
        for (int r = 0; r < 4; ++r) red[(w * 32 + i * 16 + lq * 4 + r) * 16 + lr] = acc[i][r];
    __syncthreads();
    const int row = t >> 4, col = t & 15, grow = rb * 32 + row, gcol = cb * 16 + col;
    float v = 0.f;
#pragma unroll
    for (int i = 0; i < 8; ++i) v += red[(i * 32 + row) * 16 + col];
    if (KIND == 0) { const float val = base[(size_t)grow * DM + gcol] + v; out[(size_t)grow * DM + gcol] = val; if (outb) outb[(size_t)grow * DM + gcol] = (bf16_t)f2bf(val);
        float sq = val * val; sq += __shfl_xor(sq, 1); sq += __shfl_xor(sq, 2); sq += __shfl_xor(sq, 4); sq += __shfl_xor(sq, 8);
        if (col == 0) atomicAdd(ss + grow, sq);
    } else { const float rstd = __builtin_amdgcn_rsqf(ss[grow] * (1.0f / DM) + EPS); outb[(size_t)grow * DM + gcol] = (bf16_t)f2bf(v * rstd * scale); }
    __syncthreads();
}

__device__ __forceinline__ void final_norm(const Args& A, int G) {
    const int lane = threadIdx.x & 63, gw = blockIdx.x * 8 + (threadIdx.x >> 6), NGW = G * 8;
    const float* ss = (const float*)(A.ws + WS_SS3); const f32x4* gr = (const f32x4*)A.in[22] + lane;
    f32x4 gg[4];
#pragma unroll
    for (int j = 0; j < 4; ++j) gg[j] = gr[64 * j];
    for (int m0 = gw * 4; m0 < NVALID; m0 += NGW * 4) {
        f32x4 v[4][4]; float sv[4];
#pragma unroll
        for (int r = 0; r < 4; ++r) { sv[r] = ss[m0 + r]; const f32x4* xr = (const f32x4*)(A.out + (size_t)(m0 + r) * DM) + lane;
#pragma unroll
            for (int j = 0; j < 4; ++j) v[r][j] = xr[64 * j]; }
#pragma unroll
        for (int r = 0; r < 4; ++r) { const float rstd = 1.0f / sqrtf(sv[r] * (1.f / DM) + EPS); f32x4* xr = (f32x4*)(A.out + (size_t)(m0 + r) * DM) + lane;
#pragma unroll
            for (int j = 0; j < 4; ++j) xr[64 * j] = v[r][j] * rstd * gg[j]; } }
}

constexpr int NPHASES = 12;
#ifndef REPMASK
#define REPMASK 0
#endif
#define REPS(k) for (int rep_ = 0; rep_ < 1 + ((REPMASK >> (k)) & 1); ++rep_)
__global__ void __launch_bounds__(NTHREADS, 2) fwd_megakernel(Args args) {
    extern __shared__ __attribute__((aligned(16))) unsigned char lds[];
    cg::grid_group grid = cg::this_grid();
    const int G = gridDim.x, bx = blockIdx.x;
    unsigned char* ws = args.ws;
    PG8_LAS unsigned char* lds3 = (PG8_LAS unsigned char*)lds;
    const int lo = args.ph_lo, hi = args.ph_hi;
#define IN(k) (lo <= (k) && (k) < hi)
#define SEAM(k) do { if (IN(k) && IN((k) + 1)) xcd_barrier(bar); } while (0)
    if (lo < 0) grid.sync();
    volatile LAS unsigned* MISC = (volatile LAS unsigned*)(lds3 + LDS_BYTES - 64);
    if (threadIdx.x < 16) MISC[threadIdx.x] = 0u;
    __syncthreads();
    XcdBarrier bar = xcd_barrier_post((unsigned*)(ws + WS_BAR), MISC);
    if (IN(0)) REPS(0) { p0_prologue(args, lds, G); }
    SEAM(0);
    if (IN(1)) REPS(1) {
        {   pg8::Gemm g{(const bf16_t*)(ws + WS_H0), (const bf16_t*)(ws + WS_WIN), MT, NIN, DM}; pg8::StaticOrder S; S.init(MT, NIN, G, bx);
            pg8::EpiInProj E{(bf16_t*)(ws + WS_QQ), (bf16_t*)(ws + WS_KK), (bf16_t*)(ws + WS_VV), (bf16_t*)(ws + WS_GG), (float*)(ws + WS_LF), (float*)(ws + WS_UU), args.in[9]};
            pg8::gemm_phase<pg8::EpiInProj, pg8::StaticOrder, true, true>(lds3, g, S, E); }
        {   pg8::Gemm g{(const bf16_t*)(ws + WS_MEMH), (const bf16_t*)(ws + WS_WKV), MEMR, 2 * DM, DM}; pg8::StaticOrder S; S.init(MEMR, 2 * DM, G, (bx + G - (650 % G)) % G);
            pg8::EpiMemKV E{args.out + O_MK, args.out + O_MV, (bf16_t*)(ws + WS_KB)};
            pg8::gemm_phase<pg8::EpiMemKV, pg8::StaticOrder, true, true>(lds3, g, S, E); }
        {   pg8::Gemm g{(const bf16_t*)(ws + WS_WKV) + (size_t)DM * DM, (const bf16_t*)(ws + WS_MEMH), DM, MEMR, DM}; pg8::StaticOrder S; S.init(DM, MEMR, G, (bx + 2 * G - ((650 + 64) % G)) % G);
            pg8::EpiBf16Scale E{(bf16_t*)(ws + WS_VT), MEMR, nullptr, 1.0f};
            pg8::gemm_phase<pg8::EpiBf16Scale, pg8::StaticOrder, true, true>(lds3, g, S, E); }
    }
    SEAM(1);
    if (IN(2)) REPS(2) {
        REPS(14) for (int u = bx; u < 512; u += G) hgrn_sample_unit(args, lds, u);
        REPS(15) for (int u = bx; u < 1024; u += G) hgrn_local_unit(args, lds, u);
    }
    SEAM(2);
    if (IN(3)) REPS(3) { hgrn_scan(args, G); pool_states(args, G); }
    SEAM(3);
    if (IN(4)) REPS(4) {
        REPS(12) for (int u = bx; u < 1024; u += G) hgrn_out_unit(args, lds, u);
        REPS(13) for (int u = bx; u < 32 + 1024; u += G) { if (u < 32) pool_sample_unit(args, lds, u); else pool_unit(args, lds, u - 32); }
    }
    SEAM(4);
    if (IN(5)) {
        pg8::Gemm g{(const bf16_t*)(ws + WS_MIX), (const bf16_t*)(ws + WS_WOUT), NPR, DM, DM}; pg8::StaticOrder S; S.init(NPR, DM, G, bx);
        pg8::EpiResid E{args.in[0], args.in[1], NPR, (float*)(ws + WS_X1), NPR, (bf16_t*)(ws + WS_H0), (float*)(ws + WS_SS1)};
        pg8::gemm_phase<pg8::EpiResid, pg8::StaticOrder, true, true>(lds3, g, S, E);
        for (int u = bx; u < 256; u += G) sample_gemm<0>(lds, (const bf16_t*)(ws + WS_MIX) + (size_t)NPR * DM, DM, (const bf16_t*)(ws + WS_WOUT), DM, u, args.in[1], (float*)(ws + WS_X1) + (size_t)NPR * DM, (bf16_t*)(ws + WS_H0) + (size_t)NPR * DM, (float*)(ws + WS_SS1) + NPR, 1.0f);
    }
    SEAM(5);
    if (IN(6)) REPS(6) {
        pg8::Gemm g{(const bf16_t*)(ws + WS_H0), (const bf16_t*)(ws + WS_WCQ), NPR, DM, DM}; pg8::StaticOrder S; S.init(NPR, DM, G, bx);
        pg8::EpiBf16Scale E{(bf16_t*)(ws + WS_Q), DM, (const float*)(ws + WS_SS1), 0.0625f * 1.4426950408889634f};
        pg8::gemm_phase<pg8::EpiBf16Scale, pg8::StaticOrder, true, true>(lds3, g, S, E);
        for (int u = bx; u < 256; u += G) sample_gemm<1>(lds, (const bf16_t*)(ws + WS_H0) + (size_t)NPR * DM, DM, (const bf16_t*)(ws + WS_WCQ), DM, u, nullptr, nullptr, (bf16_t*)(ws + WS_Q) + (size_t)NPR * DM, (float*)(ws + WS_SS1) + NPR, 0.0625f * 1.4426950408889634f);
    }
    SEAM(6);
    if (IN(7)) REPS(7) {
        for (int u = bx; u < 1024; u += G) { if (u < 512) attn_sample_unit(args, lds, u); else attn_prompt_unit(args, lds, u - 512); }
    }
    SEAM(7);
    if (IN(8)) {
        const float* X1 = (const float*)(ws + WS_X1);
        pg8::Gemm g{(const bf16_t*)(ws + WS_O), (const bf16_t*)(ws + WS_WCO), NPR, DM, DM}; pg8::StaticOrder S; S.init(NPR, DM, G, bx);
        pg8::EpiResid E{X1, X1 + (size_t)NPR * DM, NPR, (float*)(ws + WS_SL), NPR, (bf16_t*)(ws + WS_MIX), (float*)(ws + WS_SS2)};
        pg8::gemm_phase<pg8::EpiResid, pg8::StaticOrder, true, true>(lds3, g, S, E);
        for (int u = bx; u < 256; u += G) sample_gemm<0>(lds, (const bf16_t*)(ws + WS_O) + (size_t)NPR * DM, DM, (const bf16_t*)(ws + WS_WCO), DM, u, X1 + (size_t)NPR * DM, (float*)(ws + WS_SL) + (size_t)NPR * DM, (bf16_t*)(ws + WS_MIX) + (size_t)NPR * DM, (float*)(ws + WS_SS2) + NPR, 1.0f);
    }
    SEAM(8);
    if (IN(9)) REPS(9) {
        pg8::Gemm g{(const bf16_t*)(ws + WS_MIX), (const bf16_t*)(ws + WS_WFFI), MT, NFF2, DM}; pg8::StaticOrder S; S.init(MT, NFF2, G, bx);
        pg8::EpiSwiGLU E{(bf16_t*)(ws + WS_A), (const float*)(ws + WS_SS2)};
        pg8::gemm_phase<pg8::EpiSwiGLU, pg8::StaticOrder, true, true>(lds3, g, S, E);
    }
    SEAM(9);
    if (IN(10)) {
        const float* X2 = (const float*)(ws + WS_SL);
        pg8::Gemm g{(const bf16_t*)(ws + WS_A), (const bf16_t*)(ws + WS_WFFO), NPR, DM, DFF}; pg8::StaticOrder S; S.init(NPR, DM, G, bx);
        pg8::EpiResid E{X2, X2 + (size_t)NPR * DM, NPR, args.out, NPR, nullptr, (float*)(ws + WS_SS3)};
        pg8::gemm_phase<pg8::EpiResid, pg8::StaticOrder, true, true>(lds3, g, S, E);
        for (int u = bx; u < 256; u += G) sample_gemm<0>(lds, (const bf16_t*)(ws + WS_A) + (size_t)NPR * DFF, DFF, (const bf16_t*)(ws + WS_WFFO), DFF, u, X2 + (size_t)NPR * DM, args.out + O_YS, nullptr, (float*)(ws + WS_SS3) + NPR, 1.0f);
    }
    SEAM(10);
#ifdef EXTRA_SYNCS
    for (int i_ = 0; i_ < EXTRA_SYNCS; ++i_) xcd_barrier(bar);
#endif
    if (IN(11)) { final_norm(args, G); }
#undef IN
#undef SEAM
}

#ifndef MK_MULTI
#define MK_MULTI 0
#endif
extern "C" void kernel_launch(void* const* d_in, const int* in_sizes, int n_in, void* d_out, int out_size, void* d_ws, size_t ws_size, hipStream_t stream) {
    static int grid = 0;
    if (grid == 0) {
        if (n_in != 23 || ws_size < WS_END) { fprintf(stderr, "kernel_launch: unexpected n_in %d / ws_size %zu\n", n_in, ws_size); grid = -1; return; }
        int dev = 0, cus = 0, per_cu = 0;
        hipGetDevice(&dev); hipDeviceGetAttribute(&cus, hipDeviceAttributeMultiprocessorCount, dev);
        if (hipFuncSetAttribute((const void*)fwd_megakernel, hipFuncAttributeMaxDynamicSharedMemorySize, LDS_BYTES) != hipSuccess) { fprintf(stderr, "kernel_launch: hipFuncSetAttribute failed\n"); grid = -1; return; }
        hipOccupancyMaxActiveBlocksPerMultiprocessor(&per_cu, (const void*)fwd_megakernel, NTHREADS, LDS_BYTES);
        (void)hipGetLastError();
        if (per_cu < 1) { fprintf(stderr, "kernel_launch: occupancy query says %d blocks/CU\n", per_cu); per_cu = 1; }
        grid = cus;
    }
    if (grid < 0) return;
    Args a{};
    for (int i = 0; i < 23; ++i) a.in[i] = (const float*)d_in[i];
    a.out = (float*)d_out; a.ws = (unsigned char*)d_ws;
#if MK_MULTI
    for (int p = 0; p < NPHASES; ++p) { a.ph_lo = p; a.ph_hi = p + 1; hipLaunchKernelGGL(fwd_megakernel, dim3(grid), dim3(NTHREADS), LDS_BYTES, stream, a); }
#else
    a.ph_lo = 0; a.ph_hi = NPHASES;
    if (hipMemsetAsync((char*)d_ws + WS_BAR, 0, BAR_BYTES, stream) != hipSuccess) { fprintf(stderr, "kernel_launch: memset failed\n"); return; }
    void* kargs[] = {&a};
    hipError_t e = hipLaunchCooperativeKernel((const void*)fwd_megakernel, dim3(grid), dim3(NTHREADS), kargs, LDS_BYTES, stream);
    if (e != hipSuccess) fprintf(stderr, "kernel_launch: cooperative launch failed: %s (grid %d)\n", hipGetErrorString(e), grid);
#endif
}
```

```cpp
#include <hip/hip_runtime.h>
#include <hip/hip_cooperative_groups.h>
#include <cstdio>
#include <cstdint>
namespace cg = cooperative_groups;
namespace pg8 {
#define PG8_LAS __attribute__((address_space(3)))
typedef unsigned short bf16_t;
typedef short bf16x8 __attribute__((ext_vector_type(8)));
typedef float f32x4 __attribute__((ext_vector_type(4)));
typedef unsigned u32x4 __attribute__((ext_vector_type(4)));
constexpr int BM = 256, BK = 64, HALF = 128, HTB = HALF * BK * 2  , STAGE_BYTES = 8 * HTB, NXCD = 8, WGM = 8;

__host__ __device__ __forceinline__ int lds_byte(int r, int c) { const int st = (r >> 4) * 2 + (c >> 5), rr = r & 15, cc = c & 31, ob = rr * 64 + cc * 2; return st * 1024 + (ob ^ (((ob >> 9) & 1) << 5)); }
__host__ __device__ __forceinline__ void stage_rc(int b, int& R, int& C) { const int st = b / 1024, sb = b % 1024, swz = sb ^ (((sb >> 9) & 1) << 5); R = (st >> 1) * 16 + swz / 64; C = (st & 1) * 32 + (swz % 64) / 2; }
__host__ __device__ __forceinline__ int perm32(int rho) { const int n = rho >> 4, i = rho & 15; return 8 * (i >> 2) + 4 * n + (i & 3); }

struct Unit { int pm, pn; };
struct Gemm { const bf16_t* A; const bf16_t* Bt; int M, N, K; };

struct StaticOrder {
    int nM, nN, nwg, G, c;
    __host__ __device__ void init(int M, int N, int G_, int c_) { nM = M / BM; nN = N / BM; nwg = nM * nN; G = G_; c = c_; }
    __host__ __device__ bool next(int i, Unit& u) const {
        const long L = (long)i * G + c; if (L >= nwg) return false;
        int wgid = (int)L; { const int q = nwg / NXCD, r = nwg % NXCD, xcd = wgid % NXCD, off = wgid / NXCD; wgid = (xcd < r ? xcd * (q + 1) : r * (q + 1) + (xcd - r) * q) + off; }
        const int nig = WGM * nN, gid = wgid / nig, fm = gid * WGM, gsz = (nM - fm) < WGM ? (nM - fm) : WGM;
        u.pm = fm + ((wgid % nig) % gsz); u.pn = (wgid % nig) / gsz; return true;
    }
    __device__ __forceinline__ void a_ready(const Unit&) const {}
    __device__ __forceinline__ void done(const Unit&) const {}
};

__device__ __forceinline__ unsigned cvt_pk_bf16(float lo, float hi) { unsigned r; asm volatile("v_cvt_pk_bf16_f32 %0, %1, %2" : "=v"(r) : "v"(lo), "v"(hi)); return r; }
typedef unsigned u32x2 __attribute__((ext_vector_type(2)));
__device__ __forceinline__ float sigm(float z) { return 1.0f / (1.0f + __expf(-z)); }
constexpr float RMS_EPS = 1e-6f;
typedef _Float16 h2_t __attribute__((ext_vector_type(2)));
__device__ __forceinline__ unsigned pk_h2(float a, float b) { h2_t v; v.x = (_Float16)a; v.y = (_Float16)b; return __builtin_bit_cast(unsigned, v); }
__device__ __forceinline__ float h_lo(unsigned u) { return (float)__builtin_bit_cast(h2_t, u).x; }
__device__ __forceinline__ float h_hi(unsigned u) { return (float)__builtin_bit_cast(h2_t, u).y; }

struct EpiInProj {
    static constexpr bool PERM = true, AFTER_DRAIN = false;
    bf16_t *QQ, *KK, *VV, *GG; unsigned short *LF, *UU; const float* lbraw;
    __device__ __forceinline__ void operator()(const f32x4 (&acc)[2][2][4][2], const Unit& u, int wr, int wc, int fr, int fq) const {
        const int seg = u.pn >> 1, colt = (u.pn & 1) * 256;
        const int row0 = u.pm * BM + wr * 64 + fr;
#pragma unroll
        for (int bj = 0; bj < 2; ++bj) {
            const int cs = colt + bj * HALF + wc * 32 + 8 * fq;
            float lb[8];
            if (seg == 1) {
#pragma unroll
                for (int j = 0; j < 8; ++j) { const float l0 = lbraw[cs + j], l1 = lbraw[512 + cs + j]; lb[j] = 1.0f / (1.0f + __expf(l1 - l0)); }
            } else {
#pragma unroll
                for (int j = 0; j < 8; ++j) lb[j] = 0.f;
            }
#pragma unroll
            for (int ai = 0; ai < 2; ++ai)
#pragma unroll
                for (int m = 0; m < 4; ++m) {
                    const size_t off = (size_t)(row0 + ai * HALF + m * 16) * 512 + cs;
                    const f32x4 v0 = acc[ai][bj][m][0], v1 = acc[ai][bj][m][1];
                    float z[8] = {v0[0], v0[1], v0[2], v0[3], v1[0], v1[1], v1[2], v1[3]};
                    if (seg == 0) {
#pragma unroll
                        for (int j = 0; j < 8; ++j) z[j] = z[j] * sigm(z[j]);
                        u32x4 w; w.x = cvt_pk_bf16(z[0], z[1]); w.y = cvt_pk_bf16(z[2], z[3]); w.z = cvt_pk_bf16(z[4], z[5]); w.w = cvt_pk_bf16(z[6], z[7]);
                        *(u32x4*)(QQ + off) = w;
                    } else if (seg == 1) {
                        float lf[8], kk[8];
#pragma unroll
                        for (int j = 0; j < 8; ++j) { const float e = __expf(-z[j]); const float sg = 1.0f / (1.0f + e); const float sgn = e / (1.0f + e);
                            lf[j] = __logf(lb[j] + (1.0f - lb[j]) * sg); kk[j] = (1.0f - lb[j]) * sgn; }
                        { u32x4 w; w.x = pk_h2(lf[0], lf[1]); w.y = pk_h2(lf[2], lf[3]); w.z = pk_h2(lf[4], lf[5]); w.w = pk_h2(lf[6], lf[7]); *(u32x4*)(LF + off) = w; }
                        u32x4 w; w.x = cvt_pk_bf16(kk[0], kk[1]); w.y = cvt_pk_bf16(kk[2], kk[3]); w.z = cvt_pk_bf16(kk[4], kk[5]); w.w = cvt_pk_bf16(kk[6], kk[7]);
                        *(u32x4*)(KK + off) = w;
                    } else if (seg == 2) {
                        u32x4 w; w.x = cvt_pk_bf16(z[0], z[1]); w.y = cvt_pk_bf16(z[2], z[3]); w.z = cvt_pk_bf16(z[4], z[5]); w.w = cvt_pk_bf16(z[6], z[7]);
                        *(u32x4*)(VV + off) = w;
                    } else if (seg == 3) {
#pragma unroll
                        for (int j = 0; j < 8; ++j) z[j] = sigm(z[j]);
                        u32x4 w; w.x = cvt_pk_bf16(z[0], z[1]); w.y = cvt_pk_bf16(z[2], z[3]); w.z = cvt_pk_bf16(z[4], z[5]); w.w = cvt_pk_bf16(z[6], z[7]);
                        *(u32x4*)(GG + off) = w;
                    } else {
                        u32x4 w; w.x = pk_h2(z[0], z[1]); w.y = pk_h2(z[2], z[3]); w.z = pk_h2(z[4], z[5]); w.w = pk_h2(z[6], z[7]); *(u32x4*)(UU + off) = w;
                    }
                }
        }
    }
};

struct EpiMemKV {
    static constexpr bool PERM = true, AFTER_DRAIN = false;
    float *outK, *outV; bf16_t* KB;
    __device__ __forceinline__ void operator()(const f32x4 (&acc)[2][2][4][2], const Unit& u, int wr, int wc, int fr, int fq) const {
        const bool isk = u.pn < 4; float* o = isk ? outK : outV; const int colt = (u.pn & 3) * 256;
        const int row0 = u.pm * BM + wr * 64 + fr;
#pragma unroll
        for (int ai = 0; ai < 2; ++ai)
#pragma unroll
            for (int m = 0; m < 4; ++m)
#pragma unroll
                for (int bj = 0; bj < 2; ++bj) {
                    const size_t off = (size_t)(row0 + ai * HALF + m * 16) * 1024 + colt + bj * HALF + wc * 32 + 8 * fq;
                    const f32x4 v0 = acc[ai][bj][m][0], v1 = acc[ai][bj][m][1];
                    *(f32x4*)(o + off) = v0; *(f32x4*)(o + off + 4) = v1;
                    if (isk) { u32x4 w; w.x = cvt_pk_bf16(v0[0], v0[1]); w.y = cvt_pk_bf16(v0[2], v0[3]); w.z = cvt_pk_bf16(v1[0], v1[1]); w.w = cvt_pk_bf16(v1[2], v1[3]); *(u32x4*)(KB + off) = w; }
                }
    }
};

struct EpiBf16Scale {
    static constexpr bool PERM = true, AFTER_DRAIN = false;
    bf16_t* O; int ldc; const float* ss; float scale;
    __device__ __forceinline__ void operator()(const f32x4 (&acc)[2][2][4][2], const Unit& u, int wr, int wc, int fr, int fq) const {
        const int row0 = u.pm * BM + wr * 64 + fr;
        float ssv[2][4];
#pragma unroll
        for (int ai = 0; ai < 2; ++ai)
#pragma unroll
            for (int m = 0; m < 4; ++m) ssv[ai][m] = ss ? ss[row0 + ai * HALF + m * 16] : 0.f;
#pragma unroll
        for (int ai = 0; ai < 2; ++ai)
#pragma unroll
            for (int m = 0; m < 4; ++m) {
                const int row = row0 + ai * HALF + m * 16;
                const float sc = ss ? scale * __builtin_amdgcn_rsqf(ssv[ai][m] * (1.0f / 1024.0f) + RMS_EPS) : scale;
#pragma unroll
                for (int bj = 0; bj < 2; ++bj) {
                    const size_t off = (size_t)row * ldc + u.pn * BM + bj * HALF + wc * 32 + 8 * fq;
                    const f32x4 v0 = acc[ai][bj][m][0] * sc, v1 = acc[ai][bj][m][1] * sc;
                    u32x4 w; w.x = cvt_pk_bf16(v0[0], v0[1]); w.y = cvt_pk_bf16(v0[2], v0[3]); w.z = cvt_pk_bf16(v1[0], v1[1]); w.w = cvt_pk_bf16(v1[2], v1[3]);
                    *(u32x4*)(O + off) = w;
                }
            }
    }
};

struct EpiResid {
    static constexpr bool PERM = true, AFTER_DRAIN = false;
    const float* baseF;
    const bf16_t* baseB;
    float* out;
    bf16_t* outb;
    float* ss;
    __device__ __forceinline__ void operator()(const f32x4 (&acc)[2][2][4][2], const Unit& u, int wr, int wc, int fr, int fq) const {
        const int row0 = u.pm * BM + wr * 64 + fr;
#pragma unroll
        for (int ai = 0; ai < 2; ++ai) {
            f32x4 pre[4][2][2];
            if (baseF) {
#pragma unroll
                for (int m = 0; m < 4; ++m) { const float* bp = baseF + (size_t)(row0 + ai * HALF + m * 16) * 1024;
#pragma unroll
                    for (int bj = 0; bj < 2; ++bj) { const int col = u.pn * BM + bj * HALF + wc * 32 + 8 * fq; pre[m][bj][0] = *(const f32x4*)(bp + col); pre[m][bj][1] = *(const f32x4*)(bp + col + 4); } }
            } else {
                u32x4 pb[4][2];
#pragma unroll
                for (int m = 0; m < 4; ++m) { const bf16_t* bp = baseB + (size_t)(row0 + ai * HALF + m * 16) * 1024;
#pragma unroll
                    for (int bj = 0; bj < 2; ++bj) pb[m][bj] = *(const u32x4*)(bp + u.pn * BM + bj * HALF + wc * 32 + 8 * fq); }
#pragma unroll
                for (int m = 0; m < 4; ++m)
#pragma unroll
                    for (int bj = 0; bj < 2; ++bj) { const u32x4 p = pb[m][bj];
                        pre[m][bj][0] = (f32x4){__uint_as_float(p.x << 16), __uint_as_float(p.x & 0xffff0000u), __uint_as_float(p.y << 16), __uint_as_float(p.y & 0xffff0000u)};
                        pre[m][bj][1] = (f32x4){__uint_as_float(p.z << 16), __uint_as_float(p.z & 0xffff0000u), __uint_as_float(p.w << 16), __uint_as_float(p.w & 0xffff0000u)}; }
            }
#pragma unroll
            for (int m = 0; m < 4; ++m) {
                const int row = row0 + ai * HALF + m * 16;
                float s = 0.f;
#pragma unroll
                for (int bj = 0; bj < 2; ++bj) {
                    const int col = u.pn * BM + bj * HALF + wc * 32 + 8 * fq;
                    const f32x4 v0 = acc[ai][bj][m][0] + pre[m][bj][0], v1 = acc[ai][bj][m][1] + pre[m][bj][1];
                    s += (v0[0] * v0[0] + v0[1] * v0[1]) + (v0[2] * v0[2] + v0[3] * v0[3]) + (v1[0] * v1[0] + v1[1] * v1[1]) + (v1[2] * v1[2] + v1[3] * v1[3]);
                    if (out) { *(f32x4*)(out + (size_t)row * 1024 + col) = v0; *(f32x4*)(out + (size_t)row * 1024 + col + 4) = v1; }
                    if (outb) { u32x4 w; w.x = cvt_pk_bf16(v0[0], v0[1]); w.y = cvt_pk_bf16(v0[2], v0[3]); w.z = cvt_pk_bf16(v1[0], v1[1]); w.w = cvt_pk_bf16(v1[2], v1[3]); *(u32x4*)(outb + (size_t)row * 1024 + col) = w; }
                }
                s += __shfl_xor(s, 16); s += __shfl_xor(s, 32);
                if (fq == 0) atomicAdd(ss + row, s);
            }
        }
    }
};

struct EpiSwiGLU {
    static constexpr bool PERM = true, AFTER_DRAIN = false;
    bf16_t* ACT; const float* ss;
    __device__ __forceinline__ void operator()(const f32x4 (&acc)[2][2][4][2], const Unit& u, int wr, int wc, int fr, int fq) const {
        const int row0 = u.pm * BM + wr * 64 + fr;
        float ssv[2][4];
#pragma unroll
        for (int ai = 0; ai < 2; ++ai)
#pragma unroll
            for (int m = 0; m < 4; ++m) ssv[ai][m] = ss[row0 + ai * HALF + m * 16];
#pragma unroll
        for (int ai = 0; ai < 2; ++ai)
#pragma unroll
            for (int m = 0; m < 4; ++m) {
                const int row = row0 + ai * HALF + m * 16;
                const float r = __builtin_amdgcn_rsqf(ssv[ai][m] * (1.0f / 1024.0f) + RMS_EPS);
#pragma unroll
                for (int bj = 0; bj < 2; ++bj) {
                    const int J = u.pn * 128 + bj * 64 + wc * 16 + 4 * fq;
                    const f32x4 a = acc[ai][bj][m][0] * r, b = acc[ai][bj][m][1] * r;
                    float o[4];
#pragma unroll
                    for (int j = 0; j < 4; ++j) o[j] = a[j] * sigm(a[j]) * b[j];
                    u32x2 w; w.x = cvt_pk_bf16(o[0], o[1]); w.y = cvt_pk_bf16(o[2], o[3]);
                    *(u32x2*)(ACT + (size_t)row * 2816 + J) = w;
                }
            }
    }
};

template <class Epi, class Sched, bool ALIGN_EPI = false, bool SP2 = false>
__device__ __forceinline__ void gemm_phase(PG8_LAS unsigned char* lds, const Gemm g, const Sched& S, const Epi& E) {
    const int tid = threadIdx.x, wid = __builtin_amdgcn_readfirstlane(tid >> 6), lane = tid & 63, wr = wid >> 2, wc = wid & 3, fr = lane & 15, fq = lane >> 4;
    const int K = g.K, nt = K / BK;
    unsigned voffA[2], voffB[2];
#pragma unroll
    for (int i = 0; i < 2; ++i) { int R, C; stage_rc(tid * 16 + i * 8192, R, C); const int Rb = Epi::PERM ? ((R & ~31) + perm32(R & 31)) : R;
        voffA[i] = (unsigned)(R * K + C) * 2u; voffB[i] = (unsigned)(Rb * K + C) * 2u; }
    const size_t kstep = (size_t)(BK * 2);
    const size_t hstep = (size_t)HALF * K * 2;
    const size_t tstep = 2 * hstep;
    const unsigned ldsw = (unsigned)wid * 1024u;
    const int aoff = lds_byte(wr * 64 + fr, fq * 8), boff = lds_byte(wc * 32 + fr, fq * 8);
#define PG8_SA(b, h) (((b) * 2 + (h)) * HTB)
#define PG8_SB(b, h) ((4 + (b) * 2 + (h)) * HTB)
#define PG8_STAGE(bufoff, gbase, voff) do { _Pragma("unroll") for (int _i = 0; _i < 2; ++_i) \
        __builtin_amdgcn_global_load_lds((const unsigned*)((const char*)(gbase) + (voff)[_i]), (PG8_LAS unsigned*)(lds + (bufoff) + ldsw + _i * 8192), 16, 0, 0); } while (0)
#define PG8_LDA(dst, b, h) do { _Pragma("unroll") for (int m = 0; m < 4; ++m) _Pragma("unroll") for (int k = 0; k < 2; ++k) dst[m][k] = *(const PG8_LAS bf16x8*)(lds + PG8_SA(b, h) + aoff + m * 2048 + k * 1024); } while (0)
#define PG8_LDB(dst, b, h) do { _Pragma("unroll") for (int n = 0; n < 2; ++n) _Pragma("unroll") for (int k = 0; k < 2; ++k) dst[n][k] = *(const PG8_LAS bf16x8*)(lds + PG8_SB(b, h) + boff + n * 2048 + k * 1024); } while (0)
#define PG8_MMA(ai, bj, At, Bt) do { __builtin_amdgcn_s_setprio(1); _Pragma("unroll") for (int m = 0; m < 4; ++m) _Pragma("unroll") for (int n = 0; n < 2; ++n) _Pragma("unroll") for (int k = 0; k < 2; ++k) \
        acc[ai][bj][m][n] = __builtin_amdgcn_mfma_f32_16x16x32_bf16(Bt[n][k], At[m][k], acc[ai][bj][m][n], 0, 0, 0); __builtin_amdgcn_s_setprio(0); } while (0)
#define PG8_WAIT_V(n) asm volatile("s_waitcnt vmcnt(" #n ")" ::: "memory")
#define PG8_WAIT_L(n) asm volatile("s_waitcnt lgkmcnt(" #n ")" ::: "memory")
#define PG8_BAR __builtin_amdgcn_s_barrier()
#define PG8_SCHED __builtin_amdgcn_sched_barrier(0)
    Unit cur, nxt; int ui = 0;
    if (!S.next(0, cur)) return;
    f32x4 acc[2][2][4][2];
#pragma unroll
    for (int a = 0; a < 2; ++a)
#pragma unroll
        for (int b = 0; b < 2; ++b)
#pragma unroll
            for (int m = 0; m < 4; ++m)
#pragma unroll
                for (int n = 0; n < 2; ++n) acc[a][b][m][n] = (f32x4){0.f, 0.f, 0.f, 0.f};
    bf16x8 At[4][2], B0[2][2], B1[2][2];
    const char* cA = (const char*)g.A + (size_t)cur.pm * tstep; const char* cB = (const char*)g.Bt + (size_t)cur.pn * tstep;
    S.a_ready(cur);
    if constexpr (SP2) {
        PG8_STAGE(PG8_SB(0, 0), cB, voffB); PG8_STAGE(PG8_SB(0, 1), cB + hstep, voffB); PG8_STAGE(PG8_SA(0, 0), cA, voffA); PG8_STAGE(PG8_SA(0, 1), cA + hstep, voffA);
        if (wr == 1) PG8_BAR;
        PG8_WAIT_V(2); PG8_BAR;
        PG8_STAGE(PG8_SB(1, 0), cB + kstep, voffB); PG8_STAGE(PG8_SA(1, 0), cA + kstep, voffA); PG8_STAGE(PG8_SB(1, 1), cB + hstep + kstep, voffB);
        PG8_WAIT_V(6); PG8_BAR;
    } else {
        PG8_STAGE(PG8_SB(0, 0), cB, voffB); PG8_STAGE(PG8_SA(0, 0), cA, voffA); PG8_STAGE(PG8_SB(0, 1), cB + hstep, voffB); PG8_STAGE(PG8_SA(0, 1), cA + hstep, voffA);
        if (wr == 1) PG8_BAR;
        PG8_WAIT_V(4); PG8_BAR;
        PG8_STAGE(PG8_SB(1, 0), cB + kstep, voffB); PG8_STAGE(PG8_SA(1, 0), cA + kstep, voffA); PG8_STAGE(PG8_SB(1, 1), cB + hstep + kstep, voffB);
        PG8_WAIT_V(6); PG8_BAR;
    }
    for (;;) {
        const bool has_next = S.next(ui + 1, nxt);
        const char* nA = has_next ? (const char*)g.A + (size_t)nxt.pm * tstep : cA; const char* nB = has_next ? (const char*)g.Bt + (size_t)nxt.pn * tstep : cB;
        for (int t = 0; t < nt; t += 2) {
            const bool last = (t == nt - 2);
            const char* a1 = cA + (size_t)(t + 1) * kstep;
            const char* a2 = last ? nA : cA + (size_t)(t + 2) * kstep; const char* b2 = last ? nB : cB + (size_t)(t + 2) * kstep;
            const char* a3 = a2 + kstep; const char* b3 = b2 + kstep;
            if (last && has_next) S.a_ready(nxt);
            if constexpr (SP2) {
            PG8_LDB(B0, 0, 0); PG8_LDB(B1, 0, 1); PG8_SCHED; PG8_LDA(At, 0, 0); PG8_STAGE(PG8_SA(1, 1), a1 + hstep, voffA);
            PG8_WAIT_V(8); PG8_WAIT_L(0); PG8_BAR; PG8_MMA(0, 0, At, B0); PG8_MMA(0, 1, At, B1); PG8_BAR; PG8_SCHED;
            PG8_LDA(At, 0, 1); PG8_STAGE(PG8_SB(0, 0), b2, voffB); PG8_STAGE(PG8_SB(0, 1), b2 + hstep, voffB); PG8_STAGE(PG8_SA(0, 0), a2, voffA);
            PG8_WAIT_V(8); PG8_WAIT_L(0); PG8_BAR; PG8_MMA(1, 0, At, B0); PG8_MMA(1, 1, At, B1); PG8_BAR; PG8_SCHED;
            PG8_LDB(B0, 1, 0); PG8_LDB(B1, 1, 1); PG8_SCHED; PG8_LDA(At, 1, 0); PG8_STAGE(PG8_SA(0, 1), a2 + hstep, voffA);
            PG8_WAIT_V(8); PG8_WAIT_L(0); PG8_BAR; PG8_MMA(0, 0, At, B0); PG8_MMA(0, 1, At, B1); PG8_BAR; PG8_SCHED;
            PG8_LDA(At, 1, 1); PG8_STAGE(PG8_SB(1, 0), b3, voffB); PG8_STAGE(PG8_SB(1, 1), b3 + hstep, voffB); PG8_STAGE(PG8_SA(1, 0), a3, voffA);
            PG8_WAIT_V(8); PG8_WAIT_L(0); PG8_BAR; PG8_MMA(1, 0, At, B0); PG8_MMA(1, 1, At, B1); PG8_BAR; PG8_SCHED;
            } else {
            PG8_LDB(B0, 0, 0); PG8_SCHED; PG8_LDA(At, 0, 0); PG8_STAGE(PG8_SA(1, 1), a1 + hstep, voffA);
            PG8_WAIT_L(8); PG8_BAR; PG8_WAIT_L(0); PG8_MMA(0, 0, At, B0); PG8_BAR; PG8_SCHED;
            PG8_LDB(B1, 0, 1); PG8_STAGE(PG8_SB(0, 0), b2, voffB);
            PG8_BAR; PG8_WAIT_L(0); PG8_MMA(0, 1, At, B1); PG8_BAR;
            PG8_LDA(At, 0, 1); PG8_STAGE(PG8_SA(0, 0), a2, voffA);
            PG8_BAR; PG8_WAIT_L(0); PG8_MMA(1, 0, At, B0); PG8_BAR; PG8_SCHED;
            PG8_STAGE(PG8_SB(0, 1), b2 + hstep, voffB);
            PG8_WAIT_V(6); PG8_BAR; PG8_MMA(1, 1, At, B1); PG8_BAR;
            PG8_LDB(B0, 1, 0); PG8_SCHED; PG8_LDA(At, 1, 0); PG8_STAGE(PG8_SA(0, 1), a2 + hstep, voffA);
            PG8_WAIT_L(8); PG8_BAR; PG8_WAIT_L(0); PG8_MMA(0, 0, At, B0); PG8_BAR; PG8_SCHED;
            PG8_LDB(B1, 1, 1); PG8_STAGE(PG8_SB(1, 0), b3, voffB);
            PG8_BAR; PG8_WAIT_L(0); PG8_MMA(0, 1, At, B1); PG8_BAR;
            PG8_LDA(At, 1, 1); PG8_STAGE(PG8_SA(1, 0), a3, voffA);
            PG8_BAR; PG8_WAIT_L(0); PG8_MMA(1, 0, At, B0); PG8_BAR; PG8_SCHED;
            PG8_STAGE(PG8_SB(1, 1), b3 + hstep, voffB);
            PG8_WAIT_V(6); PG8_BAR; PG8_MMA(1, 1, At, B1); PG8_BAR;
            }
        }
        if constexpr (ALIGN_EPI) { if (wr == 0) PG8_BAR; }
        if constexpr (!Epi::AFTER_DRAIN) { E(acc, cur, wr, wc, fr, fq); S.done(cur); }
        if (!has_next) break;
#pragma unroll
        for (int a = 0; a < 2; ++a)
#pragma unroll
            for (int b = 0; b < 2; ++b)
#pragma unroll
                for (int m = 0; m < 4; ++m)
#pragma unroll
                    for (int n = 0; n < 2; ++n) acc[a][b][m][n] = (f32x4){0.f, 0.f, 0.f, 0.f};
        cur = nxt; cA = nA; cB = nB; ++ui;
        if constexpr (ALIGN_EPI) { if (wr == 1) PG8_BAR; }
    }
    PG8_WAIT_V(0);
    if constexpr (!ALIGN_EPI) { if (wr == 0) PG8_BAR; }
    PG8_BAR;
    if constexpr (Epi::AFTER_DRAIN) { E.fused(acc, cur, wr, wc, fr, fq, lds, wid, lane); S.done(cur); }
#undef PG8_SA
#undef PG8_SB
#undef PG8_STAGE
#undef PG8_LDA
#undef PG8_LDB
#undef PG8_MMA
#undef PG8_WAIT_V
#undef PG8_WAIT_L
#undef PG8_BAR
#undef PG8_SCHED
}
}
#define LAS __attribute__((address_space(3)))
#define XB_TMO      128
#define XB_XCNT(j)  (256  + 64 * (j))
#define XB_XSUB(j)  (1280 + 64 * (j))
#define XB_XGEN(j)  (2304 + 64 * (j))
#define XB_TOP      3328
#define XB_TOPGEN   3392
#define XCD_BAR_WORDS 3456
#define XB_SPIN_CAP (1u << 18)

__device__ __forceinline__ unsigned xb_ld(unsigned* p)              { return __hip_atomic_load(p, __ATOMIC_RELAXED, __HIP_MEMORY_SCOPE_AGENT); }
__device__ __forceinline__ unsigned xb_add(unsigned* p, unsigned v) { return __hip_atomic_fetch_add(p, v, __ATOMIC_RELAXED, __HIP_MEMORY_SCOPE_AGENT); }
__device__ __forceinline__ unsigned xb_xcc_id() { return (unsigned)__builtin_amdgcn_s_getreg((3 << 11) | 20) & 0xFu; }
#define XB_SPIN(cond, bar) do { unsigned _sp = 0; while (cond) { __builtin_amdgcn_s_sleep(1); \
    if ((++_sp & 255u) == 0u) { if (xb_ld(&(bar)[XB_TMO])) break; if (_sp > XB_SPIN_CAP) { atomicAdd(&(bar)[XB_TMO], 1u); break; } } } } while (0)

struct XcdBarrier {
    unsigned* bar; unsigned x;
    volatile LAS unsigned* st;
};

__device__ __forceinline__ XcdBarrier xcd_barrier_post(unsigned* bar, volatile LAS unsigned* st) {
    XcdBarrier b; b.bar = bar; b.x = xb_xcc_id(); b.st = st;
    if (threadIdx.x == 0) (void)xb_add(&bar[XB_XCNT(b.x)], 1u);
    return b;
}
__device__ __forceinline__ void xcd_barrier_complete(unsigned* bar, unsigned x, unsigned& nloc, unsigned& nx) {
    const unsigned G = gridDim.x * gridDim.y * gridDim.z;
    unsigned sum, cnt, mine, sp = 0u;
    for (;;) {
        sum = 0u; cnt = 0u; mine = 0u;
#pragma unroll
        for (unsigned j = 0; j < 16; ++j) { const unsigned c = xb_ld(&bar[XB_XCNT(j)]); sum += c; cnt += (c > 0u) ? 1u : 0u; mine = (j == x) ? c : mine; }
        if (sum == G) break;
        __builtin_amdgcn_s_sleep(1);
        if ((++sp & 255u) == 0u) { if (xb_ld(&bar[XB_TMO])) break; if (sp > XB_SPIN_CAP) { atomicAdd(&bar[XB_TMO], 1u); break; } }
    }
    nloc = mine > 0u ? mine : 1u; nx = cnt > 0u ? cnt : 1u;
}

__device__ __forceinline__ void xcd_barrier(const XcdBarrier& b) {
    asm volatile("s_waitcnt vmcnt(0)" ::: "memory");
    __syncthreads();
    if (threadIdx.x == 0) {
        unsigned* bar = b.bar;
        __builtin_amdgcn_s_waitcnt(0);
        unsigned nloc = b.st[0], nx = b.st[1];
        if (nloc == 0u) { xcd_barrier_complete(bar, b.x, nloc, nx); b.st[0] = nloc; b.st[1] = nx; }
        const unsigned old = xb_add(&bar[XB_XSUB(b.x)], 1u);
        const unsigned gen = old / nloc;
        if (old + 1u == (gen + 1u) * nloc) {
            __builtin_amdgcn_fence(__ATOMIC_RELEASE, "agent");
            asm volatile("s_waitcnt vmcnt(0)" ::: "memory");
            const unsigned og = xb_add(&bar[XB_TOP], 1u);
            const unsigned tg = og / nx;
            if (og + 1u == (tg + 1u) * nx) xb_add(&bar[XB_TOPGEN], 1u);
            else XB_SPIN(xb_ld(&bar[XB_TOPGEN]) == tg, bar);
            __builtin_amdgcn_fence(__ATOMIC_ACQUIRE, "agent");
            xb_add(&bar[XB_XGEN(b.x)], 1u);
            asm volatile("s_waitcnt vmcnt(0)" ::: "memory");
        } else {
            XB_SPIN(xb_ld(&bar[XB_XGEN(b.x)]) == gen, bar);
            __builtin_amdgcn_fence(__ATOMIC_ACQUIRE, "agent");
            asm volatile("s_waitcnt vmcnt(0)" ::: "memory");
        }
    }
    __syncthreads();
}

using pg8::bf16_t; using pg8::f32x4; using pg8::u32x4; using pg8::bf16x8; using pg8::pk_h2; using pg8::h_lo; using pg8::h_hi;
typedef unsigned u32x2v __attribute__((ext_vector_type(2)));
constexpr int DM = 1024, NPR = 16384, NSM = 128, MT = 16640, NVALID = 16512, SEQ = 2048;
constexpr int HW = 512, NIN = 2560, DFF = 2816, NFF2 = 5632, MEMR = 2048;
constexpr float EPS = 1e-6f;
constexpr int NTHREADS = 512;
constexpr int LDS_BYTES = 147456;

constexpr size_t O_YP = 0, O_YS = 16777216, O_HP = 16908288, O_PP = 17432576, O_MK = 17494016, O_MV = 19591168, O_HS = 21688320, O_PS = 30076928;

constexpr size_t MiB = 1u << 20;
constexpr size_t WS_SS1 = 0, WS_SS2 = 128 * 1024, WS_SS3 = 256 * 1024, WS_BAR = 512 * 1024, BAR_BYTES = 16384, WS_SSD = 384 * 1024;
constexpr size_t WS_WIN = 1 * MiB, WS_WOUT = 6 * MiB, WS_WCQ = 8 * MiB, WS_WCO = 10 * MiB, WS_WFFI = 12 * MiB, WS_WFFO = 23 * MiB, WS_WKV = 29 * MiB, WS_PMIX = 33 * MiB;
constexpr size_t WS_MEMH = 34 * MiB, WS_KB = 38 * MiB, WS_VT = 42 * MiB, WS_DEC = 46 * MiB;
constexpr size_t WS_H0 = 47 * MiB;
constexpr size_t WS_MIX = 80 * MiB;
constexpr size_t WS_X1 = 113 * MiB;
constexpr size_t WS_Q = 178 * MiB;
constexpr size_t WS_O = 211 * MiB;
constexpr size_t WS_SL = 244 * MiB;
constexpr size_t WS_A = 309 * MiB;
constexpr size_t WS_QQ = WS_A, WS_KK = WS_A + 17 * MiB, WS_VV = WS_A + 34 * MiB, WS_GG = WS_A + 51 * MiB, WS_LF = WS_A + 68 * MiB, WS_UU = WS_A + 101 * MiB;
constexpr size_t WS_END = 443 * MiB;

struct Args { const float* in[23]; float* out; unsigned char* ws; int ph_lo, ph_hi; };

__device__ __forceinline__ unsigned f2bf(float f) { unsigned u = __builtin_bit_cast(unsigned, f); return (u + 0x7fffu + ((u >> 16) & 1u)) >> 16; }
__device__ __forceinline__ unsigned pk2(float lo, float hi) { return f2bf(lo) | (f2bf(hi) << 16); }
__device__ __forceinline__ float bf2f(unsigned h) { return __uint_as_float(h << 16); }
__device__ __forceinline__ float bfe(const u32x4& v, int j) { const unsigned w = v[j >> 1]; return (j & 1) ? __uint_as_float(w & 0xffff0000u) : __uint_as_float(w << 16); }
__device__ __forceinline__ unsigned short bfr(const u32x4& v, int j) { const unsigned w = v[j >> 1]; return (unsigned short)((j & 1) ? (w >> 16) : (w & 0xffffu)); }
__device__ __forceinline__ float wave_sum(float v) {
#pragma unroll
    for (int o = 1; o < 64; o <<= 1) v += __shfl_xor(v, o);
    return v;
}
#define MFMA16(a, b, c) __builtin_amdgcn_mfma_f32_16x16x32_bf16((a), (b), (c), 0, 0, 0)

template <int MODE>
__device__ __forceinline__ void tr_item(const float* W, int K, int N, bf16_t* WT, const float* gk, float* scr, int item, int lane) {
    const int nblk = N / 32, kb = item / nblk, nb = item % nblk, k0 = 64 * kb, n0 = 32 * nb;
    float wv[32];
#pragma unroll
    for (int i = 0; i < 32; ++i) { const int kk = 2 * i + (lane >> 5); wv[i] = W[(size_t)(k0 + kk) * N + n0 + (lane & 31)]; }
#pragma unroll
    for (int i = 0; i < 32; ++i) { const int kk = 2 * i + (lane >> 5); scr[kk * 33 + (lane & 31)] = wv[i]; }
    asm volatile("s_waitcnt lgkmcnt(0)" ::: "memory");
    const int c = lane & 7;
    float g8[8];
#pragma unroll
    for (int i = 0; i < 8; ++i) g8[i] = gk ? gk[k0 + 8 * c + i] : 1.0f;
#pragma unroll
    for (int j = 0; j < 4; ++j) { const int n = (lane >> 3) + 8 * j; const float* s = scr + (8 * c) * 33 + n;
        u32x4 o; o.x = pk2(s[0 * 33] * g8[0], s[1 * 33] * g8[1]); o.y = pk2(s[2 * 33] * g8[2], s[3 * 33] * g8[3]); o.z = pk2(s[4 * 33] * g8[4], s[5 * 33] * g8[5]); o.w = pk2(s[6 * 33] * g8[6], s[7 * 33] * g8[7]);
        int row = n0 + n;
        if (MODE == 1) { const int half = row >= DFF ? 1 : 0; const int J = row - half * DFF;
            row = 256 * (J >> 7) + 128 * ((J >> 6) & 1) + 32 * ((J >> 4) & 3) + 8 * ((J >> 2) & 3) + 4 * half + (J & 3); }
        *(u32x4*)(WT + (size_t)row * K + k0 + 8 * c) = o; }
    asm volatile("s_waitcnt lgkmcnt(0)" ::: "memory");
}
__device__ __forceinline__ void rms_row_to_bf16(const float* xrow, const float* g, bf16_t* orow, int lane) {
    const f32x4* xr = (const f32x4*)xrow + lane; const f32x4* gr = (const f32x4*)g + lane;
    f32x4 v[4]; float s = 0.f;
#pragma unroll
    for (int j = 0; j < 4; ++j) { v[j] = xr[64 * j]; s += (v[j].x * v[j].x + v[j].y * v[j].y) + (v[j].z * v[j].z + v[j].w * v[j].w); }
    const float rstd = 1.0f / sqrtf(wave_sum(s) * (1.f / DM) + EPS);
    unsigned long long* o8 = (unsigned long long*)orow + lane;
#pragma unroll
    for (int j = 0; j < 4; ++j) { const f32x4 gg = gr[64 * j];
        o8[64 * j] = (unsigned long long)pk2(v[j].x * rstd * gg.x, v[j].y * rstd * gg.y) | ((unsigned long long)pk2(v[j].z * rstd * gg.z, v[j].w * rstd * gg.w) << 32); }
}
__device__ __forceinline__ void rms_row2_to_bf16(const float* xrow, const float* g, bf16_t* orow, int lane) {
    const f32x4* xr = (const f32x4*)xrow + lane; const f32x4* gr = (const f32x4*)g + lane;
    f32x4 v[2][4]; float s[2] = {0.f, 0.f};
#pragma unroll
    for (int r = 0; r < 2; ++r)
#pragma unroll
        for (int j = 0; j < 4; ++j) v[r][j] = xr[r * 256 + 64 * j];
#pragma unroll
    for (int r = 0; r < 2; ++r)
#pragma unroll
        for (int j = 0; j < 4; ++j) s[r] += (v[r][j].x * v[r][j].x + v[r][j].y * v[r][j].y) + (v[r][j].z * v[r][j].z + v[r][j].w * v[r][j].w);
#pragma unroll
    for (int r = 0; r < 2; ++r) { const float rstd = 1.0f / sqrtf(wave_sum(s[r]) * (1.f / DM) + EPS); unsigned long long* o8 = (unsigned long long*)(orow + (size_t)r * DM) + lane;
#pragma unroll
        for (int j = 0; j < 4; ++j) { const f32x4 gg = gr[64 * j];
            o8[64 * j] = (unsigned long long)pk2(v[r][j].x * rstd * gg.x, v[r][j].y * rstd * gg.y) | ((unsigned long long)pk2(v[r][j].z * rstd * gg.z, v[r][j].w * rstd * gg.w) << 32); } }
}
__device__ __forceinline__ void p0_prologue(const Args& A, unsigned char* lds, int G) {
    const int tid = threadIdx.x, lane = tid & 63, wave = tid >> 6;
    float* scr = (float*)(lds + wave * 16384);
    unsigned char* ws = A.ws;
    const int gw = blockIdx.x * 8 + wave, NGW = G * 8;
    constexpr int I_IN = 16 * 80, I_OUT = 16 * 32, I_CQ = 16 * 32, I_CO = 16 * 32, I_FFI = 16 * 176, I_FFO = 44 * 32, I_KV = 16 * 64, I_PM = 4 * 8;
    constexpr int NITEMS = I_IN + I_OUT + I_CQ + I_CO + I_FFI + I_FFO + I_KV + I_PM;
    for (int it = gw; it < NITEMS; it += NGW) {
        int r = it;
        if (r < I_IN) { tr_item<0>(A.in[8], DM, NIN, (bf16_t*)(ws + WS_WIN), nullptr, scr, r, lane); continue; } r -= I_IN;
        if (r < I_OUT) { tr_item<0>(A.in[13], DM, DM, (bf16_t*)(ws + WS_WOUT), nullptr, scr, r, lane); continue; } r -= I_OUT;
        if (r < I_CQ) { tr_item<0>(A.in[17], DM, DM, (bf16_t*)(ws + WS_WCQ), A.in[16], scr, r, lane); continue; } r -= I_CQ;
        if (r < I_CO) { tr_item<0>(A.in[18], DM, DM, (bf16_t*)(ws + WS_WCO), nullptr, scr, r, lane); continue; } r -= I_CO;
        if (r < I_FFI) { tr_item<1>(A.in[20], DM, NFF2, (bf16_t*)(ws + WS_WFFI), A.in[19], scr, r, lane); continue; } r -= I_FFI;
        if (r < I_FFO) { tr_item<0>(A.in[21], DFF, DM, (bf16_t*)(ws + WS_WFFO), nullptr, scr, r, lane); continue; } r -= I_FFO;
        if (r < I_KV) { tr_item<0>(A.in[15], DM, 2 * DM, (bf16_t*)(ws + WS_WKV), nullptr, scr, r, lane); continue; } r -= I_KV;
        { const int g = r >> 3; tr_item<0>(A.in[11] + (size_t)g * 128 * 128, 128, 128, (bf16_t*)(ws + WS_PMIX) + (size_t)g * 128 * 128, nullptr, scr, r & 7, lane); }
    }
    bf16_t* H0 = (bf16_t*)(ws + WS_H0);
    for (int m = gw * 2; m < NVALID; m += NGW * 2) { const float* xr = m < NPR ? A.in[0] + (size_t)m * DM : A.in[1] + (size_t)(m - NPR) * DM; rms_row2_to_bf16(xr, A.in[7], H0 + (size_t)m * DM, lane); }
    bf16_t* MEMH = (bf16_t*)(ws + WS_MEMH);
    for (int m = gw; m < MEMR; m += NGW) rms_row_to_bf16(A.in[2] + (size_t)m * DM, A.in[14], MEMH + (size_t)m * DM, lane);
    const int gt = blockIdx.x * NTHREADS + tid, NGT = G * NTHREADS;
    for (int i = gt; i < (MT - NVALID) * DM / 8; i += NGT) { const u32x4 z = {0u, 0u, 0u, 0u};
        ((u32x4*)(ws + WS_H0) + (size_t)NVALID * DM / 8)[i] = z; ((u32x4*)(ws + WS_MIX) + (size_t)NVALID * DM / 8)[i] = z; ((u32x4*)(ws + WS_O) + (size_t)NVALID * DM / 8)[i] = z; }
    for (int i = gt; i < MT; i += NGT) { ((float*)(ws + WS_SS1))[i] = 0.f; ((float*)(ws + WS_SS2))[i] = 0.f; ((float*)(ws + WS_SS3))[i] = 0.f; }
}

constexpr int BS = 129;
constexpr int L_BC = 0, L_TOT = 33024, L_QM = 35072, L_KM = 52480, L_VT = 69888, L_SP = 88320, L_AL = 123136, L_PART = 132352, L_EM = 132864;
constexpr size_t WS_SPT = WS_X1;
__device__ __forceinline__ void hgrn_lf_load(u32x2v (&lf)[4], const unsigned short* LF, int R0, int C0, int t) {
#pragma unroll
    for (int i = 0; i < 4; ++i) { const int idx = i * 512 + t, s = idx >> 5, k4 = idx & 31; lf[i] = *(const u32x2v*)(LF + (size_t)(R0 + s) * HW + C0 + k4 * 4); }
}
__device__ __forceinline__ void hgrn_cumsum(const u32x2v (&lf)[4], float* Bc, float* tot, int t) {
#pragma unroll
    for (int i = 0; i < 4; ++i) { const int idx = i * 512 + t, s = idx >> 5, k4 = idx & 31; const u32x2v v = lf[i];
        float* d = Bc + s * BS + k4 * 4; d[0] = h_lo(v.x); d[1] = h_hi(v.x); d[2] = h_lo(v.y); d[3] = h_hi(v.y); }
    __syncthreads();
    const int seg = t >> 7, k = t & 127; float run = 0.f;
#pragma unroll
    for (int i = 0; i < 16; ++i) { run += Bc[(seg * 16 + i) * BS + k]; Bc[(seg * 16 + i) * BS + k] = run; }
    tot[seg * 128 + k] = run;
    __syncthreads();
    float off = 0.f;
#pragma unroll
    for (int j = 0; j < 3; ++j) off += (j < seg) ? tot[j * 128 + k] : 0.f;
#pragma unroll
    for (int i = 0; i < 16; ++i) Bc[(seg * 16 + i) * BS + k] += off;
    __syncthreads();
}
__device__ __forceinline__ void hgrn_local_unit(const Args& A, unsigned char* lds, int unit) {
    const int t = threadIdx.x, w = t >> 6, l = t & 63, lr = l & 15, lq = l >> 4;
    const int bh = unit >> 5, c = unit & 31, b = bh >> 2, h = bh & 3, R0 = b * SEQ + c * 64, C0 = h * 128;
    unsigned char* ws = A.ws;
    float* Bc = (float*)(lds + L_BC); float* tot = (float*)(lds + L_TOT);
    bf16_t* kdT = (bf16_t*)(lds + L_QM); bf16_t* vT = (bf16_t*)(lds + L_VT);
    const bf16_t* KK = (const bf16_t*)(ws + WS_KK); const bf16_t* VV = (const bf16_t*)(ws + WS_VV);
    u32x2v lf[4]; u32x4 kkr[2], vvr[2];
    hgrn_lf_load(lf, (const unsigned short*)(ws + WS_LF), R0, C0, t);
#pragma unroll
    for (int i = 0; i < 2; ++i) { const int k0 = (w + 8 * i) * 8; kkr[i] = *(const u32x4*)(KK + (size_t)(R0 + l) * HW + C0 + k0); vvr[i] = *(const u32x4*)(VV + (size_t)(R0 + l) * HW + C0 + k0); }
    hgrn_cumsum(lf, Bc, tot, t);
#pragma unroll
    for (int i = 0; i < 2; ++i) { const int s = l, k0 = (w + 8 * i) * 8;
        const u32x4 kk = kkr[i], vv = vvr[i];
#pragma unroll
        for (int j = 0; j < 8; ++j) { const float e = __expf(Bc[63 * BS + k0 + j] - Bc[s * BS + k0 + j]);
            kdT[(k0 + j) * 72 + s] = (bf16_t)f2bf(bfe(kk, j) * e); vT[(k0 + j) * 72 + s] = bfr(vv, j); } }
    __syncthreads();
    f32x4 acc[8];
#pragma unroll
    for (int i = 0; i < 8; ++i) acc[i] = (f32x4){0.f, 0.f, 0.f, 0.f};
#pragma unroll
    for (int ks = 0; ks < 2; ++ks) { const bf16x8 a = *(const bf16x8*)(kdT + (16 * w + lr) * 72 + ks * 32 + lq * 8);
#pragma unroll
        for (int vt = 0; vt < 8; ++vt) { const bf16x8 bb = *(const bf16x8*)(vT + (16 * vt + lr) * 72 + ks * 32 + lq * 8); acc[vt] = MFMA16(a, bb, acc[vt]); } }
    unsigned short* SLT = (unsigned short*)(ws + WS_SL) + (size_t)unit * 16384;
#pragma unroll
    for (int vt = 0; vt < 8; ++vt) { u32x2v o; o.x = pk_h2(acc[vt][0], acc[vt][1]); o.y = pk_h2(acc[vt][2], acc[vt][3]); *(u32x2v*)(SLT + (16 * vt + lr) * 128 + 16 * w + lq * 4) = o; }
    if (t < 128) ((float*)(ws + WS_DEC))[unit * 128 + t] = __expf(Bc[63 * BS + t]);
    __syncthreads();
}
__device__ __forceinline__ void hgrn_out_unit(const Args& A, unsigned char* lds, int unit) {
    const int t = threadIdx.x, w = t >> 6, l = t & 63, lr = l & 15, lq = l >> 4;
    const int bh = unit >> 5, c = unit & 31, b = bh >> 2, h = bh & 3, R0 = b * SEQ + c * 64, C0 = h * 128;
    unsigned char* ws = A.ws;
    float* Bc = (float*)(lds + L_BC); float* tot = (float*)(lds + L_TOT); float* part = (float*)(lds + L_PART); float* em = (float*)(lds + L_EM);
    bf16_t* qm = (bf16_t*)(lds + L_QM); bf16_t* km = (bf16_t*)(lds + L_KM); bf16_t* vT = (bf16_t*)(lds + L_VT); bf16_t* spT = (bf16_t*)(lds + L_SP); bf16_t* aL = (bf16_t*)(lds + L_AL);
    const bf16_t* QQ = (const bf16_t*)(ws + WS_QQ); const bf16_t* KK = (const bf16_t*)(ws + WS_KK); const bf16_t* VV = (const bf16_t*)(ws + WS_VV);
    u32x2v lf[4]; u32x4 qqr[2], kkr[2], vvr[2], spr[4], ggr[2];
    hgrn_lf_load(lf, (const unsigned short*)(ws + WS_LF), R0, C0, t);
#pragma unroll
    for (int i = 0; i < 2; ++i) { const int idx = (i * 512 + t) * 8, s = idx >> 7, k0 = idx & 127; const size_t go = (size_t)(R0 + s) * HW + C0 + k0; qqr[i] = *(const u32x4*)(QQ + go); kkr[i] = *(const u32x4*)(KK + go);
        vvr[i] = *(const u32x4*)(VV + (size_t)(R0 + l) * HW + C0 + (w + 8 * i) * 8); }
    {   const bf16_t* SPT = (const bf16_t*)(ws + WS_SPT) + (size_t)unit * 16384;
#pragma unroll
        for (int i = 0; i < 4; ++i) { const int idx = i * 512 + t; spr[i] = *(const u32x4*)(SPT + (idx >> 4) * 128 + (idx & 15) * 8); }
#pragma unroll
        for (int hh = 0; hh < 2; ++hh) ggr[hh] = *(const u32x4*)((const bf16_t*)(ws + WS_GG) + (size_t)(R0 + (t >> 3)) * HW + C0 + (t & 7) * 16 + hh * 8); }
    hgrn_cumsum(lf, Bc, tot, t);
    if (t < 128) em[t] = __expf(Bc[31 * BS + t]);
#pragma unroll
    for (int i = 0; i < 2; ++i) { const int idx = (i * 512 + t) * 8, s = idx >> 7, k0 = idx & 127;
        const u32x4 qq = qqr[i], kk = kkr[i];
        float qv[8], kv[8];
#pragma unroll
        for (int j = 0; j < 8; ++j) { const float d = Bc[s * BS + k0 + j] - Bc[31 * BS + k0 + j]; qv[j] = bfe(qq, j) * __expf(d); kv[j] = bfe(kk, j) * __expf(-d); }
        u32x4 o; o.x = pk2(qv[0], qv[1]); o.y = pk2(qv[2], qv[3]); o.z = pk2(qv[4], qv[5]); o.w = pk2(qv[6], qv[7]); *(u32x4*)(qm + s * 136 + k0) = o;
        o.x = pk2(kv[0], kv[1]); o.y = pk2(kv[2], kv[3]); o.z = pk2(kv[4], kv[5]); o.w = pk2(kv[6], kv[7]); *(u32x4*)(km + s * 136 + k0) = o; }
#pragma unroll
    for (int i = 0; i < 2; ++i) { const int s = l, k0 = (w + 8 * i) * 8; const u32x4 vv = vvr[i];
#pragma unroll
        for (int j = 0; j < 8; ++j) vT[(k0 + j) * 72 + s] = bfr(vv, j); }
    __syncthreads();
    {
#pragma unroll
        for (int i = 0; i < 4; ++i) { const int idx = i * 512 + t, v = idx >> 4, k0 = (idx & 15) * 8; const u32x4 sv = spr[i];
            u32x4 o; o.x = pk2(bfe(sv, 0) * em[k0], bfe(sv, 1) * em[k0 + 1]); o.y = pk2(bfe(sv, 2) * em[k0 + 2], bfe(sv, 3) * em[k0 + 3]); o.z = pk2(bfe(sv, 4) * em[k0 + 4], bfe(sv, 5) * em[k0 + 5]); o.w = pk2(bfe(sv, 6) * em[k0 + 6], bfe(sv, 7) * em[k0 + 7]);
            *(u32x4*)(spT + v * 136 + k0) = o; } }
    {
        const int ct = w & 3;
        f32x4 a2[2]; a2[0] = (f32x4){0.f, 0.f, 0.f, 0.f}; a2[1] = a2[0];
#pragma unroll
        for (int ks = 0; ks < 4; ++ks) { const bf16x8 a = *(const bf16x8*)(qm + (16 * ct + lr) * 136 + ks * 32 + lq * 8);
#pragma unroll
            for (int i = 0; i < 2; ++i) { const int st = (w >> 2) * 2 + i; const bf16x8 bb = *(const bf16x8*)(km + (16 * st + lr) * 136 + ks * 32 + lq * 8); a2[i] = MFMA16(a, bb, a2[i]); } }
#pragma unroll
        for (int i = 0; i < 2; ++i) { const int st = (w >> 2) * 2 + i, s = 16 * st + lr;
#pragma unroll
            for (int r = 0; r < 4; ++r) { const int cc = 16 * ct + lq * 4 + r; aL[cc * 72 + s] = (bf16_t)f2bf(s <= cc ? a2[i][r] : 0.f); } }
    }
    __syncthreads();
    const int ct = w & 3, vh = w >> 2;
    f32x4 o4[4];
#pragma unroll
    for (int i = 0; i < 4; ++i) o4[i] = (f32x4){0.f, 0.f, 0.f, 0.f};
#pragma unroll
    for (int ks = 0; ks < 4; ++ks) { const bf16x8 a = *(const bf16x8*)(qm + (16 * ct + lr) * 136 + ks * 32 + lq * 8);
#pragma unroll
        for (int i = 0; i < 4; ++i) { const int vt = vh * 4 + i; const bf16x8 bb = *(const bf16x8*)(spT + (16 * vt + lr) * 136 + ks * 32 + lq * 8); o4[i] = MFMA16(a, bb, o4[i]); } }
#pragma unroll
    for (int ks = 0; ks < 2; ++ks) { const bf16x8 a = *(const bf16x8*)(aL + (16 * ct + lr) * 72 + ks * 32 + lq * 8);
#pragma unroll
        for (int i = 0; i < 4; ++i) { const int vt = vh * 4 + i; const bf16x8 bb = *(const bf16x8*)(vT + (16 * vt + lr) * 72 + ks * 32 + lq * 8); o4[i] = MFMA16(a, bb, o4[i]); } }
    float* ost = (float*)(lds + L_BC);
#pragma unroll
    for (int r = 0; r < 4; ++r) { float s = 0.f;
#pragma unroll
        for (int i = 0; i < 4; ++i) { s += o4[i][r] * o4[i][r]; ost[(16 * ct + lq * 4 + r) * 132 + (vh * 4 + i) * 16 + lr] = o4[i][r]; }
        s += __shfl_xor(s, 1); s += __shfl_xor(s, 2); s += __shfl_xor(s, 4); s += __shfl_xor(s, 8);
        if (lr == 0) part[vh * 64 + 16 * ct + lq * 4 + r] = s; }
    __syncthreads();
    {   const float* hn = A.in[10]; bf16_t* MIX = (bf16_t*)(ws + WS_MIX);
        const int cc = t >> 3, v0 = (t & 7) * 16; const float rstd = __builtin_amdgcn_rsqf((part[cc] + part[64 + cc]) * (1.0f / 128.0f) + EPS);
#pragma unroll
        for (int hh = 0; hh < 2; ++hh) { const int v = v0 + hh * 8; const u32x4 g8 = ggr[hh];
            const f32x4 oa = *(const f32x4*)(ost + cc * 132 + v), ob = *(const f32x4*)(ost + cc * 132 + v + 4), na = *(const f32x4*)(hn + C0 + v), nb = *(const f32x4*)(hn + C0 + v + 4);
            u32x4 o; o.x = pk2(oa[0] * rstd * na[0] * bfe(g8, 0), oa[1] * rstd * na[1] * bfe(g8, 1)); o.y = pk2(oa[2] * rstd * na[2] * bfe(g8, 2), oa[3] * rstd * na[3] * bfe(g8, 3));
            o.z = pk2(ob[0] * rstd * nb[0] * bfe(g8, 4), ob[1] * rstd * nb[1] * bfe(g8, 5)); o.w = pk2(ob[2] * rstd * nb[2] * bfe(g8, 6), ob[3] * rstd * nb[3] * bfe(g8, 7));
            *(u32x4*)(MIX + (size_t)(R0 + cc) * DM + C0 + v) = o; } }
    __syncthreads();
}
__device__ __forceinline__ void hgrn_scan(const Args& A, int G) {
    const u32x2v* SLT = (const u32x2v*)(A.ws + WS_SL); const f32x4* DEC4 = (const f32x4*)(A.ws + WS_DEC); u32x2v* SPT = (u32x2v*)(A.ws + WS_SPT); float* outp = A.out + O_HP;
    for (int e = blockIdx.x * NTHREADS + threadIdx.x; e < 32 * 4096; e += G * NTHREADS) { const int bh = e >> 12, i4 = e & 4095, v = i4 >> 5, k4 = i4 & 31;
        f32x4 S = (f32x4){0.f, 0.f, 0.f, 0.f};
        const u32x2v* p = SLT + (size_t)bh * 32 * 4096 + i4; u32x2v* q = SPT + (size_t)bh * 32 * 4096 + i4; const f32x4* dp = DEC4 + (size_t)bh * 32 * 32 + k4;
#pragma unroll
        for (int hf = 0; hf < 2; ++hf) { u32x2v loc[16]; f32x4 dd[16];
#pragma unroll
            for (int c = 0; c < 16; ++c) { loc[c] = p[(size_t)(hf * 16 + c) * 4096]; dd[c] = dp[(hf * 16 + c) * 32]; }
#pragma unroll
            for (int c = 0; c < 16; ++c) { u32x2v o; o.x = pk2(S[0], S[1]); o.y = pk2(S[2], S[3]); q[(size_t)(hf * 16 + c) * 4096] = o; const f32x4 lv = (f32x4){h_lo(loc[c].x), h_hi(loc[c].x), h_lo(loc[c].y), h_hi(loc[c].y)}; S = S * dd[c] + lv; } }
        float* ob = outp + (size_t)bh * 16384 + (k4 * 4) * 128 + v; ob[0] = S[0]; ob[128] = S[1]; ob[256] = S[2]; ob[384] = S[3]; }
}
__device__ __forceinline__ void pool_states(const Args& A, int G) {
    const _Float16* UU = (const _Float16*)(A.ws + WS_UU);
    const int gt = blockIdx.x * NTHREADS + threadIdx.x, NGT = G * NTHREADS;
    for (int i = gt; i < 8 * 15 * 512; i += NGT) { const int cch = i & 511, j = (i >> 9) % 15, b = i / (15 * 512); A.out[O_PP + i] = (float)UU[(size_t)(b * SEQ + 2033 + j) * HW + cch]; }
    for (int i = gt; i < 128 * 15 * 512; i += NGT) { const int cch = i & 511, j = (i >> 9) % 15, b = i / (15 * 512);
        A.out[O_PS + i] = (j < 14) ? A.in[4][(size_t)(b * 15 + j + 1) * 512 + cch] : (float)UU[(size_t)(NPR + b) * HW + cch]; }
}
__device__ __forceinline__ void hgrn_sample_unit(const Args& A, unsigned char* lds, int unit) {
    const int t = threadIdx.x, b = unit >> 2, h = unit & 3, row = NPR + b, C0 = h * 128;
    unsigned char* ws = A.ws;
    float* qs = (float*)lds; float* ks = qs + 128; float* fs = ks + 128; float* vs = fs + 128; float* po = vs + 128;
    float* red = po + 16 * 128;
    const float* S0 = A.in[3] + (size_t)unit * 16384; float* S1 = A.out + O_HS + (size_t)unit * 16384;
    f32x4 sreg[8];
#pragma unroll
    for (int i = 0; i < 8; ++i) sreg[i] = *(const f32x4*)(S0 + ((t >> 5) * 8 + i) * 128 + (t & 31) * 4);
    if (t < 128) { const size_t go = (size_t)row * HW + C0 + t;
        qs[t] = bf2f(((const bf16_t*)(ws + WS_QQ))[go]); ks[t] = bf2f(((const bf16_t*)(ws + WS_KK))[go]); fs[t] = __expf((float)__builtin_bit_cast(_Float16, ((const unsigned short*)(ws + WS_LF))[go])); vs[t] = bf2f(((const bf16_t*)(ws + WS_VV))[go]); }
    __syncthreads();
    const int v4 = t & 31, kg = t >> 5;
    const f32x4 vv = *(const f32x4*)(vs + v4 * 4);
    f32x4 o = (f32x4){0.f, 0.f, 0.f, 0.f};
#pragma unroll
    for (int i = 0; i < 8; ++i) { const int k = kg * 8 + i; const f32x4 s = sreg[i]; const f32x4 sn = s * fs[k] + vv * ks[k]; *(f32x4*)(S1 + k * 128 + v4 * 4) = sn; o += sn * qs[k]; }
    *(f32x4*)(po + kg * 128 + v4 * 4) = o;
    __syncthreads();
    float ov = 0.f;
    if (t < 128) {
#pragma unroll
        for (int i = 0; i < 16; ++i) ov += po[i * 128 + t];
        const float sq = wave_sum(ov * ov); if ((t & 63) == 0) red[t >> 6] = sq; }
    __syncthreads();
    if (t < 128) { const float rstd = __builtin_amdgcn_rsqf((red[0] + red[1]) * (1.0f / 128.0f) + EPS); const float g = bf2f(((const bf16_t*)(ws + WS_GG))[(size_t)row * HW + C0 + t]);
        ((bf16_t*)(ws + WS_MIX))[(size_t)row * DM + C0 + t] = (bf16_t)f2bf(ov * rstd * A.in[10][C0 + t] * g); }
    __syncthreads();
}

constexpr int LP_EXT = 0, LP_PL = 40448, LP_MX = 57856;
__device__ __forceinline__ void pool_unit(const Args& A, unsigned char* lds, int unit) {
    const int t = threadIdx.x, w = t >> 6, l = t & 63, lr = l & 15, lq = l >> 4;
    const int tt = unit >> 2, g = unit & 3, win = 2 << g;
    unsigned char* ws = A.ws;
    float* ext = (float*)(lds + LP_EXT); bf16_t* pl = (bf16_t*)(lds + LP_PL); bf16_t* mx = (bf16_t*)(lds + LP_MX);
    const unsigned short* UU = (const unsigned short*)(ws + WS_UU);
    u32x4 mreg[4]; u32x2v ereg[5];
    {
        const bf16_t* PM = (const bf16_t*)(ws + WS_PMIX) + (size_t)g * 16384;
#pragma unroll
        for (int i = 0; i < 4; ++i) { const int idx = i * 512 + t, d = idx >> 4, c8 = idx & 15; mreg[i] = *(const u32x4*)(PM + d * 128 + c8 * 8); }
        { const int b = tt >> 5, t0 = (tt & 31) * 64;
#pragma unroll
            for (int i5 = 0; i5 < 5; ++i5) { const int idx = i5 * 512 + t, i = idx >> 5, c4 = idx & 31; const int tp = t0 - 15 + i;
                ereg[i5] = (u32x2v){0u, 0u}; if (idx < 79 * 32 && tp >= 0) ereg[i5] = *(const u32x2v*)(UU + (size_t)(b * SEQ + tp) * HW + g * 128 + c4 * 4); } }
#pragma unroll
        for (int i = 0; i < 4; ++i) { const int idx = i * 512 + t, d = idx >> 4, c8 = idx & 15; *(u32x4*)(mx + d * 136 + c8 * 8) = mreg[i]; }
    }
    int rowbase;
    {
        const int b = tt >> 5, t0 = (tt & 31) * 64; rowbase = b * SEQ + t0;
#pragma unroll
        for (int i5 = 0; i5 < 5; ++i5) { const int idx = i5 * 512 + t, i = idx >> 5, c4 = idx & 31; if (idx < 79 * 32) *(f32x4*)(ext + i * 128 + c4 * 4) = (f32x4){h_lo(ereg[i5].x), h_hi(ereg[i5].x), h_lo(ereg[i5].y), h_hi(ereg[i5].y)}; }
        __syncthreads();
        const int cch = t & 127, tg = t >> 7;
#pragma unroll 4
        for (int i = 0; i < 16; ++i) { const int tok = tg * 16 + i; float s = 0.f;
            for (int j = 0; j < win; ++j) s += ext[(15 + tok - j) * 128 + cch];
            const int cnt = min(t0 + tok + 1, win);
            pl[tok * 136 + cch] = (bf16_t)f2bf(s / (float)cnt - ext[(15 + tok) * 128 + cch]); }
    }
    __syncthreads();
    const int ct = w & 3, dh = w >> 2;
    f32x4 o4[4];
#pragma unroll
    for (int i = 0; i < 4; ++i) o4[i] = (f32x4){0.f, 0.f, 0.f, 0.f};
#pragma unroll
    for (int ks = 0; ks < 4; ++ks) { const bf16x8 a = *(const bf16x8*)(pl + (16 * ct + lr) * 136 + ks * 32 + lq * 8);
#pragma unroll
        for (int i = 0; i < 4; ++i) { const int dt = dh * 4 + i; const bf16x8 bb = *(const bf16x8*)(mx + (16 * dt + lr) * 136 + ks * 32 + lq * 8); o4[i] = MFMA16(a, bb, o4[i]); } }
    bf16_t* MIX = (bf16_t*)(ws + WS_MIX); const float* psc = A.in[12];
    float* ost = (float*)(lds + LP_EXT);
#pragma unroll
    for (int i = 0; i < 4; ++i) { const int d = (dh * 4 + i) * 16 + lr; const float sc = psc[g * 128 + d];
#pragma unroll
        for (int r = 0; r < 4; ++r) ost[(16 * ct + lq * 4 + r) * 132 + d] = o4[i][r] * sc; }
    __syncthreads();
    {   const int tok = t >> 3, d0 = (t & 7) * 16;
#pragma unroll
        for (int hh = 0; hh < 2; ++hh) { const f32x4 oa = *(const f32x4*)(ost + tok * 132 + d0 + hh * 8), ob = *(const f32x4*)(ost + tok * 132 + d0 + hh * 8 + 4);
            u32x4 o; o.x = pk2(oa[0], oa[1]); o.y = pk2(oa[2], oa[3]); o.z = pk2(ob[0], ob[1]); o.w = pk2(ob[2], ob[3]);
            *(u32x4*)(MIX + (size_t)(rowbase + tok) * DM + 512 + g * 128 + d0 + hh * 8) = o; } }
    __syncthreads();
}

__device__ __forceinline__ void pool_sample_unit(const Args& A, unsigned char* lds, int unit) {
    const int t = threadIdx.x, w = t >> 6, l = t & 63, lr = l & 15, lq = l >> 4;
    const int su = unit >> 2, g = unit & 3, win = 2 << g;
    unsigned char* ws = A.ws;
    bf16_t* pl = (bf16_t*)(lds + LP_PL); bf16_t* mx = (bf16_t*)(lds + LP_MX);
    const _Float16* UU = (const _Float16*)(ws + WS_UU);
    const bf16_t* PM = (const bf16_t*)(ws + WS_PMIX) + (size_t)g * 16384;
    u32x4 mreg[4];
#pragma unroll
    for (int i = 0; i < 4; ++i) { const int idx = i * 512 + t, d = idx >> 4, c8 = idx & 15; mreg[i] = *(const u32x4*)(PM + d * 128 + c8 * 8); }
    const int cch = t & 127, sq = t >> 7;
    const float psc_w = A.in[12][g * 128 + 16 * w + lr];
#pragma unroll
    for (int i = 0; i < 4; ++i) { const int tok = sq * 4 + i, sb = su * 16 + tok; const float uv = (float)UU[(size_t)(NPR + sb) * HW + g * 128 + cch];
        float pv[15];
#pragma unroll
        for (int j = 0; j < 15; ++j) pv[j] = A.in[4][(size_t)(sb * 15 + j) * 512 + g * 128 + cch];
        float sacc = uv;
#pragma unroll
        for (int j = 0; j < 15; ++j) sacc += (j >= 16 - win) ? pv[j] : 0.f;
        pl[tok * 136 + cch] = (bf16_t)f2bf(sacc / (float)win - uv); }
#pragma unroll
    for (int i = 0; i < 4; ++i) { const int idx = i * 512 + t, d = idx >> 4, c8 = idx & 15; *(u32x4*)(mx + d * 136 + c8 * 8) = mreg[i]; }
    __syncthreads();
    f32x4 acc = (f32x4){0.f, 0.f, 0.f, 0.f};
#pragma unroll
    for (int ks = 0; ks < 4; ++ks) { const bf16x8 a = *(const bf16x8*)(pl + lr * 136 + ks * 32 + lq * 8); const bf16x8 bb = *(const bf16x8*)(mx + (16 * w + lr) * 136 + ks * 32 + lq * 8); acc = MFMA16(a, bb, acc); }
    bf16_t* MIX = (bf16_t*)(ws + WS_MIX);
#pragma unroll
    for (int r = 0; r < 4; ++r) MIX[(size_t)(NPR + su * 16 + lq * 4 + r) * DM + 512 + g * 128 + 16 * w + lr] = (bf16_t)f2bf(acc[r] * psc_w);
    __syncthreads();
}

__device__ __forceinline__ void attn_prompt_unit(const Args& A, unsigned char* lds, int unit) {
    const int t = threadIdx.x, w = t >> 6, l = t & 63, lr = l & 15, lq = l >> 4;
    const int qt = unit & 15, h = (unit >> 4) & 3, b = unit >> 6;
    unsigned char* ws = A.ws;
    const bf16_t* Q = (const bf16_t*)(ws + WS_Q); const bf16_t* KB = (const bf16_t*)(ws + WS_KB); const bf16_t* VT = (const bf16_t*)(ws + WS_VT); bf16_t* O = (bf16_t*)(ws + WS_O);
    const int R0 = b * SEQ + qt * 128 + 16 * w;
    bf16_t* CB = (bf16_t*)lds;
    bf16_t* Pw = (bf16_t*)(lds + 73728) + w * (16 * 264);
    const bf16_t* kg = KB + (size_t)(b * 256) * DM + h * 256;
    const bf16_t* vg = VT + (size_t)(h * 256) * MEMR + b * 256;
    u32x4 stg0[4], stg1[4];
#define AT_LOADK(c, STG) _Pragma("unroll") for (int i_ = 0; i_ < 4; ++i_) { const int idx_ = i_ * 512 + t; STG[i_] = *(const u32x4*)(kg + (size_t)((c) * 64 + (idx_ >> 5)) * DM + (idx_ & 31) * 8); }
#define AT_LOADV(c, STG) _Pragma("unroll") for (int i_ = 0; i_ < 4; ++i_) { const int idx_ = i_ * 512 + t; STG[i_] = *(const u32x4*)(vg + (size_t)(idx_ >> 3) * MEMR + (c) * 64 + (idx_ & 7) * 8); }
#define AT_STOREK(bf, STG) _Pragma("unroll") for (int i_ = 0; i_ < 4; ++i_) { const int idx_ = i_ * 512 + t; *(u32x4*)(CB + (bf) * 18432 + (idx_ >> 5) * 264 + (idx_ & 31) * 8) = STG[i_]; }
#define AT_STOREV(bf, STG) _Pragma("unroll") for (int i_ = 0; i_ < 4; ++i_) { const int idx_ = i_ * 512 + t; *(u32x4*)(CB + (bf) * 18432 + (idx_ >> 3) * 72 + (idx_ & 7) * 8) = STG[i_]; }
    AT_LOADK(0, stg0); AT_LOADK(1, stg1);
    bf16x8 qa[8];
#pragma unroll
    for (int ks = 0; ks < 8; ++ks) qa[ks] = *(const bf16x8*)(Q + (size_t)(R0 + lr) * DM + h * 256 + ks * 32 + lq * 8);
    AT_STOREK(0, stg0);
    __syncthreads();
    f32x4 sacc[16]; f32x4 oacc[16]; bf16x8 pa[8]; float rinv[4];
#pragma unroll
    for (int st = 0; st < 8; ++st) {
        if (st & 1) { if (st + 2 < 4) { AT_LOADK(st + 2, stg1); } else if (st + 2 < 8) { AT_LOADV(st - 2, stg1); } }
        else        { if (st + 2 < 4) { AT_LOADK(st + 2, stg0); } else if (st + 2 < 8) { AT_LOADV(st - 2, stg0); } }
        const bf16_t* cb = CB + (st & 1) * 18432;
        if (st < 4) {
#pragma unroll
            for (int nt = 0; nt < 4; ++nt) { f32x4 acc = (f32x4){0.f, 0.f, 0.f, 0.f};
#pragma unroll
                for (int ks = 0; ks < 8; ++ks) { const bf16x8 bb = *(const bf16x8*)(cb + (nt * 16 + lr) * 264 + ks * 32 + lq * 8); acc = MFMA16(qa[ks], bb, acc); }
                sacc[st * 4 + nt] = acc; __builtin_amdgcn_sched_barrier(0); }
        } else {
            if (st == 4) {
#pragma unroll
                for (int r = 0; r < 4; ++r) { float mx = sacc[0][r];
#pragma unroll
                    for (int nt = 1; nt < 16; ++nt) mx = fmaxf(mx, sacc[nt][r]);
                    mx = fmaxf(mx, __shfl_xor(mx, 1)); mx = fmaxf(mx, __shfl_xor(mx, 2)); mx = fmaxf(mx, __shfl_xor(mx, 4)); mx = fmaxf(mx, __shfl_xor(mx, 8));
                    float sum = 0.f;
#pragma unroll
                    for (int nt = 0; nt < 16; ++nt) { const float p = __builtin_amdgcn_exp2f(sacc[nt][r] - mx); sum += p; Pw[(lq * 4 + r) * 264 + nt * 16 + lr] = (bf16_t)f2bf(p); }
                    sum += __shfl_xor(sum, 1); sum += __shfl_xor(sum, 2); sum += __shfl_xor(sum, 4); sum += __shfl_xor(sum, 8);
                    rinv[r] = 1.0f / sum; }
                asm volatile("s_waitcnt lgkmcnt(0)" ::: "memory");
#pragma unroll
                for (int ks = 0; ks < 8; ++ks) pa[ks] = *(const bf16x8*)(Pw + lr * 264 + ks * 32 + lq * 8);
#pragma unroll
                for (int dt = 0; dt < 16; ++dt) oacc[dt] = (f32x4){0.f, 0.f, 0.f, 0.f};
            }
            const int c = st - 4;
#pragma unroll
            for (int dt = 0; dt < 16; ++dt)
#pragma unroll
                for (int k2 = 0; k2 < 2; ++k2) { const bf16x8 bb = *(const bf16x8*)(cb + (dt * 16 + lr) * 72 + k2 * 32 + lq * 8); oacc[dt] = MFMA16(pa[c * 2 + k2], bb, oacc[dt]); if (k2 == 1 && (dt & 1)) __builtin_amdgcn_sched_barrier(0); }
        }
        if (st & 1) { if (st + 1 < 4) { AT_STOREK(0, stg0); } else if (st + 1 < 8) { AT_STOREV(0, stg0); } }
        else        { if (st + 1 < 4) { AT_STOREK(1, stg1); } else if (st + 1 < 8) { AT_STOREV(1, stg1); } }
        __syncthreads();
    }
#pragma unroll
    for (int dt = 0; dt < 16; ++dt)
#pragma unroll
        for (int r = 0; r < 4; ++r) Pw[(lq * 4 + r) * 264 + dt * 16 + lr] = (bf16_t)f2bf(oacc[dt][r] * rinv[r]);
    asm volatile("s_waitcnt lgkmcnt(0)" ::: "memory");
#pragma unroll
    for (int i = 0; i < 8; ++i) { const int idx = i * 64 + l, row = idx >> 5, c8 = idx & 31; *(u32x4*)(O + (size_t)(R0 + row) * DM + h * 256 + c8 * 8) = *(const u32x4*)(Pw + row * 264 + c8 * 8); }
    asm volatile("s_waitcnt lgkmcnt(0)" ::: "memory");
#undef AT_LOADK
#undef AT_LOADV
#undef AT_STOREK
#undef AT_STOREV
}
__device__ __forceinline__ void attn_sample_unit(const Args& A, unsigned char* lds, int unit) {
    const int t = threadIdx.x, w = t >> 6, l = t & 63;
    const int b = unit >> 2, h = unit & 3;
    unsigned char* ws = A.ws;
    float* qs = (float*)lds; float* sc = qs + 256; float* red = sc + 256; float* po = red + 16;
    const float* Kc = A.in[5] + (size_t)b * 256 * 1024 + h * 256; const float* Vc = A.in[6] + (size_t)b * 256 * 1024 + h * 256;
    const int rl = l >> 4, c16 = l & 15;
    f32x4 kr[8][4];
#pragma unroll
    for (int p = 0; p < 8; ++p)
#pragma unroll
        for (int i = 0; i < 4; ++i) kr[p][i] = *(const f32x4*)(Kc + (size_t)(p * 32 + w * 4 + rl) * 1024 + i * 64 + c16 * 4);
    if (t < 256) qs[t] = bf2f(((const bf16_t*)(ws + WS_Q))[(size_t)(NPR + b) * DM + h * 256 + t]);
    __syncthreads();
    {
        f32x4 q4[4];
#pragma unroll
        for (int i = 0; i < 4; ++i) q4[i] = *(const f32x4*)(qs + i * 64 + c16 * 4);
#pragma unroll
        for (int p = 0; p < 8; ++p) { const int m = p * 32 + w * 4 + rl; float s = 0.f;
#pragma unroll
            for (int i = 0; i < 4; ++i) { const f32x4 kv = kr[p][i]; s += (kv[0] * q4[i][0] + kv[1] * q4[i][1]) + (kv[2] * q4[i][2] + kv[3] * q4[i][3]); }
            s += __shfl_xor(s, 1); s += __shfl_xor(s, 2); s += __shfl_xor(s, 4); s += __shfl_xor(s, 8);
            if (c16 == 0) sc[m] = s; }
    }
    f32x4 vr[32];
#pragma unroll
    for (int i = 0; i < 32; ++i) vr[i] = *(const f32x4*)(Vc + (size_t)(w * 32 + i) * 1024 + l * 4);
    __syncthreads();
    if (t < 256) { float mx = sc[t];
#pragma unroll
        for (int o = 1; o < 64; o <<= 1) mx = fmaxf(mx, __shfl_xor(mx, o));
        if (l == 0) red[w] = mx; }
    __syncthreads();
    const float gmx = fmaxf(fmaxf(red[0], red[1]), fmaxf(red[2], red[3]));
    float pv = 0.f;
    if (t < 256) { pv = __builtin_amdgcn_exp2f(sc[t] - gmx); const float s = wave_sum(pv); if (l == 0) red[8 + w] = s; }
    __syncthreads();
    if (t < 256) sc[t] = pv;
    const float inv = 1.0f / ((red[8] + red[9]) + (red[10] + red[11]));
    __syncthreads();
    {
        f32x4 o = (f32x4){0.f, 0.f, 0.f, 0.f};
#pragma unroll
        for (int i = 0; i < 32; ++i) o += vr[i] * sc[w * 32 + i];
        *(f32x4*)(po + w * 256 + l * 4) = o;
    }
    __syncthreads();
    if (t < 256) { float o = 0.f;
#pragma unroll
        for (int i = 0; i < 8; ++i) o += po[i * 256 + t];
        ((bf16_t*)(ws + WS_O))[(size_t)(NPR + b) * DM + h * 256 + t] = (bf16_t)f2bf(o * inv); }
    __syncthreads();
}

template <int KIND>
__device__ __forceinline__ void sample_gemm(unsigned char* lds, const bf16_t* Asm, int lda, const bf16_t* Bt, int K, int unit, const float* base, const bf16_t* baseb, float* out, bf16_t* outb, float* ss, float scale) {
    const int t = threadIdx.x, w = t >> 6, l = t & 63, lr = l & 15, lq = l >> 4;
    const int rb = unit & 3, cb = unit >> 2, kw = K >> 3, k0 = w * kw, nks = kw >> 5;
    f32x4 acc[2]; acc[0] = (f32x4){0.f, 0.f, 0.f, 0.f}; acc[1] = acc[0];
    const bf16_t* bp = Bt + (size_t)(cb * 16 + lr) * K + k0 + lq * 8;
    const bf16_t* ap = Asm + (size_t)(rb * 32 + lr) * lda + k0 + lq * 8;
#pragma unroll 2
    for (int ks = 0; ks < nks; ++ks) { const bf16x8 bb = *(const bf16x8*)(bp + ks * 32); const bf16x8 a0 = *(const bf16x8*)(ap + ks * 32), a1 = *(const bf16x8*)(ap + (size_t)16 * lda + ks * 32);
        acc[0] = MFMA16(a0, bb, acc[0]); acc[1] = MFMA16(a1, bb, acc[1]); }
    float* red = (float*)lds;
#pragma unroll
    for (int i = 0; i < 2; ++i)
#pragma unroll
        for (int r = 0; r < 4; ++r) red[(w * 32 + i * 16 + lq * 4 + r) * 16 + lr] = acc[i][r];
    __syncthreads();
    const int row = t >> 4, col = t & 15, grow = rb * 32 + row, gcol = cb * 16 + col;
    float v = 0.f;
#pragma unroll
    for (int i = 0; i < 8; ++i) v += red[(i * 32 + row) * 16 + col];
    if (KIND == 0) { const float val = (base ? base[(size_t)grow * DM + gcol] : bf2f(baseb[(size_t)grow * DM + gcol])) + v; if (out) out[(size_t)grow * DM + gcol] = val; if (outb) outb[(size_t)grow * DM + gcol] = (bf16_t)f2bf(val);
        float sq = val * val; sq += __shfl_xor(sq, 1); sq += __shfl_xor(sq, 2); sq += __shfl_xor(sq, 4); sq += __shfl_xor(sq, 8);
        if (col == 0) atomicAdd(ss + grow, sq);
    } else { const float rstd = __builtin_amdgcn_rsqf(ss[grow] * (1.0f / DM) + EPS); outb[(size_t)grow * DM + gcol] = (bf16_t)f2bf(v * rstd * scale); }
    __syncthreads();
}

__device__ __forceinline__ void final_norm(const Args& A, int G) {
    const int lane = threadIdx.x & 63, gw = blockIdx.x * 8 + (threadIdx.x >> 6), NGW = G * 8;
    const float* ss = (const float*)(A.ws + WS_SS3); const f32x4* gr = (const f32x4*)A.in[22] + lane;
    f32x4 gg[4];
#pragma unroll
    for (int j = 0; j < 4; ++j) gg[j] = gr[64 * j];
    for (int m0 = gw * 4; m0 < NVALID; m0 += NGW * 4) {
        f32x4 v[4][4]; float sv[4];
#pragma unroll
        for (int r = 0; r < 4; ++r) { sv[r] = ss[m0 + r]; const f32x4* xr = (const f32x4*)(A.out + (size_t)(m0 + r) * DM) + lane;
#pragma unroll
            for (int j = 0; j < 4; ++j) v[r][j] = xr[64 * j]; }
#pragma unroll
        for (int r = 0; r < 4; ++r) { const float rstd = 1.0f / sqrtf(sv[r] * (1.f / DM) + EPS); f32x4* xr = (f32x4*)(A.out + (size_t)(m0 + r) * DM) + lane;
#pragma unroll
            for (int j = 0; j < 4; ++j) xr[64 * j] = v[r][j] * rstd * gg[j]; } }
}

constexpr int NPHASES = 12;
#ifndef REPMASK
#define REPMASK 0
#endif
#define REPS(k) for (int rep_ = 0; rep_ < 1 + ((REPMASK >> (k)) & 1); ++rep_)
__global__ void __launch_bounds__(NTHREADS, 2) fwd_megakernel(Args args) {
    extern __shared__ __attribute__((aligned(16))) unsigned char lds[];
    cg::grid_group grid = cg::this_grid();
    const int G = gridDim.x, bx = blockIdx.x;
    unsigned char* ws = args.ws;
    PG8_LAS unsigned char* lds3 = (PG8_LAS unsigned char*)lds;
    const int lo = args.ph_lo, hi = args.ph_hi;
#define IN(k) (lo <= (k) && (k) < hi)
#define SEAM(k) do { if (IN(k) && IN((k) + 1)) xcd_barrier(bar); } while (0)
    if (lo < 0) grid.sync();
    volatile LAS unsigned* MISC = (volatile LAS unsigned*)(lds3 + LDS_BYTES - 64);
    if (threadIdx.x < 16) MISC[threadIdx.x] = 0u;
    __syncthreads();
    XcdBarrier bar = xcd_barrier_post((unsigned*)(ws + WS_BAR), MISC);
    if (IN(0)) REPS(0) { p0_prologue(args, lds, G); }
    SEAM(0);
    if (IN(1)) REPS(1) {
        {   pg8::Gemm g{(const bf16_t*)(ws + WS_H0), (const bf16_t*)(ws + WS_WIN), MT, NIN, DM}; pg8::StaticOrder S; S.init(MT, NIN, G, bx);
            pg8::EpiInProj E{(bf16_t*)(ws + WS_QQ), (bf16_t*)(ws + WS_KK), (bf16_t*)(ws + WS_VV), (bf16_t*)(ws + WS_GG), (unsigned short*)(ws + WS_LF), (unsigned short*)(ws + WS_UU), args.in[9]};
            pg8::gemm_phase<pg8::EpiInProj, pg8::StaticOrder, true, true>(lds3, g, S, E); }
        {   pg8::Gemm g{(const bf16_t*)(ws + WS_MEMH), (const bf16_t*)(ws + WS_WKV), MEMR, 2 * DM, DM}; pg8::StaticOrder S; S.init(MEMR, 2 * DM, G, (bx + G - (650 % G)) % G);
            pg8::EpiMemKV E{args.out + O_MK, args.out + O_MV, (bf16_t*)(ws + WS_KB)};
            pg8::gemm_phase<pg8::EpiMemKV, pg8::StaticOrder, true, true>(lds3, g, S, E); }
        {   pg8::Gemm g{(const bf16_t*)(ws + WS_WKV) + (size_t)DM * DM, (const bf16_t*)(ws + WS_MEMH), DM, MEMR, DM}; pg8::StaticOrder S; S.init(DM, MEMR, G, (bx + 2 * G - ((650 + 64) % G)) % G);
            pg8::EpiBf16Scale E{(bf16_t*)(ws + WS_VT), MEMR, nullptr, 1.0f};
            pg8::gemm_phase<pg8::EpiBf16Scale, pg8::StaticOrder, true, true>(lds3, g, S, E); }
    }
    SEAM(1);
    if (IN(2)) REPS(2) {
        REPS(14) for (int u = bx; u < 512; u += G) hgrn_sample_unit(args, lds, u);
        REPS(15) for (int u = bx; u < 1024; u += G) hgrn_local_unit(args, lds, u);
    }
    SEAM(2);
    if (IN(3)) REPS(3) { hgrn_scan(args, G); pool_states(args, G); }
    SEAM(3);
    if (IN(4)) REPS(4) {
        REPS(12) for (int u = bx; u < 1024; u += G) hgrn_out_unit(args, lds, u);
        REPS(13) for (int u = bx; u < 32 + 1024; u += G) { if (u < 32) pool_sample_unit(args, lds, u); else pool_unit(args, lds, u - 32); }
    }
    SEAM(4);
    if (IN(5)) REPS(5) {
        pg8::Gemm g{(const bf16_t*)(ws + WS_MIX), (const bf16_t*)(ws + WS_WOUT), NPR, DM, DM}; pg8::StaticOrder S; S.init(NPR, DM, G, bx);
        pg8::EpiResid E{args.in[0], nullptr, nullptr, (bf16_t*)(ws + WS_H0), (float*)(ws + (rep_ ? WS_SSD : WS_SS1))};
        pg8::gemm_phase<pg8::EpiResid, pg8::StaticOrder, true, true>(lds3, g, S, E);
        for (int u = bx; u < 256; u += G) sample_gemm<0>(lds, (const bf16_t*)(ws + WS_MIX) + (size_t)NPR * DM, DM, (const bf16_t*)(ws + WS_WOUT), DM, u, args.in[1], nullptr, nullptr, (bf16_t*)(ws + WS_H0) + (size_t)NPR * DM, (float*)(ws + (rep_ ? WS_SSD : WS_SS1)) + NPR, 1.0f);
    }
    SEAM(5);
    if (IN(6)) REPS(6) {
        pg8::Gemm g{(const bf16_t*)(ws + WS_H0), (const bf16_t*)(ws + WS_WCQ), NPR, DM, DM}; pg8::StaticOrder S; S.init(NPR, DM, G, bx);
        pg8::EpiBf16Scale E{(bf16_t*)(ws + WS_Q), DM, (const float*)(ws + WS_SS1), 0.0625f * 1.4426950408889634f};
        pg8::gemm_phase<pg8::EpiBf16Scale, pg8::StaticOrder, true, true>(lds3, g, S, E);
        for (int u = bx; u < 256; u += G) sample_gemm<1>(lds, (const bf16_t*)(ws + WS_H0) + (size_t)NPR * DM, DM, (const bf16_t*)(ws + WS_WCQ), DM, u, nullptr, nullptr, nullptr, (bf16_t*)(ws + WS_Q) + (size_t)NPR * DM, (float*)(ws + WS_SS1) + NPR, 0.0625f * 1.4426950408889634f);
    }
    SEAM(6);
    if (IN(7)) REPS(7) {
        REPS(16) for (int u = bx; u < 512; u += G) attn_sample_unit(args, lds, u);
        REPS(17) for (int u = bx; u < 512; u += G) attn_prompt_unit(args, lds, u);
    }
    SEAM(7);
    if (IN(8)) REPS(8) {
        pg8::Gemm g{(const bf16_t*)(ws + WS_O), (const bf16_t*)(ws + WS_WCO), NPR, DM, DM}; pg8::StaticOrder S; S.init(NPR, DM, G, bx);
        pg8::EpiResid E{nullptr, (const bf16_t*)(ws + WS_H0), nullptr, (bf16_t*)(ws + WS_MIX), (float*)(ws + (rep_ ? WS_SSD : WS_SS2))};
        pg8::gemm_phase<pg8::EpiResid, pg8::StaticOrder, true, true>(lds3, g, S, E);
        for (int u = bx; u < 256; u += G) sample_gemm<0>(lds, (const bf16_t*)(ws + WS_O) + (size_t)NPR * DM, DM, (const bf16_t*)(ws + WS_WCO), DM, u, nullptr, (const bf16_t*)(ws + WS_H0) + (size_t)NPR * DM, nullptr, (bf16_t*)(ws + WS_MIX) + (size_t)NPR * DM, (float*)(ws + (rep_ ? WS_SSD : WS_SS2)) + NPR, 1.0f);
    }
    SEAM(8);
    if (IN(9)) REPS(9) {
        pg8::Gemm g{(const bf16_t*)(ws + WS_MIX), (const bf16_t*)(ws + WS_WFFI), MT, NFF2, DM}; pg8::StaticOrder S; S.init(MT, NFF2, G, bx);
        pg8::EpiSwiGLU E{(bf16_t*)(ws + WS_A), (const float*)(ws + WS_SS2)};
        pg8::gemm_phase<pg8::EpiSwiGLU, pg8::StaticOrder, true, true>(lds3, g, S, E);
    }
    SEAM(9);
    if (IN(10)) REPS(10) {
        pg8::Gemm g{(const bf16_t*)(ws + WS_A), (const bf16_t*)(ws + WS_WFFO), NPR, DM, DFF}; pg8::StaticOrder S; S.init(NPR, DM, G, bx);
        pg8::EpiResid E{nullptr, (const bf16_t*)(ws + WS_MIX), args.out, nullptr, (float*)(ws + (rep_ ? WS_SSD : WS_SS3))};
        pg8::gemm_phase<pg8::EpiResid, pg8::StaticOrder, true, true>(lds3, g, S, E);
        for (int u = bx; u < 256; u += G) sample_gemm<0>(lds, (const bf16_t*)(ws + WS_A) + (size_t)NPR * DFF, DFF, (const bf16_t*)(ws + WS_WFFO), DFF, u, nullptr, (const bf16_t*)(ws + WS_MIX) + (size_t)NPR * DM, args.out + O_YS, nullptr, (float*)(ws + (rep_ ? WS_SSD : WS_SS3)) + NPR, 1.0f);
    }
    SEAM(10);
#ifdef EXTRA_SYNCS
    for (int i_ = 0; i_ < EXTRA_SYNCS; ++i_) xcd_barrier(bar);
#endif
    if (IN(11)) { final_norm(args, G); }
#undef IN
#undef SEAM
}

#ifndef MK_MULTI
#define MK_MULTI 0
#endif
extern "C" void kernel_launch(void* const* d_in, const int* in_sizes, int n_in, void* d_out, int out_size, void* d_ws, size_t ws_size, hipStream_t stream) {
    static int grid = 0;
    if (grid == 0) {
        if (n_in != 23 || ws_size < WS_END) { fprintf(stderr, "kernel_launch: unexpected n_in %d / ws_size %zu\n", n_in, ws_size); grid = -1; return; }
        int dev = 0, cus = 0, per_cu = 0;
        hipGetDevice(&dev); hipDeviceGetAttribute(&cus, hipDeviceAttributeMultiprocessorCount, dev);
        if (hipFuncSetAttribute((const void*)fwd_megakernel, hipFuncAttributeMaxDynamicSharedMemorySize, LDS_BYTES) != hipSuccess) { fprintf(stderr, "kernel_launch: hipFuncSetAttribute failed\n"); grid = -1; return; }
        hipOccupancyMaxActiveBlocksPerMultiprocessor(&per_cu, (const void*)fwd_megakernel, NTHREADS, LDS_BYTES);
        (void)hipGetLastError();
        if (per_cu < 1) { fprintf(stderr, "kernel_launch: occupancy query says %d blocks/CU\n", per_cu); per_cu = 1; }
        grid = cus;
    }
    if (grid < 0) return;
    Args a{};
    for (int i = 0; i < 23; ++i) a.in[i] = (const float*)d_in[i];
    a.out = (float*)d_out; a.ws = (unsigned char*)d_ws;
#if MK_MULTI
    for (int p = 0; p < NPHASES; ++p) { a.ph_lo = p; a.ph_hi = p + 1; hipLaunchKernelGGL(fwd_megakernel, dim3(grid), dim3(NTHREADS), LDS_BYTES, stream, a); }
#else
    a.ph_lo = 0; a.ph_hi = NPHASES;
    if (hipMemsetAsync((char*)d_ws + WS_BAR, 0, BAR_BYTES, stream) != hipSuccess) { fprintf(stderr, "kernel_launch: memset failed\n"); return; }
    void* kargs[] = {&a};
    hipError_t e = hipLaunchCooperativeKernel((const void*)fwd_megakernel, dim3(grid), dim3(NTHREADS), kargs, LDS_BYTES, stream);
    if (e != hipSuccess) fprintf(stderr, "kernel_launch: cooperative launch failed: %s (grid %d)\n", hipGetErrorString(e), grid);
#endif
}
```

```cpp
#include <hip/hip_runtime.h>
#include <hip/hip_cooperative_groups.h>
#include <cstdio>
#include <cstdint>
namespace cg = cooperative_groups;
namespace pg8 {
#define PG8_LAS __attribute__((address_space(3)))
typedef unsigned short bf16_t;
typedef short bf16x8 __attribute__((ext_vector_type(8)));
typedef float f32x4 __attribute__((ext_vector_type(4)));
typedef unsigned u32x4 __attribute__((ext_vector_type(4)));
constexpr int BM = 256, BK = 64, HALF = 128, HTB = HALF * BK * 2  , STAGE_BYTES = 8 * HTB, NXCD = 8, WGM = 8;

__host__ __device__ __forceinline__ int lds_byte(int r, int c) { const int st = (r >> 4) * 2 + (c >> 5), rr = r & 15, cc = c & 31, ob = rr * 64 + cc * 2; return st * 1024 + (ob ^ (((ob >> 9) & 1) << 5)); }
__host__ __device__ __forceinline__ void stage_rc(int b, int& R, int& C) { const int st = b / 1024, sb = b % 1024, swz = sb ^ (((sb >> 9) & 1) << 5); R = (st >> 1) * 16 + swz / 64; C = (st & 1) * 32 + (swz % 64) / 2; }
__host__ __device__ __forceinline__ int perm32(int rho) { const int n = rho >> 4, i = rho & 15; return 8 * (i >> 2) + 4 * n + (i & 3); }

struct Unit { int pm, pn; };
struct Gemm { const bf16_t* A; const bf16_t* Bt; int M, N, K; };

struct StaticOrder {
    int nM, nN, nwg, G, c;
    __host__ __device__ void init(int M, int N, int G_, int c_) { nM = M / BM; nN = N / BM; nwg = nM * nN; G = G_; c = c_; }
    __host__ __device__ bool next(int i, Unit& u) const {
        const long L = (long)i * G + c; if (L >= nwg) return false;
        int wgid = (int)L; { const int q = nwg / NXCD, r = nwg % NXCD, xcd = wgid % NXCD, off = wgid / NXCD; wgid = (xcd < r ? xcd * (q + 1) : r * (q + 1) + (xcd - r) * q) + off; }
        const int nig = WGM * nN, gid = wgid / nig, fm = gid * WGM, gsz = (nM - fm) < WGM ? (nM - fm) : WGM;
        u.pm = fm + ((wgid % nig) % gsz); u.pn = (wgid % nig) / gsz; return true;
    }
    __device__ __forceinline__ void a_ready(const Unit&) const {}
    __device__ __forceinline__ void done(const Unit&) const {}
};

__device__ __forceinline__ unsigned cvt_pk_bf16(float lo, float hi) { unsigned r; asm volatile("v_cvt_pk_bf16_f32 %0, %1, %2" : "=v"(r) : "v"(lo), "v"(hi)); return r; }
typedef unsigned u32x2 __attribute__((ext_vector_type(2)));
__device__ __forceinline__ float sigm(float z) { return 1.0f / (1.0f + __expf(-z)); }
constexpr float RMS_EPS = 1e-6f;
#ifndef WT_STORES
#define WT_STORES 0
#endif
__device__ __forceinline__ void st16(void* p, u32x4 v) {
#if WT_STORES
    asm volatile("global_store_dwordx4 %0, %1, off sc1\n\ts_nop 1" :: "v"(p), "v"(v) : "memory");
#else
    *(u32x4*)p = v;
#endif
}
__device__ __forceinline__ void st16f(void* p, f32x4 v) { st16(p, __builtin_bit_cast(u32x4, v)); }
__device__ __forceinline__ void st8(void* p, u32x2 v) {
#if WT_STORES
    asm volatile("global_store_dwordx2 %0, %1, off sc1\n\ts_nop 1" :: "v"(p), "v"(v) : "memory");
#else
    *(u32x2*)p = v;
#endif
}
typedef _Float16 h2_t __attribute__((ext_vector_type(2)));
__device__ __forceinline__ unsigned pk_h2(float a, float b) { h2_t v; v.x = (_Float16)a; v.y = (_Float16)b; return __builtin_bit_cast(unsigned, v); }
__device__ __forceinline__ float h_lo(unsigned u) { return (float)__builtin_bit_cast(h2_t, u).x; }
__device__ __forceinline__ float h_hi(unsigned u) { return (float)__builtin_bit_cast(h2_t, u).y; }

struct EpiInProj {
    static constexpr bool PERM = true, AFTER_DRAIN = false;
    bf16_t *QQ, *KK, *VV, *GG; unsigned short *LF, *UU; const float* lbraw;
    __device__ __forceinline__ void operator()(const f32x4 (&acc)[2][2][4][2], const Unit& u, int wr, int wc, int fr, int fq) const {
        const int seg = u.pn >> 1, colt = (u.pn & 1) * 256;
        const int row0 = u.pm * BM + wr * 64 + fr;
#pragma unroll
        for (int bj = 0; bj < 2; ++bj) {
            const int cs = colt + bj * HALF + wc * 32 + 8 * fq;
            float lb[8];
            if (seg == 1) {
#pragma unroll
                for (int j = 0; j < 8; ++j) { const float l0 = lbraw[cs + j], l1 = lbraw[512 + cs + j]; lb[j] = 1.0f / (1.0f + __expf(l1 - l0)); }
            } else {
#pragma unroll
                for (int j = 0; j < 8; ++j) lb[j] = 0.f;
            }
#pragma unroll
            for (int ai = 0; ai < 2; ++ai)
#pragma unroll
                for (int m = 0; m < 4; ++m) {
                    const size_t off = (size_t)(row0 + ai * HALF + m * 16) * 512 + cs;
                    const f32x4 v0 = acc[ai][bj][m][0], v1 = acc[ai][bj][m][1];
                    float z[8] = {v0[0], v0[1], v0[2], v0[3], v1[0], v1[1], v1[2], v1[3]};
                    if (seg == 0) {
#pragma unroll
                        for (int j = 0; j < 8; ++j) z[j] = z[j] * sigm(z[j]);
                        u32x4 w; w.x = cvt_pk_bf16(z[0], z[1]); w.y = cvt_pk_bf16(z[2], z[3]); w.z = cvt_pk_bf16(z[4], z[5]); w.w = cvt_pk_bf16(z[6], z[7]);
                        st16(QQ + off, w);
                    } else if (seg == 1) {
                        float lf[8], kk[8];
#pragma unroll
                        for (int j = 0; j < 8; ++j) { const float e = __expf(-z[j]); const float sg = 1.0f / (1.0f + e); const float sgn = e / (1.0f + e);
                            lf[j] = __logf(lb[j] + (1.0f - lb[j]) * sg); kk[j] = (1.0f - lb[j]) * sgn; }
                        { u32x4 w; w.x = pk_h2(lf[0], lf[1]); w.y = pk_h2(lf[2], lf[3]); w.z = pk_h2(lf[4], lf[5]); w.w = pk_h2(lf[6], lf[7]); st16(LF + off, w); }
                        u32x4 w; w.x = cvt_pk_bf16(kk[0], kk[1]); w.y = cvt_pk_bf16(kk[2], kk[3]); w.z = cvt_pk_bf16(kk[4], kk[5]); w.w = cvt_pk_bf16(kk[6], kk[7]);
                        st16(KK + off, w);
                    } else if (seg == 2) {
                        u32x4 w; w.x = cvt_pk_bf16(z[0], z[1]); w.y = cvt_pk_bf16(z[2], z[3]); w.z = cvt_pk_bf16(z[4], z[5]); w.w = cvt_pk_bf16(z[6], z[7]);
                        st16(VV + off, w);
                    } else if (seg == 3) {
#pragma unroll
                        for (int j = 0; j < 8; ++j) z[j] = sigm(z[j]);
                        u32x4 w; w.x = cvt_pk_bf16(z[0], z[1]); w.y = cvt_pk_bf16(z[2], z[3]); w.z = cvt_pk_bf16(z[4], z[5]); w.w = cvt_pk_bf16(z[6], z[7]);
                        st16(GG + off, w);
                    } else {
                        u32x4 w; w.x = pk_h2(z[0], z[1]); w.y = pk_h2(z[2], z[3]); w.z = pk_h2(z[4], z[5]); w.w = pk_h2(z[6], z[7]); st16(UU + off, w);
                    }
                }
        }
    }
};

struct EpiMemKV {
    static constexpr bool PERM = true, AFTER_DRAIN = false;
    float *outK, *outV; bf16_t* KB;
    __device__ __forceinline__ void operator()(const f32x4 (&acc)[2][2][4][2], const Unit& u, int wr, int wc, int fr, int fq) const {
        const bool isk = u.pn < 4; float* o = isk ? outK : outV; const int colt = (u.pn & 3) * 256;
        const int row0 = u.pm * BM + wr * 64 + fr;
#pragma unroll
        for (int ai = 0; ai < 2; ++ai)
#pragma unroll
            for (int m = 0; m < 4; ++m)
#pragma unroll
                for (int bj = 0; bj < 2; ++bj) {
                    const size_t off = (size_t)(row0 + ai * HALF + m * 16) * 1024 + colt + bj * HALF + wc * 32 + 8 * fq;
                    const f32x4 v0 = acc[ai][bj][m][0], v1 = acc[ai][bj][m][1];
                    *(f32x4*)(o + off) = v0; *(f32x4*)(o + off + 4) = v1;
                    if (isk) { u32x4 w; w.x = cvt_pk_bf16(v0[0], v0[1]); w.y = cvt_pk_bf16(v0[2], v0[3]); w.z = cvt_pk_bf16(v1[0], v1[1]); w.w = cvt_pk_bf16(v1[2], v1[3]); *(u32x4*)(KB + off) = w; }
                }
    }
};

struct EpiBf16Scale {
    static constexpr bool PERM = true, AFTER_DRAIN = false;
    bf16_t* O; int ldc; const float* ss; float scale;
    __device__ __forceinline__ void operator()(const f32x4 (&acc)[2][2][4][2], const Unit& u, int wr, int wc, int fr, int fq) const {
        const int row0 = u.pm * BM + wr * 64 + fr;
        float ssv[2][4];
#pragma unroll
        for (int ai = 0; ai < 2; ++ai)
#pragma unroll
            for (int m = 0; m < 4; ++m) ssv[ai][m] = ss ? ss[row0 + ai * HALF + m * 16] : 0.f;
#pragma unroll
        for (int ai = 0; ai < 2; ++ai)
#pragma unroll
            for (int m = 0; m < 4; ++m) {
                const int row = row0 + ai * HALF + m * 16;
                const float sc = ss ? scale * __builtin_amdgcn_rsqf(ssv[ai][m] * (1.0f / 1024.0f) + RMS_EPS) : scale;
#pragma unroll
                for (int bj = 0; bj < 2; ++bj) {
                    const size_t off = (size_t)row * ldc + u.pn * BM + bj * HALF + wc * 32 + 8 * fq;
                    const f32x4 v0 = acc[ai][bj][m][0] * sc, v1 = acc[ai][bj][m][1] * sc;
                    u32x4 w; w.x = cvt_pk_bf16(v0[0], v0[1]); w.y = cvt_pk_bf16(v0[2], v0[3]); w.z = cvt_pk_bf16(v1[0], v1[1]); w.w = cvt_pk_bf16(v1[2], v1[3]);
                    st16(O + off, w);
                }
            }
    }
};

struct EpiResid {
    static constexpr bool PERM = true, AFTER_DRAIN = false;
    const float* baseF;
    const bf16_t* baseB;
    float* out;
    bf16_t* outb;
    float* ss;
    __device__ __forceinline__ void operator()(const f32x4 (&acc)[2][2][4][2], const Unit& u, int wr, int wc, int fr, int fq) const {
        const int row0 = u.pm * BM + wr * 64 + fr;
#pragma unroll
        for (int ai = 0; ai < 2; ++ai) {
            f32x4 pre[4][2][2];
            if (baseF) {
#pragma unroll
                for (int m = 0; m < 4; ++m) { const float* bp = baseF + (size_t)(row0 + ai * HALF + m * 16) * 1024;
#pragma unroll
                    for (int bj = 0; bj < 2; ++bj) { const int col = u.pn * BM + bj * HALF + wc * 32 + 8 * fq; pre[m][bj][0] = *(const f32x4*)(bp + col); pre[m][bj][1] = *(const f32x4*)(bp + col + 4); } }
            } else {
                u32x4 pb[4][2];
#pragma unroll
                for (int m = 0; m < 4; ++m) { const bf16_t* bp = baseB + (size_t)(row0 + ai * HALF + m * 16) * 1024;
#pragma unroll
                    for (int bj = 0; bj < 2; ++bj) pb[m][bj] = *(const u32x4*)(bp + u.pn * BM + bj * HALF + wc * 32 + 8 * fq); }
#pragma unroll
                for (int m = 0; m < 4; ++m)
#pragma unroll
                    for (int bj = 0; bj < 2; ++bj) { const u32x4 p = pb[m][bj];
                        pre[m][bj][0] = (f32x4){__uint_as_float(p.x << 16), __uint_as_float(p.x & 0xffff0000u), __uint_as_float(p.y << 16), __uint_as_float(p.y & 0xffff0000u)};
                        pre[m][bj][1] = (f32x4){__uint_as_float(p.z << 16), __uint_as_float(p.z & 0xffff0000u), __uint_as_float(p.w << 16), __uint_as_float(p.w & 0xffff0000u)}; }
            }
#pragma unroll
            for (int m = 0; m < 4; ++m) {
                const int row = row0 + ai * HALF + m * 16;
                float s = 0.f;
#pragma unroll
                for (int bj = 0; bj < 2; ++bj) {
                    const int col = u.pn * BM + bj * HALF + wc * 32 + 8 * fq;
                    const f32x4 v0 = acc[ai][bj][m][0] + pre[m][bj][0], v1 = acc[ai][bj][m][1] + pre[m][bj][1];
                    s += (v0[0] * v0[0] + v0[1] * v0[1]) + (v0[2] * v0[2] + v0[3] * v0[3]) + (v1[0] * v1[0] + v1[1] * v1[1]) + (v1[2] * v1[2] + v1[3] * v1[3]);
                    if (out) { *(f32x4*)(out + (size_t)row * 1024 + col) = v0; *(f32x4*)(out + (size_t)row * 1024 + col + 4) = v1; }
                    if (outb) { u32x4 w; w.x = cvt_pk_bf16(v0[0], v0[1]); w.y = cvt_pk_bf16(v0[2], v0[3]); w.z = cvt_pk_bf16(v1[0], v1[1]); w.w = cvt_pk_bf16(v1[2], v1[3]); st16(outb + (size_t)row * 1024 + col, w); }
                }
                s += __shfl_xor(s, 16); s += __shfl_xor(s, 32);
                if (fq == 0) atomicAdd(ss + row, s);
            }
        }
    }
};

struct EpiResidNorm {
    static constexpr bool PERM = true, AFTER_DRAIN = true;
    const bf16_t* baseB; float* out; float* ss; unsigned* cnt; const float* gfin;
    __device__ __forceinline__ void fused(f32x4 (&acc)[2][2][4][2], const Unit& u, int wr, int wc, int fr, int fq, PG8_LAS unsigned char* lds, int wid, int lane) const {
        const int row0 = u.pm * BM + wr * 64 + fr;
#pragma unroll
        for (int ai = 0; ai < 2; ++ai) {
            u32x4 pb[4][2];
#pragma unroll
            for (int m = 0; m < 4; ++m) { const bf16_t* bp = baseB + (size_t)(row0 + ai * HALF + m * 16) * 1024;
#pragma unroll
                for (int bj = 0; bj < 2; ++bj) pb[m][bj] = *(const u32x4*)(bp + u.pn * BM + bj * HALF + wc * 32 + 8 * fq); }
#pragma unroll
            for (int m = 0; m < 4; ++m) { float s = 0.f;
#pragma unroll
                for (int bj = 0; bj < 2; ++bj) { const u32x4 p = pb[m][bj];
                    const f32x4 v0 = acc[ai][bj][m][0] + (f32x4){__uint_as_float(p.x << 16), __uint_as_float(p.x & 0xffff0000u), __uint_as_float(p.y << 16), __uint_as_float(p.y & 0xffff0000u)};
                    const f32x4 v1 = acc[ai][bj][m][1] + (f32x4){__uint_as_float(p.z << 16), __uint_as_float(p.z & 0xffff0000u), __uint_as_float(p.w << 16), __uint_as_float(p.w & 0xffff0000u)};
                    acc[ai][bj][m][0] = v0; acc[ai][bj][m][1] = v1;
                    s += (v0[0] * v0[0] + v0[1] * v0[1]) + (v0[2] * v0[2] + v0[3] * v0[3]) + (v1[0] * v1[0] + v1[1] * v1[1]) + (v1[2] * v1[2] + v1[3] * v1[3]); }
                s += __shfl_xor(s, 16); s += __shfl_xor(s, 32);
                if (fq == 0) atomicAdd(ss + row0 + ai * HALF + m * 16, s); }
        }
        asm volatile("s_waitcnt vmcnt(0)" ::: "memory");
        __syncthreads();
        if (threadIdx.x == 0) { unsigned* c = cnt + 64 * u.pm;
            __hip_atomic_fetch_add(c, 1u, __ATOMIC_RELEASE, __HIP_MEMORY_SCOPE_AGENT);
            unsigned sp = 0u; while (__hip_atomic_load(c, __ATOMIC_RELAXED, __HIP_MEMORY_SCOPE_AGENT) < 4u) { __builtin_amdgcn_s_sleep(2); if (++sp > (1u << 22)) break; }
            __builtin_amdgcn_fence(__ATOMIC_ACQUIRE, "agent"); }
        __syncthreads();
        float rs[2][4];
#pragma unroll
        for (int ai = 0; ai < 2; ++ai)
#pragma unroll
            for (int m = 0; m < 4; ++m) rs[ai][m] = __hip_atomic_load(ss + row0 + ai * HALF + m * 16, __ATOMIC_RELAXED, __HIP_MEMORY_SCOPE_AGENT);
        f32x4 gv[2][2];
#pragma unroll
        for (int bj = 0; bj < 2; ++bj) { const int col = u.pn * BM + bj * HALF + wc * 32 + 8 * fq; gv[bj][0] = *(const f32x4*)(gfin + col); gv[bj][1] = *(const f32x4*)(gfin + col + 4); }
#pragma unroll
        for (int ai = 0; ai < 2; ++ai)
#pragma unroll
            for (int m = 0; m < 4; ++m) { const int row = row0 + ai * HALF + m * 16; const float rstd = 1.0f / sqrtf(rs[ai][m] * (1.0f / 1024.0f) + RMS_EPS);
#pragma unroll
                for (int bj = 0; bj < 2; ++bj) { const int col = u.pn * BM + bj * HALF + wc * 32 + 8 * fq;
                    *(f32x4*)(out + (size_t)row * 1024 + col) = acc[ai][bj][m][0] * rstd * gv[bj][0]; *(f32x4*)(out + (size_t)row * 1024 + col + 4) = acc[ai][bj][m][1] * rstd * gv[bj][1]; } }
    }
};

struct EpiSwiGLU {
    static constexpr bool PERM = true, AFTER_DRAIN = false;
    bf16_t* ACT; const float* ss;
    __device__ __forceinline__ void operator()(const f32x4 (&acc)[2][2][4][2], const Unit& u, int wr, int wc, int fr, int fq) const {
        const int row0 = u.pm * BM + wr * 64 + fr;
        float ssv[2][4];
#pragma unroll
        for (int ai = 0; ai < 2; ++ai)
#pragma unroll
            for (int m = 0; m < 4; ++m) ssv[ai][m] = ss[row0 + ai * HALF + m * 16];
#pragma unroll
        for (int ai = 0; ai < 2; ++ai)
#pragma unroll
            for (int m = 0; m < 4; ++m) {
                const int row = row0 + ai * HALF + m * 16;
                const float r = __builtin_amdgcn_rsqf(ssv[ai][m] * (1.0f / 1024.0f) + RMS_EPS);
#pragma unroll
                for (int bj = 0; bj < 2; ++bj) {
                    const int J = u.pn * 128 + bj * 64 + wc * 16 + 4 * fq;
                    const f32x4 a = acc[ai][bj][m][0] * r, b = acc[ai][bj][m][1] * r;
                    float o[4];
#pragma unroll
                    for (int j = 0; j < 4; ++j) o[j] = a[j] * sigm(a[j]) * b[j];
                    u32x2 w; w.x = cvt_pk_bf16(o[0], o[1]); w.y = cvt_pk_bf16(o[2], o[3]);
                    st8(ACT + (size_t)row * 2816 + J, w);
                }
            }
    }
};

template <class Epi, class Sched, bool ALIGN_EPI = false, bool SP2 = false>
__device__ __forceinline__ void gemm_phase(PG8_LAS unsigned char* lds, const Gemm g, const Sched& S, const Epi& E) {
    const int tid = threadIdx.x, wid = __builtin_amdgcn_readfirstlane(tid >> 6), lane = tid & 63, wr = wid >> 2, wc = wid & 3, fr = lane & 15, fq = lane >> 4;
    const int K = g.K, nt = K / BK;
    unsigned voffA[2], voffB[2];
#pragma unroll
    for (int i = 0; i < 2; ++i) { int R, C; stage_rc(tid * 16 + i * 8192, R, C); const int Rb = Epi::PERM ? ((R & ~31) + perm32(R & 31)) : R;
        voffA[i] = (unsigned)(R * K + C) * 2u; voffB[i] = (unsigned)(Rb * K + C) * 2u; }
    const size_t kstep = (size_t)(BK * 2);
    const size_t hstep = (size_t)HALF * K * 2;
    const size_t tstep = 2 * hstep;
    const unsigned ldsw = (unsigned)wid * 1024u;
    const int aoff = lds_byte(wr * 64 + fr, fq * 8), boff = lds_byte(wc * 32 + fr, fq * 8);
#define PG8_SA(b, h) (((b) * 2 + (h)) * HTB)
#define PG8_SB(b, h) ((4 + (b) * 2 + (h)) * HTB)
#define PG8_STAGE(bufoff, gbase, voff) do { _Pragma("unroll") for (int _i = 0; _i < 2; ++_i) \
        __builtin_amdgcn_global_load_lds((const unsigned*)((const char*)(gbase) + (voff)[_i]), (PG8_LAS unsigned*)(lds + (bufoff) + ldsw + _i * 8192), 16, 0, 0); } while (0)
#define PG8_LDA(dst, b, h) do { _Pragma("unroll") for (int m = 0; m < 4; ++m) _Pragma("unroll") for (int k = 0; k < 2; ++k) dst[m][k] = *(const PG8_LAS bf16x8*)(lds + PG8_SA(b, h) + aoff + m * 2048 + k * 1024); } while (0)
#define PG8_LDB(dst, b, h) do { _Pragma("unroll") for (int n = 0; n < 2; ++n) _Pragma("unroll") for (int k = 0; k < 2; ++k) dst[n][k] = *(const PG8_LAS bf16x8*)(lds + PG8_SB(b, h) + boff + n * 2048 + k * 1024); } while (0)
#define PG8_MMA(ai, bj, At, Bt) do { __builtin_amdgcn_s_setprio(1); _Pragma("unroll") for (int m = 0; m < 4; ++m) _Pragma("unroll") for (int n = 0; n < 2; ++n) _Pragma("unroll") for (int k = 0; k < 2; ++k) \
        acc[ai][bj][m][n] = __builtin_amdgcn_mfma_f32_16x16x32_bf16(Bt[n][k], At[m][k], acc[ai][bj][m][n], 0, 0, 0); __builtin_amdgcn_s_setprio(0); } while (0)
#define PG8_WAIT_V(n) asm volatile("s_waitcnt vmcnt(" #n ")" ::: "memory")
#define PG8_WAIT_L(n) asm volatile("s_waitcnt lgkmcnt(" #n ")" ::: "memory")
#define PG8_BAR __builtin_amdgcn_s_barrier()
#define PG8_SCHED __builtin_amdgcn_sched_barrier(0)
    Unit cur, nxt; int ui = 0;
    if (!S.next(0, cur)) return;
    f32x4 acc[2][2][4][2];
#pragma unroll
    for (int a = 0; a < 2; ++a)
#pragma unroll
        for (int b = 0; b < 2; ++b)
#pragma unroll
            for (int m = 0; m < 4; ++m)
#pragma unroll
                for (int n = 0; n < 2; ++n) acc[a][b][m][n] = (f32x4){0.f, 0.f, 0.f, 0.f};
    bf16x8 At[4][2], B0[2][2], B1[2][2];
    const char* cA = (const char*)g.A + (size_t)cur.pm * tstep; const char* cB = (const char*)g.Bt + (size_t)cur.pn * tstep;
    S.a_ready(cur);
    if constexpr (SP2) {
        PG8_STAGE(PG8_SB(0, 0), cB, voffB); PG8_STAGE(PG8_SB(0, 1), cB + hstep, voffB); PG8_STAGE(PG8_SA(0, 0), cA, voffA); PG8_STAGE(PG8_SA(0, 1), cA + hstep, voffA);
        if (wr == 1) PG8_BAR;
        PG8_WAIT_V(2); PG8_BAR;
        PG8_STAGE(PG8_SB(1, 0), cB + kstep, voffB); PG8_STAGE(PG8_SA(1, 0), cA + kstep, voffA); PG8_STAGE(PG8_SB(1, 1), cB + hstep + kstep, voffB);
        PG8_WAIT_V(6); PG8_BAR;
    } else {
        PG8_STAGE(PG8_SB(0, 0), cB, voffB); PG8_STAGE(PG8_SA(0, 0), cA, voffA); PG8_STAGE(PG8_SB(0, 1), cB + hstep, voffB); PG8_STAGE(PG8_SA(0, 1), cA + hstep, voffA);
        if (wr == 1) PG8_BAR;
        PG8_WAIT_V(4); PG8_BAR;
        PG8_STAGE(PG8_SB(1, 0), cB + kstep, voffB); PG8_STAGE(PG8_SA(1, 0), cA + kstep, voffA); PG8_STAGE(PG8_SB(1, 1), cB + hstep + kstep, voffB);
        PG8_WAIT_V(6); PG8_BAR;
    }
    for (;;) {
        const bool has_next = S.next(ui + 1, nxt);
        const char* nA = has_next ? (const char*)g.A + (size_t)nxt.pm * tstep : cA; const char* nB = has_next ? (const char*)g.Bt + (size_t)nxt.pn * tstep : cB;
        for (int t = 0; t < nt; t += 2) {
            const bool last = (t == nt - 2);
            const char* a1 = cA + (size_t)(t + 1) * kstep;
            const char* a2 = last ? nA : cA + (size_t)(t + 2) * kstep; const char* b2 = last ? nB : cB + (size_t)(t + 2) * kstep;
            const char* a3 = a2 + kstep; const char* b3 = b2 + kstep;
            if (last && has_next) S.a_ready(nxt);
            if constexpr (SP2) {
            PG8_LDB(B0, 0, 0); PG8_LDB(B1, 0, 1); PG8_SCHED; PG8_LDA(At, 0, 0); PG8_STAGE(PG8_SA(1, 1), a1 + hstep, voffA);
            PG8_WAIT_V(8); PG8_WAIT_L(0); PG8_BAR; PG8_MMA(0, 0, At, B0); PG8_MMA(0, 1, At, B1); PG8_BAR; PG8_SCHED;
            PG8_LDA(At, 0, 1); PG8_STAGE(PG8_SB(0, 0), b2, voffB); PG8_STAGE(PG8_SB(0, 1), b2 + hstep, voffB); PG8_STAGE(PG8_SA(0, 0), a2, voffA);
            PG8_WAIT_V(8); PG8_WAIT_L(0); PG8_BAR; PG8_MMA(1, 0, At, B0); PG8_MMA(1, 1, At, B1); PG8_BAR; PG8_SCHED;
            PG8_LDB(B0, 1, 0); PG8_LDB(B1, 1, 1); PG8_SCHED; PG8_LDA(At, 1, 0); PG8_STAGE(PG8_SA(0, 1), a2 + hstep, voffA);
            PG8_WAIT_V(8); PG8_WAIT_L(0); PG8_BAR; PG8_MMA(0, 0, At, B0); PG8_MMA(0, 1, At, B1); PG8_BAR; PG8_SCHED;
            PG8_LDA(At, 1, 1); PG8_STAGE(PG8_SB(1, 0), b3, voffB); PG8_STAGE(PG8_SB(1, 1), b3 + hstep, voffB); PG8_STAGE(PG8_SA(1, 0), a3, voffA);
            PG8_WAIT_V(8); PG8_WAIT_L(0); PG8_BAR; PG8_MMA(1, 0, At, B0); PG8_MMA(1, 1, At, B1); PG8_BAR; PG8_SCHED;
            } else {
            PG8_LDB(B0, 0, 0); PG8_SCHED; PG8_LDA(At, 0, 0); PG8_STAGE(PG8_SA(1, 1), a1 + hstep, voffA);
            PG8_WAIT_L(8); PG8_BAR; PG8_WAIT_L(0); PG8_MMA(0, 0, At, B0); PG8_BAR; PG8_SCHED;
            PG8_LDB(B1, 0, 1); PG8_STAGE(PG8_SB(0, 0), b2, voffB);
            PG8_BAR; PG8_WAIT_L(0); PG8_MMA(0, 1, At, B1); PG8_BAR;
            PG8_LDA(At, 0, 1); PG8_STAGE(PG8_SA(0, 0), a2, voffA);
            PG8_BAR; PG8_WAIT_L(0); PG8_MMA(1, 0, At, B0); PG8_BAR; PG8_SCHED;
            PG8_STAGE(PG8_SB(0, 1), b2 + hstep, voffB);
            PG8_WAIT_V(6); PG8_BAR; PG8_MMA(1, 1, At, B1); PG8_BAR;
            PG8_LDB(B0, 1, 0); PG8_SCHED; PG8_LDA(At, 1, 0); PG8_STAGE(PG8_SA(0, 1), a2 + hstep, voffA);
            PG8_WAIT_L(8); PG8_BAR; PG8_WAIT_L(0); PG8_MMA(0, 0, At, B0); PG8_BAR; PG8_SCHED;
            PG8_LDB(B1, 1, 1); PG8_STAGE(PG8_SB(1, 0), b3, voffB);
            PG8_BAR; PG8_WAIT_L(0); PG8_MMA(0, 1, At, B1); PG8_BAR;
            PG8_LDA(At, 1, 1); PG8_STAGE(PG8_SA(1, 0), a3, voffA);
            PG8_BAR; PG8_WAIT_L(0); PG8_MMA(1, 0, At, B0); PG8_BAR; PG8_SCHED;
            PG8_STAGE(PG8_SB(1, 1), b3 + hstep, voffB);
            PG8_WAIT_V(6); PG8_BAR; PG8_MMA(1, 1, At, B1); PG8_BAR;
            }
        }
        if constexpr (ALIGN_EPI) { if (wr == 0) PG8_BAR; }
        if constexpr (!Epi::AFTER_DRAIN) { E(acc, cur, wr, wc, fr, fq); S.done(cur); }
        if (!has_next) break;
#pragma unroll
        for (int a = 0; a < 2; ++a)
#pragma unroll
            for (int b = 0; b < 2; ++b)
#pragma unroll
                for (int m = 0; m < 4; ++m)
#pragma unroll
                    for (int n = 0; n < 2; ++n) acc[a][b][m][n] = (f32x4){0.f, 0.f, 0.f, 0.f};
        cur = nxt; cA = nA; cB = nB; ++ui;
        if constexpr (ALIGN_EPI) { if (wr == 1) PG8_BAR; }
    }
    PG8_WAIT_V(0);
    if constexpr (!ALIGN_EPI) { if (wr == 0) PG8_BAR; }
    PG8_BAR;
    if constexpr (Epi::AFTER_DRAIN) { E.fused(acc, cur, wr, wc, fr, fq, lds, wid, lane); S.done(cur); }
#undef PG8_SA
#undef PG8_SB
#undef PG8_STAGE
#undef PG8_LDA
#undef PG8_LDB
#undef PG8_MMA
#undef PG8_WAIT_V
#undef PG8_WAIT_L
#undef PG8_BAR
#undef PG8_SCHED
}
}
#define LAS __attribute__((address_space(3)))
#define XB_TMO      128
#define XB_XCNT(j)  (256  + 64 * (j))
#define XB_XSUB(j)  (1280 + 64 * (j))
#define XB_XGEN(j)  (2304 + 64 * (j))
#define XB_TOP      3328
#define XB_TOPGEN   3392
#define XCD_BAR_WORDS 3456
#define XB_SPIN_CAP (1u << 18)

__device__ __forceinline__ unsigned xb_ld(unsigned* p)              { return __hip_atomic_load(p, __ATOMIC_RELAXED, __HIP_MEMORY_SCOPE_AGENT); }
__device__ __forceinline__ unsigned xb_add(unsigned* p, unsigned v) { return __hip_atomic_fetch_add(p, v, __ATOMIC_RELAXED, __HIP_MEMORY_SCOPE_AGENT); }
__device__ __forceinline__ unsigned xb_xcc_id() { return (unsigned)__builtin_amdgcn_s_getreg((3 << 11) | 20) & 0xFu; }
#define XB_SPIN(cond, bar) do { unsigned _sp = 0; while (cond) { __builtin_amdgcn_s_sleep(1); \
    if ((++_sp & 255u) == 0u) { if (xb_ld(&(bar)[XB_TMO])) break; if (_sp > XB_SPIN_CAP) { atomicAdd(&(bar)[XB_TMO], 1u); break; } } } } while (0)

struct XcdBarrier {
    unsigned* bar; unsigned x;
    volatile LAS unsigned* st;
};

__device__ __forceinline__ XcdBarrier xcd_barrier_post(unsigned* bar, volatile LAS unsigned* st) {
    XcdBarrier b; b.bar = bar; b.x = xb_xcc_id(); b.st = st;
    if (threadIdx.x == 0) (void)xb_add(&bar[XB_XCNT(b.x)], 1u);
    return b;
}
__device__ __forceinline__ void xcd_barrier_complete(unsigned* bar, unsigned x, unsigned& nloc, unsigned& nx) {
    const unsigned G = gridDim.x * gridDim.y * gridDim.z;
    unsigned sum, cnt, mine, sp = 0u;
    for (;;) {
        sum = 0u; cnt = 0u; mine = 0u;
#pragma unroll
        for (unsigned j = 0; j < 16; ++j) { const unsigned c = xb_ld(&bar[XB_XCNT(j)]); sum += c; cnt += (c > 0u) ? 1u : 0u; mine = (j == x) ? c : mine; }
        if (sum == G) break;
        __builtin_amdgcn_s_sleep(1);
        if ((++sp & 255u) == 0u) { if (xb_ld(&bar[XB_TMO])) break; if (sp > XB_SPIN_CAP) { atomicAdd(&bar[XB_TMO], 1u); break; } }
    }
    nloc = mine > 0u ? mine : 1u; nx = cnt > 0u ? cnt : 1u;
}

__device__ __forceinline__ void xcd_barrier(const XcdBarrier& b) {
    asm volatile("s_waitcnt vmcnt(0)" ::: "memory");
    __syncthreads();
    if (threadIdx.x == 0) {
        unsigned* bar = b.bar;
        __builtin_amdgcn_s_waitcnt(0);
        unsigned nloc = b.st[0], nx = b.st[1];
        if (nloc == 0u) { xcd_barrier_complete(bar, b.x, nloc, nx); b.st[0] = nloc; b.st[1] = nx; }
        const unsigned old = xb_add(&bar[XB_XSUB(b.x)], 1u);
        const unsigned gen = old / nloc;
        if (old + 1u == (gen + 1u) * nloc) {
            __builtin_amdgcn_fence(__ATOMIC_RELEASE, "agent");
            asm volatile("s_waitcnt vmcnt(0)" ::: "memory");
            const unsigned og = xb_add(&bar[XB_TOP], 1u);
            const unsigned tg = og / nx;
            if (og + 1u == (tg + 1u) * nx) xb_add(&bar[XB_TOPGEN], 1u);
            else XB_SPIN(xb_ld(&bar[XB_TOPGEN]) == tg, bar);
            __builtin_amdgcn_fence(__ATOMIC_ACQUIRE, "agent");
            xb_add(&bar[XB_XGEN(b.x)], 1u);
            asm volatile("s_waitcnt vmcnt(0)" ::: "memory");
        } else {
            XB_SPIN(xb_ld(&bar[XB_XGEN(b.x)]) == gen, bar);
            __builtin_amdgcn_fence(__ATOMIC_ACQUIRE, "agent");
            asm volatile("s_waitcnt vmcnt(0)" ::: "memory");
        }
    }
    __syncthreads();
}

using pg8::bf16_t; using pg8::f32x4; using pg8::u32x4; using pg8::bf16x8; using pg8::pk_h2; using pg8::h_lo; using pg8::h_hi;
typedef unsigned u32x2v __attribute__((ext_vector_type(2)));
constexpr int DM = 1024, NPR = 16384, NSM = 128, MT = 16640, NVALID = 16512, SEQ = 2048;
constexpr int HW = 512, NIN = 2560, DFF = 2816, NFF2 = 5632, MEMR = 2048;
constexpr float EPS = 1e-6f;
constexpr int NTHREADS = 512;
constexpr int LDS_BYTES = 147456;

constexpr size_t O_YP = 0, O_YS = 16777216, O_HP = 16908288, O_PP = 17432576, O_MK = 17494016, O_MV = 19591168, O_HS = 21688320, O_PS = 30076928;

constexpr size_t MiB = 1u << 20;
constexpr size_t WS_SS1 = 0, WS_SS2 = 128 * 1024, WS_SS3 = 256 * 1024, WS_BAR = 512 * 1024, BAR_BYTES = 65536, WS_SSD = 384 * 1024, WS_CNT = WS_BAR + 16384;
constexpr size_t WS_WIN = 1 * MiB, WS_WOUT = 6 * MiB, WS_WCQ = 8 * MiB, WS_WCO = 10 * MiB, WS_WFFI = 12 * MiB, WS_WFFO = 23 * MiB, WS_WKV = 29 * MiB, WS_PMIX = 33 * MiB;
constexpr size_t WS_MEMH = 34 * MiB, WS_KB = 38 * MiB, WS_VT = 42 * MiB, WS_DEC = 46 * MiB;
constexpr size_t WS_H0 = 47 * MiB;
constexpr size_t WS_MIX = 80 * MiB;
constexpr size_t WS_X1 = 113 * MiB;
constexpr size_t WS_Q = 178 * MiB;
constexpr size_t WS_O = 211 * MiB;
constexpr size_t WS_SL = 244 * MiB;
constexpr size_t WS_A = 309 * MiB;
constexpr size_t WS_QQ = WS_A, WS_KK = WS_A + 17 * MiB, WS_VV = WS_A + 34 * MiB, WS_GG = WS_A + 51 * MiB, WS_LF = WS_A + 68 * MiB, WS_UU = WS_A + 101 * MiB;
constexpr size_t WS_END = 443 * MiB;

struct Args { const float* in[23]; float* out; unsigned char* ws; int ph_lo, ph_hi; };

__device__ __forceinline__ unsigned f2bf(float f) { unsigned u = __builtin_bit_cast(unsigned, f); return (u + 0x7fffu + ((u >> 16) & 1u)) >> 16; }
__device__ __forceinline__ unsigned pk2(float lo, float hi) { return f2bf(lo) | (f2bf(hi) << 16); }
__device__ __forceinline__ float bf2f(unsigned h) { return __uint_as_float(h << 16); }
__device__ __forceinline__ float bfe(const u32x4& v, int j) { const unsigned w = v[j >> 1]; return (j & 1) ? __uint_as_float(w & 0xffff0000u) : __uint_as_float(w << 16); }
__device__ __forceinline__ unsigned short bfr(const u32x4& v, int j) { const unsigned w = v[j >> 1]; return (unsigned short)((j & 1) ? (w >> 16) : (w & 0xffffu)); }
__device__ __forceinline__ float wave_sum(float v) {
#pragma unroll
    for (int o = 1; o < 64; o <<= 1) v += __shfl_xor(v, o);
    return v;
}
#define MFMA16(a, b, c) __builtin_amdgcn_mfma_f32_16x16x32_bf16((a), (b), (c), 0, 0, 0)

template <int MODE>
__device__ __forceinline__ void tr_item(const float* W, int K, int N, bf16_t* WT, const float* gk, float* scr, int item, int lane) {
    const int nblk = N / 32, kb = item / nblk, nb = item % nblk, k0 = 64 * kb, n0 = 32 * nb;
    f32x4 wv[8];
#pragma unroll
    for (int i = 0; i < 8; ++i) { const int kk = 8 * i + (lane >> 3); wv[i] = *(const f32x4*)(W + (size_t)(k0 + kk) * N + n0 + (lane & 7) * 4); }
#pragma unroll
    for (int i = 0; i < 8; ++i) { const int kk = 8 * i + (lane >> 3); float* d = scr + kk * 33 + (lane & 7) * 4; d[0] = wv[i][0]; d[1] = wv[i][1]; d[2] = wv[i][2]; d[3] = wv[i][3]; }
    asm volatile("s_waitcnt lgkmcnt(0)" ::: "memory");
    const int c = lane & 7;
    float g8[8];
#pragma unroll
    for (int i = 0; i < 8; ++i) g8[i] = gk ? gk[k0 + 8 * c + i] : 1.0f;
#pragma unroll
    for (int j = 0; j < 4; ++j) { const int n = (lane >> 3) + 8 * j; const float* s = scr + (8 * c) * 33 + n;
        u32x4 o; o.x = pk2(s[0 * 33] * g8[0], s[1 * 33] * g8[1]); o.y = pk2(s[2 * 33] * g8[2], s[3 * 33] * g8[3]); o.z = pk2(s[4 * 33] * g8[4], s[5 * 33] * g8[5]); o.w = pk2(s[6 * 33] * g8[6], s[7 * 33] * g8[7]);
        int row = n0 + n;
        if (MODE == 1) { const int half = row >= DFF ? 1 : 0; const int J = row - half * DFF;
            row = 256 * (J >> 7) + 128 * ((J >> 6) & 1) + 32 * ((J >> 4) & 3) + 8 * ((J >> 2) & 3) + 4 * half + (J & 3); }
        *(u32x4*)(WT + (size_t)row * K + k0 + 8 * c) = o; }
    asm volatile("s_waitcnt lgkmcnt(0)" ::: "memory");
}
__device__ __forceinline__ void rms_row_to_bf16(const float* xrow, const float* g, bf16_t* orow, int lane) {
    const f32x4* xr = (const f32x4*)xrow + lane; const f32x4* gr = (const f32x4*)g + lane;
    f32x4 v[4]; float s = 0.f;
#pragma unroll
    for (int j = 0; j < 4; ++j) { v[j] = xr[64 * j]; s += (v[j].x * v[j].x + v[j].y * v[j].y) + (v[j].z * v[j].z + v[j].w * v[j].w); }
    const float rstd = 1.0f / sqrtf(wave_sum(s) * (1.f / DM) + EPS);
    unsigned long long* o8 = (unsigned long long*)orow + lane;
#pragma unroll
    for (int j = 0; j < 4; ++j) { const f32x4 gg = gr[64 * j];
        o8[64 * j] = (unsigned long long)pk2(v[j].x * rstd * gg.x, v[j].y * rstd * gg.y) | ((unsigned long long)pk2(v[j].z * rstd * gg.z, v[j].w * rstd * gg.w) << 32); }
}
__device__ __forceinline__ void rms_row2_to_bf16(const float* xrow, const float* g, bf16_t* orow, int lane) {
    const f32x4* xr = (const f32x4*)xrow + lane; const f32x4* gr = (const f32x4*)g + lane;
    f32x4 v[2][4]; float s[2] = {0.f, 0.f};
#pragma unroll
    for (int r = 0; r < 2; ++r)
#pragma unroll
        for (int j = 0; j < 4; ++j) v[r][j] = xr[r * 256 + 64 * j];
#pragma unroll
    for (int r = 0; r < 2; ++r)
#pragma unroll
        for (int j = 0; j < 4; ++j) s[r] += (v[r][j].x * v[r][j].x + v[r][j].y * v[r][j].y) + (v[r][j].z * v[r][j].z + v[r][j].w * v[r][j].w);
#pragma unroll
    for (int r = 0; r < 2; ++r) { const float rstd = 1.0f / sqrtf(wave_sum(s[r]) * (1.f / DM) + EPS); unsigned long long* o8 = (unsigned long long*)(orow + (size_t)r * DM) + lane;
#pragma unroll
        for (int j = 0; j < 4; ++j) { const f32x4 gg = gr[64 * j];
            o8[64 * j] = (unsigned long long)pk2(v[r][j].x * rstd * gg.x, v[r][j].y * rstd * gg.y) | ((unsigned long long)pk2(v[r][j].z * rstd * gg.z, v[r][j].w * rstd * gg.w) << 32); } }
}
__device__ __forceinline__ void p0_prologue(const Args& A, unsigned char* lds, int G) {
    const int tid = threadIdx.x, lane = tid & 63, wave = tid >> 6;
    float* scr = (float*)(lds + wave * 16384);
    unsigned char* ws = A.ws;
    const int gw = blockIdx.x * 8 + wave, NGW = G * 8;
    constexpr int I_IN = 16 * 80, I_OUT = 16 * 32, I_CQ = 16 * 32, I_CO = 16 * 32, I_FFI = 16 * 176, I_FFO = 44 * 32, I_KV = 16 * 64, I_PM = 4 * 8;
    constexpr int NITEMS = I_IN + I_OUT + I_CQ + I_CO + I_FFI + I_FFO + I_KV + I_PM;
    for (int it = gw; it < NITEMS; it += NGW) {
        int r = it;
        if (r < I_IN) { tr_item<0>(A.in[8], DM, NIN, (bf16_t*)(ws + WS_WIN), nullptr, scr, r, lane); continue; } r -= I_IN;
        if (r < I_OUT) { tr_item<0>(A.in[13], DM, DM, (bf16_t*)(ws + WS_WOUT), nullptr, scr, r, lane); continue; } r -= I_OUT;
        if (r < I_CQ) { tr_item<0>(A.in[17], DM, DM, (bf16_t*)(ws + WS_WCQ), A.in[16], scr, r, lane); continue; } r -= I_CQ;
        if (r < I_CO) { tr_item<0>(A.in[18], DM, DM, (bf16_t*)(ws + WS_WCO), nullptr, scr, r, lane); continue; } r -= I_CO;
        if (r < I_FFI) { tr_item<1>(A.in[20], DM, NFF2, (bf16_t*)(ws + WS_WFFI), A.in[19], scr, r, lane); continue; } r -= I_FFI;
        if (r < I_FFO) { tr_item<0>(A.in[21], DFF, DM, (bf16_t*)(ws + WS_WFFO), nullptr, scr, r, lane); continue; } r -= I_FFO;
        if (r < I_KV) { tr_item<0>(A.in[15], DM, 2 * DM, (bf16_t*)(ws + WS_WKV), nullptr, scr, r, lane); continue; } r -= I_KV;
        { const int g = r >> 3; tr_item<0>(A.in[11] + (size_t)g * 128 * 128, 128, 128, (bf16_t*)(ws + WS_PMIX) + (size_t)g * 128 * 128, nullptr, scr, r & 7, lane); }
    }
    bf16_t* H0 = (bf16_t*)(ws + WS_H0);
    for (int m = gw * 2; m < NVALID; m += NGW * 2) { const float* xr = m < NPR ? A.in[0] + (size_t)m * DM : A.in[1] + (size_t)(m - NPR) * DM; rms_row2_to_bf16(xr, A.in[7], H0 + (size_t)m * DM, lane); }
    bf16_t* MEMH = (bf16_t*)(ws + WS_MEMH);
    for (int m = gw; m < MEMR; m += NGW) rms_row_to_bf16(A.in[2] + (size_t)m * DM, A.in[14], MEMH + (size_t)m * DM, lane);
    const int gt = blockIdx.x * NTHREADS + tid, NGT = G * NTHREADS;
    for (int i = gt; i < (MT - NVALID) * DM / 8; i += NGT) { const u32x4 z = {0u, 0u, 0u, 0u};
        ((u32x4*)(ws + WS_H0) + (size_t)NVALID * DM / 8)[i] = z; ((u32x4*)(ws + WS_MIX) + (size_t)NVALID * DM / 8)[i] = z; ((u32x4*)(ws + WS_O) + (size_t)NVALID * DM / 8)[i] = z; }
    for (int i = gt; i < MT; i += NGT) { ((float*)(ws + WS_SS1))[i] = 0.f; ((float*)(ws + WS_SS2))[i] = 0.f; ((float*)(ws + WS_SS3))[i] = 0.f; }
}

constexpr int BS = 129;
constexpr int L_BC = 0, L_TOT = 33024, L_QM = 35072, L_KM = 52480, L_VT = 69888, L_SP = 88320, L_AL = 123136, L_PART = 132352, L_EM = 132864;
constexpr size_t WS_SPT = WS_X1;
__device__ __forceinline__ void hgrn_lf_load(u32x2v (&lf)[4], const unsigned short* LF, int R0, int C0, int t) {
#pragma unroll
    for (int i = 0; i < 4; ++i) { const int idx = i * 512 + t, s = idx >> 5, k4 = idx & 31; lf[i] = *(const u32x2v*)(LF + (size_t)(R0 + s) * HW + C0 + k4 * 4); }
}
__device__ __forceinline__ void hgrn_cumsum(const u32x2v (&lf)[4], float* Bc, float* tot, int t) {
#pragma unroll
    for (int i = 0; i < 4; ++i) { const int idx = i * 512 + t, s = idx >> 5, k4 = idx & 31; const u32x2v v = lf[i];
        float* d = Bc + s * BS + k4 * 4; d[0] = h_lo(v.x); d[1] = h_hi(v.x); d[2] = h_lo(v.y); d[3] = h_hi(v.y); }
    __syncthreads();
    const int seg = t >> 7, k = t & 127; float run = 0.f;
#pragma unroll
    for (int i = 0; i < 16; ++i) { run += Bc[(seg * 16 + i) * BS + k]; Bc[(seg * 16 + i) * BS + k] = run; }
    tot[seg * 128 + k] = run;
    __syncthreads();
    float off = 0.f;
#pragma unroll
    for (int j = 0; j < 3; ++j) off += (j < seg) ? tot[j * 128 + k] : 0.f;
#pragma unroll
    for (int i = 0; i < 16; ++i) Bc[(seg * 16 + i) * BS + k] += off;
    __syncthreads();
}
__device__ __forceinline__ void hgrn_local_load(const Args& A, int unit, u32x2v (&lf)[4], u32x4 (&kkr)[2], u32x4 (&vvr)[2]) {
    const int t = threadIdx.x, w = t >> 6, l = t & 63;
    const int bh = unit >> 5, c = unit & 31, b = bh >> 2, h = bh & 3, R0 = b * SEQ + c * 64, C0 = h * 128;
    const bf16_t* KK = (const bf16_t*)(A.ws + WS_KK); const bf16_t* VV = (const bf16_t*)(A.ws + WS_VV);
    hgrn_lf_load(lf, (const unsigned short*)(A.ws + WS_LF), R0, C0, t);
#pragma unroll
    for (int i = 0; i < 2; ++i) { const int k0 = (w + 8 * i) * 8; kkr[i] = *(const u32x4*)(KK + (size_t)(R0 + l) * HW + C0 + k0); vvr[i] = *(const u32x4*)(VV + (size_t)(R0 + l) * HW + C0 + k0); }
}
__device__ __forceinline__ void hgrn_local_unit(const Args& A, unsigned char* lds, int unit, int next, u32x2v (&lf)[4], u32x4 (&kkr)[2], u32x4 (&vvr)[2]) {
    const int t = threadIdx.x, w = t >> 6, l = t & 63, lr = l & 15, lq = l >> 4;
    const int bh = unit >> 5, c = unit & 31, b = bh >> 2, h = bh & 3, R0 = b * SEQ + c * 64, C0 = h * 128;
    unsigned char* ws = A.ws;
    float* Bc = (float*)(lds + L_BC); float* tot = (float*)(lds + L_TOT);
    bf16_t* kdT = (bf16_t*)(lds + L_QM); bf16_t* vT = (bf16_t*)(lds + L_VT);
    hgrn_cumsum(lf, Bc, tot, t);
#pragma unroll
    for (int i = 0; i < 2; ++i) { const int s = l, k0 = (w + 8 * i) * 8;
        const u32x4 kk = kkr[i], vv = vvr[i];
#pragma unroll
        for (int j = 0; j < 8; ++j) { const float e = __expf(Bc[63 * BS + k0 + j] - Bc[s * BS + k0 + j]);
            kdT[(k0 + j) * 72 + s] = (bf16_t)f2bf(bfe(kk, j) * e); vT[(k0 + j) * 72 + s] = bfr(vv, j); } }
    if (next >= 0) hgrn_local_load(A, next, lf, kkr, vvr);
    __syncthreads();
    f32x4 acc[8];
#pragma unroll
    for (int i = 0; i < 8; ++i) acc[i] = (f32x4){0.f, 0.f, 0.f, 0.f};
#pragma unroll
    for (int ks = 0; ks < 2; ++ks) { const bf16x8 a = *(const bf16x8*)(kdT + (16 * w + lr) * 72 + ks * 32 + lq * 8);
#pragma unroll
        for (int vt = 0; vt < 8; ++vt) { const bf16x8 bb = *(const bf16x8*)(vT + (16 * vt + lr) * 72 + ks * 32 + lq * 8); acc[vt] = MFMA16(a, bb, acc[vt]); } }
    unsigned short* SLT = (unsigned short*)(ws + WS_SL) + (size_t)unit * 16384;
#pragma unroll
    for (int vt = 0; vt < 8; ++vt) { u32x2v o; o.x = pk_h2(acc[vt][0], acc[vt][1]); o.y = pk_h2(acc[vt][2], acc[vt][3]); *(u32x2v*)(SLT + (16 * vt + lr) * 128 + 16 * w + lq * 4) = o; }
    if (t < 128) ((float*)(ws + WS_DEC))[unit * 128 + t] = __expf(Bc[63 * BS + t]);
    __syncthreads();
}
__device__ __forceinline__ void hgrn_out_load(const Args& A, int unit, u32x2v (&lf)[4], u32x4 (&qqr)[2], u32x4 (&kkr)[2], u32x4 (&vvr)[2], u32x4 (&spr)[4]) {
    const int t = threadIdx.x, w = t >> 6, l = t & 63;
    const int bh = unit >> 5, c = unit & 31, b = bh >> 2, h = bh & 3, R0 = b * SEQ + c * 64, C0 = h * 128;
    const bf16_t* QQ = (const bf16_t*)(A.ws + WS_QQ); const bf16_t* KK = (const bf16_t*)(A.ws + WS_KK); const bf16_t* VV = (const bf16_t*)(A.ws + WS_VV);
    hgrn_lf_load(lf, (const unsigned short*)(A.ws + WS_LF), R0, C0, t);
#pragma unroll
    for (int i = 0; i < 2; ++i) { const int idx = (i * 512 + t) * 8, s = idx >> 7, k0 = idx & 127; const size_t go = (size_t)(R0 + s) * HW + C0 + k0; qqr[i] = *(const u32x4*)(QQ + go); kkr[i] = *(const u32x4*)(KK + go);
        vvr[i] = *(const u32x4*)(VV + (size_t)(R0 + l) * HW + C0 + (w + 8 * i) * 8); }
    const bf16_t* SPT = (const bf16_t*)(A.ws + WS_SPT) + (size_t)unit * 16384;
#pragma unroll
    for (int i = 0; i < 4; ++i) { const int idx = i * 512 + t; spr[i] = *(const u32x4*)(SPT + (idx >> 4) * 128 + (idx & 15) * 8); }
}
__device__ __forceinline__ void hgrn_out_unit(const Args& A, unsigned char* lds, int unit, int next, u32x2v (&lf)[4], u32x4 (&qqr)[2], u32x4 (&kkr)[2], u32x4 (&vvr)[2], u32x4 (&spr)[4]) {
    const int t = threadIdx.x, w = t >> 6, l = t & 63, lr = l & 15, lq = l >> 4;
    const int bh = unit >> 5, c = unit & 31, b = bh >> 2, h = bh & 3, R0 = b * SEQ + c * 64, C0 = h * 128;
    unsigned char* ws = A.ws;
    float* Bc = (float*)(lds + L_BC); float* tot = (float*)(lds + L_TOT); float* part = (float*)(lds + L_PART); float* em = (float*)(lds + L_EM);
    bf16_t* qm = (bf16_t*)(lds + L_QM); bf16_t* km = (bf16_t*)(lds + L_KM); bf16_t* vT = (bf16_t*)(lds + L_VT); bf16_t* spT = (bf16_t*)(lds + L_SP); bf16_t* aL = (bf16_t*)(lds + L_AL);
    u32x4 ggr[2];
#pragma unroll
    for (int hh = 0; hh < 2; ++hh) ggr[hh] = *(const u32x4*)((const bf16_t*)(ws + WS_GG) + (size_t)(R0 + (t >> 3)) * HW + C0 + (t & 7) * 16 + hh * 8);
    hgrn_cumsum(lf, Bc, tot, t);
    if (t < 128) em[t] = __expf(Bc[31 * BS + t]);
#pragma unroll
    for (int i = 0; i < 2; ++i) { const int idx = (i * 512 + t) * 8, s = idx >> 7, k0 = idx & 127;
        const u32x4 qq = qqr[i], kk = kkr[i];
        float qv[8], kv[8];
#pragma unroll
        for (int j = 0; j < 8; ++j) { const float d = Bc[s * BS + k0 + j] - Bc[31 * BS + k0 + j]; qv[j] = bfe(qq, j) * __expf(d); kv[j] = bfe(kk, j) * __expf(-d); }
        u32x4 o; o.x = pk2(qv[0], qv[1]); o.y = pk2(qv[2], qv[3]); o.z = pk2(qv[4], qv[5]); o.w = pk2(qv[6], qv[7]); *(u32x4*)(qm + s * 136 + k0) = o;
        o.x = pk2(kv[0], kv[1]); o.y = pk2(kv[2], kv[3]); o.z = pk2(kv[4], kv[5]); o.w = pk2(kv[6], kv[7]); *(u32x4*)(km + s * 136 + k0) = o; }
#pragma unroll
    for (int i = 0; i < 2; ++i) { const int s = l, k0 = (w + 8 * i) * 8; const u32x4 vv = vvr[i];
#pragma unroll
        for (int j = 0; j < 8; ++j) vT[(k0 + j) * 72 + s] = bfr(vv, j); }
    __syncthreads();
    {
#pragma unroll
        for (int i = 0; i < 4; ++i) { const int idx = i * 512 + t, v = idx >> 4, k0 = (idx & 15) * 8; const u32x4 sv = spr[i];
            u32x4 o; o.x = pk2(bfe(sv, 0) * em[k0], bfe(sv, 1) * em[k0 + 1]); o.y = pk2(bfe(sv, 2) * em[k0 + 2], bfe(sv, 3) * em[k0 + 3]); o.z = pk2(bfe(sv, 4) * em[k0 + 4], bfe(sv, 5) * em[k0 + 5]); o.w = pk2(bfe(sv, 6) * em[k0 + 6], bfe(sv, 7) * em[k0 + 7]);
            *(u32x4*)(spT + v * 136 + k0) = o; } }
    if (next >= 0) hgrn_out_load(A, next, lf, qqr, kkr, vvr, spr);
    {
        const int ct = w & 3;
        f32x4 a2[2]; a2[0] = (f32x4){0.f, 0.f, 0.f, 0.f}; a2[1] = a2[0];
#pragma unroll
        for (int ks = 0; ks < 4; ++ks) { const bf16x8 a = *(const bf16x8*)(qm + (16 * ct + lr) * 136 + ks * 32 + lq * 8);
#pragma unroll
            for (int i = 0; i < 2; ++i) { const int st = (w >> 2) * 2 + i; const bf16x8 bb = *(const bf16x8*)(km + (16 * st + lr) * 136 + ks * 32 + lq * 8); a2[i] = MFMA16(a, bb, a2[i]); } }
#pragma unroll
        for (int i = 0; i < 2; ++i) { const int st = (w >> 2) * 2 + i, s = 16 * st + lr;
#pragma unroll
            for (int r = 0; r < 4; ++r) { const int cc = 16 * ct + lq * 4 + r; aL[cc * 72 + s] = (bf16_t)f2bf(s <= cc ? a2[i][r] : 0.f); } }
    }
    __syncthreads();
    const int ct = w & 3, vh = w >> 2;
    f32x4 o4[4];
#pragma unroll
    for (int i = 0; i < 4; ++i) o4[i] = (f32x4){0.f, 0.f, 0.f, 0.f};
#pragma unroll
    for (int ks = 0; ks < 4; ++ks) { const bf16x8 a = *(const bf16x8*)(qm + (16 * ct + lr) * 136 + ks * 32 + lq * 8);
#pragma unroll
        for (int i = 0; i < 4; ++i) { const int vt = vh * 4 + i; const bf16x8 bb = *(const bf16x8*)(spT + (16 * vt + lr) * 136 + ks * 32 + lq * 8); o4[i] = MFMA16(a, bb, o4[i]); } }
#pragma unroll
    for (int ks = 0; ks < 2; ++ks) { const bf16x8 a = *(const bf16x8*)(aL + (16 * ct + lr) * 72 + ks * 32 + lq * 8);
#pragma unroll
        for (int i = 0; i < 4; ++i) { const int vt = vh * 4 + i; const bf16x8 bb = *(const bf16x8*)(vT + (16 * vt + lr) * 72 + ks * 32 + lq * 8); o4[i] = MFMA16(a, bb, o4[i]); } }
    float* ost = (float*)(lds + L_BC);
#pragma unroll
    for (int r = 0; r < 4; ++r) { float s = 0.f;
#pragma unroll
        for (int i = 0; i < 4; ++i) { s += o4[i][r] * o4[i][r]; ost[(16 * ct + lq * 4 + r) * 132 + (vh * 4 + i) * 16 + lr] = o4[i][r]; }
        s += __shfl_xor(s, 1); s += __shfl_xor(s, 2); s += __shfl_xor(s, 4); s += __shfl_xor(s, 8);
        if (lr == 0) part[vh * 64 + 16 * ct + lq * 4 + r] = s; }
    __syncthreads();
    {   const float* hn = A.in[10]; bf16_t* MIX = (bf16_t*)(ws + WS_MIX);
        const int cc = t >> 3, v0 = (t & 7) * 16; const float rstd = __builtin_amdgcn_rsqf((part[cc] + part[64 + cc]) * (1.0f / 128.0f) + EPS);
#pragma unroll
        for (int hh = 0; hh < 2; ++hh) { const int v = v0 + hh * 8; const u32x4 g8 = ggr[hh];
            const f32x4 oa = *(const f32x4*)(ost + cc * 132 + v), ob = *(const f32x4*)(ost + cc * 132 + v + 4), na = *(const f32x4*)(hn + C0 + v), nb = *(const f32x4*)(hn + C0 + v + 4);
            u32x4 o; o.x = pk2(oa[0] * rstd * na[0] * bfe(g8, 0), oa[1] * rstd * na[1] * bfe(g8, 1)); o.y = pk2(oa[2] * rstd * na[2] * bfe(g8, 2), oa[3] * rstd * na[3] * bfe(g8, 3));
            o.z = pk2(ob[0] * rstd * nb[0] * bfe(g8, 4), ob[1] * rstd * nb[1] * bfe(g8, 5)); o.w = pk2(ob[2] * rstd * nb[2] * bfe(g8, 6), ob[3] * rstd * nb[3] * bfe(g8, 7));
            *(u32x4*)(MIX + (size_t)(R0 + cc) * DM + C0 + v) = o; } }
    __syncthreads();
}
__device__ __forceinline__ void hgrn_scan(const Args& A, int G) {
    const u32x2v* SLT = (const u32x2v*)(A.ws + WS_SL); const f32x4* DEC4 = (const f32x4*)(A.ws + WS_DEC); u32x2v* SPT = (u32x2v*)(A.ws + WS_SPT); float* outp = A.out + O_HP;
    for (int e = blockIdx.x * NTHREADS + threadIdx.x; e < 32 * 4096; e += G * NTHREADS) { const int bh = e >> 12, i4 = e & 4095, v = i4 >> 5, k4 = i4 & 31;
        f32x4 S = (f32x4){0.f, 0.f, 0.f, 0.f};
        const u32x2v* p = SLT + (size_t)bh * 32 * 4096 + i4; u32x2v* q = SPT + (size_t)bh * 32 * 4096 + i4; const f32x4* dp = DEC4 + (size_t)bh * 32 * 32 + k4;
#pragma unroll
        for (int hf = 0; hf < 2; ++hf) { u32x2v loc[16]; f32x4 dd[16];
#pragma unroll
            for (int c = 0; c < 16; ++c) { loc[c] = p[(size_t)(hf * 16 + c) * 4096]; dd[c] = dp[(hf * 16 + c) * 32]; }
#pragma unroll
            for (int c = 0; c < 16; ++c) { u32x2v o; o.x = pk2(S[0], S[1]); o.y = pk2(S[2], S[3]); q[(size_t)(hf * 16 + c) * 4096] = o; const f32x4 lv = (f32x4){h_lo(loc[c].x), h_hi(loc[c].x), h_lo(loc[c].y), h_hi(loc[c].y)}; S = S * dd[c] + lv; } }
        float* ob = outp + (size_t)bh * 16384 + (k4 * 4) * 128 + v; ob[0] = S[0]; ob[128] = S[1]; ob[256] = S[2]; ob[384] = S[3]; }
}
__device__ __forceinline__ void pool_states(const Args& A, int G) {
    const unsigned short* UU = (const unsigned short*)(A.ws + WS_UU);
    const int gt = blockIdx.x * NTHREADS + threadIdx.x, NGT = G * NTHREADS;
    for (int i = gt; i < 8 * 15 * 128; i += NGT) { const int c4 = i & 127, j = (i >> 7) % 15, b = i / (15 * 128); const u32x2v v = *(const u32x2v*)(UU + (size_t)(b * SEQ + 2033 + j) * HW + c4 * 4);
        *(f32x4*)(A.out + O_PP + (size_t)i * 4) = (f32x4){h_lo(v.x), h_hi(v.x), h_lo(v.y), h_hi(v.y)}; }
    for (int i0 = gt * 2; i0 < 128 * 15 * 128; i0 += NGT * 2) { f32x4 v[2];
#pragma unroll
        for (int q = 0; q < 2; ++q) { const int i = i0 + q, c4 = i & 127, j = (i >> 7) % 15, b = i / (15 * 128);
            if (j < 14) v[q] = *(const f32x4*)(A.in[4] + (size_t)(b * 15 + j + 1) * 512 + c4 * 4);
            else { const u32x2v h = *(const u32x2v*)(UU + (size_t)(NPR + b) * HW + c4 * 4); v[q] = (f32x4){h_lo(h.x), h_hi(h.x), h_lo(h.y), h_hi(h.y)}; } }
#pragma unroll
        for (int q = 0; q < 2; ++q) *(f32x4*)(A.out + O_PS + (size_t)(i0 + q) * 4) = v[q]; }
}
__device__ __forceinline__ void hgrn_sample_load(const Args& A, int unit, f32x4 (&sreg)[8]) {
    const int t = threadIdx.x; const float* S0 = A.in[3] + (size_t)unit * 16384;
#pragma unroll
    for (int i = 0; i < 8; ++i) sreg[i] = *(const f32x4*)(S0 + ((t >> 5) * 8 + i) * 128 + (t & 31) * 4);
}
__device__ __forceinline__ void hgrn_sample_unit(const Args& A, unsigned char* lds, int unit, int next, f32x4 (&sreg)[8]) {
    const int t = threadIdx.x, b = unit >> 2, h = unit & 3, row = NPR + b, C0 = h * 128;
    unsigned char* ws = A.ws;
    float* qs = (float*)lds; float* ks = qs + 128; float* fs = ks + 128; float* vs = fs + 128; float* po = vs + 128;
    float* red = po + 16 * 128;
    float* S1 = A.out + O_HS + (size_t)unit * 16384;
    if (t < 128) { const size_t go = (size_t)row * HW + C0 + t;
        qs[t] = bf2f(((const bf16_t*)(ws + WS_QQ))[go]); ks[t] = bf2f(((const bf16_t*)(ws + WS_KK))[go]); fs[t] = __expf((float)__builtin_bit_cast(_Float16, ((const unsigned short*)(ws + WS_LF))[go])); vs[t] = bf2f(((const bf16_t*)(ws + WS_VV))[go]); }
    __syncthreads();
    const int v4 = t & 31, kg = t >> 5;
    const f32x4 vv = *(const f32x4*)(vs + v4 * 4);
    f32x4 o = (f32x4){0.f, 0.f, 0.f, 0.f};
#pragma unroll
    for (int i = 0; i < 8; ++i) { const int k = kg * 8 + i; const f32x4 s = sreg[i]; const f32x4 sn = s * fs[k] + vv * ks[k]; *(f32x4*)(S1 + k * 128 + v4 * 4) = sn; o += sn * qs[k]; }
    *(f32x4*)(po + kg * 128 + v4 * 4) = o;
    if (next >= 0) hgrn_sample_load(A, next, sreg);
    __syncthreads();
    float ov = 0.f;
    if (t < 128) {
#pragma unroll
        for (int i = 0; i < 16; ++i) ov += po[i * 128 + t];
        const float sq = wave_sum(ov * ov); if ((t & 63) == 0) red[t >> 6] = sq; }
    __syncthreads();
    if (t < 128) { const float rstd = __builtin_amdgcn_rsqf((red[0] + red[1]) * (1.0f / 128.0f) + EPS); const float g = bf2f(((const bf16_t*)(ws + WS_GG))[(size_t)row * HW + C0 + t]);
        ((bf16_t*)(ws + WS_MIX))[(size_t)row * DM + C0 + t] = (bf16_t)f2bf(ov * rstd * A.in[10][C0 + t] * g); }
    __syncthreads();
}

constexpr int LP_EXT = 0, LP_PL = 40448, LP_MX = 57856;
__device__ __forceinline__ void pool_load(const Args& A, int unit, u32x4 (&mreg)[4], u32x2v (&ereg)[5]) {
    const int t = threadIdx.x; const int tt = unit >> 2, g = unit & 3;
    const unsigned short* UU = (const unsigned short*)(A.ws + WS_UU);
    const bf16_t* PM = (const bf16_t*)(A.ws + WS_PMIX) + (size_t)g * 16384;
#pragma unroll
    for (int i = 0; i < 4; ++i) { const int idx = i * 512 + t, d = idx >> 4, c8 = idx & 15; mreg[i] = *(const u32x4*)(PM + d * 128 + c8 * 8); }
    const int b = tt >> 5, t0 = (tt & 31) * 64;
#pragma unroll
    for (int i5 = 0; i5 < 5; ++i5) { const int idx = i5 * 512 + t, i = idx >> 5, c4 = idx & 31; const int tp = t0 - 15 + i;
        ereg[i5] = (u32x2v){0u, 0u}; if (idx < 79 * 32 && tp >= 0) ereg[i5] = *(const u32x2v*)(UU + (size_t)(b * SEQ + tp) * HW + g * 128 + c4 * 4); }
}
__device__ __forceinline__ void pool_unit(const Args& A, unsigned char* lds, int unit, int next, u32x4 (&mreg)[4], u32x2v (&ereg)[5]) {
    const int t = threadIdx.x, w = t >> 6, l = t & 63, lr = l & 15, lq = l >> 4;
    const int tt = unit >> 2, g = unit & 3, win = 2 << g;
    unsigned char* ws = A.ws;
    float* ext = (float*)(lds + LP_EXT); bf16_t* pl = (bf16_t*)(lds + LP_PL); bf16_t* mx = (bf16_t*)(lds + LP_MX);
    const unsigned short* UU = (const unsigned short*)(ws + WS_UU);
    {
#pragma unroll
        for (int i = 0; i < 4; ++i) { const int idx = i * 512 + t, d = idx >> 4, c8 = idx & 15; *(u32x4*)(mx + d * 136 + c8 * 8) = mreg[i]; }
    }
    int rowbase;
    {
        const int b = tt >> 5, t0 = (tt & 31) * 64; rowbase = b * SEQ + t0;
#pragma unroll
        for (int i5 = 0; i5 < 5; ++i5) { const int idx = i5 * 512 + t, i = idx >> 5, c4 = idx & 31; if (idx < 79 * 32) *(f32x4*)(ext + i * 128 + c4 * 4) = (f32x4){h_lo(ereg[i5].x), h_hi(ereg[i5].x), h_lo(ereg[i5].y), h_hi(ereg[i5].y)}; }
        if (next >= 0) pool_load(A, next, mreg, ereg);
        __syncthreads();
        const int cch = t & 127, tg = t >> 7, tk0 = tg * 16;
        float nw[16], od[16], ini[16];
#pragma unroll
        for (int i = 0; i < 16; ++i) { nw[i] = ext[(15 + tk0 + i) * 128 + cch]; od[i] = (i >= 1) ? ext[(15 + tk0 + i - win) * 128 + cch] : 0.f; ini[i] = (i >= 1 && i < win) ? ext[(15 + tk0 - i) * 128 + cch] : 0.f; }
        float sw = 0.f;
#pragma unroll
        for (int i = 1; i < 16; ++i) sw += ini[i];
#pragma unroll
        for (int i = 0; i < 16; ++i) { const int tok = tk0 + i; sw += nw[i]; sw -= od[i];
            const int cnt = min(t0 + tok + 1, win);
            pl[tok * 136 + cch] = (bf16_t)f2bf(sw / (float)cnt - nw[i]); }
    }
    __syncthreads();
    const int ct = w & 3, dh = w >> 2;
    f32x4 o4[4];
#pragma unroll
    for (int i = 0; i < 4; ++i) o4[i] = (f32x4){0.f, 0.f, 0.f, 0.f};
#pragma unroll
    for (int ks = 0; ks < 4; ++ks) { const bf16x8 a = *(const bf16x8*)(pl + (16 * ct + lr) * 136 + ks * 32 + lq * 8);
#pragma unroll
        for (int i = 0; i < 4; ++i) { const int dt = dh * 4 + i; const bf16x8 bb = *(const bf16x8*)(mx + (16 * dt + lr) * 136 + ks * 32 + lq * 8); o4[i] = MFMA16(a, bb, o4[i]); } }
    bf16_t* MIX = (bf16_t*)(ws + WS_MIX); const float* psc = A.in[12];
    float* ost = (float*)(lds + LP_EXT);
#pragma unroll
    for (int i = 0; i < 4; ++i) { const int d = (dh * 4 + i) * 16 + lr; const float sc = psc[g * 128 + d];
#pragma unroll
        for (int r = 0; r < 4; ++r) ost[(16 * ct + lq * 4 + r) * 132 + d] = o4[i][r] * sc; }
    __syncthreads();
    {   const int tok = t >> 3, d0 = (t & 7) * 16;
#pragma unroll
        for (int hh = 0; hh < 2; ++hh) { const f32x4 oa = *(const f32x4*)(ost + tok * 132 + d0 + hh * 8), ob = *(const f32x4*)(ost + tok * 132 + d0 + hh * 8 + 4);
            u32x4 o; o.x = pk2(oa[0], oa[1]); o.y = pk2(oa[2], oa[3]); o.z = pk2(ob[0], ob[1]); o.w = pk2(ob[2], ob[3]);
            *(u32x4*)(MIX + (size_t)(rowbase + tok) * DM + 512 + g * 128 + d0 + hh * 8) = o; } }
    __syncthreads();
}

__device__ __forceinline__ void pool_sample_unit(const Args& A, unsigned char* lds, int unit) {
    const int t = threadIdx.x, w = t >> 6, l = t & 63, lr = l & 15, lq = l >> 4;
    const int su = unit >> 2, g = unit & 3, win = 2 << g;
    unsigned char* ws = A.ws;
    bf16_t* pl = (bf16_t*)(lds + LP_PL); bf16_t* mx = (bf16_t*)(lds + LP_MX);
    const _Float16* UU = (const _Float16*)(ws + WS_UU);
    const bf16_t* PM = (const bf16_t*)(ws + WS_PMIX) + (size_t)g * 16384;
    u32x4 mreg[4];
#pragma unroll
    for (int i = 0; i < 4; ++i) { const int idx = i * 512 + t, d = idx >> 4, c8 = idx & 15; mreg[i] = *(const u32x4*)(PM + d * 128 + c8 * 8); }
    const int cch = t & 127, sq = t >> 7;
    const float psc_w = A.in[12][g * 128 + 16 * w + lr];
#pragma unroll
    for (int i = 0; i < 4; ++i) { const int tok = sq * 4 + i, sb = su * 16 + tok; const float uv = (float)UU[(size_t)(NPR + sb) * HW + g * 128 + cch];
        float pv[15];
#pragma unroll
        for (int j = 0; j < 15; ++j) pv[j] = A.in[4][(size_t)(sb * 15 + j) * 512 + g * 128 + cch];
        float sacc = uv;
#pragma unroll
        for (int j = 0; j < 15; ++j) sacc += (j >= 16 - win) ? pv[j] : 0.f;
        pl[tok * 136 + cch] = (bf16_t)f2bf(sacc / (float)win - uv); }
#pragma unroll
    for (int i = 0; i < 4; ++i) { const int idx = i * 512 + t, d = idx >> 4, c8 = idx & 15; *(u32x4*)(mx + d * 136 + c8 * 8) = mreg[i]; }
    __syncthreads();
    f32x4 acc = (f32x4){0.f, 0.f, 0.f, 0.f};
#pragma unroll
    for (int ks = 0; ks < 4; ++ks) { const bf16x8 a = *(const bf16x8*)(pl + lr * 136 + ks * 32 + lq * 8); const bf16x8 bb = *(const bf16x8*)(mx + (16 * w + lr) * 136 + ks * 32 + lq * 8); acc = MFMA16(a, bb, acc); }
    bf16_t* MIX = (bf16_t*)(ws + WS_MIX);
#pragma unroll
    for (int r = 0; r < 4; ++r) MIX[(size_t)(NPR + su * 16 + lq * 4 + r) * DM + 512 + g * 128 + 16 * w + lr] = (bf16_t)f2bf(acc[r] * psc_w);
    __syncthreads();
}

__device__ __forceinline__ void attn_prompt_unit(const Args& A, unsigned char* lds, int unit) {
    const int t = threadIdx.x, w = t >> 6, l = t & 63, lr = l & 15, lq = l >> 4;
    const int qt = unit & 15, h = (unit >> 4) & 3, b = unit >> 6;
    unsigned char* ws = A.ws;
    const bf16_t* Q = (const bf16_t*)(ws + WS_Q); const bf16_t* KB = (const bf16_t*)(ws + WS_KB); const bf16_t* VT = (const bf16_t*)(ws + WS_VT); bf16_t* O = (bf16_t*)(ws + WS_O);
    const int R0 = b * SEQ + qt * 128 + 16 * w;
    bf16_t* CB = (bf16_t*)lds;
    bf16_t* Pw = (bf16_t*)(lds + 73728) + w * (16 * 264);
    const bf16_t* kg = KB + (size_t)(b * 256) * DM + h * 256;
    const bf16_t* vg = VT + (size_t)(h * 256) * MEMR + b * 256;
    u32x4 stg0[4], stg1[4];
#define AT_LOADK(c, STG) _Pragma("unroll") for (int i_ = 0; i_ < 4; ++i_) { const int idx_ = i_ * 512 + t; STG[i_] = *(const u32x4*)(kg + (size_t)((c) * 64 + (idx_ >> 5)) * DM + (idx_ & 31) * 8); }
#define AT_LOADV(c, STG) _Pragma("unroll") for (int i_ = 0; i_ < 4; ++i_) { const int idx_ = i_ * 512 + t; STG[i_] = *(const u32x4*)(vg + (size_t)(idx_ >> 3) * MEMR + (c) * 64 + (idx_ & 7) * 8); }
#define AT_STOREK(bf, STG) _Pragma("unroll") for (int i_ = 0; i_ < 4; ++i_) { const int idx_ = i_ * 512 + t; *(u32x4*)(CB + (bf) * 18432 + (idx_ >> 5) * 264 + (idx_ & 31) * 8) = STG[i_]; }
#define AT_STOREV(bf, STG) _Pragma("unroll") for (int i_ = 0; i_ < 4; ++i_) { const int idx_ = i_ * 512 + t; *(u32x4*)(CB + (bf) * 18432 + (idx_ >> 3) * 72 + (idx_ & 7) * 8) = STG[i_]; }
    AT_LOADK(0, stg0); AT_LOADK(1, stg1);
    bf16x8 qa[8];
#pragma unroll
    for (int ks = 0; ks < 8; ++ks) qa[ks] = *(const bf16x8*)(Q + (size_t)(R0 + lr) * DM + h * 256 + ks * 32 + lq * 8);
    AT_STOREK(0, stg0);
    __syncthreads();
    f32x4 sacc[16]; f32x4 oacc[16]; bf16x8 pa[8]; float rinv[4];
#pragma unroll
    for (int st = 0; st < 8; ++st) {
        if (st & 1) { if (st + 2 < 4) { AT_LOADK(st + 2, stg1); } else if (st + 2 < 8) { AT_LOADV(st - 2, stg1); } }
        else        { if (st + 2 < 4) { AT_LOADK(st + 2, stg0); } else if (st + 2 < 8) { AT_LOADV(st - 2, stg0); } }
        const bf16_t* cb = CB + (st & 1) * 18432;
        if (st < 4) {
#pragma unroll
            for (int nt = 0; nt < 4; ++nt) { f32x4 acc = (f32x4){0.f, 0.f, 0.f, 0.f};
#pragma unroll
                for (int ks = 0; ks < 8; ++ks) { const bf16x8 bb = *(const bf16x8*)(cb + (nt * 16 + lr) * 264 + ks * 32 + lq * 8); acc = MFMA16(qa[ks], bb, acc); }
                sacc[st * 4 + nt] = acc; __builtin_amdgcn_sched_barrier(0); }
        } else {
            if (st == 4) {
#pragma unroll
                for (int r = 0; r < 4; ++r) { float mx = sacc[0][r];
#pragma unroll
                    for (int nt = 1; nt < 16; ++nt) mx = fmaxf(mx, sacc[nt][r]);
                    mx = fmaxf(mx, __shfl_xor(mx, 1)); mx = fmaxf(mx, __shfl_xor(mx, 2)); mx = fmaxf(mx, __shfl_xor(mx, 4)); mx = fmaxf(mx, __shfl_xor(mx, 8));
                    float sum = 0.f;
#pragma unroll
                    for (int nt = 0; nt < 16; ++nt) { const float p = __builtin_amdgcn_exp2f(sacc[nt][r] - mx); sum += p; Pw[(lq * 4 + r) * 264 + nt * 16 + lr] = (bf16_t)f2bf(p); }
                    sum += __shfl_xor(sum, 1); sum += __shfl_xor(sum, 2); sum += __shfl_xor(sum, 4); sum += __shfl_xor(sum, 8);
                    rinv[r] = 1.0f / sum; }
                asm volatile("s_waitcnt lgkmcnt(0)" ::: "memory");
#pragma unroll
                for (int ks = 0; ks < 8; ++ks) pa[ks] = *(const bf16x8*)(Pw + lr * 264 + ks * 32 + lq * 8);
#pragma unroll
                for (int dt = 0; dt < 16; ++dt) oacc[dt] = (f32x4){0.f, 0.f, 0.f, 0.f};
            }
            const int c = st - 4;
#pragma unroll
            for (int dt = 0; dt < 16; ++dt)
#pragma unroll
                for (int k2 = 0; k2 < 2; ++k2) { const bf16x8 bb = *(const bf16x8*)(cb + (dt * 16 + lr) * 72 + k2 * 32 + lq * 8); oacc[dt] = MFMA16(pa[c * 2 + k2], bb, oacc[dt]); if (k2 == 1 && (dt & 1)) __builtin_amdgcn_sched_barrier(0); }
        }
        if (st & 1) { if (st + 1 < 4) { AT_STOREK(0, stg0); } else if (st + 1 < 8) { AT_STOREV(0, stg0); } }
        else        { if (st + 1 < 4) { AT_STOREK(1, stg1); } else if (st + 1 < 8) { AT_STOREV(1, stg1); } }
        __syncthreads();
    }
#pragma unroll
    for (int dt = 0; dt < 16; ++dt)
#pragma unroll
        for (int r = 0; r < 4; ++r) Pw[(lq * 4 + r) * 264 + dt * 16 + lr] = (bf16_t)f2bf(oacc[dt][r] * rinv[r]);
    asm volatile("s_waitcnt lgkmcnt(0)" ::: "memory");
#pragma unroll
    for (int i = 0; i < 8; ++i) { const int idx = i * 64 + l, row = idx >> 5, c8 = idx & 31; *(u32x4*)(O + (size_t)(R0 + row) * DM + h * 256 + c8 * 8) = *(const u32x4*)(Pw + row * 264 + c8 * 8); }
    asm volatile("s_waitcnt lgkmcnt(0)" ::: "memory");
#undef AT_LOADK
#undef AT_LOADV
#undef AT_STOREK
#undef AT_STOREV
}
__device__ __forceinline__ void attn_sample_unit(const Args& A, unsigned char* lds, int unit) {
    const int t = threadIdx.x, w = t >> 6, l = t & 63;
    const int b = unit >> 2, h = unit & 3;
    unsigned char* ws = A.ws;
    float* qs = (float*)lds; float* sc = qs + 256; float* red = sc + 256; float* po = red + 16;
    const float* Kc = A.in[5] + (size_t)b * 256 * 1024 + h * 256; const float* Vc = A.in[6] + (size_t)b * 256 * 1024 + h * 256;
    const int rl = l >> 4, c16 = l & 15;
    f32x4 kr[8][4];
#pragma unroll
    for (int p = 0; p < 8; ++p)
#pragma unroll
        for (int i = 0; i < 4; ++i) kr[p][i] = *(const f32x4*)(Kc + (size_t)(p * 32 + w * 4 + rl) * 1024 + i * 64 + c16 * 4);
    if (t < 256) qs[t] = bf2f(((const bf16_t*)(ws + WS_Q))[(size_t)(NPR + b) * DM + h * 256 + t]);
    __syncthreads();
    {
        f32x4 q4[4];
#pragma unroll
        for (int i = 0; i < 4; ++i) q4[i] = *(const f32x4*)(qs + i * 64 + c16 * 4);
#pragma unroll
        for (int p = 0; p < 8; ++p) { const int m = p * 32 + w * 4 + rl; float s = 0.f;
#pragma unroll
            for (int i = 0; i < 4; ++i) { const f32x4 kv = kr[p][i]; s += (kv[0] * q4[i][0] + kv[1] * q4[i][1]) + (kv[2] * q4[i][2] + kv[3] * q4[i][3]); }
            s += __shfl_xor(s, 1); s += __shfl_xor(s, 2); s += __shfl_xor(s, 4); s += __shfl_xor(s, 8);
            if (c16 == 0) sc[m] = s; }
    }
    f32x4 vr[32];
#pragma unroll
    for (int i = 0; i < 32; ++i) vr[i] = *(const f32x4*)(Vc + (size_t)(w * 32 + i) * 1024 + l * 4);
    __syncthreads();
    if (t < 256) { float mx = sc[t];
#pragma unroll
        for (int o = 1; o < 64; o <<= 1) mx = fmaxf(mx, __shfl_xor(mx, o));
        if (l == 0) red[w] = mx; }
    __syncthreads();
    const float gmx = fmaxf(fmaxf(red[0], red[1]), fmaxf(red[2], red[3]));
    float pv = 0.f;
    if (t < 256) { pv = __builtin_amdgcn_exp2f(sc[t] - gmx); const float s = wave_sum(pv); if (l == 0) red[8 + w] = s; }
    __syncthreads();
    if (t < 256) sc[t] = pv;
    const float inv = 1.0f / ((red[8] + red[9]) + (red[10] + red[11]));
    __syncthreads();
    {
        f32x4 o = (f32x4){0.f, 0.f, 0.f, 0.f};
#pragma unroll
        for (int i = 0; i < 32; ++i) o += vr[i] * sc[w * 32 + i];
        *(f32x4*)(po + w * 256 + l * 4) = o;
    }
    __syncthreads();
    if (t < 256) { float o = 0.f;
#pragma unroll
        for (int i = 0; i < 8; ++i) o += po[i * 256 + t];
        ((bf16_t*)(ws + WS_O))[(size_t)(NPR + b) * DM + h * 256 + t] = (bf16_t)f2bf(o * inv); }
    __syncthreads();
}

template <int KIND, int NKS>
__device__ __forceinline__ void sample_gemm(unsigned char* lds, const bf16_t* Asm, int lda, const bf16_t* Bt, int K, int unit, const float* base, const bf16_t* baseb, float* out, bf16_t* outb, float* ss, float scale) {
    const int t = threadIdx.x, w = t >> 6, l = t & 63, lr = l & 15, lq = l >> 4;
    const int rb = unit & 3, cb = unit >> 2, kw = K >> 3, k0 = w * kw;
    f32x4 acc[2]; acc[0] = (f32x4){0.f, 0.f, 0.f, 0.f}; acc[1] = acc[0];
    const bf16_t* bp = Bt + (size_t)(cb * 16 + lr) * K + k0 + lq * 8;
    const bf16_t* ap = Asm + (size_t)(rb * 32 + lr) * lda + k0 + lq * 8;
    bf16x8 fb[NKS], fa0[NKS], fa1[NKS];
#pragma unroll
    for (int ks = 0; ks < NKS; ++ks) { fb[ks] = *(const bf16x8*)(bp + ks * 32); fa0[ks] = *(const bf16x8*)(ap + ks * 32); fa1[ks] = *(const bf16x8*)(ap + (size_t)16 * lda + ks * 32); }
    const int row_ = t >> 4, col_ = t & 15;
    float bres = 0.f;
    if (KIND == 0) bres = base ? base[(size_t)(rb * 32 + row_) * DM + cb * 16 + col_] : bf2f(baseb[(size_t)(rb * 32 + row_) * DM + cb * 16 + col_]);
#pragma unroll
    for (int ks = 0; ks < NKS; ++ks) { acc[0] = MFMA16(fa0[ks], fb[ks], acc[0]); acc[1] = MFMA16(fa1[ks], fb[ks], acc[1]); }
    float* red = (float*)lds;
#pragma unroll
    for (int i = 0; i < 2; ++i)
#pragma unroll
        for (int r = 0; r < 4; ++r) red[(w * 32 + i * 16 + lq * 4 + r) * 16 + lr] = acc[i][r];
    __syncthreads();
    const int row = t >> 4, col = t & 15, grow = rb * 32 + row, gcol = cb * 16 + col;
    float v = 0.f;
#pragma unroll
    for (int i = 0; i < 8; ++i) v += red[(i * 32 + row) * 16 + col];
    if (KIND == 0) { const float val = bres + v; if (out) out[(size_t)grow * DM + gcol] = val; if (outb) outb[(size_t)grow * DM + gcol] = (bf16_t)f2bf(val);
        float sq = val * val; sq += __shfl_xor(sq, 1); sq += __shfl_xor(sq, 2); sq += __shfl_xor(sq, 4); sq += __shfl_xor(sq, 8);
        if (col == 0) atomicAdd(ss + grow, sq);
    } else { const float rstd = __builtin_amdgcn_rsqf(ss[grow] * (1.0f / DM) + EPS); outb[(size_t)grow * DM + gcol] = (bf16_t)f2bf(v * rstd * scale); }
    __syncthreads();
}

__device__ __forceinline__ void final_norm(const Args& A, int G, int row_lo) {
    const int lane = threadIdx.x & 63, gw = blockIdx.x * 8 + (threadIdx.x >> 6), NGW = G * 8;
    const float* ss = (const float*)(A.ws + WS_SS3); const f32x4* gr = (const f32x4*)A.in[22] + lane;
    f32x4 gg[4];
#pragma unroll
    for (int j = 0; j < 4; ++j) gg[j] = gr[64 * j];
    for (int m0 = row_lo + gw * 4; m0 < NVALID; m0 += NGW * 4) {
        f32x4 v[4][4]; float sv[4];
#pragma unroll
        for (int r = 0; r < 4; ++r) { sv[r] = ss[m0 + r]; const f32x4* xr = (const f32x4*)(A.out + (size_t)(m0 + r) * DM) + lane;
#pragma unroll
            for (int j = 0; j < 4; ++j) v[r][j] = xr[64 * j]; }
#pragma unroll
        for (int r = 0; r < 4; ++r) { const float rstd = 1.0f / sqrtf(sv[r] * (1.f / DM) + EPS); f32x4* xr = (f32x4*)(A.out + (size_t)(m0 + r) * DM) + lane;
#pragma unroll
            for (int j = 0; j < 4; ++j) xr[64 * j] = v[r][j] * rstd * gg[j]; } }
}

constexpr int NPHASES = 12;
#ifndef REPMASK
#define REPMASK 0
#endif
#define REPS(k) for (int rep_ = 0; rep_ < 1 + ((REPMASK >> (k)) & 1); ++rep_)
__global__ void __launch_bounds__(NTHREADS, 2) fwd_megakernel(Args args) {
    extern __shared__ __attribute__((aligned(16))) unsigned char lds[];
    cg::grid_group grid = cg::this_grid();
    const int G = gridDim.x, bx = blockIdx.x;
    unsigned char* ws = args.ws;
    PG8_LAS unsigned char* lds3 = (PG8_LAS unsigned char*)lds;
    const int lo = args.ph_lo, hi = args.ph_hi;
#define IN(k) (lo <= (k) && (k) < hi)
#ifndef SPINBLK
#define SPINBLK 0
#endif
#ifdef SPINMASK
    unsigned long long t_prev_ = __builtin_amdgcn_s_memrealtime(), t_acc_ = 0ull;
#define STAMP(k) do { const unsigned long long t_now_ = __builtin_amdgcn_s_memrealtime(); if ((SPINMASK >> (k)) & 1) t_acc_ += t_now_ - t_prev_; t_prev_ = t_now_; } while (0)
#else
#define STAMP(k) do { } while (0)
#endif
#define SEAM(k) do { if (IN(k) && IN((k) + 1)) xcd_barrier(bar); STAMP(k); } while (0)
    if (lo < 0) grid.sync();
    volatile LAS unsigned* MISC = (volatile LAS unsigned*)(lds3 + LDS_BYTES - 64);
    if (threadIdx.x < 16) MISC[threadIdx.x] = 0u;
    __syncthreads();
    XcdBarrier bar = xcd_barrier_post((unsigned*)(ws + WS_BAR), MISC);
    if (IN(0)) REPS(0) { p0_prologue(args, lds, G); }
    SEAM(0);
    if (IN(1)) REPS(1) {
        {   pg8::Gemm g{(const bf16_t*)(ws + WS_H0), (const bf16_t*)(ws + WS_WIN), MT, NIN, DM}; pg8::StaticOrder S; S.init(MT, NIN, G, bx);
            pg8::EpiInProj E{(bf16_t*)(ws + WS_QQ), (bf16_t*)(ws + WS_KK), (bf16_t*)(ws + WS_VV), (bf16_t*)(ws + WS_GG), (unsigned short*)(ws + WS_LF), (unsigned short*)(ws + WS_UU), args.in[9]};
            pg8::gemm_phase<pg8::EpiInProj, pg8::StaticOrder, true, true>(lds3, g, S, E); }
        {   pg8::Gemm g{(const bf16_t*)(ws + WS_MEMH), (const bf16_t*)(ws + WS_WKV), MEMR, 2 * DM, DM}; pg8::StaticOrder S; S.init(MEMR, 2 * DM, G, (bx + G - (650 % G)) % G);
            pg8::EpiMemKV E{args.out + O_MK, args.out + O_MV, (bf16_t*)(ws + WS_KB)};
            pg8::gemm_phase<pg8::EpiMemKV, pg8::StaticOrder, true, true>(lds3, g, S, E); }
        {   pg8::Gemm g{(const bf16_t*)(ws + WS_WKV) + (size_t)DM * DM, (const bf16_t*)(ws + WS_MEMH), DM, MEMR, DM}; pg8::StaticOrder S; S.init(DM, MEMR, G, (bx + 2 * G - ((650 + 64) % G)) % G);
            pg8::EpiBf16Scale E{(bf16_t*)(ws + WS_VT), MEMR, nullptr, 1.0f};
            pg8::gemm_phase<pg8::EpiBf16Scale, pg8::StaticOrder, true, true>(lds3, g, S, E); }
    }
    SEAM(1);
    if (IN(2)) REPS(2) {
        {   f32x4 sreg[8]; if (bx < 512) hgrn_sample_load(args, bx, sreg);
            for (int u = bx; u < 512; u += G) hgrn_sample_unit(args, lds, u, (u + G < 512) ? u + G : -1, sreg); }
        {   u32x2v lf[4]; u32x4 kkr[2], vvr[2]; if (bx < 1024) hgrn_local_load(args, bx, lf, kkr, vvr);
            for (int u = bx; u < 1024; u += G) hgrn_local_unit(args, lds, u, (u + G < 1024) ? u + G : -1, lf, kkr, vvr); }
    }
    SEAM(2);
    if (IN(3)) REPS(3) { for (int u = bx; u < 32; u += G) pool_sample_unit(args, lds, u); hgrn_scan(args, G); pool_states(args, G); }
    SEAM(3);
    if (IN(4)) REPS(4) {
        {   u32x2v lf[4]; u32x4 qqr[2], kkr[2], vvr[2], spr[4]; if (bx < 1024) hgrn_out_load(args, bx, lf, qqr, kkr, vvr, spr);
            for (int u = bx; u < 1024; u += G) hgrn_out_unit(args, lds, u, (u + G < 1024) ? u + G : -1, lf, qqr, kkr, vvr, spr); }
        STAMP(12);
        {   u32x4 mreg[4]; u32x2v ereg[5]; if (bx < 1024) pool_load(args, bx, mreg, ereg);
            for (int u = bx; u < 1024; u += G) pool_unit(args, lds, u, (u + G < 1024) ? u + G : -1, mreg, ereg); }
        STAMP(13);
    }
    SEAM(4);
    if (IN(5)) REPS(5) {
        pg8::Gemm g{(const bf16_t*)(ws + WS_MIX), (const bf16_t*)(ws + WS_WOUT), NPR, DM, DM}; pg8::StaticOrder S; S.init(NPR, DM, G, bx);
        pg8::EpiResid E{args.in[0], nullptr, nullptr, (bf16_t*)(ws + WS_H0), (float*)(ws + (rep_ ? WS_SSD : WS_SS1))};
        pg8::gemm_phase<pg8::EpiResid, pg8::StaticOrder, true, true>(lds3, g, S, E);
        for (int u = bx; u < 256; u += G) sample_gemm<0, 4>(lds, (const bf16_t*)(ws + WS_MIX) + (size_t)NPR * DM, DM, (const bf16_t*)(ws + WS_WOUT), DM, u, args.in[1], nullptr, nullptr, (bf16_t*)(ws + WS_H0) + (size_t)NPR * DM, (float*)(ws + (rep_ ? WS_SSD : WS_SS1)) + NPR, 1.0f);
    }
    SEAM(5);
    if (IN(6)) REPS(6) {
        pg8::Gemm g{(const bf16_t*)(ws + WS_H0), (const bf16_t*)(ws + WS_WCQ), NPR, DM, DM}; pg8::StaticOrder S; S.init(NPR, DM, G, bx);
        pg8::EpiBf16Scale E{(bf16_t*)(ws + WS_Q), DM, (const float*)(ws + WS_SS1), 0.0625f * 1.4426950408889634f};
        pg8::gemm_phase<pg8::EpiBf16Scale, pg8::StaticOrder, true, true>(lds3, g, S, E);
        for (int u = bx; u < 256; u += G) sample_gemm<1, 4>(lds, (const bf16_t*)(ws + WS_H0) + (size_t)NPR * DM, DM, (const bf16_t*)(ws + WS_WCQ), DM, u, nullptr, nullptr, nullptr, (bf16_t*)(ws + WS_Q) + (size_t)NPR * DM, (float*)(ws + WS_SS1) + NPR, 0.0625f * 1.4426950408889634f);
    }
    SEAM(6);
    if (IN(7)) REPS(7) {
        REPS(16) for (int u = bx; u < 512; u += G) attn_sample_unit(args, lds, u);
        REPS(17) for (int u = bx; u < 512; u += G) attn_prompt_unit(args, lds, u);
    }
    SEAM(7);
    if (IN(8)) REPS(8) {
        pg8::Gemm g{(const bf16_t*)(ws + WS_O), (const bf16_t*)(ws + WS_WCO), NPR, DM, DM}; pg8::StaticOrder S; S.init(NPR, DM, G, bx);
        pg8::EpiResid E{nullptr, (const bf16_t*)(ws + WS_H0), nullptr, (bf16_t*)(ws + WS_MIX), (float*)(ws + (rep_ ? WS_SSD : WS_SS2))};
        pg8::gemm_phase<pg8::EpiResid, pg8::StaticOrder, true, true>(lds3, g, S, E);
        for (int u = bx; u < 256; u += G) sample_gemm<0, 4>(lds, (const bf16_t*)(ws + WS_O) + (size_t)NPR * DM, DM, (const bf16_t*)(ws + WS_WCO), DM, u, nullptr, (const bf16_t*)(ws + WS_H0) + (size_t)NPR * DM, nullptr, (bf16_t*)(ws + WS_MIX) + (size_t)NPR * DM, (float*)(ws + (rep_ ? WS_SSD : WS_SS2)) + NPR, 1.0f);
    }
    SEAM(8);
    if (IN(9)) REPS(9) {
        pg8::Gemm g{(const bf16_t*)(ws + WS_MIX), (const bf16_t*)(ws + WS_WFFI), MT, NFF2, DM}; pg8::StaticOrder S; S.init(MT, NFF2, G, bx);
        pg8::EpiSwiGLU E{(bf16_t*)(ws + WS_A), (const float*)(ws + WS_SS2)};
        pg8::gemm_phase<pg8::EpiSwiGLU, pg8::StaticOrder, true, true>(lds3, g, S, E);
    }
    SEAM(9);
    if (IN(10)) {
        pg8::Gemm g{(const bf16_t*)(ws + WS_A), (const bf16_t*)(ws + WS_WFFO), NPR, DM, DFF}; pg8::StaticOrder S; S.init(NPR, DM, G, bx);
        if (G == 256) {
            pg8::EpiResidNorm E{(const bf16_t*)(ws + WS_MIX), args.out, (float*)(ws + WS_SS3), (unsigned*)(ws + WS_CNT), args.in[22]};
            pg8::gemm_phase<pg8::EpiResidNorm, pg8::StaticOrder, false, true>(lds3, g, S, E);
        } else {
            pg8::EpiResid E{nullptr, (const bf16_t*)(ws + WS_MIX), args.out, nullptr, (float*)(ws + WS_SS3)};
            pg8::gemm_phase<pg8::EpiResid, pg8::StaticOrder, true, true>(lds3, g, S, E);
        }
        for (int u = bx; u < 256; u += G) sample_gemm<0, 11>(lds, (const bf16_t*)(ws + WS_A) + (size_t)NPR * DFF, DFF, (const bf16_t*)(ws + WS_WFFO), DFF, u, nullptr, (const bf16_t*)(ws + WS_MIX) + (size_t)NPR * DM, args.out + O_YS, nullptr, (float*)(ws + WS_SS3) + NPR, 1.0f);
    }
    SEAM(10);
#ifdef EXTRA_SYNCS
    for (int i_ = 0; i_ < EXTRA_SYNCS; ++i_) xcd_barrier(bar);
#endif
    if (IN(11)) { final_norm(args, G, G == 256 ? NPR : 0); }
#ifdef SPINMASK
    STAMP(11);
    if (bx == SPINBLK && threadIdx.x == 0) { const unsigned long long t0_ = __builtin_amdgcn_s_memrealtime(); while (__builtin_amdgcn_s_memrealtime() - t0_ < t_acc_) __builtin_amdgcn_s_sleep(8); }
#endif
#undef IN
#undef SEAM
}

#ifndef MK_MULTI
#define MK_MULTI 0
#endif
extern "C" void kernel_launch(void* const* d_in, const int* in_sizes, int n_in, void* d_out, int out_size, void* d_ws, size_t ws_size, hipStream_t stream) {
    static int grid = 0;
    if (grid == 0) {
        if (n_in != 23 || ws_size < WS_END) { fprintf(stderr, "kernel_launch: unexpected n_in %d / ws_size %zu\n", n_in, ws_size); grid = -1; return; }
        int dev = 0, cus = 0, per_cu = 0;
        hipGetDevice(&dev); hipDeviceGetAttribute(&cus, hipDeviceAttributeMultiprocessorCount, dev);
        if (hipFuncSetAttribute((const void*)fwd_megakernel, hipFuncAttributeMaxDynamicSharedMemorySize, LDS_BYTES) != hipSuccess) { fprintf(stderr, "kernel_launch: hipFuncSetAttribute failed\n"); grid = -1; return; }
        hipOccupancyMaxActiveBlocksPerMultiprocessor(&per_cu, (const void*)fwd_megakernel, NTHREADS, LDS_BYTES);
        (void)hipGetLastError();
        if (per_cu < 1) { fprintf(stderr, "kernel_launch: occupancy query says %d blocks/CU\n", per_cu); per_cu = 1; }
        grid = cus;
    }
    if (grid < 0) return;
    Args a{};
    for (int i = 0; i < 23; ++i) a.in[i] = (const float*)d_in[i];
    a.out = (float*)d_out; a.ws = (unsigned char*)d_ws;
#if MK_MULTI
    for (int p = 0; p < NPHASES; ++p) { a.ph_lo = p; a.ph_hi = p + 1; hipLaunchKernelGGL(fwd_megakernel, dim3(grid), dim3(NTHREADS), LDS_BYTES, stream, a); }
#else
    a.ph_lo = 0; a.ph_hi = NPHASES;
    if (hipMemsetAsync((char*)d_ws + WS_BAR, 0, BAR_BYTES, stream) != hipSuccess) { fprintf(stderr, "kernel_launch: memset failed\n"); return; }
    void* kargs[] = {&a};
    hipError_t e = hipLaunchCooperativeKernel((const void*)fwd_megakernel, dim3(grid), dim3(NTHREADS), kargs, LDS_BYTES, stream);
    if (e != hipSuccess) fprintf(stderr, "kernel_launch: cooperative launch failed: %s (grid %d)\n", hipGetErrorString(e), grid);
#endif
}
```

```cpp
#include <hip/hip_runtime.h>
#include <hip/hip_cooperative_groups.h>
#include <cstdio>
#include <cstdint>
namespace cg = cooperative_groups;
namespace pg8 {
#define PG8_LAS __attribute__((address_space(3)))
typedef unsigned short bf16_t;
typedef short bf16x8 __attribute__((ext_vector_type(8)));
typedef float f32x4 __attribute__((ext_vector_type(4)));
typedef unsigned u32x4 __attribute__((ext_vector_type(4)));
constexpr int BM = 256, BK = 64, HALF = 128, HTB = HALF * BK * 2  , STAGE_BYTES = 8 * HTB, NXCD = 8, WGM = 8;

__host__ __device__ __forceinline__ int lds_byte(int r, int c) { const int st = (r >> 4) * 2 + (c >> 5), rr = r & 15, cc = c & 31, ob = rr * 64 + cc * 2; return st * 1024 + (ob ^ (((ob >> 9) & 1) << 5)); }
__host__ __device__ __forceinline__ void stage_rc(int b, int& R, int& C) { const int st = b / 1024, sb = b % 1024, swz = sb ^ (((sb >> 9) & 1) << 5); R = (st >> 1) * 16 + swz / 64; C = (st & 1) * 32 + (swz % 64) / 2; }
__host__ __device__ __forceinline__ int perm32(int rho) { const int n = rho >> 4, i = rho & 15; return 8 * (i >> 2) + 4 * n + (i & 3); }

struct Unit { int pm, pn; };
struct Gemm { const bf16_t* A; const bf16_t* Bt; int M, N, K; };

struct StaticOrder {
    int nM, nN, nwg, G, c;
    __host__ __device__ void init(int M, int N, int G_, int c_) { nM = M / BM; nN = N / BM; nwg = nM * nN; G = G_; c = c_; }
    __host__ __device__ bool next(int i, Unit& u) const {
        const long L = (long)i * G + c; if (L >= nwg) return false;
        int wgid = (int)L; { const int q = nwg / NXCD, r = nwg % NXCD, xcd = wgid % NXCD, off = wgid / NXCD; wgid = (xcd < r ? xcd * (q + 1) : r * (q + 1) + (xcd - r) * q) + off; }
        const int nig = WGM * nN, gid = wgid / nig, fm = gid * WGM, gsz = (nM - fm) < WGM ? (nM - fm) : WGM;
        u.pm = fm + ((wgid % nig) % gsz); u.pn = (wgid % nig) / gsz; return true;
    }
    __device__ __forceinline__ void a_ready(const Unit&) const {}
    __device__ __forceinline__ void done(const Unit&) const {}
};

__device__ __forceinline__ unsigned cvt_pk_bf16(float lo, float hi) { unsigned r; asm volatile("v_cvt_pk_bf16_f32 %0, %1, %2" : "=v"(r) : "v"(lo), "v"(hi)); return r; }
typedef unsigned u32x2 __attribute__((ext_vector_type(2)));
__device__ __forceinline__ float sigm(float z) { return 1.0f / (1.0f + __expf(-z)); }
constexpr float RMS_EPS = 1e-6f;
#ifndef WT_STORES
#define WT_STORES 0
#endif
__device__ __forceinline__ void st16(void* p, u32x4 v) {
#if WT_STORES
    asm volatile("global_store_dwordx4 %0, %1, off sc1\n\ts_nop 1" :: "v"(p), "v"(v) : "memory");
#else
    *(u32x4*)p = v;
#endif
}
__device__ __forceinline__ void st16f(void* p, f32x4 v) { st16(p, __builtin_bit_cast(u32x4, v)); }
__device__ __forceinline__ void st8(void* p, u32x2 v) {
#if WT_STORES
    asm volatile("global_store_dwordx2 %0, %1, off sc1\n\ts_nop 1" :: "v"(p), "v"(v) : "memory");
#else
    *(u32x2*)p = v;
#endif
}
typedef _Float16 h2_t __attribute__((ext_vector_type(2)));
__device__ __forceinline__ unsigned pk_h2(float a, float b) { h2_t v; v.x = (_Float16)a; v.y = (_Float16)b; return __builtin_bit_cast(unsigned, v); }
__device__ __forceinline__ float h_lo(unsigned u) { return (float)__builtin_bit_cast(h2_t, u).x; }
__device__ __forceinline__ float h_hi(unsigned u) { return (float)__builtin_bit_cast(h2_t, u).y; }

struct EpiInProj {
    static constexpr bool PERM = true, AFTER_DRAIN = false;
    bf16_t *QQ, *KK, *VV, *GG; unsigned short *LF, *UU; const float* lbraw;
    __device__ __forceinline__ void operator()(const f32x4 (&acc)[2][2][4][2], const Unit& u, int wr, int wc, int fr, int fq) const {
        const int seg = u.pn >> 1, colt = (u.pn & 1) * 256;
        const int row0 = u.pm * BM + wr * 64 + fr;
#pragma unroll
        for (int bj = 0; bj < 2; ++bj) {
            const int cs = colt + bj * HALF + wc * 32 + 8 * fq;
            float lb[8];
            if (seg == 1) {
#pragma unroll
                for (int j = 0; j < 8; ++j) { const float l0 = lbraw[cs + j], l1 = lbraw[512 + cs + j]; lb[j] = 1.0f / (1.0f + __expf(l1 - l0)); }
            } else {
#pragma unroll
                for (int j = 0; j < 8; ++j) lb[j] = 0.f;
            }
#pragma unroll
            for (int ai = 0; ai < 2; ++ai)
#pragma unroll
                for (int m = 0; m < 4; ++m) {
                    const size_t off = (size_t)(row0 + ai * HALF + m * 16) * 512 + cs;
                    const f32x4 v0 = acc[ai][bj][m][0], v1 = acc[ai][bj][m][1];
                    float z[8] = {v0[0], v0[1], v0[2], v0[3], v1[0], v1[1], v1[2], v1[3]};
                    if (seg == 0) {
#pragma unroll
                        for (int j = 0; j < 8; ++j) z[j] = z[j] * sigm(z[j]);
                        u32x4 w; w.x = cvt_pk_bf16(z[0], z[1]); w.y = cvt_pk_bf16(z[2], z[3]); w.z = cvt_pk_bf16(z[4], z[5]); w.w = cvt_pk_bf16(z[6], z[7]);
                        st16(QQ + off, w);
                    } else if (seg == 1) {
                        float lf[8], kk[8];
#pragma unroll
                        for (int j = 0; j < 8; ++j) { const float e = __expf(-z[j]); const float sg = 1.0f / (1.0f + e); const float sgn = e / (1.0f + e);
                            lf[j] = __logf(lb[j] + (1.0f - lb[j]) * sg); kk[j] = (1.0f - lb[j]) * sgn; }
                        { u32x4 w; w.x = pk_h2(lf[0], lf[1]); w.y = pk_h2(lf[2], lf[3]); w.z = pk_h2(lf[4], lf[5]); w.w = pk_h2(lf[6], lf[7]); st16(LF + off, w); }
                        u32x4 w; w.x = cvt_pk_bf16(kk[0], kk[1]); w.y = cvt_pk_bf16(kk[2], kk[3]); w.z = cvt_pk_bf16(kk[4], kk[5]); w.w = cvt_pk_bf16(kk[6], kk[7]);
                        st16(KK + off, w);
                    } else if (seg == 2) {
                        u32x4 w; w.x = cvt_pk_bf16(z[0], z[1]); w.y = cvt_pk_bf16(z[2], z[3]); w.z = cvt_pk_bf16(z[4], z[5]); w.w = cvt_pk_bf16(z[6], z[7]);
                        st16(VV + off, w);
                    } else if (seg == 3) {
#pragma unroll
                        for (int j = 0; j < 8; ++j) z[j] = sigm(z[j]);
                        u32x4 w; w.x = cvt_pk_bf16(z[0], z[1]); w.y = cvt_pk_bf16(z[2], z[3]); w.z = cvt_pk_bf16(z[4], z[5]); w.w = cvt_pk_bf16(z[6], z[7]);
                        st16(GG + off, w);
                    } else {
                        u32x4 w; w.x = pk_h2(z[0], z[1]); w.y = pk_h2(z[2], z[3]); w.z = pk_h2(z[4], z[5]); w.w = pk_h2(z[6], z[7]); st16(UU + off, w);
                    }
                }
        }
    }
};

struct EpiMemKV {
    static constexpr bool PERM = true, AFTER_DRAIN = false;
    float *outK, *outV; bf16_t* KB;
    __device__ __forceinline__ void operator()(const f32x4 (&acc)[2][2][4][2], const Unit& u, int wr, int wc, int fr, int fq) const {
        const bool isk = u.pn < 4; float* o = isk ? outK : outV; const int colt = (u.pn & 3) * 256;
        const int row0 = u.pm * BM + wr * 64 + fr;
#pragma unroll
        for (int ai = 0; ai < 2; ++ai)
#pragma unroll
            for (int m = 0; m < 4; ++m)
#pragma unroll
                for (int bj = 0; bj < 2; ++bj) {
                    const size_t off = (size_t)(row0 + ai * HALF + m * 16) * 1024 + colt + bj * HALF + wc * 32 + 8 * fq;
                    const f32x4 v0 = acc[ai][bj][m][0], v1 = acc[ai][bj][m][1];
                    *(f32x4*)(o + off) = v0; *(f32x4*)(o + off + 4) = v1;
                    if (isk) { u32x4 w; w.x = cvt_pk_bf16(v0[0], v0[1]); w.y = cvt_pk_bf16(v0[2], v0[3]); w.z = cvt_pk_bf16(v1[0], v1[1]); w.w = cvt_pk_bf16(v1[2], v1[3]); *(u32x4*)(KB + off) = w; }
                }
    }
};

struct EpiBf16Scale {
    static constexpr bool PERM = true, AFTER_DRAIN = false;
    bf16_t* O; int ldc; const float* ss; float scale;
    __device__ __forceinline__ void operator()(const f32x4 (&acc)[2][2][4][2], const Unit& u, int wr, int wc, int fr, int fq) const {
        const int row0 = u.pm * BM + wr * 64 + fr;
        float ssv[2][4];
#pragma unroll
        for (int ai = 0; ai < 2; ++ai)
#pragma unroll
            for (int m = 0; m < 4; ++m) ssv[ai][m] = ss ? ss[row0 + ai * HALF + m * 16] : 0.f;
#pragma unroll
        for (int ai = 0; ai < 2; ++ai)
#pragma unroll
            for (int m = 0; m < 4; ++m) {
                const int row = row0 + ai * HALF + m * 16;
                const float sc = ss ? scale * __builtin_amdgcn_rsqf(ssv[ai][m] * (1.0f / 1024.0f) + RMS_EPS) : scale;
#pragma unroll
                for (int bj = 0; bj < 2; ++bj) {
                    const size_t off = (size_t)row * ldc + u.pn * BM + bj * HALF + wc * 32 + 8 * fq;
                    const f32x4 v0 = acc[ai][bj][m][0] * sc, v1 = acc[ai][bj][m][1] * sc;
                    u32x4 w; w.x = cvt_pk_bf16(v0[0], v0[1]); w.y = cvt_pk_bf16(v0[2], v0[3]); w.z = cvt_pk_bf16(v1[0], v1[1]); w.w = cvt_pk_bf16(v1[2], v1[3]);
                    st16(O + off, w);
                }
            }
    }
};

struct EpiResid {
    static constexpr bool PERM = true, AFTER_DRAIN = false;
    const float* baseF;
    const bf16_t* baseB;
    float* out;
    bf16_t* outb;
    float* ss;
    __device__ __forceinline__ void operator()(const f32x4 (&acc)[2][2][4][2], const Unit& u, int wr, int wc, int fr, int fq) const {
        const int row0 = u.pm * BM + wr * 64 + fr;
#pragma unroll
        for (int ai = 0; ai < 2; ++ai) {
            f32x4 pre[4][2][2];
            if (baseF) {
#pragma unroll
                for (int m = 0; m < 4; ++m) { const float* bp = baseF + (size_t)(row0 + ai * HALF + m * 16) * 1024;
#pragma unroll
                    for (int bj = 0; bj < 2; ++bj) { const int col = u.pn * BM + bj * HALF + wc * 32 + 8 * fq; pre[m][bj][0] = *(const f32x4*)(bp + col); pre[m][bj][1] = *(const f32x4*)(bp + col + 4); } }
            } else {
                u32x4 pb[4][2];
#pragma unroll
                for (int m = 0; m < 4; ++m) { const bf16_t* bp = baseB + (size_t)(row0 + ai * HALF + m * 16) * 1024;
#pragma unroll
                    for (int bj = 0; bj < 2; ++bj) pb[m][bj] = *(const u32x4*)(bp + u.pn * BM + bj * HALF + wc * 32 + 8 * fq); }
#pragma unroll
                for (int m = 0; m < 4; ++m)
#pragma unroll
                    for (int bj = 0; bj < 2; ++bj) { const u32x4 p = pb[m][bj];
                        pre[m][bj][0] = (f32x4){__uint_as_float(p.x << 16), __uint_as_float(p.x & 0xffff0000u), __uint_as_float(p.y << 16), __uint_as_float(p.y & 0xffff0000u)};
                        pre[m][bj][1] = (f32x4){__uint_as_float(p.z << 16), __uint_as_float(p.z & 0xffff0000u), __uint_as_float(p.w << 16), __uint_as_float(p.w & 0xffff0000u)}; }
            }
#pragma unroll
            for (int m = 0; m < 4; ++m) {
                const int row = row0 + ai * HALF + m * 16;
                float s = 0.f;
#pragma unroll
                for (int bj = 0; bj < 2; ++bj) {
                    const int col = u.pn * BM + bj * HALF + wc * 32 + 8 * fq;
                    const f32x4 v0 = acc[ai][bj][m][0] + pre[m][bj][0], v1 = acc[ai][bj][m][1] + pre[m][bj][1];
                    s += (v0[0] * v0[0] + v0[1] * v0[1]) + (v0[2] * v0[2] + v0[3] * v0[3]) + (v1[0] * v1[0] + v1[1] * v1[1]) + (v1[2] * v1[2] + v1[3] * v1[3]);
                    if (out) { *(f32x4*)(out + (size_t)row * 1024 + col) = v0; *(f32x4*)(out + (size_t)row * 1024 + col + 4) = v1; }
                    if (outb) { u32x4 w; w.x = cvt_pk_bf16(v0[0], v0[1]); w.y = cvt_pk_bf16(v0[2], v0[3]); w.z = cvt_pk_bf16(v1[0], v1[1]); w.w = cvt_pk_bf16(v1[2], v1[3]); st16(outb + (size_t)row * 1024 + col, w); }
                }
                s += __shfl_xor(s, 16); s += __shfl_xor(s, 32);
                if (fq == 0) atomicAdd(ss + row, s);
            }
        }
    }
};

struct EpiResidNorm {
    static constexpr bool PERM = true, AFTER_DRAIN = true;
    const bf16_t* baseB; float* out; float* ss; unsigned* cnt; const float* gfin;
    __device__ __forceinline__ void fused(f32x4 (&acc)[2][2][4][2], const Unit& u, int wr, int wc, int fr, int fq, PG8_LAS unsigned char* lds, int wid, int lane) const {
        const int row0 = u.pm * BM + wr * 64 + fr;
#pragma unroll
        for (int ai = 0; ai < 2; ++ai) {
            u32x4 pb[4][2];
#pragma unroll
            for (int m = 0; m < 4; ++m) { const bf16_t* bp = baseB + (size_t)(row0 + ai * HALF + m * 16) * 1024;
#pragma unroll
                for (int bj = 0; bj < 2; ++bj) pb[m][bj] = *(const u32x4*)(bp + u.pn * BM + bj * HALF + wc * 32 + 8 * fq); }
#pragma unroll
            for (int m = 0; m < 4; ++m) { float s = 0.f;
#pragma unroll
                for (int bj = 0; bj < 2; ++bj) { const u32x4 p = pb[m][bj];
                    const f32x4 v0 = acc[ai][bj][m][0] + (f32x4){__uint_as_float(p.x << 16), __uint_as_float(p.x & 0xffff0000u), __uint_as_float(p.y << 16), __uint_as_float(p.y & 0xffff0000u)};
                    const f32x4 v1 = acc[ai][bj][m][1] + (f32x4){__uint_as_float(p.z << 16), __uint_as_float(p.z & 0xffff0000u), __uint_as_float(p.w << 16), __uint_as_float(p.w & 0xffff0000u)};
                    acc[ai][bj][m][0] = v0; acc[ai][bj][m][1] = v1;
                    s += (v0[0] * v0[0] + v0[1] * v0[1]) + (v0[2] * v0[2] + v0[3] * v0[3]) + (v1[0] * v1[0] + v1[1] * v1[1]) + (v1[2] * v1[2] + v1[3] * v1[3]); }
                s += __shfl_xor(s, 16); s += __shfl_xor(s, 32);
                if (fq == 0) atomicAdd(ss + row0 + ai * HALF + m * 16, s); }
        }
        asm volatile("s_waitcnt vmcnt(0)" ::: "memory");
        __syncthreads();
        if (threadIdx.x == 0) { unsigned* c = cnt + 64 * u.pm;
            __hip_atomic_fetch_add(c, 1u, __ATOMIC_RELEASE, __HIP_MEMORY_SCOPE_AGENT);
            unsigned sp = 0u; while (__hip_atomic_load(c, __ATOMIC_RELAXED, __HIP_MEMORY_SCOPE_AGENT) < 4u) { __builtin_amdgcn_s_sleep(2); if (++sp > (1u << 22)) break; }
            __builtin_amdgcn_fence(__ATOMIC_ACQUIRE, "agent"); }
        __syncthreads();
        float rs[2][4];
#pragma unroll
        for (int ai = 0; ai < 2; ++ai)
#pragma unroll
            for (int m = 0; m < 4; ++m) rs[ai][m] = __hip_atomic_load(ss + row0 + ai * HALF + m * 16, __ATOMIC_RELAXED, __HIP_MEMORY_SCOPE_AGENT);
        f32x4 gv[2][2];
#pragma unroll
        for (int bj = 0; bj < 2; ++bj) { const int col = u.pn * BM + bj * HALF + wc * 32 + 8 * fq; gv[bj][0] = *(const f32x4*)(gfin + col); gv[bj][1] = *(const f32x4*)(gfin + col + 4); }
#pragma unroll
        for (int ai = 0; ai < 2; ++ai)
#pragma unroll
            for (int m = 0; m < 4; ++m) { const int row = row0 + ai * HALF + m * 16; const float rstd = 1.0f / sqrtf(rs[ai][m] * (1.0f / 1024.0f) + RMS_EPS);
#pragma unroll
                for (int bj = 0; bj < 2; ++bj) { const int col = u.pn * BM + bj * HALF + wc * 32 + 8 * fq;
                    *(f32x4*)(out + (size_t)row * 1024 + col) = acc[ai][bj][m][0] * rstd * gv[bj][0]; *(f32x4*)(out + (size_t)row * 1024 + col + 4) = acc[ai][bj][m][1] * rstd * gv[bj][1]; } }
    }
};

struct EpiSwiGLU {
    static constexpr bool PERM = true, AFTER_DRAIN = false;
    bf16_t* ACT; const float* ss;
    __device__ __forceinline__ void operator()(const f32x4 (&acc)[2][2][4][2], const Unit& u, int wr, int wc, int fr, int fq) const {
        const int row0 = u.pm * BM + wr * 64 + fr;
        float ssv[2][4];
#pragma unroll
        for (int ai = 0; ai < 2; ++ai)
#pragma unroll
            for (int m = 0; m < 4; ++m) ssv[ai][m] = ss[row0 + ai * HALF + m * 16];
#pragma unroll
        for (int ai = 0; ai < 2; ++ai)
#pragma unroll
            for (int m = 0; m < 4; ++m) {
                const int row = row0 + ai * HALF + m * 16;
                const float r = __builtin_amdgcn_rsqf(ssv[ai][m] * (1.0f / 1024.0f) + RMS_EPS);
#pragma unroll
                for (int bj = 0; bj < 2; ++bj) {
                    const int J = u.pn * 128 + bj * 64 + wc * 16 + 4 * fq;
                    const f32x4 a = acc[ai][bj][m][0] * r, b = acc[ai][bj][m][1] * r;
                    float o[4];
#pragma unroll
                    for (int j = 0; j < 4; ++j) o[j] = a[j] * sigm(a[j]) * b[j];
                    u32x2 w; w.x = cvt_pk_bf16(o[0], o[1]); w.y = cvt_pk_bf16(o[2], o[3]);
                    st8(ACT + (size_t)row * 2816 + J, w);
                }
            }
    }
};

template <class Epi, class Sched, bool ALIGN_EPI = false, bool SP2 = false>
__device__ __forceinline__ void gemm_phase(PG8_LAS unsigned char* lds, const Gemm g, const Sched& S, const Epi& E) {
    const int tid = threadIdx.x, wid = __builtin_amdgcn_readfirstlane(tid >> 6), lane = tid & 63, wr = wid >> 2, wc = wid & 3, fr = lane & 15, fq = lane >> 4;
    const int K = g.K, nt = K / BK;
    unsigned voffA[2], voffB[2];
#pragma unroll
    for (int i = 0; i < 2; ++i) { int R, C; stage_rc(tid * 16 + i * 8192, R, C); const int Rb = Epi::PERM ? ((R & ~31) + perm32(R & 31)) : R;
        voffA[i] = (unsigned)(R * K + C) * 2u; voffB[i] = (unsigned)(Rb * K + C) * 2u; }
    const size_t kstep = (size_t)(BK * 2);
    const size_t hstep = (size_t)HALF * K * 2;
    const size_t tstep = 2 * hstep;
    const unsigned ldsw = (unsigned)wid * 1024u;
    const int aoff = lds_byte(wr * 64 + fr, fq * 8), boff = lds_byte(wc * 32 + fr, fq * 8);
#define PG8_SA(b, h) (((b) * 2 + (h)) * HTB)
#define PG8_SB(b, h) ((4 + (b) * 2 + (h)) * HTB)
#define PG8_STAGE(bufoff, gbase, voff) do { _Pragma("unroll") for (int _i = 0; _i < 2; ++_i) \
        __builtin_amdgcn_global_load_lds((const unsigned*)((const char*)(gbase) + (voff)[_i]), (PG8_LAS unsigned*)(lds + (bufoff) + ldsw + _i * 8192), 16, 0, 0); } while (0)
#define PG8_LDA(dst, b, h) do { _Pragma("unroll") for (int m = 0; m < 4; ++m) _Pragma("unroll") for (int k = 0; k < 2; ++k) dst[m][k] = *(const PG8_LAS bf16x8*)(lds + PG8_SA(b, h) + aoff + m * 2048 + k * 1024); } while (0)
#define PG8_LDB(dst, b, h) do { _Pragma("unroll") for (int n = 0; n < 2; ++n) _Pragma("unroll") for (int k = 0; k < 2; ++k) dst[n][k] = *(const PG8_LAS bf16x8*)(lds + PG8_SB(b, h) + boff + n * 2048 + k * 1024); } while (0)
#define PG8_MMA(ai, bj, At, Bt) do { __builtin_amdgcn_s_setprio(1); _Pragma("unroll") for (int m = 0; m < 4; ++m) _Pragma("unroll") for (int n = 0; n < 2; ++n) _Pragma("unroll") for (int k = 0; k < 2; ++k) \
        acc[ai][bj][m][n] = __builtin_amdgcn_mfma_f32_16x16x32_bf16(Bt[n][k], At[m][k], acc[ai][bj][m][n], 0, 0, 0); __builtin_amdgcn_s_setprio(0); } while (0)
#define PG8_WAIT_V(n) asm volatile("s_waitcnt vmcnt(" #n ")" ::: "memory")
#define PG8_WAIT_L(n) asm volatile("s_waitcnt lgkmcnt(" #n ")" ::: "memory")
#define PG8_BAR __builtin_amdgcn_s_barrier()
#define PG8_SCHED __builtin_amdgcn_sched_barrier(0)
    Unit cur, nxt; int ui = 0;
    if (!S.next(0, cur)) return;
    f32x4 acc[2][2][4][2];
#pragma unroll
    for (int a = 0; a < 2; ++a)
#pragma unroll
        for (int b = 0; b < 2; ++b)
#pragma unroll
            for (int m = 0; m < 4; ++m)
#pragma unroll
                for (int n = 0; n < 2; ++n) acc[a][b][m][n] = (f32x4){0.f, 0.f, 0.f, 0.f};
    bf16x8 At[4][2], B0[2][2], B1[2][2];
    const char* cA = (const char*)g.A + (size_t)cur.pm * tstep; const char* cB = (const char*)g.Bt + (size_t)cur.pn * tstep;
    S.a_ready(cur);
    if constexpr (SP2) {
        PG8_STAGE(PG8_SB(0, 0), cB, voffB); PG8_STAGE(PG8_SB(0, 1), cB + hstep, voffB); PG8_STAGE(PG8_SA(0, 0), cA, voffA); PG8_STAGE(PG8_SA(0, 1), cA + hstep, voffA);
        if (wr == 1) PG8_BAR;
        PG8_WAIT_V(2); PG8_BAR;
        PG8_STAGE(PG8_SB(1, 0), cB + kstep, voffB); PG8_STAGE(PG8_SA(1, 0), cA + kstep, voffA); PG8_STAGE(PG8_SB(1, 1), cB + hstep + kstep, voffB);
        PG8_WAIT_V(6); PG8_BAR;
    } else {
        PG8_STAGE(PG8_SB(0, 0), cB, voffB); PG8_STAGE(PG8_SA(0, 0), cA, voffA); PG8_STAGE(PG8_SB(0, 1), cB + hstep, voffB); PG8_STAGE(PG8_SA(0, 1), cA + hstep, voffA);
        if (wr == 1) PG8_BAR;
        PG8_WAIT_V(4); PG8_BAR;
        PG8_STAGE(PG8_SB(1, 0), cB + kstep, voffB); PG8_STAGE(PG8_SA(1, 0), cA + kstep, voffA); PG8_STAGE(PG8_SB(1, 1), cB + hstep + kstep, voffB);
        PG8_WAIT_V(6); PG8_BAR;
    }
    for (;;) {
        const bool has_next = S.next(ui + 1, nxt);
        const char* nA = has_next ? (const char*)g.A + (size_t)nxt.pm * tstep : cA; const char* nB = has_next ? (const char*)g.Bt + (size_t)nxt.pn * tstep : cB;
        for (int t = 0; t < nt; t += 2) {
            const bool last = (t == nt - 2);
            const char* a1 = cA + (size_t)(t + 1) * kstep;
            const char* a2 = last ? nA : cA + (size_t)(t + 2) * kstep; const char* b2 = last ? nB : cB + (size_t)(t + 2) * kstep;
            const char* a3 = a2 + kstep; const char* b3 = b2 + kstep;
            if (last && has_next) S.a_ready(nxt);
            if constexpr (SP2) {
            PG8_LDB(B0, 0, 0); PG8_LDB(B1, 0, 1); PG8_SCHED; PG8_LDA(At, 0, 0); PG8_STAGE(PG8_SA(1, 1), a1 + hstep, voffA);
            PG8_WAIT_V(8); PG8_WAIT_L(0); PG8_BAR; PG8_MMA(0, 0, At, B0); PG8_MMA(0, 1, At, B1); PG8_BAR; PG8_SCHED;
            PG8_LDA(At, 0, 1); PG8_STAGE(PG8_SB(0, 0), b2, voffB); PG8_STAGE(PG8_SB(0, 1), b2 + hstep, voffB); PG8_STAGE(PG8_SA(0, 0), a2, voffA);
            PG8_WAIT_V(8); PG8_WAIT_L(0); PG8_BAR; PG8_MMA(1, 0, At, B0); PG8_MMA(1, 1, At, B1); PG8_BAR; PG8_SCHED;
            PG8_LDB(B0, 1, 0); PG8_LDB(B1, 1, 1); PG8_SCHED; PG8_LDA(At, 1, 0); PG8_STAGE(PG8_SA(0, 1), a2 + hstep, voffA);
            PG8_WAIT_V(8); PG8_WAIT_L(0); PG8_BAR; PG8_MMA(0, 0, At, B0); PG8_MMA(0, 1, At, B1); PG8_BAR; PG8_SCHED;
            PG8_LDA(At, 1, 1); PG8_STAGE(PG8_SB(1, 0), b3, voffB); PG8_STAGE(PG8_SB(1, 1), b3 + hstep, voffB); PG8_STAGE(PG8_SA(1, 0), a3, voffA);
            PG8_WAIT_V(8); PG8_WAIT_L(0); PG8_BAR; PG8_MMA(1, 0, At, B0); PG8_MMA(1, 1, At, B1); PG8_BAR; PG8_SCHED;
            } else {
            PG8_LDB(B0, 0, 0); PG8_SCHED; PG8_LDA(At, 0, 0); PG8_STAGE(PG8_SA(1, 1), a1 + hstep, voffA);
            PG8_WAIT_L(8); PG8_BAR; PG8_WAIT_L(0); PG8_MMA(0, 0, At, B0); PG8_BAR; PG8_SCHED;
            PG8_LDB(B1, 0, 1); PG8_STAGE(PG8_SB(0, 0), b2, voffB);
            PG8_BAR; PG8_WAIT_L(0); PG8_MMA(0, 1, At, B1); PG8_BAR;
            PG8_LDA(At, 0, 1); PG8_STAGE(PG8_SA(0, 0), a2, voffA);
            PG8_BAR; PG8_WAIT_L(0); PG8_MMA(1, 0, At, B0); PG8_BAR; PG8_SCHED;
            PG8_STAGE(PG8_SB(0, 1), b2 + hstep, voffB);
            PG8_WAIT_V(6); PG8_BAR; PG8_MMA(1, 1, At, B1); PG8_BAR;
            PG8_LDB(B0, 1, 0); PG8_SCHED; PG8_LDA(At, 1, 0); PG8_STAGE(PG8_SA(0, 1), a2 + hstep, voffA);
            PG8_WAIT_L(8); PG8_BAR; PG8_WAIT_L(0); PG8_MMA(0, 0, At, B0); PG8_BAR; PG8_SCHED;
            PG8_LDB(B1, 1, 1); PG8_STAGE(PG8_SB(1, 0), b3, voffB);
            PG8_BAR; PG8_WAIT_L(0); PG8_MMA(0, 1, At, B1); PG8_BAR;
            PG8_LDA(At, 1, 1); PG8_STAGE(PG8_SA(1, 0), a3, voffA);
            PG8_BAR; PG8_WAIT_L(0); PG8_MMA(1, 0, At, B0); PG8_BAR; PG8_SCHED;
            PG8_STAGE(PG8_SB(1, 1), b3 + hstep, voffB);
            PG8_WAIT_V(6); PG8_BAR; PG8_MMA(1, 1, At, B1); PG8_BAR;
            }
        }
        if constexpr (ALIGN_EPI) { if (wr == 0) PG8_BAR; }
        if constexpr (!Epi::AFTER_DRAIN) { E(acc, cur, wr, wc, fr, fq); S.done(cur); }
        if (!has_next) break;
#pragma unroll
        for (int a = 0; a < 2; ++a)
#pragma unroll
            for (int b = 0; b < 2; ++b)
#pragma unroll
                for (int m = 0; m < 4; ++m)
#pragma unroll
                    for (int n = 0; n < 2; ++n) acc[a][b][m][n] = (f32x4){0.f, 0.f, 0.f, 0.f};
        cur = nxt; cA = nA; cB = nB; ++ui;
        if constexpr (ALIGN_EPI) { if (wr == 1) PG8_BAR; }
    }
    PG8_WAIT_V(0);
    if constexpr (!ALIGN_EPI) { if (wr == 0) PG8_BAR; }
    PG8_BAR;
    if constexpr (Epi::AFTER_DRAIN) { E.fused(acc, cur, wr, wc, fr, fq, lds, wid, lane); S.done(cur); }
#undef PG8_SA
#undef PG8_SB
#undef PG8_STAGE
#undef PG8_LDA
#undef PG8_LDB
#undef PG8_MMA
#undef PG8_WAIT_V
#undef PG8_WAIT_L
#undef PG8_BAR
#undef PG8_SCHED
}
}
#define LAS __attribute__((address_space(3)))
#define XB_TMO      128
#define XB_XCNT(j)  (256  + 64 * (j))
#define XB_XSUB(j)  (1280 + 64 * (j))
#define XB_XGEN(j)  (2304 + 64 * (j))
#define XB_TOP      3328
#define XB_TOPGEN   3392
#define XCD_BAR_WORDS 3456
#define XB_SPIN_CAP (1u << 18)

__device__ __forceinline__ unsigned xb_ld(unsigned* p)              { return __hip_atomic_load(p, __ATOMIC_RELAXED, __HIP_MEMORY_SCOPE_AGENT); }
__device__ __forceinline__ unsigned xb_add(unsigned* p, unsigned v) { return __hip_atomic_fetch_add(p, v, __ATOMIC_RELAXED, __HIP_MEMORY_SCOPE_AGENT); }
__device__ __forceinline__ unsigned xb_xcc_id() { return (unsigned)__builtin_amdgcn_s_getreg((3 << 11) | 20) & 0xFu; }
#define XB_SPIN(cond, bar) do { unsigned _sp = 0; while (cond) { __builtin_amdgcn_s_sleep(1); \
    if ((++_sp & 255u) == 0u) { if (xb_ld(&(bar)[XB_TMO])) break; if (_sp > XB_SPIN_CAP) { atomicAdd(&(bar)[XB_TMO], 1u); break; } } } } while (0)

struct XcdBarrier {
    unsigned* bar; unsigned x;
    volatile LAS unsigned* st;
};

__device__ __forceinline__ XcdBarrier xcd_barrier_post(unsigned* bar, volatile LAS unsigned* st) {
    XcdBarrier b; b.bar = bar; b.x = xb_xcc_id(); b.st = st;
    if (threadIdx.x == 0) (void)xb_add(&bar[XB_XCNT(b.x)], 1u);
    return b;
}
__device__ __forceinline__ void xcd_barrier_complete(unsigned* bar, unsigned x, unsigned& nloc, unsigned& nx) {
    const unsigned G = gridDim.x * gridDim.y * gridDim.z;
    unsigned sum, cnt, mine, sp = 0u;
    for (;;) {
        sum = 0u; cnt = 0u; mine = 0u;
#pragma unroll
        for (unsigned j = 0; j < 16; ++j) { const unsigned c = xb_ld(&bar[XB_XCNT(j)]); sum += c; cnt += (c > 0u) ? 1u : 0u; mine = (j == x) ? c : mine; }
        if (sum == G) break;
        __builtin_amdgcn_s_sleep(1);
        if ((++sp & 255u) == 0u) { if (xb_ld(&bar[XB_TMO])) break; if (sp > XB_SPIN_CAP) { atomicAdd(&bar[XB_TMO], 1u); break; } }
    }
    nloc = mine > 0u ? mine : 1u; nx = cnt > 0u ? cnt : 1u;
}

__device__ __forceinline__ void xcd_barrier(const XcdBarrier& b) {
    asm volatile("s_waitcnt vmcnt(0)" ::: "memory");
    __syncthreads();
    if (threadIdx.x == 0) {
        unsigned* bar = b.bar;
        __builtin_amdgcn_s_waitcnt(0);
        unsigned nloc = b.st[0], nx = b.st[1];
        if (nloc == 0u) { xcd_barrier_complete(bar, b.x, nloc, nx); b.st[0] = nloc; b.st[1] = nx; }
        const unsigned old = xb_add(&bar[XB_XSUB(b.x)], 1u);
        const unsigned gen = old / nloc;
        if (old + 1u == (gen + 1u) * nloc) {
            __builtin_amdgcn_fence(__ATOMIC_RELEASE, "agent");
            asm volatile("s_waitcnt vmcnt(0)" ::: "memory");
            const unsigned og = xb_add(&bar[XB_TOP], 1u);
            const unsigned tg = og / nx;
            if (og + 1u == (tg + 1u) * nx) xb_add(&bar[XB_TOPGEN], 1u);
            else XB_SPIN(xb_ld(&bar[XB_TOPGEN]) == tg, bar);
            __builtin_amdgcn_fence(__ATOMIC_ACQUIRE, "agent");
            xb_add(&bar[XB_XGEN(b.x)], 1u);
            asm volatile("s_waitcnt vmcnt(0)" ::: "memory");
        } else {
            XB_SPIN(xb_ld(&bar[XB_XGEN(b.x)]) == gen, bar);
            __builtin_amdgcn_fence(__ATOMIC_ACQUIRE, "agent");
            asm volatile("s_waitcnt vmcnt(0)" ::: "memory");
        }
    }
    __syncthreads();
}

using pg8::bf16_t; using pg8::f32x4; using pg8::u32x4; using pg8::bf16x8; using pg8::pk_h2; using pg8::h_lo; using pg8::h_hi;
typedef unsigned u32x2v __attribute__((ext_vector_type(2)));
constexpr int DM = 1024, NPR = 16384, NSM = 128, MT = 16640, NVALID = 16512, SEQ = 2048;
constexpr int HW = 512, NIN = 2560, DFF = 2816, NFF2 = 5632, MEMR = 2048;
constexpr float EPS = 1e-6f;
constexpr int NTHREADS = 512;
constexpr int LDS_BYTES = 147456;

constexpr size_t O_YP = 0, O_YS = 16777216, O_HP = 16908288, O_PP = 17432576, O_MK = 17494016, O_MV = 19591168, O_HS = 21688320, O_PS = 30076928;

constexpr size_t MiB = 1u << 20;
constexpr size_t WS_SS1 = 0, WS_SS2 = 128 * 1024, WS_SS3 = 256 * 1024, WS_BAR = 512 * 1024, BAR_BYTES = 65536, WS_SSD = 384 * 1024, WS_CNT = WS_BAR + 16384;
constexpr size_t WS_WIN = 1 * MiB, WS_WOUT = 6 * MiB, WS_WCQ = 8 * MiB, WS_WCO = 10 * MiB, WS_WFFI = 12 * MiB, WS_WFFO = 23 * MiB, WS_WKV = 29 * MiB, WS_PMIX = 33 * MiB;
constexpr size_t WS_MEMH = 34 * MiB, WS_KB = 38 * MiB, WS_VT = 42 * MiB, WS_DEC = 46 * MiB;
constexpr size_t WS_H0 = 47 * MiB;
constexpr size_t WS_MIX = 80 * MiB;
constexpr size_t WS_X1 = 113 * MiB;
constexpr size_t WS_Q = 178 * MiB;
constexpr size_t WS_O = 211 * MiB;
constexpr size_t WS_SL = 244 * MiB;
constexpr size_t WS_A = 309 * MiB;
constexpr size_t WS_QQ = WS_A, WS_KK = WS_A + 17 * MiB, WS_VV = WS_A + 34 * MiB, WS_GG = WS_A + 51 * MiB, WS_LF = WS_A + 68 * MiB, WS_UU = WS_A + 101 * MiB;
constexpr size_t WS_END = 443 * MiB;

struct Args { const float* in[23]; float* out; unsigned char* ws; int ph_lo, ph_hi; };

__device__ __forceinline__ unsigned f2bf(float f) { unsigned u = __builtin_bit_cast(unsigned, f); return (u + 0x7fffu + ((u >> 16) & 1u)) >> 16; }
__device__ __forceinline__ unsigned pk2(float lo, float hi) { return f2bf(lo) | (f2bf(hi) << 16); }
__device__ __forceinline__ float bf2f(unsigned h) { return __uint_as_float(h << 16); }
__device__ __forceinline__ float bfe(const u32x4& v, int j) { const unsigned w = v[j >> 1]; return (j & 1) ? __uint_as_float(w & 0xffff0000u) : __uint_as_float(w << 16); }
__device__ __forceinline__ unsigned short bfr(const u32x4& v, int j) { const unsigned w = v[j >> 1]; return (unsigned short)((j & 1) ? (w >> 16) : (w & 0xffffu)); }
__device__ __forceinline__ float wave_sum(float v) {
#pragma unroll
    for (int o = 1; o < 64; o <<= 1) v += __shfl_xor(v, o);
    return v;
}
#define MFMA16(a, b, c) __builtin_amdgcn_mfma_f32_16x16x32_bf16((a), (b), (c), 0, 0, 0)

template <int MODE>
__device__ __forceinline__ void tr_item(const float* W, int K, int N, bf16_t* WT, const float* gk, float* scr, int item, int lane) {
    const int nblk = N / 32, kb = item / nblk, nb = item % nblk, k0 = 64 * kb, n0 = 32 * nb;
    f32x4 wv[8];
#pragma unroll
    for (int i = 0; i < 8; ++i) { const int kk = 8 * i + (lane >> 3); wv[i] = *(const f32x4*)(W + (size_t)(k0 + kk) * N + n0 + (lane & 7) * 4); }
#pragma unroll
    for (int i = 0; i < 8; ++i) { const int kk = 8 * i + (lane >> 3); float* d = scr + kk * 33 + (lane & 7) * 4; d[0] = wv[i][0]; d[1] = wv[i][1]; d[2] = wv[i][2]; d[3] = wv[i][3]; }
    asm volatile("s_waitcnt lgkmcnt(0)" ::: "memory");
    const int c = lane & 7;
    float g8[8];
#pragma unroll
    for (int i = 0; i < 8; ++i) g8[i] = gk ? gk[k0 + 8 * c + i] : 1.0f;
#pragma unroll
    for (int j = 0; j < 4; ++j) { const int n = (lane >> 3) + 8 * j; const float* s = scr + (8 * c) * 33 + n;
        u32x4 o; o.x = pk2(s[0 * 33] * g8[0], s[1 * 33] * g8[1]); o.y = pk2(s[2 * 33] * g8[2], s[3 * 33] * g8[3]); o.z = pk2(s[4 * 33] * g8[4], s[5 * 33] * g8[5]); o.w = pk2(s[6 * 33] * g8[6], s[7 * 33] * g8[7]);
        int row = n0 + n;
        if (MODE == 1) { const int half = row >= DFF ? 1 : 0; const int J = row - half * DFF;
            row = 256 * (J >> 7) + 128 * ((J >> 6) & 1) + 32 * ((J >> 4) & 3) + 8 * ((J >> 2) & 3) + 4 * half + (J & 3); }
        *(u32x4*)(WT + (size_t)row * K + k0 + 8 * c) = o; }
    asm volatile("s_waitcnt lgkmcnt(0)" ::: "memory");
}
__device__ __forceinline__ void rms_row_to_bf16(const float* xrow, const float* g, bf16_t* orow, int lane) {
    const f32x4* xr = (const f32x4*)xrow + lane; const f32x4* gr = (const f32x4*)g + lane;
    f32x4 v[4]; float s = 0.f;
#pragma unroll
    for (int j = 0; j < 4; ++j) { v[j] = xr[64 * j]; s += (v[j].x * v[j].x + v[j].y * v[j].y) + (v[j].z * v[j].z + v[j].w * v[j].w); }
    const float rstd = 1.0f / sqrtf(wave_sum(s) * (1.f / DM) + EPS);
    unsigned long long* o8 = (unsigned long long*)orow + lane;
#pragma unroll
    for (int j = 0; j < 4; ++j) { const f32x4 gg = gr[64 * j];
        o8[64 * j] = (unsigned long long)pk2(v[j].x * rstd * gg.x, v[j].y * rstd * gg.y) | ((unsigned long long)pk2(v[j].z * rstd * gg.z, v[j].w * rstd * gg.w) << 32); }
}
__device__ __forceinline__ void rms_row2_to_bf16(const float* xrow, const float* g, bf16_t* orow, int lane) {
    const f32x4* xr = (const f32x4*)xrow + lane; const f32x4* gr = (const f32x4*)g + lane;
    f32x4 v[2][4]; float s[2] = {0.f, 0.f};
#pragma unroll
    for (int r = 0; r < 2; ++r)
#pragma unroll
        for (int j = 0; j < 4; ++j) v[r][j] = xr[r * 256 + 64 * j];
#pragma unroll
    for (int r = 0; r < 2; ++r)
#pragma unroll
        for (int j = 0; j < 4; ++j) s[r] += (v[r][j].x * v[r][j].x + v[r][j].y * v[r][j].y) + (v[r][j].z * v[r][j].z + v[r][j].w * v[r][j].w);
#pragma unroll
    for (int r = 0; r < 2; ++r) { const float rstd = 1.0f / sqrtf(wave_sum(s[r]) * (1.f / DM) + EPS); unsigned long long* o8 = (unsigned long long*)(orow + (size_t)r * DM) + lane;
#pragma unroll
        for (int j = 0; j < 4; ++j) { const f32x4 gg = gr[64 * j];
            o8[64 * j] = (unsigned long long)pk2(v[r][j].x * rstd * gg.x, v[r][j].y * rstd * gg.y) | ((unsigned long long)pk2(v[r][j].z * rstd * gg.z, v[r][j].w * rstd * gg.w) << 32); } }
}
__device__ __forceinline__ void p0_prologue(const Args& A, unsigned char* lds, int G) {
    const int tid = threadIdx.x, lane = tid & 63, wave = tid >> 6;
    float* scr = (float*)(lds + wave * 16384);
    unsigned char* ws = A.ws;
    const int gw = blockIdx.x * 8 + wave, NGW = G * 8;
    constexpr int I_IN = 16 * 80, I_OUT = 16 * 32, I_CQ = 16 * 32, I_CO = 16 * 32, I_FFI = 16 * 176, I_FFO = 44 * 32, I_KV = 16 * 64, I_PM = 4 * 8;
    constexpr int NITEMS = I_IN + I_OUT + I_CQ + I_CO + I_FFI + I_FFO + I_KV + I_PM;
    for (int it = gw; it < NITEMS; it += NGW) {
        int r = it;
        if (r < I_IN) { tr_item<0>(A.in[8], DM, NIN, (bf16_t*)(ws + WS_WIN), nullptr, scr, r, lane); continue; } r -= I_IN;
        if (r < I_OUT) { tr_item<0>(A.in[13], DM, DM, (bf16_t*)(ws + WS_WOUT), nullptr, scr, r, lane); continue; } r -= I_OUT;
        if (r < I_CQ) { tr_item<0>(A.in[17], DM, DM, (bf16_t*)(ws + WS_WCQ), A.in[16], scr, r, lane); continue; } r -= I_CQ;
        if (r < I_CO) { tr_item<0>(A.in[18], DM, DM, (bf16_t*)(ws + WS_WCO), nullptr, scr, r, lane); continue; } r -= I_CO;
        if (r < I_FFI) { tr_item<1>(A.in[20], DM, NFF2, (bf16_t*)(ws + WS_WFFI), A.in[19], scr, r, lane); continue; } r -= I_FFI;
        if (r < I_FFO) { tr_item<0>(A.in[21], DFF, DM, (bf16_t*)(ws + WS_WFFO), nullptr, scr, r, lane); continue; } r -= I_FFO;
        if (r < I_KV) { tr_item<0>(A.in[15], DM, 2 * DM, (bf16_t*)(ws + WS_WKV), nullptr, scr, r, lane); continue; } r -= I_KV;
        { const int g = r >> 3; tr_item<0>(A.in[11] + (size_t)g * 128 * 128, 128, 128, (bf16_t*)(ws + WS_PMIX) + (size_t)g * 128 * 128, nullptr, scr, r & 7, lane); }
    }
    bf16_t* H0 = (bf16_t*)(ws + WS_H0);
    for (int m = gw * 2; m < NVALID; m += NGW * 2) { const float* xr = m < NPR ? A.in[0] + (size_t)m * DM : A.in[1] + (size_t)(m - NPR) * DM; rms_row2_to_bf16(xr, A.in[7], H0 + (size_t)m * DM, lane); }
    bf16_t* MEMH = (bf16_t*)(ws + WS_MEMH);
    for (int m = gw; m < MEMR; m += NGW) rms_row_to_bf16(A.in[2] + (size_t)m * DM, A.in[14], MEMH + (size_t)m * DM, lane);
    const int gt = blockIdx.x * NTHREADS + tid, NGT = G * NTHREADS;
    for (int i = gt; i < (MT - NVALID) * DM / 8; i += NGT) { const u32x4 z = {0u, 0u, 0u, 0u};
        ((u32x4*)(ws + WS_H0) + (size_t)NVALID * DM / 8)[i] = z; ((u32x4*)(ws + WS_MIX) + (size_t)NVALID * DM / 8)[i] = z; ((u32x4*)(ws + WS_O) + (size_t)NVALID * DM / 8)[i] = z; }
    for (int i = gt; i < MT; i += NGT) { ((float*)(ws + WS_SS1))[i] = 0.f; ((float*)(ws + WS_SS2))[i] = 0.f; ((float*)(ws + WS_SS3))[i] = 0.f; }
}

constexpr int BS = 129;
constexpr int L_BC = 0, L_TOT = 33024, L_QM = 35072, L_KM = 52480, L_VT = 69888, L_SP = 88320, L_AL = 123136, L_PART = 132352, L_EM = 132864;
constexpr size_t WS_SPT = WS_X1;
__device__ __forceinline__ void hgrn_lf_load(u32x2v (&lf)[4], const unsigned short* LF, int R0, int C0, int t) {
#pragma unroll
    for (int i = 0; i < 4; ++i) { const int idx = i * 512 + t, s = idx >> 5, k4 = idx & 31; lf[i] = *(const u32x2v*)(LF + (size_t)(R0 + s) * HW + C0 + k4 * 4); }
}
__device__ __forceinline__ void hgrn_cumsum(const u32x2v (&lf)[4], float* Bc, float* tot, int t) {
#pragma unroll
    for (int i = 0; i < 4; ++i) { const int idx = i * 512 + t, s = idx >> 5, k4 = idx & 31; const u32x2v v = lf[i];
        float* d = Bc + s * BS + k4 * 4; d[0] = h_lo(v.x); d[1] = h_hi(v.x); d[2] = h_lo(v.y); d[3] = h_hi(v.y); }
    __syncthreads();
    const int seg = t >> 7, k = t & 127; float run = 0.f;
#pragma unroll
    for (int i = 0; i < 16; ++i) { run += Bc[(seg * 16 + i) * BS + k]; Bc[(seg * 16 + i) * BS + k] = run; }
    tot[seg * 128 + k] = run;
    __syncthreads();
    float off = 0.f;
#pragma unroll
    for (int j = 0; j < 3; ++j) off += (j < seg) ? tot[j * 128 + k] : 0.f;
#pragma unroll
    for (int i = 0; i < 16; ++i) Bc[(seg * 16 + i) * BS + k] += off;
    __syncthreads();
}
__device__ __forceinline__ void hgrn_local_load(const Args& A, int unit, u32x2v (&lf)[4], u32x4 (&kkr)[2], u32x4 (&vvr)[2]) {
    const int t = threadIdx.x, w = t >> 6, l = t & 63;
    const int bh = unit >> 5, c = unit & 31, b = bh >> 2, h = bh & 3, R0 = b * SEQ + c * 64, C0 = h * 128;
    const bf16_t* KK = (const bf16_t*)(A.ws + WS_KK); const bf16_t* VV = (const bf16_t*)(A.ws + WS_VV);
    hgrn_lf_load(lf, (const unsigned short*)(A.ws + WS_LF), R0, C0, t);
#pragma unroll
    for (int i = 0; i < 2; ++i) { const int k0 = (w + 8 * i) * 8; kkr[i] = *(const u32x4*)(KK + (size_t)(R0 + l) * HW + C0 + k0); vvr[i] = *(const u32x4*)(VV + (size_t)(R0 + l) * HW + C0 + k0); }
}
__device__ __forceinline__ void hgrn_local_unit(const Args& A, unsigned char* lds, int unit, int next, u32x2v (&lf)[4], u32x4 (&kkr)[2], u32x4 (&vvr)[2]) {
    const int t = threadIdx.x, w = t >> 6, l = t & 63, lr = l & 15, lq = l >> 4;
    const int bh = unit >> 5, c = unit & 31, b = bh >> 2, h = bh & 3, R0 = b * SEQ + c * 64, C0 = h * 128;
    unsigned char* ws = A.ws;
    float* Bc = (float*)(lds + L_BC); float* tot = (float*)(lds + L_TOT);
    bf16_t* kdT = (bf16_t*)(lds + L_QM); bf16_t* vT = (bf16_t*)(lds + L_VT);
    hgrn_cumsum(lf, Bc, tot, t);
#pragma unroll
    for (int i = 0; i < 2; ++i) { const int s = l, k0 = (w + 8 * i) * 8;
        const u32x4 kk = kkr[i], vv = vvr[i];
#pragma unroll
        for (int j = 0; j < 8; ++j) { const float e = __expf(Bc[63 * BS + k0 + j] - Bc[s * BS + k0 + j]);
            kdT[(k0 + j) * 72 + s] = (bf16_t)f2bf(bfe(kk, j) * e); vT[(k0 + j) * 72 + s] = bfr(vv, j); } }
    if (next >= 0) hgrn_local_load(A, next, lf, kkr, vvr);
    __syncthreads();
    f32x4 acc[8];
#pragma unroll
    for (int i = 0; i < 8; ++i) acc[i] = (f32x4){0.f, 0.f, 0.f, 0.f};
#pragma unroll
    for (int ks = 0; ks < 2; ++ks) { const bf16x8 a = *(const bf16x8*)(kdT + (16 * w + lr) * 72 + ks * 32 + lq * 8);
#pragma unroll
        for (int vt = 0; vt < 8; ++vt) { const bf16x8 bb = *(const bf16x8*)(vT + (16 * vt + lr) * 72 + ks * 32 + lq * 8); acc[vt] = MFMA16(a, bb, acc[vt]); } }
    unsigned short* SLT = (unsigned short*)(ws + WS_SL) + (size_t)unit * 16384;
#pragma unroll
    for (int vt = 0; vt < 8; ++vt) { u32x2v o; o.x = pk_h2(acc[vt][0], acc[vt][1]); o.y = pk_h2(acc[vt][2], acc[vt][3]); *(u32x2v*)(SLT + (16 * vt + lr) * 128 + 16 * w + lq * 4) = o; }
    if (t < 128) ((float*)(ws + WS_DEC))[unit * 128 + t] = __expf(Bc[63 * BS + t]);
    __syncthreads();
}
__device__ __forceinline__ void hgrn_out_load(const Args& A, int unit, u32x2v (&lf)[4], u32x4 (&qqr)[2], u32x4 (&kkr)[2], u32x4 (&vvr)[2], u32x4 (&spr)[4]) {
    const int t = threadIdx.x, w = t >> 6, l = t & 63;
    const int bh = unit >> 5, c = unit & 31, b = bh >> 2, h = bh & 3, R0 = b * SEQ + c * 64, C0 = h * 128;
    const bf16_t* QQ = (const bf16_t*)(A.ws + WS_QQ); const bf16_t* KK = (const bf16_t*)(A.ws + WS_KK); const bf16_t* VV = (const bf16_t*)(A.ws + WS_VV);
    hgrn_lf_load(lf, (const unsigned short*)(A.ws + WS_LF), R0, C0, t);
#pragma unroll
    for (int i = 0; i < 2; ++i) { const int idx = (i * 512 + t) * 8, s = idx >> 7, k0 = idx & 127; const size_t go = (size_t)(R0 + s) * HW + C0 + k0; qqr[i] = *(const u32x4*)(QQ + go); kkr[i] = *(const u32x4*)(KK + go);
        vvr[i] = *(const u32x4*)(VV + (size_t)(R0 + l) * HW + C0 + (w + 8 * i) * 8); }
    const bf16_t* SPT = (const bf16_t*)(A.ws + WS_SPT) + (size_t)unit * 16384;
#pragma unroll
    for (int i = 0; i < 4; ++i) { const int idx = i * 512 + t; spr[i] = *(const u32x4*)(SPT + (idx >> 4) * 128 + (idx & 15) * 8); }
}
__device__ __forceinline__ void hgrn_out_unit(const Args& A, unsigned char* lds, int unit, int next, u32x2v (&lf)[4], u32x4 (&qqr)[2], u32x4 (&kkr)[2], u32x4 (&vvr)[2], u32x4 (&spr)[4]) {
    const int t = threadIdx.x, w = t >> 6, l = t & 63, lr = l & 15, lq = l >> 4;
    const int bh = unit >> 5, c = unit & 31, b = bh >> 2, h = bh & 3, R0 = b * SEQ + c * 64, C0 = h * 128;
    unsigned char* ws = A.ws;
    float* Bc = (float*)(lds + L_BC); float* tot = (float*)(lds + L_TOT); float* part = (float*)(lds + L_PART); float* em = (float*)(lds + L_EM);
    bf16_t* qm = (bf16_t*)(lds + L_QM); bf16_t* km = (bf16_t*)(lds + L_KM); bf16_t* vT = (bf16_t*)(lds + L_VT); bf16_t* spT = (bf16_t*)(lds + L_SP); bf16_t* aL = (bf16_t*)(lds + L_AL);
    u32x4 ggr[2];
#pragma unroll
    for (int hh = 0; hh < 2; ++hh) ggr[hh] = *(const u32x4*)((const bf16_t*)(ws + WS_GG) + (size_t)(R0 + (t >> 3)) * HW + C0 + (t & 7) * 16 + hh * 8);
    hgrn_cumsum(lf, Bc, tot, t);
    if (t < 128) em[t] = __expf(Bc[31 * BS + t]);
#pragma unroll
    for (int i = 0; i < 2; ++i) { const int idx = (i * 512 + t) * 8, s = idx >> 7, k0 = idx & 127;
        const u32x4 qq = qqr[i], kk = kkr[i];
        float qv[8], kv[8];
#pragma unroll
        for (int j = 0; j < 8; ++j) { const float d = Bc[s * BS + k0 + j] - Bc[31 * BS + k0 + j]; qv[j] = bfe(qq, j) * __expf(d); kv[j] = bfe(kk, j) * __expf(-d); }
        u32x4 o; o.x = pk2(qv[0], qv[1]); o.y = pk2(qv[2], qv[3]); o.z = pk2(qv[4], qv[5]); o.w = pk2(qv[6], qv[7]); *(u32x4*)(qm + s * 136 + k0) = o;
        o.x = pk2(kv[0], kv[1]); o.y = pk2(kv[2], kv[3]); o.z = pk2(kv[4], kv[5]); o.w = pk2(kv[6], kv[7]); *(u32x4*)(km + s * 136 + k0) = o; }
#pragma unroll
    for (int i = 0; i < 2; ++i) { const int s = l, k0 = (w + 8 * i) * 8; const u32x4 vv = vvr[i];
#pragma unroll
        for (int j = 0; j < 8; ++j) vT[(k0 + j) * 72 + s] = bfr(vv, j); }
    __syncthreads();
    {
#pragma unroll
        for (int i = 0; i < 4; ++i) { const int idx = i * 512 + t, v = idx >> 4, k0 = (idx & 15) * 8; const u32x4 sv = spr[i];
            u32x4 o; o.x = pk2(bfe(sv, 0) * em[k0], bfe(sv, 1) * em[k0 + 1]); o.y = pk2(bfe(sv, 2) * em[k0 + 2], bfe(sv, 3) * em[k0 + 3]); o.z = pk2(bfe(sv, 4) * em[k0 + 4], bfe(sv, 5) * em[k0 + 5]); o.w = pk2(bfe(sv, 6) * em[k0 + 6], bfe(sv, 7) * em[k0 + 7]);
            *(u32x4*)(spT + v * 136 + k0) = o; } }
    if (next >= 0) hgrn_out_load(A, next, lf, qqr, kkr, vvr, spr);
    {
        const int ct = w & 3;
        f32x4 a2[2]; a2[0] = (f32x4){0.f, 0.f, 0.f, 0.f}; a2[1] = a2[0];
#pragma unroll
        for (int ks = 0; ks < 4; ++ks) { const bf16x8 a = *(const bf16x8*)(qm + (16 * ct + lr) * 136 + ks * 32 + lq * 8);
#pragma unroll
            for (int i = 0; i < 2; ++i) { const int st = (w >> 2) * 2 + i; const bf16x8 bb = *(const bf16x8*)(km + (16 * st + lr) * 136 + ks * 32 + lq * 8); a2[i] = MFMA16(a, bb, a2[i]); } }
#pragma unroll
        for (int i = 0; i < 2; ++i) { const int st = (w >> 2) * 2 + i, s = 16 * st + lr;
#pragma unroll
            for (int r = 0; r < 4; ++r) { const int cc = 16 * ct + lq * 4 + r; aL[cc * 72 + s] = (bf16_t)f2bf(s <= cc ? a2[i][r] : 0.f); } }
    }
    __syncthreads();
    const int ct = w & 3, vh = w >> 2;
    f32x4 o4[4];
#pragma unroll
    for (int i = 0; i < 4; ++i) o4[i] = (f32x4){0.f, 0.f, 0.f, 0.f};
#pragma unroll
    for (int ks = 0; ks < 4; ++ks) { const bf16x8 a = *(const bf16x8*)(qm + (16 * ct + lr) * 136 + ks * 32 + lq * 8);
#pragma unroll
        for (int i = 0; i < 4; ++i) { const int vt = vh * 4 + i; const bf16x8 bb = *(const bf16x8*)(spT + (16 * vt + lr) * 136 + ks * 32 + lq * 8); o4[i] = MFMA16(a, bb, o4[i]); } }
#pragma unroll
    for (int ks = 0; ks < 2; ++ks) { const bf16x8 a = *(const bf16x8*)(aL + (16 * ct + lr) * 72 + ks * 32 + lq * 8);
#pragma unroll
        for (int i = 0; i < 4; ++i) { const int vt = vh * 4 + i; const bf16x8 bb = *(const bf16x8*)(vT + (16 * vt + lr) * 72 + ks * 32 + lq * 8); o4[i] = MFMA16(a, bb, o4[i]); } }
    float* ost = (float*)(lds + L_BC);
#pragma unroll
    for (int r = 0; r < 4; ++r) { float s = 0.f;
#pragma unroll
        for (int i = 0; i < 4; ++i) { s += o4[i][r] * o4[i][r]; ost[(16 * ct + lq * 4 + r) * 132 + (vh * 4 + i) * 16 + lr] = o4[i][r]; }
        s += __shfl_xor(s, 1); s += __shfl_xor(s, 2); s += __shfl_xor(s, 4); s += __shfl_xor(s, 8);
        if (lr == 0) part[vh * 64 + 16 * ct + lq * 4 + r] = s; }
    __syncthreads();
    {   const float* hn = A.in[10]; bf16_t* MIX = (bf16_t*)(ws + WS_MIX);
        const int cc = t >> 3, v0 = (t & 7) * 16; const float rstd = __builtin_amdgcn_rsqf((part[cc] + part[64 + cc]) * (1.0f / 128.0f) + EPS);
#pragma unroll
        for (int hh = 0; hh < 2; ++hh) { const int v = v0 + hh * 8; const u32x4 g8 = ggr[hh];
            const f32x4 oa = *(const f32x4*)(ost + cc * 132 + v), ob = *(const f32x4*)(ost + cc * 132 + v + 4), na = *(const f32x4*)(hn + C0 + v), nb = *(const f32x4*)(hn + C0 + v + 4);
            u32x4 o; o.x = pk2(oa[0] * rstd * na[0] * bfe(g8, 0), oa[1] * rstd * na[1] * bfe(g8, 1)); o.y = pk2(oa[2] * rstd * na[2] * bfe(g8, 2), oa[3] * rstd * na[3] * bfe(g8, 3));
            o.z = pk2(ob[0] * rstd * nb[0] * bfe(g8, 4), ob[1] * rstd * nb[1] * bfe(g8, 5)); o.w = pk2(ob[2] * rstd * nb[2] * bfe(g8, 6), ob[3] * rstd * nb[3] * bfe(g8, 7));
            *(u32x4*)(MIX + (size_t)(R0 + cc) * DM + C0 + v) = o; } }
    __syncthreads();
}
__device__ __forceinline__ void hgrn_scan(const Args& A, int G) {
    const u32x2v* SLT = (const u32x2v*)(A.ws + WS_SL); const f32x4* DEC4 = (const f32x4*)(A.ws + WS_DEC); u32x2v* SPT = (u32x2v*)(A.ws + WS_SPT); float* outp = A.out + O_HP;
    for (int e = blockIdx.x * NTHREADS + threadIdx.x; e < 32 * 4096; e += G * NTHREADS) { const int bh = e >> 12, i4 = e & 4095, v = i4 >> 5, k4 = i4 & 31;
        f32x4 S = (f32x4){0.f, 0.f, 0.f, 0.f};
        const u32x2v* p = SLT + (size_t)bh * 32 * 4096 + i4; u32x2v* q = SPT + (size_t)bh * 32 * 4096 + i4; const f32x4* dp = DEC4 + (size_t)bh * 32 * 32 + k4;
#pragma unroll
        for (int hf = 0; hf < 2; ++hf) { u32x2v loc[16]; f32x4 dd[16];
#pragma unroll
            for (int c = 0; c < 16; ++c) { loc[c] = p[(size_t)(hf * 16 + c) * 4096]; dd[c] = dp[(hf * 16 + c) * 32]; }
#pragma unroll
            for (int c = 0; c < 16; ++c) { u32x2v o; o.x = pk2(S[0], S[1]); o.y = pk2(S[2], S[3]); q[(size_t)(hf * 16 + c) * 4096] = o; const f32x4 lv = (f32x4){h_lo(loc[c].x), h_hi(loc[c].x), h_lo(loc[c].y), h_hi(loc[c].y)}; S = S * dd[c] + lv; } }
        float* ob = outp + (size_t)bh * 16384 + (k4 * 4) * 128 + v; ob[0] = S[0]; ob[128] = S[1]; ob[256] = S[2]; ob[384] = S[3]; }
}
__device__ __forceinline__ void pool_states(const Args& A, int G) {
    const unsigned short* UU = (const unsigned short*)(A.ws + WS_UU);
    const int gt = blockIdx.x * NTHREADS + threadIdx.x, NGT = G * NTHREADS;
    for (int i = gt; i < 8 * 15 * 128; i += NGT) { const int c4 = i & 127, j = (i >> 7) % 15, b = i / (15 * 128); const u32x2v v = *(const u32x2v*)(UU + (size_t)(b * SEQ + 2033 + j) * HW + c4 * 4);
        *(f32x4*)(A.out + O_PP + (size_t)i * 4) = (f32x4){h_lo(v.x), h_hi(v.x), h_lo(v.y), h_hi(v.y)}; }
    for (int i0 = gt * 2; i0 < 128 * 15 * 128; i0 += NGT * 2) { f32x4 v[2];
#pragma unroll
        for (int q = 0; q < 2; ++q) { const int i = i0 + q, c4 = i & 127, j = (i >> 7) % 15, b = i / (15 * 128);
            if (j < 14) v[q] = *(const f32x4*)(A.in[4] + (size_t)(b * 15 + j + 1) * 512 + c4 * 4);
            else { const u32x2v h = *(const u32x2v*)(UU + (size_t)(NPR + b) * HW + c4 * 4); v[q] = (f32x4){h_lo(h.x), h_hi(h.x), h_lo(h.y), h_hi(h.y)}; } }
#pragma unroll
        for (int q = 0; q < 2; ++q) *(f32x4*)(A.out + O_PS + (size_t)(i0 + q) * 4) = v[q]; }
}
__device__ __forceinline__ void hgrn_sample_load(const Args& A, int unit, f32x4 (&sreg)[8]) {
    const int t = threadIdx.x; const float* S0 = A.in[3] + (size_t)unit * 16384;
#pragma unroll
    for (int i = 0; i < 8; ++i) sreg[i] = *(const f32x4*)(S0 + ((t >> 5) * 8 + i) * 128 + (t & 31) * 4);
}
__device__ __forceinline__ void hgrn_sample_unit(const Args& A, unsigned char* lds, int unit, int next, f32x4 (&sreg)[8]) {
    const int t = threadIdx.x, b = unit >> 2, h = unit & 3, row = NPR + b, C0 = h * 128;
    unsigned char* ws = A.ws;
    float* qs = (float*)lds; float* ks = qs + 128; float* fs = ks + 128; float* vs = fs + 128; float* po = vs + 128;
    float* red = po + 16 * 128;
    float* S1 = A.out + O_HS + (size_t)unit * 16384;
    if (t < 128) { const size_t go = (size_t)row * HW + C0 + t;
        qs[t] = bf2f(((const bf16_t*)(ws + WS_QQ))[go]); ks[t] = bf2f(((const bf16_t*)(ws + WS_KK))[go]); fs[t] = __expf((float)__builtin_bit_cast(_Float16, ((const unsigned short*)(ws + WS_LF))[go])); vs[t] = bf2f(((const bf16_t*)(ws + WS_VV))[go]); }
    __syncthreads();
    const int v4 = t & 31, kg = t >> 5;
    const f32x4 vv = *(const f32x4*)(vs + v4 * 4);
    f32x4 o = (f32x4){0.f, 0.f, 0.f, 0.f};
#pragma unroll
    for (int i = 0; i < 8; ++i) { const int k = kg * 8 + i; const f32x4 s = sreg[i]; const f32x4 sn = s * fs[k] + vv * ks[k]; *(f32x4*)(S1 + k * 128 + v4 * 4) = sn; o += sn * qs[k]; }
    *(f32x4*)(po + kg * 128 + v4 * 4) = o;
    if (next >= 0) hgrn_sample_load(A, next, sreg);
    __syncthreads();
    float ov = 0.f;
    if (t < 128) {
#pragma unroll
        for (int i = 0; i < 16; ++i) ov += po[i * 128 + t];
        const float sq = wave_sum(ov * ov); if ((t & 63) == 0) red[t >> 6] = sq; }
    __syncthreads();
    if (t < 128) { const float rstd = __builtin_amdgcn_rsqf((red[0] + red[1]) * (1.0f / 128.0f) + EPS); const float g = bf2f(((const bf16_t*)(ws + WS_GG))[(size_t)row * HW + C0 + t]);
        ((bf16_t*)(ws + WS_MIX))[(size_t)row * DM + C0 + t] = (bf16_t)f2bf(ov * rstd * A.in[10][C0 + t] * g); }
    __syncthreads();
}

constexpr int LP_EXT = 0, LP_PL = 40448, LP_MX = 57856;
__device__ __forceinline__ void pool_load(const Args& A, int unit, u32x4 (&mreg)[4], u32x2v (&ereg)[5]) {
    const int t = threadIdx.x; const int tt = unit >> 2, g = unit & 3;
    const unsigned short* UU = (const unsigned short*)(A.ws + WS_UU);
    const bf16_t* PM = (const bf16_t*)(A.ws + WS_PMIX) + (size_t)g * 16384;
#pragma unroll
    for (int i = 0; i < 4; ++i) { const int idx = i * 512 + t, d = idx >> 4, c8 = idx & 15; mreg[i] = *(const u32x4*)(PM + d * 128 + c8 * 8); }
    const int b = tt >> 5, t0 = (tt & 31) * 64;
#pragma unroll
    for (int i5 = 0; i5 < 5; ++i5) { const int idx = i5 * 512 + t, i = idx >> 5, c4 = idx & 31; const int tp = t0 - 15 + i;
        ereg[i5] = (u32x2v){0u, 0u}; if (idx < 79 * 32 && tp >= 0) ereg[i5] = *(const u32x2v*)(UU + (size_t)(b * SEQ + tp) * HW + g * 128 + c4 * 4); }
}
__device__ __forceinline__ void pool_unit(const Args& A, unsigned char* lds, int unit, int next, u32x4 (&mreg)[4], u32x2v (&ereg)[5]) {
    const int t = threadIdx.x, w = t >> 6, l = t & 63, lr = l & 15, lq = l >> 4;
    const int tt = unit >> 2, g = unit & 3, win = 2 << g;
    unsigned char* ws = A.ws;
    float* ext = (float*)(lds + LP_EXT); bf16_t* pl = (bf16_t*)(lds + LP_PL); bf16_t* mx = (bf16_t*)(lds + LP_MX);
    const unsigned short* UU = (const unsigned short*)(ws + WS_UU);
    {
#pragma unroll
        for (int i = 0; i < 4; ++i) { const int idx = i * 512 + t, d = idx >> 4, c8 = idx & 15; *(u32x4*)(mx + d * 136 + c8 * 8) = mreg[i]; }
    }
    int rowbase;
    {
        const int b = tt >> 5, t0 = (tt & 31) * 64; rowbase = b * SEQ + t0;
#pragma unroll
        for (int i5 = 0; i5 < 5; ++i5) { const int idx = i5 * 512 + t, i = idx >> 5, c4 = idx & 31; if (idx < 79 * 32) *(f32x4*)(ext + i * 128 + c4 * 4) = (f32x4){h_lo(ereg[i5].x), h_hi(ereg[i5].x), h_lo(ereg[i5].y), h_hi(ereg[i5].y)}; }
        if (next >= 0) pool_load(A, next, mreg, ereg);
        __syncthreads();
        const int cch = t & 127, tg = t >> 7, tk0 = tg * 16;
        float nw[16], od[16], ini[16];
#pragma unroll
        for (int i = 0; i < 16; ++i) { nw[i] = ext[(15 + tk0 + i) * 128 + cch]; od[i] = (i >= 1) ? ext[(15 + tk0 + i - win) * 128 + cch] : 0.f; ini[i] = (i >= 1 && i < win) ? ext[(15 + tk0 - i) * 128 + cch] : 0.f; }
        float sw = 0.f;
#pragma unroll
        for (int i = 1; i < 16; ++i) sw += ini[i];
#pragma unroll
        for (int i = 0; i < 16; ++i) { const int tok = tk0 + i; sw += nw[i]; sw -= od[i];
            const int cnt = min(t0 + tok + 1, win);
            pl[tok * 136 + cch] = (bf16_t)f2bf(sw / (float)cnt - nw[i]); }
    }
    __syncthreads();
    const int ct = w & 3, dh = w >> 2;
    f32x4 o4[4];
#pragma unroll
    for (int i = 0; i < 4; ++i) o4[i] = (f32x4){0.f, 0.f, 0.f, 0.f};
#pragma unroll
    for (int ks = 0; ks < 4; ++ks) { const bf16x8 a = *(const bf16x8*)(pl + (16 * ct + lr) * 136 + ks * 32 + lq * 8);
#pragma unroll
        for (int i = 0; i < 4; ++i) { const int dt = dh * 4 + i; const bf16x8 bb = *(const bf16x8*)(mx + (16 * dt + lr) * 136 + ks * 32 + lq * 8); o4[i] = MFMA16(a, bb, o4[i]); } }
    bf16_t* MIX = (bf16_t*)(ws + WS_MIX); const float* psc = A.in[12];
    float* ost = (float*)(lds + LP_EXT);
#pragma unroll
    for (int i = 0; i < 4; ++i) { const int d = (dh * 4 + i) * 16 + lr; const float sc = psc[g * 128 + d];
#pragma unroll
        for (int r = 0; r < 4; ++r) ost[(16 * ct + lq * 4 + r) * 132 + d] = o4[i][r] * sc; }
    __syncthreads();
    {   const int tok = t >> 3, d0 = (t & 7) * 16;
#pragma unroll
        for (int hh = 0; hh < 2; ++hh) { const f32x4 oa = *(const f32x4*)(ost + tok * 132 + d0 + hh * 8), ob = *(const f32x4*)(ost + tok * 132 + d0 + hh * 8 + 4);
            u32x4 o; o.x = pk2(oa[0], oa[1]); o.y = pk2(oa[2], oa[3]); o.z = pk2(ob[0], ob[1]); o.w = pk2(ob[2], ob[3]);
            *(u32x4*)(MIX + (size_t)(rowbase + tok) * DM + 512 + g * 128 + d0 + hh * 8) = o; } }
    __syncthreads();
}

__device__ __forceinline__ void pool_sample_unit(const Args& A, unsigned char* lds, int unit) {
    const int t = threadIdx.x, w = t >> 6, l = t & 63, lr = l & 15, lq = l >> 4;
    const int su = unit >> 2, g = unit & 3, win = 2 << g;
    unsigned char* ws = A.ws;
    bf16_t* pl = (bf16_t*)(lds + LP_PL); bf16_t* mx = (bf16_t*)(lds + LP_MX);
    const _Float16* UU = (const _Float16*)(ws + WS_UU);
    const bf16_t* PM = (const bf16_t*)(ws + WS_PMIX) + (size_t)g * 16384;
    u32x4 mreg[4];
#pragma unroll
    for (int i = 0; i < 4; ++i) { const int idx = i * 512 + t, d = idx >> 4, c8 = idx & 15; mreg[i] = *(const u32x4*)(PM + d * 128 + c8 * 8); }
    const int cch = t & 127, sq = t >> 7;
    const float psc_w = A.in[12][g * 128 + 16 * w + lr];
#pragma unroll
    for (int i = 0; i < 4; ++i) { const int tok = sq * 4 + i, sb = su * 16 + tok; const float uv = (float)UU[(size_t)(NPR + sb) * HW + g * 128 + cch];
        float pv[15];
#pragma unroll
        for (int j = 0; j < 15; ++j) pv[j] = A.in[4][(size_t)(sb * 15 + j) * 512 + g * 128 + cch];
        float sacc = uv;
#pragma unroll
        for (int j = 0; j < 15; ++j) sacc += (j >= 16 - win) ? pv[j] : 0.f;
        pl[tok * 136 + cch] = (bf16_t)f2bf(sacc / (float)win - uv); }
#pragma unroll
    for (int i = 0; i < 4; ++i) { const int idx = i * 512 + t, d = idx >> 4, c8 = idx & 15; *(u32x4*)(mx + d * 136 + c8 * 8) = mreg[i]; }
    __syncthreads();
    f32x4 acc = (f32x4){0.f, 0.f, 0.f, 0.f};
#pragma unroll
    for (int ks = 0; ks < 4; ++ks) { const bf16x8 a = *(const bf16x8*)(pl + lr * 136 + ks * 32 + lq * 8); const bf16x8 bb = *(const bf16x8*)(mx + (16 * w + lr) * 136 + ks * 32 + lq * 8); acc = MFMA16(a, bb, acc); }
    bf16_t* MIX = (bf16_t*)(ws + WS_MIX);
#pragma unroll
    for (int r = 0; r < 4; ++r) MIX[(size_t)(NPR + su * 16 + lq * 4 + r) * DM + 512 + g * 128 + 16 * w + lr] = (bf16_t)f2bf(acc[r] * psc_w);
    __syncthreads();
}

__device__ __forceinline__ void attn_prompt_unit(const Args& A, unsigned char* lds, int unit) {
    const int t = threadIdx.x, w = t >> 6, l = t & 63, lr = l & 15, lq = l >> 4;
    const int qt = unit & 15, h = (unit >> 4) & 3, b = unit >> 6;
    unsigned char* ws = A.ws;
    const bf16_t* Q = (const bf16_t*)(ws + WS_Q); const bf16_t* KB = (const bf16_t*)(ws + WS_KB); const bf16_t* VT = (const bf16_t*)(ws + WS_VT); bf16_t* O = (bf16_t*)(ws + WS_O);
    const int R0 = b * SEQ + qt * 128 + 16 * w;
    bf16_t* CB = (bf16_t*)lds;
    bf16_t* Pw = (bf16_t*)(lds + 73728) + w * (16 * 264);
    const bf16_t* kg = KB + (size_t)(b * 256) * DM + h * 256;
    const bf16_t* vg = VT + (size_t)(h * 256) * MEMR + b * 256;
    u32x4 stg0[4], stg1[4];
#define AT_LOADK(c, STG) _Pragma("unroll") for (int i_ = 0; i_ < 4; ++i_) { const int idx_ = i_ * 512 + t; STG[i_] = *(const u32x4*)(kg + (size_t)((c) * 64 + (idx_ >> 5)) * DM + (idx_ & 31) * 8); }
#define AT_LOADV(c, STG) _Pragma("unroll") for (int i_ = 0; i_ < 4; ++i_) { const int idx_ = i_ * 512 + t; STG[i_] = *(const u32x4*)(vg + (size_t)(idx_ >> 3) * MEMR + (c) * 64 + (idx_ & 7) * 8); }
#define AT_STOREK(bf, STG) _Pragma("unroll") for (int i_ = 0; i_ < 4; ++i_) { const int idx_ = i_ * 512 + t; *(u32x4*)(CB + (bf) * 18432 + (idx_ >> 5) * 264 + (idx_ & 31) * 8) = STG[i_]; }
#define AT_STOREV(bf, STG) _Pragma("unroll") for (int i_ = 0; i_ < 4; ++i_) { const int idx_ = i_ * 512 + t; *(u32x4*)(CB + (bf) * 18432 + (idx_ >> 3) * 72 + (idx_ & 7) * 8) = STG[i_]; }
    AT_LOADK(0, stg0); AT_LOADK(1, stg1);
    bf16x8 qa[8];
#pragma unroll
    for (int ks = 0; ks < 8; ++ks) qa[ks] = *(const bf16x8*)(Q + (size_t)(R0 + lr) * DM + h * 256 + ks * 32 + lq * 8);
    AT_STOREK(0, stg0);
    __syncthreads();
    f32x4 sacc[16]; f32x4 oacc[16]; bf16x8 pa[8]; float rinv[4];
#pragma unroll
    for (int st = 0; st < 8; ++st) {
        if (st & 1) { if (st + 2 < 4) { AT_LOADK(st + 2, stg1); } else if (st + 2 < 8) { AT_LOADV(st - 2, stg1); } }
        else        { if (st + 2 < 4) { AT_LOADK(st + 2, stg0); } else if (st + 2 < 8) { AT_LOADV(st - 2, stg0); } }
        const bf16_t* cb = CB + (st & 1) * 18432;
        if (st < 4) {
#pragma unroll
            for (int nt = 0; nt < 4; ++nt) { f32x4 acc = (f32x4){0.f, 0.f, 0.f, 0.f};
#pragma unroll
                for (int ks = 0; ks < 8; ++ks) { const bf16x8 bb = *(const bf16x8*)(cb + (nt * 16 + lr) * 264 + ks * 32 + lq * 8); acc = MFMA16(qa[ks], bb, acc); }
                sacc[st * 4 + nt] = acc; __builtin_amdgcn_sched_barrier(0); }
        } else {
            if (st == 4) {
#pragma unroll
                for (int r = 0; r < 4; ++r) { float mx = sacc[0][r];
#pragma unroll
                    for (int nt = 1; nt < 16; ++nt) mx = fmaxf(mx, sacc[nt][r]);
                    mx = fmaxf(mx, __shfl_xor(mx, 1)); mx = fmaxf(mx, __shfl_xor(mx, 2)); mx = fmaxf(mx, __shfl_xor(mx, 4)); mx = fmaxf(mx, __shfl_xor(mx, 8));
                    float sum = 0.f;
#pragma unroll
                    for (int nt = 0; nt < 16; ++nt) { const float p = __builtin_amdgcn_exp2f(sacc[nt][r] - mx); sum += p; Pw[(lq * 4 + r) * 264 + nt * 16 + lr] = (bf16_t)f2bf(p); }
                    sum += __shfl_xor(sum, 1); sum += __shfl_xor(sum, 2); sum += __shfl_xor(sum, 4); sum += __shfl_xor(sum, 8);
                    rinv[r] = 1.0f / sum; }
                asm volatile("s_waitcnt lgkmcnt(0)" ::: "memory");
#pragma unroll
                for (int ks = 0; ks < 8; ++ks) pa[ks] = *(const bf16x8*)(Pw + lr * 264 + ks * 32 + lq * 8);
#pragma unroll
                for (int dt = 0; dt < 16; ++dt) oacc[dt] = (f32x4){0.f, 0.f, 0.f, 0.f};
            }
            const int c = st - 4;
#pragma unroll
            for (int dt = 0; dt < 16; ++dt)
#pragma unroll
                for (int k2 = 0; k2 < 2; ++k2) { const bf16x8 bb = *(const bf16x8*)(cb + (dt * 16 + lr) * 72 + k2 * 32 + lq * 8); oacc[dt] = MFMA16(pa[c * 2 + k2], bb, oacc[dt]); if (k2 == 1 && (dt & 1)) __builtin_amdgcn_sched_barrier(0); }
        }
        if (st & 1) { if (st + 1 < 4) { AT_STOREK(0, stg0); } else if (st + 1 < 8) { AT_STOREV(0, stg0); } }
        else        { if (st + 1 < 4) { AT_STOREK(1, stg1); } else if (st + 1 < 8) { AT_STOREV(1, stg1); } }
        __syncthreads();
    }
#pragma unroll
    for (int dt = 0; dt < 16; ++dt)
#pragma unroll
        for (int r = 0; r < 4; ++r) Pw[(lq * 4 + r) * 264 + dt * 16 + lr] = (bf16_t)f2bf(oacc[dt][r] * rinv[r]);
    asm volatile("s_waitcnt lgkmcnt(0)" ::: "memory");
#pragma unroll
    for (int i = 0; i < 8; ++i) { const int idx = i * 64 + l, row = idx >> 5, c8 = idx & 31; *(u32x4*)(O + (size_t)(R0 + row) * DM + h * 256 + c8 * 8) = *(const u32x4*)(Pw + row * 264 + c8 * 8); }
    asm volatile("s_waitcnt lgkmcnt(0)" ::: "memory");
#undef AT_LOADK
#undef AT_LOADV
#undef AT_STOREK
#undef AT_STOREV
}
__device__ __forceinline__ void attn_sample_unit(const Args& A, unsigned char* lds, int unit) {
    const int t = threadIdx.x, w = t >> 6, l = t & 63;
    const int b = unit >> 2, h = unit & 3;
    unsigned char* ws = A.ws;
    float* qs = (float*)lds; float* sc = qs + 256; float* red = sc + 256; float* po = red + 16;
    const float* Kc = A.in[5] + (size_t)b * 256 * 1024 + h * 256; const float* Vc = A.in[6] + (size_t)b * 256 * 1024 + h * 256;
    const int rl = l >> 4, c16 = l & 15;
    f32x4 kr[8][4];
#pragma unroll
    for (int p = 0; p < 8; ++p)
#pragma unroll
        for (int i = 0; i < 4; ++i) kr[p][i] = *(const f32x4*)(Kc + (size_t)(p * 32 + w * 4 + rl) * 1024 + i * 64 + c16 * 4);
    if (t < 256) qs[t] = bf2f(((const bf16_t*)(ws + WS_Q))[(size_t)(NPR + b) * DM + h * 256 + t]);
    __syncthreads();
    {
        f32x4 q4[4];
#pragma unroll
        for (int i = 0; i < 4; ++i) q4[i] = *(const f32x4*)(qs + i * 64 + c16 * 4);
#pragma unroll
        for (int p = 0; p < 8; ++p) { const int m = p * 32 + w * 4 + rl; float s = 0.f;
#pragma unroll
            for (int i = 0; i < 4; ++i) { const f32x4 kv = kr[p][i]; s += (kv[0] * q4[i][0] + kv[1] * q4[i][1]) + (kv[2] * q4[i][2] + kv[3] * q4[i][3]); }
            s += __shfl_xor(s, 1); s += __shfl_xor(s, 2); s += __shfl_xor(s, 4); s += __shfl_xor(s, 8);
            if (c16 == 0) sc[m] = s; }
    }
    f32x4 vr[32];
#pragma unroll
    for (int i = 0; i < 32; ++i) vr[i] = *(const f32x4*)(Vc + (size_t)(w * 32 + i) * 1024 + l * 4);
    __syncthreads();
    if (t < 256) { float mx = sc[t];
#pragma unroll
        for (int o = 1; o < 64; o <<= 1) mx = fmaxf(mx, __shfl_xor(mx, o));
        if (l == 0) red[w] = mx; }
    __syncthreads();
    const float gmx = fmaxf(fmaxf(red[0], red[1]), fmaxf(red[2], red[3]));
    float pv = 0.f;
    if (t < 256) { pv = __builtin_amdgcn_exp2f(sc[t] - gmx); const float s = wave_sum(pv); if (l == 0) red[8 + w] = s; }
    __syncthreads();
    if (t < 256) sc[t] = pv;
    const float inv = 1.0f / ((red[8] + red[9]) + (red[10] + red[11]));
    __syncthreads();
    {
        f32x4 o = (f32x4){0.f, 0.f, 0.f, 0.f};
#pragma unroll
        for (int i = 0; i < 32; ++i) o += vr[i] * sc[w * 32 + i];
        *(f32x4*)(po + w * 256 + l * 4) = o;
    }
    __syncthreads();
    if (t < 256) { float o = 0.f;
#pragma unroll
        for (int i = 0; i < 8; ++i) o += po[i * 256 + t];
        ((bf16_t*)(ws + WS_O))[(size_t)(NPR + b) * DM + h * 256 + t] = (bf16_t)f2bf(o * inv); }
    __syncthreads();
}

__device__ __forceinline__ void attn_sample_pair(const Args& A, unsigned char* lds, int pg) {
    const int t = threadIdx.x, w = t >> 6, l = t & 63, rl = l >> 4, c16 = l & 15;
    const int pair = pg * 2 + (w >> 2), wq = w & 3, b = pair >> 2, h = pair & 3;
    const size_t off0 = (size_t)b * 256 * 1024 + h * 256 + (size_t)(wq * 64 + rl) * 1024 + c16 * 4;
    const float* Kc = A.in[5] + off0; const float* Vc = A.in[6] + off0;
    f32x4 ra[8], rb[8];
#define AS_LD(set, base, bt) _Pragma("unroll") for (int gg_ = 0; gg_ < 2; ++gg_) _Pragma("unroll") for (int i_ = 0; i_ < 4; ++i_) set[gg_ * 4 + i_] = *(const f32x4*)((base) + (size_t)((bt) * 8 + gg_ * 4) * 1024 + i_ * 64)
    AS_LD(ra, Kc, 0); AS_LD(rb, Kc, 1);
    f32x4 q4[4];
    {   const bf16_t* qp = (const bf16_t*)(A.ws + WS_Q) + (size_t)(NPR + b) * DM + h * 256 + c16 * 4;
#pragma unroll
        for (int i = 0; i < 4; ++i) { const u32x2v qv = *(const u32x2v*)(qp + i * 64); q4[i] = (f32x4){__uint_as_float(qv.x << 16), __uint_as_float(qv.x & 0xffff0000u), __uint_as_float(qv.y << 16), __uint_as_float(qv.y & 0xffff0000u)}; } }
    float sc[16];
#define AS_SCORE(set, bt) _Pragma("unroll") for (int gg_ = 0; gg_ < 2; ++gg_) { float s_ = 0.f; _Pragma("unroll") for (int i_ = 0; i_ < 4; ++i_) { const f32x4 kv_ = set[gg_ * 4 + i_]; s_ += (kv_[0] * q4[i_][0] + kv_[1] * q4[i_][1]) + (kv_[2] * q4[i_][2] + kv_[3] * q4[i_][3]); } \
        s_ += __shfl_xor(s_, 1); s_ += __shfl_xor(s_, 2); s_ += __shfl_xor(s_, 4); s_ += __shfl_xor(s_, 8); sc[(bt) * 2 + gg_] = s_; }
#pragma unroll
    for (int bt = 0; bt < 8; ++bt) {
        if (bt & 1) { AS_SCORE(rb, bt); if (bt + 2 < 8) { AS_LD(rb, Kc, bt + 2); } else { AS_LD(rb, Vc, bt - 6); } }
        else        { AS_SCORE(ra, bt); if (bt + 2 < 8) { AS_LD(ra, Kc, bt + 2); } else { AS_LD(ra, Vc, bt - 6); } }
        asm volatile("" ::: "memory"); __builtin_amdgcn_sched_barrier(0);
    }
    float mx = sc[0];
#pragma unroll
    for (int g = 1; g < 16; ++g) mx = fmaxf(mx, sc[g]);
    mx = fmaxf(mx, __shfl_xor(mx, 16)); mx = fmaxf(mx, __shfl_xor(mx, 32));
    float ls = 0.f;
#pragma unroll
    for (int g = 0; g < 16; ++g) { sc[g] = __builtin_amdgcn_exp2f(sc[g] - mx); ls += sc[g]; }
    ls += __shfl_xor(ls, 16); ls += __shfl_xor(ls, 32);
    f32x4 o[4];
#pragma unroll
    for (int i = 0; i < 4; ++i) o[i] = (f32x4){0.f, 0.f, 0.f, 0.f};
#define AS_PV(set, bt) _Pragma("unroll") for (int gg_ = 0; gg_ < 2; ++gg_) _Pragma("unroll") for (int i_ = 0; i_ < 4; ++i_) o[i_] += set[gg_ * 4 + i_] * sc[(bt) * 2 + gg_]
#pragma unroll
    for (int bt = 0; bt < 8; ++bt) {
        if (bt & 1) { AS_PV(rb, bt); if (bt + 2 < 8) { AS_LD(rb, Vc, bt + 2); } }
        else        { AS_PV(ra, bt); if (bt + 2 < 8) { AS_LD(ra, Vc, bt + 2); } }
        asm volatile("" ::: "memory"); __builtin_amdgcn_sched_barrier(0);
    }
#pragma unroll
    for (int i = 0; i < 4; ++i)
#pragma unroll
        for (int c = 0; c < 4; ++c) { float v = o[i][c]; v += __shfl_xor(v, 16); v += __shfl_xor(v, 32); o[i][c] = v; }
    float* pw = (float*)lds + w * 260;
    if (rl == 0) {
#pragma unroll
        for (int i = 0; i < 4; ++i) *(f32x4*)(pw + i * 64 + c16 * 4) = o[i];
        if (c16 == 0) { pw[256] = mx; pw[257] = ls; } }
    __syncthreads();
    {   const int ps = t >> 8, d = t & 255; const float* pb = (const float*)lds + (ps * 4) * 260;
        const float m0 = pb[256], m1 = pb[260 + 256], m2 = pb[520 + 256], m3 = pb[780 + 256]; const float M = fmaxf(fmaxf(m0, m1), fmaxf(m2, m3));
        const float e0 = __builtin_amdgcn_exp2f(m0 - M), e1 = __builtin_amdgcn_exp2f(m1 - M), e2 = __builtin_amdgcn_exp2f(m2 - M), e3 = __builtin_amdgcn_exp2f(m3 - M);
        const float num = (pb[d] * e0 + pb[260 + d] * e1) + (pb[520 + d] * e2 + pb[780 + d] * e3);
        const float den = (pb[257] * e0 + pb[260 + 257] * e1) + (pb[520 + 257] * e2 + pb[780 + 257] * e3);
        const int pr = pg * 2 + ps, bb = pr >> 2, hh = pr & 3;
        ((bf16_t*)(A.ws + WS_O))[(size_t)(NPR + bb) * DM + hh * 256 + d] = (bf16_t)f2bf(num / den); }
    __syncthreads();
#undef AS_LD
#undef AS_SCORE
#undef AS_PV
}

template <int KIND, int NKS>
__device__ __forceinline__ void sample_gemm(unsigned char* lds, const bf16_t* Asm, int lda, const bf16_t* Bt, int K, int unit, const float* base, const bf16_t* baseb, float* out, bf16_t* outb, float* ss, float scale) {
    const int t = threadIdx.x, w = t >> 6, l = t & 63, lr = l & 15, lq = l >> 4;
    const int rb = unit & 3, cb = unit >> 2, kw = K >> 3, k0 = w * kw;
    f32x4 acc[2]; acc[0] = (f32x4){0.f, 0.f, 0.f, 0.f}; acc[1] = acc[0];
    const bf16_t* bp = Bt + (size_t)(cb * 16 + lr) * K + k0 + lq * 8;
    const bf16_t* ap = Asm + (size_t)(rb * 32 + lr) * lda + k0 + lq * 8;
    bf16x8 fb[NKS], fa0[NKS], fa1[NKS];
#pragma unroll
    for (int ks = 0; ks < NKS; ++ks) { fb[ks] = *(const bf16x8*)(bp + ks * 32); fa0[ks] = *(const bf16x8*)(ap + ks * 32); fa1[ks] = *(const bf16x8*)(ap + (size_t)16 * lda + ks * 32); }
    const int row_ = t >> 4, col_ = t & 15;
    float bres = 0.f;
    if (KIND == 0) bres = base ? base[(size_t)(rb * 32 + row_) * DM + cb * 16 + col_] : bf2f(baseb[(size_t)(rb * 32 + row_) * DM + cb * 16 + col_]);
#pragma unroll
    for (int ks = 0; ks < NKS; ++ks) { acc[0] = MFMA16(fa0[ks], fb[ks], acc[0]); acc[1] = MFMA16(fa1[ks], fb[ks], acc[1]); }
    float* red = (float*)lds;
#pragma unroll
    for (int i = 0; i < 2; ++i)
#pragma unroll
        for (int r = 0; r < 4; ++r) red[(w * 32 + i * 16 + lq * 4 + r) * 16 + lr] = acc[i][r];
    __syncthreads();
    const int row = t >> 4, col = t & 15, grow = rb * 32 + row, gcol = cb * 16 + col;
    float v = 0.f;
#pragma unroll
    for (int i = 0; i < 8; ++i) v += red[(i * 32 + row) * 16 + col];
    if (KIND == 0) { const float val = bres + v; if (out) out[(size_t)grow * DM + gcol] = val; if (outb) outb[(size_t)grow * DM + gcol] = (bf16_t)f2bf(val);
        float sq = val * val; sq += __shfl_xor(sq, 1); sq += __shfl_xor(sq, 2); sq += __shfl_xor(sq, 4); sq += __shfl_xor(sq, 8);
        if (col == 0) atomicAdd(ss + grow, sq);
    } else { const float rstd = __builtin_amdgcn_rsqf(ss[grow] * (1.0f / DM) + EPS); outb[(size_t)grow * DM + gcol] = (bf16_t)f2bf(v * rstd * scale); }
    __syncthreads();
}

__device__ __forceinline__ void final_norm(const Args& A, int G, int row_lo) {
    const int lane = threadIdx.x & 63, gw = blockIdx.x * 8 + (threadIdx.x >> 6), NGW = G * 8;
    const float* ss = (const float*)(A.ws + WS_SS3); const f32x4* gr = (const f32x4*)A.in[22] + lane;
    f32x4 gg[4];
#pragma unroll
    for (int j = 0; j < 4; ++j) gg[j] = gr[64 * j];
    for (int m0 = row_lo + gw * 4; m0 < NVALID; m0 += NGW * 4) {
        f32x4 v[4][4]; float sv[4];
#pragma unroll
        for (int r = 0; r < 4; ++r) { sv[r] = ss[m0 + r]; const f32x4* xr = (const f32x4*)(A.out + (size_t)(m0 + r) * DM) + lane;
#pragma unroll
            for (int j = 0; j < 4; ++j) v[r][j] = xr[64 * j]; }
#pragma unroll
        for (int r = 0; r < 4; ++r) { const float rstd = 1.0f / sqrtf(sv[r] * (1.f / DM) + EPS); f32x4* xr = (f32x4*)(A.out + (size_t)(m0 + r) * DM) + lane;
#pragma unroll
            for (int j = 0; j < 4; ++j) xr[64 * j] = v[r][j] * rstd * gg[j]; } }
}

constexpr int NPHASES = 12;
#ifndef REPMASK
#define REPMASK 0
#endif
#define REPS(k) for (int rep_ = 0; rep_ < 1 + ((REPMASK >> (k)) & 1); ++rep_)
__global__ void __launch_bounds__(NTHREADS, 2) fwd_megakernel(Args args) {
    extern __shared__ __attribute__((aligned(16))) unsigned char lds[];
    cg::grid_group grid = cg::this_grid();
    const int G = gridDim.x, bx = blockIdx.x;
    unsigned char* ws = args.ws;
    PG8_LAS unsigned char* lds3 = (PG8_LAS unsigned char*)lds;
    const int lo = args.ph_lo, hi = args.ph_hi;
#define IN(k) (lo <= (k) && (k) < hi)
#ifndef SPINBLK
#define SPINBLK 0
#endif
#ifdef SPINMASK
    unsigned long long t_prev_ = __builtin_amdgcn_s_memrealtime(), t_acc_ = 0ull;
#define STAMP(k) do { const unsigned long long t_now_ = __builtin_amdgcn_s_memrealtime(); if ((SPINMASK >> (k)) & 1) t_acc_ += t_now_ - t_prev_; t_prev_ = t_now_; } while (0)
#else
#define STAMP(k) do { } while (0)
#endif
#define SEAM(k) do { if (IN(k) && IN((k) + 1)) xcd_barrier(bar); STAMP(k); } while (0)
    if (lo < 0) grid.sync();
    volatile LAS unsigned* MISC = (volatile LAS unsigned*)(lds3 + LDS_BYTES - 64);
    if (threadIdx.x < 16) MISC[threadIdx.x] = 0u;
    __syncthreads();
    XcdBarrier bar = xcd_barrier_post((unsigned*)(ws + WS_BAR), MISC);
    if (IN(0)) REPS(0) { p0_prologue(args, lds, G); }
    SEAM(0);
    if (IN(1)) REPS(1) {
        {   pg8::Gemm g{(const bf16_t*)(ws + WS_H0), (const bf16_t*)(ws + WS_WIN), MT, NIN, DM}; pg8::StaticOrder S; S.init(MT, NIN, G, bx);
            pg8::EpiInProj E{(bf16_t*)(ws + WS_QQ), (bf16_t*)(ws + WS_KK), (bf16_t*)(ws + WS_VV), (bf16_t*)(ws + WS_GG), (unsigned short*)(ws + WS_LF), (unsigned short*)(ws + WS_UU), args.in[9]};
            pg8::gemm_phase<pg8::EpiInProj, pg8::StaticOrder, true, true>(lds3, g, S, E); }
        {   pg8::Gemm g{(const bf16_t*)(ws + WS_MEMH), (const bf16_t*)(ws + WS_WKV), MEMR, 2 * DM, DM}; pg8::StaticOrder S; S.init(MEMR, 2 * DM, G, (bx + G - (650 % G)) % G);
            pg8::EpiMemKV E{args.out + O_MK, args.out + O_MV, (bf16_t*)(ws + WS_KB)};
            pg8::gemm_phase<pg8::EpiMemKV, pg8::StaticOrder, true, true>(lds3, g, S, E); }
        {   pg8::Gemm g{(const bf16_t*)(ws + WS_WKV) + (size_t)DM * DM, (const bf16_t*)(ws + WS_MEMH), DM, MEMR, DM}; pg8::StaticOrder S; S.init(DM, MEMR, G, (bx + 2 * G - ((650 + 64) % G)) % G);
            pg8::EpiBf16Scale E{(bf16_t*)(ws + WS_VT), MEMR, nullptr, 1.0f};
            pg8::gemm_phase<pg8::EpiBf16Scale, pg8::StaticOrder, true, true>(lds3, g, S, E); }
    }
    SEAM(1);
    if (IN(2)) REPS(2) {
        const bool sfirst = ((bx >> 3) & 1) != 0;
#pragma unroll 1
        for (int pass = 0; pass < 2; ++pass) {
            if ((pass == 0) == sfirst) {
                f32x4 sreg[8]; if (bx < 512) hgrn_sample_load(args, bx, sreg);
                for (int u = bx; u < 512; u += G) hgrn_sample_unit(args, lds, u, (u + G < 512) ? u + G : -1, sreg);
            } else {
                u32x2v lf[4]; u32x4 kkr[2], vvr[2]; if (bx < 1024) hgrn_local_load(args, bx, lf, kkr, vvr);
                for (int u = bx; u < 1024; u += G) hgrn_local_unit(args, lds, u, (u + G < 1024) ? u + G : -1, lf, kkr, vvr);
            }
        }
    }
    SEAM(2);
    if (IN(3)) REPS(3) { for (int u = bx; u < 32; u += G) pool_sample_unit(args, lds, u); hgrn_scan(args, G); pool_states(args, G); }
    SEAM(3);
    if (IN(4)) REPS(4) {
        {   u32x2v lf[4]; u32x4 qqr[2], kkr[2], vvr[2], spr[4]; if (bx < 1024) hgrn_out_load(args, bx, lf, qqr, kkr, vvr, spr);
            for (int u = bx; u < 1024; u += G) hgrn_out_unit(args, lds, u, (u + G < 1024) ? u + G : -1, lf, qqr, kkr, vvr, spr); }
        STAMP(12);
        {   u32x4 mreg[4]; u32x2v ereg[5]; if (bx < 1024) pool_load(args, bx, mreg, ereg);
            for (int u = bx; u < 1024; u += G) pool_unit(args, lds, u, (u + G < 1024) ? u + G : -1, mreg, ereg); }
        STAMP(13);
        for (int u = bx; u < 256; u += G) sample_gemm<0, 4>(lds, (const bf16_t*)(ws + WS_MIX) + (size_t)NPR * DM, DM, (const bf16_t*)(ws + WS_WOUT), DM, u, args.in[1], nullptr, nullptr, (bf16_t*)(ws + WS_H0) + (size_t)NPR * DM, (float*)(ws + WS_SS1) + NPR, 1.0f);
    }
    SEAM(4);
    if (IN(5)) REPS(5) {
        pg8::Gemm g{(const bf16_t*)(ws + WS_MIX), (const bf16_t*)(ws + WS_WOUT), NPR, DM, DM}; pg8::StaticOrder S; S.init(NPR, DM, G, bx);
        pg8::EpiResid E{args.in[0], nullptr, nullptr, (bf16_t*)(ws + WS_H0), (float*)(ws + (rep_ ? WS_SSD : WS_SS1))};
        pg8::gemm_phase<pg8::EpiResid, pg8::StaticOrder, true, true>(lds3, g, S, E);
        for (int u = bx; u < 256; u += G) sample_gemm<1, 4>(lds, (const bf16_t*)(ws + WS_H0) + (size_t)NPR * DM, DM, (const bf16_t*)(ws + WS_WCQ), DM, u, nullptr, nullptr, nullptr, (bf16_t*)(ws + WS_Q) + (size_t)NPR * DM, (float*)(ws + WS_SS1) + NPR, 0.0625f * 1.4426950408889634f);
    }
    SEAM(5);
    const bool stream_first = ((bx >> 3) & 1) != 0;
    if (IN(7) && stream_first) for (int u = bx; u < 256; u += G) attn_sample_pair(args, lds, u);
    if (IN(6)) {
        pg8::Gemm g{(const bf16_t*)(ws + WS_H0), (const bf16_t*)(ws + WS_WCQ), NPR, DM, DM}; pg8::StaticOrder S; S.init(NPR, DM, G, bx);
        pg8::EpiBf16Scale E{(bf16_t*)(ws + WS_Q), DM, (const float*)(ws + WS_SS1), 0.0625f * 1.4426950408889634f};
        pg8::gemm_phase<pg8::EpiBf16Scale, pg8::StaticOrder, true, true>(lds3, g, S, E);
        STAMP(16);
    }
    int au0 = bx, au1 = 512, austep = G;
    if (G == 256) {
        asm volatile("s_waitcnt vmcnt(0)" ::: "memory"); __syncthreads();
        const int wg_ = (bx & 7) * 32 + (bx >> 3), pm_ = (wg_ >> 5) * 8 + ((wg_ & 31) & 7), pn_ = (wg_ & 31) >> 3;
        au0 = ((pm_ >> 3) * 4 + pn_) * 16 + (pm_ & 7) * 2; au1 = au0 + 2; austep = 1;
    } else { SEAM(6); }
    if (IN(7)) {
        for (int u = au0; u < au1; u += austep) attn_prompt_unit(args, lds, u);
        STAMP(17);
        if (!stream_first) for (int u = bx; u < 256; u += G) attn_sample_pair(args, lds, u);
    }
    SEAM(7);
    if (IN(8)) REPS(8) {
        pg8::Gemm g{(const bf16_t*)(ws + WS_O), (const bf16_t*)(ws + WS_WCO), NPR, DM, DM}; pg8::StaticOrder S; S.init(NPR, DM, G, bx);
        pg8::EpiResid E{nullptr, (const bf16_t*)(ws + WS_H0), nullptr, (bf16_t*)(ws + WS_MIX), (float*)(ws + (rep_ ? WS_SSD : WS_SS2))};
        pg8::gemm_phase<pg8::EpiResid, pg8::StaticOrder, true, true>(lds3, g, S, E);
        for (int u = bx; u < 256; u += G) sample_gemm<0, 4>(lds, (const bf16_t*)(ws + WS_O) + (size_t)NPR * DM, DM, (const bf16_t*)(ws + WS_WCO), DM, u, nullptr, (const bf16_t*)(ws + WS_H0) + (size_t)NPR * DM, nullptr, (bf16_t*)(ws + WS_MIX) + (size_t)NPR * DM, (float*)(ws + (rep_ ? WS_SSD : WS_SS2)) + NPR, 1.0f);
    }
    SEAM(8);
    if (IN(9)) REPS(9) {
        pg8::Gemm g{(const bf16_t*)(ws + WS_MIX), (const bf16_t*)(ws + WS_WFFI), MT, NFF2, DM}; pg8::StaticOrder S; S.init(MT, NFF2, G, bx);
        pg8::EpiSwiGLU E{(bf16_t*)(ws + WS_A), (const float*)(ws + WS_SS2)};
        pg8::gemm_phase<pg8::EpiSwiGLU, pg8::StaticOrder, true, true>(lds3, g, S, E);
    }
    SEAM(9);
    if (IN(10)) {
        pg8::Gemm g{(const bf16_t*)(ws + WS_A), (const bf16_t*)(ws + WS_WFFO), NPR, DM, DFF}; pg8::StaticOrder S; S.init(NPR, DM, G, bx);
        if (G == 256) {
            pg8::EpiResidNorm E{(const bf16_t*)(ws + WS_MIX), args.out, (float*)(ws + WS_SS3), (unsigned*)(ws + WS_CNT), args.in[22]};
            pg8::gemm_phase<pg8::EpiResidNorm, pg8::StaticOrder, false, true>(lds3, g, S, E);
        } else {
            pg8::EpiResid E{nullptr, (const bf16_t*)(ws + WS_MIX), args.out, nullptr, (float*)(ws + WS_SS3)};
            pg8::gemm_phase<pg8::EpiResid, pg8::StaticOrder, true, true>(lds3, g, S, E);
        }
        for (int u = bx; u < 256; u += G) sample_gemm<0, 11>(lds, (const bf16_t*)(ws + WS_A) + (size_t)NPR * DFF, DFF, (const bf16_t*)(ws + WS_WFFO), DFF, u, nullptr, (const bf16_t*)(ws + WS_MIX) + (size_t)NPR * DM, args.out + O_YS, nullptr, (float*)(ws + WS_SS3) + NPR, 1.0f);
    }
    SEAM(10);
#ifdef EXTRA_SYNCS
    for (int i_ = 0; i_ < EXTRA_SYNCS; ++i_) xcd_barrier(bar);
#endif
    if (IN(11)) { final_norm(args, G, G == 256 ? NPR : 0); }
#ifdef SPINMASK
    STAMP(11);
    if (bx == SPINBLK && threadIdx.x == 0) { const unsigned long long t0_ = __builtin_amdgcn_s_memrealtime(); while (__builtin_amdgcn_s_memrealtime() - t0_ < t_acc_) __builtin_amdgcn_s_sleep(8); }
#endif
#undef IN
#undef SEAM
}

#ifndef MK_MULTI
#define MK_MULTI 0
#endif
extern "C" void kernel_launch(void* const* d_in, const int* in_sizes, int n_in, void* d_out, int out_size, void* d_ws, size_t ws_size, hipStream_t stream) {
    static int grid = 0;
    if (grid == 0) {
        if (n_in != 23 || ws_size < WS_END) { fprintf(stderr, "kernel_launch: unexpected n_in %d / ws_size %zu\n", n_in, ws_size); grid = -1; return; }
        int dev = 0, cus = 0, per_cu = 0;
        hipGetDevice(&dev); hipDeviceGetAttribute(&cus, hipDeviceAttributeMultiprocessorCount, dev);
        if (hipFuncSetAttribute((const void*)fwd_megakernel, hipFuncAttributeMaxDynamicSharedMemorySize, LDS_BYTES) != hipSuccess) { fprintf(stderr, "kernel_launch: hipFuncSetAttribute failed\n"); grid = -1; return; }
        hipOccupancyMaxActiveBlocksPerMultiprocessor(&per_cu, (const void*)fwd_megakernel, NTHREADS, LDS_BYTES);
        (void)hipGetLastError();
        if (per_cu < 1) { fprintf(stderr, "kernel_launch: occupancy query says %d blocks/CU\n", per_cu); per_cu = 1; }
        grid = cus;
    }
    if (grid < 0) return;
    Args a{};
    for (int i = 0; i < 23; ++i) a.in[i] = (const float*)d_in[i];
    a.out = (float*)d_out; a.ws = (unsigned char*)d_ws;
#if MK_MULTI
    for (int p = 0; p < NPHASES; ++p) { a.ph_lo = p; a.ph_hi = p + 1; hipLaunchKernelGGL(fwd_megakernel, dim3(grid), dim3(NTHREADS), LDS_BYTES, stream, a); }
#else
    a.ph_lo = 0; a.ph_hi = NPHASES;
    if (hipMemsetAsync((char*)d_ws + WS_BAR, 0, BAR_BYTES, stream) != hipSuccess) { fprintf(stderr, "kernel_launch: memset failed\n"); return; }
    void* kargs[] = {&a};
    hipError_t e = hipLaunchCooperativeKernel((const void*)fwd_megakernel, dim3(grid), dim3(NTHREADS), kargs, LDS_BYTES, stream);
    if (e != hipSuccess) fprintf(stderr, "kernel_launch: cooperative launch failed: %s (grid %d)\n", hipGetErrorString(e), grid);
#endif
}
```

```cpp
#include <hip/hip_runtime.h>
#include <hip/hip_cooperative_groups.h>
#include <cstdio>
#include <cstdint>
namespace cg = cooperative_groups;
namespace pg8 {
#define PG8_LAS __attribute__((address_space(3)))
typedef unsigned short bf16_t;
typedef short bf16x8 __attribute__((ext_vector_type(8)));
typedef float f32x4 __attribute__((ext_vector_type(4)));
typedef unsigned u32x4 __attribute__((ext_vector_type(4)));
constexpr int BM = 256, BK = 64, HALF = 128, HTB = HALF * BK * 2  , STAGE_BYTES = 8 * HTB, NXCD = 8, WGM = 8;

__host__ __device__ __forceinline__ int lds_byte(int r, int c) { const int st = (r >> 4) * 2 + (c >> 5), rr = r & 15, cc = c & 31, ob = rr * 64 + cc * 2; return st * 1024 + (ob ^ (((ob >> 9) & 1) << 5)); }
__host__ __device__ __forceinline__ void stage_rc(int b, int& R, int& C) { const int st = b / 1024, sb = b % 1024, swz = sb ^ (((sb >> 9) & 1) << 5); R = (st >> 1) * 16 + swz / 64; C = (st & 1) * 32 + (swz % 64) / 2; }
__host__ __device__ __forceinline__ int perm32(int rho) { const int n = rho >> 4, i = rho & 15; return 8 * (i >> 2) + 4 * n + (i & 3); }

struct Unit { int pm, pn; };
struct Gemm { const bf16_t* A; const bf16_t* Bt; int M, N, K; };

struct StaticOrder {
    int nM, nN, nwg, G, c;
    __host__ __device__ void init(int M, int N, int G_, int c_) { nM = M / BM; nN = N / BM; nwg = nM * nN; G = G_; c = c_; }
    __host__ __device__ bool next(int i, Unit& u) const {
        const long L = (long)i * G + c; if (L >= nwg) return false;
        int wgid = (int)L; { const int q = nwg / NXCD, r = nwg % NXCD, xcd = wgid % NXCD, off = wgid / NXCD; wgid = (xcd < r ? xcd * (q + 1) : r * (q + 1) + (xcd - r) * q) + off; }
        const int nig = WGM * nN, gid = wgid / nig, fm = gid * WGM, gsz = (nM - fm) < WGM ? (nM - fm) : WGM;
        u.pm = fm + ((wgid % nig) % gsz); u.pn = (wgid % nig) / gsz; return true;
    }
    __device__ __forceinline__ void a_ready(const Unit&) const {}
    __device__ __forceinline__ void done(const Unit&) const {}
};

__device__ __forceinline__ unsigned cvt_pk_bf16(float lo, float hi) { unsigned r; asm volatile("v_cvt_pk_bf16_f32 %0, %1, %2" : "=v"(r) : "v"(lo), "v"(hi)); return r; }
typedef unsigned u32x2 __attribute__((ext_vector_type(2)));
__device__ __forceinline__ float sigm(float z) { return 1.0f / (1.0f + __expf(-z)); }
constexpr float RMS_EPS = 1e-6f;
#ifndef WT_STORES
#define WT_STORES 0
#endif
__device__ __forceinline__ void st16(void* p, u32x4 v) {
#if WT_STORES
    asm volatile("global_store_dwordx4 %0, %1, off sc1\n\ts_nop 1" :: "v"(p), "v"(v) : "memory");
#else
    *(u32x4*)p = v;
#endif
}
__device__ __forceinline__ void st16f(void* p, f32x4 v) { st16(p, __builtin_bit_cast(u32x4, v)); }
__device__ __forceinline__ void st8(void* p, u32x2 v) {
#if WT_STORES
    asm volatile("global_store_dwordx2 %0, %1, off sc1\n\ts_nop 1" :: "v"(p), "v"(v) : "memory");
#else
    *(u32x2*)p = v;
#endif
}
typedef _Float16 h2_t __attribute__((ext_vector_type(2)));
__device__ __forceinline__ unsigned pk_h2(float a, float b) { h2_t v; v.x = (_Float16)a; v.y = (_Float16)b; return __builtin_bit_cast(unsigned, v); }
__device__ __forceinline__ float h_lo(unsigned u) { return (float)__builtin_bit_cast(h2_t, u).x; }
__device__ __forceinline__ float h_hi(unsigned u) { return (float)__builtin_bit_cast(h2_t, u).y; }

struct EpiInProj {
    static constexpr bool PERM = true, AFTER_DRAIN = false;
    bf16_t *QQ, *KK, *VV, *GG; unsigned short *LF, *UU; const float* lbraw;
    __device__ __forceinline__ void operator()(const f32x4 (&acc)[2][2][4][2], const Unit& u, int wr, int wc, int fr, int fq) const {
        const int seg = u.pn >> 1, colt = (u.pn & 1) * 256;
        const int row0 = u.pm * BM + wr * 64 + fr;
#pragma unroll
        for (int bj = 0; bj < 2; ++bj) {
            const int cs = colt + bj * HALF + wc * 32 + 8 * fq;
            float lb[8];
            if (seg == 1) {
#pragma unroll
                for (int j = 0; j < 8; ++j) { const float l0 = lbraw[cs + j], l1 = lbraw[512 + cs + j]; lb[j] = 1.0f / (1.0f + __expf(l1 - l0)); }
            } else {
#pragma unroll
                for (int j = 0; j < 8; ++j) lb[j] = 0.f;
            }
#pragma unroll
            for (int ai = 0; ai < 2; ++ai)
#pragma unroll
                for (int m = 0; m < 4; ++m) {
                    const size_t off = (size_t)(row0 + ai * HALF + m * 16) * 512 + cs;
                    const f32x4 v0 = acc[ai][bj][m][0], v1 = acc[ai][bj][m][1];
                    float z[8] = {v0[0], v0[1], v0[2], v0[3], v1[0], v1[1], v1[2], v1[3]};
                    if (seg == 0) {
#pragma unroll
                        for (int j = 0; j < 8; ++j) z[j] = z[j] * sigm(z[j]);
                        u32x4 w; w.x = cvt_pk_bf16(z[0], z[1]); w.y = cvt_pk_bf16(z[2], z[3]); w.z = cvt_pk_bf16(z[4], z[5]); w.w = cvt_pk_bf16(z[6], z[7]);
                        st16(QQ + off, w);
                    } else if (seg == 1) {
                        float lf[8], kk[8];
#pragma unroll
                        for (int j = 0; j < 8; ++j) { const float e = __expf(-z[j]); const float sg = 1.0f / (1.0f + e); const float sgn = e / (1.0f + e);
                            lf[j] = __logf(lb[j] + (1.0f - lb[j]) * sg); kk[j] = (1.0f - lb[j]) * sgn; }
                        { u32x4 w; w.x = pk_h2(lf[0], lf[1]); w.y = pk_h2(lf[2], lf[3]); w.z = pk_h2(lf[4], lf[5]); w.w = pk_h2(lf[6], lf[7]); st16(LF + off, w); }
                        u32x4 w; w.x = cvt_pk_bf16(kk[0], kk[1]); w.y = cvt_pk_bf16(kk[2], kk[3]); w.z = cvt_pk_bf16(kk[4], kk[5]); w.w = cvt_pk_bf16(kk[6], kk[7]);
                        st16(KK + off, w);
                    } else if (seg == 2) {
                        u32x4 w; w.x = cvt_pk_bf16(z[0], z[1]); w.y = cvt_pk_bf16(z[2], z[3]); w.z = cvt_pk_bf16(z[4], z[5]); w.w = cvt_pk_bf16(z[6], z[7]);
                        st16(VV + off, w);
                    } else if (seg == 3) {
#pragma unroll
                        for (int j = 0; j < 8; ++j) z[j] = sigm(z[j]);
                        u32x4 w; w.x = cvt_pk_bf16(z[0], z[1]); w.y = cvt_pk_bf16(z[2], z[3]); w.z = cvt_pk_bf16(z[4], z[5]); w.w = cvt_pk_bf16(z[6], z[7]);
                        st16(GG + off, w);
                    } else {
                        u32x4 w; w.x = pk_h2(z[0], z[1]); w.y = pk_h2(z[2], z[3]); w.z = pk_h2(z[4], z[5]); w.w = pk_h2(z[6], z[7]); st16(UU + off, w);
                    }
                }
        }
    }
};

struct EpiMemKV {
    static constexpr bool PERM = true, AFTER_DRAIN = false;
    float *outK, *outV; bf16_t* KB;
    __device__ __forceinline__ void operator()(const f32x4 (&acc)[2][2][4][2], const Unit& u, int wr, int wc, int fr, int fq) const {
        const bool isk = u.pn < 4; float* o = isk ? outK : outV; const int colt = (u.pn & 3) * 256;
        const int row0 = u.pm * BM + wr * 64 + fr;
#pragma unroll
        for (int ai = 0; ai < 2; ++ai)
#pragma unroll
            for (int m = 0; m < 4; ++m)
#pragma unroll
                for (int bj = 0; bj < 2; ++bj) {
                    const size_t off = (size_t)(row0 + ai * HALF + m * 16) * 1024 + colt + bj * HALF + wc * 32 + 8 * fq;
                    const f32x4 v0 = acc[ai][bj][m][0], v1 = acc[ai][bj][m][1];
                    *(f32x4*)(o + off) = v0; *(f32x4*)(o + off + 4) = v1;
                    if (isk) { u32x4 w; w.x = cvt_pk_bf16(v0[0], v0[1]); w.y = cvt_pk_bf16(v0[2], v0[3]); w.z = cvt_pk_bf16(v1[0], v1[1]); w.w = cvt_pk_bf16(v1[2], v1[3]); *(u32x4*)(KB + off) = w; }
                }
    }
};

struct EpiBf16Scale {
    static constexpr bool PERM = true, AFTER_DRAIN = false;
    bf16_t* O; int ldc; const float* ss; float scale;
    __device__ __forceinline__ void operator()(const f32x4 (&acc)[2][2][4][2], const Unit& u, int wr, int wc, int fr, int fq) const {
        const int row0 = u.pm * BM + wr * 64 + fr;
        float ssv[2][4];
#pragma unroll
        for (int ai = 0; ai < 2; ++ai)
#pragma unroll
            for (int m = 0; m < 4; ++m) ssv[ai][m] = ss ? ss[row0 + ai * HALF + m * 16] : 0.f;
#pragma unroll
        for (int ai = 0; ai < 2; ++ai)
#pragma unroll
            for (int m = 0; m < 4; ++m) {
                const int row = row0 + ai * HALF + m * 16;
                const float sc = ss ? scale * __builtin_amdgcn_rsqf(ssv[ai][m] * (1.0f / 1024.0f) + RMS_EPS) : scale;
#pragma unroll
                for (int bj = 0; bj < 2; ++bj) {
                    const size_t off = (size_t)row * ldc + u.pn * BM + bj * HALF + wc * 32 + 8 * fq;
                    const f32x4 v0 = acc[ai][bj][m][0] * sc, v1 = acc[ai][bj][m][1] * sc;
                    u32x4 w; w.x = cvt_pk_bf16(v0[0], v0[1]); w.y = cvt_pk_bf16(v0[2], v0[3]); w.z = cvt_pk_bf16(v1[0], v1[1]); w.w = cvt_pk_bf16(v1[2], v1[3]);
                    st16(O + off, w);
                }
            }
    }
};

struct EpiResid {
    static constexpr bool PERM = true, AFTER_DRAIN = false;
    const float* baseF;
    const bf16_t* baseB;
    float* out;
    bf16_t* outb;
    float* ss;
    __device__ __forceinline__ void operator()(const f32x4 (&acc)[2][2][4][2], const Unit& u, int wr, int wc, int fr, int fq) const {
        const int row0 = u.pm * BM + wr * 64 + fr;
#pragma unroll
        for (int ai = 0; ai < 2; ++ai) {
            f32x4 pre[4][2][2];
            if (baseF) {
#pragma unroll
                for (int m = 0; m < 4; ++m) { const float* bp = baseF + (size_t)(row0 + ai * HALF + m * 16) * 1024;
#pragma unroll
                    for (int bj = 0; bj < 2; ++bj) { const int col = u.pn * BM + bj * HALF + wc * 32 + 8 * fq; pre[m][bj][0] = *(const f32x4*)(bp + col); pre[m][bj][1] = *(const f32x4*)(bp + col + 4); } }
            } else {
                u32x4 pb[4][2];
#pragma unroll
                for (int m = 0; m < 4; ++m) { const bf16_t* bp = baseB + (size_t)(row0 + ai * HALF + m * 16) * 1024;
#pragma unroll
                    for (int bj = 0; bj < 2; ++bj) pb[m][bj] = *(const u32x4*)(bp + u.pn * BM + bj * HALF + wc * 32 + 8 * fq); }
#pragma unroll
                for (int m = 0; m < 4; ++m)
#pragma unroll
                    for (int bj = 0; bj < 2; ++bj) { const u32x4 p = pb[m][bj];
                        pre[m][bj][0] = (f32x4){__uint_as_float(p.x << 16), __uint_as_float(p.x & 0xffff0000u), __uint_as_float(p.y << 16), __uint_as_float(p.y & 0xffff0000u)};
                        pre[m][bj][1] = (f32x4){__uint_as_float(p.z << 16), __uint_as_float(p.z & 0xffff0000u), __uint_as_float(p.w << 16), __uint_as_float(p.w & 0xffff0000u)}; }
            }
#pragma unroll
            for (int m = 0; m < 4; ++m) {
                const int row = row0 + ai * HALF + m * 16;
                float s = 0.f;
#pragma unroll
                for (int bj = 0; bj < 2; ++bj) {
                    const int col = u.pn * BM + bj * HALF + wc * 32 + 8 * fq;
                    const f32x4 v0 = acc[ai][bj][m][0] + pre[m][bj][0], v1 = acc[ai][bj][m][1] + pre[m][bj][1];
                    s += (v0[0] * v0[0] + v0[1] * v0[1]) + (v0[2] * v0[2] + v0[3] * v0[3]) + (v1[0] * v1[0] + v1[1] * v1[1]) + (v1[2] * v1[2] + v1[3] * v1[3]);
                    if (out) { *(f32x4*)(out + (size_t)row * 1024 + col) = v0; *(f32x4*)(out + (size_t)row * 1024 + col + 4) = v1; }
                    if (outb) { u32x4 w; w.x = cvt_pk_bf16(v0[0], v0[1]); w.y = cvt_pk_bf16(v0[2], v0[3]); w.z = cvt_pk_bf16(v1[0], v1[1]); w.w = cvt_pk_bf16(v1[2], v1[3]); st16(outb + (size_t)row * 1024 + col, w); }
                }
                s += __shfl_xor(s, 16); s += __shfl_xor(s, 32);
                if (fq == 0) atomicAdd(ss + row, s);
            }
        }
    }
};

struct EpiResidNorm {
    static constexpr bool PERM = true, AFTER_DRAIN = true;
    const bf16_t* baseB; float* out; float* ss; unsigned* cnt; const float* gfin;
    __device__ __forceinline__ void fused(f32x4 (&acc)[2][2][4][2], const Unit& u, int wr, int wc, int fr, int fq, PG8_LAS unsigned char* lds, int wid, int lane) const {
        const int row0 = u.pm * BM + wr * 64 + fr;
#pragma unroll
        for (int ai = 0; ai < 2; ++ai) {
            u32x4 pb[4][2];
#pragma unroll
            for (int m = 0; m < 4; ++m) { const bf16_t* bp = baseB + (size_t)(row0 + ai * HALF + m * 16) * 1024;
#pragma unroll
                for (int bj = 0; bj < 2; ++bj) pb[m][bj] = *(const u32x4*)(bp + u.pn * BM + bj * HALF + wc * 32 + 8 * fq); }
#pragma unroll
            for (int m = 0; m < 4; ++m) { float s = 0.f;
#pragma unroll
                for (int bj = 0; bj < 2; ++bj) { const u32x4 p = pb[m][bj];
                    const f32x4 v0 = acc[ai][bj][m][0] + (f32x4){__uint_as_float(p.x << 16), __uint_as_float(p.x & 0xffff0000u), __uint_as_float(p.y << 16), __uint_as_float(p.y & 0xffff0000u)};
                    const f32x4 v1 = acc[ai][bj][m][1] + (f32x4){__uint_as_float(p.z << 16), __uint_as_float(p.z & 0xffff0000u), __uint_as_float(p.w << 16), __uint_as_float(p.w & 0xffff0000u)};
                    acc[ai][bj][m][0] = v0; acc[ai][bj][m][1] = v1;
                    s += (v0[0] * v0[0] + v0[1] * v0[1]) + (v0[2] * v0[2] + v0[3] * v0[3]) + (v1[0] * v1[0] + v1[1] * v1[1]) + (v1[2] * v1[2] + v1[3] * v1[3]); }
                s += __shfl_xor(s, 16); s += __shfl_xor(s, 32);
                if (fq == 0) atomicAdd(ss + row0 + ai * HALF + m * 16, s); }
        }
        asm volatile("s_waitcnt vmcnt(0)" ::: "memory");
        __syncthreads();
        if (threadIdx.x == 0) { unsigned* c = cnt + 64 * u.pm;
            __hip_atomic_fetch_add(c, 1u, __ATOMIC_RELEASE, __HIP_MEMORY_SCOPE_AGENT);
            unsigned sp = 0u; while (__hip_atomic_load(c, __ATOMIC_RELAXED, __HIP_MEMORY_SCOPE_AGENT) < 4u) { __builtin_amdgcn_s_sleep(2); if (++sp > (1u << 22)) break; }
            __builtin_amdgcn_fence(__ATOMIC_ACQUIRE, "agent"); }
        __syncthreads();
        float rs[2][4];
#pragma unroll
        for (int ai = 0; ai < 2; ++ai)
#pragma unroll
            for (int m = 0; m < 4; ++m) rs[ai][m] = __hip_atomic_load(ss + row0 + ai * HALF + m * 16, __ATOMIC_RELAXED, __HIP_MEMORY_SCOPE_AGENT);
        f32x4 gv[2][2];
#pragma unroll
        for (int bj = 0; bj < 2; ++bj) { const int col = u.pn * BM + bj * HALF + wc * 32 + 8 * fq; gv[bj][0] = *(const f32x4*)(gfin + col); gv[bj][1] = *(const f32x4*)(gfin + col + 4); }
#pragma unroll
        for (int ai = 0; ai < 2; ++ai)
#pragma unroll
            for (int m = 0; m < 4; ++m) { const int row = row0 + ai * HALF + m * 16; const float rstd = 1.0f / sqrtf(rs[ai][m] * (1.0f / 1024.0f) + RMS_EPS);
#pragma unroll
                for (int bj = 0; bj < 2; ++bj) { const int col = u.pn * BM + bj * HALF + wc * 32 + 8 * fq;
                    *(f32x4*)(out + (size_t)row * 1024 + col) = acc[ai][bj][m][0] * rstd * gv[bj][0]; *(f32x4*)(out + (size_t)row * 1024 + col + 4) = acc[ai][bj][m][1] * rstd * gv[bj][1]; } }
    }
};

struct EpiSwiGLU {
    static constexpr bool PERM = true, AFTER_DRAIN = false;
    bf16_t* ACT; const float* ss;
    __device__ __forceinline__ void operator()(const f32x4 (&acc)[2][2][4][2], const Unit& u, int wr, int wc, int fr, int fq) const {
        const int row0 = u.pm * BM + wr * 64 + fr;
        float ssv[2][4];
#pragma unroll
        for (int ai = 0; ai < 2; ++ai)
#pragma unroll
            for (int m = 0; m < 4; ++m) ssv[ai][m] = ss[row0 + ai * HALF + m * 16];
#pragma unroll
        for (int ai = 0; ai < 2; ++ai)
#pragma unroll
            for (int m = 0; m < 4; ++m) {
                const int row = row0 + ai * HALF + m * 16;
                const float r = __builtin_amdgcn_rsqf(ssv[ai][m] * (1.0f / 1024.0f) + RMS_EPS);
#pragma unroll
                for (int bj = 0; bj < 2; ++bj) {
                    const int J = u.pn * 128 + bj * 64 + wc * 16 + 4 * fq;
                    const f32x4 a = acc[ai][bj][m][0] * r, b = acc[ai][bj][m][1] * r;
                    float o[4];
#pragma unroll
                    for (int j = 0; j < 4; ++j) o[j] = a[j] * sigm(a[j]) * b[j];
                    u32x2 w; w.x = cvt_pk_bf16(o[0], o[1]); w.y = cvt_pk_bf16(o[2], o[3]);
                    st8(ACT + (size_t)row * 2816 + J, w);
                }
            }
    }
};

template <class Epi, class Sched, bool ALIGN_EPI = false, bool SP2 = false>
__device__ __forceinline__ void gemm_phase(PG8_LAS unsigned char* lds, const Gemm g, const Sched& S, const Epi& E) {
    const int tid = threadIdx.x, wid = __builtin_amdgcn_readfirstlane(tid >> 6), lane = tid & 63, wr = wid >> 2, wc = wid & 3, fr = lane & 15, fq = lane >> 4;
    const int K = g.K, nt = K / BK;
    unsigned voffA[2], voffB[2];
#pragma unroll
    for (int i = 0; i < 2; ++i) { int R, C; stage_rc(tid * 16 + i * 8192, R, C); const int Rb = Epi::PERM ? ((R & ~31) + perm32(R & 31)) : R;
        voffA[i] = (unsigned)(R * K + C) * 2u; voffB[i] = (unsigned)(Rb * K + C) * 2u; }
    const size_t kstep = (size_t)(BK * 2);
    const size_t hstep = (size_t)HALF * K * 2;
    const size_t tstep = 2 * hstep;
    const unsigned ldsw = (unsigned)wid * 1024u;
    const int aoff = lds_byte(wr * 64 + fr, fq * 8), boff = lds_byte(wc * 32 + fr, fq * 8);
#define PG8_SA(b, h) (((b) * 2 + (h)) * HTB)
#define PG8_SB(b, h) ((4 + (b) * 2 + (h)) * HTB)
#define PG8_STAGE(bufoff, gbase, voff) do { _Pragma("unroll") for (int _i = 0; _i < 2; ++_i) \
        __builtin_amdgcn_global_load_lds((const unsigned*)((const char*)(gbase) + (voff)[_i]), (PG8_LAS unsigned*)(lds + (bufoff) + ldsw + _i * 8192), 16, 0, 0); } while (0)
#define PG8_LDA(dst, b, h) do { _Pragma("unroll") for (int m = 0; m < 4; ++m) _Pragma("unroll") for (int k = 0; k < 2; ++k) dst[m][k] = *(const PG8_LAS bf16x8*)(lds + PG8_SA(b, h) + aoff + m * 2048 + k * 1024); } while (0)
#define PG8_LDB(dst, b, h) do { _Pragma("unroll") for (int n = 0; n < 2; ++n) _Pragma("unroll") for (int k = 0; k < 2; ++k) dst[n][k] = *(const PG8_LAS bf16x8*)(lds + PG8_SB(b, h) + boff + n * 2048 + k * 1024); } while (0)
#define PG8_MMA(ai, bj, At, Bt) do { __builtin_amdgcn_s_setprio(1); _Pragma("unroll") for (int m = 0; m < 4; ++m) _Pragma("unroll") for (int n = 0; n < 2; ++n) _Pragma("unroll") for (int k = 0; k < 2; ++k) \
        acc[ai][bj][m][n] = __builtin_amdgcn_mfma_f32_16x16x32_bf16(Bt[n][k], At[m][k], acc[ai][bj][m][n], 0, 0, 0); __builtin_amdgcn_s_setprio(0); } while (0)
#define PG8_WAIT_V(n) asm volatile("s_waitcnt vmcnt(" #n ")" ::: "memory")
#define PG8_WAIT_L(n) asm volatile("s_waitcnt lgkmcnt(" #n ")" ::: "memory")
#define PG8_BAR __builtin_amdgcn_s_barrier()
#define PG8_SCHED __builtin_amdgcn_sched_barrier(0)
    Unit cur, nxt; int ui = 0;
    if (!S.next(0, cur)) return;
    f32x4 acc[2][2][4][2];
#pragma unroll
    for (int a = 0; a < 2; ++a)
#pragma unroll
        for (int b = 0; b < 2; ++b)
#pragma unroll
            for (int m = 0; m < 4; ++m)
#pragma unroll
                for (int n = 0; n < 2; ++n) acc[a][b][m][n] = (f32x4){0.f, 0.f, 0.f, 0.f};
    bf16x8 At[4][2], B0[2][2], B1[2][2];
    const char* cA = (const char*)g.A + (size_t)cur.pm * tstep; const char* cB = (const char*)g.Bt + (size_t)cur.pn * tstep;
    S.a_ready(cur);
    if constexpr (SP2) {
        PG8_STAGE(PG8_SB(0, 0), cB, voffB); PG8_STAGE(PG8_SB(0, 1), cB + hstep, voffB); PG8_STAGE(PG8_SA(0, 0), cA, voffA); PG8_STAGE(PG8_SA(0, 1), cA + hstep, voffA);
        if (wr == 1) PG8_BAR;
        PG8_WAIT_V(2); PG8_BAR;
        PG8_STAGE(PG8_SB(1, 0), cB + kstep, voffB); PG8_STAGE(PG8_SA(1, 0), cA + kstep, voffA); PG8_STAGE(PG8_SB(1, 1), cB + hstep + kstep, voffB);
        PG8_WAIT_V(6); PG8_BAR;
    } else {
        PG8_STAGE(PG8_SB(0, 0), cB, voffB); PG8_STAGE(PG8_SA(0, 0), cA, voffA); PG8_STAGE(PG8_SB(0, 1), cB + hstep, voffB); PG8_STAGE(PG8_SA(0, 1), cA + hstep, voffA);
        if (wr == 1) PG8_BAR;
        PG8_WAIT_V(4); PG8_BAR;
        PG8_STAGE(PG8_SB(1, 0), cB + kstep, voffB); PG8_STAGE(PG8_SA(1, 0), cA + kstep, voffA); PG8_STAGE(PG8_SB(1, 1), cB + hstep + kstep, voffB);
        PG8_WAIT_V(6); PG8_BAR;
    }
    for (;;) {
        const bool has_next = S.next(ui + 1, nxt);
        const char* nA = has_next ? (const char*)g.A + (size_t)nxt.pm * tstep : cA; const char* nB = has_next ? (const char*)g.Bt + (size_t)nxt.pn * tstep : cB;
        for (int t = 0; t < nt; t += 2) {
            const bool last = (t == nt - 2);
            const char* a1 = cA + (size_t)(t + 1) * kstep;
            const char* a2 = last ? nA : cA + (size_t)(t + 2) * kstep; const char* b2 = last ? nB : cB + (size_t)(t + 2) * kstep;
            const char* a3 = a2 + kstep; const char* b3 = b2 + kstep;
            if (last && has_next) S.a_ready(nxt);
            if constexpr (SP2) {
            PG8_LDB(B0, 0, 0); PG8_LDB(B1, 0, 1); PG8_SCHED; PG8_LDA(At, 0, 0); PG8_STAGE(PG8_SA(1, 1), a1 + hstep, voffA);
            PG8_WAIT_V(8); PG8_WAIT_L(0); PG8_BAR; PG8_MMA(0, 0, At, B0); PG8_MMA(0, 1, At, B1); PG8_BAR; PG8_SCHED;
            PG8_LDA(At, 0, 1); PG8_STAGE(PG8_SB(0, 0), b2, voffB); PG8_STAGE(PG8_SB(0, 1), b2 + hstep, voffB); PG8_STAGE(PG8_SA(0, 0), a2, voffA);
            PG8_WAIT_V(8); PG8_WAIT_L(0); PG8_BAR; PG8_MMA(1, 0, At, B0); PG8_MMA(1, 1, At, B1); PG8_BAR; PG8_SCHED;
            PG8_LDB(B0, 1, 0); PG8_LDB(B1, 1, 1); PG8_SCHED; PG8_LDA(At, 1, 0); PG8_STAGE(PG8_SA(0, 1), a2 + hstep, voffA);
            PG8_WAIT_V(8); PG8_WAIT_L(0); PG8_BAR; PG8_MMA(0, 0, At, B0); PG8_MMA(0, 1, At, B1); PG8_BAR; PG8_SCHED;
            PG8_LDA(At, 1, 1); PG8_STAGE(PG8_SB(1, 0), b3, voffB); PG8_STAGE(PG8_SB(1, 1), b3 + hstep, voffB); PG8_STAGE(PG8_SA(1, 0), a3, voffA);
            PG8_WAIT_V(8); PG8_WAIT_L(0); PG8_BAR; PG8_MMA(1, 0, At, B0); PG8_MMA(1, 1, At, B1); PG8_BAR; PG8_SCHED;
            } else {
            PG8_LDB(B0, 0, 0); PG8_SCHED; PG8_LDA(At, 0, 0); PG8_STAGE(PG8_SA(1, 1), a1 + hstep, voffA);
            PG8_WAIT_L(8); PG8_BAR; PG8_WAIT_L(0); PG8_MMA(0, 0, At, B0); PG8_BAR; PG8_SCHED;
            PG8_LDB(B1, 0, 1); PG8_STAGE(PG8_SB(0, 0), b2, voffB);
            PG8_BAR; PG8_WAIT_L(0); PG8_MMA(0, 1, At, B1); PG8_BAR;
            PG8_LDA(At, 0, 1); PG8_STAGE(PG8_SA(0, 0), a2, voffA);
            PG8_BAR; PG8_WAIT_L(0); PG8_MMA(1, 0, At, B0); PG8_BAR; PG8_SCHED;
            PG8_STAGE(PG8_SB(0, 1), b2 + hstep, voffB);
            PG8_WAIT_V(6); PG8_BAR; PG8_MMA(1, 1, At, B1); PG8_BAR;
            PG8_LDB(B0, 1, 0); PG8_SCHED; PG8_LDA(At, 1, 0); PG8_STAGE(PG8_SA(0, 1), a2 + hstep, voffA);
            PG8_WAIT_L(8); PG8_BAR; PG8_WAIT_L(0); PG8_MMA(0, 0, At, B0); PG8_BAR; PG8_SCHED;
            PG8_LDB(B1, 1, 1); PG8_STAGE(PG8_SB(1, 0), b3, voffB);
            PG8_BAR; PG8_WAIT_L(0); PG8_MMA(0, 1, At, B1); PG8_BAR;
            PG8_LDA(At, 1, 1); PG8_STAGE(PG8_SA(1, 0), a3, voffA);
            PG8_BAR; PG8_WAIT_L(0); PG8_MMA(1, 0, At, B0); PG8_BAR; PG8_SCHED;
            PG8_STAGE(PG8_SB(1, 1), b3 + hstep, voffB);
            PG8_WAIT_V(6); PG8_BAR; PG8_MMA(1, 1, At, B1); PG8_BAR;
            }
        }
        if constexpr (ALIGN_EPI) { if (wr == 0) PG8_BAR; }
        if constexpr (!Epi::AFTER_DRAIN) { E(acc, cur, wr, wc, fr, fq); S.done(cur); }
        if (!has_next) break;
#pragma unroll
        for (int a = 0; a < 2; ++a)
#pragma unroll
            for (int b = 0; b < 2; ++b)
#pragma unroll
                for (int m = 0; m < 4; ++m)
#pragma unroll
                    for (int n = 0; n < 2; ++n) acc[a][b][m][n] = (f32x4){0.f, 0.f, 0.f, 0.f};
        cur = nxt; cA = nA; cB = nB; ++ui;
        if constexpr (ALIGN_EPI) { if (wr == 1) PG8_BAR; }
    }
    PG8_WAIT_V(0);
    if constexpr (!ALIGN_EPI) { if (wr == 0) PG8_BAR; }
    PG8_BAR;
    if constexpr (Epi::AFTER_DRAIN) { E.fused(acc, cur, wr, wc, fr, fq, lds, wid, lane); S.done(cur); }
#undef PG8_SA
#undef PG8_SB
#undef PG8_STAGE
#undef PG8_LDA
#undef PG8_LDB
#undef PG8_MMA
#undef PG8_WAIT_V
#undef PG8_WAIT_L
#undef PG8_BAR
#undef PG8_SCHED
}
}
#define LAS __attribute__((address_space(3)))
#define XB_TMO      128
#define XB_XCNT(j)  (256  + 64 * (j))
#define XB_XSUB(j)  (1280 + 64 * (j))
#define XB_XGEN(j)  (2304 + 64 * (j))
#define XB_TOP      3328
#define XB_TOPGEN   3392
#define XCD_BAR_WORDS 3456
#define XB_SPIN_CAP (1u << 18)

__device__ __forceinline__ unsigned xb_ld(unsigned* p)              { return __hip_atomic_load(p, __ATOMIC_RELAXED, __HIP_MEMORY_SCOPE_AGENT); }
__device__ __forceinline__ unsigned xb_add(unsigned* p, unsigned v) { return __hip_atomic_fetch_add(p, v, __ATOMIC_RELAXED, __HIP_MEMORY_SCOPE_AGENT); }
__device__ __forceinline__ unsigned xb_xcc_id() { return (unsigned)__builtin_amdgcn_s_getreg((3 << 11) | 20) & 0xFu; }
#define XB_SPIN(cond, bar) do { unsigned _sp = 0; while (cond) { __builtin_amdgcn_s_sleep(1); \
    if ((++_sp & 255u) == 0u) { if (xb_ld(&(bar)[XB_TMO])) break; if (_sp > XB_SPIN_CAP) { atomicAdd(&(bar)[XB_TMO], 1u); break; } } } } while (0)

struct XcdBarrier {
    unsigned* bar; unsigned x;
    volatile LAS unsigned* st;
};

__device__ __forceinline__ XcdBarrier xcd_barrier_post(unsigned* bar, volatile LAS unsigned* st) {
    XcdBarrier b; b.bar = bar; b.x = xb_xcc_id(); b.st = st;
    if (threadIdx.x == 0) (void)xb_add(&bar[XB_XCNT(b.x)], 1u);
    return b;
}
__device__ __forceinline__ void xcd_barrier_complete(unsigned* bar, unsigned x, unsigned& nloc, unsigned& nx) {
    const unsigned G = gridDim.x * gridDim.y * gridDim.z;
    unsigned sum, cnt, mine, sp = 0u;
    for (;;) {
        sum = 0u; cnt = 0u; mine = 0u;
#pragma unroll
        for (unsigned j = 0; j < 16; ++j) { const unsigned c = xb_ld(&bar[XB_XCNT(j)]); sum += c; cnt += (c > 0u) ? 1u : 0u; mine = (j == x) ? c : mine; }
        if (sum == G) break;
        __builtin_amdgcn_s_sleep(1);
        if ((++sp & 255u) == 0u) { if (xb_ld(&bar[XB_TMO])) break; if (sp > XB_SPIN_CAP) { atomicAdd(&bar[XB_TMO], 1u); break; } }
    }
    nloc = mine > 0u ? mine : 1u; nx = cnt > 0u ? cnt : 1u;
}

__device__ __forceinline__ void xcd_barrier(const XcdBarrier& b) {
    asm volatile("s_waitcnt vmcnt(0)" ::: "memory");
    __syncthreads();
    if (threadIdx.x == 0) {
        unsigned* bar = b.bar;
        __builtin_amdgcn_s_waitcnt(0);
        unsigned nloc = b.st[0], nx = b.st[1];
        if (nloc == 0u) { xcd_barrier_complete(bar, b.x, nloc, nx); b.st[0] = nloc; b.st[1] = nx; }
        const unsigned old = xb_add(&bar[XB_XSUB(b.x)], 1u);
        const unsigned gen = old / nloc;
        if (old + 1u == (gen + 1u) * nloc) {
            __builtin_amdgcn_fence(__ATOMIC_RELEASE, "agent");
            asm volatile("s_waitcnt vmcnt(0)" ::: "memory");
            const unsigned og = xb_add(&bar[XB_TOP], 1u);
            const unsigned tg = og / nx;
            if (og + 1u == (tg + 1u) * nx) xb_add(&bar[XB_TOPGEN], 1u);
            else XB_SPIN(xb_ld(&bar[XB_TOPGEN]) == tg, bar);
            __builtin_amdgcn_fence(__ATOMIC_ACQUIRE, "agent");
            xb_add(&bar[XB_XGEN(b.x)], 1u);
            asm volatile("s_waitcnt vmcnt(0)" ::: "memory");
        } else {
            XB_SPIN(xb_ld(&bar[XB_XGEN(b.x)]) == gen, bar);
            __builtin_amdgcn_fence(__ATOMIC_ACQUIRE, "agent");
            asm volatile("s_waitcnt vmcnt(0)" ::: "memory");
        }
    }
    __syncthreads();
}

using pg8::bf16_t; using pg8::f32x4; using pg8::u32x4; using pg8::bf16x8; using pg8::pk_h2; using pg8::h_lo; using pg8::h_hi;
typedef unsigned u32x2v __attribute__((ext_vector_type(2)));
constexpr int DM = 1024, NPR = 16384, NSM = 128, MT = 16640, NVALID = 16512, SEQ = 2048;
constexpr int HW = 512, NIN = 2560, DFF = 2816, NFF2 = 5632, MEMR = 2048;
constexpr float EPS = 1e-6f;
constexpr int NTHREADS = 512;
constexpr int LDS_BYTES = 147456;

constexpr size_t O_YP = 0, O_YS = 16777216, O_HP = 16908288, O_PP = 17432576, O_MK = 17494016, O_MV = 19591168, O_HS = 21688320, O_PS = 30076928;

constexpr size_t MiB = 1u << 20;
constexpr size_t WS_SS1 = 0, WS_SS2 = 128 * 1024, WS_SS3 = 256 * 1024, WS_BAR = 512 * 1024, BAR_BYTES = 65536, WS_SSD = 384 * 1024, WS_CNT = WS_BAR + 16384;
constexpr size_t WS_WIN = 1 * MiB, WS_WOUT = 6 * MiB, WS_WCQ = 8 * MiB, WS_WCO = 10 * MiB, WS_WFFI = 12 * MiB, WS_WFFO = 23 * MiB, WS_WKV = 29 * MiB, WS_PMIX = 33 * MiB;
constexpr size_t WS_MEMH = 34 * MiB, WS_KB = 38 * MiB, WS_VT = 42 * MiB, WS_DEC = 46 * MiB;
constexpr size_t WS_H0 = 47 * MiB;
constexpr size_t WS_MIX = 80 * MiB;
constexpr size_t WS_X1 = 113 * MiB;
constexpr size_t WS_Q = 178 * MiB;
constexpr size_t WS_O = 211 * MiB;
constexpr size_t WS_SL = 244 * MiB;
constexpr size_t WS_A = 309 * MiB;
constexpr size_t WS_QQ = WS_A, WS_KK = WS_A + 17 * MiB, WS_VV = WS_A + 34 * MiB, WS_GG = WS_A + 51 * MiB, WS_LF = WS_A + 68 * MiB, WS_UU = WS_A + 101 * MiB;
constexpr size_t WS_END = 443 * MiB;

struct Args { const float* in[23]; float* out; unsigned char* ws; int ph_lo, ph_hi; };

__device__ __forceinline__ unsigned f2bf(float f) { unsigned u = __builtin_bit_cast(unsigned, f); return (u + 0x7fffu + ((u >> 16) & 1u)) >> 16; }
__device__ __forceinline__ unsigned pk2(float lo, float hi) { return f2bf(lo) | (f2bf(hi) << 16); }
__device__ __forceinline__ float bf2f(unsigned h) { return __uint_as_float(h << 16); }
__device__ __forceinline__ float bfe(const u32x4& v, int j) { const unsigned w = v[j >> 1]; return (j & 1) ? __uint_as_float(w & 0xffff0000u) : __uint_as_float(w << 16); }
__device__ __forceinline__ unsigned short bfr(const u32x4& v, int j) { const unsigned w = v[j >> 1]; return (unsigned short)((j & 1) ? (w >> 16) : (w & 0xffffu)); }
__device__ __forceinline__ float wave_sum(float v) {
#pragma unroll
    for (int o = 1; o < 64; o <<= 1) v += __shfl_xor(v, o);
    return v;
}
#define MFMA16(a, b, c) __builtin_amdgcn_mfma_f32_16x16x32_bf16((a), (b), (c), 0, 0, 0)

template <int MODE>
__device__ __forceinline__ void tr_item(const float* W, int K, int N, bf16_t* WT, const float* gk, float* scr, int item, int lane) {
    const int nblk = N / 32, kb = item / nblk, nb = item % nblk, k0 = 64 * kb, n0 = 32 * nb;
    f32x4 wv[8];
#pragma unroll
    for (int i = 0; i < 8; ++i) { const int kk = 8 * i + (lane >> 3); wv[i] = *(const f32x4*)(W + (size_t)(k0 + kk) * N + n0 + (lane & 7) * 4); }
#pragma unroll
    for (int i = 0; i < 8; ++i) { const int kk = 8 * i + (lane >> 3); float* d = scr + kk * 33 + (lane & 7) * 4; d[0] = wv[i][0]; d[1] = wv[i][1]; d[2] = wv[i][2]; d[3] = wv[i][3]; }
    asm volatile("s_waitcnt lgkmcnt(0)" ::: "memory");
    const int c = lane & 7;
    float g8[8];
#pragma unroll
    for (int i = 0; i < 8; ++i) g8[i] = gk ? gk[k0 + 8 * c + i] : 1.0f;
#pragma unroll
    for (int j = 0; j < 4; ++j) { const int n = (lane >> 3) + 8 * j; const float* s = scr + (8 * c) * 33 + n;
        u32x4 o; o.x = pk2(s[0 * 33] * g8[0], s[1 * 33] * g8[1]); o.y = pk2(s[2 * 33] * g8[2], s[3 * 33] * g8[3]); o.z = pk2(s[4 * 33] * g8[4], s[5 * 33] * g8[5]); o.w = pk2(s[6 * 33] * g8[6], s[7 * 33] * g8[7]);
        int row = n0 + n;
        if (MODE == 1) { const int half = row >= DFF ? 1 : 0; const int J = row - half * DFF;
            row = 256 * (J >> 7) + 128 * ((J >> 6) & 1) + 32 * ((J >> 4) & 3) + 8 * ((J >> 2) & 3) + 4 * half + (J & 3); }
        *(u32x4*)(WT + (size_t)row * K + k0 + 8 * c) = o; }
    asm volatile("s_waitcnt lgkmcnt(0)" ::: "memory");
}
__device__ __forceinline__ void rms_row_to_bf16(const float* xrow, const float* g, bf16_t* orow, int lane) {
    const f32x4* xr = (const f32x4*)xrow + lane; const f32x4* gr = (const f32x4*)g + lane;
    f32x4 v[4]; float s = 0.f;
#pragma unroll
    for (int j = 0; j < 4; ++j) { v[j] = xr[64 * j]; s += (v[j].x * v[j].x + v[j].y * v[j].y) + (v[j].z * v[j].z + v[j].w * v[j].w); }
    const float rstd = 1.0f / sqrtf(wave_sum(s) * (1.f / DM) + EPS);
    unsigned long long* o8 = (unsigned long long*)orow + lane;
#pragma unroll
    for (int j = 0; j < 4; ++j) { const f32x4 gg = gr[64 * j];
        o8[64 * j] = (unsigned long long)pk2(v[j].x * rstd * gg.x, v[j].y * rstd * gg.y) | ((unsigned long long)pk2(v[j].z * rstd * gg.z, v[j].w * rstd * gg.w) << 32); }
}
__device__ __forceinline__ void rms_row2_to_bf16(const float* xrow, const float* g, bf16_t* orow, int lane) {
    const f32x4* xr = (const f32x4*)xrow + lane; const f32x4* gr = (const f32x4*)g + lane;
    f32x4 v[2][4]; float s[2] = {0.f, 0.f};
#pragma unroll
    for (int r = 0; r < 2; ++r)
#pragma unroll
        for (int j = 0; j < 4; ++j) v[r][j] = xr[r * 256 + 64 * j];
#pragma unroll
    for (int r = 0; r < 2; ++r)
#pragma unroll
        for (int j = 0; j < 4; ++j) s[r] += (v[r][j].x * v[r][j].x + v[r][j].y * v[r][j].y) + (v[r][j].z * v[r][j].z + v[r][j].w * v[r][j].w);
#pragma unroll
    for (int r = 0; r < 2; ++r) { const float rstd = 1.0f / sqrtf(wave_sum(s[r]) * (1.f / DM) + EPS); unsigned long long* o8 = (unsigned long long*)(orow + (size_t)r * DM) + lane;
#pragma unroll
        for (int j = 0; j < 4; ++j) { const f32x4 gg = gr[64 * j];
            o8[64 * j] = (unsigned long long)pk2(v[r][j].x * rstd * gg.x, v[r][j].y * rstd * gg.y) | ((unsigned long long)pk2(v[r][j].z * rstd * gg.z, v[r][j].w * rstd * gg.w) << 32); } }
}
__device__ __forceinline__ void p0_prologue(const Args& A, unsigned char* lds, int G) {
    const int tid = threadIdx.x, lane = tid & 63, wave = tid >> 6;
    float* scr = (float*)(lds + wave * 16384);
    unsigned char* ws = A.ws;
    const int gw = blockIdx.x * 8 + wave, NGW = G * 8;
    constexpr int I_IN = 16 * 80, I_OUT = 16 * 32, I_CQ = 16 * 32, I_CO = 16 * 32, I_FFI = 16 * 176, I_FFO = 44 * 32, I_KV = 16 * 64, I_PM = 4 * 8;
    constexpr int NITEMS = I_IN + I_OUT + I_CQ + I_CO + I_FFI + I_FFO + I_KV + I_PM;
    for (int it = gw; it < NITEMS; it += NGW) {
        int r = it;
        if (r < I_IN) { tr_item<0>(A.in[8], DM, NIN, (bf16_t*)(ws + WS_WIN), nullptr, scr, r, lane); continue; } r -= I_IN;
        if (r < I_OUT) { tr_item<0>(A.in[13], DM, DM, (bf16_t*)(ws + WS_WOUT), nullptr, scr, r, lane); continue; } r -= I_OUT;
        if (r < I_CQ) { tr_item<0>(A.in[17], DM, DM, (bf16_t*)(ws + WS_WCQ), A.in[16], scr, r, lane); continue; } r -= I_CQ;
        if (r < I_CO) { tr_item<0>(A.in[18], DM, DM, (bf16_t*)(ws + WS_WCO), nullptr, scr, r, lane); continue; } r -= I_CO;
        if (r < I_FFI) { tr_item<1>(A.in[20], DM, NFF2, (bf16_t*)(ws + WS_WFFI), A.in[19], scr, r, lane); continue; } r -= I_FFI;
        if (r < I_FFO) { tr_item<0>(A.in[21], DFF, DM, (bf16_t*)(ws + WS_WFFO), nullptr, scr, r, lane); continue; } r -= I_FFO;
        if (r < I_KV) { tr_item<0>(A.in[15], DM, 2 * DM, (bf16_t*)(ws + WS_WKV), nullptr, scr, r, lane); continue; } r -= I_KV;
        { const int g = r >> 3; tr_item<0>(A.in[11] + (size_t)g * 128 * 128, 128, 128, (bf16_t*)(ws + WS_PMIX) + (size_t)g * 128 * 128, nullptr, scr, r & 7, lane); }
    }
    bf16_t* H0 = (bf16_t*)(ws + WS_H0);
    for (int m = gw * 2; m < NVALID; m += NGW * 2) { const float* xr = m < NPR ? A.in[0] + (size_t)m * DM : A.in[1] + (size_t)(m - NPR) * DM; rms_row2_to_bf16(xr, A.in[7], H0 + (size_t)m * DM, lane); }
    bf16_t* MEMH = (bf16_t*)(ws + WS_MEMH);
    for (int m = gw; m < MEMR; m += NGW) rms_row_to_bf16(A.in[2] + (size_t)m * DM, A.in[14], MEMH + (size_t)m * DM, lane);
    const int gt = blockIdx.x * NTHREADS + tid, NGT = G * NTHREADS;
    for (int i = gt; i < (MT - NVALID) * DM / 8; i += NGT) { const u32x4 z = {0u, 0u, 0u, 0u};
        ((u32x4*)(ws + WS_H0) + (size_t)NVALID * DM / 8)[i] = z; ((u32x4*)(ws + WS_MIX) + (size_t)NVALID * DM / 8)[i] = z; ((u32x4*)(ws + WS_O) + (size_t)NVALID * DM / 8)[i] = z; }
    for (int i = gt; i < MT; i += NGT) { ((float*)(ws + WS_SS1))[i] = 0.f; ((float*)(ws + WS_SS2))[i] = 0.f; ((float*)(ws + WS_SS3))[i] = 0.f; }
}

constexpr int BS = 129;
constexpr int L_BC = 0, L_TOT = 33024, L_QM = 35072, L_KM = 52480, L_VT = 69888, L_SP = 88320, L_AL = 123136, L_PART = 132352, L_EM = 132864;
constexpr size_t WS_SPT = WS_X1;
__device__ __forceinline__ void hgrn_lf_load(u32x2v (&lf)[4], const unsigned short* LF, int R0, int C0, int t) {
#pragma unroll
    for (int i = 0; i < 4; ++i) { const int idx = i * 512 + t, s = idx >> 5, k4 = idx & 31; lf[i] = *(const u32x2v*)(LF + (size_t)(R0 + s) * HW + C0 + k4 * 4); }
}
__device__ __forceinline__ void hgrn_cumsum(const u32x2v (&lf)[4], float* Bc, float* tot, int t) {
#pragma unroll
    for (int i = 0; i < 4; ++i) { const int idx = i * 512 + t, s = idx >> 5, k4 = idx & 31; const u32x2v v = lf[i];
        float* d = Bc + s * BS + k4 * 4; d[0] = h_lo(v.x); d[1] = h_hi(v.x); d[2] = h_lo(v.y); d[3] = h_hi(v.y); }
    __syncthreads();
    const int seg = t >> 7, k = t & 127; float run = 0.f;
#pragma unroll
    for (int i = 0; i < 16; ++i) { run += Bc[(seg * 16 + i) * BS + k]; Bc[(seg * 16 + i) * BS + k] = run; }
    tot[seg * 128 + k] = run;
    __syncthreads();
    float off = 0.f;
#pragma unroll
    for (int j = 0; j < 3; ++j) off += (j < seg) ? tot[j * 128 + k] : 0.f;
#pragma unroll
    for (int i = 0; i < 16; ++i) Bc[(seg * 16 + i) * BS + k] += off;
    __syncthreads();
}
__device__ __forceinline__ void hgrn_local_load(const Args& A, int unit, u32x2v (&lf)[4], u32x4 (&kkr)[2], u32x4 (&vvr)[2]) {
    const int t = threadIdx.x, w = t >> 6, l = t & 63;
    const int bh = unit >> 5, c = unit & 31, b = bh >> 2, h = bh & 3, R0 = b * SEQ + c * 64, C0 = h * 128;
    const bf16_t* KK = (const bf16_t*)(A.ws + WS_KK); const bf16_t* VV = (const bf16_t*)(A.ws + WS_VV);
    hgrn_lf_load(lf, (const unsigned short*)(A.ws + WS_LF), R0, C0, t);
#pragma unroll
    for (int i = 0; i < 2; ++i) { const int k0 = (w + 8 * i) * 8; kkr[i] = *(const u32x4*)(KK + (size_t)(R0 + l) * HW + C0 + k0); vvr[i] = *(const u32x4*)(VV + (size_t)(R0 + l) * HW + C0 + k0); }
}
__device__ __forceinline__ void hgrn_local_unit(const Args& A, unsigned char* lds, int unit, int next, u32x2v (&lf)[4], u32x4 (&kkr)[2], u32x4 (&vvr)[2]) {
    const int t = threadIdx.x, w = t >> 6, l = t & 63, lr = l & 15, lq = l >> 4;
    const int bh = unit >> 5, c = unit & 31, b = bh >> 2, h = bh & 3, R0 = b * SEQ + c * 64, C0 = h * 128;
    unsigned char* ws = A.ws;
    float* Bc = (float*)(lds + L_BC); float* tot = (float*)(lds + L_TOT);
    bf16_t* kdT = (bf16_t*)(lds + L_QM); bf16_t* vT = (bf16_t*)(lds + L_VT);
    hgrn_cumsum(lf, Bc, tot, t);
#pragma unroll
    for (int i = 0; i < 2; ++i) { const int s = l, k0 = (w + 8 * i) * 8;
        const u32x4 kk = kkr[i], vv = vvr[i];
#pragma unroll
        for (int j = 0; j < 8; ++j) { const float e = __expf(Bc[63 * BS + k0 + j] - Bc[s * BS + k0 + j]);
            kdT[(k0 + j) * 72 + s] = (bf16_t)f2bf(bfe(kk, j) * e); vT[(k0 + j) * 72 + s] = bfr(vv, j); } }
    if (next >= 0) hgrn_local_load(A, next, lf, kkr, vvr);
    __syncthreads();
    f32x4 acc[8];
#pragma unroll
    for (int i = 0; i < 8; ++i) acc[i] = (f32x4){0.f, 0.f, 0.f, 0.f};
#pragma unroll
    for (int ks = 0; ks < 2; ++ks) { const bf16x8 a = *(const bf16x8*)(kdT + (16 * w + lr) * 72 + ks * 32 + lq * 8);
#pragma unroll
        for (int vt = 0; vt < 8; ++vt) { const bf16x8 bb = *(const bf16x8*)(vT + (16 * vt + lr) * 72 + ks * 32 + lq * 8); acc[vt] = MFMA16(a, bb, acc[vt]); } }
    unsigned short* SLT = (unsigned short*)(ws + WS_SL) + (size_t)unit * 16384;
#pragma unroll
    for (int vt = 0; vt < 8; ++vt) { u32x2v o; o.x = pk_h2(acc[vt][0], acc[vt][1]); o.y = pk_h2(acc[vt][2], acc[vt][3]); *(u32x2v*)(SLT + (16 * vt + lr) * 128 + 16 * w + lq * 4) = o; }
    if (t < 128) ((float*)(ws + WS_DEC))[unit * 128 + t] = __expf(Bc[63 * BS + t]);
    __syncthreads();
}
__device__ __forceinline__ void hgrn_out_load(const Args& A, int unit, u32x2v (&lf)[4], u32x4 (&qqr)[2], u32x4 (&kkr)[2], u32x4 (&vvr)[2], u32x4 (&spr)[4]) {
    const int t = threadIdx.x, w = t >> 6, l = t & 63;
    const int bh = unit >> 5, c = unit & 31, b = bh >> 2, h = bh & 3, R0 = b * SEQ + c * 64, C0 = h * 128;
    const bf16_t* QQ = (const bf16_t*)(A.ws + WS_QQ); const bf16_t* KK = (const bf16_t*)(A.ws + WS_KK); const bf16_t* VV = (const bf16_t*)(A.ws + WS_VV);
    hgrn_lf_load(lf, (const unsigned short*)(A.ws + WS_LF), R0, C0, t);
#pragma unroll
    for (int i = 0; i < 2; ++i) { const int idx = (i * 512 + t) * 8, s = idx >> 7, k0 = idx & 127; const size_t go = (size_t)(R0 + s) * HW + C0 + k0; qqr[i] = *(const u32x4*)(QQ + go); kkr[i] = *(const u32x4*)(KK + go);
        vvr[i] = *(const u32x4*)(VV + (size_t)(R0 + l) * HW + C0 + (w + 8 * i) * 8); }
    const bf16_t* SPT = (const bf16_t*)(A.ws + WS_SPT) + (size_t)unit * 16384;
#pragma unroll
    for (int i = 0; i < 4; ++i) { const int idx = i * 512 + t; spr[i] = *(const u32x4*)(SPT + (idx >> 4) * 128 + (idx & 15) * 8); }
}
__device__ __forceinline__ void hgrn_out_unit(const Args& A, unsigned char* lds, int unit, int next, u32x2v (&lf)[4], u32x4 (&qqr)[2], u32x4 (&kkr)[2], u32x4 (&vvr)[2], u32x4 (&spr)[4]) {
    const int t = threadIdx.x, w = t >> 6, l = t & 63, lr = l & 15, lq = l >> 4;
    const int bh = unit >> 5, c = unit & 31, b = bh >> 2, h = bh & 3, R0 = b * SEQ + c * 64, C0 = h * 128;
    unsigned char* ws = A.ws;
    float* Bc = (float*)(lds + L_BC); float* tot = (float*)(lds + L_TOT); float* part = (float*)(lds + L_PART); float* em = (float*)(lds + L_EM);
    bf16_t* qm = (bf16_t*)(lds + L_QM); bf16_t* km = (bf16_t*)(lds + L_KM); bf16_t* vT = (bf16_t*)(lds + L_VT); bf16_t* spT = (bf16_t*)(lds + L_SP); bf16_t* aL = (bf16_t*)(lds + L_AL);
    u32x4 ggr[2];
#pragma unroll
    for (int hh = 0; hh < 2; ++hh) ggr[hh] = *(const u32x4*)((const bf16_t*)(ws + WS_GG) + (size_t)(R0 + (t >> 3)) * HW + C0 + (t & 7) * 16 + hh * 8);
    hgrn_cumsum(lf, Bc, tot, t);
    if (t < 128) em[t] = __expf(Bc[31 * BS + t]);
#pragma unroll
    for (int i = 0; i < 2; ++i) { const int idx = (i * 512 + t) * 8, s = idx >> 7, k0 = idx & 127;
        const u32x4 qq = qqr[i], kk = kkr[i];
        float qv[8], kv[8];
#pragma unroll
        for (int j = 0; j < 8; ++j) { const float d = Bc[s * BS + k0 + j] - Bc[31 * BS + k0 + j]; qv[j] = bfe(qq, j) * __expf(d); kv[j] = bfe(kk, j) * __expf(-d); }
        u32x4 o; o.x = pk2(qv[0], qv[1]); o.y = pk2(qv[2], qv[3]); o.z = pk2(qv[4], qv[5]); o.w = pk2(qv[6], qv[7]); *(u32x4*)(qm + s * 136 + k0) = o;
        o.x = pk2(kv[0], kv[1]); o.y = pk2(kv[2], kv[3]); o.z = pk2(kv[4], kv[5]); o.w = pk2(kv[6], kv[7]); *(u32x4*)(km + s * 136 + k0) = o; }
#pragma unroll
    for (int i = 0; i < 2; ++i) { const int s = l, k0 = (w + 8 * i) * 8; const u32x4 vv = vvr[i];
#pragma unroll
        for (int j = 0; j < 8; ++j) vT[(k0 + j) * 72 + s] = bfr(vv, j); }
    __syncthreads();
    {
#pragma unroll
        for (int i = 0; i < 4; ++i) { const int idx = i * 512 + t, v = idx >> 4, k0 = (idx & 15) * 8; const u32x4 sv = spr[i];
            u32x4 o; o.x = pk2(bfe(sv, 0) * em[k0], bfe(sv, 1) * em[k0 + 1]); o.y = pk2(bfe(sv, 2) * em[k0 + 2], bfe(sv, 3) * em[k0 + 3]); o.z = pk2(bfe(sv, 4) * em[k0 + 4], bfe(sv, 5) * em[k0 + 5]); o.w = pk2(bfe(sv, 6) * em[k0 + 6], bfe(sv, 7) * em[k0 + 7]);
            *(u32x4*)(spT + v * 136 + k0) = o; } }
    if (next >= 0) hgrn_out_load(A, next, lf, qqr, kkr, vvr, spr);
    {
        const int ct = w & 3;
        f32x4 a2[2]; a2[0] = (f32x4){0.f, 0.f, 0.f, 0.f}; a2[1] = a2[0];
#pragma unroll
        for (int ks = 0; ks < 4; ++ks) { const bf16x8 a = *(const bf16x8*)(qm + (16 * ct + lr) * 136 + ks * 32 + lq * 8);
#pragma unroll
            for (int i = 0; i < 2; ++i) { const int st = (w >> 2) * 2 + i; const bf16x8 bb = *(const bf16x8*)(km + (16 * st + lr) * 136 + ks * 32 + lq * 8); a2[i] = MFMA16(a, bb, a2[i]); } }
#pragma unroll
        for (int i = 0; i < 2; ++i) { const int st = (w >> 2) * 2 + i, s = 16 * st + lr;
#pragma unroll
            for (int r = 0; r < 4; ++r) { const int cc = 16 * ct + lq * 4 + r; aL[cc * 72 + s] = (bf16_t)f2bf(s <= cc ? a2[i][r] : 0.f); } }
    }
    __syncthreads();
    const int ct = w & 3, vh = w >> 2;
    f32x4 o4[4];
#pragma unroll
    for (int i = 0; i < 4; ++i) o4[i] = (f32x4){0.f, 0.f, 0.f, 0.f};
#pragma unroll
    for (int ks = 0; ks < 4; ++ks) { const bf16x8 a = *(const bf16x8*)(qm + (16 * ct + lr) * 136 + ks * 32 + lq * 8);
#pragma unroll
        for (int i = 0; i < 4; ++i) { const int vt = vh * 4 + i; const bf16x8 bb = *(const bf16x8*)(spT + (16 * vt + lr) * 136 + ks * 32 + lq * 8); o4[i] = MFMA16(a, bb, o4[i]); } }
#pragma unroll
    for (int ks = 0; ks < 2; ++ks) { const bf16x8 a = *(const bf16x8*)(aL + (16 * ct + lr) * 72 + ks * 32 + lq * 8);
#pragma unroll
        for (int i = 0; i < 4; ++i) { const int vt = vh * 4 + i; const bf16x8 bb = *(const bf16x8*)(vT + (16 * vt + lr) * 72 + ks * 32 + lq * 8); o4[i] = MFMA16(a, bb, o4[i]); } }
    float* ost = (float*)(lds + L_BC);
#pragma unroll
    for (int r = 0; r < 4; ++r) { float s = 0.f;
#pragma unroll
        for (int i = 0; i < 4; ++i) { s += o4[i][r] * o4[i][r]; ost[(16 * ct + lq * 4 + r) * 132 + (vh * 4 + i) * 16 + lr] = o4[i][r]; }
        s += __shfl_xor(s, 1); s += __shfl_xor(s, 2); s += __shfl_xor(s, 4); s += __shfl_xor(s, 8);
        if (lr == 0) part[vh * 64 + 16 * ct + lq * 4 + r] = s; }
    __syncthreads();
    {   const float* hn = A.in[10]; bf16_t* MIX = (bf16_t*)(ws + WS_MIX);
        const int cc = t >> 3, v0 = (t & 7) * 16; const float rstd = __builtin_amdgcn_rsqf((part[cc] + part[64 + cc]) * (1.0f / 128.0f) + EPS);
#pragma unroll
        for (int hh = 0; hh < 2; ++hh) { const int v = v0 + hh * 8; const u32x4 g8 = ggr[hh];
            const f32x4 oa = *(const f32x4*)(ost + cc * 132 + v), ob = *(const f32x4*)(ost + cc * 132 + v + 4), na = *(const f32x4*)(hn + C0 + v), nb = *(const f32x4*)(hn + C0 + v + 4);
            u32x4 o; o.x = pk2(oa[0] * rstd * na[0] * bfe(g8, 0), oa[1] * rstd * na[1] * bfe(g8, 1)); o.y = pk2(oa[2] * rstd * na[2] * bfe(g8, 2), oa[3] * rstd * na[3] * bfe(g8, 3));
            o.z = pk2(ob[0] * rstd * nb[0] * bfe(g8, 4), ob[1] * rstd * nb[1] * bfe(g8, 5)); o.w = pk2(ob[2] * rstd * nb[2] * bfe(g8, 6), ob[3] * rstd * nb[3] * bfe(g8, 7));
            *(u32x4*)(MIX + (size_t)(R0 + cc) * DM + C0 + v) = o; } }
    __syncthreads();
}
__device__ __forceinline__ void hgrn_scan(const Args& A, int G) {
    const u32x2v* SLT = (const u32x2v*)(A.ws + WS_SL); const f32x4* DEC4 = (const f32x4*)(A.ws + WS_DEC); u32x2v* SPT = (u32x2v*)(A.ws + WS_SPT); float* outp = A.out + O_HP;
    for (int e = blockIdx.x * NTHREADS + threadIdx.x; e < 32 * 4096; e += G * NTHREADS) { const int bh = e >> 12, i4 = e & 4095, v = i4 >> 5, k4 = i4 & 31;
        f32x4 S = (f32x4){0.f, 0.f, 0.f, 0.f};
        const u32x2v* p = SLT + (size_t)bh * 32 * 4096 + i4; u32x2v* q = SPT + (size_t)bh * 32 * 4096 + i4; const f32x4* dp = DEC4 + (size_t)bh * 32 * 32 + k4;
#pragma unroll
        for (int hf = 0; hf < 2; ++hf) { u32x2v loc[16]; f32x4 dd[16];
#pragma unroll
            for (int c = 0; c < 16; ++c) { loc[c] = p[(size_t)(hf * 16 + c) * 4096]; dd[c] = dp[(hf * 16 + c) * 32]; }
#pragma unroll
            for (int c = 0; c < 16; ++c) { u32x2v o; o.x = pk2(S[0], S[1]); o.y = pk2(S[2], S[3]); q[(size_t)(hf * 16 + c) * 4096] = o; const f32x4 lv = (f32x4){h_lo(loc[c].x), h_hi(loc[c].x), h_lo(loc[c].y), h_hi(loc[c].y)}; S = S * dd[c] + lv; } }
        float* ob = outp + (size_t)bh * 16384 + (k4 * 4) * 128 + v; ob[0] = S[0]; ob[128] = S[1]; ob[256] = S[2]; ob[384] = S[3]; }
}
__device__ __forceinline__ void pool_states(const Args& A, int G) {
    const unsigned short* UU = (const unsigned short*)(A.ws + WS_UU);
    const int gt = blockIdx.x * NTHREADS + threadIdx.x, NGT = G * NTHREADS;
    for (int i = gt; i < 8 * 15 * 128; i += NGT) { const int c4 = i & 127, j = (i >> 7) % 15, b = i / (15 * 128); const u32x2v v = *(const u32x2v*)(UU + (size_t)(b * SEQ + 2033 + j) * HW + c4 * 4);
        *(f32x4*)(A.out + O_PP + (size_t)i * 4) = (f32x4){h_lo(v.x), h_hi(v.x), h_lo(v.y), h_hi(v.y)}; }
    for (int i0 = gt * 2; i0 < 128 * 15 * 128; i0 += NGT * 2) { f32x4 v[2];
#pragma unroll
        for (int q = 0; q < 2; ++q) { const int i = i0 + q, c4 = i & 127, j = (i >> 7) % 15, b = i / (15 * 128);
            if (j < 14) v[q] = *(const f32x4*)(A.in[4] + (size_t)(b * 15 + j + 1) * 512 + c4 * 4);
            else { const u32x2v h = *(const u32x2v*)(UU + (size_t)(NPR + b) * HW + c4 * 4); v[q] = (f32x4){h_lo(h.x), h_hi(h.x), h_lo(h.y), h_hi(h.y)}; } }
#pragma unroll
        for (int q = 0; q < 2; ++q) *(f32x4*)(A.out + O_PS + (size_t)(i0 + q) * 4) = v[q]; }
}
__device__ __forceinline__ void hgrn_sample_load(const Args& A, int unit, f32x4 (&sreg)[8]) {
    const int t = threadIdx.x; const float* S0 = A.in[3] + (size_t)unit * 16384;
#pragma unroll
    for (int i = 0; i < 8; ++i) sreg[i] = *(const f32x4*)(S0 + ((t >> 5) * 8 + i) * 128 + (t & 31) * 4);
}
__device__ __forceinline__ void hgrn_sample_unit(const Args& A, unsigned char* lds, int unit, int next, f32x4 (&sreg)[8]) {
    const int t = threadIdx.x, b = unit >> 2, h = unit & 3, row = NPR + b, C0 = h * 128;
    unsigned char* ws = A.ws;
    float* qs = (float*)lds; float* ks = qs + 128; float* fs = ks + 128; float* vs = fs + 128; float* po = vs + 128;
    float* red = po + 16 * 128;
    float* S1 = A.out + O_HS + (size_t)unit * 16384;
    if (t < 128) { const size_t go = (size_t)row * HW + C0 + t;
        qs[t] = bf2f(((const bf16_t*)(ws + WS_QQ))[go]); ks[t] = bf2f(((const bf16_t*)(ws + WS_KK))[go]); fs[t] = __expf((float)__builtin_bit_cast(_Float16, ((const unsigned short*)(ws + WS_LF))[go])); vs[t] = bf2f(((const bf16_t*)(ws + WS_VV))[go]); }
    __syncthreads();
    const int v4 = t & 31, kg = t >> 5;
    const f32x4 vv = *(const f32x4*)(vs + v4 * 4);
    f32x4 o = (f32x4){0.f, 0.f, 0.f, 0.f};
#pragma unroll
    for (int i = 0; i < 8; ++i) { const int k = kg * 8 + i; const f32x4 s = sreg[i]; const f32x4 sn = s * fs[k] + vv * ks[k]; *(f32x4*)(S1 + k * 128 + v4 * 4) = sn; o += sn * qs[k]; }
    *(f32x4*)(po + kg * 128 + v4 * 4) = o;
    if (next >= 0) hgrn_sample_load(A, next, sreg);
    __syncthreads();
    float ov = 0.f;
    if (t < 128) {
#pragma unroll
        for (int i = 0; i < 16; ++i) ov += po[i * 128 + t];
        const float sq = wave_sum(ov * ov); if ((t & 63) == 0) red[t >> 6] = sq; }
    __syncthreads();
    if (t < 128) { const float rstd = __builtin_amdgcn_rsqf((red[0] + red[1]) * (1.0f / 128.0f) + EPS); const float g = bf2f(((const bf16_t*)(ws + WS_GG))[(size_t)row * HW + C0 + t]);
        ((bf16_t*)(ws + WS_MIX))[(size_t)row * DM + C0 + t] = (bf16_t)f2bf(ov * rstd * A.in[10][C0 + t] * g); }
    __syncthreads();
}

constexpr int LP_EXT = 0, LP_PL = 40448, LP_MX = 57856;
__device__ __forceinline__ void pool_load(const Args& A, int unit, u32x4 (&mreg)[4], u32x2v (&ereg)[5]) {
    const int t = threadIdx.x; const int tt = unit >> 2, g = unit & 3;
    const unsigned short* UU = (const unsigned short*)(A.ws + WS_UU);
    const bf16_t* PM = (const bf16_t*)(A.ws + WS_PMIX) + (size_t)g * 16384;
#pragma unroll
    for (int i = 0; i < 4; ++i) { const int idx = i * 512 + t, d = idx >> 4, c8 = idx & 15; mreg[i] = *(const u32x4*)(PM + d * 128 + c8 * 8); }
    const int b = tt >> 5, t0 = (tt & 31) * 64;
#pragma unroll
    for (int i5 = 0; i5 < 5; ++i5) { const int idx = i5 * 512 + t, i = idx >> 5, c4 = idx & 31; const int tp = t0 - 15 + i;
        ereg[i5] = (u32x2v){0u, 0u}; if (idx < 79 * 32 && tp >= 0) ereg[i5] = *(const u32x2v*)(UU + (size_t)(b * SEQ + tp) * HW + g * 128 + c4 * 4); }
}
__device__ __forceinline__ void pool_unit(const Args& A, unsigned char* lds, int unit, int next, u32x4 (&mreg)[4], u32x2v (&ereg)[5]) {
    const int t = threadIdx.x, w = t >> 6, l = t & 63, lr = l & 15, lq = l >> 4;
    const int tt = unit >> 2, g = unit & 3, win = 2 << g;
    unsigned char* ws = A.ws;
    float* ext = (float*)(lds + LP_EXT); bf16_t* pl = (bf16_t*)(lds + LP_PL); bf16_t* mx = (bf16_t*)(lds + LP_MX);
    const unsigned short* UU = (const unsigned short*)(ws + WS_UU);
    {
#pragma unroll
        for (int i = 0; i < 4; ++i) { const int idx = i * 512 + t, d = idx >> 4, c8 = idx & 15; *(u32x4*)(mx + d * 136 + c8 * 8) = mreg[i]; }
    }
    int rowbase;
    {
        const int b = tt >> 5, t0 = (tt & 31) * 64; rowbase = b * SEQ + t0;
#pragma unroll
        for (int i5 = 0; i5 < 5; ++i5) { const int idx = i5 * 512 + t, i = idx >> 5, c4 = idx & 31; if (idx < 79 * 32) *(f32x4*)(ext + i * 128 + c4 * 4) = (f32x4){h_lo(ereg[i5].x), h_hi(ereg[i5].x), h_lo(ereg[i5].y), h_hi(ereg[i5].y)}; }
        if (next >= 0) pool_load(A, next, mreg, ereg);
        __syncthreads();
        const int cch = t & 127, tg = t >> 7, tk0 = tg * 16;
        float nw[16], od[16], ini[16];
#pragma unroll
        for (int i = 0; i < 16; ++i) { nw[i] = ext[(15 + tk0 + i) * 128 + cch]; od[i] = (i >= 1) ? ext[(15 + tk0 + i - win) * 128 + cch] : 0.f; ini[i] = (i >= 1 && i < win) ? ext[(15 + tk0 - i) * 128 + cch] : 0.f; }
        float sw = 0.f;
#pragma unroll
        for (int i = 1; i < 16; ++i) sw += ini[i];
#pragma unroll
        for (int i = 0; i < 16; ++i) { const int tok = tk0 + i; sw += nw[i]; sw -= od[i];
            const int cnt = min(t0 + tok + 1, win);
            pl[tok * 136 + cch] = (bf16_t)f2bf(sw / (float)cnt - nw[i]); }
    }
    __syncthreads();
    const int ct = w & 3, dh = w >> 2;
    f32x4 o4[4];
#pragma unroll
    for (int i = 0; i < 4; ++i) o4[i] = (f32x4){0.f, 0.f, 0.f, 0.f};
#pragma unroll
    for (int ks = 0; ks < 4; ++ks) { const bf16x8 a = *(const bf16x8*)(pl + (16 * ct + lr) * 136 + ks * 32 + lq * 8);
#pragma unroll
        for (int i = 0; i < 4; ++i) { const int dt = dh * 4 + i; const bf16x8 bb = *(const bf16x8*)(mx + (16 * dt + lr) * 136 + ks * 32 + lq * 8); o4[i] = MFMA16(a, bb, o4[i]); } }
    bf16_t* MIX = (bf16_t*)(ws + WS_MIX); const float* psc = A.in[12];
    float* ost = (float*)(lds + LP_EXT);
#pragma unroll
    for (int i = 0; i < 4; ++i) { const int d = (dh * 4 + i) * 16 + lr; const float sc = psc[g * 128 + d];
#pragma unroll
        for (int r = 0; r < 4; ++r) ost[(16 * ct + lq * 4 + r) * 132 + d] = o4[i][r] * sc; }
    __syncthreads();
    {   const int tok = t >> 3, d0 = (t & 7) * 16;
#pragma unroll
        for (int hh = 0; hh < 2; ++hh) { const f32x4 oa = *(const f32x4*)(ost + tok * 132 + d0 + hh * 8), ob = *(const f32x4*)(ost + tok * 132 + d0 + hh * 8 + 4);
            u32x4 o; o.x = pk2(oa[0], oa[1]); o.y = pk2(oa[2], oa[3]); o.z = pk2(ob[0], ob[1]); o.w = pk2(ob[2], ob[3]);
            *(u32x4*)(MIX + (size_t)(rowbase + tok) * DM + 512 + g * 128 + d0 + hh * 8) = o; } }
    __syncthreads();
}

__device__ __forceinline__ void pool_sample_unit(const Args& A, unsigned char* lds, int unit) {
    const int t = threadIdx.x, w = t >> 6, l = t & 63, lr = l & 15, lq = l >> 4;
    const int su = unit >> 2, g = unit & 3, win = 2 << g;
    unsigned char* ws = A.ws;
    bf16_t* pl = (bf16_t*)(lds + LP_PL); bf16_t* mx = (bf16_t*)(lds + LP_MX);
    const _Float16* UU = (const _Float16*)(ws + WS_UU);
    const bf16_t* PM = (const bf16_t*)(ws + WS_PMIX) + (size_t)g * 16384;
    u32x4 mreg[4];
#pragma unroll
    for (int i = 0; i < 4; ++i) { const int idx = i * 512 + t, d = idx >> 4, c8 = idx & 15; mreg[i] = *(const u32x4*)(PM + d * 128 + c8 * 8); }
    const int cch = t & 127, sq = t >> 7;
    const float psc_w = A.in[12][g * 128 + 16 * w + lr];
#pragma unroll
    for (int i = 0; i < 4; ++i) { const int tok = sq * 4 + i, sb = su * 16 + tok; const float uv = (float)UU[(size_t)(NPR + sb) * HW + g * 128 + cch];
        float pv[15];
#pragma unroll
        for (int j = 0; j < 15; ++j) pv[j] = A.in[4][(size_t)(sb * 15 + j) * 512 + g * 128 + cch];
        float sacc = uv;
#pragma unroll
        for (int j = 0; j < 15; ++j) sacc += (j >= 16 - win) ? pv[j] : 0.f;
        pl[tok * 136 + cch] = (bf16_t)f2bf(sacc / (float)win - uv); }
#pragma unroll
    for (int i = 0; i < 4; ++i) { const int idx = i * 512 + t, d = idx >> 4, c8 = idx & 15; *(u32x4*)(mx + d * 136 + c8 * 8) = mreg[i]; }
    __syncthreads();
    f32x4 acc = (f32x4){0.f, 0.f, 0.f, 0.f};
#pragma unroll
    for (int ks = 0; ks < 4; ++ks) { const bf16x8 a = *(const bf16x8*)(pl + lr * 136 + ks * 32 + lq * 8); const bf16x8 bb = *(const bf16x8*)(mx + (16 * w + lr) * 136 + ks * 32 + lq * 8); acc = MFMA16(a, bb, acc); }
    bf16_t* MIX = (bf16_t*)(ws + WS_MIX);
#pragma unroll
    for (int r = 0; r < 4; ++r) MIX[(size_t)(NPR + su * 16 + lq * 4 + r) * DM + 512 + g * 128 + 16 * w + lr] = (bf16_t)f2bf(acc[r] * psc_w);
    __syncthreads();
}

__device__ __forceinline__ void attn_prompt_unit(const Args& A, unsigned char* lds, int unit) {
    const int t = threadIdx.x, w = t >> 6, l = t & 63, lr = l & 15, lq = l >> 4;
    const int qt = unit & 15, h = (unit >> 4) & 3, b = unit >> 6;
    unsigned char* ws = A.ws;
    const bf16_t* Q = (const bf16_t*)(ws + WS_Q); const bf16_t* KB = (const bf16_t*)(ws + WS_KB); const bf16_t* VT = (const bf16_t*)(ws + WS_VT); bf16_t* O = (bf16_t*)(ws + WS_O);
    const int R0 = b * SEQ + qt * 128 + 16 * w;
    bf16_t* CB = (bf16_t*)lds;
    bf16_t* Pw = (bf16_t*)(lds + 73728) + w * (16 * 264);
    const bf16_t* kg = KB + (size_t)(b * 256) * DM + h * 256;
    const bf16_t* vg = VT + (size_t)(h * 256) * MEMR + b * 256;
    u32x4 stg0[4], stg1[4];
#define AT_LOADK(c, STG) _Pragma("unroll") for (int i_ = 0; i_ < 4; ++i_) { const int idx_ = i_ * 512 + t; STG[i_] = *(const u32x4*)(kg + (size_t)((c) * 64 + (idx_ >> 5)) * DM + (idx_ & 31) * 8); }
#define AT_LOADV(c, STG) _Pragma("unroll") for (int i_ = 0; i_ < 4; ++i_) { const int idx_ = i_ * 512 + t; STG[i_] = *(const u32x4*)(vg + (size_t)(idx_ >> 3) * MEMR + (c) * 64 + (idx_ & 7) * 8); }
#define AT_STOREK(bf, STG) _Pragma("unroll") for (int i_ = 0; i_ < 4; ++i_) { const int idx_ = i_ * 512 + t; *(u32x4*)(CB + (bf) * 18432 + (idx_ >> 5) * 264 + (idx_ & 31) * 8) = STG[i_]; }
#define AT_STOREV(bf, STG) _Pragma("unroll") for (int i_ = 0; i_ < 4; ++i_) { const int idx_ = i_ * 512 + t; *(u32x4*)(CB + (bf) * 18432 + (idx_ >> 3) * 72 + (idx_ & 7) * 8) = STG[i_]; }
    AT_LOADK(0, stg0); AT_LOADK(1, stg1);
    bf16x8 qa[8];
#pragma unroll
    for (int ks = 0; ks < 8; ++ks) qa[ks] = *(const bf16x8*)(Q + (size_t)(R0 + lr) * DM + h * 256 + ks * 32 + lq * 8);
    AT_STOREK(0, stg0);
    __syncthreads();
    f32x4 sacc[16]; f32x4 oacc[16]; bf16x8 pa[8]; float rinv[4];
#pragma unroll
    for (int st = 0; st < 8; ++st) {
        if (st & 1) { if (st + 2 < 4) { AT_LOADK(st + 2, stg1); } else if (st + 2 < 8) { AT_LOADV(st - 2, stg1); } }
        else        { if (st + 2 < 4) { AT_LOADK(st + 2, stg0); } else if (st + 2 < 8) { AT_LOADV(st - 2, stg0); } }
        const bf16_t* cb = CB + (st & 1) * 18432;
        if (st < 4) {
#pragma unroll
            for (int nt = 0; nt < 4; ++nt) { f32x4 acc = (f32x4){0.f, 0.f, 0.f, 0.f};
#pragma unroll
                for (int ks = 0; ks < 8; ++ks) { const bf16x8 bb = *(const bf16x8*)(cb + (nt * 16 + lr) * 264 + ks * 32 + lq * 8); acc = MFMA16(qa[ks], bb, acc); }
                sacc[st * 4 + nt] = acc; __builtin_amdgcn_sched_barrier(0); }
        } else {
            if (st == 4) {
#pragma unroll
                for (int r = 0; r < 4; ++r) { float mx = sacc[0][r];
#pragma unroll
                    for (int nt = 1; nt < 16; ++nt) mx = fmaxf(mx, sacc[nt][r]);
                    mx = fmaxf(mx, __shfl_xor(mx, 1)); mx = fmaxf(mx, __shfl_xor(mx, 2)); mx = fmaxf(mx, __shfl_xor(mx, 4)); mx = fmaxf(mx, __shfl_xor(mx, 8));
                    float sum = 0.f;
#pragma unroll
                    for (int nt = 0; nt < 16; ++nt) { const float p = __builtin_amdgcn_exp2f(sacc[nt][r] - mx); sum += p; Pw[(lq * 4 + r) * 264 + nt * 16 + lr] = (bf16_t)f2bf(p); }
                    sum += __shfl_xor(sum, 1); sum += __shfl_xor(sum, 2); sum += __shfl_xor(sum, 4); sum += __shfl_xor(sum, 8);
                    rinv[r] = 1.0f / sum; }
                asm volatile("s_waitcnt lgkmcnt(0)" ::: "memory");
#pragma unroll
                for (int ks = 0; ks < 8; ++ks) pa[ks] = *(const bf16x8*)(Pw + lr * 264 + ks * 32 + lq * 8);
#pragma unroll
                for (int dt = 0; dt < 16; ++dt) oacc[dt] = (f32x4){0.f, 0.f, 0.f, 0.f};
            }
            const int c = st - 4;
#pragma unroll
            for (int dt = 0; dt < 16; ++dt)
#pragma unroll
                for (int k2 = 0; k2 < 2; ++k2) { const bf16x8 bb = *(const bf16x8*)(cb + (dt * 16 + lr) * 72 + k2 * 32 + lq * 8); oacc[dt] = MFMA16(pa[c * 2 + k2], bb, oacc[dt]); if (k2 == 1 && (dt & 1)) __builtin_amdgcn_sched_barrier(0); }
        }
        if (st & 1) { if (st + 1 < 4) { AT_STOREK(0, stg0); } else if (st + 1 < 8) { AT_STOREV(0, stg0); } }
        else        { if (st + 1 < 4) { AT_STOREK(1, stg1); } else if (st + 1 < 8) { AT_STOREV(1, stg1); } }
        __syncthreads();
    }
#pragma unroll
    for (int dt = 0; dt < 16; ++dt)
#pragma unroll
        for (int r = 0; r < 4; ++r) Pw[(lq * 4 + r) * 264 + dt * 16 + lr] = (bf16_t)f2bf(oacc[dt][r] * rinv[r]);
    asm volatile("s_waitcnt lgkmcnt(0)" ::: "memory");
#pragma unroll
    for (int i = 0; i < 8; ++i) { const int idx = i * 64 + l, row = idx >> 5, c8 = idx & 31; *(u32x4*)(O + (size_t)(R0 + row) * DM + h * 256 + c8 * 8) = *(const u32x4*)(Pw + row * 264 + c8 * 8); }
    asm volatile("s_waitcnt lgkmcnt(0)" ::: "memory");
#undef AT_LOADK
#undef AT_LOADV
#undef AT_STOREK
#undef AT_STOREV
}
__device__ __forceinline__ void attn_sample_unit(const Args& A, unsigned char* lds, int unit) {
    const int t = threadIdx.x, w = t >> 6, l = t & 63;
    const int b = unit >> 2, h = unit & 3;
    unsigned char* ws = A.ws;
    float* qs = (float*)lds; float* sc = qs + 256; float* red = sc + 256; float* po = red + 16;
    const float* Kc = A.in[5] + (size_t)b * 256 * 1024 + h * 256; const float* Vc = A.in[6] + (size_t)b * 256 * 1024 + h * 256;
    const int rl = l >> 4, c16 = l & 15;
    f32x4 kr[8][4];
#pragma unroll
    for (int p = 0; p < 8; ++p)
#pragma unroll
        for (int i = 0; i < 4; ++i) kr[p][i] = *(const f32x4*)(Kc + (size_t)(p * 32 + w * 4 + rl) * 1024 + i * 64 + c16 * 4);
    if (t < 256) qs[t] = bf2f(((const bf16_t*)(ws + WS_Q))[(size_t)(NPR + b) * DM + h * 256 + t]);
    __syncthreads();
    {
        f32x4 q4[4];
#pragma unroll
        for (int i = 0; i < 4; ++i) q4[i] = *(const f32x4*)(qs + i * 64 + c16 * 4);
#pragma unroll
        for (int p = 0; p < 8; ++p) { const int m = p * 32 + w * 4 + rl; float s = 0.f;
#pragma unroll
            for (int i = 0; i < 4; ++i) { const f32x4 kv = kr[p][i]; s += (kv[0] * q4[i][0] + kv[1] * q4[i][1]) + (kv[2] * q4[i][2] + kv[3] * q4[i][3]); }
            s += __shfl_xor(s, 1); s += __shfl_xor(s, 2); s += __shfl_xor(s, 4); s += __shfl_xor(s, 8);
            if (c16 == 0) sc[m] = s; }
    }
    f32x4 vr[32];
#pragma unroll
    for (int i = 0; i < 32; ++i) vr[i] = *(const f32x4*)(Vc + (size_t)(w * 32 + i) * 1024 + l * 4);
    __syncthreads();
    if (t < 256) { float mx = sc[t];
#pragma unroll
        for (int o = 1; o < 64; o <<= 1) mx = fmaxf(mx, __shfl_xor(mx, o));
        if (l == 0) red[w] = mx; }
    __syncthreads();
    const float gmx = fmaxf(fmaxf(red[0], red[1]), fmaxf(red[2], red[3]));
    float pv = 0.f;
    if (t < 256) { pv = __builtin_amdgcn_exp2f(sc[t] - gmx); const float s = wave_sum(pv); if (l == 0) red[8 + w] = s; }
    __syncthreads();
    if (t < 256) sc[t] = pv;
    const float inv = 1.0f / ((red[8] + red[9]) + (red[10] + red[11]));
    __syncthreads();
    {
        f32x4 o = (f32x4){0.f, 0.f, 0.f, 0.f};
#pragma unroll
        for (int i = 0; i < 32; ++i) o += vr[i] * sc[w * 32 + i];
        *(f32x4*)(po + w * 256 + l * 4) = o;
    }
    __syncthreads();
    if (t < 256) { float o = 0.f;
#pragma unroll
        for (int i = 0; i < 8; ++i) o += po[i * 256 + t];
        ((bf16_t*)(ws + WS_O))[(size_t)(NPR + b) * DM + h * 256 + t] = (bf16_t)f2bf(o * inv); }
    __syncthreads();
}

__device__ __forceinline__ void attn_sample_pair(const Args& A, unsigned char* lds, int pg) {
    const int t = threadIdx.x, w = t >> 6, l = t & 63, rl = l >> 4, c16 = l & 15;
    const int pair = pg * 2 + (w >> 2), wq = w & 3, b = pair >> 2, h = pair & 3;
    const size_t off0 = (size_t)b * 256 * 1024 + h * 256 + (size_t)(wq * 64 + rl) * 1024 + c16 * 4;
    const float* Kc = A.in[5] + off0; const float* Vc = A.in[6] + off0;
    f32x4 ra[8], rb[8];
#define AS_LD(set, base, bt) _Pragma("unroll") for (int gg_ = 0; gg_ < 2; ++gg_) _Pragma("unroll") for (int i_ = 0; i_ < 4; ++i_) set[gg_ * 4 + i_] = *(const f32x4*)((base) + (size_t)((bt) * 8 + gg_ * 4) * 1024 + i_ * 64)
    AS_LD(ra, Kc, 0); AS_LD(rb, Kc, 1);
    f32x4 q4[4];
    {   const bf16_t* qp = (const bf16_t*)(A.ws + WS_Q) + (size_t)(NPR + b) * DM + h * 256 + c16 * 4;
#pragma unroll
        for (int i = 0; i < 4; ++i) { const u32x2v qv = *(const u32x2v*)(qp + i * 64); q4[i] = (f32x4){__uint_as_float(qv.x << 16), __uint_as_float(qv.x & 0xffff0000u), __uint_as_float(qv.y << 16), __uint_as_float(qv.y & 0xffff0000u)}; } }
    float sc[16];
#define AS_SCORE(set, bt) _Pragma("unroll") for (int gg_ = 0; gg_ < 2; ++gg_) { float s_ = 0.f; _Pragma("unroll") for (int i_ = 0; i_ < 4; ++i_) { const f32x4 kv_ = set[gg_ * 4 + i_]; s_ += (kv_[0] * q4[i_][0] + kv_[1] * q4[i_][1]) + (kv_[2] * q4[i_][2] + kv_[3] * q4[i_][3]); } \
        s_ += __shfl_xor(s_, 1); s_ += __shfl_xor(s_, 2); s_ += __shfl_xor(s_, 4); s_ += __shfl_xor(s_, 8); sc[(bt) * 2 + gg_] = s_; }
#pragma unroll
    for (int bt = 0; bt < 8; ++bt) {
        if (bt & 1) { AS_SCORE(rb, bt); if (bt + 2 < 8) { AS_LD(rb, Kc, bt + 2); } else { AS_LD(rb, Vc, bt - 6); } }
        else        { AS_SCORE(ra, bt); if (bt + 2 < 8) { AS_LD(ra, Kc, bt + 2); } else { AS_LD(ra, Vc, bt - 6); } }
        asm volatile("" ::: "memory"); __builtin_amdgcn_sched_barrier(0);
    }
    float mx = sc[0];
#pragma unroll
    for (int g = 1; g < 16; ++g) mx = fmaxf(mx, sc[g]);
    mx = fmaxf(mx, __shfl_xor(mx, 16)); mx = fmaxf(mx, __shfl_xor(mx, 32));
    float ls = 0.f;
#pragma unroll
    for (int g = 0; g < 16; ++g) { sc[g] = __builtin_amdgcn_exp2f(sc[g] - mx); ls += sc[g]; }
    ls += __shfl_xor(ls, 16); ls += __shfl_xor(ls, 32);
    f32x4 o[4];
#pragma unroll
    for (int i = 0; i < 4; ++i) o[i] = (f32x4){0.f, 0.f, 0.f, 0.f};
#define AS_PV(set, bt) _Pragma("unroll") for (int gg_ = 0; gg_ < 2; ++gg_) _Pragma("unroll") for (int i_ = 0; i_ < 4; ++i_) o[i_] += set[gg_ * 4 + i_] * sc[(bt) * 2 + gg_]
#pragma unroll
    for (int bt = 0; bt < 8; ++bt) {
        if (bt & 1) { AS_PV(rb, bt); if (bt + 2 < 8) { AS_LD(rb, Vc, bt + 2); } }
        else        { AS_PV(ra, bt); if (bt + 2 < 8) { AS_LD(ra, Vc, bt + 2); } }
        asm volatile("" ::: "memory"); __builtin_amdgcn_sched_barrier(0);
    }
#pragma unroll
    for (int i = 0; i < 4; ++i)
#pragma unroll
        for (int c = 0; c < 4; ++c) { float v = o[i][c]; v += __shfl_xor(v, 16); v += __shfl_xor(v, 32); o[i][c] = v; }
    float* pw = (float*)lds + w * 260;
    if (rl == 0) {
#pragma unroll
        for (int i = 0; i < 4; ++i) *(f32x4*)(pw + i * 64 + c16 * 4) = o[i];
        if (c16 == 0) { pw[256] = mx; pw[257] = ls; } }
    __syncthreads();
    {   const int ps = t >> 8, d = t & 255; const float* pb = (const float*)lds + (ps * 4) * 260;
        const float m0 = pb[256], m1 = pb[260 + 256], m2 = pb[520 + 256], m3 = pb[780 + 256]; const float M = fmaxf(fmaxf(m0, m1), fmaxf(m2, m3));
        const float e0 = __builtin_amdgcn_exp2f(m0 - M), e1 = __builtin_amdgcn_exp2f(m1 - M), e2 = __builtin_amdgcn_exp2f(m2 - M), e3 = __builtin_amdgcn_exp2f(m3 - M);
        const float num = (pb[d] * e0 + pb[260 + d] * e1) + (pb[520 + d] * e2 + pb[780 + d] * e3);
        const float den = (pb[257] * e0 + pb[260 + 257] * e1) + (pb[520 + 257] * e2 + pb[780 + 257] * e3);
        const int pr = pg * 2 + ps, bb = pr >> 2, hh = pr & 3;
        ((bf16_t*)(A.ws + WS_O))[(size_t)(NPR + bb) * DM + hh * 256 + d] = (bf16_t)f2bf(num / den); }
    __syncthreads();
#undef AS_LD
#undef AS_SCORE
#undef AS_PV
}

template <int KIND, int NKS>
__device__ __forceinline__ void sample_gemm(unsigned char* lds, const bf16_t* Asm, int lda, const bf16_t* Bt, int K, int unit, const float* base, const bf16_t* baseb, float* out, bf16_t* outb, float* ss, float scale) {
    const int t = threadIdx.x, w = t >> 6, l = t & 63, lr = l & 15, lq = l >> 4;
    const int rb = unit & 3, cb = unit >> 2, kw = K >> 3, k0 = w * kw;
    f32x4 acc[2]; acc[0] = (f32x4){0.f, 0.f, 0.f, 0.f}; acc[1] = acc[0];
    const bf16_t* bp = Bt + (size_t)(cb * 16 + lr) * K + k0 + lq * 8;
    const bf16_t* ap = Asm + (size_t)(rb * 32 + lr) * lda + k0 + lq * 8;
    bf16x8 fb[NKS], fa0[NKS], fa1[NKS];
#pragma unroll
    for (int ks = 0; ks < NKS; ++ks) { fb[ks] = *(const bf16x8*)(bp + ks * 32); fa0[ks] = *(const bf16x8*)(ap + ks * 32); fa1[ks] = *(const bf16x8*)(ap + (size_t)16 * lda + ks * 32); }
    const int row_ = t >> 4, col_ = t & 15;
    float bres = 0.f;
    if (KIND == 0) bres = base ? base[(size_t)(rb * 32 + row_) * DM + cb * 16 + col_] : bf2f(baseb[(size_t)(rb * 32 + row_) * DM + cb * 16 + col_]);
#pragma unroll
    for (int ks = 0; ks < NKS; ++ks) { acc[0] = MFMA16(fa0[ks], fb[ks], acc[0]); acc[1] = MFMA16(fa1[ks], fb[ks], acc[1]); }
    float* red = (float*)lds;
#pragma unroll
    for (int i = 0; i < 2; ++i)
#pragma unroll
        for (int r = 0; r < 4; ++r) red[(w * 32 + i * 16 + lq * 4 + r) * 16 + lr] = acc[i][r];
    __syncthreads();
    const int row = t >> 4, col = t & 15, grow = rb * 32 + row, gcol = cb * 16 + col;
    float v = 0.f;
#pragma unroll
    for (int i = 0; i < 8; ++i) v += red[(i * 32 + row) * 16 + col];
    if (KIND == 0) { const float val = bres + v; if (out) out[(size_t)grow * DM + gcol] = val; if (outb) outb[(size_t)grow * DM + gcol] = (bf16_t)f2bf(val);
        float sq = val * val; sq += __shfl_xor(sq, 1); sq += __shfl_xor(sq, 2); sq += __shfl_xor(sq, 4); sq += __shfl_xor(sq, 8);
        if (col == 0) atomicAdd(ss + grow, sq);
    } else { const float rstd = __builtin_amdgcn_rsqf(ss[grow] * (1.0f / DM) + EPS); outb[(size_t)grow * DM + gcol] = (bf16_t)f2bf(v * rstd * scale); }
    __syncthreads();
}

__device__ __forceinline__ void final_norm(const Args& A, int G, int row_lo) {
    const int lane = threadIdx.x & 63, gw = blockIdx.x * 8 + (threadIdx.x >> 6), NGW = G * 8;
    const float* ss = (const float*)(A.ws + WS_SS3); const f32x4* gr = (const f32x4*)A.in[22] + lane;
    f32x4 gg[4];
#pragma unroll
    for (int j = 0; j < 4; ++j) gg[j] = gr[64 * j];
    for (int m0 = row_lo + gw * 4; m0 < NVALID; m0 += NGW * 4) {
        f32x4 v[4][4]; float sv[4];
#pragma unroll
        for (int r = 0; r < 4; ++r) { sv[r] = ss[m0 + r]; const f32x4* xr = (const f32x4*)(A.out + (size_t)(m0 + r) * DM) + lane;
#pragma unroll
            for (int j = 0; j < 4; ++j) v[r][j] = xr[64 * j]; }
#pragma unroll
        for (int r = 0; r < 4; ++r) { const float rstd = 1.0f / sqrtf(sv[r] * (1.f / DM) + EPS); f32x4* xr = (f32x4*)(A.out + (size_t)(m0 + r) * DM) + lane;
#pragma unroll
            for (int j = 0; j < 4; ++j) xr[64 * j] = v[r][j] * rstd * gg[j]; } }
}

constexpr int NPHASES = 12;
#ifndef REPMASK
#define REPMASK 0
#endif
#define REPS(k) for (int rep_ = 0; rep_ < 1 + ((REPMASK >> (k)) & 1); ++rep_)
__global__ void __launch_bounds__(NTHREADS, 2) fwd_megakernel(Args args) {
    extern __shared__ __attribute__((aligned(16))) unsigned char lds[];
    cg::grid_group grid = cg::this_grid();
    const int G = gridDim.x, bx = blockIdx.x;
    unsigned char* ws = args.ws;
    PG8_LAS unsigned char* lds3 = (PG8_LAS unsigned char*)lds;
    const int lo = args.ph_lo, hi = args.ph_hi;
#define IN(k) (lo <= (k) && (k) < hi)
#ifndef SPINBLK
#define SPINBLK 0
#endif
#ifdef SPINMASK
    unsigned long long t_prev_ = __builtin_amdgcn_s_memrealtime(), t_acc_ = 0ull;
#define STAMP(k) do { const unsigned long long t_now_ = __builtin_amdgcn_s_memrealtime(); if ((SPINMASK >> (k)) & 1) t_acc_ += t_now_ - t_prev_; t_prev_ = t_now_; } while (0)
#else
#define STAMP(k) do { } while (0)
#endif
#define SEAM(k) do { if (IN(k) && IN((k) + 1)) xcd_barrier(bar); STAMP(k); } while (0)
    if (lo < 0) grid.sync();
    volatile LAS unsigned* MISC = (volatile LAS unsigned*)(lds3 + LDS_BYTES - 64);
    if (threadIdx.x < 16) MISC[threadIdx.x] = 0u;
    __syncthreads();
    XcdBarrier bar = xcd_barrier_post((unsigned*)(ws + WS_BAR), MISC);
    if (IN(0)) REPS(0) { p0_prologue(args, lds, G); }
    SEAM(0);
    if (IN(1)) REPS(1) {
        {   pg8::Gemm g{(const bf16_t*)(ws + WS_H0), (const bf16_t*)(ws + WS_WIN), MT, NIN, DM}; pg8::StaticOrder S; S.init(MT, NIN, G, bx);
            pg8::EpiInProj E{(bf16_t*)(ws + WS_QQ), (bf16_t*)(ws + WS_KK), (bf16_t*)(ws + WS_VV), (bf16_t*)(ws + WS_GG), (unsigned short*)(ws + WS_LF), (unsigned short*)(ws + WS_UU), args.in[9]};
            pg8::gemm_phase<pg8::EpiInProj, pg8::StaticOrder, true, true>(lds3, g, S, E); }
        {   pg8::Gemm g{(const bf16_t*)(ws + WS_MEMH), (const bf16_t*)(ws + WS_WKV), MEMR, 2 * DM, DM}; pg8::StaticOrder S; S.init(MEMR, 2 * DM, G, (bx + G - (650 % G)) % G);
            pg8::EpiMemKV E{args.out + O_MK, args.out + O_MV, (bf16_t*)(ws + WS_KB)};
            pg8::gemm_phase<pg8::EpiMemKV, pg8::StaticOrder, true, true>(lds3, g, S, E); }
        {   pg8::Gemm g{(const bf16_t*)(ws + WS_WKV) + (size_t)DM * DM, (const bf16_t*)(ws + WS_MEMH), DM, MEMR, DM}; pg8::StaticOrder S; S.init(DM, MEMR, G, (bx + 2 * G - ((650 + 64) % G)) % G);
            pg8::EpiBf16Scale E{(bf16_t*)(ws + WS_VT), MEMR, nullptr, 1.0f};
            pg8::gemm_phase<pg8::EpiBf16Scale, pg8::StaticOrder, true, true>(lds3, g, S, E); }
    }
    SEAM(1);
    if (IN(2)) REPS(2) {
        const bool sfirst = ((bx >> 3) & 1) != 0;
#pragma unroll 1
        for (int pass = 0; pass < 2; ++pass) {
            if ((pass == 0) == sfirst) {
                f32x4 sreg[8]; if (bx < 512) hgrn_sample_load(args, bx, sreg);
                for (int u = bx; u < 512; u += G) hgrn_sample_unit(args, lds, u, (u + G < 512) ? u + G : -1, sreg);
            } else {
                u32x2v lf[4]; u32x4 kkr[2], vvr[2]; if (bx < 1024) hgrn_local_load(args, bx, lf, kkr, vvr);
                for (int u = bx; u < 1024; u += G) hgrn_local_unit(args, lds, u, (u + G < 1024) ? u + G : -1, lf, kkr, vvr);
            }
        }
    }
    SEAM(2);
    if (IN(3)) {
        for (int u = bx; u < 32; u += G) pool_sample_unit(args, lds, u);
        const bool scan_first = ((bx >> 3) & 1) != 0;
        if (scan_first) { hgrn_scan(args, G); pool_states(args, G); }
        {   u32x4 mreg[4]; u32x2v ereg[5]; if (bx < 1024) pool_load(args, bx, mreg, ereg);
            for (int u = bx; u < 1024; u += G) pool_unit(args, lds, u, (u + G < 1024) ? u + G : -1, mreg, ereg); }
        if (!scan_first) { hgrn_scan(args, G); pool_states(args, G); }
    }
    SEAM(3);
    if (IN(4)) REPS(4) {
        {   u32x2v lf[4]; u32x4 qqr[2], kkr[2], vvr[2], spr[4]; if (bx < 1024) hgrn_out_load(args, bx, lf, qqr, kkr, vvr, spr);
            for (int u = bx; u < 1024; u += G) hgrn_out_unit(args, lds, u, (u + G < 1024) ? u + G : -1, lf, qqr, kkr, vvr, spr); }
        STAMP(12);
        STAMP(13);
        for (int u = bx; u < 256; u += G) sample_gemm<0, 4>(lds, (const bf16_t*)(ws + WS_MIX) + (size_t)NPR * DM, DM, (const bf16_t*)(ws + WS_WOUT), DM, u, args.in[1], nullptr, nullptr, (bf16_t*)(ws + WS_H0) + (size_t)NPR * DM, (float*)(ws + WS_SS1) + NPR, 1.0f);
    }
    SEAM(4);
    if (IN(5)) REPS(5) {
        pg8::Gemm g{(const bf16_t*)(ws + WS_MIX), (const bf16_t*)(ws + WS_WOUT), NPR, DM, DM}; pg8::StaticOrder S; S.init(NPR, DM, G, bx);
        pg8::EpiResid E{args.in[0], nullptr, nullptr, (bf16_t*)(ws + WS_H0), (float*)(ws + (rep_ ? WS_SSD : WS_SS1))};
        pg8::gemm_phase<pg8::EpiResid, pg8::StaticOrder, true, true>(lds3, g, S, E);
        for (int u = bx; u < 256; u += G) sample_gemm<1, 4>(lds, (const bf16_t*)(ws + WS_H0) + (size_t)NPR * DM, DM, (const bf16_t*)(ws + WS_WCQ), DM, u, nullptr, nullptr, nullptr, (bf16_t*)(ws + WS_Q) + (size_t)NPR * DM, (float*)(ws + WS_SS1) + NPR, 0.0625f * 1.4426950408889634f);
    }
    SEAM(5);
    const bool stream_first = ((bx >> 3) & 1) != 0;
    if (IN(7) && stream_first) for (int u = bx; u < 256; u += G) attn_sample_pair(args, lds, u);
    if (IN(6)) {
        pg8::Gemm g{(const bf16_t*)(ws + WS_H0), (const bf16_t*)(ws + WS_WCQ), NPR, DM, DM}; pg8::StaticOrder S; S.init(NPR, DM, G, bx);
        pg8::EpiBf16Scale E{(bf16_t*)(ws + WS_Q), DM, (const float*)(ws + WS_SS1), 0.0625f * 1.4426950408889634f};
        pg8::gemm_phase<pg8::EpiBf16Scale, pg8::StaticOrder, true, true>(lds3, g, S, E);
        STAMP(16);
    }
    int au0 = bx, au1 = 512, austep = G;
    if (G == 256) {
        asm volatile("s_waitcnt vmcnt(0)" ::: "memory"); __syncthreads();
        const int wg_ = (bx & 7) * 32 + (bx >> 3), pm_ = (wg_ >> 5) * 8 + ((wg_ & 31) & 7), pn_ = (wg_ & 31) >> 3;
        au0 = ((pm_ >> 3) * 4 + pn_) * 16 + (pm_ & 7) * 2; au1 = au0 + 2; austep = 1;
    } else { SEAM(6); }
    if (IN(7)) {
        for (int u = au0; u < au1; u += austep) attn_prompt_unit(args, lds, u);
        STAMP(17);
        if (!stream_first) for (int u = bx; u < 256; u += G) attn_sample_pair(args, lds, u);
    }
    SEAM(7);
    if (IN(8)) REPS(8) {
        pg8::Gemm g{(const bf16_t*)(ws + WS_O), (const bf16_t*)(ws + WS_WCO), NPR, DM, DM}; pg8::StaticOrder S; S.init(NPR, DM, G, bx);
        pg8::EpiResid E{nullptr, (const bf16_t*)(ws + WS_H0), nullptr, (bf16_t*)(ws + WS_MIX), (float*)(ws + (rep_ ? WS_SSD : WS_SS2))};
        pg8::gemm_phase<pg8::EpiResid, pg8::StaticOrder, true, true>(lds3, g, S, E);
        for (int u = bx; u < 256; u += G) sample_gemm<0, 4>(lds, (const bf16_t*)(ws + WS_O) + (size_t)NPR * DM, DM, (const bf16_t*)(ws + WS_WCO), DM, u, nullptr, (const bf16_t*)(ws + WS_H0) + (size_t)NPR * DM, nullptr, (bf16_t*)(ws + WS_MIX) + (size_t)NPR * DM, (float*)(ws + (rep_ ? WS_SSD : WS_SS2)) + NPR, 1.0f);
    }
    SEAM(8);
    if (IN(9)) REPS(9) {
        pg8::Gemm g{(const bf16_t*)(ws + WS_MIX), (const bf16_t*)(ws + WS_WFFI), MT, NFF2, DM}; pg8::StaticOrder S; S.init(MT, NFF2, G, bx);
        pg8::EpiSwiGLU E{(bf16_t*)(ws + WS_A), (const float*)(ws + WS_SS2)};
        pg8::gemm_phase<pg8::EpiSwiGLU, pg8::StaticOrder, true, true>(lds3, g, S, E);
    }
    SEAM(9);
    if (IN(10)) {
        pg8::Gemm g{(const bf16_t*)(ws + WS_A), (const bf16_t*)(ws + WS_WFFO), NPR, DM, DFF}; pg8::StaticOrder S; S.init(NPR, DM, G, bx);
        if (G == 256) {
            pg8::EpiResidNorm E{(const bf16_t*)(ws + WS_MIX), args.out, (float*)(ws + WS_SS3), (unsigned*)(ws + WS_CNT), args.in[22]};
            pg8::gemm_phase<pg8::EpiResidNorm, pg8::StaticOrder, false, true>(lds3, g, S, E);
        } else {
            pg8::EpiResid E{nullptr, (const bf16_t*)(ws + WS_MIX), args.out, nullptr, (float*)(ws + WS_SS3)};
            pg8::gemm_phase<pg8::EpiResid, pg8::StaticOrder, true, true>(lds3, g, S, E);
        }
        for (int u = bx; u < 256; u += G) sample_gemm<0, 11>(lds, (const bf16_t*)(ws + WS_A) + (size_t)NPR * DFF, DFF, (const bf16_t*)(ws + WS_WFFO), DFF, u, nullptr, (const bf16_t*)(ws + WS_MIX) + (size_t)NPR * DM, args.out + O_YS, nullptr, (float*)(ws + WS_SS3) + NPR, 1.0f);
    }
    SEAM(10);
#ifdef EXTRA_SYNCS
    for (int i_ = 0; i_ < EXTRA_SYNCS; ++i_) xcd_barrier(bar);
#endif
    if (IN(11)) { final_norm(args, G, G == 256 ? NPR : 0); }
#ifdef SPINMASK
    STAMP(11);
    if (bx == SPINBLK && threadIdx.x == 0) { const unsigned long long t0_ = __builtin_amdgcn_s_memrealtime(); while (__builtin_amdgcn_s_memrealtime() - t0_ < t_acc_) __builtin_amdgcn_s_sleep(8); }
#endif
#undef IN
#undef SEAM
}

#ifndef MK_MULTI
#define MK_MULTI 0
#endif
extern "C" void kernel_launch(void* const* d_in, const int* in_sizes, int n_in, void* d_out, int out_size, void* d_ws, size_t ws_size, hipStream_t stream) {
    static int grid = 0;
    if (grid == 0) {
        if (n_in != 23 || ws_size < WS_END) { fprintf(stderr, "kernel_launch: unexpected n_in %d / ws_size %zu\n", n_in, ws_size); grid = -1; return; }
        int dev = 0, cus = 0, per_cu = 0;
        hipGetDevice(&dev); hipDeviceGetAttribute(&cus, hipDeviceAttributeMultiprocessorCount, dev);
        if (hipFuncSetAttribute((const void*)fwd_megakernel, hipFuncAttributeMaxDynamicSharedMemorySize, LDS_BYTES) != hipSuccess) { fprintf(stderr, "kernel_launch: hipFuncSetAttribute failed\n"); grid = -1; return; }
        hipOccupancyMaxActiveBlocksPerMultiprocessor(&per_cu, (const void*)fwd_megakernel, NTHREADS, LDS_BYTES);
        (void)hipGetLastError();
        if (per_cu < 1) { fprintf(stderr, "kernel_launch: occupancy query says %d blocks/CU\n", per_cu); per_cu = 1; }
        grid = cus;
    }
    if (grid < 0) return;
    Args a{};
    for (int i = 0; i < 23; ++i) a.in[i] = (const float*)d_in[i];
    a.out = (float*)d_out; a.ws = (unsigned char*)d_ws;
#if MK_MULTI
    for (int p = 0; p < NPHASES; ++p) { a.ph_lo = p; a.ph_hi = p + 1; hipLaunchKernelGGL(fwd_megakernel, dim3(grid), dim3(NTHREADS), LDS_BYTES, stream, a); }
#else
    a.ph_lo = 0; a.ph_hi = NPHASES;
    if (hipMemsetAsync((char*)d_ws + WS_BAR, 0, BAR_BYTES, stream) != hipSuccess) { fprintf(stderr, "kernel_launch: memset failed\n"); return; }
    void* kargs[] = {&a};
    hipError_t e = hipLaunchCooperativeKernel((const void*)fwd_megakernel, dim3(grid), dim3(NTHREADS), kargs, LDS_BYTES, stream);
    if (e != hipSuccess) fprintf(stderr, "kernel_launch: cooperative launch failed: %s (grid %d)\n", hipGetErrorString(e), grid);
#endif
}
```

```cpp
#include <hip/hip_runtime.h>
#include <hip/hip_cooperative_groups.h>
#include <cstdio>
#include <cstdint>
namespace cg = cooperative_groups;
namespace pg8 {
#define PG8_LAS __attribute__((address_space(3)))
typedef unsigned short bf16_t;
typedef short bf16x8 __attribute__((ext_vector_type(8)));
typedef float f32x4 __attribute__((ext_vector_type(4)));
typedef unsigned u32x4 __attribute__((ext_vector_type(4)));
constexpr int BM = 256, BK = 64, HALF = 128, HTB = HALF * BK * 2  , STAGE_BYTES = 8 * HTB, NXCD = 8, WGM = 8;

__host__ __device__ __forceinline__ int lds_byte(int r, int c) { const int st = (r >> 4) * 2 + (c >> 5), rr = r & 15, cc = c & 31, ob = rr * 64 + cc * 2; return st * 1024 + (ob ^ (((ob >> 9) & 1) << 5)); }
__host__ __device__ __forceinline__ void stage_rc(int b, int& R, int& C) { const int st = b / 1024, sb = b % 1024, swz = sb ^ (((sb >> 9) & 1) << 5); R = (st >> 1) * 16 + swz / 64; C = (st & 1) * 32 + (swz % 64) / 2; }
__host__ __device__ __forceinline__ int perm32(int rho) { const int n = rho >> 4, i = rho & 15; return 8 * (i >> 2) + 4 * n + (i & 3); }

struct Unit { int pm, pn; };
struct Gemm { const bf16_t* A; const bf16_t* Bt; int M, N, K; };

struct StaticOrder {
    int nM, nN, nwg, G, c;
    __host__ __device__ void init(int M, int N, int G_, int c_) { nM = M / BM; nN = N / BM; nwg = nM * nN; G = G_; c = c_; }
    __host__ __device__ bool next(int i, Unit& u) const {
        const long L = (long)i * G + c; if (L >= nwg) return false;
        int wgid = (int)L; { const int q = nwg / NXCD, r = nwg % NXCD, xcd = wgid % NXCD, off = wgid / NXCD; wgid = (xcd < r ? xcd * (q + 1) : r * (q + 1) + (xcd - r) * q) + off; }
        const int nig = WGM * nN, gid = wgid / nig, fm = gid * WGM, gsz = (nM - fm) < WGM ? (nM - fm) : WGM;
        u.pm = fm + ((wgid % nig) % gsz); u.pn = (wgid % nig) / gsz; return true;
    }
    __device__ __forceinline__ void a_ready(const Unit&) const {}
    __device__ __forceinline__ void done(const Unit&) const {}
};

__device__ __forceinline__ unsigned cvt_pk_bf16(float lo, float hi) { unsigned r; asm volatile("v_cvt_pk_bf16_f32 %0, %1, %2" : "=v"(r) : "v"(lo), "v"(hi)); return r; }
typedef unsigned u32x2 __attribute__((ext_vector_type(2)));
__device__ __forceinline__ float sigm(float z) { return 1.0f / (1.0f + __expf(-z)); }
constexpr float RMS_EPS = 1e-6f;
#ifndef WT_STORES
#define WT_STORES 0
#endif
__device__ __forceinline__ void st16(void* p, u32x4 v) {
#if WT_STORES
    asm volatile("global_store_dwordx4 %0, %1, off sc1\n\ts_nop 1" :: "v"(p), "v"(v) : "memory");
#else
    *(u32x4*)p = v;
#endif
}
__device__ __forceinline__ void st16f(void* p, f32x4 v) { st16(p, __builtin_bit_cast(u32x4, v)); }
__device__ __forceinline__ void st8(void* p, u32x2 v) {
#if WT_STORES
    asm volatile("global_store_dwordx2 %0, %1, off sc1\n\ts_nop 1" :: "v"(p), "v"(v) : "memory");
#else
    *(u32x2*)p = v;
#endif
}
typedef _Float16 h2_t __attribute__((ext_vector_type(2)));
__device__ __forceinline__ unsigned pk_h2(float a, float b) { h2_t v; v.x = (_Float16)a; v.y = (_Float16)b; return __builtin_bit_cast(unsigned, v); }
__device__ __forceinline__ float h_lo(unsigned u) { return (float)__builtin_bit_cast(h2_t, u).x; }
__device__ __forceinline__ float h_hi(unsigned u) { return (float)__builtin_bit_cast(h2_t, u).y; }

struct EpiInProj {
    static constexpr bool PERM = true, AFTER_DRAIN = false;
    bf16_t *QQ, *KK, *VV, *GG; unsigned short *LF, *UU; const float* lbraw;
    __device__ __forceinline__ void operator()(const f32x4 (&acc)[2][2][4][2], const Unit& u, int wr, int wc, int fr, int fq) const {
        const int seg = u.pn >> 1, colt = (u.pn & 1) * 256;
        const int row0 = u.pm * BM + wr * 64 + fr;
#pragma unroll
        for (int bj = 0; bj < 2; ++bj) {
            const int cs = colt + bj * HALF + wc * 32 + 8 * fq;
            float lb[8];
            if (seg == 1) {
#pragma unroll
                for (int j = 0; j < 8; ++j) { const float l0 = lbraw[cs + j], l1 = lbraw[512 + cs + j]; lb[j] = 1.0f / (1.0f + __expf(l1 - l0)); }
            } else {
#pragma unroll
                for (int j = 0; j < 8; ++j) lb[j] = 0.f;
            }
#pragma unroll
            for (int ai = 0; ai < 2; ++ai)
#pragma unroll
                for (int m = 0; m < 4; ++m) {
                    const size_t off = (size_t)(row0 + ai * HALF + m * 16) * 512 + cs;
                    const f32x4 v0 = acc[ai][bj][m][0], v1 = acc[ai][bj][m][1];
                    float z[8] = {v0[0], v0[1], v0[2], v0[3], v1[0], v1[1], v1[2], v1[3]};
                    if (seg == 0) {
#pragma unroll
                        for (int j = 0; j < 8; ++j) z[j] = z[j] * sigm(z[j]);
                        u32x4 w; w.x = cvt_pk_bf16(z[0], z[1]); w.y = cvt_pk_bf16(z[2], z[3]); w.z = cvt_pk_bf16(z[4], z[5]); w.w = cvt_pk_bf16(z[6], z[7]);
                        st16(QQ + off, w);
                    } else if (seg == 1) {
                        float lf[8], kk[8];
#pragma unroll
                        for (int j = 0; j < 8; ++j) { const float e = __expf(-z[j]); const float sg = 1.0f / (1.0f + e); const float sgn = e / (1.0f + e);
                            lf[j] = __logf(lb[j] + (1.0f - lb[j]) * sg); kk[j] = (1.0f - lb[j]) * sgn; }
                        { u32x4 w; w.x = pk_h2(lf[0], lf[1]); w.y = pk_h2(lf[2], lf[3]); w.z = pk_h2(lf[4], lf[5]); w.w = pk_h2(lf[6], lf[7]); st16(LF + off, w); }
                        u32x4 w; w.x = cvt_pk_bf16(kk[0], kk[1]); w.y = cvt_pk_bf16(kk[2], kk[3]); w.z = cvt_pk_bf16(kk[4], kk[5]); w.w = cvt_pk_bf16(kk[6], kk[7]);
                        st16(KK + off, w);
                    } else if (seg == 2) {
                        u32x4 w; w.x = cvt_pk_bf16(z[0], z[1]); w.y = cvt_pk_bf16(z[2], z[3]); w.z = cvt_pk_bf16(z[4], z[5]); w.w = cvt_pk_bf16(z[6], z[7]);
                        st16(VV + off, w);
                    } else if (seg == 3) {
#pragma unroll
                        for (int j = 0; j < 8; ++j) z[j] = sigm(z[j]);
                        u32x4 w; w.x = cvt_pk_bf16(z[0], z[1]); w.y = cvt_pk_bf16(z[2], z[3]); w.z = cvt_pk_bf16(z[4], z[5]); w.w = cvt_pk_bf16(z[6], z[7]);
                        st16(GG + off, w);
                    } else {
                        u32x4 w; w.x = pk_h2(z[0], z[1]); w.y = pk_h2(z[2], z[3]); w.z = pk_h2(z[4], z[5]); w.w = pk_h2(z[6], z[7]); st16(UU + off, w);
                    }
                }
        }
    }
};

struct EpiMemKV {
    static constexpr bool PERM = true, AFTER_DRAIN = false;
    float *outK, *outV; bf16_t* KB;
    __device__ __forceinline__ void operator()(const f32x4 (&acc)[2][2][4][2], const Unit& u, int wr, int wc, int fr, int fq) const {
        const bool isk = u.pn < 4; float* o = isk ? outK : outV; const int colt = (u.pn & 3) * 256;
        const int row0 = u.pm * BM + wr * 64 + fr;
#pragma unroll
        for (int ai = 0; ai < 2; ++ai)
#pragma unroll
            for (int m = 0; m < 4; ++m)
#pragma unroll
                for (int bj = 0; bj < 2; ++bj) {
                    const size_t off = (size_t)(row0 + ai * HALF + m * 16) * 1024 + colt + bj * HALF + wc * 32 + 8 * fq;
                    const f32x4 v0 = acc[ai][bj][m][0], v1 = acc[ai][bj][m][1];
                    *(f32x4*)(o + off) = v0; *(f32x4*)(o + off + 4) = v1;
                    if (isk) { u32x4 w; w.x = cvt_pk_bf16(v0[0], v0[1]); w.y = cvt_pk_bf16(v0[2], v0[3]); w.z = cvt_pk_bf16(v1[0], v1[1]); w.w = cvt_pk_bf16(v1[2], v1[3]); *(u32x4*)(KB + off) = w; }
                }
    }
};

struct EpiBf16Scale {
    static constexpr bool PERM = true, AFTER_DRAIN = false;
    bf16_t* O; int ldc; const float* ss; float scale;
    __device__ __forceinline__ void operator()(const f32x4 (&acc)[2][2][4][2], const Unit& u, int wr, int wc, int fr, int fq) const {
        const int row0 = u.pm * BM + wr * 64 + fr;
        float ssv[2][4];
#pragma unroll
        for (int ai = 0; ai < 2; ++ai)
#pragma unroll
            for (int m = 0; m < 4; ++m) ssv[ai][m] = ss ? ss[row0 + ai * HALF + m * 16] : 0.f;
#pragma unroll
        for (int ai = 0; ai < 2; ++ai)
#pragma unroll
            for (int m = 0; m < 4; ++m) {
                const int row = row0 + ai * HALF + m * 16;
                const float sc = ss ? scale * __builtin_amdgcn_rsqf(ssv[ai][m] * (1.0f / 1024.0f) + RMS_EPS) : scale;
#pragma unroll
                for (int bj = 0; bj < 2; ++bj) {
                    const size_t off = (size_t)row * ldc + u.pn * BM + bj * HALF + wc * 32 + 8 * fq;
                    const f32x4 v0 = acc[ai][bj][m][0] * sc, v1 = acc[ai][bj][m][1] * sc;
                    u32x4 w; w.x = cvt_pk_bf16(v0[0], v0[1]); w.y = cvt_pk_bf16(v0[2], v0[3]); w.z = cvt_pk_bf16(v1[0], v1[1]); w.w = cvt_pk_bf16(v1[2], v1[3]);
                    st16(O + off, w);
                }
            }
    }
};

struct EpiResid {
    static constexpr bool PERM = true, AFTER_DRAIN = false;
    const float* baseF;
    const bf16_t* baseB;
    float* out;
    bf16_t* outb;
    float* ss;
    __device__ __forceinline__ void operator()(const f32x4 (&acc)[2][2][4][2], const Unit& u, int wr, int wc, int fr, int fq) const {
        const int row0 = u.pm * BM + wr * 64 + fr;
#pragma unroll
        for (int ai = 0; ai < 2; ++ai) {
            f32x4 pre[4][2][2];
            if (baseF) {
#pragma unroll
                for (int m = 0; m < 4; ++m) { const float* bp = baseF + (size_t)(row0 + ai * HALF + m * 16) * 1024;
#pragma unroll
                    for (int bj = 0; bj < 2; ++bj) { const int col = u.pn * BM + bj * HALF + wc * 32 + 8 * fq; pre[m][bj][0] = __builtin_nontemporal_load((const f32x4*)(bp + col)); pre[m][bj][1] = __builtin_nontemporal_load((const f32x4*)(bp + col + 4)); } }
            } else {
                u32x4 pb[4][2];
#pragma unroll
                for (int m = 0; m < 4; ++m) { const bf16_t* bp = baseB + (size_t)(row0 + ai * HALF + m * 16) * 1024;
#pragma unroll
                    for (int bj = 0; bj < 2; ++bj) pb[m][bj] = *(const u32x4*)(bp + u.pn * BM + bj * HALF + wc * 32 + 8 * fq); }
#pragma unroll
                for (int m = 0; m < 4; ++m)
#pragma unroll
                    for (int bj = 0; bj < 2; ++bj) { const u32x4 p = pb[m][bj];
                        pre[m][bj][0] = (f32x4){__uint_as_float(p.x << 16), __uint_as_float(p.x & 0xffff0000u), __uint_as_float(p.y << 16), __uint_as_float(p.y & 0xffff0000u)};
                        pre[m][bj][1] = (f32x4){__uint_as_float(p.z << 16), __uint_as_float(p.z & 0xffff0000u), __uint_as_float(p.w << 16), __uint_as_float(p.w & 0xffff0000u)}; }
            }
#pragma unroll
            for (int m = 0; m < 4; ++m) {
                const int row = row0 + ai * HALF + m * 16;
                float s = 0.f;
#pragma unroll
                for (int bj = 0; bj < 2; ++bj) {
                    const int col = u.pn * BM + bj * HALF + wc * 32 + 8 * fq;
                    const f32x4 v0 = acc[ai][bj][m][0] + pre[m][bj][0], v1 = acc[ai][bj][m][1] + pre[m][bj][1];
                    s += (v0[0] * v0[0] + v0[1] * v0[1]) + (v0[2] * v0[2] + v0[3] * v0[3]) + (v1[0] * v1[0] + v1[1] * v1[1]) + (v1[2] * v1[2] + v1[3] * v1[3]);
                    if (out) { *(f32x4*)(out + (size_t)row * 1024 + col) = v0; *(f32x4*)(out + (size_t)row * 1024 + col + 4) = v1; }
                    if (outb) { u32x4 w; w.x = cvt_pk_bf16(v0[0], v0[1]); w.y = cvt_pk_bf16(v0[2], v0[3]); w.z = cvt_pk_bf16(v1[0], v1[1]); w.w = cvt_pk_bf16(v1[2], v1[3]); st16(outb + (size_t)row * 1024 + col, w); }
                }
                s += __shfl_xor(s, 16); s += __shfl_xor(s, 32);
                if (fq == 0) atomicAdd(ss + row, s);
            }
        }
    }
};

struct EpiResidNorm {
    static constexpr bool PERM = true, AFTER_DRAIN = true;
    const bf16_t* baseB; float* out; float* ss; unsigned* cnt; const float* gfin;
    __device__ __forceinline__ void fused(f32x4 (&acc)[2][2][4][2], const Unit& u, int wr, int wc, int fr, int fq, PG8_LAS unsigned char* lds, int wid, int lane) const {
        const int row0 = u.pm * BM + wr * 64 + fr;
#pragma unroll
        for (int ai = 0; ai < 2; ++ai) {
            u32x4 pb[4][2];
#pragma unroll
            for (int m = 0; m < 4; ++m) { const bf16_t* bp = baseB + (size_t)(row0 + ai * HALF + m * 16) * 1024;
#pragma unroll
                for (int bj = 0; bj < 2; ++bj) pb[m][bj] = *(const u32x4*)(bp + u.pn * BM + bj * HALF + wc * 32 + 8 * fq); }
#pragma unroll
            for (int m = 0; m < 4; ++m) { float s = 0.f;
#pragma unroll
                for (int bj = 0; bj < 2; ++bj) { const u32x4 p = pb[m][bj];
                    const f32x4 v0 = acc[ai][bj][m][0] + (f32x4){__uint_as_float(p.x << 16), __uint_as_float(p.x & 0xffff0000u), __uint_as_float(p.y << 16), __uint_as_float(p.y & 0xffff0000u)};
                    const f32x4 v1 = acc[ai][bj][m][1] + (f32x4){__uint_as_float(p.z << 16), __uint_as_float(p.z & 0xffff0000u), __uint_as_float(p.w << 16), __uint_as_float(p.w & 0xffff0000u)};
                    acc[ai][bj][m][0] = v0; acc[ai][bj][m][1] = v1;
                    s += (v0[0] * v0[0] + v0[1] * v0[1]) + (v0[2] * v0[2] + v0[3] * v0[3]) + (v1[0] * v1[0] + v1[1] * v1[1]) + (v1[2] * v1[2] + v1[3] * v1[3]); }
                s += __shfl_xor(s, 16); s += __shfl_xor(s, 32);
                if (fq == 0) atomicAdd(ss + row0 + ai * HALF + m * 16, s); }
        }
        asm volatile("s_waitcnt vmcnt(0)" ::: "memory");
        __syncthreads();
        if (threadIdx.x == 0) { unsigned* c = cnt + 64 * u.pm;
            __hip_atomic_fetch_add(c, 1u, __ATOMIC_RELEASE, __HIP_MEMORY_SCOPE_AGENT);
            unsigned sp = 0u; while (__hip_atomic_load(c, __ATOMIC_RELAXED, __HIP_MEMORY_SCOPE_AGENT) < 4u) { __builtin_amdgcn_s_sleep(2); if (++sp > (1u << 22)) break; }
            __builtin_amdgcn_fence(__ATOMIC_ACQUIRE, "agent"); }
        __syncthreads();
        float rs[2][4];
#pragma unroll
        for (int ai = 0; ai < 2; ++ai)
#pragma unroll
            for (int m = 0; m < 4; ++m) rs[ai][m] = __hip_atomic_load(ss + row0 + ai * HALF + m * 16, __ATOMIC_RELAXED, __HIP_MEMORY_SCOPE_AGENT);
        f32x4 gv[2][2];
#pragma unroll
        for (int bj = 0; bj < 2; ++bj) { const int col = u.pn * BM + bj * HALF + wc * 32 + 8 * fq; gv[bj][0] = *(const f32x4*)(gfin + col); gv[bj][1] = *(const f32x4*)(gfin + col + 4); }
#pragma unroll
        for (int ai = 0; ai < 2; ++ai)
#pragma unroll
            for (int m = 0; m < 4; ++m) { const int row = row0 + ai * HALF + m * 16; const float rstd = 1.0f / sqrtf(rs[ai][m] * (1.0f / 1024.0f) + RMS_EPS);
#pragma unroll
                for (int bj = 0; bj < 2; ++bj) { const int col = u.pn * BM + bj * HALF + wc * 32 + 8 * fq;
                    *(f32x4*)(out + (size_t)row * 1024 + col) = acc[ai][bj][m][0] * rstd * gv[bj][0]; *(f32x4*)(out + (size_t)row * 1024 + col + 4) = acc[ai][bj][m][1] * rstd * gv[bj][1]; } }
    }
};

struct EpiSwiGLU {
    static constexpr bool PERM = true, AFTER_DRAIN = false;
    bf16_t* ACT; const float* ss;
    __device__ __forceinline__ void operator()(const f32x4 (&acc)[2][2][4][2], const Unit& u, int wr, int wc, int fr, int fq) const {
        const int row0 = u.pm * BM + wr * 64 + fr;
        float ssv[2][4];
#pragma unroll
        for (int ai = 0; ai < 2; ++ai)
#pragma unroll
            for (int m = 0; m < 4; ++m) ssv[ai][m] = ss[row0 + ai * HALF + m * 16];
#pragma unroll
        for (int ai = 0; ai < 2; ++ai)
#pragma unroll
            for (int m = 0; m < 4; ++m) {
                const int row = row0 + ai * HALF + m * 16;
                const float r = __builtin_amdgcn_rsqf(ssv[ai][m] * (1.0f / 1024.0f) + RMS_EPS);
#pragma unroll
                for (int bj = 0; bj < 2; ++bj) {
                    const int J = u.pn * 128 + bj * 64 + wc * 16 + 4 * fq;
                    const f32x4 a = acc[ai][bj][m][0] * r, b = acc[ai][bj][m][1] * r;
                    float o[4];
#pragma unroll
                    for (int j = 0; j < 4; ++j) o[j] = a[j] * sigm(a[j]) * b[j];
                    u32x2 w; w.x = cvt_pk_bf16(o[0], o[1]); w.y = cvt_pk_bf16(o[2], o[3]);
                    st8(ACT + (size_t)row * 2816 + J, w);
                }
            }
    }
};

template <class Epi, class Sched, bool ALIGN_EPI = false, bool SP2 = false>
__device__ __forceinline__ void gemm_phase(PG8_LAS unsigned char* lds, const Gemm g, const Sched& S, const Epi& E) {
    const int tid = threadIdx.x, wid = __builtin_amdgcn_readfirstlane(tid >> 6), lane = tid & 63, wr = wid >> 2, wc = wid & 3, fr = lane & 15, fq = lane >> 4;
    const int K = g.K, nt = K / BK;
    unsigned voffA[2], voffB[2];
#pragma unroll
    for (int i = 0; i < 2; ++i) { int R, C; stage_rc(tid * 16 + i * 8192, R, C); const int Rb = Epi::PERM ? ((R & ~31) + perm32(R & 31)) : R;
        voffA[i] = (unsigned)(R * K + C) * 2u; voffB[i] = (unsigned)(Rb * K + C) * 2u; }
    const size_t kstep = (size_t)(BK * 2);
    const size_t hstep = (size_t)HALF * K * 2;
    const size_t tstep = 2 * hstep;
    const unsigned ldsw = (unsigned)wid * 1024u;
    const int aoff = lds_byte(wr * 64 + fr, fq * 8), boff = lds_byte(wc * 32 + fr, fq * 8);
#define PG8_SA(b, h) (((b) * 2 + (h)) * HTB)
#define PG8_SB(b, h) ((4 + (b) * 2 + (h)) * HTB)
#define PG8_STAGE(bufoff, gbase, voff) do { _Pragma("unroll") for (int _i = 0; _i < 2; ++_i) \
        __builtin_amdgcn_global_load_lds((const unsigned*)((const char*)(gbase) + (voff)[_i]), (PG8_LAS unsigned*)(lds + (bufoff) + ldsw + _i * 8192), 16, 0, 0); } while (0)
#define PG8_LDA(dst, b, h) do { _Pragma("unroll") for (int m = 0; m < 4; ++m) _Pragma("unroll") for (int k = 0; k < 2; ++k) dst[m][k] = *(const PG8_LAS bf16x8*)(lds + PG8_SA(b, h) + aoff + m * 2048 + k * 1024); } while (0)
#define PG8_LDB(dst, b, h) do { _Pragma("unroll") for (int n = 0; n < 2; ++n) _Pragma("unroll") for (int k = 0; k < 2; ++k) dst[n][k] = *(const PG8_LAS bf16x8*)(lds + PG8_SB(b, h) + boff + n * 2048 + k * 1024); } while (0)
#define PG8_MMA(ai, bj, At, Bt) do { __builtin_amdgcn_s_setprio(1); _Pragma("unroll") for (int m = 0; m < 4; ++m) _Pragma("unroll") for (int n = 0; n < 2; ++n) _Pragma("unroll") for (int k = 0; k < 2; ++k) \
        acc[ai][bj][m][n] = __builtin_amdgcn_mfma_f32_16x16x32_bf16(Bt[n][k], At[m][k], acc[ai][bj][m][n], 0, 0, 0); __builtin_amdgcn_s_setprio(0); } while (0)
#define PG8_WAIT_V(n) asm volatile("s_waitcnt vmcnt(" #n ")" ::: "memory")
#define PG8_WAIT_L(n) asm volatile("s_waitcnt lgkmcnt(" #n ")" ::: "memory")
#define PG8_BAR __builtin_amdgcn_s_barrier()
#define PG8_SCHED __builtin_amdgcn_sched_barrier(0)
    Unit cur, nxt; int ui = 0;
    if (!S.next(0, cur)) return;
    f32x4 acc[2][2][4][2];
#pragma unroll
    for (int a = 0; a < 2; ++a)
#pragma unroll
        for (int b = 0; b < 2; ++b)
#pragma unroll
            for (int m = 0; m < 4; ++m)
#pragma unroll
                for (int n = 0; n < 2; ++n) acc[a][b][m][n] = (f32x4){0.f, 0.f, 0.f, 0.f};
    bf16x8 At[4][2], B0[2][2], B1[2][2];
    const char* cA = (const char*)g.A + (size_t)cur.pm * tstep; const char* cB = (const char*)g.Bt + (size_t)cur.pn * tstep;
    S.a_ready(cur);
    if constexpr (SP2) {
        PG8_STAGE(PG8_SB(0, 0), cB, voffB); PG8_STAGE(PG8_SB(0, 1), cB + hstep, voffB); PG8_STAGE(PG8_SA(0, 0), cA, voffA); PG8_STAGE(PG8_SA(0, 1), cA + hstep, voffA);
        if (wr == 1) PG8_BAR;
        PG8_WAIT_V(2); PG8_BAR;
        PG8_STAGE(PG8_SB(1, 0), cB + kstep, voffB); PG8_STAGE(PG8_SA(1, 0), cA + kstep, voffA); PG8_STAGE(PG8_SB(1, 1), cB + hstep + kstep, voffB);
        PG8_WAIT_V(6); PG8_BAR;
    } else {
        PG8_STAGE(PG8_SB(0, 0), cB, voffB); PG8_STAGE(PG8_SA(0, 0), cA, voffA); PG8_STAGE(PG8_SB(0, 1), cB + hstep, voffB); PG8_STAGE(PG8_SA(0, 1), cA + hstep, voffA);
        if (wr == 1) PG8_BAR;
        PG8_WAIT_V(4); PG8_BAR;
        PG8_STAGE(PG8_SB(1, 0), cB + kstep, voffB); PG8_STAGE(PG8_SA(1, 0), cA + kstep, voffA); PG8_STAGE(PG8_SB(1, 1), cB + hstep + kstep, voffB);
        PG8_WAIT_V(6); PG8_BAR;
    }
    for (;;) {
        const bool has_next = S.next(ui + 1, nxt);
        const char* nA = has_next ? (const char*)g.A + (size_t)nxt.pm * tstep : cA; const char* nB = has_next ? (const char*)g.Bt + (size_t)nxt.pn * tstep : cB;
        for (int t = 0; t < nt; t += 2) {
            const bool last = (t == nt - 2);
            const char* a1 = cA + (size_t)(t + 1) * kstep;
            const char* a2 = last ? nA : cA + (size_t)(t + 2) * kstep; const char* b2 = last ? nB : cB + (size_t)(t + 2) * kstep;
            const char* a3 = a2 + kstep; const char* b3 = b2 + kstep;
            if (last && has_next) S.a_ready(nxt);
            if constexpr (SP2) {
            PG8_LDB(B0, 0, 0); PG8_LDB(B1, 0, 1); PG8_SCHED; PG8_LDA(At, 0, 0); PG8_STAGE(PG8_SA(1, 1), a1 + hstep, voffA);
            PG8_WAIT_V(8); PG8_WAIT_L(0); PG8_BAR; PG8_MMA(0, 0, At, B0); PG8_MMA(0, 1, At, B1); PG8_BAR; PG8_SCHED;
            PG8_LDA(At, 0, 1); PG8_STAGE(PG8_SB(0, 0), b2, voffB); PG8_STAGE(PG8_SB(0, 1), b2 + hstep, voffB); PG8_STAGE(PG8_SA(0, 0), a2, voffA);
            PG8_WAIT_V(8); PG8_WAIT_L(0); PG8_BAR; PG8_MMA(1, 0, At, B0); PG8_MMA(1, 1, At, B1); PG8_BAR; PG8_SCHED;
            PG8_LDB(B0, 1, 0); PG8_LDB(B1, 1, 1); PG8_SCHED; PG8_LDA(At, 1, 0); PG8_STAGE(PG8_SA(0, 1), a2 + hstep, voffA);
            PG8_WAIT_V(8); PG8_WAIT_L(0); PG8_BAR; PG8_MMA(0, 0, At, B0); PG8_MMA(0, 1, At, B1); PG8_BAR; PG8_SCHED;
            PG8_LDA(At, 1, 1); PG8_STAGE(PG8_SB(1, 0), b3, voffB); PG8_STAGE(PG8_SB(1, 1), b3 + hstep, voffB); PG8_STAGE(PG8_SA(1, 0), a3, voffA);
            PG8_WAIT_V(8); PG8_WAIT_L(0); PG8_BAR; PG8_MMA(1, 0, At, B0); PG8_MMA(1, 1, At, B1); PG8_BAR; PG8_SCHED;
            } else {
            PG8_LDB(B0, 0, 0); PG8_SCHED; PG8_LDA(At, 0, 0); PG8_STAGE(PG8_SA(1, 1), a1 + hstep, voffA);
            PG8_WAIT_L(8); PG8_BAR; PG8_WAIT_L(0); PG8_MMA(0, 0, At, B0); PG8_BAR; PG8_SCHED;
            PG8_LDB(B1, 0, 1); PG8_STAGE(PG8_SB(0, 0), b2, voffB);
            PG8_BAR; PG8_WAIT_L(0); PG8_MMA(0, 1, At, B1); PG8_BAR;
            PG8_LDA(At, 0, 1); PG8_STAGE(PG8_SA(0, 0), a2, voffA);
            PG8_BAR; PG8_WAIT_L(0); PG8_MMA(1, 0, At, B0); PG8_BAR; PG8_SCHED;
            PG8_STAGE(PG8_SB(0, 1), b2 + hstep, voffB);
            PG8_WAIT_V(6); PG8_BAR; PG8_MMA(1, 1, At, B1); PG8_BAR;
            PG8_LDB(B0, 1, 0); PG8_SCHED; PG8_LDA(At, 1, 0); PG8_STAGE(PG8_SA(0, 1), a2 + hstep, voffA);
            PG8_WAIT_L(8); PG8_BAR; PG8_WAIT_L(0); PG8_MMA(0, 0, At, B0); PG8_BAR; PG8_SCHED;
            PG8_LDB(B1, 1, 1); PG8_STAGE(PG8_SB(1, 0), b3, voffB);
            PG8_BAR; PG8_WAIT_L(0); PG8_MMA(0, 1, At, B1); PG8_BAR;
            PG8_LDA(At, 1, 1); PG8_STAGE(PG8_SA(1, 0), a3, voffA);
            PG8_BAR; PG8_WAIT_L(0); PG8_MMA(1, 0, At, B0); PG8_BAR; PG8_SCHED;
            PG8_STAGE(PG8_SB(1, 1), b3 + hstep, voffB);
            PG8_WAIT_V(6); PG8_BAR; PG8_MMA(1, 1, At, B1); PG8_BAR;
            }
        }
        if constexpr (ALIGN_EPI) { if (wr == 0) PG8_BAR; }
        if constexpr (!Epi::AFTER_DRAIN) { E(acc, cur, wr, wc, fr, fq); S.done(cur); }
        if (!has_next) break;
#pragma unroll
        for (int a = 0; a < 2; ++a)
#pragma unroll
            for (int b = 0; b < 2; ++b)
#pragma unroll
                for (int m = 0; m < 4; ++m)
#pragma unroll
                    for (int n = 0; n < 2; ++n) acc[a][b][m][n] = (f32x4){0.f, 0.f, 0.f, 0.f};
        cur = nxt; cA = nA; cB = nB; ++ui;
        if constexpr (ALIGN_EPI) { if (wr == 1) PG8_BAR; }
    }
    PG8_WAIT_V(0);
    if constexpr (!ALIGN_EPI) { if (wr == 0) PG8_BAR; }
    PG8_BAR;
    if constexpr (Epi::AFTER_DRAIN) { E.fused(acc, cur, wr, wc, fr, fq, lds, wid, lane); S.done(cur); }
#undef PG8_SA
#undef PG8_SB
#undef PG8_STAGE
#undef PG8_LDA
#undef PG8_LDB
#undef PG8_MMA
#undef PG8_WAIT_V
#undef PG8_WAIT_L
#undef PG8_BAR
#undef PG8_SCHED
}
}
#define LAS __attribute__((address_space(3)))
#define XB_TMO      128
#define XB_XCNT(j)  (256  + 64 * (j))
#define XB_XSUB(j)  (1280 + 64 * (j))
#define XB_XGEN(j)  (2304 + 64 * (j))
#define XB_TOP      3328
#define XB_TOPGEN   3392
#define XCD_BAR_WORDS 3456
#define XB_SPIN_CAP (1u << 18)

__device__ __forceinline__ unsigned xb_ld(unsigned* p)              { return __hip_atomic_load(p, __ATOMIC_RELAXED, __HIP_MEMORY_SCOPE_AGENT); }
__device__ __forceinline__ unsigned xb_add(unsigned* p, unsigned v) { return __hip_atomic_fetch_add(p, v, __ATOMIC_RELAXED, __HIP_MEMORY_SCOPE_AGENT); }
__device__ __forceinline__ unsigned xb_xcc_id() { return (unsigned)__builtin_amdgcn_s_getreg((3 << 11) | 20) & 0xFu; }
#define XB_SPIN(cond, bar) do { unsigned _sp = 0; while (cond) { __builtin_amdgcn_s_sleep(1); \
    if ((++_sp & 255u) == 0u) { if (xb_ld(&(bar)[XB_TMO])) break; if (_sp > XB_SPIN_CAP) { atomicAdd(&(bar)[XB_TMO], 1u); break; } } } } while (0)

struct XcdBarrier {
    unsigned* bar; unsigned x;
    volatile LAS unsigned* st;
};

__device__ __forceinline__ XcdBarrier xcd_barrier_post(unsigned* bar, volatile LAS unsigned* st) {
    XcdBarrier b; b.bar = bar; b.x = xb_xcc_id(); b.st = st;
    if (threadIdx.x == 0) (void)xb_add(&bar[XB_XCNT(b.x)], 1u);
    return b;
}
__device__ __forceinline__ void xcd_barrier_complete(unsigned* bar, unsigned x, unsigned& nloc, unsigned& nx) {
    const unsigned G = gridDim.x * gridDim.y * gridDim.z;
    unsigned sum, cnt, mine, sp = 0u;
    for (;;) {
        sum = 0u; cnt = 0u; mine = 0u;
#pragma unroll
        for (unsigned j = 0; j < 16; ++j) { const unsigned c = xb_ld(&bar[XB_XCNT(j)]); sum += c; cnt += (c > 0u) ? 1u : 0u; mine = (j == x) ? c : mine; }
        if (sum == G) break;
        __builtin_amdgcn_s_sleep(1);
        if ((++sp & 255u) == 0u) { if (xb_ld(&bar[XB_TMO])) break; if (sp > XB_SPIN_CAP) { atomicAdd(&bar[XB_TMO], 1u); break; } }
    }
    nloc = mine > 0u ? mine : 1u; nx = cnt > 0u ? cnt : 1u;
}

__device__ __forceinline__ void xcd_barrier(const XcdBarrier& b) {
    asm volatile("s_waitcnt vmcnt(0)" ::: "memory");
    __syncthreads();
    if (threadIdx.x == 0) {
        unsigned* bar = b.bar;
        __builtin_amdgcn_s_waitcnt(0);
        unsigned nloc = b.st[0], nx = b.st[1];
        if (nloc == 0u) { xcd_barrier_complete(bar, b.x, nloc, nx); b.st[0] = nloc; b.st[1] = nx; }
        const unsigned old = xb_add(&bar[XB_XSUB(b.x)], 1u);
        const unsigned gen = old / nloc;
        if (old + 1u == (gen + 1u) * nloc) {
            __builtin_amdgcn_fence(__ATOMIC_RELEASE, "agent");
            asm volatile("s_waitcnt vmcnt(0)" ::: "memory");
            const unsigned og = xb_add(&bar[XB_TOP], 1u);
            const unsigned tg = og / nx;
            if (og + 1u == (tg + 1u) * nx) xb_add(&bar[XB_TOPGEN], 1u);
            else XB_SPIN(xb_ld(&bar[XB_TOPGEN]) == tg, bar);
            __builtin_amdgcn_fence(__ATOMIC_ACQUIRE, "agent");
            xb_add(&bar[XB_XGEN(b.x)], 1u);
            asm volatile("s_waitcnt vmcnt(0)" ::: "memory");
        } else {
            XB_SPIN(xb_ld(&bar[XB_XGEN(b.x)]) == gen, bar);
            __builtin_amdgcn_fence(__ATOMIC_ACQUIRE, "agent");
            asm volatile("s_waitcnt vmcnt(0)" ::: "memory");
        }
    }
    __syncthreads();
}

using pg8::bf16_t; using pg8::f32x4; using pg8::u32x4; using pg8::bf16x8; using pg8::pk_h2; using pg8::h_lo; using pg8::h_hi;
typedef unsigned u32x2v __attribute__((ext_vector_type(2)));
constexpr int DM = 1024, NPR = 16384, NSM = 128, MT = 16640, NVALID = 16512, SEQ = 2048;
constexpr int HW = 512, NIN = 2560, DFF = 2816, NFF2 = 5632, MEMR = 2048;
constexpr float EPS = 1e-6f;
constexpr int NTHREADS = 512;
constexpr int LDS_BYTES = 147456;

constexpr size_t O_YP = 0, O_YS = 16777216, O_HP = 16908288, O_PP = 17432576, O_MK = 17494016, O_MV = 19591168, O_HS = 21688320, O_PS = 30076928;

constexpr size_t MiB = 1u << 20;
constexpr size_t WS_SS1 = 0, WS_SS2 = 128 * 1024, WS_SS3 = 256 * 1024, WS_BAR = 512 * 1024, BAR_BYTES = 65536, WS_SSD = 384 * 1024, WS_CNT = WS_BAR + 16384;
constexpr size_t WS_WIN = 1 * MiB, WS_WOUT = 6 * MiB, WS_WCQ = 8 * MiB, WS_WCO = 10 * MiB, WS_WFFI = 12 * MiB, WS_WFFO = 23 * MiB, WS_WKV = 29 * MiB, WS_PMIX = 33 * MiB;
constexpr size_t WS_MEMH = 34 * MiB, WS_KB = 38 * MiB, WS_VT = 42 * MiB, WS_DEC = 46 * MiB;
constexpr size_t WS_H0 = 47 * MiB;
constexpr size_t WS_MIX = 80 * MiB;
constexpr size_t WS_X1 = 113 * MiB;
constexpr size_t WS_Q = 178 * MiB;
constexpr size_t WS_O = 211 * MiB;
constexpr size_t WS_SL = 244 * MiB;
constexpr size_t WS_A = 309 * MiB;
constexpr size_t WS_QQ = WS_A, WS_KK = WS_A + 17 * MiB, WS_VV = WS_A + 34 * MiB, WS_GG = WS_A + 51 * MiB, WS_LF = WS_A + 68 * MiB, WS_UU = WS_A + 101 * MiB;
constexpr size_t WS_END = 443 * MiB;

struct Args { const float* in[23]; float* out; unsigned char* ws; int ph_lo, ph_hi; };

__device__ __forceinline__ unsigned f2bf(float f) { unsigned u = __builtin_bit_cast(unsigned, f); return (u + 0x7fffu + ((u >> 16) & 1u)) >> 16; }
__device__ __forceinline__ unsigned pk2(float lo, float hi) { return f2bf(lo) | (f2bf(hi) << 16); }
__device__ __forceinline__ float bf2f(unsigned h) { return __uint_as_float(h << 16); }
__device__ __forceinline__ float bfe(const u32x4& v, int j) { const unsigned w = v[j >> 1]; return (j & 1) ? __uint_as_float(w & 0xffff0000u) : __uint_as_float(w << 16); }
__device__ __forceinline__ unsigned short bfr(const u32x4& v, int j) { const unsigned w = v[j >> 1]; return (unsigned short)((j & 1) ? (w >> 16) : (w & 0xffffu)); }
__device__ __forceinline__ float wave_sum(float v) {
#pragma unroll
    for (int o = 1; o < 64; o <<= 1) v += __shfl_xor(v, o);
    return v;
}
#define MFMA16(a, b, c) __builtin_amdgcn_mfma_f32_16x16x32_bf16((a), (b), (c), 0, 0, 0)

template <int MODE>
__device__ __forceinline__ void tr_item(const float* W, int K, int N, bf16_t* WT, const float* gk, float* scr, int item, int lane) {
    const int nblk = N / 32, kb = item / nblk, nb = item % nblk, k0 = 64 * kb, n0 = 32 * nb;
    f32x4 wv[8];
#pragma unroll
    for (int i = 0; i < 8; ++i) { const int kk = 8 * i + (lane >> 3); wv[i] = __builtin_nontemporal_load((const f32x4*)(W + (size_t)(k0 + kk) * N + n0 + (lane & 7) * 4)); }
#pragma unroll
    for (int i = 0; i < 8; ++i) { const int kk = 8 * i + (lane >> 3); float* d = scr + kk * 33 + (lane & 7) * 4; d[0] = wv[i][0]; d[1] = wv[i][1]; d[2] = wv[i][2]; d[3] = wv[i][3]; }
    asm volatile("s_waitcnt lgkmcnt(0)" ::: "memory");
    const int c = lane & 7;
    float g8[8];
#pragma unroll
    for (int i = 0; i < 8; ++i) g8[i] = gk ? gk[k0 + 8 * c + i] : 1.0f;
#pragma unroll
    for (int j = 0; j < 4; ++j) { const int n = (lane >> 3) + 8 * j; const float* s = scr + (8 * c) * 33 + n;
        u32x4 o; o.x = pk2(s[0 * 33] * g8[0], s[1 * 33] * g8[1]); o.y = pk2(s[2 * 33] * g8[2], s[3 * 33] * g8[3]); o.z = pk2(s[4 * 33] * g8[4], s[5 * 33] * g8[5]); o.w = pk2(s[6 * 33] * g8[6], s[7 * 33] * g8[7]);
        int row = n0 + n;
        if (MODE == 1) { const int half = row >= DFF ? 1 : 0; const int J = row - half * DFF;
            row = 256 * (J >> 7) + 128 * ((J >> 6) & 1) + 32 * ((J >> 4) & 3) + 8 * ((J >> 2) & 3) + 4 * half + (J & 3); }
        *(u32x4*)(WT + (size_t)row * K + k0 + 8 * c) = o; }
    asm volatile("s_waitcnt lgkmcnt(0)" ::: "memory");
}
__device__ __forceinline__ void rms_row_to_bf16(const float* xrow, const float* g, bf16_t* orow, int lane) {
    const f32x4* xr = (const f32x4*)xrow + lane; const f32x4* gr = (const f32x4*)g + lane;
    f32x4 v[4]; float s = 0.f;
#pragma unroll
    for (int j = 0; j < 4; ++j) { v[j] = xr[64 * j]; s += (v[j].x * v[j].x + v[j].y * v[j].y) + (v[j].z * v[j].z + v[j].w * v[j].w); }
    const float rstd = 1.0f / sqrtf(wave_sum(s) * (1.f / DM) + EPS);
    unsigned long long* o8 = (unsigned long long*)orow + lane;
#pragma unroll
    for (int j = 0; j < 4; ++j) { const f32x4 gg = gr[64 * j];
        o8[64 * j] = (unsigned long long)pk2(v[j].x * rstd * gg.x, v[j].y * rstd * gg.y) | ((unsigned long long)pk2(v[j].z * rstd * gg.z, v[j].w * rstd * gg.w) << 32); }
}
__device__ __forceinline__ void rms_row2_to_bf16(const float* xrow, const float* g, bf16_t* orow, int lane) {
    const f32x4* xr = (const f32x4*)xrow + lane; const f32x4* gr = (const f32x4*)g + lane;
    f32x4 v[2][4]; float s[2] = {0.f, 0.f};
#pragma unroll
    for (int r = 0; r < 2; ++r)
#pragma unroll
        for (int j = 0; j < 4; ++j) v[r][j] = __builtin_nontemporal_load(xr + r * 256 + 64 * j);
#pragma unroll
    for (int r = 0; r < 2; ++r)
#pragma unroll
        for (int j = 0; j < 4; ++j) s[r] += (v[r][j].x * v[r][j].x + v[r][j].y * v[r][j].y) + (v[r][j].z * v[r][j].z + v[r][j].w * v[r][j].w);
#pragma unroll
    for (int r = 0; r < 2; ++r) { const float rstd = 1.0f / sqrtf(wave_sum(s[r]) * (1.f / DM) + EPS); unsigned long long* o8 = (unsigned long long*)(orow + (size_t)r * DM) + lane;
#pragma unroll
        for (int j = 0; j < 4; ++j) { const f32x4 gg = gr[64 * j];
            o8[64 * j] = (unsigned long long)pk2(v[r][j].x * rstd * gg.x, v[r][j].y * rstd * gg.y) | ((unsigned long long)pk2(v[r][j].z * rstd * gg.z, v[r][j].w * rstd * gg.w) << 32); } }
}
__device__ __forceinline__ void p0_prologue(const Args& A, unsigned char* lds, int G) {
    const int tid = threadIdx.x, lane = tid & 63, wave = tid >> 6;
    float* scr = (float*)(lds + wave * 16384);
    unsigned char* ws = A.ws;
    const int gw = blockIdx.x * 8 + wave, NGW = G * 8;
    constexpr int I_IN = 16 * 80, I_OUT = 16 * 32, I_CQ = 16 * 32, I_CO = 16 * 32, I_FFI = 16 * 176, I_FFO = 44 * 32, I_KV = 16 * 64, I_PM = 4 * 8;
    constexpr int NITEMS = I_IN + I_OUT + I_CQ + I_CO + I_FFI + I_FFO + I_KV + I_PM;
    for (int it = gw; it < NITEMS; it += NGW) {
        int r = it;
        if (r < I_IN) { tr_item<0>(A.in[8], DM, NIN, (bf16_t*)(ws + WS_WIN), nullptr, scr, r, lane); continue; } r -= I_IN;
        if (r < I_OUT) { tr_item<0>(A.in[13], DM, DM, (bf16_t*)(ws + WS_WOUT), nullptr, scr, r, lane); continue; } r -= I_OUT;
        if (r < I_CQ) { tr_item<0>(A.in[17], DM, DM, (bf16_t*)(ws + WS_WCQ), A.in[16], scr, r, lane); continue; } r -= I_CQ;
        if (r < I_CO) { tr_item<0>(A.in[18], DM, DM, (bf16_t*)(ws + WS_WCO), nullptr, scr, r, lane); continue; } r -= I_CO;
        if (r < I_FFI) { tr_item<1>(A.in[20], DM, NFF2, (bf16_t*)(ws + WS_WFFI), A.in[19], scr, r, lane); continue; } r -= I_FFI;
        if (r < I_FFO) { tr_item<0>(A.in[21], DFF, DM, (bf16_t*)(ws + WS_WFFO), nullptr, scr, r, lane); continue; } r -= I_FFO;
        if (r < I_KV) { tr_item<0>(A.in[15], DM, 2 * DM, (bf16_t*)(ws + WS_WKV), nullptr, scr, r, lane); continue; } r -= I_KV;
        { const int g = r >> 3; tr_item<0>(A.in[11] + (size_t)g * 128 * 128, 128, 128, (bf16_t*)(ws + WS_PMIX) + (size_t)g * 128 * 128, nullptr, scr, r & 7, lane); }
    }
    bf16_t* H0 = (bf16_t*)(ws + WS_H0);
    for (int m = gw * 2; m < NVALID; m += NGW * 2) { const float* xr = m < NPR ? A.in[0] + (size_t)m * DM : A.in[1] + (size_t)(m - NPR) * DM; rms_row2_to_bf16(xr, A.in[7], H0 + (size_t)m * DM, lane); }
    bf16_t* MEMH = (bf16_t*)(ws + WS_MEMH);
    for (int m = gw; m < MEMR; m += NGW) rms_row_to_bf16(A.in[2] + (size_t)m * DM, A.in[14], MEMH + (size_t)m * DM, lane);
    const int gt = blockIdx.x * NTHREADS + tid, NGT = G * NTHREADS;
    for (int i = gt; i < (MT - NVALID) * DM / 8; i += NGT) { const u32x4 z = {0u, 0u, 0u, 0u};
        ((u32x4*)(ws + WS_H0) + (size_t)NVALID * DM / 8)[i] = z; ((u32x4*)(ws + WS_MIX) + (size_t)NVALID * DM / 8)[i] = z; ((u32x4*)(ws + WS_O) + (size_t)NVALID * DM / 8)[i] = z; }
    for (int i = gt; i < MT; i += NGT) { ((float*)(ws + WS_SS1))[i] = 0.f; ((float*)(ws + WS_SS2))[i] = 0.f; ((float*)(ws + WS_SS3))[i] = 0.f; }
}

constexpr int BS = 129;
constexpr int L_BC = 0, L_TOT = 33024, L_QM = 35072, L_KM = 52480, L_VT = 69888, L_SP = 88320, L_AL = 123136, L_PART = 132352, L_EM = 132864;
constexpr size_t WS_SPT = WS_X1;
__device__ __forceinline__ void hgrn_lf_load(u32x2v (&lf)[4], const unsigned short* LF, int R0, int C0, int t) {
#pragma unroll
    for (int i = 0; i < 4; ++i) { const int idx = i * 512 + t, s = idx >> 5, k4 = idx & 31; lf[i] = *(const u32x2v*)(LF + (size_t)(R0 + s) * HW + C0 + k4 * 4); }
}
__device__ __forceinline__ void hgrn_cumsum(const u32x2v (&lf)[4], float* Bc, float* tot, int t) {
#pragma unroll
    for (int i = 0; i < 4; ++i) { const int idx = i * 512 + t, s = idx >> 5, k4 = idx & 31; const u32x2v v = lf[i];
        float* d = Bc + s * BS + k4 * 4; d[0] = h_lo(v.x); d[1] = h_hi(v.x); d[2] = h_lo(v.y); d[3] = h_hi(v.y); }
    __syncthreads();
    const int seg = t >> 7, k = t & 127; float run = 0.f;
#pragma unroll
    for (int i = 0; i < 16; ++i) { run += Bc[(seg * 16 + i) * BS + k]; Bc[(seg * 16 + i) * BS + k] = run; }
    tot[seg * 128 + k] = run;
    __syncthreads();
    float off = 0.f;
#pragma unroll
    for (int j = 0; j < 3; ++j) off += (j < seg) ? tot[j * 128 + k] : 0.f;
#pragma unroll
    for (int i = 0; i < 16; ++i) Bc[(seg * 16 + i) * BS + k] += off;
    __syncthreads();
}
__device__ __forceinline__ void hgrn_local_load(const Args& A, int unit, u32x2v (&lf)[4], u32x4 (&kkr)[2], u32x4 (&vvr)[2]) {
    const int t = threadIdx.x, w = t >> 6, l = t & 63;
    const int bh = unit >> 5, c = unit & 31, b = bh >> 2, h = bh & 3, R0 = b * SEQ + c * 64, C0 = h * 128;
    const bf16_t* KK = (const bf16_t*)(A.ws + WS_KK); const bf16_t* VV = (const bf16_t*)(A.ws + WS_VV);
    hgrn_lf_load(lf, (const unsigned short*)(A.ws + WS_LF), R0, C0, t);
#pragma unroll
    for (int i = 0; i < 2; ++i) { const int k0 = (w + 8 * i) * 8; kkr[i] = *(const u32x4*)(KK + (size_t)(R0 + l) * HW + C0 + k0); vvr[i] = *(const u32x4*)(VV + (size_t)(R0 + l) * HW + C0 + k0); }
}
__device__ __forceinline__ void hgrn_local_unit(const Args& A, unsigned char* lds, int unit, int next, u32x2v (&lf)[4], u32x4 (&kkr)[2], u32x4 (&vvr)[2]) {
    const int t = threadIdx.x, w = t >> 6, l = t & 63, lr = l & 15, lq = l >> 4;
    const int bh = unit >> 5, c = unit & 31, b = bh >> 2, h = bh & 3, R0 = b * SEQ + c * 64, C0 = h * 128;
    unsigned char* ws = A.ws;
    float* Bc = (float*)(lds + L_BC); float* tot = (float*)(lds + L_TOT);
    bf16_t* kdT = (bf16_t*)(lds + L_QM); bf16_t* vT = (bf16_t*)(lds + L_VT);
    hgrn_cumsum(lf, Bc, tot, t);
#pragma unroll
    for (int i = 0; i < 2; ++i) { const int s = l, k0 = (w + 8 * i) * 8;
        const u32x4 kk = kkr[i], vv = vvr[i];
#pragma unroll
        for (int j = 0; j < 8; ++j) { const float e = __expf(Bc[63 * BS + k0 + j] - Bc[s * BS + k0 + j]);
            kdT[(k0 + j) * 72 + s] = (bf16_t)f2bf(bfe(kk, j) * e); vT[(k0 + j) * 72 + s] = bfr(vv, j); } }
    if (next >= 0) hgrn_local_load(A, next, lf, kkr, vvr);
    __syncthreads();
    f32x4 acc[8];
#pragma unroll
    for (int i = 0; i < 8; ++i) acc[i] = (f32x4){0.f, 0.f, 0.f, 0.f};
#pragma unroll
    for (int ks = 0; ks < 2; ++ks) { const bf16x8 a = *(const bf16x8*)(kdT + (16 * w + lr) * 72 + ks * 32 + lq * 8);
#pragma unroll
        for (int vt = 0; vt < 8; ++vt) { const bf16x8 bb = *(const bf16x8*)(vT + (16 * vt + lr) * 72 + ks * 32 + lq * 8); acc[vt] = MFMA16(a, bb, acc[vt]); } }
    unsigned short* SLT = (unsigned short*)(ws + WS_SL) + (size_t)unit * 16384;
#pragma unroll
    for (int vt = 0; vt < 8; ++vt) { u32x2v o; o.x = pk_h2(acc[vt][0], acc[vt][1]); o.y = pk_h2(acc[vt][2], acc[vt][3]); *(u32x2v*)(SLT + (16 * vt + lr) * 128 + 16 * w + lq * 4) = o; }
    if (t < 128) ((float*)(ws + WS_DEC))[unit * 128 + t] = __expf(Bc[63 * BS + t]);
    __syncthreads();
}
__device__ __forceinline__ void hgrn_out_load(const Args& A, int unit, u32x2v (&lf)[4], u32x4 (&qqr)[2], u32x4 (&kkr)[2], u32x4 (&vvr)[2], u32x4 (&spr)[4]) {
    const int t = threadIdx.x, w = t >> 6, l = t & 63;
    const int bh = unit >> 5, c = unit & 31, b = bh >> 2, h = bh & 3, R0 = b * SEQ + c * 64, C0 = h * 128;
    const bf16_t* QQ = (const bf16_t*)(A.ws + WS_QQ); const bf16_t* KK = (const bf16_t*)(A.ws + WS_KK); const bf16_t* VV = (const bf16_t*)(A.ws + WS_VV);
    hgrn_lf_load(lf, (const unsigned short*)(A.ws + WS_LF), R0, C0, t);
#pragma unroll
    for (int i = 0; i < 2; ++i) { const int idx = (i * 512 + t) * 8, s = idx >> 7, k0 = idx & 127; const size_t go = (size_t)(R0 + s) * HW + C0 + k0; qqr[i] = *(const u32x4*)(QQ + go); kkr[i] = *(const u32x4*)(KK + go);
        vvr[i] = *(const u32x4*)(VV + (size_t)(R0 + l) * HW + C0 + (w + 8 * i) * 8); }
    const bf16_t* SPT = (const bf16_t*)(A.ws + WS_SPT) + (size_t)unit * 16384;
#pragma unroll
    for (int i = 0; i < 4; ++i) { const int idx = i * 512 + t; spr[i] = *(const u32x4*)(SPT + (idx >> 4) * 128 + (idx & 15) * 8); }
}
__device__ __forceinline__ void hgrn_out_unit(const Args& A, unsigned char* lds, int unit, int next, u32x2v (&lf)[4], u32x4 (&qqr)[2], u32x4 (&kkr)[2], u32x4 (&vvr)[2], u32x4 (&spr)[4]) {
    const int t = threadIdx.x, w = t >> 6, l = t & 63, lr = l & 15, lq = l >> 4;
    const int bh = unit >> 5, c = unit & 31, b = bh >> 2, h = bh & 3, R0 = b * SEQ + c * 64, C0 = h * 128;
    unsigned char* ws = A.ws;
    float* Bc = (float*)(lds + L_BC); float* tot = (float*)(lds + L_TOT); float* part = (float*)(lds + L_PART); float* em = (float*)(lds + L_EM);
    bf16_t* qm = (bf16_t*)(lds + L_QM); bf16_t* km = (bf16_t*)(lds + L_KM); bf16_t* vT = (bf16_t*)(lds + L_VT); bf16_t* spT = (bf16_t*)(lds + L_SP); bf16_t* aL = (bf16_t*)(lds + L_AL);
    u32x4 ggr[2];
#pragma unroll
    for (int hh = 0; hh < 2; ++hh) ggr[hh] = *(const u32x4*)((const bf16_t*)(ws + WS_GG) + (size_t)(R0 + (t >> 3)) * HW + C0 + (t & 7) * 16 + hh * 8);
    hgrn_cumsum(lf, Bc, tot, t);
    if (t < 128) em[t] = __expf(Bc[31 * BS + t]);
#pragma unroll
    for (int i = 0; i < 2; ++i) { const int idx = (i * 512 + t) * 8, s = idx >> 7, k0 = idx & 127;
        const u32x4 qq = qqr[i], kk = kkr[i];
        float qv[8], kv[8];
#pragma unroll
        for (int j = 0; j < 8; ++j) { const float d = Bc[s * BS + k0 + j] - Bc[31 * BS + k0 + j]; qv[j] = bfe(qq, j) * __expf(d); kv[j] = bfe(kk, j) * __expf(-d); }
        u32x4 o; o.x = pk2(qv[0], qv[1]); o.y = pk2(qv[2], qv[3]); o.z = pk2(qv[4], qv[5]); o.w = pk2(qv[6], qv[7]); *(u32x4*)(qm + s * 136 + k0) = o;
        o.x = pk2(kv[0], kv[1]); o.y = pk2(kv[2], kv[3]); o.z = pk2(kv[4], kv[5]); o.w = pk2(kv[6], kv[7]); *(u32x4*)(km + s * 136 + k0) = o; }
#pragma unroll
    for (int i = 0; i < 2; ++i) { const int s = l, k0 = (w + 8 * i) * 8; const u32x4 vv = vvr[i];
#pragma unroll
        for (int j = 0; j < 8; ++j) vT[(k0 + j) * 72 + s] = bfr(vv, j); }
    __syncthreads();
    {
#pragma unroll
        for (int i = 0; i < 4; ++i) { const int idx = i * 512 + t, v = idx >> 4, k0 = (idx & 15) * 8; const u32x4 sv = spr[i];
            u32x4 o; o.x = pk2(bfe(sv, 0) * em[k0], bfe(sv, 1) * em[k0 + 1]); o.y = pk2(bfe(sv, 2) * em[k0 + 2], bfe(sv, 3) * em[k0 + 3]); o.z = pk2(bfe(sv, 4) * em[k0 + 4], bfe(sv, 5) * em[k0 + 5]); o.w = pk2(bfe(sv, 6) * em[k0 + 6], bfe(sv, 7) * em[k0 + 7]);
            *(u32x4*)(spT + v * 136 + k0) = o; } }
    if (next >= 0) hgrn_out_load(A, next, lf, qqr, kkr, vvr, spr);
    {
        const int ct = w & 3;
        f32x4 a2[2]; a2[0] = (f32x4){0.f, 0.f, 0.f, 0.f}; a2[1] = a2[0];
#pragma unroll
        for (int ks = 0; ks < 4; ++ks) { const bf16x8 a = *(const bf16x8*)(qm + (16 * ct + lr) * 136 + ks * 32 + lq * 8);
#pragma unroll
            for (int i = 0; i < 2; ++i) { const int st = (w >> 2) * 2 + i; const bf16x8 bb = *(const bf16x8*)(km + (16 * st + lr) * 136 + ks * 32 + lq * 8); a2[i] = MFMA16(a, bb, a2[i]); } }
#pragma unroll
        for (int i = 0; i < 2; ++i) { const int st = (w >> 2) * 2 + i, s = 16 * st + lr;
#pragma unroll
            for (int r = 0; r < 4; ++r) { const int cc = 16 * ct + lq * 4 + r; aL[cc * 72 + s] = (bf16_t)f2bf(s <= cc ? a2[i][r] : 0.f); } }
    }
    __syncthreads();
    const int ct = w & 3, vh = w >> 2;
    f32x4 o4[4];
#pragma unroll
    for (int i = 0; i < 4; ++i) o4[i] = (f32x4){0.f, 0.f, 0.f, 0.f};
#pragma unroll
    for (int ks = 0; ks < 4; ++ks) { const bf16x8 a = *(const bf16x8*)(qm + (16 * ct + lr) * 136 + ks * 32 + lq * 8);
#pragma unroll
        for (int i = 0; i < 4; ++i) { const int vt = vh * 4 + i; const bf16x8 bb = *(const bf16x8*)(spT + (16 * vt + lr) * 136 + ks * 32 + lq * 8); o4[i] = MFMA16(a, bb, o4[i]); } }
#pragma unroll
    for (int ks = 0; ks < 2; ++ks) { const bf16x8 a = *(const bf16x8*)(aL + (16 * ct + lr) * 72 + ks * 32 + lq * 8);
#pragma unroll
        for (int i = 0; i < 4; ++i) { const int vt = vh * 4 + i; const bf16x8 bb = *(const bf16x8*)(vT + (16 * vt + lr) * 72 + ks * 32 + lq * 8); o4[i] = MFMA16(a, bb, o4[i]); } }
    float* ost = (float*)(lds + L_BC);
#pragma unroll
    for (int r = 0; r < 4; ++r) { float s = 0.f;
#pragma unroll
        for (int i = 0; i < 4; ++i) { s += o4[i][r] * o4[i][r]; ost[(16 * ct + lq * 4 + r) * 132 + (vh * 4 + i) * 16 + lr] = o4[i][r]; }
        s += __shfl_xor(s, 1); s += __shfl_xor(s, 2); s += __shfl_xor(s, 4); s += __shfl_xor(s, 8);
        if (lr == 0) part[vh * 64 + 16 * ct + lq * 4 + r] = s; }
    __syncthreads();
    {   const float* hn = A.in[10]; bf16_t* MIX = (bf16_t*)(ws + WS_MIX);
        const int cc = t >> 3, v0 = (t & 7) * 16; const float rstd = __builtin_amdgcn_rsqf((part[cc] + part[64 + cc]) * (1.0f / 128.0f) + EPS);
#pragma unroll
        for (int hh = 0; hh < 2; ++hh) { const int v = v0 + hh * 8; const u32x4 g8 = ggr[hh];
            const f32x4 oa = *(const f32x4*)(ost + cc * 132 + v), ob = *(const f32x4*)(ost + cc * 132 + v + 4), na = *(const f32x4*)(hn + C0 + v), nb = *(const f32x4*)(hn + C0 + v + 4);
            u32x4 o; o.x = pk2(oa[0] * rstd * na[0] * bfe(g8, 0), oa[1] * rstd * na[1] * bfe(g8, 1)); o.y = pk2(oa[2] * rstd * na[2] * bfe(g8, 2), oa[3] * rstd * na[3] * bfe(g8, 3));
            o.z = pk2(ob[0] * rstd * nb[0] * bfe(g8, 4), ob[1] * rstd * nb[1] * bfe(g8, 5)); o.w = pk2(ob[2] * rstd * nb[2] * bfe(g8, 6), ob[3] * rstd * nb[3] * bfe(g8, 7));
            *(u32x4*)(MIX + (size_t)(R0 + cc) * DM + C0 + v) = o; } }
    __syncthreads();
}
__device__ __forceinline__ void hgrn_scan(const Args& A, int G) {
    const u32x2v* SLT = (const u32x2v*)(A.ws + WS_SL); const f32x4* DEC4 = (const f32x4*)(A.ws + WS_DEC); u32x2v* SPT = (u32x2v*)(A.ws + WS_SPT); float* outp = A.out + O_HP;
    for (int e = blockIdx.x * NTHREADS + threadIdx.x; e < 32 * 4096; e += G * NTHREADS) { const int bh = e >> 12, i4 = e & 4095, v = i4 >> 5, k4 = i4 & 31;
        f32x4 S = (f32x4){0.f, 0.f, 0.f, 0.f};
        const u32x2v* p = SLT + (size_t)bh * 32 * 4096 + i4; u32x2v* q = SPT + (size_t)bh * 32 * 4096 + i4; const f32x4* dp = DEC4 + (size_t)bh * 32 * 32 + k4;
#pragma unroll
        for (int hf = 0; hf < 2; ++hf) { u32x2v loc[16]; f32x4 dd[16];
#pragma unroll
            for (int c = 0; c < 16; ++c) { loc[c] = p[(size_t)(hf * 16 + c) * 4096]; dd[c] = dp[(hf * 16 + c) * 32]; }
#pragma unroll
            for (int c = 0; c < 16; ++c) { u32x2v o; o.x = pk2(S[0], S[1]); o.y = pk2(S[2], S[3]); q[(size_t)(hf * 16 + c) * 4096] = o; const f32x4 lv = (f32x4){h_lo(loc[c].x), h_hi(loc[c].x), h_lo(loc[c].y), h_hi(loc[c].y)}; S = S * dd[c] + lv; } }
        float* ob = outp + (size_t)bh * 16384 + (k4 * 4) * 128 + v; ob[0] = S[0]; ob[128] = S[1]; ob[256] = S[2]; ob[384] = S[3]; }
}
__device__ __forceinline__ void pool_states(const Args& A, int G) {
    const unsigned short* UU = (const unsigned short*)(A.ws + WS_UU);
    const int gt = blockIdx.x * NTHREADS + threadIdx.x, NGT = G * NTHREADS;
    for (int i = gt; i < 8 * 15 * 128; i += NGT) { const int c4 = i & 127, j = (i >> 7) % 15, b = i / (15 * 128); const u32x2v v = *(const u32x2v*)(UU + (size_t)(b * SEQ + 2033 + j) * HW + c4 * 4);
        *(f32x4*)(A.out + O_PP + (size_t)i * 4) = (f32x4){h_lo(v.x), h_hi(v.x), h_lo(v.y), h_hi(v.y)}; }
    for (int i0 = gt * 2; i0 < 128 * 15 * 128; i0 += NGT * 2) { f32x4 v[2];
#pragma unroll
        for (int q = 0; q < 2; ++q) { const int i = i0 + q, c4 = i & 127, j = (i >> 7) % 15, b = i / (15 * 128);
            if (j < 14) v[q] = *(const f32x4*)(A.in[4] + (size_t)(b * 15 + j + 1) * 512 + c4 * 4);
            else { const u32x2v h = *(const u32x2v*)(UU + (size_t)(NPR + b) * HW + c4 * 4); v[q] = (f32x4){h_lo(h.x), h_hi(h.x), h_lo(h.y), h_hi(h.y)}; } }
#pragma unroll
        for (int q = 0; q < 2; ++q) *(f32x4*)(A.out + O_PS + (size_t)(i0 + q) * 4) = v[q]; }
}
__device__ __forceinline__ void hgrn_sample_load(const Args& A, int unit, f32x4 (&sreg)[8]) {
    const int t = threadIdx.x; const float* S0 = A.in[3] + (size_t)unit * 16384;
#pragma unroll
    for (int i = 0; i < 8; ++i) sreg[i] = __builtin_nontemporal_load((const f32x4*)(S0 + ((t >> 5) * 8 + i) * 128 + (t & 31) * 4));
}
__device__ __forceinline__ void hgrn_sample_unit(const Args& A, unsigned char* lds, int unit, int next, f32x4 (&sreg)[8]) {
    const int t = threadIdx.x, b = unit >> 2, h = unit & 3, row = NPR + b, C0 = h * 128;
    unsigned char* ws = A.ws;
    float* qs = (float*)lds; float* ks = qs + 128; float* fs = ks + 128; float* vs = fs + 128; float* po = vs + 128;
    float* red = po + 16 * 128;
    float* S1 = A.out + O_HS + (size_t)unit * 16384;
    if (t < 128) { const size_t go = (size_t)row * HW + C0 + t;
        qs[t] = bf2f(((const bf16_t*)(ws + WS_QQ))[go]); ks[t] = bf2f(((const bf16_t*)(ws + WS_KK))[go]); fs[t] = __expf((float)__builtin_bit_cast(_Float16, ((const unsigned short*)(ws + WS_LF))[go])); vs[t] = bf2f(((const bf16_t*)(ws + WS_VV))[go]); }
    __syncthreads();
    const int v4 = t & 31, kg = t >> 5;
    const f32x4 vv = *(const f32x4*)(vs + v4 * 4);
    f32x4 o = (f32x4){0.f, 0.f, 0.f, 0.f};
#pragma unroll
    for (int i = 0; i < 8; ++i) { const int k = kg * 8 + i; const f32x4 s = sreg[i]; const f32x4 sn = s * fs[k] + vv * ks[k]; __builtin_nontemporal_store(sn, (f32x4*)(S1 + k * 128 + v4 * 4)); o += sn * qs[k]; }
    *(f32x4*)(po + kg * 128 + v4 * 4) = o;
    if (next >= 0) hgrn_sample_load(A, next, sreg);
    __syncthreads();
    float ov = 0.f;
    if (t < 128) {
#pragma unroll
        for (int i = 0; i < 16; ++i) ov += po[i * 128 + t];
        const float sq = wave_sum(ov * ov); if ((t & 63) == 0) red[t >> 6] = sq; }
    __syncthreads();
    if (t < 128) { const float rstd = __builtin_amdgcn_rsqf((red[0] + red[1]) * (1.0f / 128.0f) + EPS); const float g = bf2f(((const bf16_t*)(ws + WS_GG))[(size_t)row * HW + C0 + t]);
        ((bf16_t*)(ws + WS_MIX))[(size_t)row * DM + C0 + t] = (bf16_t)f2bf(ov * rstd * A.in[10][C0 + t] * g); }
    __syncthreads();
}

constexpr int LP_EXT = 0, LP_PL = 40448, LP_MX = 57856;
__device__ __forceinline__ void pool_load(const Args& A, int unit, u32x4 (&mreg)[4], u32x2v (&ereg)[5]) {
    const int t = threadIdx.x; const int tt = unit >> 2, g = unit & 3;
    const unsigned short* UU = (const unsigned short*)(A.ws + WS_UU);
    const bf16_t* PM = (const bf16_t*)(A.ws + WS_PMIX) + (size_t)g * 16384;
#pragma unroll
    for (int i = 0; i < 4; ++i) { const int idx = i * 512 + t, d = idx >> 4, c8 = idx & 15; mreg[i] = *(const u32x4*)(PM + d * 128 + c8 * 8); }
    const int b = tt >> 5, t0 = (tt & 31) * 64;
#pragma unroll
    for (int i5 = 0; i5 < 5; ++i5) { const int idx = i5 * 512 + t, i = idx >> 5, c4 = idx & 31; const int tp = t0 - 15 + i;
        ereg[i5] = (u32x2v){0u, 0u}; if (idx < 79 * 32 && tp >= 0) ereg[i5] = *(const u32x2v*)(UU + (size_t)(b * SEQ + tp) * HW + g * 128 + c4 * 4); }
}
__device__ __forceinline__ void pool_unit(const Args& A, unsigned char* lds, int unit, int next, u32x4 (&mreg)[4], u32x2v (&ereg)[5]) {
    const int t = threadIdx.x, w = t >> 6, l = t & 63, lr = l & 15, lq = l >> 4;
    const int tt = unit >> 2, g = unit & 3, win = 2 << g;
    unsigned char* ws = A.ws;
    float* ext = (float*)(lds + LP_EXT); bf16_t* pl = (bf16_t*)(lds + LP_PL); bf16_t* mx = (bf16_t*)(lds + LP_MX);
    const unsigned short* UU = (const unsigned short*)(ws + WS_UU);
    {
#pragma unroll
        for (int i = 0; i < 4; ++i) { const int idx = i * 512 + t, d = idx >> 4, c8 = idx & 15; *(u32x4*)(mx + d * 136 + c8 * 8) = mreg[i]; }
    }
    int rowbase;
    {
        const int b = tt >> 5, t0 = (tt & 31) * 64; rowbase = b * SEQ + t0;
#pragma unroll
        for (int i5 = 0; i5 < 5; ++i5) { const int idx = i5 * 512 + t, i = idx >> 5, c4 = idx & 31; if (idx < 79 * 32) *(f32x4*)(ext + i * 128 + c4 * 4) = (f32x4){h_lo(ereg[i5].x), h_hi(ereg[i5].x), h_lo(ereg[i5].y), h_hi(ereg[i5].y)}; }
        if (next >= 0) pool_load(A, next, mreg, ereg);
        __syncthreads();
        const int cch = t & 127, tg = t >> 7, tk0 = tg * 16;
        float nw[16], od[16], ini[16];
#pragma unroll
        for (int i = 0; i < 16; ++i) { nw[i] = ext[(15 + tk0 + i) * 128 + cch]; od[i] = (i >= 1) ? ext[(15 + tk0 + i - win) * 128 + cch] : 0.f; ini[i] = (i >= 1 && i < win) ? ext[(15 + tk0 - i) * 128 + cch] : 0.f; }
        float sw = 0.f;
#pragma unroll
        for (int i = 1; i < 16; ++i) sw += ini[i];
#pragma unroll
        for (int i = 0; i < 16; ++i) { const int tok = tk0 + i; sw += nw[i]; sw -= od[i];
            const int cnt = min(t0 + tok + 1, win);
            pl[tok * 136 + cch] = (bf16_t)f2bf(sw / (float)cnt - nw[i]); }
    }
    __syncthreads();
    const int ct = w & 3, dh = w >> 2;
    f32x4 o4[4];
#pragma unroll
    for (int i = 0; i < 4; ++i) o4[i] = (f32x4){0.f, 0.f, 0.f, 0.f};
#pragma unroll
    for (int ks = 0; ks < 4; ++ks) { const bf16x8 a = *(const bf16x8*)(pl + (16 * ct + lr) * 136 + ks * 32 + lq * 8);
#pragma unroll
        for (int i = 0; i < 4; ++i) { const int dt = dh * 4 + i; const bf16x8 bb = *(const bf16x8*)(mx + (16 * dt + lr) * 136 + ks * 32 + lq * 8); o4[i] = MFMA16(a, bb, o4[i]); } }
    bf16_t* MIX = (bf16_t*)(ws + WS_MIX); const float* psc = A.in[12];
    float* ost = (float*)(lds + LP_EXT);
#pragma unroll
    for (int i = 0; i < 4; ++i) { const int d = (dh * 4 + i) * 16 + lr; const float sc = psc[g * 128 + d];
#pragma unroll
        for (int r = 0; r < 4; ++r) ost[(16 * ct + lq * 4 + r) * 132 + d] = o4[i][r] * sc; }
    __syncthreads();
    {   const int tok = t >> 3, d0 = (t & 7) * 16;
#pragma unroll
        for (int hh = 0; hh < 2; ++hh) { const f32x4 oa = *(const f32x4*)(ost + tok * 132 + d0 + hh * 8), ob = *(const f32x4*)(ost + tok * 132 + d0 + hh * 8 + 4);
            u32x4 o; o.x = pk2(oa[0], oa[1]); o.y = pk2(oa[2], oa[3]); o.z = pk2(ob[0], ob[1]); o.w = pk2(ob[2], ob[3]);
            *(u32x4*)(MIX + (size_t)(rowbase + tok) * DM + 512 + g * 128 + d0 + hh * 8) = o; } }
    __syncthreads();
}

__device__ __forceinline__ void pool_sample_unit(const Args& A, unsigned char* lds, int unit) {
    const int t = threadIdx.x, w = t >> 6, l = t & 63, lr = l & 15, lq = l >> 4;
    const int su = unit >> 2, g = unit & 3, win = 2 << g;
    unsigned char* ws = A.ws;
    bf16_t* pl = (bf16_t*)(lds + LP_PL); bf16_t* mx = (bf16_t*)(lds + LP_MX);
    const _Float16* UU = (const _Float16*)(ws + WS_UU);
    const bf16_t* PM = (const bf16_t*)(ws + WS_PMIX) + (size_t)g * 16384;
    u32x4 mreg[4];
#pragma unroll
    for (int i = 0; i < 4; ++i) { const int idx = i * 512 + t, d = idx >> 4, c8 = idx & 15; mreg[i] = *(const u32x4*)(PM + d * 128 + c8 * 8); }
    const int cch = t & 127, sq = t >> 7;
    const float psc_w = A.in[12][g * 128 + 16 * w + lr];
#pragma unroll
    for (int i = 0; i < 4; ++i) { const int tok = sq * 4 + i, sb = su * 16 + tok; const float uv = (float)UU[(size_t)(NPR + sb) * HW + g * 128 + cch];
        float pv[15];
#pragma unroll
        for (int j = 0; j < 15; ++j) pv[j] = A.in[4][(size_t)(sb * 15 + j) * 512 + g * 128 + cch];
        float sacc = uv;
#pragma unroll
        for (int j = 0; j < 15; ++j) sacc += (j >= 16 - win) ? pv[j] : 0.f;
        pl[tok * 136 + cch] = (bf16_t)f2bf(sacc / (float)win - uv); }
#pragma unroll
    for (int i = 0; i < 4; ++i) { const int idx = i * 512 + t, d = idx >> 4, c8 = idx & 15; *(u32x4*)(mx + d * 136 + c8 * 8) = mreg[i]; }
    __syncthreads();
    f32x4 acc = (f32x4){0.f, 0.f, 0.f, 0.f};
#pragma unroll
    for (int ks = 0; ks < 4; ++ks) { const bf16x8 a = *(const bf16x8*)(pl + lr * 136 + ks * 32 + lq * 8); const bf16x8 bb = *(const bf16x8*)(mx + (16 * w + lr) * 136 + ks * 32 + lq * 8); acc = MFMA16(a, bb, acc); }
    bf16_t* MIX = (bf16_t*)(ws + WS_MIX);
#pragma unroll
    for (int r = 0; r < 4; ++r) MIX[(size_t)(NPR + su * 16 + lq * 4 + r) * DM + 512 + g * 128 + 16 * w + lr] = (bf16_t)f2bf(acc[r] * psc_w);
    __syncthreads();
}

__device__ __forceinline__ void attn_prompt_unit(const Args& A, unsigned char* lds, int unit) {
    const int t = threadIdx.x, w = t >> 6, l = t & 63, lr = l & 15, lq = l >> 4;
    const int qt = unit & 15, h = (unit >> 4) & 3, b = unit >> 6;
    unsigned char* ws = A.ws;
    const bf16_t* Q = (const bf16_t*)(ws + WS_Q); const bf16_t* KB = (const bf16_t*)(ws + WS_KB); const bf16_t* VT = (const bf16_t*)(ws + WS_VT); bf16_t* O = (bf16_t*)(ws + WS_O);
    const int R0 = b * SEQ + qt * 128 + 16 * w;
    bf16_t* CB = (bf16_t*)lds;
    bf16_t* Pw = (bf16_t*)(lds + 73728) + w * (16 * 264);
    const bf16_t* kg = KB + (size_t)(b * 256) * DM + h * 256;
    const bf16_t* vg = VT + (size_t)(h * 256) * MEMR + b * 256;
    u32x4 stg0[4], stg1[4];
#define AT_LOADK(c, STG) _Pragma("unroll") for (int i_ = 0; i_ < 4; ++i_) { const int idx_ = i_ * 512 + t; STG[i_] = *(const u32x4*)(kg + (size_t)((c) * 64 + (idx_ >> 5)) * DM + (idx_ & 31) * 8); }
#define AT_LOADV(c, STG) _Pragma("unroll") for (int i_ = 0; i_ < 4; ++i_) { const int idx_ = i_ * 512 + t; STG[i_] = *(const u32x4*)(vg + (size_t)(idx_ >> 3) * MEMR + (c) * 64 + (idx_ & 7) * 8); }
#define AT_STOREK(bf, STG) _Pragma("unroll") for (int i_ = 0; i_ < 4; ++i_) { const int idx_ = i_ * 512 + t; *(u32x4*)(CB + (bf) * 18432 + (idx_ >> 5) * 264 + (idx_ & 31) * 8) = STG[i_]; }
#define AT_STOREV(bf, STG) _Pragma("unroll") for (int i_ = 0; i_ < 4; ++i_) { const int idx_ = i_ * 512 + t; *(u32x4*)(CB + (bf) * 18432 + (idx_ >> 3) * 72 + (idx_ & 7) * 8) = STG[i_]; }
    AT_LOADK(0, stg0); AT_LOADK(1, stg1);
    bf16x8 qa[8];
#pragma unroll
    for (int ks = 0; ks < 8; ++ks) qa[ks] = *(const bf16x8*)(Q + (size_t)(R0 + lr) * DM + h * 256 + ks * 32 + lq * 8);
    AT_STOREK(0, stg0);
    __syncthreads();
    f32x4 sacc[16]; f32x4 oacc[16]; bf16x8 pa[8]; float rinv[4];
#pragma unroll
    for (int st = 0; st < 8; ++st) {
        if (st & 1) { if (st + 2 < 4) { AT_LOADK(st + 2, stg1); } else if (st + 2 < 8) { AT_LOADV(st - 2, stg1); } }
        else        { if (st + 2 < 4) { AT_LOADK(st + 2, stg0); } else if (st + 2 < 8) { AT_LOADV(st - 2, stg0); } }
        const bf16_t* cb = CB + (st & 1) * 18432;
        if (st < 4) {
#pragma unroll
            for (int nt = 0; nt < 4; ++nt) { f32x4 acc = (f32x4){0.f, 0.f, 0.f, 0.f};
#pragma unroll
                for (int ks = 0; ks < 8; ++ks) { const bf16x8 bb = *(const bf16x8*)(cb + (nt * 16 + lr) * 264 + ks * 32 + lq * 8); acc = MFMA16(qa[ks], bb, acc); }
                sacc[st * 4 + nt] = acc; __builtin_amdgcn_sched_barrier(0); }
        } else {
            if (st == 4) {
#pragma unroll
                for (int r = 0; r < 4; ++r) { float mx = sacc[0][r];
#pragma unroll
                    for (int nt = 1; nt < 16; ++nt) mx = fmaxf(mx, sacc[nt][r]);
                    mx = fmaxf(mx, __shfl_xor(mx, 1)); mx = fmaxf(mx, __shfl_xor(mx, 2)); mx = fmaxf(mx, __shfl_xor(mx, 4)); mx = fmaxf(mx, __shfl_xor(mx, 8));
                    float sum = 0.f;
#pragma unroll
                    for (int nt = 0; nt < 16; ++nt) { const float p = __builtin_amdgcn_exp2f(sacc[nt][r] - mx); sum += p; Pw[(lq * 4 + r) * 264 + nt * 16 + lr] = (bf16_t)f2bf(p); }
                    sum += __shfl_xor(sum, 1); sum += __shfl_xor(sum, 2); sum += __shfl_xor(sum, 4); sum += __shfl_xor(sum, 8);
                    rinv[r] = 1.0f / sum; }
                asm volatile("s_waitcnt lgkmcnt(0)" ::: "memory");
#pragma unroll
                for (int ks = 0; ks < 8; ++ks) pa[ks] = *(const bf16x8*)(Pw + lr * 264 + ks * 32 + lq * 8);
#pragma unroll
                for (int dt = 0; dt < 16; ++dt) oacc[dt] = (f32x4){0.f, 0.f, 0.f, 0.f};
            }
            const int c = st - 4;
#pragma unroll
            for (int dt = 0; dt < 16; ++dt)
#pragma unroll
                for (int k2 = 0; k2 < 2; ++k2) { const bf16x8 bb = *(const bf16x8*)(cb + (dt * 16 + lr) * 72 + k2 * 32 + lq * 8); oacc[dt] = MFMA16(pa[c * 2 + k2], bb, oacc[dt]); if (k2 == 1 && (dt & 1)) __builtin_amdgcn_sched_barrier(0); }
        }
        if (st & 1) { if (st + 1 < 4) { AT_STOREK(0, stg0); } else if (st + 1 < 8) { AT_STOREV(0, stg0); } }
        else        { if (st + 1 < 4) { AT_STOREK(1, stg1); } else if (st + 1 < 8) { AT_STOREV(1, stg1); } }
        __syncthreads();
    }
#pragma unroll
    for (int dt = 0; dt < 16; ++dt)
#pragma unroll
        for (int r = 0; r < 4; ++r) Pw[(lq * 4 + r) * 264 + dt * 16 + lr] = (bf16_t)f2bf(oacc[dt][r] * rinv[r]);
    asm volatile("s_waitcnt lgkmcnt(0)" ::: "memory");
#pragma unroll
    for (int i = 0; i < 8; ++i) { const int idx = i * 64 + l, row = idx >> 5, c8 = idx & 31; *(u32x4*)(O + (size_t)(R0 + row) * DM + h * 256 + c8 * 8) = *(const u32x4*)(Pw + row * 264 + c8 * 8); }
    asm volatile("s_waitcnt lgkmcnt(0)" ::: "memory");
#undef AT_LOADK
#undef AT_LOADV
#undef AT_STOREK
#undef AT_STOREV
}
__device__ __forceinline__ void attn_sample_unit(const Args& A, unsigned char* lds, int unit) {
    const int t = threadIdx.x, w = t >> 6, l = t & 63;
    const int b = unit >> 2, h = unit & 3;
    unsigned char* ws = A.ws;
    float* qs = (float*)lds; float* sc = qs + 256; float* red = sc + 256; float* po = red + 16;
    const float* Kc = A.in[5] + (size_t)b * 256 * 1024 + h * 256; const float* Vc = A.in[6] + (size_t)b * 256 * 1024 + h * 256;
    const int rl = l >> 4, c16 = l & 15;
    f32x4 kr[8][4];
#pragma unroll
    for (int p = 0; p < 8; ++p)
#pragma unroll
        for (int i = 0; i < 4; ++i) kr[p][i] = *(const f32x4*)(Kc + (size_t)(p * 32 + w * 4 + rl) * 1024 + i * 64 + c16 * 4);
    if (t < 256) qs[t] = bf2f(((const bf16_t*)(ws + WS_Q))[(size_t)(NPR + b) * DM + h * 256 + t]);
    __syncthreads();
    {
        f32x4 q4[4];
#pragma unroll
        for (int i = 0; i < 4; ++i) q4[i] = *(const f32x4*)(qs + i * 64 + c16 * 4);
#pragma unroll
        for (int p = 0; p < 8; ++p) { const int m = p * 32 + w * 4 + rl; float s = 0.f;
#pragma unroll
            for (int i = 0; i < 4; ++i) { const f32x4 kv = kr[p][i]; s += (kv[0] * q4[i][0] + kv[1] * q4[i][1]) + (kv[2] * q4[i][2] + kv[3] * q4[i][3]); }
            s += __shfl_xor(s, 1); s += __shfl_xor(s, 2); s += __shfl_xor(s, 4); s += __shfl_xor(s, 8);
            if (c16 == 0) sc[m] = s; }
    }
    f32x4 vr[32];
#pragma unroll
    for (int i = 0; i < 32; ++i) vr[i] = *(const f32x4*)(Vc + (size_t)(w * 32 + i) * 1024 + l * 4);
    __syncthreads();
    if (t < 256) { float mx = sc[t];
#pragma unroll
        for (int o = 1; o < 64; o <<= 1) mx = fmaxf(mx, __shfl_xor(mx, o));
        if (l == 0) red[w] = mx; }
    __syncthreads();
    const float gmx = fmaxf(fmaxf(red[0], red[1]), fmaxf(red[2], red[3]));
    float pv = 0.f;
    if (t < 256) { pv = __builtin_amdgcn_exp2f(sc[t] - gmx); const float s = wave_sum(pv); if (l == 0) red[8 + w] = s; }
    __syncthreads();
    if (t < 256) sc[t] = pv;
    const float inv = 1.0f / ((red[8] + red[9]) + (red[10] + red[11]));
    __syncthreads();
    {
        f32x4 o = (f32x4){0.f, 0.f, 0.f, 0.f};
#pragma unroll
        for (int i = 0; i < 32; ++i) o += vr[i] * sc[w * 32 + i];
        *(f32x4*)(po + w * 256 + l * 4) = o;
    }
    __syncthreads();
    if (t < 256) { float o = 0.f;
#pragma unroll
        for (int i = 0; i < 8; ++i) o += po[i * 256 + t];
        ((bf16_t*)(ws + WS_O))[(size_t)(NPR + b) * DM + h * 256 + t] = (bf16_t)f2bf(o * inv); }
    __syncthreads();
}

__device__ __forceinline__ void attn_sample_pair(const Args& A, unsigned char* lds, int pg) {
    const int t = threadIdx.x, w = t >> 6, l = t & 63, rl = l >> 4, c16 = l & 15;
    const int pair = pg * 2 + (w >> 2), wq = w & 3, b = pair >> 2, h = pair & 3;
    const size_t off0 = (size_t)b * 256 * 1024 + h * 256 + (size_t)(wq * 64 + rl) * 1024 + c16 * 4;
    const float* Kc = A.in[5] + off0; const float* Vc = A.in[6] + off0;
    f32x4 ra[8], rb[8];
#define AS_LD(set, base, bt) _Pragma("unroll") for (int gg_ = 0; gg_ < 2; ++gg_) _Pragma("unroll") for (int i_ = 0; i_ < 4; ++i_) set[gg_ * 4 + i_] = __builtin_nontemporal_load((const f32x4*)((base) + (size_t)((bt) * 8 + gg_ * 4) * 1024 + i_ * 64))
    AS_LD(ra, Kc, 0); AS_LD(rb, Kc, 1);
    f32x4 q4[4];
    {   const bf16_t* qp = (const bf16_t*)(A.ws + WS_Q) + (size_t)(NPR + b) * DM + h * 256 + c16 * 4;
#pragma unroll
        for (int i = 0; i < 4; ++i) { const u32x2v qv = *(const u32x2v*)(qp + i * 64); q4[i] = (f32x4){__uint_as_float(qv.x << 16), __uint_as_float(qv.x & 0xffff0000u), __uint_as_float(qv.y << 16), __uint_as_float(qv.y & 0xffff0000u)}; } }
    float sc[16];
#define AS_SCORE(set, bt) _Pragma("unroll") for (int gg_ = 0; gg_ < 2; ++gg_) { float s_ = 0.f; _Pragma("unroll") for (int i_ = 0; i_ < 4; ++i_) { const f32x4 kv_ = set[gg_ * 4 + i_]; s_ += (kv_[0] * q4[i_][0] + kv_[1] * q4[i_][1]) + (kv_[2] * q4[i_][2] + kv_[3] * q4[i_][3]); } \
        s_ += __shfl_xor(s_, 1); s_ += __shfl_xor(s_, 2); s_ += __shfl_xor(s_, 4); s_ += __shfl_xor(s_, 8); sc[(bt) * 2 + gg_] = s_; }
#pragma unroll
    for (int bt = 0; bt < 8; ++bt) {
        if (bt & 1) { AS_SCORE(rb, bt); if (bt + 2 < 8) { AS_LD(rb, Kc, bt + 2); } else { AS_LD(rb, Vc, bt - 6); } }
        else        { AS_SCORE(ra, bt); if (bt + 2 < 8) { AS_LD(ra, Kc, bt + 2); } else { AS_LD(ra, Vc, bt - 6); } }
        asm volatile("" ::: "memory"); __builtin_amdgcn_sched_barrier(0);
    }
    float mx = sc[0];
#pragma unroll
    for (int g = 1; g < 16; ++g) mx = fmaxf(mx, sc[g]);
    mx = fmaxf(mx, __shfl_xor(mx, 16)); mx = fmaxf(mx, __shfl_xor(mx, 32));
    float ls = 0.f;
#pragma unroll
    for (int g = 0; g < 16; ++g) { sc[g] = __builtin_amdgcn_exp2f(sc[g] - mx); ls += sc[g]; }
    ls += __shfl_xor(ls, 16); ls += __shfl_xor(ls, 32);
    f32x4 o[4];
#pragma unroll
    for (int i = 0; i < 4; ++i) o[i] = (f32x4){0.f, 0.f, 0.f, 0.f};
#define AS_PV(set, bt) _Pragma("unroll") for (int gg_ = 0; gg_ < 2; ++gg_) _Pragma("unroll") for (int i_ = 0; i_ < 4; ++i_) o[i_] += set[gg_ * 4 + i_] * sc[(bt) * 2 + gg_]
#pragma unroll
    for (int bt = 0; bt < 8; ++bt) {
        if (bt & 1) { AS_PV(rb, bt); if (bt + 2 < 8) { AS_LD(rb, Vc, bt + 2); } }
        else        { AS_PV(ra, bt); if (bt + 2 < 8) { AS_LD(ra, Vc, bt + 2); } }
        asm volatile("" ::: "memory"); __builtin_amdgcn_sched_barrier(0);
    }
#pragma unroll
    for (int i = 0; i < 4; ++i)
#pragma unroll
        for (int c = 0; c < 4; ++c) { float v = o[i][c]; v += __shfl_xor(v, 16); v += __shfl_xor(v, 32); o[i][c] = v; }
    float* pw = (float*)lds + w * 260;
    if (rl == 0) {
#pragma unroll
        for (int i = 0; i < 4; ++i) *(f32x4*)(pw + i * 64 + c16 * 4) = o[i];
        if (c16 == 0) { pw[256] = mx; pw[257] = ls; } }
    __syncthreads();
    {   const int ps = t >> 8, d = t & 255; const float* pb = (const float*)lds + (ps * 4) * 260;
        const float m0 = pb[256], m1 = pb[260 + 256], m2 = pb[520 + 256], m3 = pb[780 + 256]; const float M = fmaxf(fmaxf(m0, m1), fmaxf(m2, m3));
        const float e0 = __builtin_amdgcn_exp2f(m0 - M), e1 = __builtin_amdgcn_exp2f(m1 - M), e2 = __builtin_amdgcn_exp2f(m2 - M), e3 = __builtin_amdgcn_exp2f(m3 - M);
        const float num = (pb[d] * e0 + pb[260 + d] * e1) + (pb[520 + d] * e2 + pb[780 + d] * e3);
        const float den = (pb[257] * e0 + pb[260 + 257] * e1) + (pb[520 + 257] * e2 + pb[780 + 257] * e3);
        const int pr = pg * 2 + ps, bb = pr >> 2, hh = pr & 3;
        ((bf16_t*)(A.ws + WS_O))[(size_t)(NPR + bb) * DM + hh * 256 + d] = (bf16_t)f2bf(num / den); }
    __syncthreads();
#undef AS_LD
#undef AS_SCORE
#undef AS_PV
}

template <int KIND, int NKS>
__device__ __forceinline__ void sample_gemm(unsigned char* lds, const bf16_t* Asm, int lda, const bf16_t* Bt, int K, int unit, const float* base, const bf16_t* baseb, float* out, bf16_t* outb, float* ss, float scale) {
    const int t = threadIdx.x, w = t >> 6, l = t & 63, lr = l & 15, lq = l >> 4;
    const int rb = unit & 3, cb = unit >> 2, kw = K >> 3, k0 = w * kw;
    f32x4 acc[2]; acc[0] = (f32x4){0.f, 0.f, 0.f, 0.f}; acc[1] = acc[0];
    const bf16_t* bp = Bt + (size_t)(cb * 16 + lr) * K + k0 + lq * 8;
    const bf16_t* ap = Asm + (size_t)(rb * 32 + lr) * lda + k0 + lq * 8;
    bf16x8 fb[NKS], fa0[NKS], fa1[NKS];
#pragma unroll
    for (int ks = 0; ks < NKS; ++ks) { fb[ks] = *(const bf16x8*)(bp + ks * 32); fa0[ks] = *(const bf16x8*)(ap + ks * 32); fa1[ks] = *(const bf16x8*)(ap + (size_t)16 * lda + ks * 32); }
    const int row_ = t >> 4, col_ = t & 15;
    float bres = 0.f;
    if (KIND == 0) bres = base ? base[(size_t)(rb * 32 + row_) * DM + cb * 16 + col_] : bf2f(baseb[(size_t)(rb * 32 + row_) * DM + cb * 16 + col_]);
#pragma unroll
    for (int ks = 0; ks < NKS; ++ks) { acc[0] = MFMA16(fa0[ks], fb[ks], acc[0]); acc[1] = MFMA16(fa1[ks], fb[ks], acc[1]); }
    float* red = (float*)lds;
#pragma unroll
    for (int i = 0; i < 2; ++i)
#pragma unroll
        for (int r = 0; r < 4; ++r) red[(w * 32 + i * 16 + lq * 4 + r) * 16 + lr] = acc[i][r];
    __syncthreads();
    const int row = t >> 4, col = t & 15, grow = rb * 32 + row, gcol = cb * 16 + col;
    float v = 0.f;
#pragma unroll
    for (int i = 0; i < 8; ++i) v += red[(i * 32 + row) * 16 + col];
    if (KIND == 0) { const float val = bres + v; if (out) out[(size_t)grow * DM + gcol] = val; if (outb) outb[(size_t)grow * DM + gcol] = (bf16_t)f2bf(val);
        float sq = val * val; sq += __shfl_xor(sq, 1); sq += __shfl_xor(sq, 2); sq += __shfl_xor(sq, 4); sq += __shfl_xor(sq, 8);
        if (col == 0) atomicAdd(ss + grow, sq);
    } else { const float rstd = __builtin_amdgcn_rsqf(ss[grow] * (1.0f / DM) + EPS); outb[(size_t)grow * DM + gcol] = (bf16_t)f2bf(v * rstd * scale); }
    __syncthreads();
}

__device__ __forceinline__ void final_norm(const Args& A, int G, int row_lo) {
    const int lane = threadIdx.x & 63, gw = blockIdx.x * 8 + (threadIdx.x >> 6), NGW = G * 8;
    const float* ss = (const float*)(A.ws + WS_SS3); const f32x4* gr = (const f32x4*)A.in[22] + lane;
    f32x4 gg[4];
#pragma unroll
    for (int j = 0; j < 4; ++j) gg[j] = gr[64 * j];
    for (int m0 = row_lo + gw * 4; m0 < NVALID; m0 += NGW * 4) {
        f32x4 v[4][4]; float sv[4];
#pragma unroll
        for (int r = 0; r < 4; ++r) { sv[r] = ss[m0 + r]; const f32x4* xr = (const f32x4*)(A.out + (size_t)(m0 + r) * DM) + lane;
#pragma unroll
            for (int j = 0; j < 4; ++j) v[r][j] = xr[64 * j]; }
#pragma unroll
        for (int r = 0; r < 4; ++r) { const float rstd = 1.0f / sqrtf(sv[r] * (1.f / DM) + EPS); f32x4* xr = (f32x4*)(A.out + (size_t)(m0 + r) * DM) + lane;
#pragma unroll
            for (int j = 0; j < 4; ++j) xr[64 * j] = v[r][j] * rstd * gg[j]; } }
}

constexpr int NPHASES = 12;
#ifndef REPMASK
#define REPMASK 0
#endif
#define REPS(k) for (int rep_ = 0; rep_ < 1 + ((REPMASK >> (k)) & 1); ++rep_)
__global__ void __launch_bounds__(NTHREADS, 2) fwd_megakernel(Args args) {
    extern __shared__ __attribute__((aligned(16))) unsigned char lds[];
    cg::grid_group grid = cg::this_grid();
    const int G = gridDim.x, bx = blockIdx.x;
    unsigned char* ws = args.ws;
    PG8_LAS unsigned char* lds3 = (PG8_LAS unsigned char*)lds;
    const int lo = args.ph_lo, hi = args.ph_hi;
#define IN(k) (lo <= (k) && (k) < hi)
#ifndef SPINBLK
#define SPINBLK 0
#endif
#ifdef SPINMASK
    unsigned long long t_prev_ = __builtin_amdgcn_s_memrealtime(), t_acc_ = 0ull;
#define STAMP(k) do { const unsigned long long t_now_ = __builtin_amdgcn_s_memrealtime(); if ((SPINMASK >> (k)) & 1) t_acc_ += t_now_ - t_prev_; t_prev_ = t_now_; } while (0)
#else
#define STAMP(k) do { } while (0)
#endif
#define SEAM(k) do { if (IN(k) && IN((k) + 1)) xcd_barrier(bar); STAMP(k); } while (0)
    if (lo < 0) grid.sync();
    volatile LAS unsigned* MISC = (volatile LAS unsigned*)(lds3 + LDS_BYTES - 64);
    if (threadIdx.x < 16) MISC[threadIdx.x] = 0u;
    __syncthreads();
    XcdBarrier bar = xcd_barrier_post((unsigned*)(ws + WS_BAR), MISC);
    if (IN(0)) REPS(0) { p0_prologue(args, lds, G); }
    SEAM(0);
    if (IN(1)) REPS(1) {
        {   pg8::Gemm g{(const bf16_t*)(ws + WS_H0), (const bf16_t*)(ws + WS_WIN), MT, NIN, DM}; pg8::StaticOrder S; S.init(MT, NIN, G, bx);
            pg8::EpiInProj E{(bf16_t*)(ws + WS_QQ), (bf16_t*)(ws + WS_KK), (bf16_t*)(ws + WS_VV), (bf16_t*)(ws + WS_GG), (unsigned short*)(ws + WS_LF), (unsigned short*)(ws + WS_UU), args.in[9]};
            pg8::gemm_phase<pg8::EpiInProj, pg8::StaticOrder, true, true>(lds3, g, S, E); }
        {   pg8::Gemm g{(const bf16_t*)(ws + WS_MEMH), (const bf16_t*)(ws + WS_WKV), MEMR, 2 * DM, DM}; pg8::StaticOrder S; S.init(MEMR, 2 * DM, G, (bx + G - (650 % G)) % G);
            pg8::EpiMemKV E{args.out + O_MK, args.out + O_MV, (bf16_t*)(ws + WS_KB)};
            pg8::gemm_phase<pg8::EpiMemKV, pg8::StaticOrder, true, true>(lds3, g, S, E); }
        {   pg8::Gemm g{(const bf16_t*)(ws + WS_WKV) + (size_t)DM * DM, (const bf16_t*)(ws + WS_MEMH), DM, MEMR, DM}; pg8::StaticOrder S; S.init(DM, MEMR, G, (bx + 2 * G - ((650 + 64) % G)) % G);
            pg8::EpiBf16Scale E{(bf16_t*)(ws + WS_VT), MEMR, nullptr, 1.0f};
            pg8::gemm_phase<pg8::EpiBf16Scale, pg8::StaticOrder, true, true>(lds3, g, S, E); }
    }
    SEAM(1);
    if (IN(2)) REPS(2) {
        const bool sfirst = ((bx >> 3) & 1) != 0;
#pragma unroll 1
        for (int pass = 0; pass < 2; ++pass) {
            if ((pass == 0) == sfirst) {
                f32x4 sreg[8]; if (bx < 512) hgrn_sample_load(args, bx, sreg);
                for (int u = bx; u < 512; u += G) hgrn_sample_unit(args, lds, u, (u + G < 512) ? u + G : -1, sreg);
            } else {
                u32x2v lf[4]; u32x4 kkr[2], vvr[2]; if (bx < 1024) hgrn_local_load(args, bx, lf, kkr, vvr);
                for (int u = bx; u < 1024; u += G) hgrn_local_unit(args, lds, u, (u + G < 1024) ? u + G : -1, lf, kkr, vvr);
            }
        }
    }
    SEAM(2);
    if (IN(3)) {
        for (int u = bx; u < 32; u += G) pool_sample_unit(args, lds, u);
        const bool scan_first = ((bx >> 3) & 1) != 0;
        if (scan_first) { hgrn_scan(args, G); pool_states(args, G); }
        {   u32x4 mreg[4]; u32x2v ereg[5]; if (bx < 1024) pool_load(args, bx, mreg, ereg);
            for (int u = bx; u < 1024; u += G) pool_unit(args, lds, u, (u + G < 1024) ? u + G : -1, mreg, ereg); }
        if (!scan_first) { hgrn_scan(args, G); pool_states(args, G); }
    }
    SEAM(3);
    if (IN(4)) REPS(4) {
        {   u32x2v lf[4]; u32x4 qqr[2], kkr[2], vvr[2], spr[4]; if (bx < 1024) hgrn_out_load(args, bx, lf, qqr, kkr, vvr, spr);
            for (int u = bx; u < 1024; u += G) hgrn_out_unit(args, lds, u, (u + G < 1024) ? u + G : -1, lf, qqr, kkr, vvr, spr); }
        STAMP(12);
        STAMP(13);
        for (int u = bx; u < 256; u += G) sample_gemm<0, 4>(lds, (const bf16_t*)(ws + WS_MIX) + (size_t)NPR * DM, DM, (const bf16_t*)(ws + WS_WOUT), DM, u, args.in[1], nullptr, nullptr, (bf16_t*)(ws + WS_H0) + (size_t)NPR * DM, (float*)(ws + WS_SS1) + NPR, 1.0f);
    }
    SEAM(4);
    if (IN(5)) REPS(5) {
        pg8::Gemm g{(const bf16_t*)(ws + WS_MIX), (const bf16_t*)(ws + WS_WOUT), NPR, DM, DM}; pg8::StaticOrder S; S.init(NPR, DM, G, bx);
        pg8::EpiResid E{args.in[0], nullptr, nullptr, (bf16_t*)(ws + WS_H0), (float*)(ws + (rep_ ? WS_SSD : WS_SS1))};
        pg8::gemm_phase<pg8::EpiResid, pg8::StaticOrder, true, true>(lds3, g, S, E);
        for (int u = bx; u < 256; u += G) sample_gemm<1, 4>(lds, (const bf16_t*)(ws + WS_H0) + (size_t)NPR * DM, DM, (const bf16_t*)(ws + WS_WCQ), DM, u, nullptr, nullptr, nullptr, (bf16_t*)(ws + WS_Q) + (size_t)NPR * DM, (float*)(ws + WS_SS1) + NPR, 0.0625f * 1.4426950408889634f);
    }
    SEAM(5);
    const bool stream_first = ((bx >> 3) & 1) != 0;
    if (IN(7) && stream_first) for (int u = bx; u < 256; u += G) attn_sample_pair(args, lds, u);
    if (IN(6)) {
        pg8::Gemm g{(const bf16_t*)(ws + WS_H0), (const bf16_t*)(ws + WS_WCQ), NPR, DM, DM}; pg8::StaticOrder S; S.init(NPR, DM, G, bx);
        pg8::EpiBf16Scale E{(bf16_t*)(ws + WS_Q), DM, (const float*)(ws + WS_SS1), 0.0625f * 1.4426950408889634f};
        pg8::gemm_phase<pg8::EpiBf16Scale, pg8::StaticOrder, true, true>(lds3, g, S, E);
        STAMP(16);
    }
    int au0 = bx, au1 = 512, austep = G;
    if (G == 256) {
        asm volatile("s_waitcnt vmcnt(0)" ::: "memory"); __syncthreads();
        const int wg_ = (bx & 7) * 32 + (bx >> 3), pm_ = (wg_ >> 5) * 8 + ((wg_ & 31) & 7), pn_ = (wg_ & 31) >> 3;
        au0 = ((pm_ >> 3) * 4 + pn_) * 16 + (pm_ & 7) * 2; au1 = au0 + 2; austep = 1;
    } else { SEAM(6); }
    if (IN(7)) {
        for (int u = au0; u < au1; u += austep) attn_prompt_unit(args, lds, u);
        STAMP(17);
        if (!stream_first) for (int u = bx; u < 256; u += G) attn_sample_pair(args, lds, u);
    }
    SEAM(7);
    if (IN(8)) REPS(8) {
        pg8::Gemm g{(const bf16_t*)(ws + WS_O), (const bf16_t*)(ws + WS_WCO), NPR, DM, DM}; pg8::StaticOrder S; S.init(NPR, DM, G, bx);
        pg8::EpiResid E{nullptr, (const bf16_t*)(ws + WS_H0), nullptr, (bf16_t*)(ws + WS_MIX), (float*)(ws + (rep_ ? WS_SSD : WS_SS2))};
        pg8::gemm_phase<pg8::EpiResid, pg8::StaticOrder, true, true>(lds3, g, S, E);
        for (int u = bx; u < 256; u += G) sample_gemm<0, 4>(lds, (const bf16_t*)(ws + WS_O) + (size_t)NPR * DM, DM, (const bf16_t*)(ws + WS_WCO), DM, u, nullptr, (const bf16_t*)(ws + WS_H0) + (size_t)NPR * DM, nullptr, (bf16_t*)(ws + WS_MIX) + (size_t)NPR * DM, (float*)(ws + (rep_ ? WS_SSD : WS_SS2)) + NPR, 1.0f);
    }
    SEAM(8);
    if (IN(9)) REPS(9) {
        pg8::Gemm g{(const bf16_t*)(ws + WS_MIX), (const bf16_t*)(ws + WS_WFFI), MT, NFF2, DM}; pg8::StaticOrder S; S.init(MT, NFF2, G, bx);
        pg8::EpiSwiGLU E{(bf16_t*)(ws + WS_A), (const float*)(ws + WS_SS2)};
        pg8::gemm_phase<pg8::EpiSwiGLU, pg8::StaticOrder, true, true>(lds3, g, S, E);
    }
    SEAM(9);
    if (IN(10)) {
        pg8::Gemm g{(const bf16_t*)(ws + WS_A), (const bf16_t*)(ws + WS_WFFO), NPR, DM, DFF}; pg8::StaticOrder S; S.init(NPR, DM, G, bx);
        if (G == 256) {
            pg8::EpiResidNorm E{(const bf16_t*)(ws + WS_MIX), args.out, (float*)(ws + WS_SS3), (unsigned*)(ws + WS_CNT), args.in[22]};
            pg8::gemm_phase<pg8::EpiResidNorm, pg8::StaticOrder, false, true>(lds3, g, S, E);
        } else {
            pg8::EpiResid E{nullptr, (const bf16_t*)(ws + WS_MIX), args.out, nullptr, (float*)(ws + WS_SS3)};
            pg8::gemm_phase<pg8::EpiResid, pg8::StaticOrder, true, true>(lds3, g, S, E);
        }
        for (int u = bx; u < 256; u += G) sample_gemm<0, 11>(lds, (const bf16_t*)(ws + WS_A) + (size_t)NPR * DFF, DFF, (const bf16_t*)(ws + WS_WFFO), DFF, u, nullptr, (const bf16_t*)(ws + WS_MIX) + (size_t)NPR * DM, args.out + O_YS, nullptr, (float*)(ws + WS_SS3) + NPR, 1.0f);
    }
    SEAM(10);
#ifdef EXTRA_SYNCS
    for (int i_ = 0; i_ < EXTRA_SYNCS; ++i_) xcd_barrier(bar);
#endif
    if (IN(11)) { final_norm(args, G, G == 256 ? NPR : 0); }
#ifdef SPINMASK
    STAMP(11);
    if (bx == SPINBLK && threadIdx.x == 0) { const unsigned long long t0_ = __builtin_amdgcn_s_memrealtime(); while (__builtin_amdgcn_s_memrealtime() - t0_ < t_acc_) __builtin_amdgcn_s_sleep(8); }
#endif
#undef IN
#undef SEAM
}

#ifndef MK_MULTI
#define MK_MULTI 0
#endif
extern "C" void kernel_launch(void* const* d_in, const int* in_sizes, int n_in, void* d_out, int out_size, void* d_ws, size_t ws_size, hipStream_t stream) {
    static int grid = 0;
    if (grid == 0) {
        if (n_in != 23 || ws_size < WS_END) { fprintf(stderr, "kernel_launch: unexpected n_in %d / ws_size %zu\n", n_in, ws_size); grid = -1; return; }
        int dev = 0, cus = 0, per_cu = 0;
        hipGetDevice(&dev); hipDeviceGetAttribute(&cus, hipDeviceAttributeMultiprocessorCount, dev);
        if (hipFuncSetAttribute((const void*)fwd_megakernel, hipFuncAttributeMaxDynamicSharedMemorySize, LDS_BYTES) != hipSuccess) { fprintf(stderr, "kernel_launch: hipFuncSetAttribute failed\n"); grid = -1; return; }
        hipOccupancyMaxActiveBlocksPerMultiprocessor(&per_cu, (const void*)fwd_megakernel, NTHREADS, LDS_BYTES);
        (void)hipGetLastError();
        if (per_cu < 1) { fprintf(stderr, "kernel_launch: occupancy query says %d blocks/CU\n", per_cu); per_cu = 1; }
        grid = cus;
    }
    if (grid < 0) return;
    Args a{};
    for (int i = 0; i < 23; ++i) a.in[i] = (const float*)d_in[i];
    a.out = (float*)d_out; a.ws = (unsigned char*)d_ws;
#if MK_MULTI
    for (int p = 0; p < NPHASES; ++p) { a.ph_lo = p; a.ph_hi = p + 1; hipLaunchKernelGGL(fwd_megakernel, dim3(grid), dim3(NTHREADS), LDS_BYTES, stream, a); }
#else
    a.ph_lo = 0; a.ph_hi = NPHASES;
    if (hipMemsetAsync((char*)d_ws + WS_BAR, 0, BAR_BYTES, stream) != hipSuccess) { fprintf(stderr, "kernel_launch: memset failed\n"); return; }
    void* kargs[] = {&a};
    hipError_t e = hipLaunchCooperativeKernel((const void*)fwd_megakernel, dim3(grid), dim3(NTHREADS), kargs, LDS_BYTES, stream);
    if (e != hipSuccess) fprintf(stderr, "kernel_launch: cooperative launch failed: %s (grid %d)\n", hipGetErrorString(e), grid);
#endif
}
```

```cpp
#include <hip/hip_runtime.h>
#include <hip/hip_cooperative_groups.h>
#include <cstdio>
#include <cstdint>
namespace cg = cooperative_groups;
namespace pg8 {
#define PG8_LAS __attribute__((address_space(3)))
typedef unsigned short bf16_t;
typedef short bf16x8 __attribute__((ext_vector_type(8)));
typedef float f32x4 __attribute__((ext_vector_type(4)));
typedef unsigned u32x4 __attribute__((ext_vector_type(4)));
constexpr int BM = 256, BK = 64, HALF = 128, HTB = HALF * BK * 2  , STAGE_BYTES = 8 * HTB, NXCD = 8, WGM = 8;

__host__ __device__ __forceinline__ int lds_byte(int r, int c) { const int st = (r >> 4) * 2 + (c >> 5), rr = r & 15, cc = c & 31, ob = rr * 64 + cc * 2; return st * 1024 + (ob ^ (((ob >> 9) & 1) << 5)); }
__host__ __device__ __forceinline__ void stage_rc(int b, int& R, int& C) { const int st = b / 1024, sb = b % 1024, swz = sb ^ (((sb >> 9) & 1) << 5); R = (st >> 1) * 16 + swz / 64; C = (st & 1) * 32 + (swz % 64) / 2; }
__host__ __device__ __forceinline__ int perm32(int rho) { const int n = rho >> 4, i = rho & 15; return 8 * (i >> 2) + 4 * n + (i & 3); }

struct Unit { int pm, pn; };
struct Gemm { const bf16_t* A; const bf16_t* Bt; int M, N, K; };

struct StaticOrder {
    int nM, nN, nwg, G, c;
    __host__ __device__ void init(int M, int N, int G_, int c_) { nM = M / BM; nN = N / BM; nwg = nM * nN; G = G_; c = c_; }
    __host__ __device__ bool next(int i, Unit& u) const {
        const long L = (long)i * G + c; if (L >= nwg) return false;
        int wgid = (int)L; { const int q = nwg / NXCD, r = nwg % NXCD, xcd = wgid % NXCD, off = wgid / NXCD; wgid = (xcd < r ? xcd * (q + 1) : r * (q + 1) + (xcd - r) * q) + off; }
        const int nig = WGM * nN, gid = wgid / nig, fm = gid * WGM, gsz = (nM - fm) < WGM ? (nM - fm) : WGM;
        u.pm = fm + ((wgid % nig) % gsz); u.pn = (wgid % nig) / gsz; return true;
    }
    __device__ __forceinline__ void a_ready(const Unit&) const {}
    __device__ __forceinline__ void done(const Unit&) const {}
};

__device__ __forceinline__ unsigned cvt_pk_bf16(float lo, float hi) { unsigned r; asm volatile("v_cvt_pk_bf16_f32 %0, %1, %2" : "=v"(r) : "v"(lo), "v"(hi)); return r; }
typedef unsigned u32x2 __attribute__((ext_vector_type(2)));
__device__ __forceinline__ float sigm(float z) { return __builtin_amdgcn_rcpf(1.0f + __expf(-z)); }
constexpr float RMS_EPS = 1e-6f;
#ifndef WT_STORES
#define WT_STORES 0
#endif
__device__ __forceinline__ void st16(void* p, u32x4 v) {
#if WT_STORES
    asm volatile("global_store_dwordx4 %0, %1, off sc1\n\ts_nop 1" :: "v"(p), "v"(v) : "memory");
#else
    *(u32x4*)p = v;
#endif
}
__device__ __forceinline__ void st16f(void* p, f32x4 v) { st16(p, __builtin_bit_cast(u32x4, v)); }
__device__ __forceinline__ void st8(void* p, u32x2 v) {
#if WT_STORES
    asm volatile("global_store_dwordx2 %0, %1, off sc1\n\ts_nop 1" :: "v"(p), "v"(v) : "memory");
#else
    *(u32x2*)p = v;
#endif
}
typedef _Float16 h2_t __attribute__((ext_vector_type(2)));
__device__ __forceinline__ unsigned pk_h2(float a, float b) { h2_t v; v.x = (_Float16)a; v.y = (_Float16)b; return __builtin_bit_cast(unsigned, v); }
__device__ __forceinline__ float h_lo(unsigned u) { return (float)__builtin_bit_cast(h2_t, u).x; }
__device__ __forceinline__ float h_hi(unsigned u) { return (float)__builtin_bit_cast(h2_t, u).y; }

struct EpiInProj {
    static constexpr bool PERM = true, AFTER_DRAIN = false;
    bf16_t *QQ, *KK, *VV, *GG; unsigned short *LF, *UU; const float* lbraw;
    __device__ __forceinline__ void operator()(const f32x4 (&acc)[2][2][4][2], const Unit& u, int wr, int wc, int fr, int fq) const {
        const int seg = u.pn >> 1, colt = (u.pn & 1) * 256;
        const int row0 = u.pm * BM + wr * 64 + fr;
#pragma unroll
        for (int bj = 0; bj < 2; ++bj) {
            const int cs = colt + bj * HALF + wc * 32 + 8 * fq;
            float lb[8];
            if (seg == 1) {
#pragma unroll
                for (int j = 0; j < 8; ++j) { const float l0 = lbraw[cs + j], l1 = lbraw[512 + cs + j]; lb[j] = __builtin_amdgcn_rcpf(1.0f + __expf(l1 - l0)); }
            } else {
#pragma unroll
                for (int j = 0; j < 8; ++j) lb[j] = 0.f;
            }
#pragma unroll
            for (int ai = 0; ai < 2; ++ai)
#pragma unroll
                for (int m = 0; m < 4; ++m) {
                    const size_t off = (size_t)(row0 + ai * HALF + m * 16) * 512 + cs;
                    const f32x4 v0 = acc[ai][bj][m][0], v1 = acc[ai][bj][m][1];
                    float z[8] = {v0[0], v0[1], v0[2], v0[3], v1[0], v1[1], v1[2], v1[3]};
                    if (seg == 0) {
#pragma unroll
                        for (int j = 0; j < 8; ++j) z[j] = z[j] * sigm(z[j]);
                        u32x4 w; w.x = cvt_pk_bf16(z[0], z[1]); w.y = cvt_pk_bf16(z[2], z[3]); w.z = cvt_pk_bf16(z[4], z[5]); w.w = cvt_pk_bf16(z[6], z[7]);
                        st16(QQ + off, w);
                    } else if (seg == 1) {
                        float lf[8], kk[8];
#pragma unroll
                        for (int j = 0; j < 8; ++j) { const float e = __expf(-z[j]); const float sg = __builtin_amdgcn_rcpf(1.0f + e); const float sgn = e * sg;
                            lf[j] = __logf(lb[j] + (1.0f - lb[j]) * sg); kk[j] = (1.0f - lb[j]) * sgn; }
                        { u32x4 w; w.x = pk_h2(lf[0], lf[1]); w.y = pk_h2(lf[2], lf[3]); w.z = pk_h2(lf[4], lf[5]); w.w = pk_h2(lf[6], lf[7]); st16(LF + off, w); }
                        u32x4 w; w.x = cvt_pk_bf16(kk[0], kk[1]); w.y = cvt_pk_bf16(kk[2], kk[3]); w.z = cvt_pk_bf16(kk[4], kk[5]); w.w = cvt_pk_bf16(kk[6], kk[7]);
                        st16(KK + off, w);
                    } else if (seg == 2) {
                        u32x4 w; w.x = cvt_pk_bf16(z[0], z[1]); w.y = cvt_pk_bf16(z[2], z[3]); w.z = cvt_pk_bf16(z[4], z[5]); w.w = cvt_pk_bf16(z[6], z[7]);
                        st16(VV + off, w);
                    } else if (seg == 3) {
#pragma unroll
                        for (int j = 0; j < 8; ++j) z[j] = sigm(z[j]);
                        u32x4 w; w.x = cvt_pk_bf16(z[0], z[1]); w.y = cvt_pk_bf16(z[2], z[3]); w.z = cvt_pk_bf16(z[4], z[5]); w.w = cvt_pk_bf16(z[6], z[7]);
                        st16(GG + off, w);
                    } else {
                        u32x4 w; w.x = pk_h2(z[0], z[1]); w.y = pk_h2(z[2], z[3]); w.z = pk_h2(z[4], z[5]); w.w = pk_h2(z[6], z[7]); st16(UU + off, w);
                    }
                }
        }
    }
};

struct EpiMemKV {
    static constexpr bool PERM = true, AFTER_DRAIN = false;
    float *outK, *outV; bf16_t* KB;
    __device__ __forceinline__ void operator()(const f32x4 (&acc)[2][2][4][2], const Unit& u, int wr, int wc, int fr, int fq) const {
        const bool isk = u.pn < 4; float* o = isk ? outK : outV; const int colt = (u.pn & 3) * 256;
        const int row0 = u.pm * BM + wr * 64 + fr;
#pragma unroll
        for (int ai = 0; ai < 2; ++ai)
#pragma unroll
            for (int m = 0; m < 4; ++m)
#pragma unroll
                for (int bj = 0; bj < 2; ++bj) {
                    const size_t off = (size_t)(row0 + ai * HALF + m * 16) * 1024 + colt + bj * HALF + wc * 32 + 8 * fq;
                    const f32x4 v0 = acc[ai][bj][m][0], v1 = acc[ai][bj][m][1];
                    *(f32x4*)(o + off) = v0; *(f32x4*)(o + off + 4) = v1;
                    if (isk) { u32x4 w; w.x = cvt_pk_bf16(v0[0], v0[1]); w.y = cvt_pk_bf16(v0[2], v0[3]); w.z = cvt_pk_bf16(v1[0], v1[1]); w.w = cvt_pk_bf16(v1[2], v1[3]); *(u32x4*)(KB + off) = w; }
                }
    }
};

struct EpiBf16Scale {
    static constexpr bool PERM = true, AFTER_DRAIN = false;
    bf16_t* O; int ldc; const float* ss; float scale;
    __device__ __forceinline__ void operator()(const f32x4 (&acc)[2][2][4][2], const Unit& u, int wr, int wc, int fr, int fq) const {
        const int row0 = u.pm * BM + wr * 64 + fr;
        float ssv[2][4];
#pragma unroll
        for (int ai = 0; ai < 2; ++ai)
#pragma unroll
            for (int m = 0; m < 4; ++m) ssv[ai][m] = ss ? ss[row0 + ai * HALF + m * 16] : 0.f;
#pragma unroll
        for (int ai = 0; ai < 2; ++ai)
#pragma unroll
            for (int m = 0; m < 4; ++m) {
                const int row = row0 + ai * HALF + m * 16;
                const float sc = ss ? scale * __builtin_amdgcn_rsqf(ssv[ai][m] * (1.0f / 1024.0f) + RMS_EPS) : scale;
#pragma unroll
                for (int bj = 0; bj < 2; ++bj) {
                    const size_t off = (size_t)row * ldc + u.pn * BM + bj * HALF + wc * 32 + 8 * fq;
                    const f32x4 v0 = acc[ai][bj][m][0] * sc, v1 = acc[ai][bj][m][1] * sc;
                    u32x4 w; w.x = cvt_pk_bf16(v0[0], v0[1]); w.y = cvt_pk_bf16(v0[2], v0[3]); w.z = cvt_pk_bf16(v1[0], v1[1]); w.w = cvt_pk_bf16(v1[2], v1[3]);
                    st16(O + off, w);
                }
            }
    }
};

struct EpiResid {
    static constexpr bool PERM = true, AFTER_DRAIN = false;
    const float* baseF;
    const bf16_t* baseB;
    float* out;
    bf16_t* outb;
    float* ss;
    __device__ __forceinline__ void operator()(const f32x4 (&acc)[2][2][4][2], const Unit& u, int wr, int wc, int fr, int fq) const {
        const int row0 = u.pm * BM + wr * 64 + fr;
#pragma unroll
        for (int ai = 0; ai < 2; ++ai) {
            f32x4 pre[4][2][2];
            if (baseF) {
#pragma unroll
                for (int m = 0; m < 4; ++m) { const float* bp = baseF + (size_t)(row0 + ai * HALF + m * 16) * 1024;
#pragma unroll
                    for (int bj = 0; bj < 2; ++bj) { const int col = u.pn * BM + bj * HALF + wc * 32 + 8 * fq; pre[m][bj][0] = __builtin_nontemporal_load((const f32x4*)(bp + col)); pre[m][bj][1] = __builtin_nontemporal_load((const f32x4*)(bp + col + 4)); } }
            } else {
                u32x4 pb[4][2];
#pragma unroll
                for (int m = 0; m < 4; ++m) { const bf16_t* bp = baseB + (size_t)(row0 + ai * HALF + m * 16) * 1024;
#pragma unroll
                    for (int bj = 0; bj < 2; ++bj) pb[m][bj] = *(const u32x4*)(bp + u.pn * BM + bj * HALF + wc * 32 + 8 * fq); }
#pragma unroll
                for (int m = 0; m < 4; ++m)
#pragma unroll
                    for (int bj = 0; bj < 2; ++bj) { const u32x4 p = pb[m][bj];
                        pre[m][bj][0] = (f32x4){__uint_as_float(p.x << 16), __uint_as_float(p.x & 0xffff0000u), __uint_as_float(p.y << 16), __uint_as_float(p.y & 0xffff0000u)};
                        pre[m][bj][1] = (f32x4){__uint_as_float(p.z << 16), __uint_as_float(p.z & 0xffff0000u), __uint_as_float(p.w << 16), __uint_as_float(p.w & 0xffff0000u)}; }
            }
#pragma unroll
            for (int m = 0; m < 4; ++m) {
                const int row = row0 + ai * HALF + m * 16;
                float s = 0.f;
#pragma unroll
                for (int bj = 0; bj < 2; ++bj) {
                    const int col = u.pn * BM + bj * HALF + wc * 32 + 8 * fq;
                    const f32x4 v0 = acc[ai][bj][m][0] + pre[m][bj][0], v1 = acc[ai][bj][m][1] + pre[m][bj][1];
                    s += (v0[0] * v0[0] + v0[1] * v0[1]) + (v0[2] * v0[2] + v0[3] * v0[3]) + (v1[0] * v1[0] + v1[1] * v1[1]) + (v1[2] * v1[2] + v1[3] * v1[3]);
                    if (out) { *(f32x4*)(out + (size_t)row * 1024 + col) = v0; *(f32x4*)(out + (size_t)row * 1024 + col + 4) = v1; }
                    if (outb) { u32x4 w; w.x = cvt_pk_bf16(v0[0], v0[1]); w.y = cvt_pk_bf16(v0[2], v0[3]); w.z = cvt_pk_bf16(v1[0], v1[1]); w.w = cvt_pk_bf16(v1[2], v1[3]); st16(outb + (size_t)row * 1024 + col, w); }
                }
                s += __shfl_xor(s, 16); s += __shfl_xor(s, 32);
                if (fq == 0) atomicAdd(ss + row, s);
            }
        }
    }
};

struct EpiResidNorm {
    static constexpr bool PERM = true, AFTER_DRAIN = true;
    const bf16_t* baseB; float* out; float* ss; unsigned* cnt; const float* gfin;
    __device__ __forceinline__ void fused(f32x4 (&acc)[2][2][4][2], const Unit& u, int wr, int wc, int fr, int fq, PG8_LAS unsigned char* lds, int wid, int lane) const {
        const int row0 = u.pm * BM + wr * 64 + fr;
#pragma unroll
        for (int ai = 0; ai < 2; ++ai) {
            u32x4 pb[4][2];
#pragma unroll
            for (int m = 0; m < 4; ++m) { const bf16_t* bp = baseB + (size_t)(row0 + ai * HALF + m * 16) * 1024;
#pragma unroll
                for (int bj = 0; bj < 2; ++bj) pb[m][bj] = *(const u32x4*)(bp + u.pn * BM + bj * HALF + wc * 32 + 8 * fq); }
#pragma unroll
            for (int m = 0; m < 4; ++m) { float s = 0.f;
#pragma unroll
                for (int bj = 0; bj < 2; ++bj) { const u32x4 p = pb[m][bj];
                    const f32x4 v0 = acc[ai][bj][m][0] + (f32x4){__uint_as_float(p.x << 16), __uint_as_float(p.x & 0xffff0000u), __uint_as_float(p.y << 16), __uint_as_float(p.y & 0xffff0000u)};
                    const f32x4 v1 = acc[ai][bj][m][1] + (f32x4){__uint_as_float(p.z << 16), __uint_as_float(p.z & 0xffff0000u), __uint_as_float(p.w << 16), __uint_as_float(p.w & 0xffff0000u)};
                    acc[ai][bj][m][0] = v0; acc[ai][bj][m][1] = v1;
                    s += (v0[0] * v0[0] + v0[1] * v0[1]) + (v0[2] * v0[2] + v0[3] * v0[3]) + (v1[0] * v1[0] + v1[1] * v1[1]) + (v1[2] * v1[2] + v1[3] * v1[3]); }
                s += __shfl_xor(s, 16); s += __shfl_xor(s, 32);
                if (fq == 0) atomicAdd(ss + row0 + ai * HALF + m * 16, s); }
        }
        asm volatile("s_waitcnt vmcnt(0)" ::: "memory");
        __syncthreads();
        if (threadIdx.x == 0) { unsigned* c = cnt + 64 * u.pm;
            __hip_atomic_fetch_add(c, 1u, __ATOMIC_RELEASE, __HIP_MEMORY_SCOPE_AGENT);
            unsigned sp = 0u; while (__hip_atomic_load(c, __ATOMIC_RELAXED, __HIP_MEMORY_SCOPE_AGENT) < 4u) { __builtin_amdgcn_s_sleep(2); if (++sp > (1u << 22)) break; }
            __builtin_amdgcn_fence(__ATOMIC_ACQUIRE, "agent"); }
        __syncthreads();
        float rs[2][4];
#pragma unroll
        for (int ai = 0; ai < 2; ++ai)
#pragma unroll
            for (int m = 0; m < 4; ++m) rs[ai][m] = __hip_atomic_load(ss + row0 + ai * HALF + m * 16, __ATOMIC_RELAXED, __HIP_MEMORY_SCOPE_AGENT);
        f32x4 gv[2][2];
#pragma unroll
        for (int bj = 0; bj < 2; ++bj) { const int col = u.pn * BM + bj * HALF + wc * 32 + 8 * fq; gv[bj][0] = *(const f32x4*)(gfin + col); gv[bj][1] = *(const f32x4*)(gfin + col + 4); }
#pragma unroll
        for (int ai = 0; ai < 2; ++ai)
#pragma unroll
            for (int m = 0; m < 4; ++m) { const int row = row0 + ai * HALF + m * 16; const float rstd = 1.0f / sqrtf(rs[ai][m] * (1.0f / 1024.0f) + RMS_EPS);
#pragma unroll
                for (int bj = 0; bj < 2; ++bj) { const int col = u.pn * BM + bj * HALF + wc * 32 + 8 * fq;
                    *(f32x4*)(out + (size_t)row * 1024 + col) = acc[ai][bj][m][0] * rstd * gv[bj][0]; *(f32x4*)(out + (size_t)row * 1024 + col + 4) = acc[ai][bj][m][1] * rstd * gv[bj][1]; } }
    }
};

struct EpiSwiGLU {
    static constexpr bool PERM = true, AFTER_DRAIN = false;
    bf16_t* ACT; const float* ss;
    __device__ __forceinline__ void operator()(const f32x4 (&acc)[2][2][4][2], const Unit& u, int wr, int wc, int fr, int fq) const {
        const int row0 = u.pm * BM + wr * 64 + fr;
        float ssv[2][4];
#pragma unroll
        for (int ai = 0; ai < 2; ++ai)
#pragma unroll
            for (int m = 0; m < 4; ++m) ssv[ai][m] = ss[row0 + ai * HALF + m * 16];
#pragma unroll
        for (int ai = 0; ai < 2; ++ai)
#pragma unroll
            for (int m = 0; m < 4; ++m) {
                const int row = row0 + ai * HALF + m * 16;
                const float r = __builtin_amdgcn_rsqf(ssv[ai][m] * (1.0f / 1024.0f) + RMS_EPS);
#pragma unroll
                for (int bj = 0; bj < 2; ++bj) {
                    const int J = u.pn * 128 + bj * 64 + wc * 16 + 4 * fq;
                    const f32x4 a = acc[ai][bj][m][0] * r, b = acc[ai][bj][m][1] * r;
                    float o[4];
#pragma unroll
                    for (int j = 0; j < 4; ++j) o[j] = a[j] * sigm(a[j]) * b[j];
                    u32x2 w; w.x = cvt_pk_bf16(o[0], o[1]); w.y = cvt_pk_bf16(o[2], o[3]);
                    st8(ACT + (size_t)row * 2816 + J, w);
                }
            }
    }
};

template <class Epi, class Sched, bool ALIGN_EPI = false, bool SP2 = false>
__device__ __forceinline__ void gemm_phase(PG8_LAS unsigned char* lds, const Gemm g, const Sched& S, const Epi& E) {
    const int tid = threadIdx.x, wid = __builtin_amdgcn_readfirstlane(tid >> 6), lane = tid & 63, wr = wid >> 2, wc = wid & 3, fr = lane & 15, fq = lane >> 4;
    const int K = g.K, nt = K / BK;
    unsigned voffA[2], voffB[2];
#pragma unroll
    for (int i = 0; i < 2; ++i) { int R, C; stage_rc(tid * 16 + i * 8192, R, C); const int Rb = Epi::PERM ? ((R & ~31) + perm32(R & 31)) : R;
        voffA[i] = (unsigned)(R * K + C) * 2u; voffB[i] = (unsigned)(Rb * K + C) * 2u; }
    const size_t kstep = (size_t)(BK * 2);
    const size_t hstep = (size_t)HALF * K * 2;
    const size_t tstep = 2 * hstep;
    const unsigned ldsw = (unsigned)wid * 1024u;
    const int aoff = lds_byte(wr * 64 + fr, fq * 8), boff = lds_byte(wc * 32 + fr, fq * 8);
#define PG8_SA(b, h) (((b) * 2 + (h)) * HTB)
#define PG8_SB(b, h) ((4 + (b) * 2 + (h)) * HTB)
#define PG8_STAGE(bufoff, gbase, voff) do { _Pragma("unroll") for (int _i = 0; _i < 2; ++_i) \
        __builtin_amdgcn_global_load_lds((const unsigned*)((const char*)(gbase) + (voff)[_i]), (PG8_LAS unsigned*)(lds + (bufoff) + ldsw + _i * 8192), 16, 0, 0); } while (0)
#define PG8_LDA(dst, b, h) do { _Pragma("unroll") for (int m = 0; m < 4; ++m) _Pragma("unroll") for (int k = 0; k < 2; ++k) dst[m][k] = *(const PG8_LAS bf16x8*)(lds + PG8_SA(b, h) + aoff + m * 2048 + k * 1024); } while (0)
#define PG8_LDB(dst, b, h) do { _Pragma("unroll") for (int n = 0; n < 2; ++n) _Pragma("unroll") for (int k = 0; k < 2; ++k) dst[n][k] = *(const PG8_LAS bf16x8*)(lds + PG8_SB(b, h) + boff + n * 2048 + k * 1024); } while (0)
#define PG8_MMA(ai, bj, At, Bt) do { __builtin_amdgcn_s_setprio(1); _Pragma("unroll") for (int m = 0; m < 4; ++m) _Pragma("unroll") for (int n = 0; n < 2; ++n) _Pragma("unroll") for (int k = 0; k < 2; ++k) \
        acc[ai][bj][m][n] = __builtin_amdgcn_mfma_f32_16x16x32_bf16(Bt[n][k], At[m][k], acc[ai][bj][m][n], 0, 0, 0); __builtin_amdgcn_s_setprio(0); } while (0)
#define PG8_WAIT_V(n) asm volatile("s_waitcnt vmcnt(" #n ")" ::: "memory")
#define PG8_WAIT_L(n) asm volatile("s_waitcnt lgkmcnt(" #n ")" ::: "memory")
#define PG8_BAR __builtin_amdgcn_s_barrier()
#define PG8_SCHED __builtin_amdgcn_sched_barrier(0)
    Unit cur, nxt; int ui = 0;
    if (!S.next(0, cur)) return;
    f32x4 acc[2][2][4][2];
#pragma unroll
    for (int a = 0; a < 2; ++a)
#pragma unroll
        for (int b = 0; b < 2; ++b)
#pragma unroll
            for (int m = 0; m < 4; ++m)
#pragma unroll
                for (int n = 0; n < 2; ++n) acc[a][b][m][n] = (f32x4){0.f, 0.f, 0.f, 0.f};
    bf16x8 At[4][2], B0[2][2], B1[2][2];
    const char* cA = (const char*)g.A + (size_t)cur.pm * tstep; const char* cB = (const char*)g.Bt + (size_t)cur.pn * tstep;
    S.a_ready(cur);
    if constexpr (SP2) {
        PG8_STAGE(PG8_SB(0, 0), cB, voffB); PG8_STAGE(PG8_SB(0, 1), cB + hstep, voffB); PG8_STAGE(PG8_SA(0, 0), cA, voffA); PG8_STAGE(PG8_SA(0, 1), cA + hstep, voffA);
        if (wr == 1) PG8_BAR;
        PG8_WAIT_V(2); PG8_BAR;
        PG8_STAGE(PG8_SB(1, 0), cB + kstep, voffB); PG8_STAGE(PG8_SA(1, 0), cA + kstep, voffA); PG8_STAGE(PG8_SB(1, 1), cB + hstep + kstep, voffB);
        PG8_WAIT_V(6); PG8_BAR;
    } else {
        PG8_STAGE(PG8_SB(0, 0), cB, voffB); PG8_STAGE(PG8_SA(0, 0), cA, voffA); PG8_STAGE(PG8_SB(0, 1), cB + hstep, voffB); PG8_STAGE(PG8_SA(0, 1), cA + hstep, voffA);
        if (wr == 1) PG8_BAR;
        PG8_WAIT_V(4); PG8_BAR;
        PG8_STAGE(PG8_SB(1, 0), cB + kstep, voffB); PG8_STAGE(PG8_SA(1, 0), cA + kstep, voffA); PG8_STAGE(PG8_SB(1, 1), cB + hstep + kstep, voffB);
        PG8_WAIT_V(6); PG8_BAR;
    }
    for (;;) {
        const bool has_next = S.next(ui + 1, nxt);
        const char* nA = has_next ? (const char*)g.A + (size_t)nxt.pm * tstep : cA; const char* nB = has_next ? (const char*)g.Bt + (size_t)nxt.pn * tstep : cB;
        for (int t = 0; t < nt; t += 2) {
            const bool last = (t == nt - 2);
            const char* a1 = cA + (size_t)(t + 1) * kstep;
            const char* a2 = last ? nA : cA + (size_t)(t + 2) * kstep; const char* b2 = last ? nB : cB + (size_t)(t + 2) * kstep;
            const char* a3 = a2 + kstep; const char* b3 = b2 + kstep;
            if (last && has_next) S.a_ready(nxt);
            if constexpr (SP2) {
            PG8_LDB(B0, 0, 0); PG8_LDB(B1, 0, 1); PG8_SCHED; PG8_LDA(At, 0, 0); PG8_STAGE(PG8_SA(1, 1), a1 + hstep, voffA);
            PG8_WAIT_V(8); PG8_WAIT_L(0); PG8_BAR; PG8_MMA(0, 0, At, B0); PG8_MMA(0, 1, At, B1); PG8_BAR; PG8_SCHED;
            PG8_LDA(At, 0, 1); PG8_STAGE(PG8_SB(0, 0), b2, voffB); PG8_STAGE(PG8_SB(0, 1), b2 + hstep, voffB); PG8_STAGE(PG8_SA(0, 0), a2, voffA);
            PG8_WAIT_V(8); PG8_WAIT_L(0); PG8_BAR; PG8_MMA(1, 0, At, B0); PG8_MMA(1, 1, At, B1); PG8_BAR; PG8_SCHED;
            PG8_LDB(B0, 1, 0); PG8_LDB(B1, 1, 1); PG8_SCHED; PG8_LDA(At, 1, 0); PG8_STAGE(PG8_SA(0, 1), a2 + hstep, voffA);
            PG8_WAIT_V(8); PG8_WAIT_L(0); PG8_BAR; PG8_MMA(0, 0, At, B0); PG8_MMA(0, 1, At, B1); PG8_BAR; PG8_SCHED;
            PG8_LDA(At, 1, 1); PG8_STAGE(PG8_SB(1, 0), b3, voffB); PG8_STAGE(PG8_SB(1, 1), b3 + hstep, voffB); PG8_STAGE(PG8_SA(1, 0), a3, voffA);
            PG8_WAIT_V(8); PG8_WAIT_L(0); PG8_BAR; PG8_MMA(1, 0, At, B0); PG8_MMA(1, 1, At, B1); PG8_BAR; PG8_SCHED;
            } else {
            PG8_LDB(B0, 0, 0); PG8_SCHED; PG8_LDA(At, 0, 0); PG8_STAGE(PG8_SA(1, 1), a1 + hstep, voffA);
            PG8_WAIT_L(8); PG8_BAR; PG8_WAIT_L(0); PG8_MMA(0, 0, At, B0); PG8_BAR; PG8_SCHED;
            PG8_LDB(B1, 0, 1); PG8_STAGE(PG8_SB(0, 0), b2, voffB);
            PG8_BAR; PG8_WAIT_L(0); PG8_MMA(0, 1, At, B1); PG8_BAR;
            PG8_LDA(At, 0, 1); PG8_STAGE(PG8_SA(0, 0), a2, voffA);
            PG8_BAR; PG8_WAIT_L(0); PG8_MMA(1, 0, At, B0); PG8_BAR; PG8_SCHED;
            PG8_STAGE(PG8_SB(0, 1), b2 + hstep, voffB);
            PG8_WAIT_V(6); PG8_BAR; PG8_MMA(1, 1, At, B1); PG8_BAR;
            PG8_LDB(B0, 1, 0); PG8_SCHED; PG8_LDA(At, 1, 0); PG8_STAGE(PG8_SA(0, 1), a2 + hstep, voffA);
            PG8_WAIT_L(8); PG8_BAR; PG8_WAIT_L(0); PG8_MMA(0, 0, At, B0); PG8_BAR; PG8_SCHED;
            PG8_LDB(B1, 1, 1); PG8_STAGE(PG8_SB(1, 0), b3, voffB);
            PG8_BAR; PG8_WAIT_L(0); PG8_MMA(0, 1, At, B1); PG8_BAR;
            PG8_LDA(At, 1, 1); PG8_STAGE(PG8_SA(1, 0), a3, voffA);
            PG8_BAR; PG8_WAIT_L(0); PG8_MMA(1, 0, At, B0); PG8_BAR; PG8_SCHED;
            PG8_STAGE(PG8_SB(1, 1), b3 + hstep, voffB);
            PG8_WAIT_V(6); PG8_BAR; PG8_MMA(1, 1, At, B1); PG8_BAR;
            }
        }
        if constexpr (ALIGN_EPI) { if (wr == 0) PG8_BAR; }
        if constexpr (!Epi::AFTER_DRAIN) { E(acc, cur, wr, wc, fr, fq); S.done(cur); }
        if (!has_next) break;
#pragma unroll
        for (int a = 0; a < 2; ++a)
#pragma unroll
            for (int b = 0; b < 2; ++b)
#pragma unroll
                for (int m = 0; m < 4; ++m)
#pragma unroll
                    for (int n = 0; n < 2; ++n) acc[a][b][m][n] = (f32x4){0.f, 0.f, 0.f, 0.f};
        cur = nxt; cA = nA; cB = nB; ++ui;
        if constexpr (ALIGN_EPI) { if (wr == 1) PG8_BAR; }
    }
    PG8_WAIT_V(0);
    if constexpr (!ALIGN_EPI) { if (wr == 0) PG8_BAR; }
    PG8_BAR;
    if constexpr (Epi::AFTER_DRAIN) { E.fused(acc, cur, wr, wc, fr, fq, lds, wid, lane); S.done(cur); }
#undef PG8_SA
#undef PG8_SB
#undef PG8_STAGE
#undef PG8_LDA
#undef PG8_LDB
#undef PG8_MMA
#undef PG8_WAIT_V
#undef PG8_WAIT_L
#undef PG8_BAR
#undef PG8_SCHED
}
}
#define LAS __attribute__((address_space(3)))
#define XB_TMO      128
#define XB_XCNT(j)  (256  + 64 * (j))
#define XB_XSUB(j)  (1280 + 64 * (j))
#define XB_XGEN(j)  (2304 + 64 * (j))
#define XB_TOP      3328
#define XB_TOPGEN   3392
#define XCD_BAR_WORDS 3456
#define XB_SPIN_CAP (1u << 18)

__device__ __forceinline__ unsigned xb_ld(unsigned* p)              { return __hip_atomic_load(p, __ATOMIC_RELAXED, __HIP_MEMORY_SCOPE_AGENT); }
__device__ __forceinline__ unsigned xb_add(unsigned* p, unsigned v) { return __hip_atomic_fetch_add(p, v, __ATOMIC_RELAXED, __HIP_MEMORY_SCOPE_AGENT); }
__device__ __forceinline__ unsigned xb_xcc_id() { return (unsigned)__builtin_amdgcn_s_getreg((3 << 11) | 20) & 0xFu; }
#define XB_SPIN(cond, bar) do { unsigned _sp = 0; while (cond) { __builtin_amdgcn_s_sleep(1); \
    if ((++_sp & 255u) == 0u) { if (xb_ld(&(bar)[XB_TMO])) break; if (_sp > XB_SPIN_CAP) { atomicAdd(&(bar)[XB_TMO], 1u); break; } } } } while (0)

struct XcdBarrier {
    unsigned* bar; unsigned x;
    volatile LAS unsigned* st;
};

__device__ __forceinline__ XcdBarrier xcd_barrier_post(unsigned* bar, volatile LAS unsigned* st) {
    XcdBarrier b; b.bar = bar; b.x = xb_xcc_id(); b.st = st;
    if (threadIdx.x == 0) (void)xb_add(&bar[XB_XCNT(b.x)], 1u);
    return b;
}
__device__ __forceinline__ void xcd_barrier_complete(unsigned* bar, unsigned x, unsigned& nloc, unsigned& nx) {
    const unsigned G = gridDim.x * gridDim.y * gridDim.z;
    unsigned sum, cnt, mine, sp = 0u;
    for (;;) {
        sum = 0u; cnt = 0u; mine = 0u;
#pragma unroll
        for (unsigned j = 0; j < 16; ++j) { const unsigned c = xb_ld(&bar[XB_XCNT(j)]); sum += c; cnt += (c > 0u) ? 1u : 0u; mine = (j == x) ? c : mine; }
        if (sum == G) break;
        __builtin_amdgcn_s_sleep(1);
        if ((++sp & 255u) == 0u) { if (xb_ld(&bar[XB_TMO])) break; if (sp > XB_SPIN_CAP) { atomicAdd(&bar[XB_TMO], 1u); break; } }
    }
    nloc = mine > 0u ? mine : 1u; nx = cnt > 0u ? cnt : 1u;
}

__device__ __forceinline__ void xcd_barrier(const XcdBarrier& b) {
    asm volatile("s_waitcnt vmcnt(0)" ::: "memory");
    __syncthreads();
    if (threadIdx.x == 0) {
        unsigned* bar = b.bar;
        __builtin_amdgcn_s_waitcnt(0);
        unsigned nloc = b.st[0], nx = b.st[1];
        if (nloc == 0u) { xcd_barrier_complete(bar, b.x, nloc, nx); b.st[0] = nloc; b.st[1] = nx; }
        const unsigned old = xb_add(&bar[XB_XSUB(b.x)], 1u);
        const unsigned gen = old / nloc;
        if (old + 1u == (gen + 1u) * nloc) {
            __builtin_amdgcn_fence(__ATOMIC_RELEASE, "agent");
            asm volatile("s_waitcnt vmcnt(0)" ::: "memory");
            const unsigned og = xb_add(&bar[XB_TOP], 1u);
            const unsigned tg = og / nx;
            if (og + 1u == (tg + 1u) * nx) xb_add(&bar[XB_TOPGEN], 1u);
            else XB_SPIN(xb_ld(&bar[XB_TOPGEN]) == tg, bar);
            __builtin_amdgcn_fence(__ATOMIC_ACQUIRE, "agent");
            xb_add(&bar[XB_XGEN(b.x)], 1u);
            asm volatile("s_waitcnt vmcnt(0)" ::: "memory");
        } else {
            XB_SPIN(xb_ld(&bar[XB_XGEN(b.x)]) == gen, bar);
            __builtin_amdgcn_fence(__ATOMIC_ACQUIRE, "agent");
            asm volatile("s_waitcnt vmcnt(0)" ::: "memory");
        }
    }
    __syncthreads();
}

using pg8::bf16_t; using pg8::f32x4; using pg8::u32x4; using pg8::bf16x8; using pg8::pk_h2; using pg8::h_lo; using pg8::h_hi;
typedef unsigned u32x2v __attribute__((ext_vector_type(2)));
constexpr int DM = 1024, NPR = 16384, NSM = 128, MT = 16640, NVALID = 16512, SEQ = 2048;
constexpr int HW = 512, NIN = 2560, DFF = 2816, NFF2 = 5632, MEMR = 2048;
constexpr float EPS = 1e-6f;
constexpr int NTHREADS = 512;
constexpr int LDS_BYTES = 147456;

constexpr size_t O_YP = 0, O_YS = 16777216, O_HP = 16908288, O_PP = 17432576, O_MK = 17494016, O_MV = 19591168, O_HS = 21688320, O_PS = 30076928;

constexpr size_t MiB = 1u << 20;
constexpr size_t WS_SS1 = 0, WS_SS2 = 128 * 1024, WS_SS3 = 256 * 1024, WS_BAR = 512 * 1024, BAR_BYTES = 65536, WS_SSD = 384 * 1024, WS_CNT = WS_BAR + 16384;
constexpr size_t WS_WIN = 1 * MiB, WS_WOUT = 6 * MiB, WS_WCQ = 8 * MiB, WS_WCO = 10 * MiB, WS_WFFI = 12 * MiB, WS_WFFO = 23 * MiB, WS_WKV = 29 * MiB, WS_PMIX = 33 * MiB;
constexpr size_t WS_MEMH = 34 * MiB, WS_KB = 38 * MiB, WS_VT = 42 * MiB, WS_DEC = 46 * MiB;
constexpr size_t WS_H0 = 47 * MiB;
constexpr size_t WS_MIX = 80 * MiB;
constexpr size_t WS_X1 = 113 * MiB;
constexpr size_t WS_Q = 178 * MiB;
constexpr size_t WS_O = 211 * MiB;
constexpr size_t WS_SL = 244 * MiB;
constexpr size_t WS_A = 309 * MiB;
constexpr size_t WS_QQ = WS_A, WS_KK = WS_A + 17 * MiB, WS_VV = WS_A + 34 * MiB, WS_GG = WS_A + 51 * MiB, WS_LF = WS_A + 68 * MiB, WS_UU = WS_A + 101 * MiB;
constexpr size_t WS_END = 443 * MiB;

struct Args { const float* in[23]; float* out; unsigned char* ws; int ph_lo, ph_hi; };

typedef float f32x2_t __attribute__((ext_vector_type(2))); typedef __bf16 bf16x2_t __attribute__((ext_vector_type(2)));
__device__ __forceinline__ unsigned pk2(float lo, float hi) { const f32x2_t v = {lo, hi}; const bf16x2_t b = __builtin_convertvector(v, bf16x2_t); return __builtin_bit_cast(unsigned, b); }
__device__ __forceinline__ unsigned f2bf(float f) { return pk2(f, 0.f) & 0xffffu; }
__device__ __forceinline__ float bf2f(unsigned h) { return __uint_as_float(h << 16); }
__device__ __forceinline__ float bfe(const u32x4& v, int j) { const unsigned w = v[j >> 1]; return (j & 1) ? __uint_as_float(w & 0xffff0000u) : __uint_as_float(w << 16); }
__device__ __forceinline__ unsigned short bfr(const u32x4& v, int j) { const unsigned w = v[j >> 1]; return (unsigned short)((j & 1) ? (w >> 16) : (w & 0xffffu)); }
__device__ __forceinline__ float wave_sum(float v) {
#pragma unroll
    for (int o = 1; o < 64; o <<= 1) v += __shfl_xor(v, o);
    return v;
}
#define MFMA16(a, b, c) __builtin_amdgcn_mfma_f32_16x16x32_bf16((a), (b), (c), 0, 0, 0)

template <int MODE>
__device__ __forceinline__ void tr_item(const float* W, int K, int N, bf16_t* WT, const float* gk, float* scr, int item, int lane) {
    const int nblk = N / 32, kb = item / nblk, nb = item % nblk, k0 = 64 * kb, n0 = 32 * nb;
    f32x4 wv[8];
#pragma unroll
    for (int i = 0; i < 8; ++i) { const int kk = 8 * i + (lane >> 3); wv[i] = __builtin_nontemporal_load((const f32x4*)(W + (size_t)(k0 + kk) * N + n0 + (lane & 7) * 4)); }
#pragma unroll
    for (int i = 0; i < 8; ++i) { const int kk = 8 * i + (lane >> 3); float* d = scr + kk * 33 + (lane & 7) * 4; d[0] = wv[i][0]; d[1] = wv[i][1]; d[2] = wv[i][2]; d[3] = wv[i][3]; }
    asm volatile("s_waitcnt lgkmcnt(0)" ::: "memory");
    const int c = lane & 7;
    float g8[8];
#pragma unroll
    for (int i = 0; i < 8; ++i) g8[i] = gk ? gk[k0 + 8 * c + i] : 1.0f;
#pragma unroll
    for (int j = 0; j < 4; ++j) { const int n = (lane >> 3) + 8 * j; const float* s = scr + (8 * c) * 33 + n;
        u32x4 o; o.x = pk2(s[0 * 33] * g8[0], s[1 * 33] * g8[1]); o.y = pk2(s[2 * 33] * g8[2], s[3 * 33] * g8[3]); o.z = pk2(s[4 * 33] * g8[4], s[5 * 33] * g8[5]); o.w = pk2(s[6 * 33] * g8[6], s[7 * 33] * g8[7]);
        int row = n0 + n;
        if (MODE == 1) { const int half = row >= DFF ? 1 : 0; const int J = row - half * DFF;
            row = 256 * (J >> 7) + 128 * ((J >> 6) & 1) + 32 * ((J >> 4) & 3) + 8 * ((J >> 2) & 3) + 4 * half + (J & 3); }
        *(u32x4*)(WT + (size_t)row * K + k0 + 8 * c) = o; }
    asm volatile("s_waitcnt lgkmcnt(0)" ::: "memory");
}
__device__ __forceinline__ void rms_row_to_bf16(const float* xrow, const float* g, bf16_t* orow, int lane) {
    const f32x4* xr = (const f32x4*)xrow + lane; const f32x4* gr = (const f32x4*)g + lane;
    f32x4 v[4]; float s = 0.f;
#pragma unroll
    for (int j = 0; j < 4; ++j) { v[j] = xr[64 * j]; s += (v[j].x * v[j].x + v[j].y * v[j].y) + (v[j].z * v[j].z + v[j].w * v[j].w); }
    const float rstd = 1.0f / sqrtf(wave_sum(s) * (1.f / DM) + EPS);
    unsigned long long* o8 = (unsigned long long*)orow + lane;
#pragma unroll
    for (int j = 0; j < 4; ++j) { const f32x4 gg = gr[64 * j];
        o8[64 * j] = (unsigned long long)pk2(v[j].x * rstd * gg.x, v[j].y * rstd * gg.y) | ((unsigned long long)pk2(v[j].z * rstd * gg.z, v[j].w * rstd * gg.w) << 32); }
}
__device__ __forceinline__ void rms_row2_to_bf16(const float* xrow, const float* g, bf16_t* orow, int lane) {
    const f32x4* xr = (const f32x4*)xrow + lane; const f32x4* gr = (const f32x4*)g + lane;
    f32x4 v[2][4]; float s[2] = {0.f, 0.f};
#pragma unroll
    for (int r = 0; r < 2; ++r)
#pragma unroll
        for (int j = 0; j < 4; ++j) v[r][j] = __builtin_nontemporal_load(xr + r * 256 + 64 * j);
#pragma unroll
    for (int r = 0; r < 2; ++r)
#pragma unroll
        for (int j = 0; j < 4; ++j) s[r] += (v[r][j].x * v[r][j].x + v[r][j].y * v[r][j].y) + (v[r][j].z * v[r][j].z + v[r][j].w * v[r][j].w);
#pragma unroll
    for (int r = 0; r < 2; ++r) { const float rstd = 1.0f / sqrtf(wave_sum(s[r]) * (1.f / DM) + EPS); unsigned long long* o8 = (unsigned long long*)(orow + (size_t)r * DM) + lane;
#pragma unroll
        for (int j = 0; j < 4; ++j) { const f32x4 gg = gr[64 * j];
            o8[64 * j] = (unsigned long long)pk2(v[r][j].x * rstd * gg.x, v[r][j].y * rstd * gg.y) | ((unsigned long long)pk2(v[r][j].z * rstd * gg.z, v[r][j].w * rstd * gg.w) << 32); } }
}
__device__ __forceinline__ void p0_prologue(const Args& A, unsigned char* lds, int G) {
    const int tid = threadIdx.x, lane = tid & 63, wave = tid >> 6;
    float* scr = (float*)(lds + wave * 16384);
    unsigned char* ws = A.ws;
    const int gw = blockIdx.x * 8 + wave, NGW = G * 8;
    constexpr int I_IN = 16 * 80, I_OUT = 16 * 32, I_CQ = 16 * 32, I_CO = 16 * 32, I_FFI = 16 * 176, I_FFO = 44 * 32, I_KV = 16 * 64, I_PM = 4 * 8;
    constexpr int NITEMS = I_IN + I_OUT + I_CQ + I_CO + I_FFI + I_FFO + I_KV + I_PM;
    for (int it = gw; it < NITEMS; it += NGW) {
        int r = it;
        if (r < I_IN) { tr_item<0>(A.in[8], DM, NIN, (bf16_t*)(ws + WS_WIN), nullptr, scr, r, lane); continue; } r -= I_IN;
        if (r < I_OUT) { tr_item<0>(A.in[13], DM, DM, (bf16_t*)(ws + WS_WOUT), nullptr, scr, r, lane); continue; } r -= I_OUT;
        if (r < I_CQ) { tr_item<0>(A.in[17], DM, DM, (bf16_t*)(ws + WS_WCQ), A.in[16], scr, r, lane); continue; } r -= I_CQ;
        if (r < I_CO) { tr_item<0>(A.in[18], DM, DM, (bf16_t*)(ws + WS_WCO), nullptr, scr, r, lane); continue; } r -= I_CO;
        if (r < I_FFI) { tr_item<1>(A.in[20], DM, NFF2, (bf16_t*)(ws + WS_WFFI), A.in[19], scr, r, lane); continue; } r -= I_FFI;
        if (r < I_FFO) { tr_item<0>(A.in[21], DFF, DM, (bf16_t*)(ws + WS_WFFO), nullptr, scr, r, lane); continue; } r -= I_FFO;
        if (r < I_KV) { tr_item<0>(A.in[15], DM, 2 * DM, (bf16_t*)(ws + WS_WKV), nullptr, scr, r, lane); continue; } r -= I_KV;
        { const int g = r >> 3; tr_item<0>(A.in[11] + (size_t)g * 128 * 128, 128, 128, (bf16_t*)(ws + WS_PMIX) + (size_t)g * 128 * 128, nullptr, scr, r & 7, lane); }
    }
    bf16_t* H0 = (bf16_t*)(ws + WS_H0);
    for (int m = gw * 2; m < NVALID; m += NGW * 2) { const float* xr = m < NPR ? A.in[0] + (size_t)m * DM : A.in[1] + (size_t)(m - NPR) * DM; rms_row2_to_bf16(xr, A.in[7], H0 + (size_t)m * DM, lane); }
    bf16_t* MEMH = (bf16_t*)(ws + WS_MEMH);
    for (int m = gw; m < MEMR; m += NGW) rms_row_to_bf16(A.in[2] + (size_t)m * DM, A.in[14], MEMH + (size_t)m * DM, lane);
    const int gt = blockIdx.x * NTHREADS + tid, NGT = G * NTHREADS;
    for (int i = gt; i < (MT - NVALID) * DM / 8; i += NGT) { const u32x4 z = {0u, 0u, 0u, 0u};
        ((u32x4*)(ws + WS_H0) + (size_t)NVALID * DM / 8)[i] = z; ((u32x4*)(ws + WS_MIX) + (size_t)NVALID * DM / 8)[i] = z; ((u32x4*)(ws + WS_O) + (size_t)NVALID * DM / 8)[i] = z; }
    for (int i = gt; i < MT; i += NGT) { ((float*)(ws + WS_SS1))[i] = 0.f; ((float*)(ws + WS_SS2))[i] = 0.f; ((float*)(ws + WS_SS3))[i] = 0.f; }
}

constexpr int BS = 129;
constexpr int L_BC = 0, L_TOT = 33024, L_QM = 35072, L_KM = 52480, L_VT = 69888, L_SP = 88320, L_AL = 123136, L_PART = 132352, L_EM = 132864;
constexpr size_t WS_SPT = WS_X1;
__device__ __forceinline__ void hgrn_lf_load(u32x2v (&lf)[4], const unsigned short* LF, int R0, int C0, int t) {
#pragma unroll
    for (int i = 0; i < 4; ++i) { const int idx = i * 512 + t, s = idx >> 5, k4 = idx & 31; lf[i] = *(const u32x2v*)(LF + (size_t)(R0 + s) * HW + C0 + k4 * 4); }
}
__device__ __forceinline__ void hgrn_cumsum(const u32x2v (&lf)[4], float* Bc, float* tot, int t) {
#pragma unroll
    for (int i = 0; i < 4; ++i) { const int idx = i * 512 + t, s = idx >> 5, k4 = idx & 31; const u32x2v v = lf[i];
        float* d = Bc + s * BS + k4 * 4; d[0] = h_lo(v.x); d[1] = h_hi(v.x); d[2] = h_lo(v.y); d[3] = h_hi(v.y); }
    __syncthreads();
    const int seg = t >> 7, k = t & 127; float run = 0.f;
#pragma unroll
    for (int i = 0; i < 16; ++i) { run += Bc[(seg * 16 + i) * BS + k]; Bc[(seg * 16 + i) * BS + k] = run; }
    tot[seg * 128 + k] = run;
    __syncthreads();
    float off = 0.f;
#pragma unroll
    for (int j = 0; j < 3; ++j) off += (j < seg) ? tot[j * 128 + k] : 0.f;
#pragma unroll
    for (int i = 0; i < 16; ++i) Bc[(seg * 16 + i) * BS + k] += off;
    __syncthreads();
}
__device__ __forceinline__ void hgrn_local_load(const Args& A, int unit, u32x2v (&lf)[4], u32x4 (&kkr)[2], u32x4 (&vvr)[2]) {
    const int t = threadIdx.x, w = t >> 6, l = t & 63;
    const int bh = unit >> 5, c = unit & 31, b = bh >> 2, h = bh & 3, R0 = b * SEQ + c * 64, C0 = h * 128;
    const bf16_t* KK = (const bf16_t*)(A.ws + WS_KK); const bf16_t* VV = (const bf16_t*)(A.ws + WS_VV);
    hgrn_lf_load(lf, (const unsigned short*)(A.ws + WS_LF), R0, C0, t);
#pragma unroll
    for (int i = 0; i < 2; ++i) { const int k0 = (w + 8 * i) * 8; kkr[i] = *(const u32x4*)(KK + (size_t)(R0 + l) * HW + C0 + k0); vvr[i] = *(const u32x4*)(VV + (size_t)(R0 + l) * HW + C0 + k0); }
}
__device__ __forceinline__ void hgrn_local_unit(const Args& A, unsigned char* lds, int unit, int next, u32x2v (&lf)[4], u32x4 (&kkr)[2], u32x4 (&vvr)[2]) {
    const int t = threadIdx.x, w = t >> 6, l = t & 63, lr = l & 15, lq = l >> 4;
    const int bh = unit >> 5, c = unit & 31, b = bh >> 2, h = bh & 3, R0 = b * SEQ + c * 64, C0 = h * 128;
    unsigned char* ws = A.ws;
    float* Bc = (float*)(lds + L_BC); float* tot = (float*)(lds + L_TOT);
    bf16_t* kdT = (bf16_t*)(lds + L_QM); bf16_t* vT = (bf16_t*)(lds + L_VT);
    hgrn_cumsum(lf, Bc, tot, t);
#pragma unroll
    for (int i = 0; i < 2; ++i) { const int s = l, k0 = (w + 8 * i) * 8;
        const u32x4 kk = kkr[i], vv = vvr[i];
#pragma unroll
        for (int j = 0; j < 8; ++j) { const float e = __expf(Bc[63 * BS + k0 + j] - Bc[s * BS + k0 + j]);
            kdT[(k0 + j) * 72 + s] = (bf16_t)f2bf(bfe(kk, j) * e); vT[(k0 + j) * 72 + s] = bfr(vv, j); } }
    if (next >= 0) hgrn_local_load(A, next, lf, kkr, vvr);
    __syncthreads();
    f32x4 acc[8];
#pragma unroll
    for (int i = 0; i < 8; ++i) acc[i] = (f32x4){0.f, 0.f, 0.f, 0.f};
#pragma unroll
    for (int ks = 0; ks < 2; ++ks) { const bf16x8 a = *(const bf16x8*)(kdT + (16 * w + lr) * 72 + ks * 32 + lq * 8);
#pragma unroll
        for (int vt = 0; vt < 8; ++vt) { const bf16x8 bb = *(const bf16x8*)(vT + (16 * vt + lr) * 72 + ks * 32 + lq * 8); acc[vt] = MFMA16(a, bb, acc[vt]); } }
    unsigned short* SLT = (unsigned short*)(ws + WS_SL) + (size_t)unit * 16384;
#pragma unroll
    for (int vt = 0; vt < 8; ++vt) { u32x2v o; o.x = pk_h2(acc[vt][0], acc[vt][1]); o.y = pk_h2(acc[vt][2], acc[vt][3]); *(u32x2v*)(SLT + (16 * vt + lr) * 128 + 16 * w + lq * 4) = o; }
    if (t < 128) ((float*)(ws + WS_DEC))[unit * 128 + t] = __expf(Bc[63 * BS + t]);
    __syncthreads();
}
__device__ __forceinline__ void hgrn_out_load(const Args& A, int unit, u32x2v (&lf)[4], u32x4 (&qqr)[2], u32x4 (&kkr)[2], u32x4 (&vvr)[2], u32x4 (&spr)[4]) {
    const int t = threadIdx.x, w = t >> 6, l = t & 63;
    const int bh = unit >> 5, c = unit & 31, b = bh >> 2, h = bh & 3, R0 = b * SEQ + c * 64, C0 = h * 128;
    const bf16_t* QQ = (const bf16_t*)(A.ws + WS_QQ); const bf16_t* KK = (const bf16_t*)(A.ws + WS_KK); const bf16_t* VV = (const bf16_t*)(A.ws + WS_VV);
    hgrn_lf_load(lf, (const unsigned short*)(A.ws + WS_LF), R0, C0, t);
#pragma unroll
    for (int i = 0; i < 2; ++i) { const int idx = (i * 512 + t) * 8, s = idx >> 7, k0 = idx & 127; const size_t go = (size_t)(R0 + s) * HW + C0 + k0; qqr[i] = *(const u32x4*)(QQ + go); kkr[i] = *(const u32x4*)(KK + go);
        vvr[i] = *(const u32x4*)(VV + (size_t)(R0 + l) * HW + C0 + (w + 8 * i) * 8); }
    const bf16_t* SPT = (const bf16_t*)(A.ws + WS_SPT) + (size_t)unit * 16384;
#pragma unroll
    for (int i = 0; i < 4; ++i) { const int idx = i * 512 + t; spr[i] = *(const u32x4*)(SPT + (idx >> 4) * 128 + (idx & 15) * 8); }
}
__device__ __forceinline__ void hgrn_out_unit(const Args& A, unsigned char* lds, int unit, int next, u32x2v (&lf)[4], u32x4 (&qqr)[2], u32x4 (&kkr)[2], u32x4 (&vvr)[2], u32x4 (&spr)[4]) {
    const int t = threadIdx.x, w = t >> 6, l = t & 63, lr = l & 15, lq = l >> 4;
    const int bh = unit >> 5, c = unit & 31, b = bh >> 2, h = bh & 3, R0 = b * SEQ + c * 64, C0 = h * 128;
    unsigned char* ws = A.ws;
    float* Bc = (float*)(lds + L_BC); float* tot = (float*)(lds + L_TOT); float* part = (float*)(lds + L_PART); float* em = (float*)(lds + L_EM);
    bf16_t* qm = (bf16_t*)(lds + L_QM); bf16_t* km = (bf16_t*)(lds + L_KM); bf16_t* vT = (bf16_t*)(lds + L_VT); bf16_t* spT = (bf16_t*)(lds + L_SP); bf16_t* aL = (bf16_t*)(lds + L_AL);
    u32x4 ggr[2];
#pragma unroll
    for (int hh = 0; hh < 2; ++hh) ggr[hh] = *(const u32x4*)((const bf16_t*)(ws + WS_GG) + (size_t)(R0 + (t >> 3)) * HW + C0 + (t & 7) * 16 + hh * 8);
    hgrn_cumsum(lf, Bc, tot, t);
    if (t < 128) em[t] = __expf(Bc[31 * BS + t]);
#pragma unroll
    for (int i = 0; i < 2; ++i) { const int idx = (i * 512 + t) * 8, s = idx >> 7, k0 = idx & 127;
        const u32x4 qq = qqr[i], kk = kkr[i];
        float qv[8], kv[8];
#pragma unroll
        for (int j = 0; j < 8; ++j) { const float d = Bc[s * BS + k0 + j] - Bc[31 * BS + k0 + j]; qv[j] = bfe(qq, j) * __expf(d); kv[j] = bfe(kk, j) * __expf(-d); }
        u32x4 o; o.x = pk2(qv[0], qv[1]); o.y = pk2(qv[2], qv[3]); o.z = pk2(qv[4], qv[5]); o.w = pk2(qv[6], qv[7]); *(u32x4*)(qm + s * 136 + k0) = o;
        o.x = pk2(kv[0], kv[1]); o.y = pk2(kv[2], kv[3]); o.z = pk2(kv[4], kv[5]); o.w = pk2(kv[6], kv[7]); *(u32x4*)(km + s * 136 + k0) = o; }
#pragma unroll
    for (int i = 0; i < 2; ++i) { const int s = l, k0 = (w + 8 * i) * 8; const u32x4 vv = vvr[i];
#pragma unroll
        for (int j = 0; j < 8; ++j) vT[(k0 + j) * 72 + s] = bfr(vv, j); }
    __syncthreads();
    {
#pragma unroll
        for (int i = 0; i < 4; ++i) { const int idx = i * 512 + t, v = idx >> 4, k0 = (idx & 15) * 8; const u32x4 sv = spr[i];
            u32x4 o; o.x = pk2(bfe(sv, 0) * em[k0], bfe(sv, 1) * em[k0 + 1]); o.y = pk2(bfe(sv, 2) * em[k0 + 2], bfe(sv, 3) * em[k0 + 3]); o.z = pk2(bfe(sv, 4) * em[k0 + 4], bfe(sv, 5) * em[k0 + 5]); o.w = pk2(bfe(sv, 6) * em[k0 + 6], bfe(sv, 7) * em[k0 + 7]);
            *(u32x4*)(spT + v * 136 + k0) = o; } }
    if (next >= 0) hgrn_out_load(A, next, lf, qqr, kkr, vvr, spr);
    {
        const int ct = w & 3;
        f32x4 a2[2]; a2[0] = (f32x4){0.f, 0.f, 0.f, 0.f}; a2[1] = a2[0];
#pragma unroll
        for (int ks = 0; ks < 4; ++ks) { const bf16x8 a = *(const bf16x8*)(qm + (16 * ct + lr) * 136 + ks * 32 + lq * 8);
#pragma unroll
            for (int i = 0; i < 2; ++i) { const int st = (w >> 2) * 2 + i; const bf16x8 bb = *(const bf16x8*)(km + (16 * st + lr) * 136 + ks * 32 + lq * 8); a2[i] = MFMA16(a, bb, a2[i]); } }
#pragma unroll
        for (int i = 0; i < 2; ++i) { const int st = (w >> 2) * 2 + i, s = 16 * st + lr;
#pragma unroll
            for (int r = 0; r < 4; ++r) { const int cc = 16 * ct + lq * 4 + r; aL[cc * 72 + s] = (bf16_t)f2bf(s <= cc ? a2[i][r] : 0.f); } }
    }
    __syncthreads();
    const int ct = w & 3, vh = w >> 2;
    f32x4 o4[4];
#pragma unroll
    for (int i = 0; i < 4; ++i) o4[i] = (f32x4){0.f, 0.f, 0.f, 0.f};
#pragma unroll
    for (int ks = 0; ks < 4; ++ks) { const bf16x8 a = *(const bf16x8*)(qm + (16 * ct + lr) * 136 + ks * 32 + lq * 8);
#pragma unroll
        for (int i = 0; i < 4; ++i) { const int vt = vh * 4 + i; const bf16x8 bb = *(const bf16x8*)(spT + (16 * vt + lr) * 136 + ks * 32 + lq * 8); o4[i] = MFMA16(a, bb, o4[i]); } }
#pragma unroll
    for (int ks = 0; ks < 2; ++ks) { const bf16x8 a = *(const bf16x8*)(aL + (16 * ct + lr) * 72 + ks * 32 + lq * 8);
#pragma unroll
        for (int i = 0; i < 4; ++i) { const int vt = vh * 4 + i; const bf16x8 bb = *(const bf16x8*)(vT + (16 * vt + lr) * 72 + ks * 32 + lq * 8); o4[i] = MFMA16(a, bb, o4[i]); } }
    float* ost = (float*)(lds + L_BC);
#pragma unroll
    for (int r = 0; r < 4; ++r) { float s = 0.f;
#pragma unroll
        for (int i = 0; i < 4; ++i) { s += o4[i][r] * o4[i][r]; ost[(16 * ct + lq * 4 + r) * 132 + (vh * 4 + i) * 16 + lr] = o4[i][r]; }
        s += __shfl_xor(s, 1); s += __shfl_xor(s, 2); s += __shfl_xor(s, 4); s += __shfl_xor(s, 8);
        if (lr == 0) part[vh * 64 + 16 * ct + lq * 4 + r] = s; }
    __syncthreads();
    {   const float* hn = A.in[10]; bf16_t* MIX = (bf16_t*)(ws + WS_MIX);
        const int cc = t >> 3, v0 = (t & 7) * 16; const float rstd = __builtin_amdgcn_rsqf((part[cc] + part[64 + cc]) * (1.0f / 128.0f) + EPS);
#pragma unroll
        for (int hh = 0; hh < 2; ++hh) { const int v = v0 + hh * 8; const u32x4 g8 = ggr[hh];
            const f32x4 oa = *(const f32x4*)(ost + cc * 132 + v), ob = *(const f32x4*)(ost + cc * 132 + v + 4), na = *(const f32x4*)(hn + C0 + v), nb = *(const f32x4*)(hn + C0 + v + 4);
            u32x4 o; o.x = pk2(oa[0] * rstd * na[0] * bfe(g8, 0), oa[1] * rstd * na[1] * bfe(g8, 1)); o.y = pk2(oa[2] * rstd * na[2] * bfe(g8, 2), oa[3] * rstd * na[3] * bfe(g8, 3));
            o.z = pk2(ob[0] * rstd * nb[0] * bfe(g8, 4), ob[1] * rstd * nb[1] * bfe(g8, 5)); o.w = pk2(ob[2] * rstd * nb[2] * bfe(g8, 6), ob[3] * rstd * nb[3] * bfe(g8, 7));
            *(u32x4*)(MIX + (size_t)(R0 + cc) * DM + C0 + v) = o; } }
    __syncthreads();
}
__device__ __forceinline__ void hgrn_scan(const Args& A, int G) {
    const u32x2v* SLT = (const u32x2v*)(A.ws + WS_SL); const f32x4* DEC4 = (const f32x4*)(A.ws + WS_DEC); u32x2v* SPT = (u32x2v*)(A.ws + WS_SPT); float* outp = A.out + O_HP;
    for (int e = blockIdx.x * NTHREADS + threadIdx.x; e < 32 * 4096; e += G * NTHREADS) { const int bh = e >> 12, i4 = e & 4095, v = i4 >> 5, k4 = i4 & 31;
        f32x4 S = (f32x4){0.f, 0.f, 0.f, 0.f};
        const u32x2v* p = SLT + (size_t)bh * 32 * 4096 + i4; u32x2v* q = SPT + (size_t)bh * 32 * 4096 + i4; const f32x4* dp = DEC4 + (size_t)bh * 32 * 32 + k4;
#pragma unroll
        for (int hf = 0; hf < 2; ++hf) { u32x2v loc[16]; f32x4 dd[16];
#pragma unroll
            for (int c = 0; c < 16; ++c) { loc[c] = p[(size_t)(hf * 16 + c) * 4096]; dd[c] = dp[(hf * 16 + c) * 32]; }
#pragma unroll
            for (int c = 0; c < 16; ++c) { u32x2v o; o.x = pk2(S[0], S[1]); o.y = pk2(S[2], S[3]); q[(size_t)(hf * 16 + c) * 4096] = o; const f32x4 lv = (f32x4){h_lo(loc[c].x), h_hi(loc[c].x), h_lo(loc[c].y), h_hi(loc[c].y)}; S = S * dd[c] + lv; } }
        float* ob = outp + (size_t)bh * 16384 + (k4 * 4) * 128 + v; ob[0] = S[0]; ob[128] = S[1]; ob[256] = S[2]; ob[384] = S[3]; }
}
__device__ __forceinline__ void pool_states(const Args& A, int G) {
    const unsigned short* UU = (const unsigned short*)(A.ws + WS_UU);
    const int gt = blockIdx.x * NTHREADS + threadIdx.x, NGT = G * NTHREADS;
    for (int i = gt; i < 8 * 15 * 128; i += NGT) { const int c4 = i & 127, j = (i >> 7) % 15, b = i / (15 * 128); const u32x2v v = *(const u32x2v*)(UU + (size_t)(b * SEQ + 2033 + j) * HW + c4 * 4);
        *(f32x4*)(A.out + O_PP + (size_t)i * 4) = (f32x4){h_lo(v.x), h_hi(v.x), h_lo(v.y), h_hi(v.y)}; }
    for (int i0 = gt * 2; i0 < 128 * 15 * 128; i0 += NGT * 2) { f32x4 v[2];
#pragma unroll
        for (int q = 0; q < 2; ++q) { const int i = i0 + q, c4 = i & 127, j = (i >> 7) % 15, b = i / (15 * 128);
            if (j < 14) v[q] = *(const f32x4*)(A.in[4] + (size_t)(b * 15 + j + 1) * 512 + c4 * 4);
            else { const u32x2v h = *(const u32x2v*)(UU + (size_t)(NPR + b) * HW + c4 * 4); v[q] = (f32x4){h_lo(h.x), h_hi(h.x), h_lo(h.y), h_hi(h.y)}; } }
#pragma unroll
        for (int q = 0; q < 2; ++q) *(f32x4*)(A.out + O_PS + (size_t)(i0 + q) * 4) = v[q]; }
}
__device__ __forceinline__ void hgrn_sample_load(const Args& A, int unit, f32x4 (&sreg)[8]) {
    const int t = threadIdx.x; const float* S0 = A.in[3] + (size_t)unit * 16384;
#pragma unroll
    for (int i = 0; i < 8; ++i) sreg[i] = __builtin_nontemporal_load((const f32x4*)(S0 + ((t >> 5) * 8 + i) * 128 + (t & 31) * 4));
}
__device__ __forceinline__ void hgrn_sample_unit(const Args& A, unsigned char* lds, int unit, int next, f32x4 (&sreg)[8]) {
    const int t = threadIdx.x, b = unit >> 2, h = unit & 3, row = NPR + b, C0 = h * 128;
    unsigned char* ws = A.ws;
    float* qs = (float*)lds; float* ks = qs + 128; float* fs = ks + 128; float* vs = fs + 128; float* po = vs + 128;
    float* red = po + 16 * 128;
    float* S1 = A.out + O_HS + (size_t)unit * 16384;
    if (t < 128) { const size_t go = (size_t)row * HW + C0 + t;
        qs[t] = bf2f(((const bf16_t*)(ws + WS_QQ))[go]); ks[t] = bf2f(((const bf16_t*)(ws + WS_KK))[go]); fs[t] = __expf((float)__builtin_bit_cast(_Float16, ((const unsigned short*)(ws + WS_LF))[go])); vs[t] = bf2f(((const bf16_t*)(ws + WS_VV))[go]); }
    __syncthreads();
    const int v4 = t & 31, kg = t >> 5;
    const f32x4 vv = *(const f32x4*)(vs + v4 * 4);
    f32x4 o = (f32x4){0.f, 0.f, 0.f, 0.f};
#pragma unroll
    for (int i = 0; i < 8; ++i) { const int k = kg * 8 + i; const f32x4 s = sreg[i]; const f32x4 sn = s * fs[k] + vv * ks[k]; __builtin_nontemporal_store(sn, (f32x4*)(S1 + k * 128 + v4 * 4)); o += sn * qs[k]; }
    *(f32x4*)(po + kg * 128 + v4 * 4) = o;
    if (next >= 0) hgrn_sample_load(A, next, sreg);
    __syncthreads();
    float ov = 0.f;
    if (t < 128) {
#pragma unroll
        for (int i = 0; i < 16; ++i) ov += po[i * 128 + t];
        const float sq = wave_sum(ov * ov); if ((t & 63) == 0) red[t >> 6] = sq; }
    __syncthreads();
    if (t < 128) { const float rstd = __builtin_amdgcn_rsqf((red[0] + red[1]) * (1.0f / 128.0f) + EPS); const float g = bf2f(((const bf16_t*)(ws + WS_GG))[(size_t)row * HW + C0 + t]);
        ((bf16_t*)(ws + WS_MIX))[(size_t)row * DM + C0 + t] = (bf16_t)f2bf(ov * rstd * A.in[10][C0 + t] * g); }
    __syncthreads();
}

constexpr int LP_EXT = 0, LP_PL = 40448, LP_MX = 57856;
__device__ __forceinline__ void pool_load(const Args& A, int unit, u32x4 (&mreg)[4], u32x2v (&ereg)[5]) {
    const int t = threadIdx.x; const int tt = unit >> 2, g = unit & 3;
    const unsigned short* UU = (const unsigned short*)(A.ws + WS_UU);
    const bf16_t* PM = (const bf16_t*)(A.ws + WS_PMIX) + (size_t)g * 16384;
#pragma unroll
    for (int i = 0; i < 4; ++i) { const int idx = i * 512 + t, d = idx >> 4, c8 = idx & 15; mreg[i] = *(const u32x4*)(PM + d * 128 + c8 * 8); }
    const int b = tt >> 5, t0 = (tt & 31) * 64;
#pragma unroll
    for (int i5 = 0; i5 < 5; ++i5) { const int idx = i5 * 512 + t, i = idx >> 5, c4 = idx & 31; const int tp = t0 - 15 + i;
        ereg[i5] = (u32x2v){0u, 0u}; if (idx < 79 * 32 && tp >= 0) ereg[i5] = *(const u32x2v*)(UU + (size_t)(b * SEQ + tp) * HW + g * 128 + c4 * 4); }
}
__device__ __forceinline__ void pool_unit(const Args& A, unsigned char* lds, int unit, int next, u32x4 (&mreg)[4], u32x2v (&ereg)[5]) {
    const int t = threadIdx.x, w = t >> 6, l = t & 63, lr = l & 15, lq = l >> 4;
    const int tt = unit >> 2, g = unit & 3, win = 2 << g;
    unsigned char* ws = A.ws;
    float* ext = (float*)(lds + LP_EXT); bf16_t* pl = (bf16_t*)(lds + LP_PL); bf16_t* mx = (bf16_t*)(lds + LP_MX);
    const unsigned short* UU = (const unsigned short*)(ws + WS_UU);
    {
#pragma unroll
        for (int i = 0; i < 4; ++i) { const int idx = i * 512 + t, d = idx >> 4, c8 = idx & 15; *(u32x4*)(mx + d * 136 + c8 * 8) = mreg[i]; }
    }
    int rowbase;
    {
        const int b = tt >> 5, t0 = (tt & 31) * 64; rowbase = b * SEQ + t0;
#pragma unroll
        for (int i5 = 0; i5 < 5; ++i5) { const int idx = i5 * 512 + t, i = idx >> 5, c4 = idx & 31; if (idx < 79 * 32) *(f32x4*)(ext + i * 128 + c4 * 4) = (f32x4){h_lo(ereg[i5].x), h_hi(ereg[i5].x), h_lo(ereg[i5].y), h_hi(ereg[i5].y)}; }
        if (next >= 0) pool_load(A, next, mreg, ereg);
        __syncthreads();
        const int cch = t & 127, tg = t >> 7, tk0 = tg * 16;
        float nw[16], od[16], ini[16];
#pragma unroll
        for (int i = 0; i < 16; ++i) { nw[i] = ext[(15 + tk0 + i) * 128 + cch]; od[i] = (i >= 1) ? ext[(15 + tk0 + i - win) * 128 + cch] : 0.f; ini[i] = (i >= 1 && i < win) ? ext[(15 + tk0 - i) * 128 + cch] : 0.f; }
        float sw = 0.f;
#pragma unroll
        for (int i = 1; i < 16; ++i) sw += ini[i];
#pragma unroll
        for (int i = 0; i < 16; ++i) { const int tok = tk0 + i; sw += nw[i]; sw -= od[i];
            const int cnt = min(t0 + tok + 1, win);
            pl[tok * 136 + cch] = (bf16_t)f2bf(sw * __builtin_amdgcn_rcpf((float)cnt) - nw[i]); }
    }
    __syncthreads();
    const int ct = w & 3, dh = w >> 2;
    f32x4 o4[4];
#pragma unroll
    for (int i = 0; i < 4; ++i) o4[i] = (f32x4){0.f, 0.f, 0.f, 0.f};
#pragma unroll
    for (int ks = 0; ks < 4; ++ks) { const bf16x8 a = *(const bf16x8*)(pl + (16 * ct + lr) * 136 + ks * 32 + lq * 8);
#pragma unroll
        for (int i = 0; i < 4; ++i) { const int dt = dh * 4 + i; const bf16x8 bb = *(const bf16x8*)(mx + (16 * dt + lr) * 136 + ks * 32 + lq * 8); o4[i] = MFMA16(a, bb, o4[i]); } }
    bf16_t* MIX = (bf16_t*)(ws + WS_MIX); const float* psc = A.in[12];
    float* ost = (float*)(lds + LP_EXT);
#pragma unroll
    for (int i = 0; i < 4; ++i) { const int d = (dh * 4 + i) * 16 + lr; const float sc = psc[g * 128 + d];
#pragma unroll
        for (int r = 0; r < 4; ++r) ost[(16 * ct + lq * 4 + r) * 132 + d] = o4[i][r] * sc; }
    __syncthreads();
    {   const int tok = t >> 3, d0 = (t & 7) * 16;
#pragma unroll
        for (int hh = 0; hh < 2; ++hh) { const f32x4 oa = *(const f32x4*)(ost + tok * 132 + d0 + hh * 8), ob = *(const f32x4*)(ost + tok * 132 + d0 + hh * 8 + 4);
            u32x4 o; o.x = pk2(oa[0], oa[1]); o.y = pk2(oa[2], oa[3]); o.z = pk2(ob[0], ob[1]); o.w = pk2(ob[2], ob[3]);
            *(u32x4*)(MIX + (size_t)(rowbase + tok) * DM + 512 + g * 128 + d0 + hh * 8) = o; } }
    __syncthreads();
}

__device__ __forceinline__ void pool_sample_unit(const Args& A, unsigned char* lds, int unit) {
    const int t = threadIdx.x, w = t >> 6, l = t & 63, lr = l & 15, lq = l >> 4;
    const int su = unit >> 2, g = unit & 3, win = 2 << g;
    unsigned char* ws = A.ws;
    bf16_t* pl = (bf16_t*)(lds + LP_PL); bf16_t* mx = (bf16_t*)(lds + LP_MX);
    const _Float16* UU = (const _Float16*)(ws + WS_UU);
    const bf16_t* PM = (const bf16_t*)(ws + WS_PMIX) + (size_t)g * 16384;
    u32x4 mreg[4];
#pragma unroll
    for (int i = 0; i < 4; ++i) { const int idx = i * 512 + t, d = idx >> 4, c8 = idx & 15; mreg[i] = *(const u32x4*)(PM + d * 128 + c8 * 8); }
    const int cch = t & 127, sq = t >> 7;
    const float psc_w = A.in[12][g * 128 + 16 * w + lr];
#pragma unroll
    for (int i = 0; i < 4; ++i) { const int tok = sq * 4 + i, sb = su * 16 + tok; const float uv = (float)UU[(size_t)(NPR + sb) * HW + g * 128 + cch];
        float pv[15];
#pragma unroll
        for (int j = 0; j < 15; ++j) pv[j] = A.in[4][(size_t)(sb * 15 + j) * 512 + g * 128 + cch];
        float sacc = uv;
#pragma unroll
        for (int j = 0; j < 15; ++j) sacc += (j >= 16 - win) ? pv[j] : 0.f;
        pl[tok * 136 + cch] = (bf16_t)f2bf(sacc * __builtin_amdgcn_rcpf((float)win) - uv); }
#pragma unroll
    for (int i = 0; i < 4; ++i) { const int idx = i * 512 + t, d = idx >> 4, c8 = idx & 15; *(u32x4*)(mx + d * 136 + c8 * 8) = mreg[i]; }
    __syncthreads();
    f32x4 acc = (f32x4){0.f, 0.f, 0.f, 0.f};
#pragma unroll
    for (int ks = 0; ks < 4; ++ks) { const bf16x8 a = *(const bf16x8*)(pl + lr * 136 + ks * 32 + lq * 8); const bf16x8 bb = *(const bf16x8*)(mx + (16 * w + lr) * 136 + ks * 32 + lq * 8); acc = MFMA16(a, bb, acc); }
    bf16_t* MIX = (bf16_t*)(ws + WS_MIX);
#pragma unroll
    for (int r = 0; r < 4; ++r) MIX[(size_t)(NPR + su * 16 + lq * 4 + r) * DM + 512 + g * 128 + 16 * w + lr] = (bf16_t)f2bf(acc[r] * psc_w);
    __syncthreads();
}

__device__ __forceinline__ void attn_prompt_unit(const Args& A, unsigned char* lds, int unit) {
    const int t = threadIdx.x, w = t >> 6, l = t & 63, lr = l & 15, lq = l >> 4;
    const int qt = unit & 15, h = (unit >> 4) & 3, b = unit >> 6;
    unsigned char* ws = A.ws;
    const bf16_t* Q = (const bf16_t*)(ws + WS_Q); const bf16_t* KB = (const bf16_t*)(ws + WS_KB); const bf16_t* VT = (const bf16_t*)(ws + WS_VT); bf16_t* O = (bf16_t*)(ws + WS_O);
    const int R0 = b * SEQ + qt * 128 + 16 * w;
    bf16_t* CB = (bf16_t*)lds;
    bf16_t* Pw = (bf16_t*)(lds + 73728) + w * (16 * 264);
    const bf16_t* kg = KB + (size_t)(b * 256) * DM + h * 256;
    const bf16_t* vg = VT + (size_t)(h * 256) * MEMR + b * 256;
    u32x4 stg0[4], stg1[4];
#define AT_LOADK(c, STG) _Pragma("unroll") for (int i_ = 0; i_ < 4; ++i_) { const int idx_ = i_ * 512 + t; STG[i_] = *(const u32x4*)(kg + (size_t)((c) * 64 + (idx_ >> 5)) * DM + (idx_ & 31) * 8); }
#define AT_LOADV(c, STG) _Pragma("unroll") for (int i_ = 0; i_ < 4; ++i_) { const int idx_ = i_ * 512 + t; STG[i_] = *(const u32x4*)(vg + (size_t)(idx_ >> 3) * MEMR + (c) * 64 + (idx_ & 7) * 8); }
#define AT_STOREK(bf, STG) _Pragma("unroll") for (int i_ = 0; i_ < 4; ++i_) { const int idx_ = i_ * 512 + t; *(u32x4*)(CB + (bf) * 18432 + (idx_ >> 5) * 264 + (idx_ & 31) * 8) = STG[i_]; }
#define AT_STOREV(bf, STG) _Pragma("unroll") for (int i_ = 0; i_ < 4; ++i_) { const int idx_ = i_ * 512 + t; *(u32x4*)(CB + (bf) * 18432 + (idx_ >> 3) * 72 + (idx_ & 7) * 8) = STG[i_]; }
    AT_LOADK(0, stg0); AT_LOADK(1, stg1);
    bf16x8 qa[8];
#pragma unroll
    for (int ks = 0; ks < 8; ++ks) qa[ks] = *(const bf16x8*)(Q + (size_t)(R0 + lr) * DM + h * 256 + ks * 32 + lq * 8);
    AT_STOREK(0, stg0);
    __syncthreads();
    f32x4 sacc[16]; f32x4 oacc[16]; bf16x8 pa[8]; float rinv[4];
#pragma unroll
    for (int st = 0; st < 8; ++st) {
        if (st & 1) { if (st + 2 < 4) { AT_LOADK(st + 2, stg1); } else if (st + 2 < 8) { AT_LOADV(st - 2, stg1); } }
        else        { if (st + 2 < 4) { AT_LOADK(st + 2, stg0); } else if (st + 2 < 8) { AT_LOADV(st - 2, stg0); } }
        const bf16_t* cb = CB + (st & 1) * 18432;
        if (st < 4) {
#pragma unroll
            for (int nt = 0; nt < 4; ++nt) { f32x4 acc = (f32x4){0.f, 0.f, 0.f, 0.f};
#pragma unroll
                for (int ks = 0; ks < 8; ++ks) { const bf16x8 bb = *(const bf16x8*)(cb + (nt * 16 + lr) * 264 + ks * 32 + lq * 8); acc = MFMA16(qa[ks], bb, acc); }
                sacc[st * 4 + nt] = acc; __builtin_amdgcn_sched_barrier(0); }
        } else {
            if (st == 4) {
#pragma unroll
                for (int r = 0; r < 4; ++r) { float mx = sacc[0][r];
#pragma unroll
                    for (int nt = 1; nt < 16; ++nt) mx = fmaxf(mx, sacc[nt][r]);
                    mx = fmaxf(mx, __shfl_xor(mx, 1)); mx = fmaxf(mx, __shfl_xor(mx, 2)); mx = fmaxf(mx, __shfl_xor(mx, 4)); mx = fmaxf(mx, __shfl_xor(mx, 8));
                    float sum = 0.f;
#pragma unroll
                    for (int nt = 0; nt < 16; ++nt) { const float p = __builtin_amdgcn_exp2f(sacc[nt][r] - mx); sum += p; Pw[(lq * 4 + r) * 264 + nt * 16 + lr] = (bf16_t)f2bf(p); }
                    sum += __shfl_xor(sum, 1); sum += __shfl_xor(sum, 2); sum += __shfl_xor(sum, 4); sum += __shfl_xor(sum, 8);
                    rinv[r] = 1.0f / sum; }
                asm volatile("s_waitcnt lgkmcnt(0)" ::: "memory");
#pragma unroll
                for (int ks = 0; ks < 8; ++ks) pa[ks] = *(const bf16x8*)(Pw + lr * 264 + ks * 32 + lq * 8);
#pragma unroll
                for (int dt = 0; dt < 16; ++dt) oacc[dt] = (f32x4){0.f, 0.f, 0.f, 0.f};
            }
            const int c = st - 4;
#pragma unroll
            for (int dt = 0; dt < 16; ++dt)
#pragma unroll
                for (int k2 = 0; k2 < 2; ++k2) { const bf16x8 bb = *(const bf16x8*)(cb + (dt * 16 + lr) * 72 + k2 * 32 + lq * 8); oacc[dt] = MFMA16(pa[c * 2 + k2], bb, oacc[dt]); if (k2 == 1 && (dt & 1)) __builtin_amdgcn_sched_barrier(0); }
        }
        if (st & 1) { if (st + 1 < 4) { AT_STOREK(0, stg0); } else if (st + 1 < 8) { AT_STOREV(0, stg0); } }
        else        { if (st + 1 < 4) { AT_STOREK(1, stg1); } else if (st + 1 < 8) { AT_STOREV(1, stg1); } }
        __syncthreads();
    }
#pragma unroll
    for (int dt = 0; dt < 16; ++dt)
#pragma unroll
        for (int r = 0; r < 4; ++r) Pw[(lq * 4 + r) * 264 + dt * 16 + lr] = (bf16_t)f2bf(oacc[dt][r] * rinv[r]);
    asm volatile("s_waitcnt lgkmcnt(0)" ::: "memory");
#pragma unroll
    for (int i = 0; i < 8; ++i) { const int idx = i * 64 + l, row = idx >> 5, c8 = idx & 31; *(u32x4*)(O + (size_t)(R0 + row) * DM + h * 256 + c8 * 8) = *(const u32x4*)(Pw + row * 264 + c8 * 8); }
    asm volatile("s_waitcnt lgkmcnt(0)" ::: "memory");
#undef AT_LOADK
#undef AT_LOADV
#undef AT_STOREK
#undef AT_STOREV
}
__device__ __forceinline__ void attn_sample_unit(const Args& A, unsigned char* lds, int unit) {
    const int t = threadIdx.x, w = t >> 6, l = t & 63;
    const int b = unit >> 2, h = unit & 3;
    unsigned char* ws = A.ws;
    float* qs = (float*)lds; float* sc = qs + 256; float* red = sc + 256; float* po = red + 16;
    const float* Kc = A.in[5] + (size_t)b * 256 * 1024 + h * 256; const float* Vc = A.in[6] + (size_t)b * 256 * 1024 + h * 256;
    const int rl = l >> 4, c16 = l & 15;
    f32x4 kr[8][4];
#pragma unroll
    for (int p = 0; p < 8; ++p)
#pragma unroll
        for (int i = 0; i < 4; ++i) kr[p][i] = *(const f32x4*)(Kc + (size_t)(p * 32 + w * 4 + rl) * 1024 + i * 64 + c16 * 4);
    if (t < 256) qs[t] = bf2f(((const bf16_t*)(ws + WS_Q))[(size_t)(NPR + b) * DM + h * 256 + t]);
    __syncthreads();
    {
        f32x4 q4[4];
#pragma unroll
        for (int i = 0; i < 4; ++i) q4[i] = *(const f32x4*)(qs + i * 64 + c16 * 4);
#pragma unroll
        for (int p = 0; p < 8; ++p) { const int m = p * 32 + w * 4 + rl; float s = 0.f;
#pragma unroll
            for (int i = 0; i < 4; ++i) { const f32x4 kv = kr[p][i]; s += (kv[0] * q4[i][0] + kv[1] * q4[i][1]) + (kv[2] * q4[i][2] + kv[3] * q4[i][3]); }
            s += __shfl_xor(s, 1); s += __shfl_xor(s, 2); s += __shfl_xor(s, 4); s += __shfl_xor(s, 8);
            if (c16 == 0) sc[m] = s; }
    }
    f32x4 vr[32];
#pragma unroll
    for (int i = 0; i < 32; ++i) vr[i] = *(const f32x4*)(Vc + (size_t)(w * 32 + i) * 1024 + l * 4);
    __syncthreads();
    if (t < 256) { float mx = sc[t];
#pragma unroll
        for (int o = 1; o < 64; o <<= 1) mx = fmaxf(mx, __shfl_xor(mx, o));
        if (l == 0) red[w] = mx; }
    __syncthreads();
    const float gmx = fmaxf(fmaxf(red[0], red[1]), fmaxf(red[2], red[3]));
    float pv = 0.f;
    if (t < 256) { pv = __builtin_amdgcn_exp2f(sc[t] - gmx); const float s = wave_sum(pv); if (l == 0) red[8 + w] = s; }
    __syncthreads();
    if (t < 256) sc[t] = pv;
    const float inv = 1.0f / ((red[8] + red[9]) + (red[10] + red[11]));
    __syncthreads();
    {
        f32x4 o = (f32x4){0.f, 0.f, 0.f, 0.f};
#pragma unroll
        for (int i = 0; i < 32; ++i) o += vr[i] * sc[w * 32 + i];
        *(f32x4*)(po + w * 256 + l * 4) = o;
    }
    __syncthreads();
    if (t < 256) { float o = 0.f;
#pragma unroll
        for (int i = 0; i < 8; ++i) o += po[i * 256 + t];
        ((bf16_t*)(ws + WS_O))[(size_t)(NPR + b) * DM + h * 256 + t] = (bf16_t)f2bf(o * inv); }
    __syncthreads();
}

__device__ __forceinline__ void attn_sample_pair(const Args& A, unsigned char* lds, int pg) {
    const int t = threadIdx.x, w = t >> 6, l = t & 63, rl = l >> 4, c16 = l & 15;
    const int pair = pg * 2 + (w >> 2), wq = w & 3, b = pair >> 2, h = pair & 3;
    const size_t off0 = (size_t)b * 256 * 1024 + h * 256 + (size_t)(wq * 64 + rl) * 1024 + c16 * 4;
    const float* Kc = A.in[5] + off0; const float* Vc = A.in[6] + off0;
    f32x4 ra[8], rb[8];
#define AS_LD(set, base, bt) _Pragma("unroll") for (int gg_ = 0; gg_ < 2; ++gg_) _Pragma("unroll") for (int i_ = 0; i_ < 4; ++i_) set[gg_ * 4 + i_] = __builtin_nontemporal_load((const f32x4*)((base) + (size_t)((bt) * 8 + gg_ * 4) * 1024 + i_ * 64))
    AS_LD(ra, Kc, 0); AS_LD(rb, Kc, 1);
    f32x4 q4[4];
    {   const bf16_t* qp = (const bf16_t*)(A.ws + WS_Q) + (size_t)(NPR + b) * DM + h * 256 + c16 * 4;
#pragma unroll
        for (int i = 0; i < 4; ++i) { const u32x2v qv = *(const u32x2v*)(qp + i * 64); q4[i] = (f32x4){__uint_as_float(qv.x << 16), __uint_as_float(qv.x & 0xffff0000u), __uint_as_float(qv.y << 16), __uint_as_float(qv.y & 0xffff0000u)}; } }
    float sc[16];
#define AS_SCORE(set, bt) _Pragma("unroll") for (int gg_ = 0; gg_ < 2; ++gg_) { float s_ = 0.f; _Pragma("unroll") for (int i_ = 0; i_ < 4; ++i_) { const f32x4 kv_ = set[gg_ * 4 + i_]; s_ += (kv_[0] * q4[i_][0] + kv_[1] * q4[i_][1]) + (kv_[2] * q4[i_][2] + kv_[3] * q4[i_][3]); } \
        s_ += __shfl_xor(s_, 1); s_ += __shfl_xor(s_, 2); s_ += __shfl_xor(s_, 4); s_ += __shfl_xor(s_, 8); sc[(bt) * 2 + gg_] = s_; }
#pragma unroll
    for (int bt = 0; bt < 8; ++bt) {
        if (bt & 1) { AS_SCORE(rb, bt); if (bt + 2 < 8) { AS_LD(rb, Kc, bt + 2); } else { AS_LD(rb, Vc, bt - 6); } }
        else        { AS_SCORE(ra, bt); if (bt + 2 < 8) { AS_LD(ra, Kc, bt + 2); } else { AS_LD(ra, Vc, bt - 6); } }
        asm volatile("" ::: "memory"); __builtin_amdgcn_sched_barrier(0);
    }
    float mx = sc[0];
#pragma unroll
    for (int g = 1; g < 16; ++g) mx = fmaxf(mx, sc[g]);
    mx = fmaxf(mx, __shfl_xor(mx, 16)); mx = fmaxf(mx, __shfl_xor(mx, 32));
    float ls = 0.f;
#pragma unroll
    for (int g = 0; g < 16; ++g) { sc[g] = __builtin_amdgcn_exp2f(sc[g] - mx); ls += sc[g]; }
    ls += __shfl_xor(ls, 16); ls += __shfl_xor(ls, 32);
    f32x4 o[4];
#pragma unroll
    for (int i = 0; i < 4; ++i) o[i] = (f32x4){0.f, 0.f, 0.f, 0.f};
#define AS_PV(set, bt) _Pragma("unroll") for (int gg_ = 0; gg_ < 2; ++gg_) _Pragma("unroll") for (int i_ = 0; i_ < 4; ++i_) o[i_] += set[gg_ * 4 + i_] * sc[(bt) * 2 + gg_]
#pragma unroll
    for (int bt = 0; bt < 8; ++bt) {
        if (bt & 1) { AS_PV(rb, bt); if (bt + 2 < 8) { AS_LD(rb, Vc, bt + 2); } }
        else        { AS_PV(ra, bt); if (bt + 2 < 8) { AS_LD(ra, Vc, bt + 2); } }
        asm volatile("" ::: "memory"); __builtin_amdgcn_sched_barrier(0);
    }
#pragma unroll
    for (int i = 0; i < 4; ++i)
#pragma unroll
        for (int c = 0; c < 4; ++c) { float v = o[i][c]; v += __shfl_xor(v, 16); v += __shfl_xor(v, 32); o[i][c] = v; }
    float* pw = (float*)lds + w * 260;
    if (rl == 0) {
#pragma unroll
        for (int i = 0; i < 4; ++i) *(f32x4*)(pw + i * 64 + c16 * 4) = o[i];
        if (c16 == 0) { pw[256] = mx; pw[257] = ls; } }
    __syncthreads();
    {   const int ps = t >> 8, d = t & 255; const float* pb = (const float*)lds + (ps * 4) * 260;
        const float m0 = pb[256], m1 = pb[260 + 256], m2 = pb[520 + 256], m3 = pb[780 + 256]; const float M = fmaxf(fmaxf(m0, m1), fmaxf(m2, m3));
        const float e0 = __builtin_amdgcn_exp2f(m0 - M), e1 = __builtin_amdgcn_exp2f(m1 - M), e2 = __builtin_amdgcn_exp2f(m2 - M), e3 = __builtin_amdgcn_exp2f(m3 - M);
        const float num = (pb[d] * e0 + pb[260 + d] * e1) + (pb[520 + d] * e2 + pb[780 + d] * e3);
        const float den = (pb[257] * e0 + pb[260 + 257] * e1) + (pb[520 + 257] * e2 + pb[780 + 257] * e3);
        const int pr = pg * 2 + ps, bb = pr >> 2, hh = pr & 3;
        ((bf16_t*)(A.ws + WS_O))[(size_t)(NPR + bb) * DM + hh * 256 + d] = (bf16_t)f2bf(num / den); }
    __syncthreads();
#undef AS_LD
#undef AS_SCORE
#undef AS_PV
}

template <int KIND, int NKS>
__device__ __forceinline__ void sample_gemm(unsigned char* lds, const bf16_t* Asm, int lda, const bf16_t* Bt, int K, int unit, const float* base, const bf16_t* baseb, float* out, bf16_t* outb, float* ss, float scale) {
    const int t = threadIdx.x, w = t >> 6, l = t & 63, lr = l & 15, lq = l >> 4;
    const int rb = unit & 3, cb = unit >> 2, kw = K >> 3, k0 = w * kw;
    f32x4 acc[2]; acc[0] = (f32x4){0.f, 0.f, 0.f, 0.f}; acc[1] = acc[0];
    const bf16_t* bp = Bt + (size_t)(cb * 16 + lr) * K + k0 + lq * 8;
    const bf16_t* ap = Asm + (size_t)(rb * 32 + lr) * lda + k0 + lq * 8;
    bf16x8 fb[NKS], fa0[NKS], fa1[NKS];
#pragma unroll
    for (int ks = 0; ks < NKS; ++ks) { fb[ks] = *(const bf16x8*)(bp + ks * 32); fa0[ks] = *(const bf16x8*)(ap + ks * 32); fa1[ks] = *(const bf16x8*)(ap + (size_t)16 * lda + ks * 32); }
    const int row_ = t >> 4, col_ = t & 15;
    float bres = 0.f;
    if (KIND == 0) bres = base ? base[(size_t)(rb * 32 + row_) * DM + cb * 16 + col_] : bf2f(baseb[(size_t)(rb * 32 + row_) * DM + cb * 16 + col_]);
#pragma unroll
    for (int ks = 0; ks < NKS; ++ks) { acc[0] = MFMA16(fa0[ks], fb[ks], acc[0]); acc[1] = MFMA16(fa1[ks], fb[ks], acc[1]); }
    float* red = (float*)lds;
#pragma unroll
    for (int i = 0; i < 2; ++i)
#pragma unroll
        for (int r = 0; r < 4; ++r) red[(w * 32 + i * 16 + lq * 4 + r) * 16 + lr] = acc[i][r];
    __syncthreads();
    const int row = t >> 4, col = t & 15, grow = rb * 32 + row, gcol = cb * 16 + col;
    float v = 0.f;
#pragma unroll
    for (int i = 0; i < 8; ++i) v += red[(i * 32 + row) * 16 + col];
    if (KIND == 0) { const float val = bres + v; if (out) out[(size_t)grow * DM + gcol] = val; if (outb) outb[(size_t)grow * DM + gcol] = (bf16_t)f2bf(val);
        float sq = val * val; sq += __shfl_xor(sq, 1); sq += __shfl_xor(sq, 2); sq += __shfl_xor(sq, 4); sq += __shfl_xor(sq, 8);
        if (col == 0) atomicAdd(ss + grow, sq);
    } else { const float rstd = __builtin_amdgcn_rsqf(ss[grow] * (1.0f / DM) + EPS); outb[(size_t)grow * DM + gcol] = (bf16_t)f2bf(v * rstd * scale); }
    __syncthreads();
}

__device__ __forceinline__ void final_norm(const Args& A, int G, int row_lo) {
    const int lane = threadIdx.x & 63, gw = blockIdx.x * 8 + (threadIdx.x >> 6), NGW = G * 8;
    const float* ss = (const float*)(A.ws + WS_SS3); const f32x4* gr = (const f32x4*)A.in[22] + lane;
    f32x4 gg[4];
#pragma unroll
    for (int j = 0; j < 4; ++j) gg[j] = gr[64 * j];
    for (int m0 = row_lo + gw * 4; m0 < NVALID; m0 += NGW * 4) {
        f32x4 v[4][4]; float sv[4];
#pragma unroll
        for (int r = 0; r < 4; ++r) { sv[r] = ss[m0 + r]; const f32x4* xr = (const f32x4*)(A.out + (size_t)(m0 + r) * DM) + lane;
#pragma unroll
            for (int j = 0; j < 4; ++j) v[r][j] = xr[64 * j]; }
#pragma unroll
        for (int r = 0; r < 4; ++r) { const float rstd = 1.0f / sqrtf(sv[r] * (1.f / DM) + EPS); f32x4* xr = (f32x4*)(A.out + (size_t)(m0 + r) * DM) + lane;
#pragma unroll
            for (int j = 0; j < 4; ++j) xr[64 * j] = v[r][j] * rstd * gg[j]; } }
}

constexpr int NPHASES = 12;
#ifndef REPMASK
#define REPMASK 0
#endif
#define REPS(k) for (int rep_ = 0; rep_ < 1 + ((REPMASK >> (k)) & 1); ++rep_)
__global__ void __launch_bounds__(NTHREADS, 2) fwd_megakernel(Args args) {
    extern __shared__ __attribute__((aligned(16))) unsigned char lds[];
    cg::grid_group grid = cg::this_grid();
    const int G = gridDim.x, bx = blockIdx.x;
    unsigned char* ws = args.ws;
    PG8_LAS unsigned char* lds3 = (PG8_LAS unsigned char*)lds;
    const int lo = args.ph_lo, hi = args.ph_hi;
#define IN(k) (lo <= (k) && (k) < hi)
#ifndef SPINBLK
#define SPINBLK 0
#endif
#ifdef SPINMASK
    unsigned long long t_prev_ = __builtin_amdgcn_s_memrealtime(), t_acc_ = 0ull;
#define STAMP(k) do { const unsigned long long t_now_ = __builtin_amdgcn_s_memrealtime(); if ((SPINMASK >> (k)) & 1) t_acc_ += t_now_ - t_prev_; t_prev_ = t_now_; } while (0)
#else
#define STAMP(k) do { } while (0)
#endif
#define SEAM(k) do { if (IN(k) && IN((k) + 1)) xcd_barrier(bar); STAMP(k); } while (0)
    if (lo < 0) grid.sync();
    volatile LAS unsigned* MISC = (volatile LAS unsigned*)(lds3 + LDS_BYTES - 64);
    if (threadIdx.x < 16) MISC[threadIdx.x] = 0u;
    __syncthreads();
    XcdBarrier bar = xcd_barrier_post((unsigned*)(ws + WS_BAR), MISC);
    if (IN(0)) REPS(0) { p0_prologue(args, lds, G); }
    SEAM(0);
    if (IN(1)) REPS(1) {
        {   pg8::Gemm g{(const bf16_t*)(ws + WS_H0), (const bf16_t*)(ws + WS_WIN), MT, NIN, DM}; pg8::StaticOrder S; S.init(MT, NIN, G, bx);
            pg8::EpiInProj E{(bf16_t*)(ws + WS_QQ), (bf16_t*)(ws + WS_KK), (bf16_t*)(ws + WS_VV), (bf16_t*)(ws + WS_GG), (unsigned short*)(ws + WS_LF), (unsigned short*)(ws + WS_UU), args.in[9]};
            pg8::gemm_phase<pg8::EpiInProj, pg8::StaticOrder, true, true>(lds3, g, S, E); }
        {   pg8::Gemm g{(const bf16_t*)(ws + WS_MEMH), (const bf16_t*)(ws + WS_WKV), MEMR, 2 * DM, DM}; pg8::StaticOrder S; S.init(MEMR, 2 * DM, G, (bx + G - (650 % G)) % G);
            pg8::EpiMemKV E{args.out + O_MK, args.out + O_MV, (bf16_t*)(ws + WS_KB)};
            pg8::gemm_phase<pg8::EpiMemKV, pg8::StaticOrder, true, true>(lds3, g, S, E); }
        {   pg8::Gemm g{(const bf16_t*)(ws + WS_WKV) + (size_t)DM * DM, (const bf16_t*)(ws + WS_MEMH), DM, MEMR, DM}; pg8::StaticOrder S; S.init(DM, MEMR, G, (bx + 2 * G - ((650 + 64) % G)) % G);
            pg8::EpiBf16Scale E{(bf16_t*)(ws + WS_VT), MEMR, nullptr, 1.0f};
            pg8::gemm_phase<pg8::EpiBf16Scale, pg8::StaticOrder, true, true>(lds3, g, S, E); }
    }
    SEAM(1);
    if (IN(2)) REPS(2) {
        const bool sfirst = ((bx >> 3) & 1) != 0;
#pragma unroll 1
        for (int pass = 0; pass < 2; ++pass) {
            if ((pass == 0) == sfirst) {
                f32x4 sreg[8]; if (bx < 512) hgrn_sample_load(args, bx, sreg);
                for (int u = bx; u < 512; u += G) hgrn_sample_unit(args, lds, u, (u + G < 512) ? u + G : -1, sreg);
            } else {
                u32x2v lf[4]; u32x4 kkr[2], vvr[2]; if (bx < 1024) hgrn_local_load(args, bx, lf, kkr, vvr);
                for (int u = bx; u < 1024; u += G) hgrn_local_unit(args, lds, u, (u + G < 1024) ? u + G : -1, lf, kkr, vvr);
            }
        }
    }
    SEAM(2);
    if (IN(3)) {
        for (int u = bx; u < 32; u += G) pool_sample_unit(args, lds, u);
        const bool scan_first = ((bx >> 3) & 1) != 0;
        if (scan_first) { hgrn_scan(args, G); pool_states(args, G); }
        {   u32x4 mreg[4]; u32x2v ereg[5]; if (bx < 1024) pool_load(args, bx, mreg, ereg);
            for (int u = bx; u < 1024; u += G) pool_unit(args, lds, u, (u + G < 1024) ? u + G : -1, mreg, ereg); }
        if (!scan_first) { hgrn_scan(args, G); pool_states(args, G); }
    }
    SEAM(3);
    if (IN(4)) REPS(4) {
        {   u32x2v lf[4]; u32x4 qqr[2], kkr[2], vvr[2], spr[4]; if (bx < 1024) hgrn_out_load(args, bx, lf, qqr, kkr, vvr, spr);
            for (int u = bx; u < 1024; u += G) hgrn_out_unit(args, lds, u, (u + G < 1024) ? u + G : -1, lf, qqr, kkr, vvr, spr); }
        STAMP(12);
        STAMP(13);
        for (int u = bx; u < 256; u += G) sample_gemm<0, 4>(lds, (const bf16_t*)(ws + WS_MIX) + (size_t)NPR * DM, DM, (const bf16_t*)(ws + WS_WOUT), DM, u, args.in[1], nullptr, nullptr, (bf16_t*)(ws + WS_H0) + (size_t)NPR * DM, (float*)(ws + WS_SS1) + NPR, 1.0f);
    }
    SEAM(4);
    if (IN(5)) REPS(5) {
        pg8::Gemm g{(const bf16_t*)(ws + WS_MIX), (const bf16_t*)(ws + WS_WOUT), NPR, DM, DM}; pg8::StaticOrder S; S.init(NPR, DM, G, bx);
        pg8::EpiResid E{args.in[0], nullptr, nullptr, (bf16_t*)(ws + WS_H0), (float*)(ws + (rep_ ? WS_SSD : WS_SS1))};
        pg8::gemm_phase<pg8::EpiResid, pg8::StaticOrder, true, true>(lds3, g, S, E);
        for (int u = bx; u < 256; u += G) sample_gemm<1, 4>(lds, (const bf16_t*)(ws + WS_H0) + (size_t)NPR * DM, DM, (const bf16_t*)(ws + WS_WCQ), DM, u, nullptr, nullptr, nullptr, (bf16_t*)(ws + WS_Q) + (size_t)NPR * DM, (float*)(ws + WS_SS1) + NPR, 0.0625f * 1.4426950408889634f);
    }
    SEAM(5);
    const bool stream_first = ((bx >> 3) & 1) != 0;
    if (IN(7) && stream_first) for (int u = bx; u < 256; u += G) attn_sample_pair(args, lds, u);
    if (IN(6)) {
        pg8::Gemm g{(const bf16_t*)(ws + WS_H0), (const bf16_t*)(ws + WS_WCQ), NPR, DM, DM}; pg8::StaticOrder S; S.init(NPR, DM, G, bx);
        pg8::EpiBf16Scale E{(bf16_t*)(ws + WS_Q), DM, (const float*)(ws + WS_SS1), 0.0625f * 1.4426950408889634f};
        pg8::gemm_phase<pg8::EpiBf16Scale, pg8::StaticOrder, true, true>(lds3, g, S, E);
        STAMP(16);
    }
    int au0 = bx, au1 = 512, austep = G;
    if (G == 256) {
        asm volatile("s_waitcnt vmcnt(0)" ::: "memory"); __syncthreads();
        const int wg_ = (bx & 7) * 32 + (bx >> 3), pm_ = (wg_ >> 5) * 8 + ((wg_ & 31) & 7), pn_ = (wg_ & 31) >> 3;
        au0 = ((pm_ >> 3) * 4 + pn_) * 16 + (pm_ & 7) * 2; au1 = au0 + 2; austep = 1;
    } else { SEAM(6); }
    if (IN(7)) {
        for (int u = au0; u < au1; u += austep) attn_prompt_unit(args, lds, u);
        STAMP(17);
        if (!stream_first) for (int u = bx; u < 256; u += G) attn_sample_pair(args, lds, u);
    }
    SEAM(7);
    if (IN(8)) REPS(8) {
        pg8::Gemm g{(const bf16_t*)(ws + WS_O), (const bf16_t*)(ws + WS_WCO), NPR, DM, DM}; pg8::StaticOrder S; S.init(NPR, DM, G, bx);
        pg8::EpiResid E{nullptr, (const bf16_t*)(ws + WS_H0), nullptr, (bf16_t*)(ws + WS_MIX), (float*)(ws + (rep_ ? WS_SSD : WS_SS2))};
        pg8::gemm_phase<pg8::EpiResid, pg8::StaticOrder, true, true>(lds3, g, S, E);
        for (int u = bx; u < 256; u += G) sample_gemm<0, 4>(lds, (const bf16_t*)(ws + WS_O) + (size_t)NPR * DM, DM, (const bf16_t*)(ws + WS_WCO), DM, u, nullptr, (const bf16_t*)(ws + WS_H0) + (size_t)NPR * DM, nullptr, (bf16_t*)(ws + WS_MIX) + (size_t)NPR * DM, (float*)(ws + (rep_ ? WS_SSD : WS_SS2)) + NPR, 1.0f);
    }
    SEAM(8);
    if (IN(9)) REPS(9) {
        pg8::Gemm g{(const bf16_t*)(ws + WS_MIX), (const bf16_t*)(ws + WS_WFFI), MT, NFF2, DM}; pg8::StaticOrder S; S.init(MT, NFF2, G, bx);
        pg8::EpiSwiGLU E{(bf16_t*)(ws + WS_A), (const float*)(ws + WS_SS2)};
        pg8::gemm_phase<pg8::EpiSwiGLU, pg8::StaticOrder, true, true>(lds3, g, S, E);
    }
    SEAM(9);
    if (IN(10)) {
        pg8::Gemm g{(const bf16_t*)(ws + WS_A), (const bf16_t*)(ws + WS_WFFO), NPR, DM, DFF}; pg8::StaticOrder S; S.init(NPR, DM, G, bx);
        if (G == 256) {
            pg8::EpiResidNorm E{(const bf16_t*)(ws + WS_MIX), args.out, (float*)(ws + WS_SS3), (unsigned*)(ws + WS_CNT), args.in[22]};
            pg8::gemm_phase<pg8::EpiResidNorm, pg8::StaticOrder, false, true>(lds3, g, S, E);
        } else {
            pg8::EpiResid E{nullptr, (const bf16_t*)(ws + WS_MIX), args.out, nullptr, (float*)(ws + WS_SS3)};
            pg8::gemm_phase<pg8::EpiResid, pg8::StaticOrder, true, true>(lds3, g, S, E);
        }
        for (int u = bx; u < 256; u += G) sample_gemm<0, 11>(lds, (const bf16_t*)(ws + WS_A) + (size_t)NPR * DFF, DFF, (const bf16_t*)(ws + WS_WFFO), DFF, u, nullptr, (const bf16_t*)(ws + WS_MIX) + (size_t)NPR * DM, args.out + O_YS, nullptr, (float*)(ws + WS_SS3) + NPR, 1.0f);
    }
    SEAM(10);
#ifdef EXTRA_SYNCS
    for (int i_ = 0; i_ < EXTRA_SYNCS; ++i_) xcd_barrier(bar);
#endif
    if (IN(11)) { final_norm(args, G, G == 256 ? NPR : 0); }
#ifdef SPINMASK
    STAMP(11);
    if (bx == SPINBLK && threadIdx.x == 0) { const unsigned long long t0_ = __builtin_amdgcn_s_memrealtime(); while (__builtin_amdgcn_s_memrealtime() - t0_ < t_acc_) __builtin_amdgcn_s_sleep(8); }
#endif
#undef IN
#undef SEAM
}

#ifndef MK_MULTI
#define MK_MULTI 0
#endif
extern "C" void kernel_launch(void* const* d_in, const int* in_sizes, int n_in, void* d_out, int out_size, void* d_ws, size_t ws_size, hipStream_t stream) {
    static int grid = 0;
    if (grid == 0) {
        if (n_in != 23 || ws_size < WS_END) { fprintf(stderr, "kernel_launch: unexpected n_in %d / ws_size %zu\n", n_in, ws_size); grid = -1; return; }
        int dev = 0, cus = 0, per_cu = 0;
        hipGetDevice(&dev); hipDeviceGetAttribute(&cus, hipDeviceAttributeMultiprocessorCount, dev);
        if (hipFuncSetAttribute((const void*)fwd_megakernel, hipFuncAttributeMaxDynamicSharedMemorySize, LDS_BYTES) != hipSuccess) { fprintf(stderr, "kernel_launch: hipFuncSetAttribute failed\n"); grid = -1; return; }
        hipOccupancyMaxActiveBlocksPerMultiprocessor(&per_cu, (const void*)fwd_megakernel, NTHREADS, LDS_BYTES);
        (void)hipGetLastError();
        if (per_cu < 1) { fprintf(stderr, "kernel_launch: occupancy query says %d blocks/CU\n", per_cu); per_cu = 1; }
        grid = cus;
    }
    if (grid < 0) return;
    Args a{};
    for (int i = 0; i < 23; ++i) a.in[i] = (const float*)d_in[i];
    a.out = (float*)d_out; a.ws = (unsigned char*)d_ws;
#if MK_MULTI
    for (int p = 0; p < NPHASES; ++p) { a.ph_lo = p; a.ph_hi = p + 1; hipLaunchKernelGGL(fwd_megakernel, dim3(grid), dim3(NTHREADS), LDS_BYTES, stream, a); }
#else
    a.ph_lo = 0; a.ph_hi = NPHASES;
    if (hipMemsetAsync((char*)d_ws + WS_BAR, 0, BAR_BYTES, stream) != hipSuccess) { fprintf(stderr, "kernel_launch: memset failed\n"); return; }
    void* kargs[] = {&a};
    hipError_t e = hipLaunchCooperativeKernel((const void*)fwd_megakernel, dim3(grid), dim3(NTHREADS), kargs, LDS_BYTES, stream);
    if (e != hipSuccess) fprintf(stderr, "kernel_launch: cooperative launch failed: %s (grid %d)\n", hipGetErrorString(e), grid);
#endif
}
```

```cpp
#include <hip/hip_runtime.h>
#include <hip/hip_cooperative_groups.h>
#include <cstdio>
#include <cstdint>
namespace cg = cooperative_groups;
namespace pg8 {
#define PG8_LAS __attribute__((address_space(3)))
typedef unsigned short bf16_t;
typedef short bf16x8 __attribute__((ext_vector_type(8)));
typedef float f32x4 __attribute__((ext_vector_type(4)));
typedef unsigned u32x4 __attribute__((ext_vector_type(4)));
constexpr int BM = 256, BK = 64, HALF = 128, HTB = HALF * BK * 2  , STAGE_BYTES = 8 * HTB, NXCD = 8, WGM = 8;

__host__ __device__ __forceinline__ int lds_byte(int r, int c) { const int st = (r >> 4) * 2 + (c >> 5), rr = r & 15, cc = c & 31, ob = rr * 64 + cc * 2; return st * 1024 + (ob ^ (((ob >> 9) & 1) << 5)); }
__host__ __device__ __forceinline__ void stage_rc(int b, int& R, int& C) { const int st = b / 1024, sb = b % 1024, swz = sb ^ (((sb >> 9) & 1) << 5); R = (st >> 1) * 16 + swz / 64; C = (st & 1) * 32 + (swz % 64) / 2; }
__host__ __device__ __forceinline__ int perm32(int rho) { const int n = rho >> 4, i = rho & 15; return 8 * (i >> 2) + 4 * n + (i & 3); }

struct Unit { int pm, pn; };
struct Gemm { const bf16_t* A; const bf16_t* Bt; int M, N, K; };

struct StaticOrder {
    int nM, nN, nwg, G, c;
    __host__ __device__ void init(int M, int N, int G_, int c_) { nM = M / BM; nN = N / BM; nwg = nM * nN; G = G_; c = c_; }
    __host__ __device__ bool next(int i, Unit& u) const {
        const long L = (long)i * G + c; if (L >= nwg) return false;
        int wgid = (int)L; { const int q = nwg / NXCD, r = nwg % NXCD, xcd = wgid % NXCD, off = wgid / NXCD; wgid = (xcd < r ? xcd * (q + 1) : r * (q + 1) + (xcd - r) * q) + off; }
        const int nig = WGM * nN, gid = wgid / nig, fm = gid * WGM, gsz = (nM - fm) < WGM ? (nM - fm) : WGM;
        u.pm = fm + ((wgid % nig) % gsz); u.pn = (wgid % nig) / gsz; return true;
    }
    __device__ __forceinline__ void a_ready(const Unit&) const {}
    __device__ __forceinline__ void done(const Unit&) const {}
};

__device__ __forceinline__ unsigned cvt_pk_bf16(float lo, float hi) { unsigned r; asm volatile("v_cvt_pk_bf16_f32 %0, %1, %2" : "=v"(r) : "v"(lo), "v"(hi)); return r; }
typedef unsigned u32x2 __attribute__((ext_vector_type(2)));
__device__ __forceinline__ float sigm(float z) { return __builtin_amdgcn_rcpf(1.0f + __expf(-z)); }
constexpr float RMS_EPS = 1e-6f;
#ifndef WT_STORES
#define WT_STORES 0
#endif
__device__ __forceinline__ void st16(void* p, u32x4 v) {
#if WT_STORES
    asm volatile("global_store_dwordx4 %0, %1, off sc1\n\ts_nop 1" :: "v"(p), "v"(v) : "memory");
#else
    *(u32x4*)p = v;
#endif
}
__device__ __forceinline__ void st16f(void* p, f32x4 v) { st16(p, __builtin_bit_cast(u32x4, v)); }
__device__ __forceinline__ void st8(void* p, u32x2 v) {
#if WT_STORES
    asm volatile("global_store_dwordx2 %0, %1, off sc1\n\ts_nop 1" :: "v"(p), "v"(v) : "memory");
#else
    *(u32x2*)p = v;
#endif
}
typedef _Float16 h2_t __attribute__((ext_vector_type(2)));
__device__ __forceinline__ unsigned pk_h2(float a, float b) { h2_t v; v.x = (_Float16)a; v.y = (_Float16)b; return __builtin_bit_cast(unsigned, v); }
__device__ __forceinline__ float h_lo(unsigned u) { return (float)__builtin_bit_cast(h2_t, u).x; }
__device__ __forceinline__ float h_hi(unsigned u) { return (float)__builtin_bit_cast(h2_t, u).y; }

struct EpiInProj {
    static constexpr bool PERM = true, AFTER_DRAIN = false;
    bf16_t *QQ, *KK, *VV, *GG; unsigned short *LF, *UU; const float* lbraw;
    __device__ __forceinline__ void operator()(const f32x4 (&acc)[2][2][4][2], const Unit& u, int wr, int wc, int fr, int fq) const {
        const int seg = u.pn >> 1, colt = (u.pn & 1) * 256;
        const int row0 = u.pm * BM + wr * 64 + fr;
#pragma unroll
        for (int bj = 0; bj < 2; ++bj) {
            const int cs = colt + bj * HALF + wc * 32 + 8 * fq;
            float lb[8];
            if (seg == 1) {
#pragma unroll
                for (int j = 0; j < 8; ++j) { const float l0 = lbraw[cs + j], l1 = lbraw[512 + cs + j]; lb[j] = __builtin_amdgcn_rcpf(1.0f + __expf(l1 - l0)); }
            } else {
#pragma unroll
                for (int j = 0; j < 8; ++j) lb[j] = 0.f;
            }
#pragma unroll
            for (int ai = 0; ai < 2; ++ai)
#pragma unroll
                for (int m = 0; m < 4; ++m) {
                    const size_t off = (size_t)(row0 + ai * HALF + m * 16) * 512 + cs;
                    const f32x4 v0 = acc[ai][bj][m][0], v1 = acc[ai][bj][m][1];
                    float z[8] = {v0[0], v0[1], v0[2], v0[3], v1[0], v1[1], v1[2], v1[3]};
                    if (seg == 0) {
#pragma unroll
                        for (int j = 0; j < 8; ++j) z[j] = z[j] * sigm(z[j]);
                        u32x4 w; w.x = cvt_pk_bf16(z[0], z[1]); w.y = cvt_pk_bf16(z[2], z[3]); w.z = cvt_pk_bf16(z[4], z[5]); w.w = cvt_pk_bf16(z[6], z[7]);
                        st16(QQ + off, w);
                    } else if (seg == 1) {
                        float lf[8], kk[8];
#pragma unroll
                        for (int j = 0; j < 8; ++j) { const float e = __expf(-z[j]); const float sg = __builtin_amdgcn_rcpf(1.0f + e); const float sgn = e * sg;
                            lf[j] = __logf(lb[j] + (1.0f - lb[j]) * sg); kk[j] = (1.0f - lb[j]) * sgn; }
                        { u32x4 w; w.x = pk_h2(lf[0], lf[1]); w.y = pk_h2(lf[2], lf[3]); w.z = pk_h2(lf[4], lf[5]); w.w = pk_h2(lf[6], lf[7]); st16(LF + off, w); }
                        u32x4 w; w.x = cvt_pk_bf16(kk[0], kk[1]); w.y = cvt_pk_bf16(kk[2], kk[3]); w.z = cvt_pk_bf16(kk[4], kk[5]); w.w = cvt_pk_bf16(kk[6], kk[7]);
                        st16(KK + off, w);
                    } else if (seg == 2) {
                        u32x4 w; w.x = cvt_pk_bf16(z[0], z[1]); w.y = cvt_pk_bf16(z[2], z[3]); w.z = cvt_pk_bf16(z[4], z[5]); w.w = cvt_pk_bf16(z[6], z[7]);
                        st16(VV + off, w);
                    } else if (seg == 3) {
#pragma unroll
                        for (int j = 0; j < 8; ++j) z[j] = sigm(z[j]);
                        u32x4 w; w.x = cvt_pk_bf16(z[0], z[1]); w.y = cvt_pk_bf16(z[2], z[3]); w.z = cvt_pk_bf16(z[4], z[5]); w.w = cvt_pk_bf16(z[6], z[7]);
                        st16(GG + off, w);
                    } else {
                        u32x4 w; w.x = pk_h2(z[0], z[1]); w.y = pk_h2(z[2], z[3]); w.z = pk_h2(z[4], z[5]); w.w = pk_h2(z[6], z[7]); st16(UU + off, w);
                    }
                }
        }
    }
};

struct EpiMemKV {
    static constexpr bool PERM = true, AFTER_DRAIN = false;
    float *outK, *outV; bf16_t* KB;
    __device__ __forceinline__ void operator()(const f32x4 (&acc)[2][2][4][2], const Unit& u, int wr, int wc, int fr, int fq) const {
        const bool isk = u.pn < 4; float* o = isk ? outK : outV; const int colt = (u.pn & 3) * 256;
        const int row0 = u.pm * BM + wr * 64 + fr;
#pragma unroll
        for (int ai = 0; ai < 2; ++ai)
#pragma unroll
            for (int m = 0; m < 4; ++m)
#pragma unroll
                for (int bj = 0; bj < 2; ++bj) {
                    const size_t off = (size_t)(row0 + ai * HALF + m * 16) * 1024 + colt + bj * HALF + wc * 32 + 8 * fq;
                    const f32x4 v0 = acc[ai][bj][m][0], v1 = acc[ai][bj][m][1];
                    *(f32x4*)(o + off) = v0; *(f32x4*)(o + off + 4) = v1;
                    if (isk) { u32x4 w; w.x = cvt_pk_bf16(v0[0], v0[1]); w.y = cvt_pk_bf16(v0[2], v0[3]); w.z = cvt_pk_bf16(v1[0], v1[1]); w.w = cvt_pk_bf16(v1[2], v1[3]); *(u32x4*)(KB + off) = w; }
                }
    }
};

struct EpiBf16Scale {
    static constexpr bool PERM = true, AFTER_DRAIN = false;
    bf16_t* O; int ldc; const float* ss; float scale;
    __device__ __forceinline__ void operator()(const f32x4 (&acc)[2][2][4][2], const Unit& u, int wr, int wc, int fr, int fq) const {
        const int row0 = u.pm * BM + wr * 64 + fr;
        float ssv[2][4];
#pragma unroll
        for (int ai = 0; ai < 2; ++ai)
#pragma unroll
            for (int m = 0; m < 4; ++m) ssv[ai][m] = ss ? ss[row0 + ai * HALF + m * 16] : 0.f;
#pragma unroll
        for (int ai = 0; ai < 2; ++ai)
#pragma unroll
            for (int m = 0; m < 4; ++m) {
                const int row = row0 + ai * HALF + m * 16;
                const float sc = ss ? scale * __builtin_amdgcn_rsqf(ssv[ai][m] * (1.0f / 1024.0f) + RMS_EPS) : scale;
#pragma unroll
                for (int bj = 0; bj < 2; ++bj) {
                    const size_t off = (size_t)row * ldc + u.pn * BM + bj * HALF + wc * 32 + 8 * fq;
                    const f32x4 v0 = acc[ai][bj][m][0] * sc, v1 = acc[ai][bj][m][1] * sc;
                    u32x4 w; w.x = cvt_pk_bf16(v0[0], v0[1]); w.y = cvt_pk_bf16(v0[2], v0[3]); w.z = cvt_pk_bf16(v1[0], v1[1]); w.w = cvt_pk_bf16(v1[2], v1[3]);
                    st16(O + off, w);
                }
            }
    }
};

struct EpiResid {
    static constexpr bool PERM = true, AFTER_DRAIN = false;
    const float* baseF;
    const bf16_t* baseB;
    float* out;
    bf16_t* outb;
    float* ss;
    __device__ __forceinline__ void operator()(const f32x4 (&acc)[2][2][4][2], const Unit& u, int wr, int wc, int fr, int fq) const {
        const int row0 = u.pm * BM + wr * 64 + fr;
#pragma unroll
        for (int ai = 0; ai < 2; ++ai) {
            f32x4 pre[4][2][2];
            if (baseF) {
#pragma unroll
                for (int m = 0; m < 4; ++m) { const float* bp = baseF + (size_t)(row0 + ai * HALF + m * 16) * 1024;
#pragma unroll
                    for (int bj = 0; bj < 2; ++bj) { const int col = u.pn * BM + bj * HALF + wc * 32 + 8 * fq; pre[m][bj][0] = __builtin_nontemporal_load((const f32x4*)(bp + col)); pre[m][bj][1] = __builtin_nontemporal_load((const f32x4*)(bp + col + 4)); } }
            } else {
                u32x4 pb[4][2];
#pragma unroll
                for (int m = 0; m < 4; ++m) { const bf16_t* bp = baseB + (size_t)(row0 + ai * HALF + m * 16) * 1024;
#pragma unroll
                    for (int bj = 0; bj < 2; ++bj) pb[m][bj] = *(const u32x4*)(bp + u.pn * BM + bj * HALF + wc * 32 + 8 * fq); }
#pragma unroll
                for (int m = 0; m < 4; ++m)
#pragma unroll
                    for (int bj = 0; bj < 2; ++bj) { const u32x4 p = pb[m][bj];
                        pre[m][bj][0] = (f32x4){__uint_as_float(p.x << 16), __uint_as_float(p.x & 0xffff0000u), __uint_as_float(p.y << 16), __uint_as_float(p.y & 0xffff0000u)};
                        pre[m][bj][1] = (f32x4){__uint_as_float(p.z << 16), __uint_as_float(p.z & 0xffff0000u), __uint_as_float(p.w << 16), __uint_as_float(p.w & 0xffff0000u)}; }
            }
#pragma unroll
            for (int m = 0; m < 4; ++m) {
                const int row = row0 + ai * HALF + m * 16;
                float s = 0.f;
#pragma unroll
                for (int bj = 0; bj < 2; ++bj) {
                    const int col = u.pn * BM + bj * HALF + wc * 32 + 8 * fq;
                    const f32x4 v0 = acc[ai][bj][m][0] + pre[m][bj][0], v1 = acc[ai][bj][m][1] + pre[m][bj][1];
                    s += (v0[0] * v0[0] + v0[1] * v0[1]) + (v0[2] * v0[2] + v0[3] * v0[3]) + (v1[0] * v1[0] + v1[1] * v1[1]) + (v1[2] * v1[2] + v1[3] * v1[3]);
                    if (out) { *(f32x4*)(out + (size_t)row * 1024 + col) = v0; *(f32x4*)(out + (size_t)row * 1024 + col + 4) = v1; }
                    if (outb) { u32x4 w; w.x = cvt_pk_bf16(v0[0], v0[1]); w.y = cvt_pk_bf16(v0[2], v0[3]); w.z = cvt_pk_bf16(v1[0], v1[1]); w.w = cvt_pk_bf16(v1[2], v1[3]); st16(outb + (size_t)row * 1024 + col, w); }
                }
                s += __shfl_xor(s, 16); s += __shfl_xor(s, 32);
                if (fq == 0) atomicAdd(ss + row, s);
            }
        }
    }
};

struct EpiResidNorm {
    static constexpr bool PERM = true, AFTER_DRAIN = true;
    const bf16_t* baseB; float* out; float* ss; unsigned* cnt; const float* gfin;
    __device__ __forceinline__ void fused(f32x4 (&acc)[2][2][4][2], const Unit& u, int wr, int wc, int fr, int fq, PG8_LAS unsigned char* lds, int wid, int lane) const {
        const int row0 = u.pm * BM + wr * 64 + fr;
#pragma unroll
        for (int ai = 0; ai < 2; ++ai) {
            u32x4 pb[4][2];
#pragma unroll
            for (int m = 0; m < 4; ++m) { const bf16_t* bp = baseB + (size_t)(row0 + ai * HALF + m * 16) * 1024;
#pragma unroll
                for (int bj = 0; bj < 2; ++bj) pb[m][bj] = *(const u32x4*)(bp + u.pn * BM + bj * HALF + wc * 32 + 8 * fq); }
#pragma unroll
            for (int m = 0; m < 4; ++m) { float s = 0.f;
#pragma unroll
                for (int bj = 0; bj < 2; ++bj) { const u32x4 p = pb[m][bj];
                    const f32x4 v0 = acc[ai][bj][m][0] + (f32x4){__uint_as_float(p.x << 16), __uint_as_float(p.x & 0xffff0000u), __uint_as_float(p.y << 16), __uint_as_float(p.y & 0xffff0000u)};
                    const f32x4 v1 = acc[ai][bj][m][1] + (f32x4){__uint_as_float(p.z << 16), __uint_as_float(p.z & 0xffff0000u), __uint_as_float(p.w << 16), __uint_as_float(p.w & 0xffff0000u)};
                    acc[ai][bj][m][0] = v0; acc[ai][bj][m][1] = v1;
                    s += (v0[0] * v0[0] + v0[1] * v0[1]) + (v0[2] * v0[2] + v0[3] * v0[3]) + (v1[0] * v1[0] + v1[1] * v1[1]) + (v1[2] * v1[2] + v1[3] * v1[3]); }
                s += __shfl_xor(s, 16); s += __shfl_xor(s, 32);
                if (fq == 0) atomicAdd(ss + row0 + ai * HALF + m * 16, s); }
        }
        asm volatile("s_waitcnt vmcnt(0)" ::: "memory");
        __syncthreads();
        if (threadIdx.x == 0) { unsigned* c = cnt + 64 * u.pm;
            __hip_atomic_fetch_add(c, 1u, __ATOMIC_RELEASE, __HIP_MEMORY_SCOPE_AGENT);
            unsigned sp = 0u; while (__hip_atomic_load(c, __ATOMIC_RELAXED, __HIP_MEMORY_SCOPE_AGENT) < 4u) { __builtin_amdgcn_s_sleep(2); if (++sp > (1u << 22)) break; }
            __builtin_amdgcn_fence(__ATOMIC_ACQUIRE, "agent"); }
        __syncthreads();
        float rs[2][4];
#pragma unroll
        for (int ai = 0; ai < 2; ++ai)
#pragma unroll
            for (int m = 0; m < 4; ++m) rs[ai][m] = __hip_atomic_load(ss + row0 + ai * HALF + m * 16, __ATOMIC_RELAXED, __HIP_MEMORY_SCOPE_AGENT);
        f32x4 gv[2][2];
#pragma unroll
        for (int bj = 0; bj < 2; ++bj) { const int col = u.pn * BM + bj * HALF + wc * 32 + 8 * fq; gv[bj][0] = *(const f32x4*)(gfin + col); gv[bj][1] = *(const f32x4*)(gfin + col + 4); }
#pragma unroll
        for (int ai = 0; ai < 2; ++ai)
#pragma unroll
            for (int m = 0; m < 4; ++m) { const int row = row0 + ai * HALF + m * 16; const float rstd = 1.0f / sqrtf(rs[ai][m] * (1.0f / 1024.0f) + RMS_EPS);
#pragma unroll
                for (int bj = 0; bj < 2; ++bj) { const int col = u.pn * BM + bj * HALF + wc * 32 + 8 * fq;
                    *(f32x4*)(out + (size_t)row * 1024 + col) = acc[ai][bj][m][0] * rstd * gv[bj][0]; *(f32x4*)(out + (size_t)row * 1024 + col + 4) = acc[ai][bj][m][1] * rstd * gv[bj][1]; } }
    }
};

struct EpiSwiGLU {
    static constexpr bool PERM = true, AFTER_DRAIN = false;
    bf16_t* ACT; const float* ss;
    __device__ __forceinline__ void operator()(const f32x4 (&acc)[2][2][4][2], const Unit& u, int wr, int wc, int fr, int fq) const {
        const int row0 = u.pm * BM + wr * 64 + fr;
        float ssv[2][4];
#pragma unroll
        for (int ai = 0; ai < 2; ++ai)
#pragma unroll
            for (int m = 0; m < 4; ++m) ssv[ai][m] = ss[row0 + ai * HALF + m * 16];
        const int J = u.pn * 128 + wc * 32 + 8 * fq;
#pragma unroll
        for (int ai = 0; ai < 2; ++ai)
#pragma unroll
            for (int m = 0; m < 4; ++m) {
                const int row = row0 + ai * HALF + m * 16;
                const float r = __builtin_amdgcn_rsqf(ssv[ai][m] * (1.0f / 1024.0f) + RMS_EPS);
                float o[8];
#pragma unroll
                for (int n = 0; n < 2; ++n) { const f32x4 a = acc[ai][0][m][n] * r, b = acc[ai][1][m][n] * r;
#pragma unroll
                    for (int j = 0; j < 4; ++j) o[4 * n + j] = a[j] * sigm(a[j]) * b[j]; }
                u32x4 w; w.x = cvt_pk_bf16(o[0], o[1]); w.y = cvt_pk_bf16(o[2], o[3]); w.z = cvt_pk_bf16(o[4], o[5]); w.w = cvt_pk_bf16(o[6], o[7]);
                st16(ACT + (size_t)row * 2816 + J, w);
            }
    }
};

template <class Epi, class Sched, bool ALIGN_EPI = false, bool SP2 = false>
__device__ __forceinline__ void gemm_phase(PG8_LAS unsigned char* lds, const Gemm g, const Sched& S, const Epi& E) {
    const int tid = threadIdx.x, wid = __builtin_amdgcn_readfirstlane(tid >> 6), lane = tid & 63, wr = wid >> 2, wc = wid & 3, fr = lane & 15, fq = lane >> 4;
    const int K = g.K, nt = K / BK;
    unsigned voffA[2], voffB[2];
#pragma unroll
    for (int i = 0; i < 2; ++i) { int R, C; stage_rc(tid * 16 + i * 8192, R, C); const int Rb = Epi::PERM ? ((R & ~31) + perm32(R & 31)) : R;
        voffA[i] = (unsigned)(R * K + C) * 2u; voffB[i] = (unsigned)(Rb * K + C) * 2u; }
    const size_t kstep = (size_t)(BK * 2);
    const size_t hstep = (size_t)HALF * K * 2;
    const size_t tstep = 2 * hstep;
    const unsigned ldsw = (unsigned)wid * 1024u;
    const int aoff = lds_byte(wr * 64 + fr, fq * 8), boff = lds_byte(wc * 32 + fr, fq * 8);
#define PG8_SA(b, h) (((b) * 2 + (h)) * HTB)
#define PG8_SB(b, h) ((4 + (b) * 2 + (h)) * HTB)
#define PG8_STAGE(bufoff, gbase, voff) do { _Pragma("unroll") for (int _i = 0; _i < 2; ++_i) \
        __builtin_amdgcn_global_load_lds((const unsigned*)((const char*)(gbase) + (voff)[_i]), (PG8_LAS unsigned*)(lds + (bufoff) + ldsw + _i * 8192), 16, 0, 0); } while (0)
#define PG8_LDA(dst, b, h) do { _Pragma("unroll") for (int m = 0; m < 4; ++m) _Pragma("unroll") for (int k = 0; k < 2; ++k) dst[m][k] = *(const PG8_LAS bf16x8*)(lds + PG8_SA(b, h) + aoff + m * 2048 + k * 1024); } while (0)
#define PG8_LDB(dst, b, h) do { _Pragma("unroll") for (int n = 0; n < 2; ++n) _Pragma("unroll") for (int k = 0; k < 2; ++k) dst[n][k] = *(const PG8_LAS bf16x8*)(lds + PG8_SB(b, h) + boff + n * 2048 + k * 1024); } while (0)
#define PG8_MMA(ai, bj, At, Bt) do { __builtin_amdgcn_s_setprio(1); _Pragma("unroll") for (int m = 0; m < 4; ++m) _Pragma("unroll") for (int n = 0; n < 2; ++n) _Pragma("unroll") for (int k = 0; k < 2; ++k) \
        acc[ai][bj][m][n] = __builtin_amdgcn_mfma_f32_16x16x32_bf16(Bt[n][k], At[m][k], acc[ai][bj][m][n], 0, 0, 0); __builtin_amdgcn_s_setprio(0); } while (0)
#define PG8_WAIT_V(n) asm volatile("s_waitcnt vmcnt(" #n ")" ::: "memory")
#define PG8_WAIT_L(n) asm volatile("s_waitcnt lgkmcnt(" #n ")" ::: "memory")
#define PG8_BAR __builtin_amdgcn_s_barrier()
#define PG8_SCHED __builtin_amdgcn_sched_barrier(0)
    Unit cur, nxt; int ui = 0;
    if (!S.next(0, cur)) return;
    f32x4 acc[2][2][4][2];
#pragma unroll
    for (int a = 0; a < 2; ++a)
#pragma unroll
        for (int b = 0; b < 2; ++b)
#pragma unroll
            for (int m = 0; m < 4; ++m)
#pragma unroll
                for (int n = 0; n < 2; ++n) acc[a][b][m][n] = (f32x4){0.f, 0.f, 0.f, 0.f};
    bf16x8 At[4][2], B0[2][2], B1[2][2];
    const char* cA = (const char*)g.A + (size_t)cur.pm * tstep; const char* cB = (const char*)g.Bt + (size_t)cur.pn * tstep;
    S.a_ready(cur);
    if constexpr (SP2) {
        PG8_STAGE(PG8_SB(0, 0), cB, voffB); PG8_STAGE(PG8_SB(0, 1), cB + hstep, voffB); PG8_STAGE(PG8_SA(0, 0), cA, voffA); PG8_STAGE(PG8_SA(0, 1), cA + hstep, voffA);
        if (wr == 1) PG8_BAR;
        PG8_WAIT_V(2); PG8_BAR;
        PG8_STAGE(PG8_SB(1, 0), cB + kstep, voffB); PG8_STAGE(PG8_SA(1, 0), cA + kstep, voffA); PG8_STAGE(PG8_SB(1, 1), cB + hstep + kstep, voffB);
        PG8_WAIT_V(6); PG8_BAR;
    } else {
        PG8_STAGE(PG8_SB(0, 0), cB, voffB); PG8_STAGE(PG8_SA(0, 0), cA, voffA); PG8_STAGE(PG8_SB(0, 1), cB + hstep, voffB); PG8_STAGE(PG8_SA(0, 1), cA + hstep, voffA);
        if (wr == 1) PG8_BAR;
        PG8_WAIT_V(4); PG8_BAR;
        PG8_STAGE(PG8_SB(1, 0), cB + kstep, voffB); PG8_STAGE(PG8_SA(1, 0), cA + kstep, voffA); PG8_STAGE(PG8_SB(1, 1), cB + hstep + kstep, voffB);
        PG8_WAIT_V(6); PG8_BAR;
    }
    for (;;) {
        const bool has_next = S.next(ui + 1, nxt);
        const char* nA = has_next ? (const char*)g.A + (size_t)nxt.pm * tstep : cA; const char* nB = has_next ? (const char*)g.Bt + (size_t)nxt.pn * tstep : cB;
        for (int t = 0; t < nt; t += 2) {
            const bool last = (t == nt - 2);
            const char* a1 = cA + (size_t)(t + 1) * kstep;
            const char* a2 = last ? nA : cA + (size_t)(t + 2) * kstep; const char* b2 = last ? nB : cB + (size_t)(t + 2) * kstep;
            const char* a3 = a2 + kstep; const char* b3 = b2 + kstep;
            if (last && has_next) S.a_ready(nxt);
            if constexpr (SP2) {
            PG8_LDB(B0, 0, 0); PG8_LDB(B1, 0, 1); PG8_SCHED; PG8_LDA(At, 0, 0); PG8_STAGE(PG8_SA(1, 1), a1 + hstep, voffA);
            PG8_WAIT_V(8); PG8_WAIT_L(0); PG8_BAR; PG8_MMA(0, 0, At, B0); PG8_MMA(0, 1, At, B1); PG8_BAR; PG8_SCHED;
            PG8_LDA(At, 0, 1); PG8_STAGE(PG8_SB(0, 0), b2, voffB); PG8_STAGE(PG8_SB(0, 1), b2 + hstep, voffB); PG8_STAGE(PG8_SA(0, 0), a2, voffA);
            PG8_WAIT_V(8); PG8_WAIT_L(0); PG8_BAR; PG8_MMA(1, 0, At, B0); PG8_MMA(1, 1, At, B1); PG8_BAR; PG8_SCHED;
            PG8_LDB(B0, 1, 0); PG8_LDB(B1, 1, 1); PG8_SCHED; PG8_LDA(At, 1, 0); PG8_STAGE(PG8_SA(0, 1), a2 + hstep, voffA);
            PG8_WAIT_V(8); PG8_WAIT_L(0); PG8_BAR; PG8_MMA(0, 0, At, B0); PG8_MMA(0, 1, At, B1); PG8_BAR; PG8_SCHED;
            PG8_LDA(At, 1, 1); PG8_STAGE(PG8_SB(1, 0), b3, voffB); PG8_STAGE(PG8_SB(1, 1), b3 + hstep, voffB); PG8_STAGE(PG8_SA(1, 0), a3, voffA);
            PG8_WAIT_V(8); PG8_WAIT_L(0); PG8_BAR; PG8_MMA(1, 0, At, B0); PG8_MMA(1, 1, At, B1); PG8_BAR; PG8_SCHED;
            } else {
            PG8_LDB(B0, 0, 0); PG8_SCHED; PG8_LDA(At, 0, 0); PG8_STAGE(PG8_SA(1, 1), a1 + hstep, voffA);
            PG8_WAIT_L(8); PG8_BAR; PG8_WAIT_L(0); PG8_MMA(0, 0, At, B0); PG8_BAR; PG8_SCHED;
            PG8_LDB(B1, 0, 1); PG8_STAGE(PG8_SB(0, 0), b2, voffB);
            PG8_BAR; PG8_WAIT_L(0); PG8_MMA(0, 1, At, B1); PG8_BAR;
            PG8_LDA(At, 0, 1); PG8_STAGE(PG8_SA(0, 0), a2, voffA);
            PG8_BAR; PG8_WAIT_L(0); PG8_MMA(1, 0, At, B0); PG8_BAR; PG8_SCHED;
            PG8_STAGE(PG8_SB(0, 1), b2 + hstep, voffB);
            PG8_WAIT_V(6); PG8_BAR; PG8_MMA(1, 1, At, B1); PG8_BAR;
            PG8_LDB(B0, 1, 0); PG8_SCHED; PG8_LDA(At, 1, 0); PG8_STAGE(PG8_SA(0, 1), a2 + hstep, voffA);
            PG8_WAIT_L(8); PG8_BAR; PG8_WAIT_L(0); PG8_MMA(0, 0, At, B0); PG8_BAR; PG8_SCHED;
            PG8_LDB(B1, 1, 1); PG8_STAGE(PG8_SB(1, 0), b3, voffB);
            PG8_BAR; PG8_WAIT_L(0); PG8_MMA(0, 1, At, B1); PG8_BAR;
            PG8_LDA(At, 1, 1); PG8_STAGE(PG8_SA(1, 0), a3, voffA);
            PG8_BAR; PG8_WAIT_L(0); PG8_MMA(1, 0, At, B0); PG8_BAR; PG8_SCHED;
            PG8_STAGE(PG8_SB(1, 1), b3 + hstep, voffB);
            PG8_WAIT_V(6); PG8_BAR; PG8_MMA(1, 1, At, B1); PG8_BAR;
            }
        }
        if constexpr (ALIGN_EPI) { if (wr == 0) PG8_BAR; }
        if constexpr (!Epi::AFTER_DRAIN) { E(acc, cur, wr, wc, fr, fq); S.done(cur); }
        if (!has_next) break;
#pragma unroll
        for (int a = 0; a < 2; ++a)
#pragma unroll
            for (int b = 0; b < 2; ++b)
#pragma unroll
                for (int m = 0; m < 4; ++m)
#pragma unroll
                    for (int n = 0; n < 2; ++n) acc[a][b][m][n] = (f32x4){0.f, 0.f, 0.f, 0.f};
        cur = nxt; cA = nA; cB = nB; ++ui;
        if constexpr (ALIGN_EPI) { if (wr == 1) PG8_BAR; }
    }
    PG8_WAIT_V(0);
    if constexpr (!ALIGN_EPI) { if (wr == 0) PG8_BAR; }
    PG8_BAR;
    if constexpr (Epi::AFTER_DRAIN) { E.fused(acc, cur, wr, wc, fr, fq, lds, wid, lane); S.done(cur); }
#undef PG8_SA
#undef PG8_SB
#undef PG8_STAGE
#undef PG8_LDA
#undef PG8_LDB
#undef PG8_MMA
#undef PG8_WAIT_V
#undef PG8_WAIT_L
#undef PG8_BAR
#undef PG8_SCHED
}
}
#define LAS __attribute__((address_space(3)))
#define XB_TMO      128
#define XB_XCNT(j)  (256  + 64 * (j))
#define XB_XSUB(j)  (1280 + 64 * (j))
#define XB_XGEN(j)  (2304 + 64 * (j))
#define XB_TOP      3328
#define XB_TOPGEN   3392
#define XCD_BAR_WORDS 3456
#define XB_SPIN_CAP (1u << 18)

__device__ __forceinline__ unsigned xb_ld(unsigned* p)              { return __hip_atomic_load(p, __ATOMIC_RELAXED, __HIP_MEMORY_SCOPE_AGENT); }
__device__ __forceinline__ unsigned xb_add(unsigned* p, unsigned v) { return __hip_atomic_fetch_add(p, v, __ATOMIC_RELAXED, __HIP_MEMORY_SCOPE_AGENT); }
__device__ __forceinline__ unsigned xb_xcc_id() { return (unsigned)__builtin_amdgcn_s_getreg((3 << 11) | 20) & 0xFu; }
#define XB_SPIN(cond, bar) do { unsigned _sp = 0; while (cond) { __builtin_amdgcn_s_sleep(1); \
    if ((++_sp & 255u) == 0u) { if (xb_ld(&(bar)[XB_TMO])) break; if (_sp > XB_SPIN_CAP) { atomicAdd(&(bar)[XB_TMO], 1u); break; } } } } while (0)

struct XcdBarrier {
    unsigned* bar; unsigned x;
    volatile LAS unsigned* st;
};

__device__ __forceinline__ XcdBarrier xcd_barrier_post(unsigned* bar, volatile LAS unsigned* st) {
    XcdBarrier b; b.bar = bar; b.x = xb_xcc_id(); b.st = st;
    if (threadIdx.x == 0) (void)xb_add(&bar[XB_XCNT(b.x)], 1u);
    return b;
}
__device__ __forceinline__ void xcd_barrier_complete(unsigned* bar, unsigned x, unsigned& nloc, unsigned& nx) {
    const unsigned G = gridDim.x * gridDim.y * gridDim.z;
    unsigned sum, cnt, mine, sp = 0u;
    for (;;) {
        sum = 0u; cnt = 0u; mine = 0u;
#pragma unroll
        for (unsigned j = 0; j < 16; ++j) { const unsigned c = xb_ld(&bar[XB_XCNT(j)]); sum += c; cnt += (c > 0u) ? 1u : 0u; mine = (j == x) ? c : mine; }
        if (sum == G) break;
        __builtin_amdgcn_s_sleep(1);
        if ((++sp & 255u) == 0u) { if (xb_ld(&bar[XB_TMO])) break; if (sp > XB_SPIN_CAP) { atomicAdd(&bar[XB_TMO], 1u); break; } }
    }
    nloc = mine > 0u ? mine : 1u; nx = cnt > 0u ? cnt : 1u;
}

__device__ __forceinline__ void xcd_barrier(const XcdBarrier& b) {
    asm volatile("s_waitcnt vmcnt(0)" ::: "memory");
    __syncthreads();
    if (threadIdx.x == 0) {
        unsigned* bar = b.bar;
        __builtin_amdgcn_s_waitcnt(0);
        unsigned nloc = b.st[0], nx = b.st[1];
        if (nloc == 0u) { xcd_barrier_complete(bar, b.x, nloc, nx); b.st[0] = nloc; b.st[1] = nx; }
        const unsigned old = xb_add(&bar[XB_XSUB(b.x)], 1u);
        const unsigned gen = old / nloc;
        if (old + 1u == (gen + 1u) * nloc) {
            __builtin_amdgcn_fence(__ATOMIC_RELEASE, "agent");
            asm volatile("s_waitcnt vmcnt(0)" ::: "memory");
            const unsigned og = xb_add(&bar[XB_TOP], 1u);
            const unsigned tg = og / nx;
            if (og + 1u == (tg + 1u) * nx) xb_add(&bar[XB_TOPGEN], 1u);
            else XB_SPIN(xb_ld(&bar[XB_TOPGEN]) == tg, bar);
            __builtin_amdgcn_fence(__ATOMIC_ACQUIRE, "agent");
            xb_add(&bar[XB_XGEN(b.x)], 1u);
            asm volatile("s_waitcnt vmcnt(0)" ::: "memory");
        } else {
            XB_SPIN(xb_ld(&bar[XB_XGEN(b.x)]) == gen, bar);
            __builtin_amdgcn_fence(__ATOMIC_ACQUIRE, "agent");
            asm volatile("s_waitcnt vmcnt(0)" ::: "memory");
        }
    }
    __syncthreads();
}

using pg8::bf16_t; using pg8::f32x4; using pg8::u32x4; using pg8::bf16x8; using pg8::pk_h2; using pg8::h_lo; using pg8::h_hi;
typedef unsigned u32x2v __attribute__((ext_vector_type(2)));
constexpr int DM = 1024, NPR = 16384, NSM = 128, MT = 16640, NVALID = 16512, SEQ = 2048;
constexpr int HW = 512, NIN = 2560, DFF = 2816, NFF2 = 5632, MEMR = 2048;
constexpr float EPS = 1e-6f;
constexpr int NTHREADS = 512;
constexpr int LDS_BYTES = 147456;

constexpr size_t O_YP = 0, O_YS = 16777216, O_HP = 16908288, O_PP = 17432576, O_MK = 17494016, O_MV = 19591168, O_HS = 21688320, O_PS = 30076928;

constexpr size_t MiB = 1u << 20;
constexpr size_t WS_SS1 = 0, WS_SS2 = 128 * 1024, WS_SS3 = 256 * 1024, WS_BAR = 512 * 1024, BAR_BYTES = 65536, WS_SSD = 384 * 1024, WS_CNT = WS_BAR + 16384;
constexpr size_t WS_WIN = 1 * MiB, WS_WOUT = 6 * MiB, WS_WCQ = 8 * MiB, WS_WCO = 10 * MiB, WS_WFFI = 12 * MiB, WS_WFFO = 23 * MiB, WS_WKV = 29 * MiB, WS_PMIX = 33 * MiB;
constexpr size_t WS_MEMH = 34 * MiB, WS_KB = 38 * MiB, WS_VT = 42 * MiB, WS_DEC = 46 * MiB;
constexpr size_t WS_H0 = 47 * MiB;
constexpr size_t WS_MIX = 80 * MiB;
constexpr size_t WS_X1 = 113 * MiB;
constexpr size_t WS_Q = 178 * MiB;
constexpr size_t WS_O = 211 * MiB;
constexpr size_t WS_SL = 244 * MiB;
constexpr size_t WS_A = 309 * MiB;
constexpr size_t WS_QQ = WS_A, WS_KK = WS_A + 17 * MiB, WS_VV = WS_A + 34 * MiB, WS_GG = WS_A + 51 * MiB, WS_LF = WS_A + 68 * MiB, WS_UU = WS_A + 101 * MiB;
constexpr size_t WS_END = 443 * MiB;

struct Args { const float* in[23]; float* out; unsigned char* ws; int ph_lo, ph_hi; };

typedef float f32x2_t __attribute__((ext_vector_type(2))); typedef __bf16 bf16x2_t __attribute__((ext_vector_type(2)));
__device__ __forceinline__ unsigned pk2(float lo, float hi) { const f32x2_t v = {lo, hi}; const bf16x2_t b = __builtin_convertvector(v, bf16x2_t); return __builtin_bit_cast(unsigned, b); }
__device__ __forceinline__ unsigned f2bf(float f) { return pk2(f, 0.f) & 0xffffu; }
__device__ __forceinline__ float bf2f(unsigned h) { return __uint_as_float(h << 16); }
__device__ __forceinline__ float bfe(const u32x4& v, int j) { const unsigned w = v[j >> 1]; return (j & 1) ? __uint_as_float(w & 0xffff0000u) : __uint_as_float(w << 16); }
__device__ __forceinline__ unsigned short bfr(const u32x4& v, int j) { const unsigned w = v[j >> 1]; return (unsigned short)((j & 1) ? (w >> 16) : (w & 0xffffu)); }
__device__ __forceinline__ float wave_sum(float v) {
#pragma unroll
    for (int o = 1; o < 64; o <<= 1) v += __shfl_xor(v, o);
    return v;
}
#define MFMA16(a, b, c) __builtin_amdgcn_mfma_f32_16x16x32_bf16((a), (b), (c), 0, 0, 0)

template <int MODE>
__device__ __forceinline__ void tr_item(const float* W, int K, int N, bf16_t* WT, const float* gk, float* scr, int item, int lane) {
    const int nblk = N / 32, kb = item / nblk, nb = item % nblk, k0 = 64 * kb, n0 = 32 * nb;
    f32x4 wv[8];
#pragma unroll
    for (int i = 0; i < 8; ++i) { const int kk = 8 * i + (lane >> 3); wv[i] = __builtin_nontemporal_load((const f32x4*)(W + (size_t)(k0 + kk) * N + n0 + (lane & 7) * 4)); }
#pragma unroll
    for (int i = 0; i < 8; ++i) { const int kk = 8 * i + (lane >> 3); float* d = scr + kk * 33 + (lane & 7) * 4; d[0] = wv[i][0]; d[1] = wv[i][1]; d[2] = wv[i][2]; d[3] = wv[i][3]; }
    asm volatile("s_waitcnt lgkmcnt(0)" ::: "memory");
    const int c = lane & 7;
    float g8[8];
#pragma unroll
    for (int i = 0; i < 8; ++i) g8[i] = gk ? gk[k0 + 8 * c + i] : 1.0f;
#pragma unroll
    for (int j = 0; j < 4; ++j) { const int n = (lane >> 3) + 8 * j; const float* s = scr + (8 * c) * 33 + n;
        u32x4 o; o.x = pk2(s[0 * 33] * g8[0], s[1 * 33] * g8[1]); o.y = pk2(s[2 * 33] * g8[2], s[3 * 33] * g8[3]); o.z = pk2(s[4 * 33] * g8[4], s[5 * 33] * g8[5]); o.w = pk2(s[6 * 33] * g8[6], s[7 * 33] * g8[7]);
        int row = n0 + n;
        if (MODE == 1) { const int half = row >= DFF ? 1 : 0; const int J = row - half * DFF;
            row = 256 * (J >> 7) + 128 * half + (J & 127); }
        *(u32x4*)(WT + (size_t)row * K + k0 + 8 * c) = o; }
    asm volatile("s_waitcnt lgkmcnt(0)" ::: "memory");
}
__device__ __forceinline__ void rms_row_to_bf16(const float* xrow, const float* g, bf16_t* orow, int lane) {
    const f32x4* xr = (const f32x4*)xrow + lane; const f32x4* gr = (const f32x4*)g + lane;
    f32x4 v[4]; float s = 0.f;
#pragma unroll
    for (int j = 0; j < 4; ++j) { v[j] = xr[64 * j]; s += (v[j].x * v[j].x + v[j].y * v[j].y) + (v[j].z * v[j].z + v[j].w * v[j].w); }
    const float rstd = 1.0f / sqrtf(wave_sum(s) * (1.f / DM) + EPS);
    unsigned long long* o8 = (unsigned long long*)orow + lane;
#pragma unroll
    for (int j = 0; j < 4; ++j) { const f32x4 gg = gr[64 * j];
        o8[64 * j] = (unsigned long long)pk2(v[j].x * rstd * gg.x, v[j].y * rstd * gg.y) | ((unsigned long long)pk2(v[j].z * rstd * gg.z, v[j].w * rstd * gg.w) << 32); }
}
__device__ __forceinline__ void rms_row2_to_bf16(const float* xrow, const float* g, bf16_t* orow, int lane) {
    const f32x4* xr = (const f32x4*)xrow + lane; const f32x4* gr = (const f32x4*)g + lane;
    f32x4 v[2][4]; float s[2] = {0.f, 0.f};
#pragma unroll
    for (int r = 0; r < 2; ++r)
#pragma unroll
        for (int j = 0; j < 4; ++j) v[r][j] = __builtin_nontemporal_load(xr + r * 256 + 64 * j);
#pragma unroll
    for (int r = 0; r < 2; ++r)
#pragma unroll
        for (int j = 0; j < 4; ++j) s[r] += (v[r][j].x * v[r][j].x + v[r][j].y * v[r][j].y) + (v[r][j].z * v[r][j].z + v[r][j].w * v[r][j].w);
#pragma unroll
    for (int r = 0; r < 2; ++r) { const float rstd = 1.0f / sqrtf(wave_sum(s[r]) * (1.f / DM) + EPS); unsigned long long* o8 = (unsigned long long*)(orow + (size_t)r * DM) + lane;
#pragma unroll
        for (int j = 0; j < 4; ++j) { const f32x4 gg = gr[64 * j];
            o8[64 * j] = (unsigned long long)pk2(v[r][j].x * rstd * gg.x, v[r][j].y * rstd * gg.y) | ((unsigned long long)pk2(v[r][j].z * rstd * gg.z, v[r][j].w * rstd * gg.w) << 32); } }
}
__device__ __forceinline__ void p0_prologue(const Args& A, unsigned char* lds, int G) {
    const int tid = threadIdx.x, lane = tid & 63, wave = tid >> 6;
    float* scr = (float*)(lds + wave * 16384);
    unsigned char* ws = A.ws;
    const int gw = blockIdx.x * 8 + wave, NGW = G * 8;
    constexpr int I_IN = 16 * 80, I_OUT = 16 * 32, I_CQ = 16 * 32, I_CO = 16 * 32, I_FFI = 16 * 176, I_FFO = 44 * 32, I_KV = 16 * 64, I_PM = 4 * 8;
    constexpr int NITEMS = I_IN + I_OUT + I_CQ + I_CO + I_FFI + I_FFO + I_KV + I_PM;
    for (int it = gw; it < NITEMS; it += NGW) {
        int r = it;
        if (r < I_IN) { tr_item<0>(A.in[8], DM, NIN, (bf16_t*)(ws + WS_WIN), nullptr, scr, r, lane); continue; } r -= I_IN;
        if (r < I_OUT) { tr_item<0>(A.in[13], DM, DM, (bf16_t*)(ws + WS_WOUT), nullptr, scr, r, lane); continue; } r -= I_OUT;
        if (r < I_CQ) { tr_item<0>(A.in[17], DM, DM, (bf16_t*)(ws + WS_WCQ), A.in[16], scr, r, lane); continue; } r -= I_CQ;
        if (r < I_CO) { tr_item<0>(A.in[18], DM, DM, (bf16_t*)(ws + WS_WCO), nullptr, scr, r, lane); continue; } r -= I_CO;
        if (r < I_FFI) { tr_item<1>(A.in[20], DM, NFF2, (bf16_t*)(ws + WS_WFFI), A.in[19], scr, r, lane); continue; } r -= I_FFI;
        if (r < I_FFO) { tr_item<0>(A.in[21], DFF, DM, (bf16_t*)(ws + WS_WFFO), nullptr, scr, r, lane); continue; } r -= I_FFO;
        if (r < I_KV) { tr_item<0>(A.in[15], DM, 2 * DM, (bf16_t*)(ws + WS_WKV), nullptr, scr, r, lane); continue; } r -= I_KV;
        { const int g = r >> 3; tr_item<0>(A.in[11] + (size_t)g * 128 * 128, 128, 128, (bf16_t*)(ws + WS_PMIX) + (size_t)g * 128 * 128, nullptr, scr, r & 7, lane); }
    }
    bf16_t* H0 = (bf16_t*)(ws + WS_H0);
    for (int m = gw * 2; m < NVALID; m += NGW * 2) { const float* xr = m < NPR ? A.in[0] + (size_t)m * DM : A.in[1] + (size_t)(m - NPR) * DM; rms_row2_to_bf16(xr, A.in[7], H0 + (size_t)m * DM, lane); }
    bf16_t* MEMH = (bf16_t*)(ws + WS_MEMH);
    for (int m = gw; m < MEMR; m += NGW) rms_row_to_bf16(A.in[2] + (size_t)m * DM, A.in[14], MEMH + (size_t)m * DM, lane);
    const int gt = blockIdx.x * NTHREADS + tid, NGT = G * NTHREADS;
    for (int i = gt; i < (MT - NVALID) * DM / 8; i += NGT) { const u32x4 z = {0u, 0u, 0u, 0u};
        ((u32x4*)(ws + WS_H0) + (size_t)NVALID * DM / 8)[i] = z; ((u32x4*)(ws + WS_MIX) + (size_t)NVALID * DM / 8)[i] = z; ((u32x4*)(ws + WS_O) + (size_t)NVALID * DM / 8)[i] = z; }
    for (int i = gt; i < MT; i += NGT) { ((float*)(ws + WS_SS1))[i] = 0.f; ((float*)(ws + WS_SS2))[i] = 0.f; ((float*)(ws + WS_SS3))[i] = 0.f; }
}

constexpr int BS = 129;
constexpr int L_BC = 0, L_TOT = 33024, L_QM = 35072, L_KM = 52480, L_VT = 69888, L_SP = 88320, L_AL = 123136, L_PART = 132352, L_EM = 132864;
constexpr size_t WS_SPT = WS_X1;
__device__ __forceinline__ void hgrn_lf_load(u32x2v (&lf)[4], const unsigned short* LF, int R0, int C0, int t) {
#pragma unroll
    for (int i = 0; i < 4; ++i) { const int idx = i * 512 + t, s = idx >> 5, k4 = idx & 31; lf[i] = *(const u32x2v*)(LF + (size_t)(R0 + s) * HW + C0 + k4 * 4); }
}
__device__ __forceinline__ void hgrn_cumsum(const u32x2v (&lf)[4], float* Bc, float* tot, int t) {
#pragma unroll
    for (int i = 0; i < 4; ++i) { const int idx = i * 512 + t, s = idx >> 5, k4 = idx & 31; const u32x2v v = lf[i];
        float* d = Bc + s * BS + k4 * 4; d[0] = h_lo(v.x); d[1] = h_hi(v.x); d[2] = h_lo(v.y); d[3] = h_hi(v.y); }
    __syncthreads();
    const int seg = t >> 7, k = t & 127; float run = 0.f;
#pragma unroll
    for (int i = 0; i < 16; ++i) { run += Bc[(seg * 16 + i) * BS + k]; Bc[(seg * 16 + i) * BS + k] = run; }
    tot[seg * 128 + k] = run;
    __syncthreads();
    float off = 0.f;
#pragma unroll
    for (int j = 0; j < 3; ++j) off += (j < seg) ? tot[j * 128 + k] : 0.f;
#pragma unroll
    for (int i = 0; i < 16; ++i) Bc[(seg * 16 + i) * BS + k] += off;
    __syncthreads();
}
__device__ __forceinline__ void hgrn_local_load(const Args& A, int unit, u32x2v (&lf)[4], u32x4 (&kkr)[2], u32x4 (&vvr)[2]) {
    const int t = threadIdx.x, w = t >> 6, l = t & 63;
    const int bh = unit >> 5, c = unit & 31, b = bh >> 2, h = bh & 3, R0 = b * SEQ + c * 64, C0 = h * 128;
    const bf16_t* KK = (const bf16_t*)(A.ws + WS_KK); const bf16_t* VV = (const bf16_t*)(A.ws + WS_VV);
    hgrn_lf_load(lf, (const unsigned short*)(A.ws + WS_LF), R0, C0, t);
#pragma unroll
    for (int i = 0; i < 2; ++i) { const int k0 = (w + 8 * i) * 8; kkr[i] = *(const u32x4*)(KK + (size_t)(R0 + l) * HW + C0 + k0); vvr[i] = *(const u32x4*)(VV + (size_t)(R0 + l) * HW + C0 + k0); }
}
__device__ __forceinline__ void hgrn_local_unit(const Args& A, unsigned char* lds, int unit, int next, u32x2v (&lf)[4], u32x4 (&kkr)[2], u32x4 (&vvr)[2]) {
    const int t = threadIdx.x, w = t >> 6, l = t & 63, lr = l & 15, lq = l >> 4;
    const int bh = unit >> 5, c = unit & 31, b = bh >> 2, h = bh & 3, R0 = b * SEQ + c * 64, C0 = h * 128;
    unsigned char* ws = A.ws;
    float* Bc = (float*)(lds + L_BC); float* tot = (float*)(lds + L_TOT);
    bf16_t* kdT = (bf16_t*)(lds + L_QM); bf16_t* vT = (bf16_t*)(lds + L_VT);
    hgrn_cumsum(lf, Bc, tot, t);
#pragma unroll
    for (int i = 0; i < 2; ++i) { const int s = l, k0 = (w + 8 * i) * 8;
        const u32x4 kk = kkr[i], vv = vvr[i];
#pragma unroll
        for (int j = 0; j < 8; ++j) { const float e = __expf(Bc[63 * BS + k0 + j] - Bc[s * BS + k0 + j]);
            kdT[(k0 + j) * 72 + s] = (bf16_t)f2bf(bfe(kk, j) * e); vT[(k0 + j) * 72 + s] = bfr(vv, j); } }
    if (next >= 0) hgrn_local_load(A, next, lf, kkr, vvr);
    __syncthreads();
    f32x4 acc[8];
#pragma unroll
    for (int i = 0; i < 8; ++i) acc[i] = (f32x4){0.f, 0.f, 0.f, 0.f};
#pragma unroll
    for (int ks = 0; ks < 2; ++ks) { const bf16x8 a = *(const bf16x8*)(kdT + (16 * w + lr) * 72 + ks * 32 + lq * 8);
#pragma unroll
        for (int vt = 0; vt < 8; ++vt) { const bf16x8 bb = *(const bf16x8*)(vT + (16 * vt + lr) * 72 + ks * 32 + lq * 8); acc[vt] = MFMA16(a, bb, acc[vt]); } }
    unsigned short* SLT = (unsigned short*)(ws + WS_SL) + (size_t)unit * 16384;
#pragma unroll
    for (int vt = 0; vt < 8; ++vt) { u32x2v o; o.x = pk_h2(acc[vt][0], acc[vt][1]); o.y = pk_h2(acc[vt][2], acc[vt][3]); *(u32x2v*)(SLT + (16 * vt + lr) * 128 + 16 * w + lq * 4) = o; }
    if (t < 128) ((float*)(ws + WS_DEC))[unit * 128 + t] = __expf(Bc[63 * BS + t]);
    __syncthreads();
}
__device__ __forceinline__ void hgrn_out_load(const Args& A, int unit, u32x2v (&lf)[4], u32x4 (&qqr)[2], u32x4 (&kkr)[2], u32x4 (&vvr)[2], u32x4 (&spr)[4]) {
    const int t = threadIdx.x, w = t >> 6, l = t & 63;
    const int bh = unit >> 5, c = unit & 31, b = bh >> 2, h = bh & 3, R0 = b * SEQ + c * 64, C0 = h * 128;
    const bf16_t* QQ = (const bf16_t*)(A.ws + WS_QQ); const bf16_t* KK = (const bf16_t*)(A.ws + WS_KK); const bf16_t* VV = (const bf16_t*)(A.ws + WS_VV);
    hgrn_lf_load(lf, (const unsigned short*)(A.ws + WS_LF), R0, C0, t);
#pragma unroll
    for (int i = 0; i < 2; ++i) { const int idx = (i * 512 + t) * 8, s = idx >> 7, k0 = idx & 127; const size_t go = (size_t)(R0 + s) * HW + C0 + k0; qqr[i] = *(const u32x4*)(QQ + go); kkr[i] = *(const u32x4*)(KK + go);
        vvr[i] = *(const u32x4*)(VV + (size_t)(R0 + l) * HW + C0 + (w + 8 * i) * 8); }
    const bf16_t* SPT = (const bf16_t*)(A.ws + WS_SPT) + (size_t)unit * 16384;
#pragma unroll
    for (int i = 0; i < 4; ++i) { const int idx = i * 512 + t; spr[i] = *(const u32x4*)(SPT + (idx >> 4) * 128 + (idx & 15) * 8); }
}
__device__ __forceinline__ void hgrn_out_unit(const Args& A, unsigned char* lds, int unit, int next, u32x2v (&lf)[4], u32x4 (&qqr)[2], u32x4 (&kkr)[2], u32x4 (&vvr)[2], u32x4 (&spr)[4]) {
    const int t = threadIdx.x, w = t >> 6, l = t & 63, lr = l & 15, lq = l >> 4;
    const int bh = unit >> 5, c = unit & 31, b = bh >> 2, h = bh & 3, R0 = b * SEQ + c * 64, C0 = h * 128;
    unsigned char* ws = A.ws;
    float* Bc = (float*)(lds + L_BC); float* tot = (float*)(lds + L_TOT); float* part = (float*)(lds + L_PART); float* em = (float*)(lds + L_EM);
    bf16_t* qm = (bf16_t*)(lds + L_QM); bf16_t* km = (bf16_t*)(lds + L_KM); bf16_t* vT = (bf16_t*)(lds + L_VT); bf16_t* spT = (bf16_t*)(lds + L_SP); bf16_t* aL = (bf16_t*)(lds + L_AL);
    u32x4 ggr[2];
#pragma unroll
    for (int hh = 0; hh < 2; ++hh) ggr[hh] = *(const u32x4*)((const bf16_t*)(ws + WS_GG) + (size_t)(R0 + (t >> 3)) * HW + C0 + (t & 7) * 16 + hh * 8);
    hgrn_cumsum(lf, Bc, tot, t);
    if (t < 128) em[t] = __expf(Bc[31 * BS + t]);
#pragma unroll
    for (int i = 0; i < 2; ++i) { const int idx = (i * 512 + t) * 8, s = idx >> 7, k0 = idx & 127;
        const u32x4 qq = qqr[i], kk = kkr[i];
        float qv[8], kv[8];
#pragma unroll
        for (int j = 0; j < 8; ++j) { const float d = Bc[s * BS + k0 + j] - Bc[31 * BS + k0 + j]; qv[j] = bfe(qq, j) * __expf(d); kv[j] = bfe(kk, j) * __expf(-d); }
        u32x4 o; o.x = pk2(qv[0], qv[1]); o.y = pk2(qv[2], qv[3]); o.z = pk2(qv[4], qv[5]); o.w = pk2(qv[6], qv[7]); *(u32x4*)(qm + s * 136 + k0) = o;
        o.x = pk2(kv[0], kv[1]); o.y = pk2(kv[2], kv[3]); o.z = pk2(kv[4], kv[5]); o.w = pk2(kv[6], kv[7]); *(u32x4*)(km + s * 136 + k0) = o; }
#pragma unroll
    for (int i = 0; i < 2; ++i) { const int s = l, k0 = (w + 8 * i) * 8; const u32x4 vv = vvr[i];
#pragma unroll
        for (int j = 0; j < 8; ++j) vT[(k0 + j) * 72 + s] = bfr(vv, j); }
    __syncthreads();
    {
#pragma unroll
        for (int i = 0; i < 4; ++i) { const int idx = i * 512 + t, v = idx >> 4, k0 = (idx & 15) * 8; const u32x4 sv = spr[i];
            u32x4 o; o.x = pk2(bfe(sv, 0) * em[k0], bfe(sv, 1) * em[k0 + 1]); o.y = pk2(bfe(sv, 2) * em[k0 + 2], bfe(sv, 3) * em[k0 + 3]); o.z = pk2(bfe(sv, 4) * em[k0 + 4], bfe(sv, 5) * em[k0 + 5]); o.w = pk2(bfe(sv, 6) * em[k0 + 6], bfe(sv, 7) * em[k0 + 7]);
            *(u32x4*)(spT + v * 136 + k0) = o; } }
    if (next >= 0) hgrn_out_load(A, next, lf, qqr, kkr, vvr, spr);
    {
        const int ct = w & 3;
        f32x4 a2[2]; a2[0] = (f32x4){0.f, 0.f, 0.f, 0.f}; a2[1] = a2[0];
#pragma unroll
        for (int ks = 0; ks < 4; ++ks) { const bf16x8 a = *(const bf16x8*)(qm + (16 * ct + lr) * 136 + ks * 32 + lq * 8);
#pragma unroll
            for (int i = 0; i < 2; ++i) { const int st = (w >> 2) * 2 + i; const bf16x8 bb = *(const bf16x8*)(km + (16 * st + lr) * 136 + ks * 32 + lq * 8); a2[i] = MFMA16(a, bb, a2[i]); } }
#pragma unroll
        for (int i = 0; i < 2; ++i) { const int st = (w >> 2) * 2 + i, s = 16 * st + lr;
#pragma unroll
            for (int r = 0; r < 4; ++r) { const int cc = 16 * ct + lq * 4 + r; aL[cc * 72 + s] = (bf16_t)f2bf(s <= cc ? a2[i][r] : 0.f); } }
    }
    __syncthreads();
    const int ct = w & 3, vh = w >> 2;
    f32x4 o4[4];
#pragma unroll
    for (int i = 0; i < 4; ++i) o4[i] = (f32x4){0.f, 0.f, 0.f, 0.f};
#pragma unroll
    for (int ks = 0; ks < 4; ++ks) { const bf16x8 a = *(const bf16x8*)(qm + (16 * ct + lr) * 136 + ks * 32 + lq * 8);
#pragma unroll
        for (int i = 0; i < 4; ++i) { const int vt = vh * 4 + i; const bf16x8 bb = *(const bf16x8*)(spT + (16 * vt + lr) * 136 + ks * 32 + lq * 8); o4[i] = MFMA16(a, bb, o4[i]); } }
#pragma unroll
    for (int ks = 0; ks < 2; ++ks) { const bf16x8 a = *(const bf16x8*)(aL + (16 * ct + lr) * 72 + ks * 32 + lq * 8);
#pragma unroll
        for (int i = 0; i < 4; ++i) { const int vt = vh * 4 + i; const bf16x8 bb = *(const bf16x8*)(vT + (16 * vt + lr) * 72 + ks * 32 + lq * 8); o4[i] = MFMA16(a, bb, o4[i]); } }
    float* ost = (float*)(lds + L_BC);
#pragma unroll
    for (int r = 0; r < 4; ++r) { float s = 0.f;
#pragma unroll
        for (int i = 0; i < 4; ++i) { s += o4[i][r] * o4[i][r]; ost[(16 * ct + lq * 4 + r) * 132 + (vh * 4 + i) * 16 + lr] = o4[i][r]; }
        s += __shfl_xor(s, 1); s += __shfl_xor(s, 2); s += __shfl_xor(s, 4); s += __shfl_xor(s, 8);
        if (lr == 0) part[vh * 64 + 16 * ct + lq * 4 + r] = s; }
    __syncthreads();
    {   const float* hn = A.in[10]; bf16_t* MIX = (bf16_t*)(ws + WS_MIX);
        const int cc = t >> 3, v0 = (t & 7) * 16; const float rstd = __builtin_amdgcn_rsqf((part[cc] + part[64 + cc]) * (1.0f / 128.0f) + EPS);
#pragma unroll
        for (int hh = 0; hh < 2; ++hh) { const int v = v0 + hh * 8; const u32x4 g8 = ggr[hh];
            const f32x4 oa = *(const f32x4*)(ost + cc * 132 + v), ob = *(const f32x4*)(ost + cc * 132 + v + 4), na = *(const f32x4*)(hn + C0 + v), nb = *(const f32x4*)(hn + C0 + v + 4);
            u32x4 o; o.x = pk2(oa[0] * rstd * na[0] * bfe(g8, 0), oa[1] * rstd * na[1] * bfe(g8, 1)); o.y = pk2(oa[2] * rstd * na[2] * bfe(g8, 2), oa[3] * rstd * na[3] * bfe(g8, 3));
            o.z = pk2(ob[0] * rstd * nb[0] * bfe(g8, 4), ob[1] * rstd * nb[1] * bfe(g8, 5)); o.w = pk2(ob[2] * rstd * nb[2] * bfe(g8, 6), ob[3] * rstd * nb[3] * bfe(g8, 7));
            *(u32x4*)(MIX + (size_t)(R0 + cc) * DM + C0 + v) = o; } }
    __syncthreads();
}
__device__ __forceinline__ void hgrn_scan(const Args& A, int G) {
    const u32x2v* SLT = (const u32x2v*)(A.ws + WS_SL); const f32x4* DEC4 = (const f32x4*)(A.ws + WS_DEC); u32x2v* SPT = (u32x2v*)(A.ws + WS_SPT); float* outp = A.out + O_HP;
    for (int e = blockIdx.x * NTHREADS + threadIdx.x; e < 32 * 4096; e += G * NTHREADS) { const int bh = e >> 12, i4 = e & 4095, v = i4 >> 5, k4 = i4 & 31;
        f32x4 S = (f32x4){0.f, 0.f, 0.f, 0.f};
        const u32x2v* p = SLT + (size_t)bh * 32 * 4096 + i4; u32x2v* q = SPT + (size_t)bh * 32 * 4096 + i4; const f32x4* dp = DEC4 + (size_t)bh * 32 * 32 + k4;
#pragma unroll
        for (int hf = 0; hf < 2; ++hf) { u32x2v loc[16]; f32x4 dd[16];
#pragma unroll
            for (int c = 0; c < 16; ++c) { loc[c] = p[(size_t)(hf * 16 + c) * 4096]; dd[c] = dp[(hf * 16 + c) * 32]; }
#pragma unroll
            for (int c = 0; c < 16; ++c) { u32x2v o; o.x = pk2(S[0], S[1]); o.y = pk2(S[2], S[3]); q[(size_t)(hf * 16 + c) * 4096] = o; const f32x4 lv = (f32x4){h_lo(loc[c].x), h_hi(loc[c].x), h_lo(loc[c].y), h_hi(loc[c].y)}; S = S * dd[c] + lv; } }
        float* ob = outp + (size_t)bh * 16384 + (k4 * 4) * 128 + v; ob[0] = S[0]; ob[128] = S[1]; ob[256] = S[2]; ob[384] = S[3]; }
}
__device__ __forceinline__ void pool_states(const Args& A, int G) {
    const unsigned short* UU = (const unsigned short*)(A.ws + WS_UU);
    const int gt = blockIdx.x * NTHREADS + threadIdx.x, NGT = G * NTHREADS;
    for (int i = gt; i < 8 * 15 * 128; i += NGT) { const int c4 = i & 127, j = (i >> 7) % 15, b = i / (15 * 128); const u32x2v v = *(const u32x2v*)(UU + (size_t)(b * SEQ + 2033 + j) * HW + c4 * 4);
        *(f32x4*)(A.out + O_PP + (size_t)i * 4) = (f32x4){h_lo(v.x), h_hi(v.x), h_lo(v.y), h_hi(v.y)}; }
    for (int i0 = gt * 2; i0 < 128 * 15 * 128; i0 += NGT * 2) { f32x4 v[2];
#pragma unroll
        for (int q = 0; q < 2; ++q) { const int i = i0 + q, c4 = i & 127, j = (i >> 7) % 15, b = i / (15 * 128);
            if (j < 14) v[q] = *(const f32x4*)(A.in[4] + (size_t)(b * 15 + j + 1) * 512 + c4 * 4);
            else { const u32x2v h = *(const u32x2v*)(UU + (size_t)(NPR + b) * HW + c4 * 4); v[q] = (f32x4){h_lo(h.x), h_hi(h.x), h_lo(h.y), h_hi(h.y)}; } }
#pragma unroll
        for (int q = 0; q < 2; ++q) *(f32x4*)(A.out + O_PS + (size_t)(i0 + q) * 4) = v[q]; }
}
__device__ __forceinline__ void hgrn_sample_load(const Args& A, int unit, f32x4 (&sreg)[8]) {
    const int t = threadIdx.x; const float* S0 = A.in[3] + (size_t)unit * 16384;
#pragma unroll
    for (int i = 0; i < 8; ++i) sreg[i] = __builtin_nontemporal_load((const f32x4*)(S0 + ((t >> 5) * 8 + i) * 128 + (t & 31) * 4));
}
__device__ __forceinline__ void hgrn_sample_unit(const Args& A, unsigned char* lds, int unit, int next, f32x4 (&sreg)[8]) {
    const int t = threadIdx.x, b = unit >> 2, h = unit & 3, row = NPR + b, C0 = h * 128;
    unsigned char* ws = A.ws;
    float* qs = (float*)lds; float* ks = qs + 128; float* fs = ks + 128; float* vs = fs + 128; float* po = vs + 128;
    float* red = po + 16 * 128;
    float* S1 = A.out + O_HS + (size_t)unit * 16384;
    if (t < 128) { const size_t go = (size_t)row * HW + C0 + t;
        qs[t] = bf2f(((const bf16_t*)(ws + WS_QQ))[go]); ks[t] = bf2f(((const bf16_t*)(ws + WS_KK))[go]); fs[t] = __expf((float)__builtin_bit_cast(_Float16, ((const unsigned short*)(ws + WS_LF))[go])); vs[t] = bf2f(((const bf16_t*)(ws + WS_VV))[go]); }
    __syncthreads();
    const int v4 = t & 31, kg = t >> 5;
    const f32x4 vv = *(const f32x4*)(vs + v4 * 4);
    f32x4 o = (f32x4){0.f, 0.f, 0.f, 0.f};
#pragma unroll
    for (int i = 0; i < 8; ++i) { const int k = kg * 8 + i; const f32x4 s = sreg[i]; const f32x4 sn = s * fs[k] + vv * ks[k]; __builtin_nontemporal_store(sn, (f32x4*)(S1 + k * 128 + v4 * 4)); o += sn * qs[k]; }
    *(f32x4*)(po + kg * 128 + v4 * 4) = o;
    if (next >= 0) hgrn_sample_load(A, next, sreg);
    __syncthreads();
    float ov = 0.f;
    if (t < 128) {
#pragma unroll
        for (int i = 0; i < 16; ++i) ov += po[i * 128 + t];
        const float sq = wave_sum(ov * ov); if ((t & 63) == 0) red[t >> 6] = sq; }
    __syncthreads();
    if (t < 128) { const float rstd = __builtin_amdgcn_rsqf((red[0] + red[1]) * (1.0f / 128.0f) + EPS); const float g = bf2f(((const bf16_t*)(ws + WS_GG))[(size_t)row * HW + C0 + t]);
        ((bf16_t*)(ws + WS_MIX))[(size_t)row * DM + C0 + t] = (bf16_t)f2bf(ov * rstd * A.in[10][C0 + t] * g); }
    __syncthreads();
}

constexpr int LP_EXT = 0, LP_PL = 40448, LP_MX = 57856;
__device__ __forceinline__ void pool_load(const Args& A, int unit, u32x4 (&mreg)[4], u32x2v (&ereg)[5]) {
    const int t = threadIdx.x; const int tt = unit >> 2, g = unit & 3;
    const unsigned short* UU = (const unsigned short*)(A.ws + WS_UU);
    const bf16_t* PM = (const bf16_t*)(A.ws + WS_PMIX) + (size_t)g * 16384;
#pragma unroll
    for (int i = 0; i < 4; ++i) { const int idx = i * 512 + t, d = idx >> 4, c8 = idx & 15; mreg[i] = *(const u32x4*)(PM + d * 128 + c8 * 8); }
    const int b = tt >> 5, t0 = (tt & 31) * 64;
#pragma unroll
    for (int i5 = 0; i5 < 5; ++i5) { const int idx = i5 * 512 + t, i = idx >> 5, c4 = idx & 31; const int tp = t0 - 15 + i;
        ereg[i5] = (u32x2v){0u, 0u}; if (idx < 79 * 32 && tp >= 0) ereg[i5] = *(const u32x2v*)(UU + (size_t)(b * SEQ + tp) * HW + g * 128 + c4 * 4); }
}
__device__ __forceinline__ void pool_unit(const Args& A, unsigned char* lds, int unit, int next, u32x4 (&mreg)[4], u32x2v (&ereg)[5]) {
    const int t = threadIdx.x, w = t >> 6, l = t & 63, lr = l & 15, lq = l >> 4;
    const int tt = unit >> 2, g = unit & 3, win = 2 << g;
    unsigned char* ws = A.ws;
    float* ext = (float*)(lds + LP_EXT); bf16_t* pl = (bf16_t*)(lds + LP_PL); bf16_t* mx = (bf16_t*)(lds + LP_MX);
    const unsigned short* UU = (const unsigned short*)(ws + WS_UU);
    {
#pragma unroll
        for (int i = 0; i < 4; ++i) { const int idx = i * 512 + t, d = idx >> 4, c8 = idx & 15; *(u32x4*)(mx + d * 136 + c8 * 8) = mreg[i]; }
    }
    int rowbase;
    {
        const int b = tt >> 5, t0 = (tt & 31) * 64; rowbase = b * SEQ + t0;
#pragma unroll
        for (int i5 = 0; i5 < 5; ++i5) { const int idx = i5 * 512 + t, i = idx >> 5, c4 = idx & 31; if (idx < 79 * 32) *(f32x4*)(ext + i * 128 + c4 * 4) = (f32x4){h_lo(ereg[i5].x), h_hi(ereg[i5].x), h_lo(ereg[i5].y), h_hi(ereg[i5].y)}; }
        if (next >= 0) pool_load(A, next, mreg, ereg);
        __syncthreads();
        const int cch = t & 127, tg = t >> 7, tk0 = tg * 16;
        float nw[16], od[16], ini[16];
#pragma unroll
        for (int i = 0; i < 16; ++i) { nw[i] = ext[(15 + tk0 + i) * 128 + cch]; od[i] = (i >= 1) ? ext[(15 + tk0 + i - win) * 128 + cch] : 0.f; ini[i] = (i >= 1 && i < win) ? ext[(15 + tk0 - i) * 128 + cch] : 0.f; }
        float sw = 0.f;
#pragma unroll
        for (int i = 1; i < 16; ++i) sw += ini[i];
#pragma unroll
        for (int i = 0; i < 16; ++i) { const int tok = tk0 + i; sw += nw[i]; sw -= od[i];
            const int cnt = min(t0 + tok + 1, win);
            pl[tok * 136 + cch] = (bf16_t)f2bf(sw * __builtin_amdgcn_rcpf((float)cnt) - nw[i]); }
    }
    __syncthreads();
    const int ct = w & 3, dh = w >> 2;
    f32x4 o4[4];
#pragma unroll
    for (int i = 0; i < 4; ++i) o4[i] = (f32x4){0.f, 0.f, 0.f, 0.f};
#pragma unroll
    for (int ks = 0; ks < 4; ++ks) { const bf16x8 a = *(const bf16x8*)(pl + (16 * ct + lr) * 136 + ks * 32 + lq * 8);
#pragma unroll
        for (int i = 0; i < 4; ++i) { const int dt = dh * 4 + i; const bf16x8 bb = *(const bf16x8*)(mx + (16 * dt + lr) * 136 + ks * 32 + lq * 8); o4[i] = MFMA16(a, bb, o4[i]); } }
    bf16_t* MIX = (bf16_t*)(ws + WS_MIX); const float* psc = A.in[12];
    float* ost = (float*)(lds + LP_EXT);
#pragma unroll
    for (int i = 0; i < 4; ++i) { const int d = (dh * 4 + i) * 16 + lr; const float sc = psc[g * 128 + d];
#pragma unroll
        for (int r = 0; r < 4; ++r) ost[(16 * ct + lq * 4 + r) * 132 + d] = o4[i][r] * sc; }
    __syncthreads();
    {   const int tok = t >> 3, d0 = (t & 7) * 16;
#pragma unroll
        for (int hh = 0; hh < 2; ++hh) { const f32x4 oa = *(const f32x4*)(ost + tok * 132 + d0 + hh * 8), ob = *(const f32x4*)(ost + tok * 132 + d0 + hh * 8 + 4);
            u32x4 o; o.x = pk2(oa[0], oa[1]); o.y = pk2(oa[2], oa[3]); o.z = pk2(ob[0], ob[1]); o.w = pk2(ob[2], ob[3]);
            *(u32x4*)(MIX + (size_t)(rowbase + tok) * DM + 512 + g * 128 + d0 + hh * 8) = o; } }
    __syncthreads();
}

__device__ __forceinline__ void pool_sample_unit(const Args& A, unsigned char* lds, int unit) {
    const int t = threadIdx.x, w = t >> 6, l = t & 63, lr = l & 15, lq = l >> 4;
    const int su = unit >> 2, g = unit & 3, win = 2 << g;
    unsigned char* ws = A.ws;
    bf16_t* pl = (bf16_t*)(lds + LP_PL); bf16_t* mx = (bf16_t*)(lds + LP_MX);
    const _Float16* UU = (const _Float16*)(ws + WS_UU);
    const bf16_t* PM = (const bf16_t*)(ws + WS_PMIX) + (size_t)g * 16384;
    u32x4 mreg[4];
#pragma unroll
    for (int i = 0; i < 4; ++i) { const int idx = i * 512 + t, d = idx >> 4, c8 = idx & 15; mreg[i] = *(const u32x4*)(PM + d * 128 + c8 * 8); }
    const int cch = t & 127, sq = t >> 7;
    const float psc_w = A.in[12][g * 128 + 16 * w + lr];
#pragma unroll
    for (int i = 0; i < 4; ++i) { const int tok = sq * 4 + i, sb = su * 16 + tok; const float uv = (float)UU[(size_t)(NPR + sb) * HW + g * 128 + cch];
        float pv[15];
#pragma unroll
        for (int j = 0; j < 15; ++j) pv[j] = A.in[4][(size_t)(sb * 15 + j) * 512 + g * 128 + cch];
        float sacc = uv;
#pragma unroll
        for (int j = 0; j < 15; ++j) sacc += (j >= 16 - win) ? pv[j] : 0.f;
        pl[tok * 136 + cch] = (bf16_t)f2bf(sacc * __builtin_amdgcn_rcpf((float)win) - uv); }
#pragma unroll
    for (int i = 0; i < 4; ++i) { const int idx = i * 512 + t, d = idx >> 4, c8 = idx & 15; *(u32x4*)(mx + d * 136 + c8 * 8) = mreg[i]; }
    __syncthreads();
    f32x4 acc = (f32x4){0.f, 0.f, 0.f, 0.f};
#pragma unroll
    for (int ks = 0; ks < 4; ++ks) { const bf16x8 a = *(const bf16x8*)(pl + lr * 136 + ks * 32 + lq * 8); const bf16x8 bb = *(const bf16x8*)(mx + (16 * w + lr) * 136 + ks * 32 + lq * 8); acc = MFMA16(a, bb, acc); }
    bf16_t* MIX = (bf16_t*)(ws + WS_MIX);
#pragma unroll
    for (int r = 0; r < 4; ++r) MIX[(size_t)(NPR + su * 16 + lq * 4 + r) * DM + 512 + g * 128 + 16 * w + lr] = (bf16_t)f2bf(acc[r] * psc_w);
    __syncthreads();
}

__device__ __forceinline__ void attn_prompt_unit(const Args& A, unsigned char* lds, int unit) {
    const int t = threadIdx.x, w = t >> 6, l = t & 63, lr = l & 15, lq = l >> 4;
    const int qt = unit & 15, h = (unit >> 4) & 3, b = unit >> 6;
    unsigned char* ws = A.ws;
    const bf16_t* Q = (const bf16_t*)(ws + WS_Q); const bf16_t* KB = (const bf16_t*)(ws + WS_KB); const bf16_t* VT = (const bf16_t*)(ws + WS_VT); bf16_t* O = (bf16_t*)(ws + WS_O);
    const int R0 = b * SEQ + qt * 128 + 16 * w;
    bf16_t* CB = (bf16_t*)lds;
    bf16_t* Pw = (bf16_t*)(lds + 73728) + w * (16 * 264);
    const bf16_t* kg = KB + (size_t)(b * 256) * DM + h * 256;
    const bf16_t* vg = VT + (size_t)(h * 256) * MEMR + b * 256;
    u32x4 stg0[4], stg1[4];
#define AT_LOADK(c, STG) _Pragma("unroll") for (int i_ = 0; i_ < 4; ++i_) { const int idx_ = i_ * 512 + t; STG[i_] = *(const u32x4*)(kg + (size_t)((c) * 64 + (idx_ >> 5)) * DM + (idx_ & 31) * 8); }
#define AT_LOADV(c, STG) _Pragma("unroll") for (int i_ = 0; i_ < 4; ++i_) { const int idx_ = i_ * 512 + t; STG[i_] = *(const u32x4*)(vg + (size_t)(idx_ >> 3) * MEMR + (c) * 64 + (idx_ & 7) * 8); }
#define AT_STOREK(bf, STG) _Pragma("unroll") for (int i_ = 0; i_ < 4; ++i_) { const int idx_ = i_ * 512 + t; *(u32x4*)(CB + (bf) * 18432 + (idx_ >> 5) * 264 + (idx_ & 31) * 8) = STG[i_]; }
#define AT_STOREV(bf, STG) _Pragma("unroll") for (int i_ = 0; i_ < 4; ++i_) { const int idx_ = i_ * 512 + t; *(u32x4*)(CB + (bf) * 18432 + (idx_ >> 3) * 72 + (idx_ & 7) * 8) = STG[i_]; }
    AT_LOADK(0, stg0); AT_LOADK(1, stg1);
    bf16x8 qa[8];
#pragma unroll
    for (int ks = 0; ks < 8; ++ks) qa[ks] = *(const bf16x8*)(Q + (size_t)(R0 + lr) * DM + h * 256 + ks * 32 + lq * 8);
    AT_STOREK(0, stg0);
    __syncthreads();
    f32x4 sacc[16]; f32x4 oacc[16]; bf16x8 pa[8]; float rinv[4];
#pragma unroll
    for (int st = 0; st < 8; ++st) {
        if (st & 1) { if (st + 2 < 4) { AT_LOADK(st + 2, stg1); } else if (st + 2 < 8) { AT_LOADV(st - 2, stg1); } }
        else        { if (st + 2 < 4) { AT_LOADK(st + 2, stg0); } else if (st + 2 < 8) { AT_LOADV(st - 2, stg0); } }
        const bf16_t* cb = CB + (st & 1) * 18432;
        if (st < 4) {
#pragma unroll
            for (int nt = 0; nt < 4; ++nt) { f32x4 acc = (f32x4){0.f, 0.f, 0.f, 0.f};
#pragma unroll
                for (int ks = 0; ks < 8; ++ks) { const bf16x8 bb = *(const bf16x8*)(cb + (nt * 16 + lr) * 264 + ks * 32 + lq * 8); acc = MFMA16(qa[ks], bb, acc); }
                sacc[st * 4 + nt] = acc; __builtin_amdgcn_sched_barrier(0); }
        } else {
            if (st == 4) {
#pragma unroll
                for (int r = 0; r < 4; ++r) { float mx = sacc[0][r];
#pragma unroll
                    for (int nt = 1; nt < 16; ++nt) mx = fmaxf(mx, sacc[nt][r]);
                    mx = fmaxf(mx, __shfl_xor(mx, 1)); mx = fmaxf(mx, __shfl_xor(mx, 2)); mx = fmaxf(mx, __shfl_xor(mx, 4)); mx = fmaxf(mx, __shfl_xor(mx, 8));
                    float sum = 0.f;
#pragma unroll
                    for (int nt = 0; nt < 16; ++nt) { const float p = __builtin_amdgcn_exp2f(sacc[nt][r] - mx); sum += p; Pw[(lq * 4 + r) * 264 + nt * 16 + lr] = (bf16_t)f2bf(p); }
                    sum += __shfl_xor(sum, 1); sum += __shfl_xor(sum, 2); sum += __shfl_xor(sum, 4); sum += __shfl_xor(sum, 8);
                    rinv[r] = 1.0f / sum; }
                asm volatile("s_waitcnt lgkmcnt(0)" ::: "memory");
#pragma unroll
                for (int ks = 0; ks < 8; ++ks) pa[ks] = *(const bf16x8*)(Pw + lr * 264 + ks * 32 + lq * 8);
#pragma unroll
                for (int dt = 0; dt < 16; ++dt) oacc[dt] = (f32x4){0.f, 0.f, 0.f, 0.f};
            }
            const int c = st - 4;
#pragma unroll
            for (int dt = 0; dt < 16; ++dt)
#pragma unroll
                for (int k2 = 0; k2 < 2; ++k2) { const bf16x8 bb = *(const bf16x8*)(cb + (dt * 16 + lr) * 72 + k2 * 32 + lq * 8); oacc[dt] = MFMA16(pa[c * 2 + k2], bb, oacc[dt]); if (k2 == 1 && (dt & 1)) __builtin_amdgcn_sched_barrier(0); }
        }
        if (st & 1) { if (st + 1 < 4) { AT_STOREK(0, stg0); } else if (st + 1 < 8) { AT_STOREV(0, stg0); } }
        else        { if (st + 1 < 4) { AT_STOREK(1, stg1); } else if (st + 1 < 8) { AT_STOREV(1, stg1); } }
        __syncthreads();
    }
#pragma unroll
    for (int dt = 0; dt < 16; ++dt)
#pragma unroll
        for (int r = 0; r < 4; ++r) Pw[(lq * 4 + r) * 264 + dt * 16 + lr] = (bf16_t)f2bf(oacc[dt][r] * rinv[r]);
    asm volatile("s_waitcnt lgkmcnt(0)" ::: "memory");
#pragma unroll
    for (int i = 0; i < 8; ++i) { const int idx = i * 64 + l, row = idx >> 5, c8 = idx & 31; *(u32x4*)(O + (size_t)(R0 + row) * DM + h * 256 + c8 * 8) = *(const u32x4*)(Pw + row * 264 + c8 * 8); }
    asm volatile("s_waitcnt lgkmcnt(0)" ::: "memory");
#undef AT_LOADK
#undef AT_LOADV
#undef AT_STOREK
#undef AT_STOREV
}
__device__ __forceinline__ void attn_sample_unit(const Args& A, unsigned char* lds, int unit) {
    const int t = threadIdx.x, w = t >> 6, l = t & 63;
    const int b = unit >> 2, h = unit & 3;
    unsigned char* ws = A.ws;
    float* qs = (float*)lds; float* sc = qs + 256; float* red = sc + 256; float* po = red + 16;
    const float* Kc = A.in[5] + (size_t)b * 256 * 1024 + h * 256; const float* Vc = A.in[6] + (size_t)b * 256 * 1024 + h * 256;
    const int rl = l >> 4, c16 = l & 15;
    f32x4 kr[8][4];
#pragma unroll
    for (int p = 0; p < 8; ++p)
#pragma unroll
        for (int i = 0; i < 4; ++i) kr[p][i] = *(const f32x4*)(Kc + (size_t)(p * 32 + w * 4 + rl) * 1024 + i * 64 + c16 * 4);
    if (t < 256) qs[t] = bf2f(((const bf16_t*)(ws + WS_Q))[(size_t)(NPR + b) * DM + h * 256 + t]);
    __syncthreads();
    {
        f32x4 q4[4];
#pragma unroll
        for (int i = 0; i < 4; ++i) q4[i] = *(const f32x4*)(qs + i * 64 + c16 * 4);
#pragma unroll
        for (int p = 0; p < 8; ++p) { const int m = p * 32 + w * 4 + rl; float s = 0.f;
#pragma unroll
            for (int i = 0; i < 4; ++i) { const f32x4 kv = kr[p][i]; s += (kv[0] * q4[i][0] + kv[1] * q4[i][1]) + (kv[2] * q4[i][2] + kv[3] * q4[i][3]); }
            s += __shfl_xor(s, 1); s += __shfl_xor(s, 2); s += __shfl_xor(s, 4); s += __shfl_xor(s, 8);
            if (c16 == 0) sc[m] = s; }
    }
    f32x4 vr[32];
#pragma unroll
    for (int i = 0; i < 32; ++i) vr[i] = *(const f32x4*)(Vc + (size_t)(w * 32 + i) * 1024 + l * 4);
    __syncthreads();
    if (t < 256) { float mx = sc[t];
#pragma unroll
        for (int o = 1; o < 64; o <<= 1) mx = fmaxf(mx, __shfl_xor(mx, o));
        if (l == 0) red[w] = mx; }
    __syncthreads();
    const float gmx = fmaxf(fmaxf(red[0], red[1]), fmaxf(red[2], red[3]));
    float pv = 0.f;
    if (t < 256) { pv = __builtin_amdgcn_exp2f(sc[t] - gmx); const float s = wave_sum(pv); if (l == 0) red[8 + w] = s; }
    __syncthreads();
    if (t < 256) sc[t] = pv;
    const float inv = 1.0f / ((red[8] + red[9]) + (red[10] + red[11]));
    __syncthreads();
    {
        f32x4 o = (f32x4){0.f, 0.f, 0.f, 0.f};
#pragma unroll
        for (int i = 0; i < 32; ++i) o += vr[i] * sc[w * 32 + i];
        *(f32x4*)(po + w * 256 + l * 4) = o;
    }
    __syncthreads();
    if (t < 256) { float o = 0.f;
#pragma unroll
        for (int i = 0; i < 8; ++i) o += po[i * 256 + t];
        ((bf16_t*)(ws + WS_O))[(size_t)(NPR + b) * DM + h * 256 + t] = (bf16_t)f2bf(o * inv); }
    __syncthreads();
}

__device__ __forceinline__ void attn_sample_pair(const Args& A, unsigned char* lds, int pg) {
    const int t = threadIdx.x, w = t >> 6, l = t & 63, rl = l >> 4, c16 = l & 15;
    const int pair = pg * 2 + (w >> 2), wq = w & 3, b = pair >> 2, h = pair & 3;
    const size_t off0 = (size_t)b * 256 * 1024 + h * 256 + (size_t)(wq * 64 + rl) * 1024 + c16 * 4;
    const float* Kc = A.in[5] + off0; const float* Vc = A.in[6] + off0;
    f32x4 ra[8], rb[8];
#define AS_LD(set, base, bt) _Pragma("unroll") for (int gg_ = 0; gg_ < 2; ++gg_) _Pragma("unroll") for (int i_ = 0; i_ < 4; ++i_) set[gg_ * 4 + i_] = __builtin_nontemporal_load((const f32x4*)((base) + (size_t)((bt) * 8 + gg_ * 4) * 1024 + i_ * 64))
    AS_LD(ra, Kc, 0); AS_LD(rb, Kc, 1);
    f32x4 q4[4];
    {   const bf16_t* qp = (const bf16_t*)(A.ws + WS_Q) + (size_t)(NPR + b) * DM + h * 256 + c16 * 4;
#pragma unroll
        for (int i = 0; i < 4; ++i) { const u32x2v qv = *(const u32x2v*)(qp + i * 64); q4[i] = (f32x4){__uint_as_float(qv.x << 16), __uint_as_float(qv.x & 0xffff0000u), __uint_as_float(qv.y << 16), __uint_as_float(qv.y & 0xffff0000u)}; } }
    float sc[16];
#define AS_SCORE(set, bt) _Pragma("unroll") for (int gg_ = 0; gg_ < 2; ++gg_) { float s_ = 0.f; _Pragma("unroll") for (int i_ = 0; i_ < 4; ++i_) { const f32x4 kv_ = set[gg_ * 4 + i_]; s_ += (kv_[0] * q4[i_][0] + kv_[1] * q4[i_][1]) + (kv_[2] * q4[i_][2] + kv_[3] * q4[i_][3]); } \
        s_ += __shfl_xor(s_, 1); s_ += __shfl_xor(s_, 2); s_ += __shfl_xor(s_, 4); s_ += __shfl_xor(s_, 8); sc[(bt) * 2 + gg_] = s_; }
#pragma unroll
    for (int bt = 0; bt < 8; ++bt) {
        if (bt & 1) { AS_SCORE(rb, bt); if (bt + 2 < 8) { AS_LD(rb, Kc, bt + 2); } else { AS_LD(rb, Vc, bt - 6); } }
        else        { AS_SCORE(ra, bt); if (bt + 2 < 8) { AS_LD(ra, Kc, bt + 2); } else { AS_LD(ra, Vc, bt - 6); } }
        asm volatile("" ::: "memory"); __builtin_amdgcn_sched_barrier(0);
    }
    float mx = sc[0];
#pragma unroll
    for (int g = 1; g < 16; ++g) mx = fmaxf(mx, sc[g]);
    mx = fmaxf(mx, __shfl_xor(mx, 16)); mx = fmaxf(mx, __shfl_xor(mx, 32));
    float ls = 0.f;
#pragma unroll
    for (int g = 0; g < 16; ++g) { sc[g] = __builtin_amdgcn_exp2f(sc[g] - mx); ls += sc[g]; }
    ls += __shfl_xor(ls, 16); ls += __shfl_xor(ls, 32);
    f32x4 o[4];
#pragma unroll
    for (int i = 0; i < 4; ++i) o[i] = (f32x4){0.f, 0.f, 0.f, 0.f};
#define AS_PV(set, bt) _Pragma("unroll") for (int gg_ = 0; gg_ < 2; ++gg_) _Pragma("unroll") for (int i_ = 0; i_ < 4; ++i_) o[i_] += set[gg_ * 4 + i_] * sc[(bt) * 2 + gg_]
#pragma unroll
    for (int bt = 0; bt < 8; ++bt) {
        if (bt & 1) { AS_PV(rb, bt); if (bt + 2 < 8) { AS_LD(rb, Vc, bt + 2); } }
        else        { AS_PV(ra, bt); if (bt + 2 < 8) { AS_LD(ra, Vc, bt + 2); } }
        asm volatile("" ::: "memory"); __builtin_amdgcn_sched_barrier(0);
    }
#pragma unroll
    for (int i = 0; i < 4; ++i)
#pragma unroll
        for (int c = 0; c < 4; ++c) { float v = o[i][c]; v += __shfl_xor(v, 16); v += __shfl_xor(v, 32); o[i][c] = v; }
    float* pw = (float*)lds + w * 260;
    if (rl == 0) {
#pragma unroll
        for (int i = 0; i < 4; ++i) *(f32x4*)(pw + i * 64 + c16 * 4) = o[i];
        if (c16 == 0) { pw[256] = mx; pw[257] = ls; } }
    __syncthreads();
    {   const int ps = t >> 8, d = t & 255; const float* pb = (const float*)lds + (ps * 4) * 260;
        const float m0 = pb[256], m1 = pb[260 + 256], m2 = pb[520 + 256], m3 = pb[780 + 256]; const float M = fmaxf(fmaxf(m0, m1), fmaxf(m2, m3));
        const float e0 = __builtin_amdgcn_exp2f(m0 - M), e1 = __builtin_amdgcn_exp2f(m1 - M), e2 = __builtin_amdgcn_exp2f(m2 - M), e3 = __builtin_amdgcn_exp2f(m3 - M);
        const float num = (pb[d] * e0 + pb[260 + d] * e1) + (pb[520 + d] * e2 + pb[780 + d] * e3);
        const float den = (pb[257] * e0 + pb[260 + 257] * e1) + (pb[520 + 257] * e2 + pb[780 + 257] * e3);
        const int pr = pg * 2 + ps, bb = pr >> 2, hh = pr & 3;
        ((bf16_t*)(A.ws + WS_O))[(size_t)(NPR + bb) * DM + hh * 256 + d] = (bf16_t)f2bf(num / den); }
    __syncthreads();
#undef AS_LD
#undef AS_SCORE
#undef AS_PV
}

template <int KIND, int NKS>
__device__ __forceinline__ void sample_gemm(unsigned char* lds, const bf16_t* Asm, int lda, const bf16_t* Bt, int K, int unit, const float* base, const bf16_t* baseb, float* out, bf16_t* outb, float* ss, float scale) {
    const int t = threadIdx.x, w = t >> 6, l = t & 63, lr = l & 15, lq = l >> 4;
    const int rb = unit & 3, cb = unit >> 2, kw = K >> 3, k0 = w * kw;
    f32x4 acc[2]; acc[0] = (f32x4){0.f, 0.f, 0.f, 0.f}; acc[1] = acc[0];
    const bf16_t* bp = Bt + (size_t)(cb * 16 + lr) * K + k0 + lq * 8;
    const bf16_t* ap = Asm + (size_t)(rb * 32 + lr) * lda + k0 + lq * 8;
    bf16x8 fb[NKS], fa0[NKS], fa1[NKS];
#pragma unroll
    for (int ks = 0; ks < NKS; ++ks) { fb[ks] = *(const bf16x8*)(bp + ks * 32); fa0[ks] = *(const bf16x8*)(ap + ks * 32); fa1[ks] = *(const bf16x8*)(ap + (size_t)16 * lda + ks * 32); }
    const int row_ = t >> 4, col_ = t & 15;
    float bres = 0.f;
    if (KIND == 0) bres = base ? base[(size_t)(rb * 32 + row_) * DM + cb * 16 + col_] : bf2f(baseb[(size_t)(rb * 32 + row_) * DM + cb * 16 + col_]);
#pragma unroll
    for (int ks = 0; ks < NKS; ++ks) { acc[0] = MFMA16(fa0[ks], fb[ks], acc[0]); acc[1] = MFMA16(fa1[ks], fb[ks], acc[1]); }
    float* red = (float*)lds;
#pragma unroll
    for (int i = 0; i < 2; ++i)
#pragma unroll
        for (int r = 0; r < 4; ++r) red[(w * 32 + i * 16 + lq * 4 + r) * 16 + lr] = acc[i][r];
    __syncthreads();
    const int row = t >> 4, col = t & 15, grow = rb * 32 + row, gcol = cb * 16 + col;
    float v = 0.f;
#pragma unroll
    for (int i = 0; i < 8; ++i) v += red[(i * 32 + row) * 16 + col];
    if (KIND == 0) { const float val = bres + v; if (out) out[(size_t)grow * DM + gcol] = val; if (outb) outb[(size_t)grow * DM + gcol] = (bf16_t)f2bf(val);
        float sq = val * val; sq += __shfl_xor(sq, 1); sq += __shfl_xor(sq, 2); sq += __shfl_xor(sq, 4); sq += __shfl_xor(sq, 8);
        if (col == 0) atomicAdd(ss + grow, sq);
    } else { const float rstd = __builtin_amdgcn_rsqf(ss[grow] * (1.0f / DM) + EPS); outb[(size_t)grow * DM + gcol] = (bf16_t)f2bf(v * rstd * scale); }
    __syncthreads();
}

__device__ __forceinline__ void final_norm(const Args& A, int G, int row_lo) {
    const int lane = threadIdx.x & 63, gw = blockIdx.x * 8 + (threadIdx.x >> 6), NGW = G * 8;
    const float* ss = (const float*)(A.ws + WS_SS3); const f32x4* gr = (const f32x4*)A.in[22] + lane;
    f32x4 gg[4];
#pragma unroll
    for (int j = 0; j < 4; ++j) gg[j] = gr[64 * j];
    for (int m0 = row_lo + gw * 4; m0 < NVALID; m0 += NGW * 4) {
        f32x4 v[4][4]; float sv[4];
#pragma unroll
        for (int r = 0; r < 4; ++r) { sv[r] = ss[m0 + r]; const f32x4* xr = (const f32x4*)(A.out + (size_t)(m0 + r) * DM) + lane;
#pragma unroll
            for (int j = 0; j < 4; ++j) v[r][j] = xr[64 * j]; }
#pragma unroll
        for (int r = 0; r < 4; ++r) { const float rstd = 1.0f / sqrtf(sv[r] * (1.f / DM) + EPS); f32x4* xr = (f32x4*)(A.out + (size_t)(m0 + r) * DM) + lane;
#pragma unroll
            for (int j = 0; j < 4; ++j) xr[64 * j] = v[r][j] * rstd * gg[j]; } }
}

constexpr int NPHASES = 12;
#ifndef REPMASK
#define REPMASK 0
#endif
#define REPS(k) for (int rep_ = 0; rep_ < 1 + ((REPMASK >> (k)) & 1); ++rep_)
__global__ void __launch_bounds__(NTHREADS, 2) fwd_megakernel(Args args) {
    extern __shared__ __attribute__((aligned(16))) unsigned char lds[];
    cg::grid_group grid = cg::this_grid();
    const int G = gridDim.x, bx = blockIdx.x;
    unsigned char* ws = args.ws;
    PG8_LAS unsigned char* lds3 = (PG8_LAS unsigned char*)lds;
    const int lo = args.ph_lo, hi = args.ph_hi;
#define IN(k) (lo <= (k) && (k) < hi)
#ifndef SPINBLK
#define SPINBLK 0
#endif
#ifdef SPINMASK
    unsigned long long t_prev_ = __builtin_amdgcn_s_memrealtime(), t_acc_ = 0ull;
#define STAMP(k) do { const unsigned long long t_now_ = __builtin_amdgcn_s_memrealtime(); if ((SPINMASK >> (k)) & 1) t_acc_ += t_now_ - t_prev_; t_prev_ = t_now_; } while (0)
#else
#define STAMP(k) do { } while (0)
#endif
#define SEAM(k) do { if (IN(k) && IN((k) + 1)) xcd_barrier(bar); STAMP(k); } while (0)
    if (lo < 0) grid.sync();
    volatile LAS unsigned* MISC = (volatile LAS unsigned*)(lds3 + LDS_BYTES - 64);
    if (threadIdx.x < 16) MISC[threadIdx.x] = 0u;
    __syncthreads();
    XcdBarrier bar = xcd_barrier_post((unsigned*)(ws + WS_BAR), MISC);
    if (IN(0)) REPS(0) { p0_prologue(args, lds, G); }
    SEAM(0);
    if (IN(1)) REPS(1) {
        {   pg8::Gemm g{(const bf16_t*)(ws + WS_H0), (const bf16_t*)(ws + WS_WIN), MT, NIN, DM}; pg8::StaticOrder S; S.init(MT, NIN, G, bx);
            pg8::EpiInProj E{(bf16_t*)(ws + WS_QQ), (bf16_t*)(ws + WS_KK), (bf16_t*)(ws + WS_VV), (bf16_t*)(ws + WS_GG), (unsigned short*)(ws + WS_LF), (unsigned short*)(ws + WS_UU), args.in[9]};
            pg8::gemm_phase<pg8::EpiInProj, pg8::StaticOrder, true, true>(lds3, g, S, E); }
        {   pg8::Gemm g{(const bf16_t*)(ws + WS_MEMH), (const bf16_t*)(ws + WS_WKV), MEMR, 2 * DM, DM}; pg8::StaticOrder S; S.init(MEMR, 2 * DM, G, (bx + G - (650 % G)) % G);
            pg8::EpiMemKV E{args.out + O_MK, args.out + O_MV, (bf16_t*)(ws + WS_KB)};
            pg8::gemm_phase<pg8::EpiMemKV, pg8::StaticOrder, true, true>(lds3, g, S, E); }
        {   pg8::Gemm g{(const bf16_t*)(ws + WS_WKV) + (size_t)DM * DM, (const bf16_t*)(ws + WS_MEMH), DM, MEMR, DM}; pg8::StaticOrder S; S.init(DM, MEMR, G, (bx + 2 * G - ((650 + 64) % G)) % G);
            pg8::EpiBf16Scale E{(bf16_t*)(ws + WS_VT), MEMR, nullptr, 1.0f};
            pg8::gemm_phase<pg8::EpiBf16Scale, pg8::StaticOrder, true, true>(lds3, g, S, E); }
    }
    SEAM(1);
    if (IN(2)) REPS(2) {
        const bool sfirst = ((bx >> 3) & 1) != 0;
#pragma unroll 1
        for (int pass = 0; pass < 2; ++pass) {
            if ((pass == 0) == sfirst) {
                f32x4 sreg[8]; if (bx < 512) hgrn_sample_load(args, bx, sreg);
                for (int u = bx; u < 512; u += G) hgrn_sample_unit(args, lds, u, (u + G < 512) ? u + G : -1, sreg);
            } else {
                u32x2v lf[4]; u32x4 kkr[2], vvr[2]; if (bx < 1024) hgrn_local_load(args, bx, lf, kkr, vvr);
                for (int u = bx; u < 1024; u += G) hgrn_local_unit(args, lds, u, (u + G < 1024) ? u + G : -1, lf, kkr, vvr);
            }
        }
    }
    SEAM(2);
    if (IN(3)) {
        for (int u = bx; u < 32; u += G) pool_sample_unit(args, lds, u);
        const bool scan_first = ((bx >> 3) & 1) != 0;
        if (scan_first) { hgrn_scan(args, G); pool_states(args, G); }
        {   u32x4 mreg[4]; u32x2v ereg[5]; if (bx < 1024) pool_load(args, bx, mreg, ereg);
            for (int u = bx; u < 1024; u += G) pool_unit(args, lds, u, (u + G < 1024) ? u + G : -1, mreg, ereg); }
        if (!scan_first) { hgrn_scan(args, G); pool_states(args, G); }
    }
    SEAM(3);
    if (IN(4)) REPS(4) {
        {   u32x2v lf[4]; u32x4 qqr[2], kkr[2], vvr[2], spr[4]; if (bx < 1024) hgrn_out_load(args, bx, lf, qqr, kkr, vvr, spr);
            for (int u = bx; u < 1024; u += G) hgrn_out_unit(args, lds, u, (u + G < 1024) ? u + G : -1, lf, qqr, kkr, vvr, spr); }
        STAMP(12);
        STAMP(13);
        for (int u = bx; u < 256; u += G) sample_gemm<0, 4>(lds, (const bf16_t*)(ws + WS_MIX) + (size_t)NPR * DM, DM, (const bf16_t*)(ws + WS_WOUT), DM, u, args.in[1], nullptr, nullptr, (bf16_t*)(ws + WS_H0) + (size_t)NPR * DM, (float*)(ws + WS_SS1) + NPR, 1.0f);
    }
    SEAM(4);
    if (IN(5)) REPS(5) {
        pg8::Gemm g{(const bf16_t*)(ws + WS_MIX), (const bf16_t*)(ws + WS_WOUT), NPR, DM, DM}; pg8::StaticOrder S; S.init(NPR, DM, G, bx);
        pg8::EpiResid E{args.in[0], nullptr, nullptr, (bf16_t*)(ws + WS_H0), (float*)(ws + (rep_ ? WS_SSD : WS_SS1))};
        pg8::gemm_phase<pg8::EpiResid, pg8::StaticOrder, true, true>(lds3, g, S, E);
        for (int u = bx; u < 256; u += G) sample_gemm<1, 4>(lds, (const bf16_t*)(ws + WS_H0) + (size_t)NPR * DM, DM, (const bf16_t*)(ws + WS_WCQ), DM, u, nullptr, nullptr, nullptr, (bf16_t*)(ws + WS_Q) + (size_t)NPR * DM, (float*)(ws + WS_SS1) + NPR, 0.0625f * 1.4426950408889634f);
    }
    SEAM(5);
    const bool stream_first = ((bx >> 3) & 1) != 0;
    if (IN(7) && stream_first) for (int u = bx; u < 256; u += G) attn_sample_pair(args, lds, u);
    if (IN(6)) {
        pg8::Gemm g{(const bf16_t*)(ws + WS_H0), (const bf16_t*)(ws + WS_WCQ), NPR, DM, DM}; pg8::StaticOrder S; S.init(NPR, DM, G, bx);
        pg8::EpiBf16Scale E{(bf16_t*)(ws + WS_Q), DM, (const float*)(ws + WS_SS1), 0.0625f * 1.4426950408889634f};
        pg8::gemm_phase<pg8::EpiBf16Scale, pg8::StaticOrder, true, true>(lds3, g, S, E);
        STAMP(16);
    }
    int au0 = bx, au1 = 512, austep = G;
    if (G == 256) {
        asm volatile("s_waitcnt vmcnt(0)" ::: "memory"); __syncthreads();
        const int wg_ = (bx & 7) * 32 + (bx >> 3), pm_ = (wg_ >> 5) * 8 + ((wg_ & 31) & 7), pn_ = (wg_ & 31) >> 3;
        au0 = ((pm_ >> 3) * 4 + pn_) * 16 + (pm_ & 7) * 2; au1 = au0 + 2; austep = 1;
    } else { SEAM(6); }
    if (IN(7)) {
        for (int u = au0; u < au1; u += austep) attn_prompt_unit(args, lds, u);
        STAMP(17);
        if (!stream_first) for (int u = bx; u < 256; u += G) attn_sample_pair(args, lds, u);
    }
    SEAM(7);
    if (IN(8)) REPS(8) {
        pg8::Gemm g{(const bf16_t*)(ws + WS_O), (const bf16_t*)(ws + WS_WCO), NPR, DM, DM}; pg8::StaticOrder S; S.init(NPR, DM, G, bx);
        pg8::EpiResid E{nullptr, (const bf16_t*)(ws + WS_H0), nullptr, (bf16_t*)(ws + WS_MIX), (float*)(ws + (rep_ ? WS_SSD : WS_SS2))};
        pg8::gemm_phase<pg8::EpiResid, pg8::StaticOrder, true, true>(lds3, g, S, E);
        for (int u = bx; u < 256; u += G) sample_gemm<0, 4>(lds, (const bf16_t*)(ws + WS_O) + (size_t)NPR * DM, DM, (const bf16_t*)(ws + WS_WCO), DM, u, nullptr, (const bf16_t*)(ws + WS_H0) + (size_t)NPR * DM, nullptr, (bf16_t*)(ws + WS_MIX) + (size_t)NPR * DM, (float*)(ws + (rep_ ? WS_SSD : WS_SS2)) + NPR, 1.0f);
    }
    SEAM(8);
    if (IN(9)) REPS(9) {
        pg8::Gemm g{(const bf16_t*)(ws + WS_MIX), (const bf16_t*)(ws + WS_WFFI), MT, NFF2, DM}; pg8::StaticOrder S; S.init(MT, NFF2, G, bx);
        pg8::EpiSwiGLU E{(bf16_t*)(ws + WS_A), (const float*)(ws + WS_SS2)};
        pg8::gemm_phase<pg8::EpiSwiGLU, pg8::StaticOrder, true, true>(lds3, g, S, E);
    }
    SEAM(9);
    if (IN(10)) {
        pg8::Gemm g{(const bf16_t*)(ws + WS_A), (const bf16_t*)(ws + WS_WFFO), NPR, DM, DFF}; pg8::StaticOrder S; S.init(NPR, DM, G, bx);
        if (G == 256) {
            pg8::EpiResidNorm E{(const bf16_t*)(ws + WS_MIX), args.out, (float*)(ws + WS_SS3), (unsigned*)(ws + WS_CNT), args.in[22]};
            pg8::gemm_phase<pg8::EpiResidNorm, pg8::StaticOrder, false, true>(lds3, g, S, E);
        } else {
            pg8::EpiResid E{nullptr, (const bf16_t*)(ws + WS_MIX), args.out, nullptr, (float*)(ws + WS_SS3)};
            pg8::gemm_phase<pg8::EpiResid, pg8::StaticOrder, true, true>(lds3, g, S, E);
        }
        for (int u = bx; u < 256; u += G) sample_gemm<0, 11>(lds, (const bf16_t*)(ws + WS_A) + (size_t)NPR * DFF, DFF, (const bf16_t*)(ws + WS_WFFO), DFF, u, nullptr, (const bf16_t*)(ws + WS_MIX) + (size_t)NPR * DM, args.out + O_YS, nullptr, (float*)(ws + WS_SS3) + NPR, 1.0f);
    }
    SEAM(10);
#ifdef EXTRA_SYNCS
    for (int i_ = 0; i_ < EXTRA_SYNCS; ++i_) xcd_barrier(bar);
#endif
    if (IN(11)) { final_norm(args, G, G == 256 ? NPR : 0); }
#ifdef SPINMASK
    STAMP(11);
    if (bx == SPINBLK && threadIdx.x == 0) { const unsigned long long t0_ = __builtin_amdgcn_s_memrealtime(); while (__builtin_amdgcn_s_memrealtime() - t0_ < t_acc_) __builtin_amdgcn_s_sleep(8); }
#endif
#undef IN
#undef SEAM
}

#ifndef MK_MULTI
#define MK_MULTI 0
#endif
extern "C" void kernel_launch(void* const* d_in, const int* in_sizes, int n_in, void* d_out, int out_size, void* d_ws, size_t ws_size, hipStream_t stream) {
    static int grid = 0;
    if (grid == 0) {
        if (n_in != 23 || ws_size < WS_END) { fprintf(stderr, "kernel_launch: unexpected n_in %d / ws_size %zu\n", n_in, ws_size); grid = -1; return; }
        int dev = 0, cus = 0, per_cu = 0;
        hipGetDevice(&dev); hipDeviceGetAttribute(&cus, hipDeviceAttributeMultiprocessorCount, dev);
        if (hipFuncSetAttribute((const void*)fwd_megakernel, hipFuncAttributeMaxDynamicSharedMemorySize, LDS_BYTES) != hipSuccess) { fprintf(stderr, "kernel_launch: hipFuncSetAttribute failed\n"); grid = -1; return; }
        hipOccupancyMaxActiveBlocksPerMultiprocessor(&per_cu, (const void*)fwd_megakernel, NTHREADS, LDS_BYTES);
        (void)hipGetLastError();
        if (per_cu < 1) { fprintf(stderr, "kernel_launch: occupancy query says %d blocks/CU\n", per_cu); per_cu = 1; }
        grid = cus;
    }
    if (grid < 0) return;
    Args a{};
    for (int i = 0; i < 23; ++i) a.in[i] = (const float*)d_in[i];
    a.out = (float*)d_out; a.ws = (unsigned char*)d_ws;
#if MK_MULTI
    for (int p = 0; p < NPHASES; ++p) { a.ph_lo = p; a.ph_hi = p + 1; hipLaunchKernelGGL(fwd_megakernel, dim3(grid), dim3(NTHREADS), LDS_BYTES, stream, a); }
#else
    a.ph_lo = 0; a.ph_hi = NPHASES;
    if (hipMemsetAsync((char*)d_ws + WS_BAR, 0, BAR_BYTES, stream) != hipSuccess) { fprintf(stderr, "kernel_launch: memset failed\n"); return; }
    void* kargs[] = {&a};
    hipError_t e = hipLaunchCooperativeKernel((const void*)fwd_megakernel, dim3(grid), dim3(NTHREADS), kargs, LDS_BYTES, stream);
    if (e != hipSuccess) fprintf(stderr, "kernel_launch: cooperative launch failed: %s (grid %d)\n", hipGetErrorString(e), grid);
#endif
}
```

```cpp
#include <hip/hip_runtime.h>
#include <hip/hip_cooperative_groups.h>
#include <cstdio>
#include <cstdint>
namespace cg = cooperative_groups;
namespace pg8 {
#define PG8_LAS __attribute__((address_space(3)))
typedef unsigned short bf16_t;
typedef short bf16x8 __attribute__((ext_vector_type(8)));
typedef float f32x4 __attribute__((ext_vector_type(4)));
typedef unsigned u32x4 __attribute__((ext_vector_type(4)));
constexpr int BM = 256, BK = 64, HALF = 128, HTB = HALF * BK * 2  , STAGE_BYTES = 8 * HTB, NXCD = 8, WGM = 8;

__host__ __device__ __forceinline__ int lds_byte(int r, int c) { const int st = (r >> 4) * 2 + (c >> 5), rr = r & 15, cc = c & 31, ob = rr * 64 + cc * 2; return st * 1024 + (ob ^ (((ob >> 9) & 1) << 5)); }
__host__ __device__ __forceinline__ void stage_rc(int b, int& R, int& C) { const int st = b / 1024, sb = b % 1024, swz = sb ^ (((sb >> 9) & 1) << 5); R = (st >> 1) * 16 + swz / 64; C = (st & 1) * 32 + (swz % 64) / 2; }
__host__ __device__ __forceinline__ int perm32(int rho) { const int n = rho >> 4, i = rho & 15; return 8 * (i >> 2) + 4 * n + (i & 3); }

struct Unit { int pm, pn; };
struct Gemm { const bf16_t* A; const bf16_t* Bt; int M, N, K; };

struct StaticOrder {
    int nM, nN, nwg, G, c;
    __host__ __device__ void init(int M, int N, int G_, int c_) { nM = M / BM; nN = N / BM; nwg = nM * nN; G = G_; c = c_; }
    __host__ __device__ bool next(int i, Unit& u) const {
        const long L = (long)i * G + c; if (L >= nwg) return false;
        int wgid = (int)L; { const int q = nwg / NXCD, r = nwg % NXCD, xcd = wgid % NXCD, off = wgid / NXCD; wgid = (xcd < r ? xcd * (q + 1) : r * (q + 1) + (xcd - r) * q) + off; }
        const int nig = WGM * nN, gid = wgid / nig, fm = gid * WGM, gsz = (nM - fm) < WGM ? (nM - fm) : WGM;
        u.pm = fm + ((wgid % nig) % gsz); u.pn = (wgid % nig) / gsz; return true;
    }
    __device__ __forceinline__ void a_ready(const Unit&) const {}
    __device__ __forceinline__ void done(const Unit&) const {}
};

__device__ __forceinline__ unsigned cvt_pk_bf16(float lo, float hi) { unsigned r; asm volatile("v_cvt_pk_bf16_f32 %0, %1, %2" : "=v"(r) : "v"(lo), "v"(hi)); return r; }
typedef unsigned u32x2 __attribute__((ext_vector_type(2)));
__device__ __forceinline__ float sigm(float z) { return __builtin_amdgcn_rcpf(1.0f + __expf(-z)); }
constexpr float RMS_EPS = 1e-6f;
#ifndef WT_STORES
#define WT_STORES 0
#endif
__device__ __forceinline__ void st16(void* p, u32x4 v) {
#if WT_STORES
    asm volatile("global_store_dwordx4 %0, %1, off sc1\n\ts_nop 1" :: "v"(p), "v"(v) : "memory");
#else
    *(u32x4*)p = v;
#endif
}
__device__ __forceinline__ void st16f(void* p, f32x4 v) { st16(p, __builtin_bit_cast(u32x4, v)); }
__device__ __forceinline__ void st8(void* p, u32x2 v) {
#if WT_STORES
    asm volatile("global_store_dwordx2 %0, %1, off sc1\n\ts_nop 1" :: "v"(p), "v"(v) : "memory");
#else
    *(u32x2*)p = v;
#endif
}
typedef _Float16 h2_t __attribute__((ext_vector_type(2)));
__device__ __forceinline__ unsigned pk_h2(float a, float b) { h2_t v; v.x = (_Float16)a; v.y = (_Float16)b; return __builtin_bit_cast(unsigned, v); }
__device__ __forceinline__ float h_lo(unsigned u) { return (float)__builtin_bit_cast(h2_t, u).x; }
__device__ __forceinline__ float h_hi(unsigned u) { return (float)__builtin_bit_cast(h2_t, u).y; }

struct EpiInProj {
    static constexpr bool PERM = true, AFTER_DRAIN = false;
    bf16_t *QQ, *KK, *VV, *GG; unsigned short *LF, *UU; const float* lbraw;
    __device__ __forceinline__ void operator()(const f32x4 (&acc)[2][2][4][2], const Unit& u, int wr, int wc, int fr, int fq) const {
        const int seg = u.pn >> 1, colt = (u.pn & 1) * 256;
        const int row0 = u.pm * BM + wr * 64 + fr;
#pragma unroll
        for (int bj = 0; bj < 2; ++bj) {
            const int cs = colt + bj * HALF + wc * 32 + 8 * fq;
            float lb[8];
            if (seg == 1) {
#pragma unroll
                for (int j = 0; j < 8; ++j) { const float l0 = lbraw[cs + j], l1 = lbraw[512 + cs + j]; lb[j] = __builtin_amdgcn_rcpf(1.0f + __expf(l1 - l0)); }
            } else {
#pragma unroll
                for (int j = 0; j < 8; ++j) lb[j] = 0.f;
            }
#pragma unroll
            for (int ai = 0; ai < 2; ++ai)
#pragma unroll
                for (int m = 0; m < 4; ++m) {
                    const size_t off = (size_t)(row0 + ai * HALF + m * 16) * 512 + cs;
                    const f32x4 v0 = acc[ai][bj][m][0], v1 = acc[ai][bj][m][1];
                    float z[8] = {v0[0], v0[1], v0[2], v0[3], v1[0], v1[1], v1[2], v1[3]};
                    if (seg == 0) {
#pragma unroll
                        for (int j = 0; j < 8; ++j) z[j] = z[j] * sigm(z[j]);
                        u32x4 w; w.x = cvt_pk_bf16(z[0], z[1]); w.y = cvt_pk_bf16(z[2], z[3]); w.z = cvt_pk_bf16(z[4], z[5]); w.w = cvt_pk_bf16(z[6], z[7]);
                        st16(QQ + off, w);
                    } else if (seg == 1) {
                        float lf[8], kk[8];
#pragma unroll
                        for (int j = 0; j < 8; ++j) { const float e = __expf(-z[j]); const float sg = __builtin_amdgcn_rcpf(1.0f + e); const float sgn = e * sg;
                            lf[j] = __logf(lb[j] + (1.0f - lb[j]) * sg); kk[j] = (1.0f - lb[j]) * sgn; }
                        { u32x4 w; w.x = pk_h2(lf[0], lf[1]); w.y = pk_h2(lf[2], lf[3]); w.z = pk_h2(lf[4], lf[5]); w.w = pk_h2(lf[6], lf[7]); st16(LF + off, w); }
                        u32x4 w; w.x = cvt_pk_bf16(kk[0], kk[1]); w.y = cvt_pk_bf16(kk[2], kk[3]); w.z = cvt_pk_bf16(kk[4], kk[5]); w.w = cvt_pk_bf16(kk[6], kk[7]);
                        st16(KK + off, w);
                    } else if (seg == 2) {
                        u32x4 w; w.x = cvt_pk_bf16(z[0], z[1]); w.y = cvt_pk_bf16(z[2], z[3]); w.z = cvt_pk_bf16(z[4], z[5]); w.w = cvt_pk_bf16(z[6], z[7]);
                        st16(VV + off, w);
                    } else if (seg == 3) {
#pragma unroll
                        for (int j = 0; j < 8; ++j) z[j] = sigm(z[j]);
                        u32x4 w; w.x = cvt_pk_bf16(z[0], z[1]); w.y = cvt_pk_bf16(z[2], z[3]); w.z = cvt_pk_bf16(z[4], z[5]); w.w = cvt_pk_bf16(z[6], z[7]);
                        st16(GG + off, w);
                    } else {
                        u32x4 w; w.x = pk_h2(z[0], z[1]); w.y = pk_h2(z[2], z[3]); w.z = pk_h2(z[4], z[5]); w.w = pk_h2(z[6], z[7]); st16(UU + off, w);
                    }
                }
        }
    }
};

struct EpiMemKV {
    static constexpr bool PERM = true, AFTER_DRAIN = false;
    float *outK, *outV; bf16_t* KB;
    __device__ __forceinline__ void operator()(const f32x4 (&acc)[2][2][4][2], const Unit& u, int wr, int wc, int fr, int fq) const {
        const bool isk = u.pn < 4; float* o = isk ? outK : outV; const int colt = (u.pn & 3) * 256;
        const int row0 = u.pm * BM + wr * 64 + fr;
#pragma unroll
        for (int ai = 0; ai < 2; ++ai)
#pragma unroll
            for (int m = 0; m < 4; ++m)
#pragma unroll
                for (int bj = 0; bj < 2; ++bj) {
                    const size_t off = (size_t)(row0 + ai * HALF + m * 16) * 1024 + colt + bj * HALF + wc * 32 + 8 * fq;
                    const f32x4 v0 = acc[ai][bj][m][0], v1 = acc[ai][bj][m][1];
                    *(f32x4*)(o + off) = v0; *(f32x4*)(o + off + 4) = v1;
                    if (isk) { u32x4 w; w.x = cvt_pk_bf16(v0[0], v0[1]); w.y = cvt_pk_bf16(v0[2], v0[3]); w.z = cvt_pk_bf16(v1[0], v1[1]); w.w = cvt_pk_bf16(v1[2], v1[3]); *(u32x4*)(KB + off) = w; }
                }
    }
};

struct EpiBf16Scale {
    static constexpr bool PERM = true, AFTER_DRAIN = false;
    bf16_t* O; int ldc; const float* ss; float scale;
    __device__ __forceinline__ void operator()(const f32x4 (&acc)[2][2][4][2], const Unit& u, int wr, int wc, int fr, int fq) const {
        const int row0 = u.pm * BM + wr * 64 + fr;
        float ssv[2][4];
#pragma unroll
        for (int ai = 0; ai < 2; ++ai)
#pragma unroll
            for (int m = 0; m < 4; ++m) ssv[ai][m] = ss ? ss[row0 + ai * HALF + m * 16] : 0.f;
#pragma unroll
        for (int ai = 0; ai < 2; ++ai)
#pragma unroll
            for (int m = 0; m < 4; ++m) {
                const int row = row0 + ai * HALF + m * 16;
                const float sc = ss ? scale * __builtin_amdgcn_rsqf(ssv[ai][m] * (1.0f / 1024.0f) + RMS_EPS) : scale;
#pragma unroll
                for (int bj = 0; bj < 2; ++bj) {
                    const size_t off = (size_t)row * ldc + u.pn * BM + bj * HALF + wc * 32 + 8 * fq;
                    const f32x4 v0 = acc[ai][bj][m][0] * sc, v1 = acc[ai][bj][m][1] * sc;
                    u32x4 w; w.x = cvt_pk_bf16(v0[0], v0[1]); w.y = cvt_pk_bf16(v0[2], v0[3]); w.z = cvt_pk_bf16(v1[0], v1[1]); w.w = cvt_pk_bf16(v1[2], v1[3]);
                    st16(O + off, w);
                }
            }
    }
};

struct EpiResid {
    static constexpr bool PERM = true, AFTER_DRAIN = false;
    const float* baseF;
    const bf16_t* baseB;
    float* out;
    bf16_t* outb;
    float* ss;
    __device__ __forceinline__ void operator()(const f32x4 (&acc)[2][2][4][2], const Unit& u, int wr, int wc, int fr, int fq) const {
        const int row0 = u.pm * BM + wr * 64 + fr;
#pragma unroll
        for (int ai = 0; ai < 2; ++ai) {
            f32x4 pre[4][2][2];
            if (baseF) {
#pragma unroll
                for (int m = 0; m < 4; ++m) { const float* bp = baseF + (size_t)(row0 + ai * HALF + m * 16) * 1024;
#pragma unroll
                    for (int bj = 0; bj < 2; ++bj) { const int col = u.pn * BM + bj * HALF + wc * 32 + 8 * fq; pre[m][bj][0] = __builtin_nontemporal_load((const f32x4*)(bp + col)); pre[m][bj][1] = __builtin_nontemporal_load((const f32x4*)(bp + col + 4)); } }
            } else {
                u32x4 pb[4][2];
#pragma unroll
                for (int m = 0; m < 4; ++m) { const bf16_t* bp = baseB + (size_t)(row0 + ai * HALF + m * 16) * 1024;
#pragma unroll
                    for (int bj = 0; bj < 2; ++bj) pb[m][bj] = *(const u32x4*)(bp + u.pn * BM + bj * HALF + wc * 32 + 8 * fq); }
#pragma unroll
                for (int m = 0; m < 4; ++m)
#pragma unroll
                    for (int bj = 0; bj < 2; ++bj) { const u32x4 p = pb[m][bj];
                        pre[m][bj][0] = (f32x4){__uint_as_float(p.x << 16), __uint_as_float(p.x & 0xffff0000u), __uint_as_float(p.y << 16), __uint_as_float(p.y & 0xffff0000u)};
                        pre[m][bj][1] = (f32x4){__uint_as_float(p.z << 16), __uint_as_float(p.z & 0xffff0000u), __uint_as_float(p.w << 16), __uint_as_float(p.w & 0xffff0000u)}; }
            }
#pragma unroll
            for (int m = 0; m < 4; ++m) {
                const int row = row0 + ai * HALF + m * 16;
                float s = 0.f;
#pragma unroll
                for (int bj = 0; bj < 2; ++bj) {
                    const int col = u.pn * BM + bj * HALF + wc * 32 + 8 * fq;
                    const f32x4 v0 = acc[ai][bj][m][0] + pre[m][bj][0], v1 = acc[ai][bj][m][1] + pre[m][bj][1];
                    s += (v0[0] * v0[0] + v0[1] * v0[1]) + (v0[2] * v0[2] + v0[3] * v0[3]) + (v1[0] * v1[0] + v1[1] * v1[1]) + (v1[2] * v1[2] + v1[3] * v1[3]);
                    if (out) { *(f32x4*)(out + (size_t)row * 1024 + col) = v0; *(f32x4*)(out + (size_t)row * 1024 + col + 4) = v1; }
                    if (outb) { u32x4 w; w.x = cvt_pk_bf16(v0[0], v0[1]); w.y = cvt_pk_bf16(v0[2], v0[3]); w.z = cvt_pk_bf16(v1[0], v1[1]); w.w = cvt_pk_bf16(v1[2], v1[3]); st16(outb + (size_t)row * 1024 + col, w); }
                }
                s += __shfl_xor(s, 16); s += __shfl_xor(s, 32);
                if (fq == 0) atomicAdd(ss + row, s);
            }
        }
    }
};

struct EpiResidNorm {
    static constexpr bool PERM = true, AFTER_DRAIN = true;
    const bf16_t* baseB; float* out; float* ss; unsigned* cnt; const float* gfin;
    __device__ __forceinline__ void fused(f32x4 (&acc)[2][2][4][2], const Unit& u, int wr, int wc, int fr, int fq, PG8_LAS unsigned char* lds, int wid, int lane) const {
        const int row0 = u.pm * BM + wr * 64 + fr;
#pragma unroll
        for (int ai = 0; ai < 2; ++ai) {
            u32x4 pb[4][2];
#pragma unroll
            for (int m = 0; m < 4; ++m) { const bf16_t* bp = baseB + (size_t)(row0 + ai * HALF + m * 16) * 1024;
#pragma unroll
                for (int bj = 0; bj < 2; ++bj) pb[m][bj] = *(const u32x4*)(bp + u.pn * BM + bj * HALF + wc * 32 + 8 * fq); }
#pragma unroll
            for (int m = 0; m < 4; ++m) { float s = 0.f;
#pragma unroll
                for (int bj = 0; bj < 2; ++bj) { const u32x4 p = pb[m][bj];
                    const f32x4 v0 = acc[ai][bj][m][0] + (f32x4){__uint_as_float(p.x << 16), __uint_as_float(p.x & 0xffff0000u), __uint_as_float(p.y << 16), __uint_as_float(p.y & 0xffff0000u)};
                    const f32x4 v1 = acc[ai][bj][m][1] + (f32x4){__uint_as_float(p.z << 16), __uint_as_float(p.z & 0xffff0000u), __uint_as_float(p.w << 16), __uint_as_float(p.w & 0xffff0000u)};
                    acc[ai][bj][m][0] = v0; acc[ai][bj][m][1] = v1;
                    s += (v0[0] * v0[0] + v0[1] * v0[1]) + (v0[2] * v0[2] + v0[3] * v0[3]) + (v1[0] * v1[0] + v1[1] * v1[1]) + (v1[2] * v1[2] + v1[3] * v1[3]); }
                s += __shfl_xor(s, 16); s += __shfl_xor(s, 32);
                if (fq == 0) atomicAdd(ss + row0 + ai * HALF + m * 16, s); }
        }
        asm volatile("s_waitcnt vmcnt(0)" ::: "memory");
        __syncthreads();
        if (threadIdx.x == 0) { unsigned* c = cnt + 64 * u.pm;
            __hip_atomic_fetch_add(c, 1u, __ATOMIC_RELEASE, __HIP_MEMORY_SCOPE_AGENT);
            unsigned sp = 0u; while (__hip_atomic_load(c, __ATOMIC_RELAXED, __HIP_MEMORY_SCOPE_AGENT) < 4u) { __builtin_amdgcn_s_sleep(2); if (++sp > (1u << 22)) break; }
            __builtin_amdgcn_fence(__ATOMIC_ACQUIRE, "agent"); }
        __syncthreads();
        float rs[2][4];
#pragma unroll
        for (int ai = 0; ai < 2; ++ai)
#pragma unroll
            for (int m = 0; m < 4; ++m) rs[ai][m] = __hip_atomic_load(ss + row0 + ai * HALF + m * 16, __ATOMIC_RELAXED, __HIP_MEMORY_SCOPE_AGENT);
        f32x4 gv[2][2];
#pragma unroll
        for (int bj = 0; bj < 2; ++bj) { const int col = u.pn * BM + bj * HALF + wc * 32 + 8 * fq; gv[bj][0] = *(const f32x4*)(gfin + col); gv[bj][1] = *(const f32x4*)(gfin + col + 4); }
#pragma unroll
        for (int ai = 0; ai < 2; ++ai)
#pragma unroll
            for (int m = 0; m < 4; ++m) { const int row = row0 + ai * HALF + m * 16; const float rstd = 1.0f / sqrtf(rs[ai][m] * (1.0f / 1024.0f) + RMS_EPS);
#pragma unroll
                for (int bj = 0; bj < 2; ++bj) { const int col = u.pn * BM + bj * HALF + wc * 32 + 8 * fq;
                    *(f32x4*)(out + (size_t)row * 1024 + col) = acc[ai][bj][m][0] * rstd * gv[bj][0]; *(f32x4*)(out + (size_t)row * 1024 + col + 4) = acc[ai][bj][m][1] * rstd * gv[bj][1]; } }
    }
};

struct EpiSwiGLU {
    static constexpr bool PERM = true, AFTER_DRAIN = false;
    bf16_t* ACT; const float* ss;
    __device__ __forceinline__ void operator()(const f32x4 (&acc)[2][2][4][2], const Unit& u, int wr, int wc, int fr, int fq) const {
        const int row0 = u.pm * BM + wr * 64 + fr;
        float ssv[2][4];
#pragma unroll
        for (int ai = 0; ai < 2; ++ai)
#pragma unroll
            for (int m = 0; m < 4; ++m) ssv[ai][m] = ss[row0 + ai * HALF + m * 16];
        const int J = u.pn * 128 + wc * 32 + 8 * fq;
#pragma unroll
        for (int ai = 0; ai < 2; ++ai)
#pragma unroll
            for (int m = 0; m < 4; ++m) {
                const int row = row0 + ai * HALF + m * 16;
                const float r = __builtin_amdgcn_rsqf(ssv[ai][m] * (1.0f / 1024.0f) + RMS_EPS);
                float o[8];
#pragma unroll
                for (int n = 0; n < 2; ++n) { const f32x4 a = acc[ai][0][m][n] * r, b = acc[ai][1][m][n] * r;
#pragma unroll
                    for (int j = 0; j < 4; ++j) o[4 * n + j] = a[j] * sigm(a[j]) * b[j]; }
                u32x4 w; w.x = cvt_pk_bf16(o[0], o[1]); w.y = cvt_pk_bf16(o[2], o[3]); w.z = cvt_pk_bf16(o[4], o[5]); w.w = cvt_pk_bf16(o[6], o[7]);
                st16(ACT + (size_t)row * 2816 + J, w);
            }
    }
};

template <class Epi, class Sched, bool ALIGN_EPI = false, bool SP2 = false>
__device__ __forceinline__ void gemm_phase(PG8_LAS unsigned char* lds, const Gemm g, const Sched& S, const Epi& E) {
    const int tid = threadIdx.x, wid = __builtin_amdgcn_readfirstlane(tid >> 6), lane = tid & 63, wr = wid >> 2, wc = wid & 3, fr = lane & 15, fq = lane >> 4;
    const int K = g.K, nt = K / BK;
    unsigned voffA[2], voffB[2];
#pragma unroll
    for (int i = 0; i < 2; ++i) { int R, C; stage_rc(tid * 16 + i * 8192, R, C); const int Rb = Epi::PERM ? ((R & ~31) + perm32(R & 31)) : R;
        voffA[i] = (unsigned)(R * K + C) * 2u; voffB[i] = (unsigned)(Rb * K + C) * 2u; }
    const size_t kstep = (size_t)(BK * 2);
    const size_t hstep = (size_t)HALF * K * 2;
    const size_t tstep = 2 * hstep;
    const unsigned ldsw = (unsigned)wid * 1024u;
    const int aoff = lds_byte(wr * 64 + fr, fq * 8), boff = lds_byte(wc * 32 + fr, fq * 8);
#define PG8_SA(b, h) (((b) * 2 + (h)) * HTB)
#define PG8_SB(b, h) ((4 + (b) * 2 + (h)) * HTB)
#define PG8_STAGE(bufoff, gbase, voff) do { _Pragma("unroll") for (int _i = 0; _i < 2; ++_i) \
        __builtin_amdgcn_global_load_lds((const unsigned*)((const char*)(gbase) + (voff)[_i]), (PG8_LAS unsigned*)(lds + (bufoff) + ldsw + _i * 8192), 16, 0, 0); } while (0)
#define PG8_LDA(dst, b, h) do { _Pragma("unroll") for (int m = 0; m < 4; ++m) _Pragma("unroll") for (int k = 0; k < 2; ++k) dst[m][k] = *(const PG8_LAS bf16x8*)(lds + PG8_SA(b, h) + aoff + m * 2048 + k * 1024); } while (0)
#define PG8_LDB(dst, b, h) do { _Pragma("unroll") for (int n = 0; n < 2; ++n) _Pragma("unroll") for (int k = 0; k < 2; ++k) dst[n][k] = *(const PG8_LAS bf16x8*)(lds + PG8_SB(b, h) + boff + n * 2048 + k * 1024); } while (0)
#define PG8_MMA(ai, bj, At, Bt) do { __builtin_amdgcn_s_setprio(1); _Pragma("unroll") for (int m = 0; m < 4; ++m) _Pragma("unroll") for (int n = 0; n < 2; ++n) _Pragma("unroll") for (int k = 0; k < 2; ++k) \
        acc[ai][bj][m][n] = __builtin_amdgcn_mfma_f32_16x16x32_bf16(Bt[n][k], At[m][k], acc[ai][bj][m][n], 0, 0, 0); __builtin_amdgcn_s_setprio(0); } while (0)
#define PG8_WAIT_V(n) asm volatile("s_waitcnt vmcnt(" #n ")" ::: "memory")
#define PG8_WAIT_L(n) asm volatile("s_waitcnt lgkmcnt(" #n ")" ::: "memory")
#define PG8_BAR __builtin_amdgcn_s_barrier()
#define PG8_SCHED __builtin_amdgcn_sched_barrier(0)
    Unit cur, nxt; int ui = 0;
    if (!S.next(0, cur)) return;
    f32x4 acc[2][2][4][2];
#pragma unroll
    for (int a = 0; a < 2; ++a)
#pragma unroll
        for (int b = 0; b < 2; ++b)
#pragma unroll
            for (int m = 0; m < 4; ++m)
#pragma unroll
                for (int n = 0; n < 2; ++n) acc[a][b][m][n] = (f32x4){0.f, 0.f, 0.f, 0.f};
    bf16x8 At[4][2], B0[2][2], B1[2][2];
    const char* cA = (const char*)g.A + (size_t)cur.pm * tstep; const char* cB = (const char*)g.Bt + (size_t)cur.pn * tstep;
    S.a_ready(cur);
    if constexpr (SP2) {
        PG8_STAGE(PG8_SB(0, 0), cB, voffB); PG8_STAGE(PG8_SB(0, 1), cB + hstep, voffB); PG8_STAGE(PG8_SA(0, 0), cA, voffA); PG8_STAGE(PG8_SA(0, 1), cA + hstep, voffA);
        if (wr == 1) PG8_BAR;
        PG8_WAIT_V(2); PG8_BAR;
        PG8_STAGE(PG8_SB(1, 0), cB + kstep, voffB); PG8_STAGE(PG8_SA(1, 0), cA + kstep, voffA); PG8_STAGE(PG8_SB(1, 1), cB + hstep + kstep, voffB);
        PG8_WAIT_V(6); PG8_BAR;
    } else {
        PG8_STAGE(PG8_SB(0, 0), cB, voffB); PG8_STAGE(PG8_SA(0, 0), cA, voffA); PG8_STAGE(PG8_SB(0, 1), cB + hstep, voffB); PG8_STAGE(PG8_SA(0, 1), cA + hstep, voffA);
        if (wr == 1) PG8_BAR;
        PG8_WAIT_V(4); PG8_BAR;
        PG8_STAGE(PG8_SB(1, 0), cB + kstep, voffB); PG8_STAGE(PG8_SA(1, 0), cA + kstep, voffA); PG8_STAGE(PG8_SB(1, 1), cB + hstep + kstep, voffB);
        PG8_WAIT_V(6); PG8_BAR;
    }
    for (;;) {
        const bool has_next = S.next(ui + 1, nxt);
        const char* nA = has_next ? (const char*)g.A + (size_t)nxt.pm * tstep : cA; const char* nB = has_next ? (const char*)g.Bt + (size_t)nxt.pn * tstep : cB;
        for (int t = 0; t < nt; t += 2) {
            const bool last = (t == nt - 2);
            const char* a1 = cA + (size_t)(t + 1) * kstep;
            const char* a2 = last ? nA : cA + (size_t)(t + 2) * kstep; const char* b2 = last ? nB : cB + (size_t)(t + 2) * kstep;
            const char* a3 = a2 + kstep; const char* b3 = b2 + kstep;
            if (last && has_next) S.a_ready(nxt);
            if constexpr (SP2) {
            PG8_LDB(B0, 0, 0); PG8_LDB(B1, 0, 1); PG8_SCHED; PG8_LDA(At, 0, 0); PG8_STAGE(PG8_SA(1, 1), a1 + hstep, voffA);
            PG8_WAIT_V(8); PG8_WAIT_L(0); PG8_BAR; PG8_MMA(0, 0, At, B0); PG8_MMA(0, 1, At, B1); PG8_BAR; PG8_SCHED;
            PG8_LDA(At, 0, 1); PG8_STAGE(PG8_SB(0, 0), b2, voffB); PG8_STAGE(PG8_SB(0, 1), b2 + hstep, voffB); PG8_STAGE(PG8_SA(0, 0), a2, voffA);
            PG8_WAIT_V(8); PG8_WAIT_L(0); PG8_BAR; PG8_MMA(1, 0, At, B0); PG8_MMA(1, 1, At, B1); PG8_BAR; PG8_SCHED;
            PG8_LDB(B0, 1, 0); PG8_LDB(B1, 1, 1); PG8_SCHED; PG8_LDA(At, 1, 0); PG8_STAGE(PG8_SA(0, 1), a2 + hstep, voffA);
            PG8_WAIT_V(8); PG8_WAIT_L(0); PG8_BAR; PG8_MMA(0, 0, At, B0); PG8_MMA(0, 1, At, B1); PG8_BAR; PG8_SCHED;
            PG8_LDA(At, 1, 1); PG8_STAGE(PG8_SB(1, 0), b3, voffB); PG8_STAGE(PG8_SB(1, 1), b3 + hstep, voffB); PG8_STAGE(PG8_SA(1, 0), a3, voffA);
            PG8_WAIT_V(8); PG8_WAIT_L(0); PG8_BAR; PG8_MMA(1, 0, At, B0); PG8_MMA(1, 1, At, B1); PG8_BAR; PG8_SCHED;
            } else {
            PG8_LDB(B0, 0, 0); PG8_SCHED; PG8_LDA(At, 0, 0); PG8_STAGE(PG8_SA(1, 1), a1 + hstep, voffA);
            PG8_WAIT_L(8); PG8_BAR; PG8_WAIT_L(0); PG8_MMA(0, 0, At, B0); PG8_BAR; PG8_SCHED;
            PG8_LDB(B1, 0, 1); PG8_STAGE(PG8_SB(0, 0), b2, voffB);
            PG8_BAR; PG8_WAIT_L(0); PG8_MMA(0, 1, At, B1); PG8_BAR;
            PG8_LDA(At, 0, 1); PG8_STAGE(PG8_SA(0, 0), a2, voffA);
            PG8_BAR; PG8_WAIT_L(0); PG8_MMA(1, 0, At, B0); PG8_BAR; PG8_SCHED;
            PG8_STAGE(PG8_SB(0, 1), b2 + hstep, voffB);
            PG8_WAIT_V(6); PG8_BAR; PG8_MMA(1, 1, At, B1); PG8_BAR;
            PG8_LDB(B0, 1, 0); PG8_SCHED; PG8_LDA(At, 1, 0); PG8_STAGE(PG8_SA(0, 1), a2 + hstep, voffA);
            PG8_WAIT_L(8); PG8_BAR; PG8_WAIT_L(0); PG8_MMA(0, 0, At, B0); PG8_BAR; PG8_SCHED;
            PG8_LDB(B1, 1, 1); PG8_STAGE(PG8_SB(1, 0), b3, voffB);
            PG8_BAR; PG8_WAIT_L(0); PG8_MMA(0, 1, At, B1); PG8_BAR;
            PG8_LDA(At, 1, 1); PG8_STAGE(PG8_SA(1, 0), a3, voffA);
            PG8_BAR; PG8_WAIT_L(0); PG8_MMA(1, 0, At, B0); PG8_BAR; PG8_SCHED;
            PG8_STAGE(PG8_SB(1, 1), b3 + hstep, voffB);
            PG8_WAIT_V(6); PG8_BAR; PG8_MMA(1, 1, At, B1); PG8_BAR;
            }
        }
        if constexpr (ALIGN_EPI) { if (wr == 0) PG8_BAR; }
        if constexpr (!Epi::AFTER_DRAIN) { E(acc, cur, wr, wc, fr, fq); S.done(cur); }
        if (!has_next) break;
#pragma unroll
        for (int a = 0; a < 2; ++a)
#pragma unroll
            for (int b = 0; b < 2; ++b)
#pragma unroll
                for (int m = 0; m < 4; ++m)
#pragma unroll
                    for (int n = 0; n < 2; ++n) acc[a][b][m][n] = (f32x4){0.f, 0.f, 0.f, 0.f};
        cur = nxt; cA = nA; cB = nB; ++ui;
        if constexpr (ALIGN_EPI) { if (wr == 1) PG8_BAR; }
    }
    PG8_WAIT_V(0);
    if constexpr (!ALIGN_EPI) { if (wr == 0) PG8_BAR; }
    PG8_BAR;
    if constexpr (Epi::AFTER_DRAIN) { E.fused(acc, cur, wr, wc, fr, fq, lds, wid, lane); S.done(cur); }
#undef PG8_SA
#undef PG8_SB
#undef PG8_STAGE
#undef PG8_LDA
#undef PG8_LDB
#undef PG8_MMA
#undef PG8_WAIT_V
#undef PG8_WAIT_L
#undef PG8_BAR
#undef PG8_SCHED
}
}
#define LAS __attribute__((address_space(3)))
#define XB_TMO      128
#define XB_XCNT(j)  (256  + 64 * (j))
#define XB_XSUB(j)  (1280 + 64 * (j))
#define XB_XGEN(j)  (2304 + 64 * (j))
#define XB_TOP      3328
#define XB_TOPGEN   3392
#define XCD_BAR_WORDS 3456
#define XB_SPIN_CAP (1u << 18)

__device__ __forceinline__ unsigned xb_ld(unsigned* p)              { return __hip_atomic_load(p, __ATOMIC_RELAXED, __HIP_MEMORY_SCOPE_AGENT); }
__device__ __forceinline__ unsigned xb_add(unsigned* p, unsigned v) { return __hip_atomic_fetch_add(p, v, __ATOMIC_RELAXED, __HIP_MEMORY_SCOPE_AGENT); }
__device__ __forceinline__ unsigned xb_xcc_id() { return (unsigned)__builtin_amdgcn_s_getreg((3 << 11) | 20) & 0xFu; }
#define XB_SPIN(cond, bar) do { unsigned _sp = 0; while (cond) { __builtin_amdgcn_s_sleep(1); \
    if ((++_sp & 255u) == 0u) { if (xb_ld(&(bar)[XB_TMO])) break; if (_sp > XB_SPIN_CAP) { atomicAdd(&(bar)[XB_TMO], 1u); break; } } } } while (0)

struct XcdBarrier {
    unsigned* bar; unsigned x;
    volatile LAS unsigned* st;
};

__device__ __forceinline__ XcdBarrier xcd_barrier_post(unsigned* bar, volatile LAS unsigned* st) {
    XcdBarrier b; b.bar = bar; b.x = xb_xcc_id(); b.st = st;
    if (threadIdx.x == 0) (void)xb_add(&bar[XB_XCNT(b.x)], 1u);
    return b;
}
__device__ __forceinline__ void xcd_barrier_complete(unsigned* bar, unsigned x, unsigned& nloc, unsigned& nx) {
    const unsigned G = gridDim.x * gridDim.y * gridDim.z;
    unsigned sum, cnt, mine, sp = 0u;
    for (;;) {
        sum = 0u; cnt = 0u; mine = 0u;
#pragma unroll
        for (unsigned j = 0; j < 16; ++j) { const unsigned c = xb_ld(&bar[XB_XCNT(j)]); sum += c; cnt += (c > 0u) ? 1u : 0u; mine = (j == x) ? c : mine; }
        if (sum == G) break;
        __builtin_amdgcn_s_sleep(1);
        if ((++sp & 255u) == 0u) { if (xb_ld(&bar[XB_TMO])) break; if (sp > XB_SPIN_CAP) { atomicAdd(&bar[XB_TMO], 1u); break; } }
    }
    nloc = mine > 0u ? mine : 1u; nx = cnt > 0u ? cnt : 1u;
}

__device__ __forceinline__ void xcd_barrier(const XcdBarrier& b) {
    asm volatile("s_waitcnt vmcnt(0)" ::: "memory");
    __syncthreads();
    if (threadIdx.x == 0) {
        unsigned* bar = b.bar;
        __builtin_amdgcn_s_waitcnt(0);
        unsigned nloc = b.st[0], nx = b.st[1];
        if (nloc == 0u) { xcd_barrier_complete(bar, b.x, nloc, nx); b.st[0] = nloc; b.st[1] = nx; }
        const unsigned old = xb_add(&bar[XB_XSUB(b.x)], 1u);
        const unsigned gen = old / nloc;
        if (old + 1u == (gen + 1u) * nloc) {
            __builtin_amdgcn_fence(__ATOMIC_RELEASE, "agent");
            asm volatile("s_waitcnt vmcnt(0)" ::: "memory");
            const unsigned og = xb_add(&bar[XB_TOP], 1u);
            const unsigned tg = og / nx;
            if (og + 1u == (tg + 1u) * nx) xb_add(&bar[XB_TOPGEN], 1u);
            else XB_SPIN(xb_ld(&bar[XB_TOPGEN]) == tg, bar);
            __builtin_amdgcn_fence(__ATOMIC_ACQUIRE, "agent");
            xb_add(&bar[XB_XGEN(b.x)], 1u);
            asm volatile("s_waitcnt vmcnt(0)" ::: "memory");
        } else {
            XB_SPIN(xb_ld(&bar[XB_XGEN(b.x)]) == gen, bar);
            __builtin_amdgcn_fence(__ATOMIC_ACQUIRE, "agent");
            asm volatile("s_waitcnt vmcnt(0)" ::: "memory");
        }
    }
    __syncthreads();
}

using pg8::bf16_t; using pg8::f32x4; using pg8::u32x4; using pg8::bf16x8; using pg8::pk_h2; using pg8::h_lo; using pg8::h_hi;
typedef unsigned u32x2v __attribute__((ext_vector_type(2)));
constexpr int DM = 1024, NPR = 16384, NSM = 128, MT = 16640, NVALID = 16512, SEQ = 2048;
constexpr int HW = 512, NIN = 2560, DFF = 2816, NFF2 = 5632, MEMR = 2048;
constexpr float EPS = 1e-6f;
constexpr int NTHREADS = 512;
constexpr int LDS_BYTES = 147456;

constexpr size_t O_YP = 0, O_YS = 16777216, O_HP = 16908288, O_PP = 17432576, O_MK = 17494016, O_MV = 19591168, O_HS = 21688320, O_PS = 30076928;

constexpr size_t MiB = 1u << 20;
constexpr size_t WS_SS1 = 0, WS_SS2 = 128 * 1024, WS_SS3 = 256 * 1024, WS_BAR = 512 * 1024, BAR_BYTES = 65536, WS_SSD = 384 * 1024, WS_CNT = WS_BAR + 16384;
constexpr size_t WS_WIN = 1 * MiB, WS_WOUT = 6 * MiB, WS_WCQ = 8 * MiB, WS_WCO = 10 * MiB, WS_WFFI = 12 * MiB, WS_WFFO = 23 * MiB, WS_WKV = 29 * MiB, WS_PMIX = 33 * MiB;
constexpr size_t WS_MEMH = 34 * MiB, WS_KB = 38 * MiB, WS_VT = 42 * MiB, WS_DEC = 46 * MiB;
constexpr size_t WS_H0 = 47 * MiB;
constexpr size_t WS_MIX = 80 * MiB;
constexpr size_t WS_X1 = 113 * MiB;
constexpr size_t WS_Q = 178 * MiB;
constexpr size_t WS_O = 211 * MiB;
constexpr size_t WS_SL = 244 * MiB;
constexpr size_t WS_A = 309 * MiB;
constexpr size_t WS_QQ = WS_A, WS_KK = WS_A + 17 * MiB, WS_VV = WS_A + 34 * MiB, WS_GG = WS_A + 51 * MiB, WS_LF = WS_A + 68 * MiB, WS_UU = WS_A + 101 * MiB;
constexpr size_t WS_END = 443 * MiB;

struct Args { const float* in[23]; float* out; unsigned char* ws; int ph_lo, ph_hi; };

typedef float f32x2_t __attribute__((ext_vector_type(2))); typedef __bf16 bf16x2_t __attribute__((ext_vector_type(2)));
__device__ __forceinline__ unsigned pk2(float lo, float hi) { const f32x2_t v = {lo, hi}; const bf16x2_t b = __builtin_convertvector(v, bf16x2_t); return __builtin_bit_cast(unsigned, b); }
__device__ __forceinline__ unsigned f2bf(float f) { return pk2(f, 0.f) & 0xffffu; }
__device__ __forceinline__ float bf2f(unsigned h) { return __uint_as_float(h << 16); }
__device__ __forceinline__ float bfe(const u32x4& v, int j) { const unsigned w = v[j >> 1]; return (j & 1) ? __uint_as_float(w & 0xffff0000u) : __uint_as_float(w << 16); }
__device__ __forceinline__ unsigned short bfr(const u32x4& v, int j) { const unsigned w = v[j >> 1]; return (unsigned short)((j & 1) ? (w >> 16) : (w & 0xffffu)); }
__device__ __forceinline__ float wave_sum(float v) {
#pragma unroll
    for (int o = 1; o < 64; o <<= 1) v += __shfl_xor(v, o);
    return v;
}
#define MFMA16(a, b, c) __builtin_amdgcn_mfma_f32_16x16x32_bf16((a), (b), (c), 0, 0, 0)

template <int MODE>
__device__ __forceinline__ void tr_item(const float* W, int K, int N, bf16_t* WT, const float* gk, float* scr, int item, int lane) {
    const int nblk = N / 32, kb = item / nblk, nb = item % nblk, k0 = 64 * kb, n0 = 32 * nb;
    f32x4 wv[8];
#pragma unroll
    for (int i = 0; i < 8; ++i) { const int kk = 8 * i + (lane >> 3); wv[i] = __builtin_nontemporal_load((const f32x4*)(W + (size_t)(k0 + kk) * N + n0 + (lane & 7) * 4)); }
#pragma unroll
    for (int i = 0; i < 8; ++i) { const int kk = 8 * i + (lane >> 3); float* d = scr + kk * 33 + (lane & 7) * 4; d[0] = wv[i][0]; d[1] = wv[i][1]; d[2] = wv[i][2]; d[3] = wv[i][3]; }
    asm volatile("s_waitcnt lgkmcnt(0)" ::: "memory");
    const int c = lane & 7;
    float g8[8];
#pragma unroll
    for (int i = 0; i < 8; ++i) g8[i] = gk ? gk[k0 + 8 * c + i] : 1.0f;
#pragma unroll
    for (int j = 0; j < 4; ++j) { const int n = (lane >> 3) + 8 * j; const float* s = scr + (8 * c) * 33 + n;
        u32x4 o; o.x = pk2(s[0 * 33] * g8[0], s[1 * 33] * g8[1]); o.y = pk2(s[2 * 33] * g8[2], s[3 * 33] * g8[3]); o.z = pk2(s[4 * 33] * g8[4], s[5 * 33] * g8[5]); o.w = pk2(s[6 * 33] * g8[6], s[7 * 33] * g8[7]);
        int row = n0 + n;
        if (MODE == 1) { const int half = row >= DFF ? 1 : 0; const int J = row - half * DFF;
            row = 256 * (J >> 7) + 128 * half + (J & 127); }
        *(u32x4*)(WT + (size_t)row * K + k0 + 8 * c) = o; }
    asm volatile("s_waitcnt lgkmcnt(0)" ::: "memory");
}
__device__ __forceinline__ void rms_row_to_bf16(const float* xrow, const float* g, bf16_t* orow, int lane) {
    const f32x4* xr = (const f32x4*)xrow + lane; const f32x4* gr = (const f32x4*)g + lane;
    f32x4 v[4]; float s = 0.f;
#pragma unroll
    for (int j = 0; j < 4; ++j) { v[j] = xr[64 * j]; s += (v[j].x * v[j].x + v[j].y * v[j].y) + (v[j].z * v[j].z + v[j].w * v[j].w); }
    const float rstd = 1.0f / sqrtf(wave_sum(s) * (1.f / DM) + EPS);
    unsigned long long* o8 = (unsigned long long*)orow + lane;
#pragma unroll
    for (int j = 0; j < 4; ++j) { const f32x4 gg = gr[64 * j];
        o8[64 * j] = (unsigned long long)pk2(v[j].x * rstd * gg.x, v[j].y * rstd * gg.y) | ((unsigned long long)pk2(v[j].z * rstd * gg.z, v[j].w * rstd * gg.w) << 32); }
}
__device__ __forceinline__ void rms_row2_to_bf16(const float* xrow, const float* g, bf16_t* orow, int lane) {
    const f32x4* xr = (const f32x4*)xrow + lane; const f32x4* gr = (const f32x4*)g + lane;
    f32x4 v[2][4]; float s[2] = {0.f, 0.f};
#pragma unroll
    for (int r = 0; r < 2; ++r)
#pragma unroll
        for (int j = 0; j < 4; ++j) v[r][j] = __builtin_nontemporal_load(xr + r * 256 + 64 * j);
#pragma unroll
    for (int r = 0; r < 2; ++r)
#pragma unroll
        for (int j = 0; j < 4; ++j) s[r] += (v[r][j].x * v[r][j].x + v[r][j].y * v[r][j].y) + (v[r][j].z * v[r][j].z + v[r][j].w * v[r][j].w);
#pragma unroll
    for (int r = 0; r < 2; ++r) { const float rstd = 1.0f / sqrtf(wave_sum(s[r]) * (1.f / DM) + EPS); unsigned long long* o8 = (unsigned long long*)(orow + (size_t)r * DM) + lane;
#pragma unroll
        for (int j = 0; j < 4; ++j) { const f32x4 gg = gr[64 * j];
            o8[64 * j] = (unsigned long long)pk2(v[r][j].x * rstd * gg.x, v[r][j].y * rstd * gg.y) | ((unsigned long long)pk2(v[r][j].z * rstd * gg.z, v[r][j].w * rstd * gg.w) << 32); } }
}
__device__ __forceinline__ void p0_prologue(const Args& A, unsigned char* lds, int G) {
    const int tid = threadIdx.x, lane = tid & 63, wave = tid >> 6;
    float* scr = (float*)(lds + wave * 16384);
    unsigned char* ws = A.ws;
    const int gw = blockIdx.x * 8 + wave, NGW = G * 8;
    constexpr int I_IN = 16 * 80, I_OUT = 16 * 32, I_CQ = 16 * 32, I_CO = 16 * 32, I_FFI = 16 * 176, I_FFO = 44 * 32, I_KV = 16 * 64, I_PM = 4 * 8;
    constexpr int NITEMS = I_IN + I_OUT + I_CQ + I_CO + I_FFI + I_FFO + I_KV + I_PM;
    for (int it = gw; it < NITEMS; it += NGW) {
        int r = it;
        if (r < I_IN) { tr_item<0>(A.in[8], DM, NIN, (bf16_t*)(ws + WS_WIN), nullptr, scr, r, lane); continue; } r -= I_IN;
        if (r < I_OUT) { tr_item<0>(A.in[13], DM, DM, (bf16_t*)(ws + WS_WOUT), nullptr, scr, r, lane); continue; } r -= I_OUT;
        if (r < I_CQ) { tr_item<0>(A.in[17], DM, DM, (bf16_t*)(ws + WS_WCQ), A.in[16], scr, r, lane); continue; } r -= I_CQ;
        if (r < I_CO) { tr_item<0>(A.in[18], DM, DM, (bf16_t*)(ws + WS_WCO), nullptr, scr, r, lane); continue; } r -= I_CO;
        if (r < I_FFI) { tr_item<1>(A.in[20], DM, NFF2, (bf16_t*)(ws + WS_WFFI), A.in[19], scr, r, lane); continue; } r -= I_FFI;
        if (r < I_FFO) { tr_item<0>(A.in[21], DFF, DM, (bf16_t*)(ws + WS_WFFO), nullptr, scr, r, lane); continue; } r -= I_FFO;
        if (r < I_KV) { tr_item<0>(A.in[15], DM, 2 * DM, (bf16_t*)(ws + WS_WKV), nullptr, scr, r, lane); continue; } r -= I_KV;
        { const int g = r >> 3; tr_item<0>(A.in[11] + (size_t)g * 128 * 128, 128, 128, (bf16_t*)(ws + WS_PMIX) + (size_t)g * 128 * 128, nullptr, scr, r & 7, lane); }
    }
    bf16_t* H0 = (bf16_t*)(ws + WS_H0);
    for (int m = gw * 2; m < NVALID; m += NGW * 2) { const float* xr = m < NPR ? A.in[0] + (size_t)m * DM : A.in[1] + (size_t)(m - NPR) * DM; rms_row2_to_bf16(xr, A.in[7], H0 + (size_t)m * DM, lane); }
    bf16_t* MEMH = (bf16_t*)(ws + WS_MEMH);
    for (int m = gw; m < MEMR; m += NGW) rms_row_to_bf16(A.in[2] + (size_t)m * DM, A.in[14], MEMH + (size_t)m * DM, lane);
    const int gt = blockIdx.x * NTHREADS + tid, NGT = G * NTHREADS;
    for (int i = gt; i < (MT - NVALID) * DM / 8; i += NGT) { const u32x4 z = {0u, 0u, 0u, 0u};
        ((u32x4*)(ws + WS_H0) + (size_t)NVALID * DM / 8)[i] = z; ((u32x4*)(ws + WS_MIX) + (size_t)NVALID * DM / 8)[i] = z; ((u32x4*)(ws + WS_O) + (size_t)NVALID * DM / 8)[i] = z; }
    for (int i = gt; i < MT; i += NGT) { ((float*)(ws + WS_SS1))[i] = 0.f; ((float*)(ws + WS_SS2))[i] = 0.f; ((float*)(ws + WS_SS3))[i] = 0.f; }
}

constexpr int BS = 129;
constexpr int L_BC = 0, L_TOT = 33024, L_QM = 35072, L_KM = 52480, L_VT = 69888, L_SP = 88320, L_AL = 123136, L_PART = 132352, L_EM = 132864;
constexpr size_t WS_SPT = WS_X1;
__device__ __forceinline__ void hgrn_lf_load(u32x2v (&lf)[4], const unsigned short* LF, int R0, int C0, int t) {
#pragma unroll
    for (int i = 0; i < 4; ++i) { const int idx = i * 512 + t, s = idx >> 5, k4 = idx & 31; lf[i] = *(const u32x2v*)(LF + (size_t)(R0 + s) * HW + C0 + k4 * 4); }
}
__device__ __forceinline__ void hgrn_cumsum(const u32x2v (&lf)[4], float* Bc, float* tot, int t) {
#pragma unroll
    for (int i = 0; i < 4; ++i) { const int idx = i * 512 + t, s = idx >> 5, k4 = idx & 31; const u32x2v v = lf[i];
        float* d = Bc + s * BS + k4 * 4; d[0] = h_lo(v.x); d[1] = h_hi(v.x); d[2] = h_lo(v.y); d[3] = h_hi(v.y); }
    __syncthreads();
    const int seg = t >> 7, k = t & 127; float run = 0.f;
#pragma unroll
    for (int i = 0; i < 16; ++i) { run += Bc[(seg * 16 + i) * BS + k]; Bc[(seg * 16 + i) * BS + k] = run; }
    tot[seg * 128 + k] = run;
    __syncthreads();
    float off = 0.f;
#pragma unroll
    for (int j = 0; j < 3; ++j) off += (j < seg) ? tot[j * 128 + k] : 0.f;
#pragma unroll
    for (int i = 0; i < 16; ++i) Bc[(seg * 16 + i) * BS + k] += off;
    __syncthreads();
}
__device__ __forceinline__ void hgrn_local_load(const Args& A, int unit, u32x2v (&lf)[4], u32x4 (&kkr)[2], u32x4 (&vvr)[2]) {
    const int t = threadIdx.x, w = t >> 6, l = t & 63;
    const int bh = unit >> 5, c = unit & 31, b = bh >> 2, h = bh & 3, R0 = b * SEQ + c * 64, C0 = h * 128;
    const bf16_t* KK = (const bf16_t*)(A.ws + WS_KK); const bf16_t* VV = (const bf16_t*)(A.ws + WS_VV);
    hgrn_lf_load(lf, (const unsigned short*)(A.ws + WS_LF), R0, C0, t);
#pragma unroll
    for (int i = 0; i < 2; ++i) { const int k0 = (w + 8 * i) * 8; kkr[i] = *(const u32x4*)(KK + (size_t)(R0 + l) * HW + C0 + k0); vvr[i] = *(const u32x4*)(VV + (size_t)(R0 + l) * HW + C0 + k0); }
}
__device__ __forceinline__ void hgrn_local_unit(const Args& A, unsigned char* lds, int unit, int next, u32x2v (&lf)[4], u32x4 (&kkr)[2], u32x4 (&vvr)[2]) {
    const int t = threadIdx.x, w = t >> 6, l = t & 63, lr = l & 15, lq = l >> 4;
    const int bh = unit >> 5, c = unit & 31, b = bh >> 2, h = bh & 3, R0 = b * SEQ + c * 64, C0 = h * 128;
    unsigned char* ws = A.ws;
    float* Bc = (float*)(lds + L_BC); float* tot = (float*)(lds + L_TOT);
    bf16_t* kdT = (bf16_t*)(lds + L_QM); bf16_t* vT = (bf16_t*)(lds + L_VT);
    hgrn_cumsum(lf, Bc, tot, t);
#pragma unroll
    for (int i = 0; i < 2; ++i) { const int s = l, k0 = (w + 8 * i) * 8;
        const u32x4 kk = kkr[i], vv = vvr[i];
#pragma unroll
        for (int j = 0; j < 8; ++j) { const float e = __expf(Bc[63 * BS + k0 + j] - Bc[s * BS + k0 + j]);
            kdT[(k0 + j) * 72 + s] = (bf16_t)f2bf(bfe(kk, j) * e); vT[(k0 + j) * 72 + s] = bfr(vv, j); } }
    if (next >= 0) hgrn_local_load(A, next, lf, kkr, vvr);
    __syncthreads();
    f32x4 acc[8];
#pragma unroll
    for (int i = 0; i < 8; ++i) acc[i] = (f32x4){0.f, 0.f, 0.f, 0.f};
#pragma unroll
    for (int ks = 0; ks < 2; ++ks) { const bf16x8 a = *(const bf16x8*)(kdT + (16 * w + lr) * 72 + ks * 32 + lq * 8);
#pragma unroll
        for (int vt = 0; vt < 8; ++vt) { const bf16x8 bb = *(const bf16x8*)(vT + (16 * vt + lr) * 72 + ks * 32 + lq * 8); acc[vt] = MFMA16(a, bb, acc[vt]); } }
    unsigned short* SLT = (unsigned short*)(ws + WS_SL) + (size_t)unit * 16384;
#pragma unroll
    for (int vt = 0; vt < 8; ++vt) { u32x2v o; o.x = pk_h2(acc[vt][0], acc[vt][1]); o.y = pk_h2(acc[vt][2], acc[vt][3]); *(u32x2v*)(SLT + (16 * vt + lr) * 128 + 16 * w + lq * 4) = o; }
    if (t < 128) ((float*)(ws + WS_DEC))[unit * 128 + t] = __expf(Bc[63 * BS + t]);
    __syncthreads();
}
__device__ __forceinline__ void hgrn_out_load(const Args& A, int unit, u32x2v (&lf)[4], u32x4 (&qqr)[2], u32x4 (&kkr)[2], u32x4 (&vvr)[2], u32x4 (&spr)[4]) {
    const int t = threadIdx.x, w = t >> 6, l = t & 63;
    const int bh = unit >> 5, c = unit & 31, b = bh >> 2, h = bh & 3, R0 = b * SEQ + c * 64, C0 = h * 128;
    const bf16_t* QQ = (const bf16_t*)(A.ws + WS_QQ); const bf16_t* KK = (const bf16_t*)(A.ws + WS_KK); const bf16_t* VV = (const bf16_t*)(A.ws + WS_VV);
    hgrn_lf_load(lf, (const unsigned short*)(A.ws + WS_LF), R0, C0, t);
#pragma unroll
    for (int i = 0; i < 2; ++i) { const int idx = (i * 512 + t) * 8, s = idx >> 7, k0 = idx & 127; const size_t go = (size_t)(R0 + s) * HW + C0 + k0; qqr[i] = *(const u32x4*)(QQ + go); kkr[i] = *(const u32x4*)(KK + go);
        vvr[i] = *(const u32x4*)(VV + (size_t)(R0 + l) * HW + C0 + (w + 8 * i) * 8); }
    const bf16_t* SPT = (const bf16_t*)(A.ws + WS_SPT) + (size_t)unit * 16384;
#pragma unroll
    for (int i = 0; i < 4; ++i) { const int idx = i * 512 + t; spr[i] = *(const u32x4*)(SPT + (idx >> 4) * 128 + (idx & 15) * 8); }
}
__device__ __forceinline__ void hgrn_out_unit(const Args& A, unsigned char* lds, int unit, int next, u32x2v (&lf)[4], u32x4 (&qqr)[2], u32x4 (&kkr)[2], u32x4 (&vvr)[2], u32x4 (&spr)[4]) {
    const int t = threadIdx.x, w = t >> 6, l = t & 63, lr = l & 15, lq = l >> 4;
    const int bh = unit >> 5, c = unit & 31, b = bh >> 2, h = bh & 3, R0 = b * SEQ + c * 64, C0 = h * 128;
    unsigned char* ws = A.ws;
    float* Bc = (float*)(lds + L_BC); float* tot = (float*)(lds + L_TOT); float* part = (float*)(lds + L_PART); float* em = (float*)(lds + L_EM);
    bf16_t* qm = (bf16_t*)(lds + L_QM); bf16_t* km = (bf16_t*)(lds + L_KM); bf16_t* vT = (bf16_t*)(lds + L_VT); bf16_t* spT = (bf16_t*)(lds + L_SP); bf16_t* aL = (bf16_t*)(lds + L_AL);
    u32x4 ggr[2];
#pragma unroll
    for (int hh = 0; hh < 2; ++hh) ggr[hh] = *(const u32x4*)((const bf16_t*)(ws + WS_GG) + (size_t)(R0 + (t >> 3)) * HW + C0 + (t & 7) * 16 + hh * 8);
    hgrn_cumsum(lf, Bc, tot, t);
    if (t < 128) em[t] = __expf(Bc[31 * BS + t]);
#pragma unroll
    for (int i = 0; i < 2; ++i) { const int idx = (i * 512 + t) * 8, s = idx >> 7, k0 = idx & 127;
        const u32x4 qq = qqr[i], kk = kkr[i];
        float qv[8], kv[8];
#pragma unroll
        for (int j = 0; j < 8; ++j) { const float d = Bc[s * BS + k0 + j] - Bc[31 * BS + k0 + j]; qv[j] = bfe(qq, j) * __expf(d); kv[j] = bfe(kk, j) * __expf(-d); }
        u32x4 o; o.x = pk2(qv[0], qv[1]); o.y = pk2(qv[2], qv[3]); o.z = pk2(qv[4], qv[5]); o.w = pk2(qv[6], qv[7]); *(u32x4*)(qm + s * 136 + k0) = o;
        o.x = pk2(kv[0], kv[1]); o.y = pk2(kv[2], kv[3]); o.z = pk2(kv[4], kv[5]); o.w = pk2(kv[6], kv[7]); *(u32x4*)(km + s * 136 + k0) = o; }
#pragma unroll
    for (int i = 0; i < 2; ++i) { const int s = l, k0 = (w + 8 * i) * 8; const u32x4 vv = vvr[i];
#pragma unroll
        for (int j = 0; j < 8; ++j) vT[(k0 + j) * 72 + s] = bfr(vv, j); }
    __syncthreads();
    {
#pragma unroll
        for (int i = 0; i < 4; ++i) { const int idx = i * 512 + t, v = idx >> 4, k0 = (idx & 15) * 8; const u32x4 sv = spr[i];
            u32x4 o; o.x = pk2(bfe(sv, 0) * em[k0], bfe(sv, 1) * em[k0 + 1]); o.y = pk2(bfe(sv, 2) * em[k0 + 2], bfe(sv, 3) * em[k0 + 3]); o.z = pk2(bfe(sv, 4) * em[k0 + 4], bfe(sv, 5) * em[k0 + 5]); o.w = pk2(bfe(sv, 6) * em[k0 + 6], bfe(sv, 7) * em[k0 + 7]);
            *(u32x4*)(spT + v * 136 + k0) = o; } }
    if (next >= 0) hgrn_out_load(A, next, lf, qqr, kkr, vvr, spr);
    {
        const int ct = w & 3;
        f32x4 a2[2]; a2[0] = (f32x4){0.f, 0.f, 0.f, 0.f}; a2[1] = a2[0];
#pragma unroll
        for (int ks = 0; ks < 4; ++ks) { const bf16x8 a = *(const bf16x8*)(qm + (16 * ct + lr) * 136 + ks * 32 + lq * 8);
#pragma unroll
            for (int i = 0; i < 2; ++i) { const int st = (w >> 2) * 2 + i; const bf16x8 bb = *(const bf16x8*)(km + (16 * st + lr) * 136 + ks * 32 + lq * 8); a2[i] = MFMA16(a, bb, a2[i]); } }
#pragma unroll
        for (int i = 0; i < 2; ++i) { const int st = (w >> 2) * 2 + i, s = 16 * st + lr;
#pragma unroll
            for (int r = 0; r < 4; ++r) { const int cc = 16 * ct + lq * 4 + r; aL[cc * 72 + s] = (bf16_t)f2bf(s <= cc ? a2[i][r] : 0.f); } }
    }
    __syncthreads();
    const int ct = w & 3, vh = w >> 2;
    f32x4 o4[4];
#pragma unroll
    for (int i = 0; i < 4; ++i) o4[i] = (f32x4){0.f, 0.f, 0.f, 0.f};
#pragma unroll
    for (int ks = 0; ks < 4; ++ks) { const bf16x8 a = *(const bf16x8*)(qm + (16 * ct + lr) * 136 + ks * 32 + lq * 8);
#pragma unroll
        for (int i = 0; i < 4; ++i) { const int vt = vh * 4 + i; const bf16x8 bb = *(const bf16x8*)(spT + (16 * vt + lr) * 136 + ks * 32 + lq * 8); o4[i] = MFMA16(a, bb, o4[i]); } }
#pragma unroll
    for (int ks = 0; ks < 2; ++ks) { const bf16x8 a = *(const bf16x8*)(aL + (16 * ct + lr) * 72 + ks * 32 + lq * 8);
#pragma unroll
        for (int i = 0; i < 4; ++i) { const int vt = vh * 4 + i; const bf16x8 bb = *(const bf16x8*)(vT + (16 * vt + lr) * 72 + ks * 32 + lq * 8); o4[i] = MFMA16(a, bb, o4[i]); } }
    float* ost = (float*)(lds + L_BC);
#pragma unroll
    for (int r = 0; r < 4; ++r) { float s = 0.f;
#pragma unroll
        for (int i = 0; i < 4; ++i) { s += o4[i][r] * o4[i][r]; ost[(16 * ct + lq * 4 + r) * 132 + (vh * 4 + i) * 16 + lr] = o4[i][r]; }
        s += __shfl_xor(s, 1); s += __shfl_xor(s, 2); s += __shfl_xor(s, 4); s += __shfl_xor(s, 8);
        if (lr == 0) part[vh * 64 + 16 * ct + lq * 4 + r] = s; }
    __syncthreads();
    {   const float* hn = A.in[10]; bf16_t* MIX = (bf16_t*)(ws + WS_MIX);
        const int cc = t >> 3, v0 = (t & 7) * 16; const float rstd = __builtin_amdgcn_rsqf((part[cc] + part[64 + cc]) * (1.0f / 128.0f) + EPS);
#pragma unroll
        for (int hh = 0; hh < 2; ++hh) { const int v = v0 + hh * 8; const u32x4 g8 = ggr[hh];
            const f32x4 oa = *(const f32x4*)(ost + cc * 132 + v), ob = *(const f32x4*)(ost + cc * 132 + v + 4), na = *(const f32x4*)(hn + C0 + v), nb = *(const f32x4*)(hn + C0 + v + 4);
            u32x4 o; o.x = pk2(oa[0] * rstd * na[0] * bfe(g8, 0), oa[1] * rstd * na[1] * bfe(g8, 1)); o.y = pk2(oa[2] * rstd * na[2] * bfe(g8, 2), oa[3] * rstd * na[3] * bfe(g8, 3));
            o.z = pk2(ob[0] * rstd * nb[0] * bfe(g8, 4), ob[1] * rstd * nb[1] * bfe(g8, 5)); o.w = pk2(ob[2] * rstd * nb[2] * bfe(g8, 6), ob[3] * rstd * nb[3] * bfe(g8, 7));
            *(u32x4*)(MIX + (size_t)(R0 + cc) * DM + C0 + v) = o; } }
    __syncthreads();
}
__device__ __forceinline__ void hgrn_scan(const Args& A, int G) {
    const u32x2v* SLT = (const u32x2v*)(A.ws + WS_SL); const f32x4* DEC4 = (const f32x4*)(A.ws + WS_DEC); u32x2v* SPT = (u32x2v*)(A.ws + WS_SPT); float* outp = A.out + O_HP;
    for (int e = blockIdx.x * NTHREADS + threadIdx.x; e < 32 * 4096; e += G * NTHREADS) { const int bh = e >> 12, i4 = e & 4095, v = i4 >> 5, k4 = i4 & 31;
        f32x4 S = (f32x4){0.f, 0.f, 0.f, 0.f};
        const u32x2v* p = SLT + (size_t)bh * 32 * 4096 + i4; u32x2v* q = SPT + (size_t)bh * 32 * 4096 + i4; const f32x4* dp = DEC4 + (size_t)bh * 32 * 32 + k4;
#pragma unroll
        for (int hf = 0; hf < 2; ++hf) { u32x2v loc[16]; f32x4 dd[16];
#pragma unroll
            for (int c = 0; c < 16; ++c) { loc[c] = p[(size_t)(hf * 16 + c) * 4096]; dd[c] = dp[(hf * 16 + c) * 32]; }
#pragma unroll
            for (int c = 0; c < 16; ++c) { u32x2v o; o.x = pk2(S[0], S[1]); o.y = pk2(S[2], S[3]); q[(size_t)(hf * 16 + c) * 4096] = o; const f32x4 lv = (f32x4){h_lo(loc[c].x), h_hi(loc[c].x), h_lo(loc[c].y), h_hi(loc[c].y)}; S = S * dd[c] + lv; } }
        float* ob = outp + (size_t)bh * 16384 + (k4 * 4) * 128 + v; ob[0] = S[0]; ob[128] = S[1]; ob[256] = S[2]; ob[384] = S[3]; }
}
__device__ __forceinline__ void pool_states(const Args& A, int G) {
    const unsigned short* UU = (const unsigned short*)(A.ws + WS_UU);
    const int gt = blockIdx.x * NTHREADS + threadIdx.x, NGT = G * NTHREADS;
    for (int i = gt; i < 8 * 15 * 128; i += NGT) { const int c4 = i & 127, j = (i >> 7) % 15, b = i / (15 * 128); const u32x2v v = *(const u32x2v*)(UU + (size_t)(b * SEQ + 2033 + j) * HW + c4 * 4);
        *(f32x4*)(A.out + O_PP + (size_t)i * 4) = (f32x4){h_lo(v.x), h_hi(v.x), h_lo(v.y), h_hi(v.y)}; }
    for (int i0 = gt * 2; i0 < 128 * 15 * 128; i0 += NGT * 2) { f32x4 v[2];
#pragma unroll
        for (int q = 0; q < 2; ++q) { const int i = i0 + q, c4 = i & 127, j = (i >> 7) % 15, b = i / (15 * 128);
            if (j < 14) v[q] = *(const f32x4*)(A.in[4] + (size_t)(b * 15 + j + 1) * 512 + c4 * 4);
            else { const u32x2v h = *(const u32x2v*)(UU + (size_t)(NPR + b) * HW + c4 * 4); v[q] = (f32x4){h_lo(h.x), h_hi(h.x), h_lo(h.y), h_hi(h.y)}; } }
#pragma unroll
        for (int q = 0; q < 2; ++q) *(f32x4*)(A.out + O_PS + (size_t)(i0 + q) * 4) = v[q]; }
}
__device__ __forceinline__ void hgrn_sample_load(const Args& A, int unit, f32x4 (&sreg)[8]) {
    const int t = threadIdx.x; const float* S0 = A.in[3] + (size_t)unit * 16384;
#pragma unroll
    for (int i = 0; i < 8; ++i) sreg[i] = __builtin_nontemporal_load((const f32x4*)(S0 + ((t >> 5) * 8 + i) * 128 + (t & 31) * 4));
}
__device__ __forceinline__ void hgrn_sample_unit(const Args& A, unsigned char* lds, int unit, int next, f32x4 (&sreg)[8]) {
    const int t = threadIdx.x, b = unit >> 2, h = unit & 3, row = NPR + b, C0 = h * 128;
    unsigned char* ws = A.ws;
    float* qs = (float*)lds; float* ks = qs + 128; float* fs = ks + 128; float* vs = fs + 128; float* po = vs + 128;
    float* red = po + 16 * 128;
    float* S1 = A.out + O_HS + (size_t)unit * 16384;
    if (t < 128) { const size_t go = (size_t)row * HW + C0 + t;
        qs[t] = bf2f(((const bf16_t*)(ws + WS_QQ))[go]); ks[t] = bf2f(((const bf16_t*)(ws + WS_KK))[go]); fs[t] = __expf((float)__builtin_bit_cast(_Float16, ((const unsigned short*)(ws + WS_LF))[go])); vs[t] = bf2f(((const bf16_t*)(ws + WS_VV))[go]); }
    __syncthreads();
    const int v4 = t & 31, kg = t >> 5;
    const f32x4 vv = *(const f32x4*)(vs + v4 * 4);
    f32x4 o = (f32x4){0.f, 0.f, 0.f, 0.f};
#pragma unroll
    for (int i = 0; i < 8; ++i) { const int k = kg * 8 + i; const f32x4 s = sreg[i]; const f32x4 sn = s * fs[k] + vv * ks[k]; __builtin_nontemporal_store(sn, (f32x4*)(S1 + k * 128 + v4 * 4)); o += sn * qs[k]; }
    *(f32x4*)(po + kg * 128 + v4 * 4) = o;
    if (next >= 0) hgrn_sample_load(A, next, sreg);
    __syncthreads();
    float ov = 0.f;
    if (t < 128) {
#pragma unroll
        for (int i = 0; i < 16; ++i) ov += po[i * 128 + t];
        const float sq = wave_sum(ov * ov); if ((t & 63) == 0) red[t >> 6] = sq; }
    __syncthreads();
    if (t < 128) { const float rstd = __builtin_amdgcn_rsqf((red[0] + red[1]) * (1.0f / 128.0f) + EPS); const float g = bf2f(((const bf16_t*)(ws + WS_GG))[(size_t)row * HW + C0 + t]);
        ((bf16_t*)(ws + WS_MIX))[(size_t)row * DM + C0 + t] = (bf16_t)f2bf(ov * rstd * A.in[10][C0 + t] * g); }
    __syncthreads();
}

constexpr int LP_EXT = 0, LP_PL = 40448, LP_MX = 57856;
__device__ __forceinline__ void pool_load(const Args& A, int unit, u32x4 (&mreg)[4], u32x2v (&ereg)[5]) {
    const int t = threadIdx.x; const int tt = unit >> 2, g = unit & 3;
    const unsigned short* UU = (const unsigned short*)(A.ws + WS_UU);
    const bf16_t* PM = (const bf16_t*)(A.ws + WS_PMIX) + (size_t)g * 16384;
#pragma unroll
    for (int i = 0; i < 4; ++i) { const int idx = i * 512 + t, d = idx >> 4, c8 = idx & 15; mreg[i] = *(const u32x4*)(PM + d * 128 + c8 * 8); }
    const int b = tt >> 5, t0 = (tt & 31) * 64;
#pragma unroll
    for (int i5 = 0; i5 < 5; ++i5) { const int idx = i5 * 512 + t, i = idx >> 5, c4 = idx & 31; const int tp = t0 - 15 + i;
        ereg[i5] = (u32x2v){0u, 0u}; if (idx < 79 * 32 && tp >= 0) ereg[i5] = *(const u32x2v*)(UU + (size_t)(b * SEQ + tp) * HW + g * 128 + c4 * 4); }
}
__device__ __forceinline__ void pool_unit(const Args& A, unsigned char* lds, int unit, int next, u32x4 (&mreg)[4], u32x2v (&ereg)[5]) {
    const int t = threadIdx.x, w = t >> 6, l = t & 63, lr = l & 15, lq = l >> 4;
    const int tt = unit >> 2, g = unit & 3, win = 2 << g;
    unsigned char* ws = A.ws;
    float* ext = (float*)(lds + LP_EXT); bf16_t* pl = (bf16_t*)(lds + LP_PL); bf16_t* mx = (bf16_t*)(lds + LP_MX);
    const unsigned short* UU = (const unsigned short*)(ws + WS_UU);
    {
#pragma unroll
        for (int i = 0; i < 4; ++i) { const int idx = i * 512 + t, d = idx >> 4, c8 = idx & 15; *(u32x4*)(mx + d * 136 + c8 * 8) = mreg[i]; }
    }
    int rowbase;
    {
        const int b = tt >> 5, t0 = (tt & 31) * 64; rowbase = b * SEQ + t0;
#pragma unroll
        for (int i5 = 0; i5 < 5; ++i5) { const int idx = i5 * 512 + t, i = idx >> 5, c4 = idx & 31; if (idx < 79 * 32) *(f32x4*)(ext + i * 128 + c4 * 4) = (f32x4){h_lo(ereg[i5].x), h_hi(ereg[i5].x), h_lo(ereg[i5].y), h_hi(ereg[i5].y)}; }
        if (next >= 0) pool_load(A, next, mreg, ereg);
        __syncthreads();
        const int cch = t & 127, tg = t >> 7, tk0 = tg * 16;
        float nw[16], od[16], ini[16];
#pragma unroll
        for (int i = 0; i < 16; ++i) { nw[i] = ext[(15 + tk0 + i) * 128 + cch]; od[i] = (i >= 1) ? ext[(15 + tk0 + i - win) * 128 + cch] : 0.f; ini[i] = (i >= 1 && i < win) ? ext[(15 + tk0 - i) * 128 + cch] : 0.f; }
        float sw = 0.f;
#pragma unroll
        for (int i = 1; i < 16; ++i) sw += ini[i];
#pragma unroll
        for (int i = 0; i < 16; ++i) { const int tok = tk0 + i; sw += nw[i]; sw -= od[i];
            const int cnt = min(t0 + tok + 1, win);
            pl[tok * 136 + cch] = (bf16_t)f2bf(sw * __builtin_amdgcn_rcpf((float)cnt) - nw[i]); }
    }
    __syncthreads();
    const int ct = w & 3, dh = w >> 2;
    f32x4 o4[4];
#pragma unroll
    for (int i = 0; i < 4; ++i) o4[i] = (f32x4){0.f, 0.f, 0.f, 0.f};
#pragma unroll
    for (int ks = 0; ks < 4; ++ks) { const bf16x8 a = *(const bf16x8*)(pl + (16 * ct + lr) * 136 + ks * 32 + lq * 8);
#pragma unroll
        for (int i = 0; i < 4; ++i) { const int dt = dh * 4 + i; const bf16x8 bb = *(const bf16x8*)(mx + (16 * dt + lr) * 136 + ks * 32 + lq * 8); o4[i] = MFMA16(a, bb, o4[i]); } }
    bf16_t* MIX = (bf16_t*)(ws + WS_MIX); const float* psc = A.in[12];
    float* ost = (float*)(lds + LP_EXT);
#pragma unroll
    for (int i = 0; i < 4; ++i) { const int d = (dh * 4 + i) * 16 + lr; const float sc = psc[g * 128 + d];
#pragma unroll
        for (int r = 0; r < 4; ++r) ost[(16 * ct + lq * 4 + r) * 132 + d] = o4[i][r] * sc; }
    __syncthreads();
    {   const int tok = t >> 3, d0 = (t & 7) * 16;
#pragma unroll
        for (int hh = 0; hh < 2; ++hh) { const f32x4 oa = *(const f32x4*)(ost + tok * 132 + d0 + hh * 8), ob = *(const f32x4*)(ost + tok * 132 + d0 + hh * 8 + 4);
            u32x4 o; o.x = pk2(oa[0], oa[1]); o.y = pk2(oa[2], oa[3]); o.z = pk2(ob[0], ob[1]); o.w = pk2(ob[2], ob[3]);
            *(u32x4*)(MIX + (size_t)(rowbase + tok) * DM + 512 + g * 128 + d0 + hh * 8) = o; } }
    __syncthreads();
}

__device__ __forceinline__ void pool_sample_unit(const Args& A, unsigned char* lds, int unit) {
    const int t = threadIdx.x, w = t >> 6, l = t & 63, lr = l & 15, lq = l >> 4;
    const int su = unit >> 2, g = unit & 3, win = 2 << g;
    unsigned char* ws = A.ws;
    bf16_t* pl = (bf16_t*)(lds + LP_PL); bf16_t* mx = (bf16_t*)(lds + LP_MX);
    const _Float16* UU = (const _Float16*)(ws + WS_UU);
    const bf16_t* PM = (const bf16_t*)(ws + WS_PMIX) + (size_t)g * 16384;
    u32x4 mreg[4];
#pragma unroll
    for (int i = 0; i < 4; ++i) { const int idx = i * 512 + t, d = idx >> 4, c8 = idx & 15; mreg[i] = *(const u32x4*)(PM + d * 128 + c8 * 8); }
    const int cch = t & 127, sq = t >> 7;
    const float psc_w = A.in[12][g * 128 + 16 * w + lr];
#pragma unroll
    for (int i = 0; i < 4; ++i) { const int tok = sq * 4 + i, sb = su * 16 + tok; const float uv = (float)UU[(size_t)(NPR + sb) * HW + g * 128 + cch];
        float pv[15];
#pragma unroll
        for (int j = 0; j < 15; ++j) pv[j] = A.in[4][(size_t)(sb * 15 + j) * 512 + g * 128 + cch];
        float sacc = uv;
#pragma unroll
        for (int j = 0; j < 15; ++j) sacc += (j >= 16 - win) ? pv[j] : 0.f;
        pl[tok * 136 + cch] = (bf16_t)f2bf(sacc * __builtin_amdgcn_rcpf((float)win) - uv); }
#pragma unroll
    for (int i = 0; i < 4; ++i) { const int idx = i * 512 + t, d = idx >> 4, c8 = idx & 15; *(u32x4*)(mx + d * 136 + c8 * 8) = mreg[i]; }
    __syncthreads();
    f32x4 acc = (f32x4){0.f, 0.f, 0.f, 0.f};
#pragma unroll
    for (int ks = 0; ks < 4; ++ks) { const bf16x8 a = *(const bf16x8*)(pl + lr * 136 + ks * 32 + lq * 8); const bf16x8 bb = *(const bf16x8*)(mx + (16 * w + lr) * 136 + ks * 32 + lq * 8); acc = MFMA16(a, bb, acc); }
    bf16_t* MIX = (bf16_t*)(ws + WS_MIX);
#pragma unroll
    for (int r = 0; r < 4; ++r) MIX[(size_t)(NPR + su * 16 + lq * 4 + r) * DM + 512 + g * 128 + 16 * w + lr] = (bf16_t)f2bf(acc[r] * psc_w);
    __syncthreads();
}

__device__ __forceinline__ void attn_prompt_unit(const Args& A, unsigned char* lds, int unit) {
    const int t = threadIdx.x, w = t >> 6, l = t & 63, lr = l & 15, lq = l >> 4;
    const int qt = unit & 15, h = (unit >> 4) & 3, b = unit >> 6;
    unsigned char* ws = A.ws;
    const bf16_t* Q = (const bf16_t*)(ws + WS_Q); const bf16_t* KB = (const bf16_t*)(ws + WS_KB); const bf16_t* VT = (const bf16_t*)(ws + WS_VT); bf16_t* O = (bf16_t*)(ws + WS_O);
    const int R0 = b * SEQ + qt * 128 + 16 * w;
    bf16_t* CB = (bf16_t*)lds;
    bf16_t* Pw = (bf16_t*)(lds + 73728) + w * (16 * 264);
    const bf16_t* kg = KB + (size_t)(b * 256) * DM + h * 256;
    const bf16_t* vg = VT + (size_t)(h * 256) * MEMR + b * 256;
    u32x4 stg0[4], stg1[4];
#define AT_LOADK(c, STG) _Pragma("unroll") for (int i_ = 0; i_ < 4; ++i_) { const int idx_ = i_ * 512 + t; STG[i_] = *(const u32x4*)(kg + (size_t)((c) * 64 + (idx_ >> 5)) * DM + (idx_ & 31) * 8); }
#define AT_LOADV(c, STG) _Pragma("unroll") for (int i_ = 0; i_ < 4; ++i_) { const int idx_ = i_ * 512 + t; STG[i_] = *(const u32x4*)(vg + (size_t)(idx_ >> 3) * MEMR + (c) * 64 + (idx_ & 7) * 8); }
#define AT_STOREK(bf, STG) _Pragma("unroll") for (int i_ = 0; i_ < 4; ++i_) { const int idx_ = i_ * 512 + t; *(u32x4*)(CB + (bf) * 18432 + (idx_ >> 5) * 264 + (idx_ & 31) * 8) = STG[i_]; }
#define AT_STOREV(bf, STG) _Pragma("unroll") for (int i_ = 0; i_ < 4; ++i_) { const int idx_ = i_ * 512 + t; *(u32x4*)(CB + (bf) * 18432 + (idx_ >> 3) * 72 + (idx_ & 7) * 8) = STG[i_]; }
    AT_LOADK(0, stg0); AT_LOADK(1, stg1);
    bf16x8 qa[8];
#pragma unroll
    for (int ks = 0; ks < 8; ++ks) qa[ks] = *(const bf16x8*)(Q + (size_t)(R0 + lr) * DM + h * 256 + ks * 32 + lq * 8);
    AT_STOREK(0, stg0);
    __syncthreads();
    f32x4 sacc[16]; f32x4 oacc[16]; bf16x8 pa[8]; float rinv[4];
#pragma unroll
    for (int st = 0; st < 8; ++st) {
        if (st & 1) { if (st + 2 < 4) { AT_LOADK(st + 2, stg1); } else if (st + 2 < 8) { AT_LOADV(st - 2, stg1); } }
        else        { if (st + 2 < 4) { AT_LOADK(st + 2, stg0); } else if (st + 2 < 8) { AT_LOADV(st - 2, stg0); } }
        const bf16_t* cb = CB + (st & 1) * 18432;
        if (st < 4) {
#pragma unroll
            for (int nt = 0; nt < 4; ++nt) { f32x4 acc = (f32x4){0.f, 0.f, 0.f, 0.f};
#pragma unroll
                for (int ks = 0; ks < 8; ++ks) { const bf16x8 bb = *(const bf16x8*)(cb + (nt * 16 + lr) * 264 + ks * 32 + lq * 8); acc = MFMA16(qa[ks], bb, acc); }
                sacc[st * 4 + nt] = acc; __builtin_amdgcn_sched_barrier(0); }
        } else {
            if (st == 4) {
#pragma unroll
                for (int r = 0; r < 4; ++r) { float mx = sacc[0][r];
#pragma unroll
                    for (int nt = 1; nt < 16; ++nt) mx = fmaxf(mx, sacc[nt][r]);
                    mx = fmaxf(mx, __shfl_xor(mx, 1)); mx = fmaxf(mx, __shfl_xor(mx, 2)); mx = fmaxf(mx, __shfl_xor(mx, 4)); mx = fmaxf(mx, __shfl_xor(mx, 8));
                    float sum = 0.f;
#pragma unroll
                    for (int nt = 0; nt < 16; ++nt) { const float p = __builtin_amdgcn_exp2f(sacc[nt][r] - mx); sum += p; Pw[(lq * 4 + r) * 264 + nt * 16 + lr] = (bf16_t)f2bf(p); }
                    sum += __shfl_xor(sum, 1); sum += __shfl_xor(sum, 2); sum += __shfl_xor(sum, 4); sum += __shfl_xor(sum, 8);
                    rinv[r] = 1.0f / sum; }
                asm volatile("s_waitcnt lgkmcnt(0)" ::: "memory");
#pragma unroll
                for (int ks = 0; ks < 8; ++ks) pa[ks] = *(const bf16x8*)(Pw + lr * 264 + ks * 32 + lq * 8);
#pragma unroll
                for (int dt = 0; dt < 16; ++dt) oacc[dt] = (f32x4){0.f, 0.f, 0.f, 0.f};
            }
            const int c = st - 4;
#pragma unroll
            for (int dt = 0; dt < 16; ++dt)
#pragma unroll
                for (int k2 = 0; k2 < 2; ++k2) { const bf16x8 bb = *(const bf16x8*)(cb + (dt * 16 + lr) * 72 + k2 * 32 + lq * 8); oacc[dt] = MFMA16(pa[c * 2 + k2], bb, oacc[dt]); if (k2 == 1 && (dt & 1)) __builtin_amdgcn_sched_barrier(0); }
        }
        if (st & 1) { if (st + 1 < 4) { AT_STOREK(0, stg0); } else if (st + 1 < 8) { AT_STOREV(0, stg0); } }
        else        { if (st + 1 < 4) { AT_STOREK(1, stg1); } else if (st + 1 < 8) { AT_STOREV(1, stg1); } }
        __syncthreads();
    }
#pragma unroll
    for (int dt = 0; dt < 16; ++dt)
#pragma unroll
        for (int r = 0; r < 4; ++r) Pw[(lq * 4 + r) * 264 + dt * 16 + lr] = (bf16_t)f2bf(oacc[dt][r] * rinv[r]);
    asm volatile("s_waitcnt lgkmcnt(0)" ::: "memory");
#pragma unroll
    for (int i = 0; i < 8; ++i) { const int idx = i * 64 + l, row = idx >> 5, c8 = idx & 31; *(u32x4*)(O + (size_t)(R0 + row) * DM + h * 256 + c8 * 8) = *(const u32x4*)(Pw + row * 264 + c8 * 8); }
    asm volatile("s_waitcnt lgkmcnt(0)" ::: "memory");
#undef AT_LOADK
#undef AT_LOADV
#undef AT_STOREK
#undef AT_STOREV
}
__device__ __forceinline__ void attn_sample_unit(const Args& A, unsigned char* lds, int unit) {
    const int t = threadIdx.x, w = t >> 6, l = t & 63;
    const int b = unit >> 2, h = unit & 3;
    unsigned char* ws = A.ws;
    float* qs = (float*)lds; float* sc = qs + 256; float* red = sc + 256; float* po = red + 16;
    const float* Kc = A.in[5] + (size_t)b * 256 * 1024 + h * 256; const float* Vc = A.in[6] + (size_t)b * 256 * 1024 + h * 256;
    const int rl = l >> 4, c16 = l & 15;
    f32x4 kr[8][4];
#pragma unroll
    for (int p = 0; p < 8; ++p)
#pragma unroll
        for (int i = 0; i < 4; ++i) kr[p][i] = *(const f32x4*)(Kc + (size_t)(p * 32 + w * 4 + rl) * 1024 + i * 64 + c16 * 4);
    if (t < 256) qs[t] = bf2f(((const bf16_t*)(ws + WS_Q))[(size_t)(NPR + b) * DM + h * 256 + t]);
    __syncthreads();
    {
        f32x4 q4[4];
#pragma unroll
        for (int i = 0; i < 4; ++i) q4[i] = *(const f32x4*)(qs + i * 64 + c16 * 4);
#pragma unroll
        for (int p = 0; p < 8; ++p) { const int m = p * 32 + w * 4 + rl; float s = 0.f;
#pragma unroll
            for (int i = 0; i < 4; ++i) { const f32x4 kv = kr[p][i]; s += (kv[0] * q4[i][0] + kv[1] * q4[i][1]) + (kv[2] * q4[i][2] + kv[3] * q4[i][3]); }
            s += __shfl_xor(s, 1); s += __shfl_xor(s, 2); s += __shfl_xor(s, 4); s += __shfl_xor(s, 8);
            if (c16 == 0) sc[m] = s; }
    }
    f32x4 vr[32];
#pragma unroll
    for (int i = 0; i < 32; ++i) vr[i] = *(const f32x4*)(Vc + (size_t)(w * 32 + i) * 1024 + l * 4);
    __syncthreads();
    if (t < 256) { float mx = sc[t];
#pragma unroll
        for (int o = 1; o < 64; o <<= 1) mx = fmaxf(mx, __shfl_xor(mx, o));
        if (l == 0) red[w] = mx; }
    __syncthreads();
    const float gmx = fmaxf(fmaxf(red[0], red[1]), fmaxf(red[2], red[3]));
    float pv = 0.f;
    if (t < 256) { pv = __builtin_amdgcn_exp2f(sc[t] - gmx); const float s = wave_sum(pv); if (l == 0) red[8 + w] = s; }
    __syncthreads();
    if (t < 256) sc[t] = pv;
    const float inv = 1.0f / ((red[8] + red[9]) + (red[10] + red[11]));
    __syncthreads();
    {
        f32x4 o = (f32x4){0.f, 0.f, 0.f, 0.f};
#pragma unroll
        for (int i = 0; i < 32; ++i) o += vr[i] * sc[w * 32 + i];
        *(f32x4*)(po + w * 256 + l * 4) = o;
    }
    __syncthreads();
    if (t < 256) { float o = 0.f;
#pragma unroll
        for (int i = 0; i < 8; ++i) o += po[i * 256 + t];
        ((bf16_t*)(ws + WS_O))[(size_t)(NPR + b) * DM + h * 256 + t] = (bf16_t)f2bf(o * inv); }
    __syncthreads();
}

__device__ __forceinline__ void attn_sample_pair(const Args& A, unsigned char* lds, int pg) {
    const int t = threadIdx.x, w = t >> 6, l = t & 63, rl = l >> 4, c16 = l & 15;
    const int pair = pg * 2 + (w >> 2), wq = w & 3, b = pair >> 2, h = pair & 3;
    const size_t off0 = (size_t)b * 256 * 1024 + h * 256 + (size_t)(wq * 64 + rl) * 1024 + c16 * 4;
    const float* Kc = A.in[5] + off0; const float* Vc = A.in[6] + off0;
    f32x4 ra[8], rb[8];
#define AS_LD(set, base, bt) _Pragma("unroll") for (int gg_ = 0; gg_ < 2; ++gg_) _Pragma("unroll") for (int i_ = 0; i_ < 4; ++i_) set[gg_ * 4 + i_] = __builtin_nontemporal_load((const f32x4*)((base) + (size_t)((bt) * 8 + gg_ * 4) * 1024 + i_ * 64))
    AS_LD(ra, Kc, 0); AS_LD(rb, Kc, 1);
    f32x4 q4[4];
    {   const bf16_t* qp = (const bf16_t*)(A.ws + WS_Q) + (size_t)(NPR + b) * DM + h * 256 + c16 * 4;
#pragma unroll
        for (int i = 0; i < 4; ++i) { const u32x2v qv = *(const u32x2v*)(qp + i * 64); q4[i] = (f32x4){__uint_as_float(qv.x << 16), __uint_as_float(qv.x & 0xffff0000u), __uint_as_float(qv.y << 16), __uint_as_float(qv.y & 0xffff0000u)}; } }
    float sc[16];
#define AS_SCORE(set, bt) _Pragma("unroll") for (int gg_ = 0; gg_ < 2; ++gg_) { float s_ = 0.f; _Pragma("unroll") for (int i_ = 0; i_ < 4; ++i_) { const f32x4 kv_ = set[gg_ * 4 + i_]; s_ += (kv_[0] * q4[i_][0] + kv_[1] * q4[i_][1]) + (kv_[2] * q4[i_][2] + kv_[3] * q4[i_][3]); } \
        s_ += __shfl_xor(s_, 1); s_ += __shfl_xor(s_, 2); s_ += __shfl_xor(s_, 4); s_ += __shfl_xor(s_, 8); sc[(bt) * 2 + gg_] = s_; }
#pragma unroll
    for (int bt = 0; bt < 8; ++bt) {
        if (bt & 1) { AS_SCORE(rb, bt); if (bt + 2 < 8) { AS_LD(rb, Kc, bt + 2); } else { AS_LD(rb, Vc, bt - 6); } }
        else        { AS_SCORE(ra, bt); if (bt + 2 < 8) { AS_LD(ra, Kc, bt + 2); } else { AS_LD(ra, Vc, bt - 6); } }
        asm volatile("" ::: "memory"); __builtin_amdgcn_sched_barrier(0);
    }
    float mx = sc[0];
#pragma unroll
    for (int g = 1; g < 16; ++g) mx = fmaxf(mx, sc[g]);
    mx = fmaxf(mx, __shfl_xor(mx, 16)); mx = fmaxf(mx, __shfl_xor(mx, 32));
    float ls = 0.f;
#pragma unroll
    for (int g = 0; g < 16; ++g) { sc[g] = __builtin_amdgcn_exp2f(sc[g] - mx); ls += sc[g]; }
    ls += __shfl_xor(ls, 16); ls += __shfl_xor(ls, 32);
    f32x4 o[4];
#pragma unroll
    for (int i = 0; i < 4; ++i) o[i] = (f32x4){0.f, 0.f, 0.f, 0.f};
#define AS_PV(set, bt) _Pragma("unroll") for (int gg_ = 0; gg_ < 2; ++gg_) _Pragma("unroll") for (int i_ = 0; i_ < 4; ++i_) o[i_] += set[gg_ * 4 + i_] * sc[(bt) * 2 + gg_]
#pragma unroll
    for (int bt = 0; bt < 8; ++bt) {
        if (bt & 1) { AS_PV(rb, bt); if (bt + 2 < 8) { AS_LD(rb, Vc, bt + 2); } }
        else        { AS_PV(ra, bt); if (bt + 2 < 8) { AS_LD(ra, Vc, bt + 2); } }
        asm volatile("" ::: "memory"); __builtin_amdgcn_sched_barrier(0);
    }
#pragma unroll
    for (int i = 0; i < 4; ++i)
#pragma unroll
        for (int c = 0; c < 4; ++c) { float v = o[i][c]; v += __shfl_xor(v, 16); v += __shfl_xor(v, 32); o[i][c] = v; }
    float* pw = (float*)lds + w * 260;
    if (rl == 0) {
#pragma unroll
        for (int i = 0; i < 4; ++i) *(f32x4*)(pw + i * 64 + c16 * 4) = o[i];
        if (c16 == 0) { pw[256] = mx; pw[257] = ls; } }
    __syncthreads();
    {   const int ps = t >> 8, d = t & 255; const float* pb = (const float*)lds + (ps * 4) * 260;
        const float m0 = pb[256], m1 = pb[260 + 256], m2 = pb[520 + 256], m3 = pb[780 + 256]; const float M = fmaxf(fmaxf(m0, m1), fmaxf(m2, m3));
        const float e0 = __builtin_amdgcn_exp2f(m0 - M), e1 = __builtin_amdgcn_exp2f(m1 - M), e2 = __builtin_amdgcn_exp2f(m2 - M), e3 = __builtin_amdgcn_exp2f(m3 - M);
        const float num = (pb[d] * e0 + pb[260 + d] * e1) + (pb[520 + d] * e2 + pb[780 + d] * e3);
        const float den = (pb[257] * e0 + pb[260 + 257] * e1) + (pb[520 + 257] * e2 + pb[780 + 257] * e3);
        const int pr = pg * 2 + ps, bb = pr >> 2, hh = pr & 3;
        ((bf16_t*)(A.ws + WS_O))[(size_t)(NPR + bb) * DM + hh * 256 + d] = (bf16_t)f2bf(num / den); }
    __syncthreads();
#undef AS_LD
#undef AS_SCORE
#undef AS_PV
}

template <int KIND, int NKS>
__device__ __forceinline__ void sample_gemm(unsigned char* lds, const bf16_t* Asm, int lda, const bf16_t* Bt, int K, int unit, const float* base, const bf16_t* baseb, float* out, bf16_t* outb, float* ss, float scale, unsigned* rcnt = nullptr, const float* gfin = nullptr) {
    const int t = threadIdx.x, w = t >> 6, l = t & 63, lr = l & 15, lq = l >> 4;
    const int rb = unit & 3, cb = unit >> 2, kw = K >> 3, k0 = w * kw;
    f32x4 acc[2]; acc[0] = (f32x4){0.f, 0.f, 0.f, 0.f}; acc[1] = acc[0];
    const bf16_t* bp = Bt + (size_t)(cb * 16 + lr) * K + k0 + lq * 8;
    const bf16_t* ap = Asm + (size_t)(rb * 32 + lr) * lda + k0 + lq * 8;
    bf16x8 fb[NKS], fa0[NKS], fa1[NKS];
#pragma unroll
    for (int ks = 0; ks < NKS; ++ks) { fb[ks] = *(const bf16x8*)(bp + ks * 32); fa0[ks] = *(const bf16x8*)(ap + ks * 32); fa1[ks] = *(const bf16x8*)(ap + (size_t)16 * lda + ks * 32); }
    const int row_ = t >> 4, col_ = t & 15;
    float bres = 0.f;
    if (KIND == 0) bres = base ? base[(size_t)(rb * 32 + row_) * DM + cb * 16 + col_] : bf2f(baseb[(size_t)(rb * 32 + row_) * DM + cb * 16 + col_]);
#pragma unroll
    for (int ks = 0; ks < NKS; ++ks) { acc[0] = MFMA16(fa0[ks], fb[ks], acc[0]); acc[1] = MFMA16(fa1[ks], fb[ks], acc[1]); }
    float* red = (float*)lds;
#pragma unroll
    for (int i = 0; i < 2; ++i)
#pragma unroll
        for (int r = 0; r < 4; ++r) red[(w * 32 + i * 16 + lq * 4 + r) * 16 + lr] = acc[i][r];
    __syncthreads();
    const int row = t >> 4, col = t & 15, grow = rb * 32 + row, gcol = cb * 16 + col;
    float v = 0.f;
#pragma unroll
    for (int i = 0; i < 8; ++i) v += red[(i * 32 + row) * 16 + col];
    if (KIND == 0) { const float val = bres + v;
        float sq = val * val; sq += __shfl_xor(sq, 1); sq += __shfl_xor(sq, 2); sq += __shfl_xor(sq, 4); sq += __shfl_xor(sq, 8);
        if (col == 0) atomicAdd(ss + grow, sq);
        if (rcnt) {
            asm volatile("s_waitcnt vmcnt(0)" ::: "memory");
            __syncthreads();
            if (t == 0) { unsigned* c = rcnt + 64 * rb;
                __hip_atomic_fetch_add(c, 1u, __ATOMIC_RELEASE, __HIP_MEMORY_SCOPE_AGENT);
                unsigned sp = 0u; while (__hip_atomic_load(c, __ATOMIC_RELAXED, __HIP_MEMORY_SCOPE_AGENT) < 64u) { __builtin_amdgcn_s_sleep(2); if (++sp > (1u << 22)) break; }
                __builtin_amdgcn_fence(__ATOMIC_ACQUIRE, "agent"); }
            __syncthreads();
            const float tot = __hip_atomic_load(ss + grow, __ATOMIC_RELAXED, __HIP_MEMORY_SCOPE_AGENT);
            out[(size_t)grow * DM + gcol] = val * __builtin_amdgcn_rsqf(tot * (1.0f / DM) + EPS) * gfin[gcol];
        } else { if (out) out[(size_t)grow * DM + gcol] = val; if (outb) outb[(size_t)grow * DM + gcol] = (bf16_t)f2bf(val); }
    } else { const float rstd = __builtin_amdgcn_rsqf(ss[grow] * (1.0f / DM) + EPS); outb[(size_t)grow * DM + gcol] = (bf16_t)f2bf(v * rstd * scale); }
    __syncthreads();
}

__device__ __forceinline__ void final_norm(const Args& A, int G, int row_lo) {
    const int lane = threadIdx.x & 63, gw = blockIdx.x * 8 + (threadIdx.x >> 6), NGW = G * 8;
    const float* ss = (const float*)(A.ws + WS_SS3); const f32x4* gr = (const f32x4*)A.in[22] + lane;
    f32x4 gg[4];
#pragma unroll
    for (int j = 0; j < 4; ++j) gg[j] = gr[64 * j];
    for (int m0 = row_lo + gw * 4; m0 < NVALID; m0 += NGW * 4) {
        f32x4 v[4][4]; float sv[4];
#pragma unroll
        for (int r = 0; r < 4; ++r) { sv[r] = ss[m0 + r]; const f32x4* xr = (const f32x4*)(A.out + (size_t)(m0 + r) * DM) + lane;
#pragma unroll
            for (int j = 0; j < 4; ++j) v[r][j] = xr[64 * j]; }
#pragma unroll
        for (int r = 0; r < 4; ++r) { const float rstd = 1.0f / sqrtf(sv[r] * (1.f / DM) + EPS); f32x4* xr = (f32x4*)(A.out + (size_t)(m0 + r) * DM) + lane;
#pragma unroll
            for (int j = 0; j < 4; ++j) xr[64 * j] = v[r][j] * rstd * gg[j]; } }
}

constexpr int NPHASES = 12;
#ifndef REPMASK
#define REPMASK 0
#endif
#define REPS(k) for (int rep_ = 0; rep_ < 1 + ((REPMASK >> (k)) & 1); ++rep_)
__global__ void __launch_bounds__(NTHREADS, 2) fwd_megakernel(Args args) {
    extern __shared__ __attribute__((aligned(16))) unsigned char lds[];
    cg::grid_group grid = cg::this_grid();
    const int G = gridDim.x, bx = blockIdx.x;
    unsigned char* ws = args.ws;
    PG8_LAS unsigned char* lds3 = (PG8_LAS unsigned char*)lds;
    const int lo = args.ph_lo, hi = args.ph_hi;
#define IN(k) (lo <= (k) && (k) < hi)
#ifndef SPINBLK
#define SPINBLK 0
#endif
#ifdef SPINMASK
    unsigned long long t_prev_ = __builtin_amdgcn_s_memrealtime(), t_acc_ = 0ull;
#define STAMP(k) do { const unsigned long long t_now_ = __builtin_amdgcn_s_memrealtime(); if ((SPINMASK >> (k)) & 1) t_acc_ += t_now_ - t_prev_; t_prev_ = t_now_; } while (0)
#else
#define STAMP(k) do { } while (0)
#endif
#define SEAM(k) do { if (IN(k) && IN((k) + 1)) xcd_barrier(bar); STAMP(k); } while (0)
    if (lo < 0) grid.sync();
    volatile LAS unsigned* MISC = (volatile LAS unsigned*)(lds3 + LDS_BYTES - 64);
    if (threadIdx.x < 16) MISC[threadIdx.x] = 0u;
    __syncthreads();
    XcdBarrier bar = xcd_barrier_post((unsigned*)(ws + WS_BAR), MISC);
    if (IN(0)) REPS(0) { p0_prologue(args, lds, G); }
    SEAM(0);
    if (IN(1)) REPS(1) {
        {   pg8::Gemm g{(const bf16_t*)(ws + WS_H0), (const bf16_t*)(ws + WS_WIN), MT, NIN, DM}; pg8::StaticOrder S; S.init(MT, NIN, G, bx);
            pg8::EpiInProj E{(bf16_t*)(ws + WS_QQ), (bf16_t*)(ws + WS_KK), (bf16_t*)(ws + WS_VV), (bf16_t*)(ws + WS_GG), (unsigned short*)(ws + WS_LF), (unsigned short*)(ws + WS_UU), args.in[9]};
            pg8::gemm_phase<pg8::EpiInProj, pg8::StaticOrder, true, true>(lds3, g, S, E); }
        {   pg8::Gemm g{(const bf16_t*)(ws + WS_MEMH), (const bf16_t*)(ws + WS_WKV), MEMR, 2 * DM, DM}; pg8::StaticOrder S; S.init(MEMR, 2 * DM, G, (bx + G - (650 % G)) % G);
            pg8::EpiMemKV E{args.out + O_MK, args.out + O_MV, (bf16_t*)(ws + WS_KB)};
            pg8::gemm_phase<pg8::EpiMemKV, pg8::StaticOrder, true, true>(lds3, g, S, E); }
        {   pg8::Gemm g{(const bf16_t*)(ws + WS_WKV) + (size_t)DM * DM, (const bf16_t*)(ws + WS_MEMH), DM, MEMR, DM}; pg8::StaticOrder S; S.init(DM, MEMR, G, (bx + 2 * G - ((650 + 64) % G)) % G);
            pg8::EpiBf16Scale E{(bf16_t*)(ws + WS_VT), MEMR, nullptr, 1.0f};
            pg8::gemm_phase<pg8::EpiBf16Scale, pg8::StaticOrder, true, true>(lds3, g, S, E); }
    }
    SEAM(1);
    if (IN(2)) REPS(2) {
        const bool sfirst = ((bx >> 3) & 1) != 0;
#pragma unroll 1
        for (int pass = 0; pass < 2; ++pass) {
            if ((pass == 0) == sfirst) {
                f32x4 sreg[8]; if (bx < 512) hgrn_sample_load(args, bx, sreg);
                for (int u = bx; u < 512; u += G) hgrn_sample_unit(args, lds, u, (u + G < 512) ? u + G : -1, sreg);
            } else {
                u32x2v lf[4]; u32x4 kkr[2], vvr[2]; if (bx < 1024) hgrn_local_load(args, bx, lf, kkr, vvr);
                for (int u = bx; u < 1024; u += G) hgrn_local_unit(args, lds, u, (u + G < 1024) ? u + G : -1, lf, kkr, vvr);
            }
        }
    }
    SEAM(2);
    if (IN(3)) {
        for (int u = bx; u < 32; u += G) pool_sample_unit(args, lds, u);
        const bool scan_first = ((bx >> 3) & 1) != 0;
        if (scan_first) { hgrn_scan(args, G); pool_states(args, G); }
        {   u32x4 mreg[4]; u32x2v ereg[5]; if (bx < 1024) pool_load(args, bx, mreg, ereg);
            for (int u = bx; u < 1024; u += G) pool_unit(args, lds, u, (u + G < 1024) ? u + G : -1, mreg, ereg); }
        if (!scan_first) { hgrn_scan(args, G); pool_states(args, G); }
    }
    SEAM(3);
    if (IN(4)) REPS(4) {
        {   u32x2v lf[4]; u32x4 qqr[2], kkr[2], vvr[2], spr[4]; if (bx < 1024) hgrn_out_load(args, bx, lf, qqr, kkr, vvr, spr);
            for (int u = bx; u < 1024; u += G) hgrn_out_unit(args, lds, u, (u + G < 1024) ? u + G : -1, lf, qqr, kkr, vvr, spr); }
        STAMP(12);
        STAMP(13);
        for (int u = bx; u < 256; u += G) sample_gemm<0, 4>(lds, (const bf16_t*)(ws + WS_MIX) + (size_t)NPR * DM, DM, (const bf16_t*)(ws + WS_WOUT), DM, u, args.in[1], nullptr, nullptr, (bf16_t*)(ws + WS_H0) + (size_t)NPR * DM, (float*)(ws + WS_SS1) + NPR, 1.0f);
    }
    SEAM(4);
    if (IN(5)) REPS(5) {
        pg8::Gemm g{(const bf16_t*)(ws + WS_MIX), (const bf16_t*)(ws + WS_WOUT), NPR, DM, DM}; pg8::StaticOrder S; S.init(NPR, DM, G, bx);
        pg8::EpiResid E{args.in[0], nullptr, nullptr, (bf16_t*)(ws + WS_H0), (float*)(ws + (rep_ ? WS_SSD : WS_SS1))};
        pg8::gemm_phase<pg8::EpiResid, pg8::StaticOrder, true, true>(lds3, g, S, E);
        for (int u = bx; u < 256; u += G) sample_gemm<1, 4>(lds, (const bf16_t*)(ws + WS_H0) + (size_t)NPR * DM, DM, (const bf16_t*)(ws + WS_WCQ), DM, u, nullptr, nullptr, nullptr, (bf16_t*)(ws + WS_Q) + (size_t)NPR * DM, (float*)(ws + WS_SS1) + NPR, 0.0625f * 1.4426950408889634f);
    }
    SEAM(5);
    const bool stream_first = ((bx >> 3) & 1) != 0;
    if (IN(7) && stream_first) for (int u = bx; u < 256; u += G) attn_sample_pair(args, lds, u);
    if (IN(6)) {
        pg8::Gemm g{(const bf16_t*)(ws + WS_H0), (const bf16_t*)(ws + WS_WCQ), NPR, DM, DM}; pg8::StaticOrder S; S.init(NPR, DM, G, bx);
        pg8::EpiBf16Scale E{(bf16_t*)(ws + WS_Q), DM, (const float*)(ws + WS_SS1), 0.0625f * 1.4426950408889634f};
        pg8::gemm_phase<pg8::EpiBf16Scale, pg8::StaticOrder, true, true>(lds3, g, S, E);
        STAMP(16);
    }
    int au0 = bx, au1 = 512, austep = G;
    if (G == 256) {
        asm volatile("s_waitcnt vmcnt(0)" ::: "memory"); __syncthreads();
        const int wg_ = (bx & 7) * 32 + (bx >> 3), pm_ = (wg_ >> 5) * 8 + ((wg_ & 31) & 7), pn_ = (wg_ & 31) >> 3;
        au0 = ((pm_ >> 3) * 4 + pn_) * 16 + (pm_ & 7) * 2; au1 = au0 + 2; austep = 1;
    } else { SEAM(6); }
    if (IN(7)) {
        for (int u = au0; u < au1; u += austep) attn_prompt_unit(args, lds, u);
        STAMP(17);
        if (!stream_first) for (int u = bx; u < 256; u += G) attn_sample_pair(args, lds, u);
    }
    SEAM(7);
    if (IN(8)) REPS(8) {
        pg8::Gemm g{(const bf16_t*)(ws + WS_O), (const bf16_t*)(ws + WS_WCO), NPR, DM, DM}; pg8::StaticOrder S; S.init(NPR, DM, G, bx);
        pg8::EpiResid E{nullptr, (const bf16_t*)(ws + WS_H0), nullptr, (bf16_t*)(ws + WS_MIX), (float*)(ws + (rep_ ? WS_SSD : WS_SS2))};
        pg8::gemm_phase<pg8::EpiResid, pg8::StaticOrder, true, true>(lds3, g, S, E);
        for (int u = bx; u < 256; u += G) sample_gemm<0, 4>(lds, (const bf16_t*)(ws + WS_O) + (size_t)NPR * DM, DM, (const bf16_t*)(ws + WS_WCO), DM, u, nullptr, (const bf16_t*)(ws + WS_H0) + (size_t)NPR * DM, nullptr, (bf16_t*)(ws + WS_MIX) + (size_t)NPR * DM, (float*)(ws + (rep_ ? WS_SSD : WS_SS2)) + NPR, 1.0f);
    }
    SEAM(8);
    if (IN(9)) REPS(9) {
        pg8::Gemm g{(const bf16_t*)(ws + WS_MIX), (const bf16_t*)(ws + WS_WFFI), MT, NFF2, DM}; pg8::StaticOrder S; S.init(MT, NFF2, G, bx);
        pg8::EpiSwiGLU E{(bf16_t*)(ws + WS_A), (const float*)(ws + WS_SS2)};
        pg8::gemm_phase<pg8::EpiSwiGLU, pg8::StaticOrder, true, true>(lds3, g, S, E);
    }
    SEAM(9);
    if (IN(10)) {
        pg8::Gemm g{(const bf16_t*)(ws + WS_A), (const bf16_t*)(ws + WS_WFFO), NPR, DM, DFF}; pg8::StaticOrder S; S.init(NPR, DM, G, bx);
        if (G == 256) {
            pg8::EpiResidNorm E{(const bf16_t*)(ws + WS_MIX), args.out, (float*)(ws + WS_SS3), (unsigned*)(ws + WS_CNT), args.in[22]};
            pg8::gemm_phase<pg8::EpiResidNorm, pg8::StaticOrder, false, true>(lds3, g, S, E);
        } else {
            pg8::EpiResid E{nullptr, (const bf16_t*)(ws + WS_MIX), args.out, nullptr, (float*)(ws + WS_SS3)};
            pg8::gemm_phase<pg8::EpiResid, pg8::StaticOrder, true, true>(lds3, g, S, E);
        }
        for (int u = bx; u < 256; u += G) sample_gemm<0, 11>(lds, (const bf16_t*)(ws + WS_A) + (size_t)NPR * DFF, DFF, (const bf16_t*)(ws + WS_WFFO), DFF, u, nullptr, (const bf16_t*)(ws + WS_MIX) + (size_t)NPR * DM, args.out + O_YS, nullptr, (float*)(ws + WS_SS3) + NPR, 1.0f, (G == 256) ? (unsigned*)(ws + WS_CNT) + 64 * 64 : nullptr, args.in[22]);
    }
    if (G != 256) SEAM(10);
#ifdef EXTRA_SYNCS
    for (int i_ = 0; i_ < EXTRA_SYNCS; ++i_) xcd_barrier(bar);
#endif
    if (IN(11) && G != 256) { final_norm(args, G, 0); }
#ifdef SPINMASK
    STAMP(11);
    if (bx == SPINBLK && threadIdx.x == 0) { const unsigned long long t0_ = __builtin_amdgcn_s_memrealtime(); while (__builtin_amdgcn_s_memrealtime() - t0_ < t_acc_) __builtin_amdgcn_s_sleep(8); }
#endif
#undef IN
#undef SEAM
}

#ifndef MK_MULTI
#define MK_MULTI 0
#endif
extern "C" void kernel_launch(void* const* d_in, const int* in_sizes, int n_in, void* d_out, int out_size, void* d_ws, size_t ws_size, hipStream_t stream) {
    static int grid = 0;
    if (grid == 0) {
        if (n_in != 23 || ws_size < WS_END) { fprintf(stderr, "kernel_launch: unexpected n_in %d / ws_size %zu\n", n_in, ws_size); grid = -1; return; }
        int dev = 0, cus = 0, per_cu = 0;
        hipGetDevice(&dev); hipDeviceGetAttribute(&cus, hipDeviceAttributeMultiprocessorCount, dev);
        if (hipFuncSetAttribute((const void*)fwd_megakernel, hipFuncAttributeMaxDynamicSharedMemorySize, LDS_BYTES) != hipSuccess) { fprintf(stderr, "kernel_launch: hipFuncSetAttribute failed\n"); grid = -1; return; }
        hipOccupancyMaxActiveBlocksPerMultiprocessor(&per_cu, (const void*)fwd_megakernel, NTHREADS, LDS_BYTES);
        (void)hipGetLastError();
        if (per_cu < 1) { fprintf(stderr, "kernel_launch: occupancy query says %d blocks/CU\n", per_cu); per_cu = 1; }
        grid = cus;
    }
    if (grid < 0) return;
    Args a{};
    for (int i = 0; i < 23; ++i) a.in[i] = (const float*)d_in[i];
    a.out = (float*)d_out; a.ws = (unsigned char*)d_ws;
#if MK_MULTI
    for (int p = 0; p < NPHASES; ++p) { a.ph_lo = p; a.ph_hi = p + 1; hipLaunchKernelGGL(fwd_megakernel, dim3(grid), dim3(NTHREADS), LDS_BYTES, stream, a); }
#else
    a.ph_lo = 0; a.ph_hi = NPHASES;
    if (hipMemsetAsync((char*)d_ws + WS_BAR, 0, BAR_BYTES, stream) != hipSuccess) { fprintf(stderr, "kernel_launch: memset failed\n"); return; }
    void* kargs[] = {&a};
    hipError_t e = hipLaunchCooperativeKernel((const void*)fwd_megakernel, dim3(grid), dim3(NTHREADS), kargs, LDS_BYTES, stream);
    if (e != hipSuccess) fprintf(stderr, "kernel_launch: cooperative launch failed: %s (grid %d)\n", hipGetErrorString(e), grid);
#endif
}
```

```cpp
#include <hip/hip_runtime.h>
#include <hip/hip_cooperative_groups.h>
#include <cstdio>
#include <cstdint>
namespace cg = cooperative_groups;
namespace pg8 {
#define PG8_LAS __attribute__((address_space(3)))
typedef unsigned short bf16_t;
typedef short bf16x8 __attribute__((ext_vector_type(8)));
typedef float f32x4 __attribute__((ext_vector_type(4)));
typedef unsigned u32x4 __attribute__((ext_vector_type(4)));
constexpr int BM = 256, BK = 64, HALF = 128, HTB = HALF * BK * 2  , STAGE_BYTES = 8 * HTB, NXCD = 8, WGM = 8;

__host__ __device__ __forceinline__ int lds_byte(int r, int c) { const int st = (r >> 4) * 2 + (c >> 5), rr = r & 15, cc = c & 31, ob = rr * 64 + cc * 2; return st * 1024 + (ob ^ (((ob >> 9) & 1) << 5)); }
__host__ __device__ __forceinline__ void stage_rc(int b, int& R, int& C) { const int st = b / 1024, sb = b % 1024, swz = sb ^ (((sb >> 9) & 1) << 5); R = (st >> 1) * 16 + swz / 64; C = (st & 1) * 32 + (swz % 64) / 2; }
__host__ __device__ __forceinline__ int perm32(int rho) { const int n = rho >> 4, i = rho & 15; return 8 * (i >> 2) + 4 * n + (i & 3); }

struct Unit { int pm, pn; };
struct Gemm { const bf16_t* A; const bf16_t* Bt; int M, N, K; };

struct StaticOrder {
    int nM, nN, nwg, G, c;
    __host__ __device__ void init(int M, int N, int G_, int c_) { nM = M / BM; nN = N / BM; nwg = nM * nN; G = G_; c = c_; }
    __host__ __device__ bool next(int i, Unit& u) const {
        const long L = (long)i * G + c; if (L >= nwg) return false;
        int wgid = (int)L; { const int q = nwg / NXCD, r = nwg % NXCD, xcd = wgid % NXCD, off = wgid / NXCD; wgid = (xcd < r ? xcd * (q + 1) : r * (q + 1) + (xcd - r) * q) + off; }
        const int nig = WGM * nN, gid = wgid / nig, fm = gid * WGM, gsz = (nM - fm) < WGM ? (nM - fm) : WGM;
        u.pm = fm + ((wgid % nig) % gsz); u.pn = (wgid % nig) / gsz; return true;
    }
    __device__ __forceinline__ void a_ready(const Unit&) const {}
    __device__ __forceinline__ void done(const Unit&) const {}
};

__device__ __forceinline__ unsigned cvt_pk_bf16(float lo, float hi) { unsigned r; asm volatile("v_cvt_pk_bf16_f32 %0, %1, %2" : "=v"(r) : "v"(lo), "v"(hi)); return r; }
typedef unsigned u32x2 __attribute__((ext_vector_type(2)));
__device__ __forceinline__ float sigm(float z) { return __builtin_amdgcn_rcpf(1.0f + __expf(-z)); }
constexpr float RMS_EPS = 1e-6f;
#ifndef WT_STORES
#define WT_STORES 0
#endif
__device__ __forceinline__ void st16(void* p, u32x4 v) {
#if WT_STORES
    asm volatile("global_store_dwordx4 %0, %1, off sc1\n\ts_nop 1" :: "v"(p), "v"(v) : "memory");
#else
    *(u32x4*)p = v;
#endif
}
__device__ __forceinline__ void st16f(void* p, f32x4 v) { st16(p, __builtin_bit_cast(u32x4, v)); }
__device__ __forceinline__ void st8(void* p, u32x2 v) {
#if WT_STORES
    asm volatile("global_store_dwordx2 %0, %1, off sc1\n\ts_nop 1" :: "v"(p), "v"(v) : "memory");
#else
    *(u32x2*)p = v;
#endif
}
typedef _Float16 h2_t __attribute__((ext_vector_type(2)));
__device__ __forceinline__ unsigned pk_h2(float a, float b) { h2_t v; v.x = (_Float16)a; v.y = (_Float16)b; return __builtin_bit_cast(unsigned, v); }
__device__ __forceinline__ float h_lo(unsigned u) { return (float)__builtin_bit_cast(h2_t, u).x; }
__device__ __forceinline__ float h_hi(unsigned u) { return (float)__builtin_bit_cast(h2_t, u).y; }

struct EpiInProj {
    static constexpr bool PERM = true, AFTER_DRAIN = false;
    bf16_t *QQ, *KK, *VV, *GG; unsigned short *LF, *UU; const float* lbraw; const float* ss0;
    __device__ __forceinline__ void operator()(const f32x4 (&acc)[2][2][4][2], const Unit& u, int wr, int wc, int fr, int fq) const {
        const int seg = u.pn >> 1, colt = (u.pn & 1) * 256;
        const int row0 = u.pm * BM + wr * 64 + fr;
        float rs0[2][4];
#pragma unroll
        for (int ai = 0; ai < 2; ++ai)
#pragma unroll
            for (int m = 0; m < 4; ++m) rs0[ai][m] = __builtin_amdgcn_rsqf(ss0[row0 + ai * HALF + m * 16] * (1.0f / 1024.0f) + RMS_EPS);
#pragma unroll
        for (int bj = 0; bj < 2; ++bj) {
            const int cs = colt + bj * HALF + wc * 32 + 8 * fq;
            float lb[8];
            if (seg == 1) {
#pragma unroll
                for (int j = 0; j < 8; ++j) { const float l0 = lbraw[cs + j], l1 = lbraw[512 + cs + j]; lb[j] = __builtin_amdgcn_rcpf(1.0f + __expf(l1 - l0)); }
            } else {
#pragma unroll
                for (int j = 0; j < 8; ++j) lb[j] = 0.f;
            }
#pragma unroll
            for (int ai = 0; ai < 2; ++ai)
#pragma unroll
                for (int m = 0; m < 4; ++m) {
                    const size_t off = (size_t)(row0 + ai * HALF + m * 16) * 512 + cs;
                    const f32x4 v0 = acc[ai][bj][m][0] * rs0[ai][m], v1 = acc[ai][bj][m][1] * rs0[ai][m];
                    float z[8] = {v0[0], v0[1], v0[2], v0[3], v1[0], v1[1], v1[2], v1[3]};
                    if (seg == 0) {
#pragma unroll
                        for (int j = 0; j < 8; ++j) z[j] = z[j] * sigm(z[j]);
                        u32x4 w; w.x = cvt_pk_bf16(z[0], z[1]); w.y = cvt_pk_bf16(z[2], z[3]); w.z = cvt_pk_bf16(z[4], z[5]); w.w = cvt_pk_bf16(z[6], z[7]);
                        st16(QQ + off, w);
                    } else if (seg == 1) {
                        float lf[8], kk[8];
#pragma unroll
                        for (int j = 0; j < 8; ++j) { const float e = __expf(-z[j]); const float sg = __builtin_amdgcn_rcpf(1.0f + e); const float sgn = e * sg;
                            lf[j] = __logf(lb[j] + (1.0f - lb[j]) * sg); kk[j] = (1.0f - lb[j]) * sgn; }
                        { u32x4 w; w.x = pk_h2(lf[0], lf[1]); w.y = pk_h2(lf[2], lf[3]); w.z = pk_h2(lf[4], lf[5]); w.w = pk_h2(lf[6], lf[7]); st16(LF + off, w); }
                        u32x4 w; w.x = cvt_pk_bf16(kk[0], kk[1]); w.y = cvt_pk_bf16(kk[2], kk[3]); w.z = cvt_pk_bf16(kk[4], kk[5]); w.w = cvt_pk_bf16(kk[6], kk[7]);
                        st16(KK + off, w);
                    } else if (seg == 2) {
                        u32x4 w; w.x = cvt_pk_bf16(z[0], z[1]); w.y = cvt_pk_bf16(z[2], z[3]); w.z = cvt_pk_bf16(z[4], z[5]); w.w = cvt_pk_bf16(z[6], z[7]);
                        st16(VV + off, w);
                    } else if (seg == 3) {
#pragma unroll
                        for (int j = 0; j < 8; ++j) z[j] = sigm(z[j]);
                        u32x4 w; w.x = cvt_pk_bf16(z[0], z[1]); w.y = cvt_pk_bf16(z[2], z[3]); w.z = cvt_pk_bf16(z[4], z[5]); w.w = cvt_pk_bf16(z[6], z[7]);
                        st16(GG + off, w);
                    } else {
                        u32x4 w; w.x = pk_h2(z[0], z[1]); w.y = pk_h2(z[2], z[3]); w.z = pk_h2(z[4], z[5]); w.w = pk_h2(z[6], z[7]); st16(UU + off, w);
                    }
                }
        }
    }
};

struct EpiMemKV {
    static constexpr bool PERM = true, AFTER_DRAIN = false;
    float *outK, *outV; bf16_t* KB;
    __device__ __forceinline__ void operator()(const f32x4 (&acc)[2][2][4][2], const Unit& u, int wr, int wc, int fr, int fq) const {
        const bool isk = u.pn < 4; float* o = isk ? outK : outV; const int colt = (u.pn & 3) * 256;
        const int row0 = u.pm * BM + wr * 64 + fr;
#pragma unroll
        for (int ai = 0; ai < 2; ++ai)
#pragma unroll
            for (int m = 0; m < 4; ++m)
#pragma unroll
                for (int bj = 0; bj < 2; ++bj) {
                    const size_t off = (size_t)(row0 + ai * HALF + m * 16) * 1024 + colt + bj * HALF + wc * 32 + 8 * fq;
                    const f32x4 v0 = acc[ai][bj][m][0], v1 = acc[ai][bj][m][1];
                    *(f32x4*)(o + off) = v0; *(f32x4*)(o + off + 4) = v1;
                    if (isk) { u32x4 w; w.x = cvt_pk_bf16(v0[0], v0[1]); w.y = cvt_pk_bf16(v0[2], v0[3]); w.z = cvt_pk_bf16(v1[0], v1[1]); w.w = cvt_pk_bf16(v1[2], v1[3]); *(u32x4*)(KB + off) = w; }
                }
    }
};

struct EpiBf16Scale {
    static constexpr bool PERM = true, AFTER_DRAIN = false;
    bf16_t* O; int ldc; const float* ss; float scale;
    __device__ __forceinline__ void operator()(const f32x4 (&acc)[2][2][4][2], const Unit& u, int wr, int wc, int fr, int fq) const {
        const int row0 = u.pm * BM + wr * 64 + fr;
        float ssv[2][4];
#pragma unroll
        for (int ai = 0; ai < 2; ++ai)
#pragma unroll
            for (int m = 0; m < 4; ++m) ssv[ai][m] = ss ? ss[row0 + ai * HALF + m * 16] : 0.f;
#pragma unroll
        for (int ai = 0; ai < 2; ++ai)
#pragma unroll
            for (int m = 0; m < 4; ++m) {
                const int row = row0 + ai * HALF + m * 16;
                const float sc = ss ? scale * __builtin_amdgcn_rsqf(ssv[ai][m] * (1.0f / 1024.0f) + RMS_EPS) : scale;
#pragma unroll
                for (int bj = 0; bj < 2; ++bj) {
                    const size_t off = (size_t)row * ldc + u.pn * BM + bj * HALF + wc * 32 + 8 * fq;
                    const f32x4 v0 = acc[ai][bj][m][0] * sc, v1 = acc[ai][bj][m][1] * sc;
                    u32x4 w; w.x = cvt_pk_bf16(v0[0], v0[1]); w.y = cvt_pk_bf16(v0[2], v0[3]); w.z = cvt_pk_bf16(v1[0], v1[1]); w.w = cvt_pk_bf16(v1[2], v1[3]);
                    st16(O + off, w);
                }
            }
    }
};

struct EpiResid {
    static constexpr bool PERM = true, AFTER_DRAIN = false;
    const float* baseF;
    const bf16_t* baseB;
    float* out;
    bf16_t* outb;
    float* ss;
    __device__ __forceinline__ void operator()(const f32x4 (&acc)[2][2][4][2], const Unit& u, int wr, int wc, int fr, int fq) const {
        const int row0 = u.pm * BM + wr * 64 + fr;
#pragma unroll
        for (int ai = 0; ai < 2; ++ai) {
            f32x4 pre[4][2][2];
            if (baseF) {
#pragma unroll
                for (int m = 0; m < 4; ++m) { const float* bp = baseF + (size_t)(row0 + ai * HALF + m * 16) * 1024;
#pragma unroll
                    for (int bj = 0; bj < 2; ++bj) { const int col = u.pn * BM + bj * HALF + wc * 32 + 8 * fq; pre[m][bj][0] = __builtin_nontemporal_load((const f32x4*)(bp + col)); pre[m][bj][1] = __builtin_nontemporal_load((const f32x4*)(bp + col + 4)); } }
            } else {
                u32x4 pb[4][2];
#pragma unroll
                for (int m = 0; m < 4; ++m) { const bf16_t* bp = baseB + (size_t)(row0 + ai * HALF + m * 16) * 1024;
#pragma unroll
                    for (int bj = 0; bj < 2; ++bj) pb[m][bj] = *(const u32x4*)(bp + u.pn * BM + bj * HALF + wc * 32 + 8 * fq); }
#pragma unroll
                for (int m = 0; m < 4; ++m)
#pragma unroll
                    for (int bj = 0; bj < 2; ++bj) { const u32x4 p = pb[m][bj];
                        pre[m][bj][0] = (f32x4){__uint_as_float(p.x << 16), __uint_as_float(p.x & 0xffff0000u), __uint_as_float(p.y << 16), __uint_as_float(p.y & 0xffff0000u)};
                        pre[m][bj][1] = (f32x4){__uint_as_float(p.z << 16), __uint_as_float(p.z & 0xffff0000u), __uint_as_float(p.w << 16), __uint_as_float(p.w & 0xffff0000u)}; }
            }
#pragma unroll
            for (int m = 0; m < 4; ++m) {
                const int row = row0 + ai * HALF + m * 16;
                float s = 0.f;
#pragma unroll
                for (int bj = 0; bj < 2; ++bj) {
                    const int col = u.pn * BM + bj * HALF + wc * 32 + 8 * fq;
                    const f32x4 v0 = acc[ai][bj][m][0] + pre[m][bj][0], v1 = acc[ai][bj][m][1] + pre[m][bj][1];
                    s += (v0[0] * v0[0] + v0[1] * v0[1]) + (v0[2] * v0[2] + v0[3] * v0[3]) + (v1[0] * v1[0] + v1[1] * v1[1]) + (v1[2] * v1[2] + v1[3] * v1[3]);
                    if (out) { *(f32x4*)(out + (size_t)row * 1024 + col) = v0; *(f32x4*)(out + (size_t)row * 1024 + col + 4) = v1; }
                    if (outb) { u32x4 w; w.x = cvt_pk_bf16(v0[0], v0[1]); w.y = cvt_pk_bf16(v0[2], v0[3]); w.z = cvt_pk_bf16(v1[0], v1[1]); w.w = cvt_pk_bf16(v1[2], v1[3]); st16(outb + (size_t)row * 1024 + col, w); }
                }
                s += __shfl_xor(s, 16); s += __shfl_xor(s, 32);
                if (fq == 0) atomicAdd(ss + row, s);
            }
        }
    }
};

struct EpiResidNorm {
    static constexpr bool PERM = true, AFTER_DRAIN = true;
    const bf16_t* baseB; float* out; float* ss; unsigned* cnt; const float* gfin;
    __device__ __forceinline__ void fused(f32x4 (&acc)[2][2][4][2], const Unit& u, int wr, int wc, int fr, int fq, PG8_LAS unsigned char* lds, int wid, int lane) const {
        const int row0 = u.pm * BM + wr * 64 + fr;
#pragma unroll
        for (int ai = 0; ai < 2; ++ai) {
            u32x4 pb[4][2];
#pragma unroll
            for (int m = 0; m < 4; ++m) { const bf16_t* bp = baseB + (size_t)(row0 + ai * HALF + m * 16) * 1024;
#pragma unroll
                for (int bj = 0; bj < 2; ++bj) pb[m][bj] = *(const u32x4*)(bp + u.pn * BM + bj * HALF + wc * 32 + 8 * fq); }
#pragma unroll
            for (int m = 0; m < 4; ++m) { float s = 0.f;
#pragma unroll
                for (int bj = 0; bj < 2; ++bj) { const u32x4 p = pb[m][bj];
                    const f32x4 v0 = acc[ai][bj][m][0] + (f32x4){__uint_as_float(p.x << 16), __uint_as_float(p.x & 0xffff0000u), __uint_as_float(p.y << 16), __uint_as_float(p.y & 0xffff0000u)};
                    const f32x4 v1 = acc[ai][bj][m][1] + (f32x4){__uint_as_float(p.z << 16), __uint_as_float(p.z & 0xffff0000u), __uint_as_float(p.w << 16), __uint_as_float(p.w & 0xffff0000u)};
                    acc[ai][bj][m][0] = v0; acc[ai][bj][m][1] = v1;
                    s += (v0[0] * v0[0] + v0[1] * v0[1]) + (v0[2] * v0[2] + v0[3] * v0[3]) + (v1[0] * v1[0] + v1[1] * v1[1]) + (v1[2] * v1[2] + v1[3] * v1[3]); }
                s += __shfl_xor(s, 16); s += __shfl_xor(s, 32);
                if (fq == 0) atomicAdd(ss + row0 + ai * HALF + m * 16, s); }
        }
        asm volatile("s_waitcnt vmcnt(0)" ::: "memory");
        __syncthreads();
        if (threadIdx.x == 0) { unsigned* c = cnt + 64 * u.pm;
            __hip_atomic_fetch_add(c, 1u, __ATOMIC_RELEASE, __HIP_MEMORY_SCOPE_AGENT);
            unsigned sp = 0u; while (__hip_atomic_load(c, __ATOMIC_RELAXED, __HIP_MEMORY_SCOPE_AGENT) < 4u) { __builtin_amdgcn_s_sleep(2); if (++sp > (1u << 22)) break; }
            __builtin_amdgcn_fence(__ATOMIC_ACQUIRE, "agent"); }
        __syncthreads();
        float rs[2][4];
#pragma unroll
        for (int ai = 0; ai < 2; ++ai)
#pragma unroll
            for (int m = 0; m < 4; ++m) rs[ai][m] = __hip_atomic_load(ss + row0 + ai * HALF + m * 16, __ATOMIC_RELAXED, __HIP_MEMORY_SCOPE_AGENT);
        f32x4 gv[2][2];
#pragma unroll
        for (int bj = 0; bj < 2; ++bj) { const int col = u.pn * BM + bj * HALF + wc * 32 + 8 * fq; gv[bj][0] = *(const f32x4*)(gfin + col); gv[bj][1] = *(const f32x4*)(gfin + col + 4); }
#pragma unroll
        for (int ai = 0; ai < 2; ++ai)
#pragma unroll
            for (int m = 0; m < 4; ++m) { const int row = row0 + ai * HALF + m * 16; const float rstd = 1.0f / sqrtf(rs[ai][m] * (1.0f / 1024.0f) + RMS_EPS);
#pragma unroll
                for (int bj = 0; bj < 2; ++bj) { const int col = u.pn * BM + bj * HALF + wc * 32 + 8 * fq;
                    *(f32x4*)(out + (size_t)row * 1024 + col) = acc[ai][bj][m][0] * rstd * gv[bj][0]; *(f32x4*)(out + (size_t)row * 1024 + col + 4) = acc[ai][bj][m][1] * rstd * gv[bj][1]; } }
    }
};

struct EpiSwiGLU {
    static constexpr bool PERM = true, AFTER_DRAIN = false;
    bf16_t* ACT; const float* ss;
    __device__ __forceinline__ void operator()(const f32x4 (&acc)[2][2][4][2], const Unit& u, int wr, int wc, int fr, int fq) const {
        const int row0 = u.pm * BM + wr * 64 + fr;
        float ssv[2][4];
#pragma unroll
        for (int ai = 0; ai < 2; ++ai)
#pragma unroll
            for (int m = 0; m < 4; ++m) ssv[ai][m] = ss[row0 + ai * HALF + m * 16];
        const int J = u.pn * 128 + wc * 32 + 8 * fq;
#pragma unroll
        for (int ai = 0; ai < 2; ++ai)
#pragma unroll
            for (int m = 0; m < 4; ++m) {
                const int row = row0 + ai * HALF + m * 16;
                const float r = __builtin_amdgcn_rsqf(ssv[ai][m] * (1.0f / 1024.0f) + RMS_EPS);
                float o[8];
#pragma unroll
                for (int n = 0; n < 2; ++n) { const f32x4 a = acc[ai][0][m][n] * r, b = acc[ai][1][m][n] * r;
#pragma unroll
                    for (int j = 0; j < 4; ++j) o[4 * n + j] = a[j] * sigm(a[j]) * b[j]; }
                u32x4 w; w.x = cvt_pk_bf16(o[0], o[1]); w.y = cvt_pk_bf16(o[2], o[3]); w.z = cvt_pk_bf16(o[4], o[5]); w.w = cvt_pk_bf16(o[6], o[7]);
                st16(ACT + (size_t)row * 2816 + J, w);
            }
    }
};

template <class Epi, class Sched, bool ALIGN_EPI = false, bool SP2 = false>
__device__ __forceinline__ void gemm_phase(PG8_LAS unsigned char* lds, const Gemm g, const Sched& S, const Epi& E) {
    const int tid = threadIdx.x, wid = __builtin_amdgcn_readfirstlane(tid >> 6), lane = tid & 63, wr = wid >> 2, wc = wid & 3, fr = lane & 15, fq = lane >> 4;
    const int K = g.K, nt = K / BK;
    unsigned voffA[2], voffB[2];
#pragma unroll
    for (int i = 0; i < 2; ++i) { int R, C; stage_rc(tid * 16 + i * 8192, R, C); const int Rb = Epi::PERM ? ((R & ~31) + perm32(R & 31)) : R;
        voffA[i] = (unsigned)(R * K + C) * 2u; voffB[i] = (unsigned)(Rb * K + C) * 2u; }
    const size_t kstep = (size_t)(BK * 2);
    const size_t hstep = (size_t)HALF * K * 2;
    const size_t tstep = 2 * hstep;
    const unsigned ldsw = (unsigned)wid * 1024u;
    const int aoff = lds_byte(wr * 64 + fr, fq * 8), boff = lds_byte(wc * 32 + fr, fq * 8);
#define PG8_SA(b, h) (((b) * 2 + (h)) * HTB)
#define PG8_SB(b, h) ((4 + (b) * 2 + (h)) * HTB)
#define PG8_STAGE(bufoff, gbase, voff) do { _Pragma("unroll") for (int _i = 0; _i < 2; ++_i) \
        __builtin_amdgcn_global_load_lds((const unsigned*)((const char*)(gbase) + (voff)[_i]), (PG8_LAS unsigned*)(lds + (bufoff) + ldsw + _i * 8192), 16, 0, 0); } while (0)
#define PG8_LDA(dst, b, h) do { _Pragma("unroll") for (int m = 0; m < 4; ++m) _Pragma("unroll") for (int k = 0; k < 2; ++k) dst[m][k] = *(const PG8_LAS bf16x8*)(lds + PG8_SA(b, h) + aoff + m * 2048 + k * 1024); } while (0)
#define PG8_LDB(dst, b, h) do { _Pragma("unroll") for (int n = 0; n < 2; ++n) _Pragma("unroll") for (int k = 0; k < 2; ++k) dst[n][k] = *(const PG8_LAS bf16x8*)(lds + PG8_SB(b, h) + boff + n * 2048 + k * 1024); } while (0)
#define PG8_MMA(ai, bj, At, Bt) do { __builtin_amdgcn_s_setprio(1); _Pragma("unroll") for (int m = 0; m < 4; ++m) _Pragma("unroll") for (int n = 0; n < 2; ++n) _Pragma("unroll") for (int k = 0; k < 2; ++k) \
        acc[ai][bj][m][n] = __builtin_amdgcn_mfma_f32_16x16x32_bf16(Bt[n][k], At[m][k], acc[ai][bj][m][n], 0, 0, 0); __builtin_amdgcn_s_setprio(0); } while (0)
#define PG8_WAIT_V(n) asm volatile("s_waitcnt vmcnt(" #n ")" ::: "memory")
#define PG8_WAIT_L(n) asm volatile("s_waitcnt lgkmcnt(" #n ")" ::: "memory")
#define PG8_BAR __builtin_amdgcn_s_barrier()
#define PG8_SCHED __builtin_amdgcn_sched_barrier(0)
    Unit cur, nxt; int ui = 0;
    if (!S.next(0, cur)) return;
    f32x4 acc[2][2][4][2];
#pragma unroll
    for (int a = 0; a < 2; ++a)
#pragma unroll
        for (int b = 0; b < 2; ++b)
#pragma unroll
            for (int m = 0; m < 4; ++m)
#pragma unroll
                for (int n = 0; n < 2; ++n) acc[a][b][m][n] = (f32x4){0.f, 0.f, 0.f, 0.f};
    bf16x8 At[4][2], B0[2][2], B1[2][2];
    const char* cA = (const char*)g.A + (size_t)cur.pm * tstep; const char* cB = (const char*)g.Bt + (size_t)cur.pn * tstep;
    S.a_ready(cur);
    if constexpr (SP2) {
        PG8_STAGE(PG8_SB(0, 0), cB, voffB); PG8_STAGE(PG8_SB(0, 1), cB + hstep, voffB); PG8_STAGE(PG8_SA(0, 0), cA, voffA); PG8_STAGE(PG8_SA(0, 1), cA + hstep, voffA);
        if (wr == 1) PG8_BAR;
        PG8_WAIT_V(2); PG8_BAR;
        PG8_STAGE(PG8_SB(1, 0), cB + kstep, voffB); PG8_STAGE(PG8_SA(1, 0), cA + kstep, voffA); PG8_STAGE(PG8_SB(1, 1), cB + hstep + kstep, voffB);
        PG8_WAIT_V(6); PG8_BAR;
    } else {
        PG8_STAGE(PG8_SB(0, 0), cB, voffB); PG8_STAGE(PG8_SA(0, 0), cA, voffA); PG8_STAGE(PG8_SB(0, 1), cB + hstep, voffB); PG8_STAGE(PG8_SA(0, 1), cA + hstep, voffA);
        if (wr == 1) PG8_BAR;
        PG8_WAIT_V(4); PG8_BAR;
        PG8_STAGE(PG8_SB(1, 0), cB + kstep, voffB); PG8_STAGE(PG8_SA(1, 0), cA + kstep, voffA); PG8_STAGE(PG8_SB(1, 1), cB + hstep + kstep, voffB);
        PG8_WAIT_V(6); PG8_BAR;
    }
    for (;;) {
        const bool has_next = S.next(ui + 1, nxt);
        const char* nA = has_next ? (const char*)g.A + (size_t)nxt.pm * tstep : cA; const char* nB = has_next ? (const char*)g.Bt + (size_t)nxt.pn * tstep : cB;
        for (int t = 0; t < nt; t += 2) {
            const bool last = (t == nt - 2);
            const char* a1 = cA + (size_t)(t + 1) * kstep;
            const char* a2 = last ? nA : cA + (size_t)(t + 2) * kstep; const char* b2 = last ? nB : cB + (size_t)(t + 2) * kstep;
            const char* a3 = a2 + kstep; const char* b3 = b2 + kstep;
            if (last && has_next) S.a_ready(nxt);
            if constexpr (SP2) {
            PG8_LDB(B0, 0, 0); PG8_LDB(B1, 0, 1); PG8_SCHED; PG8_LDA(At, 0, 0); PG8_STAGE(PG8_SA(1, 1), a1 + hstep, voffA);
            PG8_WAIT_V(8); PG8_WAIT_L(0); PG8_BAR; PG8_MMA(0, 0, At, B0); PG8_MMA(0, 1, At, B1); PG8_BAR; PG8_SCHED;
            PG8_LDA(At, 0, 1); PG8_STAGE(PG8_SB(0, 0), b2, voffB); PG8_STAGE(PG8_SB(0, 1), b2 + hstep, voffB); PG8_STAGE(PG8_SA(0, 0), a2, voffA);
            PG8_WAIT_V(8); PG8_WAIT_L(0); PG8_BAR; PG8_MMA(1, 0, At, B0); PG8_MMA(1, 1, At, B1); PG8_BAR; PG8_SCHED;
            PG8_LDB(B0, 1, 0); PG8_LDB(B1, 1, 1); PG8_SCHED; PG8_LDA(At, 1, 0); PG8_STAGE(PG8_SA(0, 1), a2 + hstep, voffA);
            PG8_WAIT_V(8); PG8_WAIT_L(0); PG8_BAR; PG8_MMA(0, 0, At, B0); PG8_MMA(0, 1, At, B1); PG8_BAR; PG8_SCHED;
            PG8_LDA(At, 1, 1); PG8_STAGE(PG8_SB(1, 0), b3, voffB); PG8_STAGE(PG8_SB(1, 1), b3 + hstep, voffB); PG8_STAGE(PG8_SA(1, 0), a3, voffA);
            PG8_WAIT_V(8); PG8_WAIT_L(0); PG8_BAR; PG8_MMA(1, 0, At, B0); PG8_MMA(1, 1, At, B1); PG8_BAR; PG8_SCHED;
            } else {
            PG8_LDB(B0, 0, 0); PG8_SCHED; PG8_LDA(At, 0, 0); PG8_STAGE(PG8_SA(1, 1), a1 + hstep, voffA);
            PG8_WAIT_L(8); PG8_BAR; PG8_WAIT_L(0); PG8_MMA(0, 0, At, B0); PG8_BAR; PG8_SCHED;
            PG8_LDB(B1, 0, 1); PG8_STAGE(PG8_SB(0, 0), b2, voffB);
            PG8_BAR; PG8_WAIT_L(0); PG8_MMA(0, 1, At, B1); PG8_BAR;
            PG8_LDA(At, 0, 1); PG8_STAGE(PG8_SA(0, 0), a2, voffA);
            PG8_BAR; PG8_WAIT_L(0); PG8_MMA(1, 0, At, B0); PG8_BAR; PG8_SCHED;
            PG8_STAGE(PG8_SB(0, 1), b2 + hstep, voffB);
            PG8_WAIT_V(6); PG8_BAR; PG8_MMA(1, 1, At, B1); PG8_BAR;
            PG8_LDB(B0, 1, 0); PG8_SCHED; PG8_LDA(At, 1, 0); PG8_STAGE(PG8_SA(0, 1), a2 + hstep, voffA);
            PG8_WAIT_L(8); PG8_BAR; PG8_WAIT_L(0); PG8_MMA(0, 0, At, B0); PG8_BAR; PG8_SCHED;
            PG8_LDB(B1, 1, 1); PG8_STAGE(PG8_SB(1, 0), b3, voffB);
            PG8_BAR; PG8_WAIT_L(0); PG8_MMA(0, 1, At, B1); PG8_BAR;
            PG8_LDA(At, 1, 1); PG8_STAGE(PG8_SA(1, 0), a3, voffA);
            PG8_BAR; PG8_WAIT_L(0); PG8_MMA(1, 0, At, B0); PG8_BAR; PG8_SCHED;
            PG8_STAGE(PG8_SB(1, 1), b3 + hstep, voffB);
            PG8_WAIT_V(6); PG8_BAR; PG8_MMA(1, 1, At, B1); PG8_BAR;
            }
        }
        if constexpr (ALIGN_EPI) { if (wr == 0) PG8_BAR; }
        if constexpr (!Epi::AFTER_DRAIN) { E(acc, cur, wr, wc, fr, fq); S.done(cur); }
        if (!has_next) break;
#pragma unroll
        for (int a = 0; a < 2; ++a)
#pragma unroll
            for (int b = 0; b < 2; ++b)
#pragma unroll
                for (int m = 0; m < 4; ++m)
#pragma unroll
                    for (int n = 0; n < 2; ++n) acc[a][b][m][n] = (f32x4){0.f, 0.f, 0.f, 0.f};
        cur = nxt; cA = nA; cB = nB; ++ui;
        if constexpr (ALIGN_EPI) { if (wr == 1) PG8_BAR; }
    }
    PG8_WAIT_V(0);
    if constexpr (!ALIGN_EPI) { if (wr == 0) PG8_BAR; }
    PG8_BAR;
    if constexpr (Epi::AFTER_DRAIN) { E.fused(acc, cur, wr, wc, fr, fq, lds, wid, lane); S.done(cur); }
#undef PG8_SA
#undef PG8_SB
#undef PG8_STAGE
#undef PG8_LDA
#undef PG8_LDB
#undef PG8_MMA
#undef PG8_WAIT_V
#undef PG8_WAIT_L
#undef PG8_BAR
#undef PG8_SCHED
}
}
#define LAS __attribute__((address_space(3)))
#define XB_TMO      128
#define XB_XCNT(j)  (256  + 64 * (j))
#define XB_XSUB(j)  (1280 + 64 * (j))
#define XB_XGEN(j)  (2304 + 64 * (j))
#define XB_TOP      3328
#define XB_TOPGEN   3392
#define XCD_BAR_WORDS 3456
#define XB_SPIN_CAP (1u << 18)

__device__ __forceinline__ unsigned xb_ld(unsigned* p)              { return __hip_atomic_load(p, __ATOMIC_RELAXED, __HIP_MEMORY_SCOPE_AGENT); }
__device__ __forceinline__ unsigned xb_add(unsigned* p, unsigned v) { return __hip_atomic_fetch_add(p, v, __ATOMIC_RELAXED, __HIP_MEMORY_SCOPE_AGENT); }
__device__ __forceinline__ unsigned xb_xcc_id() { return (unsigned)__builtin_amdgcn_s_getreg((3 << 11) | 20) & 0xFu; }
#define XB_SPIN(cond, bar) do { unsigned _sp = 0; while (cond) { __builtin_amdgcn_s_sleep(1); \
    if ((++_sp & 255u) == 0u) { if (xb_ld(&(bar)[XB_TMO])) break; if (_sp > XB_SPIN_CAP) { atomicAdd(&(bar)[XB_TMO], 1u); break; } } } } while (0)

struct XcdBarrier {
    unsigned* bar; unsigned x;
    volatile LAS unsigned* st;
};

__device__ __forceinline__ XcdBarrier xcd_barrier_post(unsigned* bar, volatile LAS unsigned* st) {
    XcdBarrier b; b.bar = bar; b.x = xb_xcc_id(); b.st = st;
    if (threadIdx.x == 0) (void)xb_add(&bar[XB_XCNT(b.x)], 1u);
    return b;
}
__device__ __forceinline__ void xcd_barrier_complete(unsigned* bar, unsigned x, unsigned& nloc, unsigned& nx) {
    const unsigned G = gridDim.x * gridDim.y * gridDim.z;
    unsigned sum, cnt, mine, sp = 0u;
    for (;;) {
        sum = 0u; cnt = 0u; mine = 0u;
#pragma unroll
        for (unsigned j = 0; j < 16; ++j) { const unsigned c = xb_ld(&bar[XB_XCNT(j)]); sum += c; cnt += (c > 0u) ? 1u : 0u; mine = (j == x) ? c : mine; }
        if (sum == G) break;
        __builtin_amdgcn_s_sleep(1);
        if ((++sp & 255u) == 0u) { if (xb_ld(&bar[XB_TMO])) break; if (sp > XB_SPIN_CAP) { atomicAdd(&bar[XB_TMO], 1u); break; } }
    }
    nloc = mine > 0u ? mine : 1u; nx = cnt > 0u ? cnt : 1u;
}

__device__ __forceinline__ void xcd_barrier(const XcdBarrier& b) {
    asm volatile("s_waitcnt vmcnt(0)" ::: "memory");
    __syncthreads();
    if (threadIdx.x == 0) {
        unsigned* bar = b.bar;
        __builtin_amdgcn_s_waitcnt(0);
        unsigned nloc = b.st[0], nx = b.st[1];
        if (nloc == 0u) { xcd_barrier_complete(bar, b.x, nloc, nx); b.st[0] = nloc; b.st[1] = nx; }
        const unsigned old = xb_add(&bar[XB_XSUB(b.x)], 1u);
        const unsigned gen = old / nloc;
        if (old + 1u == (gen + 1u) * nloc) {
            __builtin_amdgcn_fence(__ATOMIC_RELEASE, "agent");
            asm volatile("s_waitcnt vmcnt(0)" ::: "memory");
            const unsigned og = xb_add(&bar[XB_TOP], 1u);
            const unsigned tg = og / nx;
            if (og + 1u == (tg + 1u) * nx) xb_add(&bar[XB_TOPGEN], 1u);
            else XB_SPIN(xb_ld(&bar[XB_TOPGEN]) == tg, bar);
            __builtin_amdgcn_fence(__ATOMIC_ACQUIRE, "agent");
            xb_add(&bar[XB_XGEN(b.x)], 1u);
            asm volatile("s_waitcnt vmcnt(0)" ::: "memory");
        } else {
            XB_SPIN(xb_ld(&bar[XB_XGEN(b.x)]) == gen, bar);
            __builtin_amdgcn_fence(__ATOMIC_ACQUIRE, "agent");
            asm volatile("s_waitcnt vmcnt(0)" ::: "memory");
        }
    }
    __syncthreads();
}

using pg8::bf16_t; using pg8::f32x4; using pg8::u32x4; using pg8::bf16x8; using pg8::pk_h2; using pg8::h_lo; using pg8::h_hi;
typedef unsigned u32x2v __attribute__((ext_vector_type(2)));
constexpr int DM = 1024, NPR = 16384, NSM = 128, MT = 16640, NVALID = 16512, SEQ = 2048;
constexpr int HW = 512, NIN = 2560, DFF = 2816, NFF2 = 5632, MEMR = 2048;
constexpr float EPS = 1e-6f;
constexpr int NTHREADS = 512;
constexpr int LDS_BYTES = 147456;

constexpr size_t O_YP = 0, O_YS = 16777216, O_HP = 16908288, O_PP = 17432576, O_MK = 17494016, O_MV = 19591168, O_HS = 21688320, O_PS = 30076928;

constexpr size_t MiB = 1u << 20;
constexpr size_t WS_SS1 = 0, WS_SS2 = 128 * 1024, WS_SS3 = 256 * 1024, WS_BAR = 512 * 1024, BAR_BYTES = 65536, WS_SSD = 384 * 1024, WS_SS0 = 640 * 1024, WS_CNT = WS_BAR + 16384;
constexpr size_t WS_WIN = 1 * MiB, WS_WOUT = 6 * MiB, WS_WCQ = 8 * MiB, WS_WCO = 10 * MiB, WS_WFFI = 12 * MiB, WS_WFFO = 23 * MiB, WS_WKV = 29 * MiB, WS_PMIX = 33 * MiB;
constexpr size_t WS_MEMH = 34 * MiB, WS_KB = 38 * MiB, WS_VT = 42 * MiB, WS_DEC = 46 * MiB;
constexpr size_t WS_H0 = 47 * MiB;
constexpr size_t WS_MIX = 80 * MiB;
constexpr size_t WS_X1 = 113 * MiB;
constexpr size_t WS_Q = 178 * MiB;
constexpr size_t WS_O = 211 * MiB;
constexpr size_t WS_SL = 244 * MiB;
constexpr size_t WS_A = 309 * MiB;
constexpr size_t WS_QQ = WS_A, WS_KK = WS_A + 17 * MiB, WS_VV = WS_A + 34 * MiB, WS_GG = WS_A + 51 * MiB, WS_LF = WS_A + 68 * MiB, WS_UU = WS_A + 101 * MiB;
constexpr size_t WS_END = 443 * MiB;

struct Args { const float* in[23]; float* out; unsigned char* ws; int ph_lo, ph_hi; };

typedef float f32x2_t __attribute__((ext_vector_type(2))); typedef __bf16 bf16x2_t __attribute__((ext_vector_type(2)));
__device__ __forceinline__ unsigned pk2(float lo, float hi) { const f32x2_t v = {lo, hi}; const bf16x2_t b = __builtin_convertvector(v, bf16x2_t); return __builtin_bit_cast(unsigned, b); }
__device__ __forceinline__ unsigned f2bf(float f) { return pk2(f, 0.f) & 0xffffu; }
__device__ __forceinline__ float bf2f(unsigned h) { return __uint_as_float(h << 16); }
__device__ __forceinline__ float bfe(const u32x4& v, int j) { const unsigned w = v[j >> 1]; return (j & 1) ? __uint_as_float(w & 0xffff0000u) : __uint_as_float(w << 16); }
__device__ __forceinline__ unsigned short bfr(const u32x4& v, int j) { const unsigned w = v[j >> 1]; return (unsigned short)((j & 1) ? (w >> 16) : (w & 0xffffu)); }
__device__ __forceinline__ float wave_sum(float v) {
#pragma unroll
    for (int o = 1; o < 64; o <<= 1) v += __shfl_xor(v, o);
    return v;
}
#define MFMA16(a, b, c) __builtin_amdgcn_mfma_f32_16x16x32_bf16((a), (b), (c), 0, 0, 0)

template <int MODE>
__device__ __forceinline__ void tr_item(const float* W, int K, int N, bf16_t* WT, const float* gk, float* scr, int item, int lane) {
    const int nblk = N / 32, kb = item / nblk, nb = item % nblk, k0 = 64 * kb, n0 = 32 * nb;
    f32x4 wv[8];
#pragma unroll
    for (int i = 0; i < 8; ++i) { const int kk = 8 * i + (lane >> 3); wv[i] = __builtin_nontemporal_load((const f32x4*)(W + (size_t)(k0 + kk) * N + n0 + (lane & 7) * 4)); }
#pragma unroll
    for (int i = 0; i < 8; ++i) { const int kk = 8 * i + (lane >> 3); float* d = scr + kk * 33 + (lane & 7) * 4; d[0] = wv[i][0]; d[1] = wv[i][1]; d[2] = wv[i][2]; d[3] = wv[i][3]; }
    asm volatile("s_waitcnt lgkmcnt(0)" ::: "memory");
    const int c = lane & 7;
    float g8[8];
#pragma unroll
    for (int i = 0; i < 8; ++i) g8[i] = gk ? gk[k0 + 8 * c + i] : 1.0f;
#pragma unroll
    for (int j = 0; j < 4; ++j) { const int n = (lane >> 3) + 8 * j; const float* s = scr + (8 * c) * 33 + n;
        u32x4 o; o.x = pk2(s[0 * 33] * g8[0], s[1 * 33] * g8[1]); o.y = pk2(s[2 * 33] * g8[2], s[3 * 33] * g8[3]); o.z = pk2(s[4 * 33] * g8[4], s[5 * 33] * g8[5]); o.w = pk2(s[6 * 33] * g8[6], s[7 * 33] * g8[7]);
        int row = n0 + n;
        if (MODE == 1) { const int half = row >= DFF ? 1 : 0; const int J = row - half * DFF;
            row = 256 * (J >> 7) + 128 * half + (J & 127); }
        *(u32x4*)(WT + (size_t)row * K + k0 + 8 * c) = o; }
    asm volatile("s_waitcnt lgkmcnt(0)" ::: "memory");
}
__device__ __forceinline__ void rms_row_to_bf16(const float* xrow, const float* g, bf16_t* orow, int lane) {
    const f32x4* xr = (const f32x4*)xrow + lane; const f32x4* gr = (const f32x4*)g + lane;
    f32x4 v[4]; float s = 0.f;
#pragma unroll
    for (int j = 0; j < 4; ++j) { v[j] = xr[64 * j]; s += (v[j].x * v[j].x + v[j].y * v[j].y) + (v[j].z * v[j].z + v[j].w * v[j].w); }
    const float rstd = 1.0f / sqrtf(wave_sum(s) * (1.f / DM) + EPS);
    unsigned long long* o8 = (unsigned long long*)orow + lane;
#pragma unroll
    for (int j = 0; j < 4; ++j) { const f32x4 gg = gr[64 * j];
        o8[64 * j] = (unsigned long long)pk2(v[j].x * rstd * gg.x, v[j].y * rstd * gg.y) | ((unsigned long long)pk2(v[j].z * rstd * gg.z, v[j].w * rstd * gg.w) << 32); }
}
__device__ __forceinline__ void x_row2_to_bf16(const float* xrow, bf16_t* orow, float* ssrow, int lane) {
    const f32x4* xr = (const f32x4*)xrow + lane;
    f32x4 v[2][4]; float s[2] = {0.f, 0.f};
#pragma unroll
    for (int r = 0; r < 2; ++r)
#pragma unroll
        for (int j = 0; j < 4; ++j) v[r][j] = __builtin_nontemporal_load(xr + r * 256 + 64 * j);
#pragma unroll
    for (int r = 0; r < 2; ++r)
#pragma unroll
        for (int j = 0; j < 4; ++j) s[r] += (v[r][j].x * v[r][j].x + v[r][j].y * v[r][j].y) + (v[r][j].z * v[r][j].z + v[r][j].w * v[r][j].w);
#pragma unroll
    for (int r = 0; r < 2; ++r) { const float tot = wave_sum(s[r]); if (lane == 0) ssrow[r] = tot; unsigned long long* o8 = (unsigned long long*)(orow + (size_t)r * DM) + lane;
#pragma unroll
        for (int j = 0; j < 4; ++j) o8[64 * j] = (unsigned long long)pk2(v[r][j].x, v[r][j].y) | ((unsigned long long)pk2(v[r][j].z, v[r][j].w) << 32); }
}
__device__ __forceinline__ void rms_row2_to_bf16(const float* xrow, const float* g, bf16_t* orow, int lane) {
    const f32x4* xr = (const f32x4*)xrow + lane; const f32x4* gr = (const f32x4*)g + lane;
    f32x4 v[2][4]; float s[2] = {0.f, 0.f};
#pragma unroll
    for (int r = 0; r < 2; ++r)
#pragma unroll
        for (int j = 0; j < 4; ++j) v[r][j] = __builtin_nontemporal_load(xr + r * 256 + 64 * j);
#pragma unroll
    for (int r = 0; r < 2; ++r)
#pragma unroll
        for (int j = 0; j < 4; ++j) s[r] += (v[r][j].x * v[r][j].x + v[r][j].y * v[r][j].y) + (v[r][j].z * v[r][j].z + v[r][j].w * v[r][j].w);
#pragma unroll
    for (int r = 0; r < 2; ++r) { const float rstd = 1.0f / sqrtf(wave_sum(s[r]) * (1.f / DM) + EPS); unsigned long long* o8 = (unsigned long long*)(orow + (size_t)r * DM) + lane;
#pragma unroll
        for (int j = 0; j < 4; ++j) { const f32x4 gg = gr[64 * j];
            o8[64 * j] = (unsigned long long)pk2(v[r][j].x * rstd * gg.x, v[r][j].y * rstd * gg.y) | ((unsigned long long)pk2(v[r][j].z * rstd * gg.z, v[r][j].w * rstd * gg.w) << 32); } }
}
__device__ __forceinline__ void p0_prologue(const Args& A, unsigned char* lds, int G) {
    const int tid = threadIdx.x, lane = tid & 63, wave = tid >> 6;
    float* scr = (float*)(lds + wave * 16384);
    unsigned char* ws = A.ws;
    const int gw = blockIdx.x * 8 + wave, NGW = G * 8;
    constexpr int I_IN = 16 * 80, I_OUT = 16 * 32, I_CQ = 16 * 32, I_CO = 16 * 32, I_FFI = 16 * 176, I_FFO = 44 * 32, I_KV = 16 * 64, I_PM = 4 * 8;
    constexpr int NITEMS = I_IN + I_OUT + I_CQ + I_CO + I_FFI + I_FFO + I_KV + I_PM;
    for (int it = gw; it < NITEMS; it += NGW) {
        int r = it;
        if (r < I_IN) { tr_item<0>(A.in[8], DM, NIN, (bf16_t*)(ws + WS_WIN), A.in[7], scr, r, lane); continue; } r -= I_IN;
        if (r < I_OUT) { tr_item<0>(A.in[13], DM, DM, (bf16_t*)(ws + WS_WOUT), nullptr, scr, r, lane); continue; } r -= I_OUT;
        if (r < I_CQ) { tr_item<0>(A.in[17], DM, DM, (bf16_t*)(ws + WS_WCQ), A.in[16], scr, r, lane); continue; } r -= I_CQ;
        if (r < I_CO) { tr_item<0>(A.in[18], DM, DM, (bf16_t*)(ws + WS_WCO), nullptr, scr, r, lane); continue; } r -= I_CO;
        if (r < I_FFI) { tr_item<1>(A.in[20], DM, NFF2, (bf16_t*)(ws + WS_WFFI), A.in[19], scr, r, lane); continue; } r -= I_FFI;
        if (r < I_FFO) { tr_item<0>(A.in[21], DFF, DM, (bf16_t*)(ws + WS_WFFO), nullptr, scr, r, lane); continue; } r -= I_FFO;
        if (r < I_KV) { tr_item<0>(A.in[15], DM, 2 * DM, (bf16_t*)(ws + WS_WKV), nullptr, scr, r, lane); continue; } r -= I_KV;
        { const int g = r >> 3; tr_item<0>(A.in[11] + (size_t)g * 128 * 128, 128, 128, (bf16_t*)(ws + WS_PMIX) + (size_t)g * 128 * 128, nullptr, scr, r & 7, lane); }
    }
    bf16_t* H0 = (bf16_t*)(ws + WS_H0);
    for (int m = gw * 2; m < NVALID; m += NGW * 2) { const float* xr = m < NPR ? A.in[0] + (size_t)m * DM : A.in[1] + (size_t)(m - NPR) * DM; x_row2_to_bf16(xr, H0 + (size_t)m * DM, (float*)(ws + WS_SS0) + m, lane); }
    bf16_t* MEMH = (bf16_t*)(ws + WS_MEMH);
    for (int m = gw; m < MEMR; m += NGW) rms_row_to_bf16(A.in[2] + (size_t)m * DM, A.in[14], MEMH + (size_t)m * DM, lane);
    const int gt = blockIdx.x * NTHREADS + tid, NGT = G * NTHREADS;
    for (int i = gt; i < (MT - NVALID) * DM / 8; i += NGT) { const u32x4 z = {0u, 0u, 0u, 0u};
        ((u32x4*)(ws + WS_H0) + (size_t)NVALID * DM / 8)[i] = z; ((u32x4*)(ws + WS_MIX) + (size_t)NVALID * DM / 8)[i] = z; ((u32x4*)(ws + WS_O) + (size_t)NVALID * DM / 8)[i] = z; }
    for (int i = NVALID + gt; i < MT; i += NGT) ((float*)(ws + WS_SS0))[i] = 0.f;
    for (int i = gt; i < MT; i += NGT) { ((float*)(ws + WS_SS1))[i] = 0.f; ((float*)(ws + WS_SS2))[i] = 0.f; ((float*)(ws + WS_SS3))[i] = 0.f; }
}

constexpr int BS = 129;
constexpr int L_BC = 0, L_TOT = 33024, L_QM = 35072, L_KM = 52480, L_VT = 69888, L_SP = 88320, L_AL = 123136, L_PART = 132352, L_EM = 132864;
constexpr size_t WS_SPT = WS_X1;
__device__ __forceinline__ void hgrn_lf_load(u32x2v (&lf)[4], const unsigned short* LF, int R0, int C0, int t) {
#pragma unroll
    for (int i = 0; i < 4; ++i) { const int idx = i * 512 + t, s = idx >> 5, k4 = idx & 31; lf[i] = *(const u32x2v*)(LF + (size_t)(R0 + s) * HW + C0 + k4 * 4); }
}
__device__ __forceinline__ void hgrn_cumsum(const u32x2v (&lf)[4], float* Bc, float* tot, int t) {
#pragma unroll
    for (int i = 0; i < 4; ++i) { const int idx = i * 512 + t, s = idx >> 5, k4 = idx & 31; const u32x2v v = lf[i];
        float* d = Bc + s * BS + k4 * 4; d[0] = h_lo(v.x); d[1] = h_hi(v.x); d[2] = h_lo(v.y); d[3] = h_hi(v.y); }
    __syncthreads();
    const int seg = t >> 7, k = t & 127; float run = 0.f;
#pragma unroll
    for (int i = 0; i < 16; ++i) { run += Bc[(seg * 16 + i) * BS + k]; Bc[(seg * 16 + i) * BS + k] = run; }
    tot[seg * 128 + k] = run;
    __syncthreads();
    float off = 0.f;
#pragma unroll
    for (int j = 0; j < 3; ++j) off += (j < seg) ? tot[j * 128 + k] : 0.f;
#pragma unroll
    for (int i = 0; i < 16; ++i) Bc[(seg * 16 + i) * BS + k] += off;
    __syncthreads();
}
__device__ __forceinline__ void hgrn_local_load(const Args& A, int unit, u32x2v (&lf)[4], u32x4 (&kkr)[2], u32x4 (&vvr)[2]) {
    const int t = threadIdx.x, w = t >> 6, l = t & 63;
    const int bh = unit >> 5, c = unit & 31, b = bh >> 2, h = bh & 3, R0 = b * SEQ + c * 64, C0 = h * 128;
    const bf16_t* KK = (const bf16_t*)(A.ws + WS_KK); const bf16_t* VV = (const bf16_t*)(A.ws + WS_VV);
    hgrn_lf_load(lf, (const unsigned short*)(A.ws + WS_LF), R0, C0, t);
#pragma unroll
    for (int i = 0; i < 2; ++i) { const int k0 = (w + 8 * i) * 8; kkr[i] = *(const u32x4*)(KK + (size_t)(R0 + l) * HW + C0 + k0); vvr[i] = *(const u32x4*)(VV + (size_t)(R0 + l) * HW + C0 + k0); }
}
__device__ __forceinline__ void hgrn_local_unit(const Args& A, unsigned char* lds, int unit, int next, u32x2v (&lf)[4], u32x4 (&kkr)[2], u32x4 (&vvr)[2]) {
    const int t = threadIdx.x, w = t >> 6, l = t & 63, lr = l & 15, lq = l >> 4;
    const int bh = unit >> 5, c = unit & 31, b = bh >> 2, h = bh & 3, R0 = b * SEQ + c * 64, C0 = h * 128;
    unsigned char* ws = A.ws;
    float* Bc = (float*)(lds + L_BC); float* tot = (float*)(lds + L_TOT);
    bf16_t* kdT = (bf16_t*)(lds + L_QM); bf16_t* vT = (bf16_t*)(lds + L_VT);
    hgrn_cumsum(lf, Bc, tot, t);
#pragma unroll
    for (int i = 0; i < 2; ++i) { const int s = l, k0 = (w + 8 * i) * 8;
        const u32x4 kk = kkr[i], vv = vvr[i];
#pragma unroll
        for (int j = 0; j < 8; ++j) { const float e = __expf(Bc[63 * BS + k0 + j] - Bc[s * BS + k0 + j]);
            kdT[(k0 + j) * 72 + s] = (bf16_t)f2bf(bfe(kk, j) * e); vT[(k0 + j) * 72 + s] = bfr(vv, j); } }
    if (next >= 0) hgrn_local_load(A, next, lf, kkr, vvr);
    __syncthreads();
    f32x4 acc[8];
#pragma unroll
    for (int i = 0; i < 8; ++i) acc[i] = (f32x4){0.f, 0.f, 0.f, 0.f};
#pragma unroll
    for (int ks = 0; ks < 2; ++ks) { const bf16x8 a = *(const bf16x8*)(kdT + (16 * w + lr) * 72 + ks * 32 + lq * 8);
#pragma unroll
        for (int vt = 0; vt < 8; ++vt) { const bf16x8 bb = *(const bf16x8*)(vT + (16 * vt + lr) * 72 + ks * 32 + lq * 8); acc[vt] = MFMA16(a, bb, acc[vt]); } }
    unsigned short* SLT = (unsigned short*)(ws + WS_SL) + (size_t)unit * 16384;
#pragma unroll
    for (int vt = 0; vt < 8; ++vt) { u32x2v o; o.x = pk_h2(acc[vt][0], acc[vt][1]); o.y = pk_h2(acc[vt][2], acc[vt][3]); *(u32x2v*)(SLT + (16 * vt + lr) * 128 + 16 * w + lq * 4) = o; }
    if (t < 128) ((float*)(ws + WS_DEC))[unit * 128 + t] = __expf(Bc[63 * BS + t]);
    __syncthreads();
}
__device__ __forceinline__ void hgrn_out_load(const Args& A, int unit, u32x2v (&lf)[4], u32x4 (&qqr)[2], u32x4 (&kkr)[2], u32x4 (&vvr)[2], u32x4 (&spr)[4]) {
    const int t = threadIdx.x, w = t >> 6, l = t & 63;
    const int bh = unit >> 5, c = unit & 31, b = bh >> 2, h = bh & 3, R0 = b * SEQ + c * 64, C0 = h * 128;
    const bf16_t* QQ = (const bf16_t*)(A.ws + WS_QQ); const bf16_t* KK = (const bf16_t*)(A.ws + WS_KK); const bf16_t* VV = (const bf16_t*)(A.ws + WS_VV);
    hgrn_lf_load(lf, (const unsigned short*)(A.ws + WS_LF), R0, C0, t);
#pragma unroll
    for (int i = 0; i < 2; ++i) { const int idx = (i * 512 + t) * 8, s = idx >> 7, k0 = idx & 127; const size_t go = (size_t)(R0 + s) * HW + C0 + k0; qqr[i] = *(const u32x4*)(QQ + go); kkr[i] = *(const u32x4*)(KK + go);
        vvr[i] = *(const u32x4*)(VV + (size_t)(R0 + l) * HW + C0 + (w + 8 * i) * 8); }
    const bf16_t* SPT = (const bf16_t*)(A.ws + WS_SPT) + (size_t)unit * 16384;
#pragma unroll
    for (int i = 0; i < 4; ++i) { const int idx = i * 512 + t; spr[i] = *(const u32x4*)(SPT + (idx >> 4) * 128 + (idx & 15) * 8); }
}
__device__ __forceinline__ void hgrn_out_unit(const Args& A, unsigned char* lds, int unit, int next, u32x2v (&lf)[4], u32x4 (&qqr)[2], u32x4 (&kkr)[2], u32x4 (&vvr)[2], u32x4 (&spr)[4]) {
    const int t = threadIdx.x, w = t >> 6, l = t & 63, lr = l & 15, lq = l >> 4;
    const int bh = unit >> 5, c = unit & 31, b = bh >> 2, h = bh & 3, R0 = b * SEQ + c * 64, C0 = h * 128;
    unsigned char* ws = A.ws;
    float* Bc = (float*)(lds + L_BC); float* tot = (float*)(lds + L_TOT); float* part = (float*)(lds + L_PART); float* em = (float*)(lds + L_EM);
    bf16_t* qm = (bf16_t*)(lds + L_QM); bf16_t* km = (bf16_t*)(lds + L_KM); bf16_t* vT = (bf16_t*)(lds + L_VT); bf16_t* spT = (bf16_t*)(lds + L_SP); bf16_t* aL = (bf16_t*)(lds + L_AL);
    u32x4 ggr[2];
#pragma unroll
    for (int hh = 0; hh < 2; ++hh) ggr[hh] = *(const u32x4*)((const bf16_t*)(ws + WS_GG) + (size_t)(R0 + (t >> 3)) * HW + C0 + (t & 7) * 16 + hh * 8);
    hgrn_cumsum(lf, Bc, tot, t);
    if (t < 128) em[t] = __expf(Bc[31 * BS + t]);
#pragma unroll
    for (int i = 0; i < 2; ++i) { const int idx = (i * 512 + t) * 8, s = idx >> 7, k0 = idx & 127;
        const u32x4 qq = qqr[i], kk = kkr[i];
        float qv[8], kv[8];
#pragma unroll
        for (int j = 0; j < 8; ++j) { const float d = Bc[s * BS + k0 + j] - Bc[31 * BS + k0 + j]; qv[j] = bfe(qq, j) * __expf(d); kv[j] = bfe(kk, j) * __expf(-d); }
        u32x4 o; o.x = pk2(qv[0], qv[1]); o.y = pk2(qv[2], qv[3]); o.z = pk2(qv[4], qv[5]); o.w = pk2(qv[6], qv[7]); *(u32x4*)(qm + s * 136 + k0) = o;
        o.x = pk2(kv[0], kv[1]); o.y = pk2(kv[2], kv[3]); o.z = pk2(kv[4], kv[5]); o.w = pk2(kv[6], kv[7]); *(u32x4*)(km + s * 136 + k0) = o; }
#pragma unroll
    for (int i = 0; i < 2; ++i) { const int s = l, k0 = (w + 8 * i) * 8; const u32x4 vv = vvr[i];
#pragma unroll
        for (int j = 0; j < 8; ++j) vT[(k0 + j) * 72 + s] = bfr(vv, j); }
    __syncthreads();
    {
#pragma unroll
        for (int i = 0; i < 4; ++i) { const int idx = i * 512 + t, v = idx >> 4, k0 = (idx & 15) * 8; const u32x4 sv = spr[i];
            u32x4 o; o.x = pk2(bfe(sv, 0) * em[k0], bfe(sv, 1) * em[k0 + 1]); o.y = pk2(bfe(sv, 2) * em[k0 + 2], bfe(sv, 3) * em[k0 + 3]); o.z = pk2(bfe(sv, 4) * em[k0 + 4], bfe(sv, 5) * em[k0 + 5]); o.w = pk2(bfe(sv, 6) * em[k0 + 6], bfe(sv, 7) * em[k0 + 7]);
            *(u32x4*)(spT + v * 136 + k0) = o; } }
    if (next >= 0) hgrn_out_load(A, next, lf, qqr, kkr, vvr, spr);
    {
        const int ct = w & 3;
        f32x4 a2[2]; a2[0] = (f32x4){0.f, 0.f, 0.f, 0.f}; a2[1] = a2[0];
#pragma unroll
        for (int ks = 0; ks < 4; ++ks) { const bf16x8 a = *(const bf16x8*)(qm + (16 * ct + lr) * 136 + ks * 32 + lq * 8);
#pragma unroll
            for (int i = 0; i < 2; ++i) { const int st = (w >> 2) * 2 + i; const bf16x8 bb = *(const bf16x8*)(km + (16 * st + lr) * 136 + ks * 32 + lq * 8); a2[i] = MFMA16(a, bb, a2[i]); } }
#pragma unroll
        for (int i = 0; i < 2; ++i) { const int st = (w >> 2) * 2 + i, s = 16 * st + lr;
#pragma unroll
            for (int r = 0; r < 4; ++r) { const int cc = 16 * ct + lq * 4 + r; aL[cc * 72 + s] = (bf16_t)f2bf(s <= cc ? a2[i][r] : 0.f); } }
    }
    __syncthreads();
    const int ct = w & 3, vh = w >> 2;
    f32x4 o4[4];
#pragma unroll
    for (int i = 0; i < 4; ++i) o4[i] = (f32x4){0.f, 0.f, 0.f, 0.f};
#pragma unroll
    for (int ks = 0; ks < 4; ++ks) { const bf16x8 a = *(const bf16x8*)(qm + (16 * ct + lr) * 136 + ks * 32 + lq * 8);
#pragma unroll
        for (int i = 0; i < 4; ++i) { const int vt = vh * 4 + i; const bf16x8 bb = *(const bf16x8*)(spT + (16 * vt + lr) * 136 + ks * 32 + lq * 8); o4[i] = MFMA16(a, bb, o4[i]); } }
#pragma unroll
    for (int ks = 0; ks < 2; ++ks) { const bf16x8 a = *(const bf16x8*)(aL + (16 * ct + lr) * 72 + ks * 32 + lq * 8);
#pragma unroll
        for (int i = 0; i < 4; ++i) { const int vt = vh * 4 + i; const bf16x8 bb = *(const bf16x8*)(vT + (16 * vt + lr) * 72 + ks * 32 + lq * 8); o4[i] = MFMA16(a, bb, o4[i]); } }
    float* ost = (float*)(lds + L_BC);
#pragma unroll
    for (int r = 0; r < 4; ++r) { float s = 0.f;
#pragma unroll
        for (int i = 0; i < 4; ++i) { s += o4[i][r] * o4[i][r]; ost[(16 * ct + lq * 4 + r) * 132 + (vh * 4 + i) * 16 + lr] = o4[i][r]; }
        s += __shfl_xor(s, 1); s += __shfl_xor(s, 2); s += __shfl_xor(s, 4); s += __shfl_xor(s, 8);
        if (lr == 0) part[vh * 64 + 16 * ct + lq * 4 + r] = s; }
    __syncthreads();
    {   const float* hn = A.in[10]; bf16_t* MIX = (bf16_t*)(ws + WS_MIX);
        const int cc = t >> 3, v0 = (t & 7) * 16; const float rstd = __builtin_amdgcn_rsqf((part[cc] + part[64 + cc]) * (1.0f / 128.0f) + EPS);
#pragma unroll
        for (int hh = 0; hh < 2; ++hh) { const int v = v0 + hh * 8; const u32x4 g8 = ggr[hh];
            const f32x4 oa = *(const f32x4*)(ost + cc * 132 + v), ob = *(const f32x4*)(ost + cc * 132 + v + 4), na = *(const f32x4*)(hn + C0 + v), nb = *(const f32x4*)(hn + C0 + v + 4);
            u32x4 o; o.x = pk2(oa[0] * rstd * na[0] * bfe(g8, 0), oa[1] * rstd * na[1] * bfe(g8, 1)); o.y = pk2(oa[2] * rstd * na[2] * bfe(g8, 2), oa[3] * rstd * na[3] * bfe(g8, 3));
            o.z = pk2(ob[0] * rstd * nb[0] * bfe(g8, 4), ob[1] * rstd * nb[1] * bfe(g8, 5)); o.w = pk2(ob[2] * rstd * nb[2] * bfe(g8, 6), ob[3] * rstd * nb[3] * bfe(g8, 7));
            *(u32x4*)(MIX + (size_t)(R0 + cc) * DM + C0 + v) = o; } }
    __syncthreads();
}
__device__ __forceinline__ void hgrn_scan(const Args& A, int G) {
    const u32x2v* SLT = (const u32x2v*)(A.ws + WS_SL); const f32x4* DEC4 = (const f32x4*)(A.ws + WS_DEC); u32x2v* SPT = (u32x2v*)(A.ws + WS_SPT); float* outp = A.out + O_HP;
    for (int e = blockIdx.x * NTHREADS + threadIdx.x; e < 32 * 4096; e += G * NTHREADS) { const int bh = e >> 12, i4 = e & 4095, v = i4 >> 5, k4 = i4 & 31;
        f32x4 S = (f32x4){0.f, 0.f, 0.f, 0.f};
        const u32x2v* p = SLT + (size_t)bh * 32 * 4096 + i4; u32x2v* q = SPT + (size_t)bh * 32 * 4096 + i4; const f32x4* dp = DEC4 + (size_t)bh * 32 * 32 + k4;
#pragma unroll
        for (int hf = 0; hf < 2; ++hf) { u32x2v loc[16]; f32x4 dd[16];
#pragma unroll
            for (int c = 0; c < 16; ++c) { loc[c] = p[(size_t)(hf * 16 + c) * 4096]; dd[c] = dp[(hf * 16 + c) * 32]; }
#pragma unroll
            for (int c = 0; c < 16; ++c) { u32x2v o; o.x = pk2(S[0], S[1]); o.y = pk2(S[2], S[3]); q[(size_t)(hf * 16 + c) * 4096] = o; const f32x4 lv = (f32x4){h_lo(loc[c].x), h_hi(loc[c].x), h_lo(loc[c].y), h_hi(loc[c].y)}; S = S * dd[c] + lv; } }
        float* ob = outp + (size_t)bh * 16384 + (k4 * 4) * 128 + v; ob[0] = S[0]; ob[128] = S[1]; ob[256] = S[2]; ob[384] = S[3]; }
}
__device__ __forceinline__ void pool_states(const Args& A, int G) {
    const unsigned short* UU = (const unsigned short*)(A.ws + WS_UU);
    const int gt = blockIdx.x * NTHREADS + threadIdx.x, NGT = G * NTHREADS;
    for (int i = gt; i < 8 * 15 * 128; i += NGT) { const int c4 = i & 127, j = (i >> 7) % 15, b = i / (15 * 128); const u32x2v v = *(const u32x2v*)(UU + (size_t)(b * SEQ + 2033 + j) * HW + c4 * 4);
        *(f32x4*)(A.out + O_PP + (size_t)i * 4) = (f32x4){h_lo(v.x), h_hi(v.x), h_lo(v.y), h_hi(v.y)}; }
    for (int i0 = gt * 2; i0 < 128 * 15 * 128; i0 += NGT * 2) { f32x4 v[2];
#pragma unroll
        for (int q = 0; q < 2; ++q) { const int i = i0 + q, c4 = i & 127, j = (i >> 7) % 15, b = i / (15 * 128);
            if (j < 14) v[q] = *(const f32x4*)(A.in[4] + (size_t)(b * 15 + j + 1) * 512 + c4 * 4);
            else { const u32x2v h = *(const u32x2v*)(UU + (size_t)(NPR + b) * HW + c4 * 4); v[q] = (f32x4){h_lo(h.x), h_hi(h.x), h_lo(h.y), h_hi(h.y)}; } }
#pragma unroll
        for (int q = 0; q < 2; ++q) *(f32x4*)(A.out + O_PS + (size_t)(i0 + q) * 4) = v[q]; }
}
__device__ __forceinline__ void hgrn_sample_load(const Args& A, int unit, f32x4 (&sreg)[8]) {
    const int t = threadIdx.x; const float* S0 = A.in[3] + (size_t)unit * 16384;
#pragma unroll
    for (int i = 0; i < 8; ++i) sreg[i] = __builtin_nontemporal_load((const f32x4*)(S0 + ((t >> 5) * 8 + i) * 128 + (t & 31) * 4));
}
__device__ __forceinline__ void hgrn_sample_unit(const Args& A, unsigned char* lds, int unit, int next, f32x4 (&sreg)[8]) {
    const int t = threadIdx.x, b = unit >> 2, h = unit & 3, row = NPR + b, C0 = h * 128;
    unsigned char* ws = A.ws;
    float* qs = (float*)lds; float* ks = qs + 128; float* fs = ks + 128; float* vs = fs + 128; float* po = vs + 128;
    float* red = po + 16 * 128;
    float* S1 = A.out + O_HS + (size_t)unit * 16384;
    if (t < 128) { const size_t go = (size_t)row * HW + C0 + t;
        qs[t] = bf2f(((const bf16_t*)(ws + WS_QQ))[go]); ks[t] = bf2f(((const bf16_t*)(ws + WS_KK))[go]); fs[t] = __expf((float)__builtin_bit_cast(_Float16, ((const unsigned short*)(ws + WS_LF))[go])); vs[t] = bf2f(((const bf16_t*)(ws + WS_VV))[go]); }
    __syncthreads();
    const int v4 = t & 31, kg = t >> 5;
    const f32x4 vv = *(const f32x4*)(vs + v4 * 4);
    f32x4 o = (f32x4){0.f, 0.f, 0.f, 0.f};
#pragma unroll
    for (int i = 0; i < 8; ++i) { const int k = kg * 8 + i; const f32x4 s = sreg[i]; const f32x4 sn = s * fs[k] + vv * ks[k]; __builtin_nontemporal_store(sn, (f32x4*)(S1 + k * 128 + v4 * 4)); o += sn * qs[k]; }
    *(f32x4*)(po + kg * 128 + v4 * 4) = o;
    if (next >= 0) hgrn_sample_load(A, next, sreg);
    __syncthreads();
    float ov = 0.f;
    if (t < 128) {
#pragma unroll
        for (int i = 0; i < 16; ++i) ov += po[i * 128 + t];
        const float sq = wave_sum(ov * ov); if ((t & 63) == 0) red[t >> 6] = sq; }
    __syncthreads();
    if (t < 128) { const float rstd = __builtin_amdgcn_rsqf((red[0] + red[1]) * (1.0f / 128.0f) + EPS); const float g = bf2f(((const bf16_t*)(ws + WS_GG))[(size_t)row * HW + C0 + t]);
        ((bf16_t*)(ws + WS_MIX))[(size_t)row * DM + C0 + t] = (bf16_t)f2bf(ov * rstd * A.in[10][C0 + t] * g); }
    __syncthreads();
}

constexpr int LP_EXT = 0, LP_PL = 40448, LP_MX = 57856;
__device__ __forceinline__ void pool_load(const Args& A, int unit, u32x4 (&mreg)[4], u32x2v (&ereg)[5]) {
    const int t = threadIdx.x; const int tt = unit >> 2, g = unit & 3;
    const unsigned short* UU = (const unsigned short*)(A.ws + WS_UU);
    const bf16_t* PM = (const bf16_t*)(A.ws + WS_PMIX) + (size_t)g * 16384;
#pragma unroll
    for (int i = 0; i < 4; ++i) { const int idx = i * 512 + t, d = idx >> 4, c8 = idx & 15; mreg[i] = *(const u32x4*)(PM + d * 128 + c8 * 8); }
    const int b = tt >> 5, t0 = (tt & 31) * 64;
#pragma unroll
    for (int i5 = 0; i5 < 5; ++i5) { const int idx = i5 * 512 + t, i = idx >> 5, c4 = idx & 31; const int tp = t0 - 15 + i;
        ereg[i5] = (u32x2v){0u, 0u}; if (idx < 79 * 32 && tp >= 0) ereg[i5] = *(const u32x2v*)(UU + (size_t)(b * SEQ + tp) * HW + g * 128 + c4 * 4); }
}
__device__ __forceinline__ void pool_unit(const Args& A, unsigned char* lds, int unit, int next, u32x4 (&mreg)[4], u32x2v (&ereg)[5]) {
    const int t = threadIdx.x, w = t >> 6, l = t & 63, lr = l & 15, lq = l >> 4;
    const int tt = unit >> 2, g = unit & 3, win = 2 << g;
    unsigned char* ws = A.ws;
    float* ext = (float*)(lds + LP_EXT); bf16_t* pl = (bf16_t*)(lds + LP_PL); bf16_t* mx = (bf16_t*)(lds + LP_MX);
    const unsigned short* UU = (const unsigned short*)(ws + WS_UU);
    {
#pragma unroll
        for (int i = 0; i < 4; ++i) { const int idx = i * 512 + t, d = idx >> 4, c8 = idx & 15; *(u32x4*)(mx + d * 136 + c8 * 8) = mreg[i]; }
    }
    int rowbase;
    {
        const int b = tt >> 5, t0 = (tt & 31) * 64; rowbase = b * SEQ + t0;
#pragma unroll
        for (int i5 = 0; i5 < 5; ++i5) { const int idx = i5 * 512 + t, i = idx >> 5, c4 = idx & 31; if (idx < 79 * 32) *(f32x4*)(ext + i * 128 + c4 * 4) = (f32x4){h_lo(ereg[i5].x), h_hi(ereg[i5].x), h_lo(ereg[i5].y), h_hi(ereg[i5].y)}; }
        if (next >= 0) pool_load(A, next, mreg, ereg);
        __syncthreads();
        const int cch = t & 127, tg = t >> 7, tk0 = tg * 16;
        float nw[16], od[16], ini[16];
#pragma unroll
        for (int i = 0; i < 16; ++i) { nw[i] = ext[(15 + tk0 + i) * 128 + cch]; od[i] = (i >= 1) ? ext[(15 + tk0 + i - win) * 128 + cch] : 0.f; ini[i] = (i >= 1 && i < win) ? ext[(15 + tk0 - i) * 128 + cch] : 0.f; }
        float sw = 0.f;
#pragma unroll
        for (int i = 1; i < 16; ++i) sw += ini[i];
#pragma unroll
        for (int i = 0; i < 16; ++i) { const int tok = tk0 + i; sw += nw[i]; sw -= od[i];
            const int cnt = min(t0 + tok + 1, win);
            pl[tok * 136 + cch] = (bf16_t)f2bf(sw * __builtin_amdgcn_rcpf((float)cnt) - nw[i]); }
    }
    __syncthreads();
    const int ct = w & 3, dh = w >> 2;
    f32x4 o4[4];
#pragma unroll
    for (int i = 0; i < 4; ++i) o4[i] = (f32x4){0.f, 0.f, 0.f, 0.f};
#pragma unroll
    for (int ks = 0; ks < 4; ++ks) { const bf16x8 a = *(const bf16x8*)(pl + (16 * ct + lr) * 136 + ks * 32 + lq * 8);
#pragma unroll
        for (int i = 0; i < 4; ++i) { const int dt = dh * 4 + i; const bf16x8 bb = *(const bf16x8*)(mx + (16 * dt + lr) * 136 + ks * 32 + lq * 8); o4[i] = MFMA16(a, bb, o4[i]); } }
    bf16_t* MIX = (bf16_t*)(ws + WS_MIX); const float* psc = A.in[12];
    float* ost = (float*)(lds + LP_EXT);
#pragma unroll
    for (int i = 0; i < 4; ++i) { const int d = (dh * 4 + i) * 16 + lr; const float sc = psc[g * 128 + d];
#pragma unroll
        for (int r = 0; r < 4; ++r) ost[(16 * ct + lq * 4 + r) * 132 + d] = o4[i][r] * sc; }
    __syncthreads();
    {   const int tok = t >> 3, d0 = (t & 7) * 16;
#pragma unroll
        for (int hh = 0; hh < 2; ++hh) { const f32x4 oa = *(const f32x4*)(ost + tok * 132 + d0 + hh * 8), ob = *(const f32x4*)(ost + tok * 132 + d0 + hh * 8 + 4);
            u32x4 o; o.x = pk2(oa[0], oa[1]); o.y = pk2(oa[2], oa[3]); o.z = pk2(ob[0], ob[1]); o.w = pk2(ob[2], ob[3]);
            *(u32x4*)(MIX + (size_t)(rowbase + tok) * DM + 512 + g * 128 + d0 + hh * 8) = o; } }
    __syncthreads();
}

__device__ __forceinline__ void pool_sample_unit(const Args& A, unsigned char* lds, int unit) {
    const int t = threadIdx.x, w = t >> 6, l = t & 63, lr = l & 15, lq = l >> 4;
    const int su = unit >> 2, g = unit & 3, win = 2 << g;
    unsigned char* ws = A.ws;
    bf16_t* pl = (bf16_t*)(lds + LP_PL); bf16_t* mx = (bf16_t*)(lds + LP_MX);
    const _Float16* UU = (const _Float16*)(ws + WS_UU);
    const bf16_t* PM = (const bf16_t*)(ws + WS_PMIX) + (size_t)g * 16384;
    u32x4 mreg[4];
#pragma unroll
    for (int i = 0; i < 4; ++i) { const int idx = i * 512 + t, d = idx >> 4, c8 = idx & 15; mreg[i] = *(const u32x4*)(PM + d * 128 + c8 * 8); }
    const int cch = t & 127, sq = t >> 7;
    const float psc_w = A.in[12][g * 128 + 16 * w + lr];
#pragma unroll
    for (int i = 0; i < 4; ++i) { const int tok = sq * 4 + i, sb = su * 16 + tok; const float uv = (float)UU[(size_t)(NPR + sb) * HW + g * 128 + cch];
        float pv[15];
#pragma unroll
        for (int j = 0; j < 15; ++j) pv[j] = A.in[4][(size_t)(sb * 15 + j) * 512 + g * 128 + cch];
        float sacc = uv;
#pragma unroll
        for (int j = 0; j < 15; ++j) sacc += (j >= 16 - win) ? pv[j] : 0.f;
        pl[tok * 136 + cch] = (bf16_t)f2bf(sacc * __builtin_amdgcn_rcpf((float)win) - uv); }
#pragma unroll
    for (int i = 0; i < 4; ++i) { const int idx = i * 512 + t, d = idx >> 4, c8 = idx & 15; *(u32x4*)(mx + d * 136 + c8 * 8) = mreg[i]; }
    __syncthreads();
    f32x4 acc = (f32x4){0.f, 0.f, 0.f, 0.f};
#pragma unroll
    for (int ks = 0; ks < 4; ++ks) { const bf16x8 a = *(const bf16x8*)(pl + lr * 136 + ks * 32 + lq * 8); const bf16x8 bb = *(const bf16x8*)(mx + (16 * w + lr) * 136 + ks * 32 + lq * 8); acc = MFMA16(a, bb, acc); }
    bf16_t* MIX = (bf16_t*)(ws + WS_MIX);
#pragma unroll
    for (int r = 0; r < 4; ++r) MIX[(size_t)(NPR + su * 16 + lq * 4 + r) * DM + 512 + g * 128 + 16 * w + lr] = (bf16_t)f2bf(acc[r] * psc_w);
    __syncthreads();
}

__device__ __forceinline__ void attn_prompt_unit(const Args& A, unsigned char* lds, int unit) {
    const int t = threadIdx.x, w = t >> 6, l = t & 63, lr = l & 15, lq = l >> 4;
    const int qt = unit & 15, h = (unit >> 4) & 3, b = unit >> 6;
    unsigned char* ws = A.ws;
    const bf16_t* Q = (const bf16_t*)(ws + WS_Q); const bf16_t* KB = (const bf16_t*)(ws + WS_KB); const bf16_t* VT = (const bf16_t*)(ws + WS_VT); bf16_t* O = (bf16_t*)(ws + WS_O);
    const int R0 = b * SEQ + qt * 128 + 16 * w;
    bf16_t* CB = (bf16_t*)lds;
    bf16_t* Pw = (bf16_t*)(lds + 73728) + w * (16 * 264);
    const bf16_t* kg = KB + (size_t)(b * 256) * DM + h * 256;
    const bf16_t* vg = VT + (size_t)(h * 256) * MEMR + b * 256;
    u32x4 stg0[4], stg1[4];
#define AT_LOADK(c, STG) _Pragma("unroll") for (int i_ = 0; i_ < 4; ++i_) { const int idx_ = i_ * 512 + t; STG[i_] = *(const u32x4*)(kg + (size_t)((c) * 64 + (idx_ >> 5)) * DM + (idx_ & 31) * 8); }
#define AT_LOADV(c, STG) _Pragma("unroll") for (int i_ = 0; i_ < 4; ++i_) { const int idx_ = i_ * 512 + t; STG[i_] = *(const u32x4*)(vg + (size_t)(idx_ >> 3) * MEMR + (c) * 64 + (idx_ & 7) * 8); }
#define AT_STOREK(bf, STG) _Pragma("unroll") for (int i_ = 0; i_ < 4; ++i_) { const int idx_ = i_ * 512 + t; *(u32x4*)(CB + (bf) * 18432 + (idx_ >> 5) * 264 + (idx_ & 31) * 8) = STG[i_]; }
#define AT_STOREV(bf, STG) _Pragma("unroll") for (int i_ = 0; i_ < 4; ++i_) { const int idx_ = i_ * 512 + t; *(u32x4*)(CB + (bf) * 18432 + (idx_ >> 3) * 72 + (idx_ & 7) * 8) = STG[i_]; }
    AT_LOADK(0, stg0); AT_LOADK(1, stg1);
    bf16x8 qa[8];
#pragma unroll
    for (int ks = 0; ks < 8; ++ks) qa[ks] = *(const bf16x8*)(Q + (size_t)(R0 + lr) * DM + h * 256 + ks * 32 + lq * 8);
    AT_STOREK(0, stg0);
    __syncthreads();
    f32x4 sacc[16]; f32x4 oacc[16]; bf16x8 pa[8]; float rinv[4];
#pragma unroll
    for (int st = 0; st < 8; ++st) {
        if (st & 1) { if (st + 2 < 4) { AT_LOADK(st + 2, stg1); } else if (st + 2 < 8) { AT_LOADV(st - 2, stg1); } }
        else        { if (st + 2 < 4) { AT_LOADK(st + 2, stg0); } else if (st + 2 < 8) { AT_LOADV(st - 2, stg0); } }
        const bf16_t* cb = CB + (st & 1) * 18432;
        if (st < 4) {
#pragma unroll
            for (int nt = 0; nt < 4; ++nt) { f32x4 acc = (f32x4){0.f, 0.f, 0.f, 0.f};
#pragma unroll
                for (int ks = 0; ks < 8; ++ks) { const bf16x8 bb = *(const bf16x8*)(cb + (nt * 16 + lr) * 264 + ks * 32 + lq * 8); acc = MFMA16(qa[ks], bb, acc); }
                sacc[st * 4 + nt] = acc; __builtin_amdgcn_sched_barrier(0); }
        } else {
            if (st == 4) {
#pragma unroll
                for (int r = 0; r < 4; ++r) { float mx = sacc[0][r];
#pragma unroll
                    for (int nt = 1; nt < 16; ++nt) mx = fmaxf(mx, sacc[nt][r]);
                    mx = fmaxf(mx, __shfl_xor(mx, 1)); mx = fmaxf(mx, __shfl_xor(mx, 2)); mx = fmaxf(mx, __shfl_xor(mx, 4)); mx = fmaxf(mx, __shfl_xor(mx, 8));
                    float sum = 0.f;
#pragma unroll
                    for (int nt = 0; nt < 16; ++nt) { const float p = __builtin_amdgcn_exp2f(sacc[nt][r] - mx); sum += p; Pw[(lq * 4 + r) * 264 + nt * 16 + lr] = (bf16_t)f2bf(p); }
                    sum += __shfl_xor(sum, 1); sum += __shfl_xor(sum, 2); sum += __shfl_xor(sum, 4); sum += __shfl_xor(sum, 8);
                    rinv[r] = 1.0f / sum; }
                asm volatile("s_waitcnt lgkmcnt(0)" ::: "memory");
#pragma unroll
                for (int ks = 0; ks < 8; ++ks) pa[ks] = *(const bf16x8*)(Pw + lr * 264 + ks * 32 + lq * 8);
#pragma unroll
                for (int dt = 0; dt < 16; ++dt) oacc[dt] = (f32x4){0.f, 0.f, 0.f, 0.f};
            }
            const int c = st - 4;
#pragma unroll
            for (int dt = 0; dt < 16; ++dt)
#pragma unroll
                for (int k2 = 0; k2 < 2; ++k2) { const bf16x8 bb = *(const bf16x8*)(cb + (dt * 16 + lr) * 72 + k2 * 32 + lq * 8); oacc[dt] = MFMA16(pa[c * 2 + k2], bb, oacc[dt]); if (k2 == 1 && (dt & 1)) __builtin_amdgcn_sched_barrier(0); }
        }
        if (st & 1) { if (st + 1 < 4) { AT_STOREK(0, stg0); } else if (st + 1 < 8) { AT_STOREV(0, stg0); } }
        else        { if (st + 1 < 4) { AT_STOREK(1, stg1); } else if (st + 1 < 8) { AT_STOREV(1, stg1); } }
        __syncthreads();
    }
#pragma unroll
    for (int dt = 0; dt < 16; ++dt)
#pragma unroll
        for (int r = 0; r < 4; ++r) Pw[(lq * 4 + r) * 264 + dt * 16 + lr] = (bf16_t)f2bf(oacc[dt][r] * rinv[r]);
    asm volatile("s_waitcnt lgkmcnt(0)" ::: "memory");
#pragma unroll
    for (int i = 0; i < 8; ++i) { const int idx = i * 64 + l, row = idx >> 5, c8 = idx & 31; *(u32x4*)(O + (size_t)(R0 + row) * DM + h * 256 + c8 * 8) = *(const u32x4*)(Pw + row * 264 + c8 * 8); }
    asm volatile("s_waitcnt lgkmcnt(0)" ::: "memory");
#undef AT_LOADK
#undef AT_LOADV
#undef AT_STOREK
#undef AT_STOREV
}
__device__ __forceinline__ void attn_sample_unit(const Args& A, unsigned char* lds, int unit) {
    const int t = threadIdx.x, w = t >> 6, l = t & 63;
    const int b = unit >> 2, h = unit & 3;
    unsigned char* ws = A.ws;
    float* qs = (float*)lds; float* sc = qs + 256; float* red = sc + 256; float* po = red + 16;
    const float* Kc = A.in[5] + (size_t)b * 256 * 1024 + h * 256; const float* Vc = A.in[6] + (size_t)b * 256 * 1024 + h * 256;
    const int rl = l >> 4, c16 = l & 15;
    f32x4 kr[8][4];
#pragma unroll
    for (int p = 0; p < 8; ++p)
#pragma unroll
        for (int i = 0; i < 4; ++i) kr[p][i] = *(const f32x4*)(Kc + (size_t)(p * 32 + w * 4 + rl) * 1024 + i * 64 + c16 * 4);
    if (t < 256) qs[t] = bf2f(((const bf16_t*)(ws + WS_Q))[(size_t)(NPR + b) * DM + h * 256 + t]);
    __syncthreads();
    {
        f32x4 q4[4];
#pragma unroll
        for (int i = 0; i < 4; ++i) q4[i] = *(const f32x4*)(qs + i * 64 + c16 * 4);
#pragma unroll
        for (int p = 0; p < 8; ++p) { const int m = p * 32 + w * 4 + rl; float s = 0.f;
#pragma unroll
            for (int i = 0; i < 4; ++i) { const f32x4 kv = kr[p][i]; s += (kv[0] * q4[i][0] + kv[1] * q4[i][1]) + (kv[2] * q4[i][2] + kv[3] * q4[i][3]); }
            s += __shfl_xor(s, 1); s += __shfl_xor(s, 2); s += __shfl_xor(s, 4); s += __shfl_xor(s, 8);
            if (c16 == 0) sc[m] = s; }
    }
    f32x4 vr[32];
#pragma unroll
    for (int i = 0; i < 32; ++i) vr[i] = *(const f32x4*)(Vc + (size_t)(w * 32 + i) * 1024 + l * 4);
    __syncthreads();
    if (t < 256) { float mx = sc[t];
#pragma unroll
        for (int o = 1; o < 64; o <<= 1) mx = fmaxf(mx, __shfl_xor(mx, o));
        if (l == 0) red[w] = mx; }
    __syncthreads();
    const float gmx = fmaxf(fmaxf(red[0], red[1]), fmaxf(red[2], red[3]));
    float pv = 0.f;
    if (t < 256) { pv = __builtin_amdgcn_exp2f(sc[t] - gmx); const float s = wave_sum(pv); if (l == 0) red[8 + w] = s; }
    __syncthreads();
    if (t < 256) sc[t] = pv;
    const float inv = 1.0f / ((red[8] + red[9]) + (red[10] + red[11]));
    __syncthreads();
    {
        f32x4 o = (f32x4){0.f, 0.f, 0.f, 0.f};
#pragma unroll
        for (int i = 0; i < 32; ++i) o += vr[i] * sc[w * 32 + i];
        *(f32x4*)(po + w * 256 + l * 4) = o;
    }
    __syncthreads();
    if (t < 256) { float o = 0.f;
#pragma unroll
        for (int i = 0; i < 8; ++i) o += po[i * 256 + t];
        ((bf16_t*)(ws + WS_O))[(size_t)(NPR + b) * DM + h * 256 + t] = (bf16_t)f2bf(o * inv); }
    __syncthreads();
}

__device__ __forceinline__ void attn_sample_pair(const Args& A, unsigned char* lds, int pg) {
    const int t = threadIdx.x, w = t >> 6, l = t & 63, rl = l >> 4, c16 = l & 15;
    const int pair = pg * 2 + (w >> 2), wq = w & 3, b = pair >> 2, h = pair & 3;
    const size_t off0 = (size_t)b * 256 * 1024 + h * 256 + (size_t)(wq * 64 + rl) * 1024 + c16 * 4;
    const float* Kc = A.in[5] + off0; const float* Vc = A.in[6] + off0;
    f32x4 ra[8], rb[8];
#define AS_LD(set, base, bt) _Pragma("unroll") for (int gg_ = 0; gg_ < 2; ++gg_) _Pragma("unroll") for (int i_ = 0; i_ < 4; ++i_) set[gg_ * 4 + i_] = __builtin_nontemporal_load((const f32x4*)((base) + (size_t)((bt) * 8 + gg_ * 4) * 1024 + i_ * 64))
    AS_LD(ra, Kc, 0); AS_LD(rb, Kc, 1);
    f32x4 q4[4];
    {   const bf16_t* qp = (const bf16_t*)(A.ws + WS_Q) + (size_t)(NPR + b) * DM + h * 256 + c16 * 4;
#pragma unroll
        for (int i = 0; i < 4; ++i) { const u32x2v qv = *(const u32x2v*)(qp + i * 64); q4[i] = (f32x4){__uint_as_float(qv.x << 16), __uint_as_float(qv.x & 0xffff0000u), __uint_as_float(qv.y << 16), __uint_as_float(qv.y & 0xffff0000u)}; } }
    float sc[16];
#define AS_SCORE(set, bt) _Pragma("unroll") for (int gg_ = 0; gg_ < 2; ++gg_) { float s_ = 0.f; _Pragma("unroll") for (int i_ = 0; i_ < 4; ++i_) { const f32x4 kv_ = set[gg_ * 4 + i_]; s_ += (kv_[0] * q4[i_][0] + kv_[1] * q4[i_][1]) + (kv_[2] * q4[i_][2] + kv_[3] * q4[i_][3]); } \
        s_ += __shfl_xor(s_, 1); s_ += __shfl_xor(s_, 2); s_ += __shfl_xor(s_, 4); s_ += __shfl_xor(s_, 8); sc[(bt) * 2 + gg_] = s_; }
#pragma unroll
    for (int bt = 0; bt < 8; ++bt) {
        if (bt & 1) { AS_SCORE(rb, bt); if (bt + 2 < 8) { AS_LD(rb, Kc, bt + 2); } else { AS_LD(rb, Vc, bt - 6); } }
        else        { AS_SCORE(ra, bt); if (bt + 2 < 8) { AS_LD(ra, Kc, bt + 2); } else { AS_LD(ra, Vc, bt - 6); } }
        asm volatile("" ::: "memory"); __builtin_amdgcn_sched_barrier(0);
    }
    float mx = sc[0];
#pragma unroll
    for (int g = 1; g < 16; ++g) mx = fmaxf(mx, sc[g]);
    mx = fmaxf(mx, __shfl_xor(mx, 16)); mx = fmaxf(mx, __shfl_xor(mx, 32));
    float ls = 0.f;
#pragma unroll
    for (int g = 0; g < 16; ++g) { sc[g] = __builtin_amdgcn_exp2f(sc[g] - mx); ls += sc[g]; }
    ls += __shfl_xor(ls, 16); ls += __shfl_xor(ls, 32);
    f32x4 o[4];
#pragma unroll
    for (int i = 0; i < 4; ++i) o[i] = (f32x4){0.f, 0.f, 0.f, 0.f};
#define AS_PV(set, bt) _Pragma("unroll") for (int gg_ = 0; gg_ < 2; ++gg_) _Pragma("unroll") for (int i_ = 0; i_ < 4; ++i_) o[i_] += set[gg_ * 4 + i_] * sc[(bt) * 2 + gg_]
#pragma unroll
    for (int bt = 0; bt < 8; ++bt) {
        if (bt & 1) { AS_PV(rb, bt); if (bt + 2 < 8) { AS_LD(rb, Vc, bt + 2); } }
        else        { AS_PV(ra, bt); if (bt + 2 < 8) { AS_LD(ra, Vc, bt + 2); } }
        asm volatile("" ::: "memory"); __builtin_amdgcn_sched_barrier(0);
    }
#pragma unroll
    for (int i = 0; i < 4; ++i)
#pragma unroll
        for (int c = 0; c < 4; ++c) { float v = o[i][c]; v += __shfl_xor(v, 16); v += __shfl_xor(v, 32); o[i][c] = v; }
    float* pw = (float*)lds + w * 260;
    if (rl == 0) {
#pragma unroll
        for (int i = 0; i < 4; ++i) *(f32x4*)(pw + i * 64 + c16 * 4) = o[i];
        if (c16 == 0) { pw[256] = mx; pw[257] = ls; } }
    __syncthreads();
    {   const int ps = t >> 8, d = t & 255; const float* pb = (const float*)lds + (ps * 4) * 260;
        const float m0 = pb[256], m1 = pb[260 + 256], m2 = pb[520 + 256], m3 = pb[780 + 256]; const float M = fmaxf(fmaxf(m0, m1), fmaxf(m2, m3));
        const float e0 = __builtin_amdgcn_exp2f(m0 - M), e1 = __builtin_amdgcn_exp2f(m1 - M), e2 = __builtin_amdgcn_exp2f(m2 - M), e3 = __builtin_amdgcn_exp2f(m3 - M);
        const float num = (pb[d] * e0 + pb[260 + d] * e1) + (pb[520 + d] * e2 + pb[780 + d] * e3);
        const float den = (pb[257] * e0 + pb[260 + 257] * e1) + (pb[520 + 257] * e2 + pb[780 + 257] * e3);
        const int pr = pg * 2 + ps, bb = pr >> 2, hh = pr & 3;
        ((bf16_t*)(A.ws + WS_O))[(size_t)(NPR + bb) * DM + hh * 256 + d] = (bf16_t)f2bf(num / den); }
    __syncthreads();
#undef AS_LD
#undef AS_SCORE
#undef AS_PV
}

template <int KIND, int NKS>
__device__ __forceinline__ void sample_gemm(unsigned char* lds, const bf16_t* Asm, int lda, const bf16_t* Bt, int K, int unit, const float* base, const bf16_t* baseb, float* out, bf16_t* outb, float* ss, float scale, unsigned* rcnt = nullptr, const float* gfin = nullptr) {
    const int t = threadIdx.x, w = t >> 6, l = t & 63, lr = l & 15, lq = l >> 4;
    const int rb = unit & 3, cb = unit >> 2, kw = K >> 3, k0 = w * kw;
    f32x4 acc[2]; acc[0] = (f32x4){0.f, 0.f, 0.f, 0.f}; acc[1] = acc[0];
    const bf16_t* bp = Bt + (size_t)(cb * 16 + lr) * K + k0 + lq * 8;
    const bf16_t* ap = Asm + (size_t)(rb * 32 + lr) * lda + k0 + lq * 8;
    bf16x8 fb[NKS], fa0[NKS], fa1[NKS];
#pragma unroll
    for (int ks = 0; ks < NKS; ++ks) { fb[ks] = *(const bf16x8*)(bp + ks * 32); fa0[ks] = *(const bf16x8*)(ap + ks * 32); fa1[ks] = *(const bf16x8*)(ap + (size_t)16 * lda + ks * 32); }
    const int row_ = t >> 4, col_ = t & 15;
    float bres = 0.f;
    if (KIND == 0) bres = base ? base[(size_t)(rb * 32 + row_) * DM + cb * 16 + col_] : bf2f(baseb[(size_t)(rb * 32 + row_) * DM + cb * 16 + col_]);
#pragma unroll
    for (int ks = 0; ks < NKS; ++ks) { acc[0] = MFMA16(fa0[ks], fb[ks], acc[0]); acc[1] = MFMA16(fa1[ks], fb[ks], acc[1]); }
    float* red = (float*)lds;
#pragma unroll
    for (int i = 0; i < 2; ++i)
#pragma unroll
        for (int r = 0; r < 4; ++r) red[(w * 32 + i * 16 + lq * 4 + r) * 16 + lr] = acc[i][r];
    __syncthreads();
    const int row = t >> 4, col = t & 15, grow = rb * 32 + row, gcol = cb * 16 + col;
    float v = 0.f;
#pragma unroll
    for (int i = 0; i < 8; ++i) v += red[(i * 32 + row) * 16 + col];
    if (KIND == 0) { const float val = bres + v;
        float sq = val * val; sq += __shfl_xor(sq, 1); sq += __shfl_xor(sq, 2); sq += __shfl_xor(sq, 4); sq += __shfl_xor(sq, 8);
        if (col == 0) atomicAdd(ss + grow, sq);
        if (rcnt) {
            asm volatile("s_waitcnt vmcnt(0)" ::: "memory");
            __syncthreads();
            if (t == 0) { unsigned* c = rcnt + 64 * rb;
                __hip_atomic_fetch_add(c, 1u, __ATOMIC_RELEASE, __HIP_MEMORY_SCOPE_AGENT);
                unsigned sp = 0u; while (__hip_atomic_load(c, __ATOMIC_RELAXED, __HIP_MEMORY_SCOPE_AGENT) < 64u) { __builtin_amdgcn_s_sleep(2); if (++sp > (1u << 22)) break; }
                __builtin_amdgcn_fence(__ATOMIC_ACQUIRE, "agent"); }
            __syncthreads();
            const float tot = __hip_atomic_load(ss + grow, __ATOMIC_RELAXED, __HIP_MEMORY_SCOPE_AGENT);
            out[(size_t)grow * DM + gcol] = val * __builtin_amdgcn_rsqf(tot * (1.0f / DM) + EPS) * gfin[gcol];
        } else { if (out) out[(size_t)grow * DM + gcol] = val; if (outb) outb[(size_t)grow * DM + gcol] = (bf16_t)f2bf(val); }
    } else { const float rstd = __builtin_amdgcn_rsqf(ss[grow] * (1.0f / DM) + EPS); outb[(size_t)grow * DM + gcol] = (bf16_t)f2bf(v * rstd * scale); }
    __syncthreads();
}

__device__ __forceinline__ void final_norm(const Args& A, int G, int row_lo) {
    const int lane = threadIdx.x & 63, gw = blockIdx.x * 8 + (threadIdx.x >> 6), NGW = G * 8;
    const float* ss = (const float*)(A.ws + WS_SS3); const f32x4* gr = (const f32x4*)A.in[22] + lane;
    f32x4 gg[4];
#pragma unroll
    for (int j = 0; j < 4; ++j) gg[j] = gr[64 * j];
    for (int m0 = row_lo + gw * 4; m0 < NVALID; m0 += NGW * 4) {
        f32x4 v[4][4]; float sv[4];
#pragma unroll
        for (int r = 0; r < 4; ++r) { sv[r] = ss[m0 + r]; const f32x4* xr = (const f32x4*)(A.out + (size_t)(m0 + r) * DM) + lane;
#pragma unroll
            for (int j = 0; j < 4; ++j) v[r][j] = xr[64 * j]; }
#pragma unroll
        for (int r = 0; r < 4; ++r) { const float rstd = 1.0f / sqrtf(sv[r] * (1.f / DM) + EPS); f32x4* xr = (f32x4*)(A.out + (size_t)(m0 + r) * DM) + lane;
#pragma unroll
            for (int j = 0; j < 4; ++j) xr[64 * j] = v[r][j] * rstd * gg[j]; } }
}

constexpr int NPHASES = 12;
#ifndef REPMASK
#define REPMASK 0
#endif
#define REPS(k) for (int rep_ = 0; rep_ < 1 + ((REPMASK >> (k)) & 1); ++rep_)
__global__ void __launch_bounds__(NTHREADS, 2) fwd_megakernel(Args args) {
    extern __shared__ __attribute__((aligned(16))) unsigned char lds[];
    cg::grid_group grid = cg::this_grid();
    const int G = gridDim.x, bx = blockIdx.x;
    unsigned char* ws = args.ws;
    PG8_LAS unsigned char* lds3 = (PG8_LAS unsigned char*)lds;
    const int lo = args.ph_lo, hi = args.ph_hi;
#define IN(k) (lo <= (k) && (k) < hi)
#ifndef SPINBLK
#define SPINBLK 0
#endif
#ifdef SPINMASK
    unsigned long long t_prev_ = __builtin_amdgcn_s_memrealtime(), t_acc_ = 0ull;
#define STAMP(k) do { const unsigned long long t_now_ = __builtin_amdgcn_s_memrealtime(); if ((SPINMASK >> (k)) & 1) t_acc_ += t_now_ - t_prev_; t_prev_ = t_now_; } while (0)
#else
#define STAMP(k) do { } while (0)
#endif
#define SEAM(k) do { if (IN(k) && IN((k) + 1)) xcd_barrier(bar); STAMP(k); } while (0)
    if (lo < 0) grid.sync();
    volatile LAS unsigned* MISC = (volatile LAS unsigned*)(lds3 + LDS_BYTES - 64);
    if (threadIdx.x < 16) MISC[threadIdx.x] = 0u;
    __syncthreads();
    XcdBarrier bar = xcd_barrier_post((unsigned*)(ws + WS_BAR), MISC);
    if (IN(0)) REPS(0) { p0_prologue(args, lds, G); }
    SEAM(0);
    if (IN(1)) REPS(1) {
        {   pg8::Gemm g{(const bf16_t*)(ws + WS_H0), (const bf16_t*)(ws + WS_WIN), MT, NIN, DM}; pg8::StaticOrder S; S.init(MT, NIN, G, bx);
            pg8::EpiInProj E{(bf16_t*)(ws + WS_QQ), (bf16_t*)(ws + WS_KK), (bf16_t*)(ws + WS_VV), (bf16_t*)(ws + WS_GG), (unsigned short*)(ws + WS_LF), (unsigned short*)(ws + WS_UU), args.in[9], (const float*)(ws + WS_SS0)};
            pg8::gemm_phase<pg8::EpiInProj, pg8::StaticOrder, true, true>(lds3, g, S, E); }
        {   pg8::Gemm g{(const bf16_t*)(ws + WS_MEMH), (const bf16_t*)(ws + WS_WKV), MEMR, 2 * DM, DM}; pg8::StaticOrder S; S.init(MEMR, 2 * DM, G, (bx + G - (650 % G)) % G);
            pg8::EpiMemKV E{args.out + O_MK, args.out + O_MV, (bf16_t*)(ws + WS_KB)};
            pg8::gemm_phase<pg8::EpiMemKV, pg8::StaticOrder, true, true>(lds3, g, S, E); }
        {   pg8::Gemm g{(const bf16_t*)(ws + WS_WKV) + (size_t)DM * DM, (const bf16_t*)(ws + WS_MEMH), DM, MEMR, DM}; pg8::StaticOrder S; S.init(DM, MEMR, G, (bx + 2 * G - ((650 + 64) % G)) % G);
            pg8::EpiBf16Scale E{(bf16_t*)(ws + WS_VT), MEMR, nullptr, 1.0f};
            pg8::gemm_phase<pg8::EpiBf16Scale, pg8::StaticOrder, true, true>(lds3, g, S, E); }
    }
    SEAM(1);
    if (IN(2)) REPS(2) {
        const bool sfirst = ((bx >> 3) & 1) != 0;
#pragma unroll 1
        for (int pass = 0; pass < 2; ++pass) {
            if ((pass == 0) == sfirst) {
                f32x4 sreg[8]; if (bx < 512) hgrn_sample_load(args, bx, sreg);
                for (int u = bx; u < 512; u += G) hgrn_sample_unit(args, lds, u, (u + G < 512) ? u + G : -1, sreg);
            } else {
                u32x2v lf[4]; u32x4 kkr[2], vvr[2]; if (bx < 1024) hgrn_local_load(args, bx, lf, kkr, vvr);
                for (int u = bx; u < 1024; u += G) hgrn_local_unit(args, lds, u, (u + G < 1024) ? u + G : -1, lf, kkr, vvr);
            }
        }
    }
    SEAM(2);
    if (IN(3)) {
        for (int u = bx; u < 32; u += G) pool_sample_unit(args, lds, u);
        const bool scan_first = ((bx >> 3) & 1) != 0;
        if (scan_first) { hgrn_scan(args, G); pool_states(args, G); }
        {   u32x4 mreg[4]; u32x2v ereg[5]; if (bx < 1024) pool_load(args, bx, mreg, ereg);
            for (int u = bx; u < 1024; u += G) pool_unit(args, lds, u, (u + G < 1024) ? u + G : -1, mreg, ereg); }
        if (!scan_first) { hgrn_scan(args, G); pool_states(args, G); }
    }
    SEAM(3);
    if (IN(4)) REPS(4) {
        {   u32x2v lf[4]; u32x4 qqr[2], kkr[2], vvr[2], spr[4]; if (bx < 1024) hgrn_out_load(args, bx, lf, qqr, kkr, vvr, spr);
            for (int u = bx; u < 1024; u += G) hgrn_out_unit(args, lds, u, (u + G < 1024) ? u + G : -1, lf, qqr, kkr, vvr, spr); }
        STAMP(12);
        STAMP(13);
        for (int u = bx; u < 256; u += G) sample_gemm<0, 4>(lds, (const bf16_t*)(ws + WS_MIX) + (size_t)NPR * DM, DM, (const bf16_t*)(ws + WS_WOUT), DM, u, args.in[1], nullptr, nullptr, (bf16_t*)(ws + WS_H0) + (size_t)NPR * DM, (float*)(ws + WS_SS1) + NPR, 1.0f);
    }
    SEAM(4);
    if (IN(5)) REPS(5) {
        pg8::Gemm g{(const bf16_t*)(ws + WS_MIX), (const bf16_t*)(ws + WS_WOUT), NPR, DM, DM}; pg8::StaticOrder S; S.init(NPR, DM, G, bx);
        pg8::EpiResid E{nullptr, (const bf16_t*)(ws + WS_H0), nullptr, (bf16_t*)(ws + WS_H0), (float*)(ws + (rep_ ? WS_SSD : WS_SS1))};
        pg8::gemm_phase<pg8::EpiResid, pg8::StaticOrder, true, true>(lds3, g, S, E);
        for (int u = bx; u < 256; u += G) sample_gemm<1, 4>(lds, (const bf16_t*)(ws + WS_H0) + (size_t)NPR * DM, DM, (const bf16_t*)(ws + WS_WCQ), DM, u, nullptr, nullptr, nullptr, (bf16_t*)(ws + WS_Q) + (size_t)NPR * DM, (float*)(ws + WS_SS1) + NPR, 0.0625f * 1.4426950408889634f);
    }
    SEAM(5);
    const bool stream_first = ((bx >> 3) & 1) != 0;
    if (IN(7) && stream_first) for (int u = bx; u < 256; u += G) attn_sample_pair(args, lds, u);
    if (IN(6)) {
        pg8::Gemm g{(const bf16_t*)(ws + WS_H0), (const bf16_t*)(ws + WS_WCQ), NPR, DM, DM}; pg8::StaticOrder S; S.init(NPR, DM, G, bx);
        pg8::EpiBf16Scale E{(bf16_t*)(ws + WS_Q), DM, (const float*)(ws + WS_SS1), 0.0625f * 1.4426950408889634f};
        pg8::gemm_phase<pg8::EpiBf16Scale, pg8::StaticOrder, true, true>(lds3, g, S, E);
        STAMP(16);
    }
    int au0 = bx, au1 = 512, austep = G;
    if (G == 256) {
        asm volatile("s_waitcnt vmcnt(0)" ::: "memory"); __syncthreads();
        const int wg_ = (bx & 7) * 32 + (bx >> 3), pm_ = (wg_ >> 5) * 8 + ((wg_ & 31) & 7), pn_ = (wg_ & 31) >> 3;
        au0 = ((pm_ >> 3) * 4 + pn_) * 16 + (pm_ & 7) * 2; au1 = au0 + 2; austep = 1;
    } else { SEAM(6); }
    if (IN(7)) {
        for (int u = au0; u < au1; u += austep) attn_prompt_unit(args, lds, u);
        STAMP(17);
        if (!stream_first) for (int u = bx; u < 256; u += G) attn_sample_pair(args, lds, u);
    }
    SEAM(7);
    if (IN(8)) REPS(8) {
        pg8::Gemm g{(const bf16_t*)(ws + WS_O), (const bf16_t*)(ws + WS_WCO), NPR, DM, DM}; pg8::StaticOrder S; S.init(NPR, DM, G, bx);
        pg8::EpiResid E{nullptr, (const bf16_t*)(ws + WS_H0), nullptr, (bf16_t*)(ws + WS_MIX), (float*)(ws + (rep_ ? WS_SSD : WS_SS2))};
        pg8::gemm_phase<pg8::EpiResid, pg8::StaticOrder, true, true>(lds3, g, S, E);
        for (int u = bx; u < 256; u += G) sample_gemm<0, 4>(lds, (const bf16_t*)(ws + WS_O) + (size_t)NPR * DM, DM, (const bf16_t*)(ws + WS_WCO), DM, u, nullptr, (const bf16_t*)(ws + WS_H0) + (size_t)NPR * DM, nullptr, (bf16_t*)(ws + WS_MIX) + (size_t)NPR * DM, (float*)(ws + (rep_ ? WS_SSD : WS_SS2)) + NPR, 1.0f);
    }
    SEAM(8);
    if (IN(9)) REPS(9) {
        pg8::Gemm g{(const bf16_t*)(ws + WS_MIX), (const bf16_t*)(ws + WS_WFFI), MT, NFF2, DM}; pg8::StaticOrder S; S.init(MT, NFF2, G, bx);
        pg8::EpiSwiGLU E{(bf16_t*)(ws + WS_A), (const float*)(ws + WS_SS2)};
        pg8::gemm_phase<pg8::EpiSwiGLU, pg8::StaticOrder, true, true>(lds3, g, S, E);
    }
    SEAM(9);
    if (IN(10)) {
        pg8::Gemm g{(const bf16_t*)(ws + WS_A), (const bf16_t*)(ws + WS_WFFO), NPR, DM, DFF}; pg8::StaticOrder S; S.init(NPR, DM, G, bx);
        if (G == 256) {
            pg8::EpiResidNorm E{(const bf16_t*)(ws + WS_MIX), args.out, (float*)(ws + WS_SS3), (unsigned*)(ws + WS_CNT), args.in[22]};
            pg8::gemm_phase<pg8::EpiResidNorm, pg8::StaticOrder, false, true>(lds3, g, S, E);
        } else {
            pg8::EpiResid E{nullptr, (const bf16_t*)(ws + WS_MIX), args.out, nullptr, (float*)(ws + WS_SS3)};
            pg8::gemm_phase<pg8::EpiResid, pg8::StaticOrder, true, true>(lds3, g, S, E);
        }
        for (int u = bx; u < 256; u += G) sample_gemm<0, 11>(lds, (const bf16_t*)(ws + WS_A) + (size_t)NPR * DFF, DFF, (const bf16_t*)(ws + WS_WFFO), DFF, u, nullptr, (const bf16_t*)(ws + WS_MIX) + (size_t)NPR * DM, args.out + O_YS, nullptr, (float*)(ws + WS_SS3) + NPR, 1.0f, (G == 256) ? (unsigned*)(ws + WS_CNT) + 64 * 64 : nullptr, args.in[22]);
    }
    if (G != 256) SEAM(10);
#ifdef EXTRA_SYNCS
    for (int i_ = 0; i_ < EXTRA_SYNCS; ++i_) xcd_barrier(bar);
#endif
    if (IN(11) && G != 256) { final_norm(args, G, 0); }
#ifdef SPINMASK
    STAMP(11);
    if (bx == SPINBLK && threadIdx.x == 0) { const unsigned long long t0_ = __builtin_amdgcn_s_memrealtime(); while (__builtin_amdgcn_s_memrealtime() - t0_ < t_acc_) __builtin_amdgcn_s_sleep(8); }
#endif
#undef IN
#undef SEAM
}

#ifndef MK_MULTI
#define MK_MULTI 0
#endif
extern "C" void kernel_launch(void* const* d_in, const int* in_sizes, int n_in, void* d_out, int out_size, void* d_ws, size_t ws_size, hipStream_t stream) {
    static int grid = 0;
    if (grid == 0) {
        if (n_in != 23 || ws_size < WS_END) { fprintf(stderr, "kernel_launch: unexpected n_in %d / ws_size %zu\n", n_in, ws_size); grid = -1; return; }
        int dev = 0, cus = 0, per_cu = 0;
        hipGetDevice(&dev); hipDeviceGetAttribute(&cus, hipDeviceAttributeMultiprocessorCount, dev);
        if (hipFuncSetAttribute((const void*)fwd_megakernel, hipFuncAttributeMaxDynamicSharedMemorySize, LDS_BYTES) != hipSuccess) { fprintf(stderr, "kernel_launch: hipFuncSetAttribute failed\n"); grid = -1; return; }
        hipOccupancyMaxActiveBlocksPerMultiprocessor(&per_cu, (const void*)fwd_megakernel, NTHREADS, LDS_BYTES);
        (void)hipGetLastError();
        if (per_cu < 1) { fprintf(stderr, "kernel_launch: occupancy query says %d blocks/CU\n", per_cu); per_cu = 1; }
        grid = cus;
    }
    if (grid < 0) return;
    Args a{};
    for (int i = 0; i < 23; ++i) a.in[i] = (const float*)d_in[i];
    a.out = (float*)d_out; a.ws = (unsigned char*)d_ws;
#if MK_MULTI
    for (int p = 0; p < NPHASES; ++p) { a.ph_lo = p; a.ph_hi = p + 1; hipLaunchKernelGGL(fwd_megakernel, dim3(grid), dim3(NTHREADS), LDS_BYTES, stream, a); }
#else
    a.ph_lo = 0; a.ph_hi = NPHASES;
    if (hipMemsetAsync((char*)d_ws + WS_BAR, 0, BAR_BYTES, stream) != hipSuccess) { fprintf(stderr, "kernel_launch: memset failed\n"); return; }
    void* kargs[] = {&a};
    hipError_t e = hipLaunchCooperativeKernel((const void*)fwd_megakernel, dim3(grid), dim3(NTHREADS), kargs, LDS_BYTES, stream);
    if (e != hipSuccess) fprintf(stderr, "kernel_launch: cooperative launch failed: %s (grid %d)\n", hipGetErrorString(e), grid);
#endif
}
```

```cpp
#include <hip/hip_runtime.h>
#include <hip/hip_cooperative_groups.h>
#include <cstdio>
#include <cstdint>
namespace cg = cooperative_groups;
namespace pg8 {
#define PG8_LAS __attribute__((address_space(3)))
typedef unsigned short bf16_t;
typedef short bf16x8 __attribute__((ext_vector_type(8)));
typedef float f32x4 __attribute__((ext_vector_type(4)));
typedef unsigned u32x4 __attribute__((ext_vector_type(4)));
constexpr int BM = 256, BK = 64, HALF = 128, HTB = HALF * BK * 2  , STAGE_BYTES = 8 * HTB, NXCD = 8, WGM = 8;

__host__ __device__ __forceinline__ int lds_byte(int r, int c) { const int st = (r >> 4) * 2 + (c >> 5), rr = r & 15, cc = c & 31, ob = rr * 64 + cc * 2; return st * 1024 + (ob ^ (((ob >> 9) & 1) << 5)); }
__host__ __device__ __forceinline__ void stage_rc(int b, int& R, int& C) { const int st = b / 1024, sb = b % 1024, swz = sb ^ (((sb >> 9) & 1) << 5); R = (st >> 1) * 16 + swz / 64; C = (st & 1) * 32 + (swz % 64) / 2; }
__host__ __device__ __forceinline__ int perm32(int rho) { const int n = rho >> 4, i = rho & 15; return 8 * (i >> 2) + 4 * n + (i & 3); }

struct Unit { int pm, pn; };
struct Gemm { const bf16_t* A; const bf16_t* Bt; int M, N, K; };

struct StaticOrder {
    int nM, nN, nwg, G, c;
    __host__ __device__ void init(int M, int N, int G_, int c_) { nM = M / BM; nN = N / BM; nwg = nM * nN; G = G_; c = c_; }
    __host__ __device__ bool next(int i, Unit& u) const {
        const long L = (long)i * G + c; if (L >= nwg) return false;
        int wgid = (int)L; { const int q = nwg / NXCD, r = nwg % NXCD, xcd = wgid % NXCD, off = wgid / NXCD; wgid = (xcd < r ? xcd * (q + 1) : r * (q + 1) + (xcd - r) * q) + off; }
        const int nig = WGM * nN, gid = wgid / nig, fm = gid * WGM, gsz = (nM - fm) < WGM ? (nM - fm) : WGM;
        u.pm = fm + ((wgid % nig) % gsz); u.pn = (wgid % nig) / gsz; return true;
    }
    __device__ __forceinline__ void a_ready(const Unit&) const {}
    __device__ __forceinline__ void done(const Unit&) const {}
};

__device__ __forceinline__ unsigned cvt_pk_bf16(float lo, float hi) { unsigned r; asm volatile("v_cvt_pk_bf16_f32 %0, %1, %2" : "=v"(r) : "v"(lo), "v"(hi)); return r; }
typedef unsigned u32x2 __attribute__((ext_vector_type(2)));
__device__ __forceinline__ float sigm(float z) { return __builtin_amdgcn_rcpf(1.0f + __expf(-z)); }
constexpr float RMS_EPS = 1e-6f;
#ifndef WT_STORES
#define WT_STORES 0
#endif
__device__ __forceinline__ void st16(void* p, u32x4 v) {
#if WT_STORES
    asm volatile("global_store_dwordx4 %0, %1, off sc1\n\ts_nop 1" :: "v"(p), "v"(v) : "memory");
#else
    *(u32x4*)p = v;
#endif
}
__device__ __forceinline__ void st16f(void* p, f32x4 v) { st16(p, __builtin_bit_cast(u32x4, v)); }
__device__ __forceinline__ void st8(void* p, u32x2 v) {
#if WT_STORES
    asm volatile("global_store_dwordx2 %0, %1, off sc1\n\ts_nop 1" :: "v"(p), "v"(v) : "memory");
#else
    *(u32x2*)p = v;
#endif
}
typedef _Float16 h2_t __attribute__((ext_vector_type(2)));
__device__ __forceinline__ unsigned pk_h2(float a, float b) { h2_t v; v.x = (_Float16)a; v.y = (_Float16)b; return __builtin_bit_cast(unsigned, v); }
__device__ __forceinline__ float h_lo(unsigned u) { return (float)__builtin_bit_cast(h2_t, u).x; }
__device__ __forceinline__ float h_hi(unsigned u) { return (float)__builtin_bit_cast(h2_t, u).y; }

struct EpiInProj {
    static constexpr bool PERM = true, AFTER_DRAIN = false;
    bf16_t *QQ, *KK, *VV, *GG; unsigned short *LF, *UU; const float* lbraw; const float* ss0;
    __device__ __forceinline__ void operator()(const f32x4 (&acc)[2][2][4][2], const Unit& u, int wr, int wc, int fr, int fq) const {
        const int seg = u.pn >> 1, colt = (u.pn & 1) * 256;
        const int row0 = u.pm * BM + wr * 64 + fr;
        float rs0[2][4];
#pragma unroll
        for (int ai = 0; ai < 2; ++ai)
#pragma unroll
            for (int m = 0; m < 4; ++m) rs0[ai][m] = __builtin_amdgcn_rsqf(ss0[row0 + ai * HALF + m * 16] * (1.0f / 1024.0f) + RMS_EPS);
#pragma unroll
        for (int bj = 0; bj < 2; ++bj) {
            const int cs = colt + bj * HALF + wc * 32 + 8 * fq;
            float lb[8];
            if (seg == 1) {
#pragma unroll
                for (int j = 0; j < 8; ++j) { const float l0 = lbraw[cs + j], l1 = lbraw[512 + cs + j]; lb[j] = __builtin_amdgcn_rcpf(1.0f + __expf(l1 - l0)); }
            } else {
#pragma unroll
                for (int j = 0; j < 8; ++j) lb[j] = 0.f;
            }
#pragma unroll
            for (int ai = 0; ai < 2; ++ai)
#pragma unroll
                for (int m = 0; m < 4; ++m) {
                    const size_t off = (size_t)(row0 + ai * HALF + m * 16) * 512 + cs;
                    const f32x4 v0 = acc[ai][bj][m][0] * rs0[ai][m], v1 = acc[ai][bj][m][1] * rs0[ai][m];
                    float z[8] = {v0[0], v0[1], v0[2], v0[3], v1[0], v1[1], v1[2], v1[3]};
                    if (seg == 0) {
#pragma unroll
                        for (int j = 0; j < 8; ++j) z[j] = z[j] * sigm(z[j]);
                        u32x4 w; w.x = cvt_pk_bf16(z[0], z[1]); w.y = cvt_pk_bf16(z[2], z[3]); w.z = cvt_pk_bf16(z[4], z[5]); w.w = cvt_pk_bf16(z[6], z[7]);
                        st16(QQ + off, w);
                    } else if (seg == 1) {
                        float lf[8], kk[8];
#pragma unroll
                        for (int j = 0; j < 8; ++j) { const float e = __expf(-z[j]); const float sg = __builtin_amdgcn_rcpf(1.0f + e); const float sgn = e * sg;
                            lf[j] = __logf(lb[j] + (1.0f - lb[j]) * sg); kk[j] = (1.0f - lb[j]) * sgn; }
                        { u32x4 w; w.x = pk_h2(lf[0], lf[1]); w.y = pk_h2(lf[2], lf[3]); w.z = pk_h2(lf[4], lf[5]); w.w = pk_h2(lf[6], lf[7]); st16(LF + off, w); }
                        u32x4 w; w.x = cvt_pk_bf16(kk[0], kk[1]); w.y = cvt_pk_bf16(kk[2], kk[3]); w.z = cvt_pk_bf16(kk[4], kk[5]); w.w = cvt_pk_bf16(kk[6], kk[7]);
                        st16(KK + off, w);
                    } else if (seg == 2) {
                        u32x4 w; w.x = cvt_pk_bf16(z[0], z[1]); w.y = cvt_pk_bf16(z[2], z[3]); w.z = cvt_pk_bf16(z[4], z[5]); w.w = cvt_pk_bf16(z[6], z[7]);
                        st16(VV + off, w);
                    } else if (seg == 3) {
#pragma unroll
                        for (int j = 0; j < 8; ++j) z[j] = sigm(z[j]);
                        u32x4 w; w.x = cvt_pk_bf16(z[0], z[1]); w.y = cvt_pk_bf16(z[2], z[3]); w.z = cvt_pk_bf16(z[4], z[5]); w.w = cvt_pk_bf16(z[6], z[7]);
                        st16(GG + off, w);
                    } else {
                        u32x4 w; w.x = pk_h2(z[0], z[1]); w.y = pk_h2(z[2], z[3]); w.z = pk_h2(z[4], z[5]); w.w = pk_h2(z[6], z[7]); st16(UU + off, w);
                    }
                }
        }
    }
};

struct EpiMemKV {
    static constexpr bool PERM = true, AFTER_DRAIN = false;
    float *outK, *outV; bf16_t* KB;
    __device__ __forceinline__ void operator()(const f32x4 (&acc)[2][2][4][2], const Unit& u, int wr, int wc, int fr, int fq) const {
        const bool isk = u.pn < 4; float* o = isk ? outK : outV; const int colt = (u.pn & 3) * 256;
        const int row0 = u.pm * BM + wr * 64 + fr;
#pragma unroll
        for (int ai = 0; ai < 2; ++ai)
#pragma unroll
            for (int m = 0; m < 4; ++m)
#pragma unroll
                for (int bj = 0; bj < 2; ++bj) {
                    const size_t off = (size_t)(row0 + ai * HALF + m * 16) * 1024 + colt + bj * HALF + wc * 32 + 8 * fq;
                    const f32x4 v0 = acc[ai][bj][m][0], v1 = acc[ai][bj][m][1];
                    *(f32x4*)(o + off) = v0; *(f32x4*)(o + off + 4) = v1;
                    if (isk) { u32x4 w; w.x = cvt_pk_bf16(v0[0], v0[1]); w.y = cvt_pk_bf16(v0[2], v0[3]); w.z = cvt_pk_bf16(v1[0], v1[1]); w.w = cvt_pk_bf16(v1[2], v1[3]); *(u32x4*)(KB + off) = w; }
                }
    }
};

struct EpiBf16Scale {
    static constexpr bool PERM = true, AFTER_DRAIN = false;
    bf16_t* O; int ldc; const float* ss; float scale;
    __device__ __forceinline__ void operator()(const f32x4 (&acc)[2][2][4][2], const Unit& u, int wr, int wc, int fr, int fq) const {
        const int row0 = u.pm * BM + wr * 64 + fr;
        float ssv[2][4];
#pragma unroll
        for (int ai = 0; ai < 2; ++ai)
#pragma unroll
            for (int m = 0; m < 4; ++m) ssv[ai][m] = ss ? ss[row0 + ai * HALF + m * 16] : 0.f;
#pragma unroll
        for (int ai = 0; ai < 2; ++ai)
#pragma unroll
            for (int m = 0; m < 4; ++m) {
                const int row = row0 + ai * HALF + m * 16;
                const float sc = ss ? scale * __builtin_amdgcn_rsqf(ssv[ai][m] * (1.0f / 1024.0f) + RMS_EPS) : scale;
#pragma unroll
                for (int bj = 0; bj < 2; ++bj) {
                    const size_t off = (size_t)row * ldc + u.pn * BM + bj * HALF + wc * 32 + 8 * fq;
                    const f32x4 v0 = acc[ai][bj][m][0] * sc, v1 = acc[ai][bj][m][1] * sc;
                    u32x4 w; w.x = cvt_pk_bf16(v0[0], v0[1]); w.y = cvt_pk_bf16(v0[2], v0[3]); w.z = cvt_pk_bf16(v1[0], v1[1]); w.w = cvt_pk_bf16(v1[2], v1[3]);
                    st16(O + off, w);
                }
            }
    }
};

struct EpiResid {
    static constexpr bool PERM = true, AFTER_DRAIN = false;
    const float* baseF;
    const bf16_t* baseB;
    float* out;
    bf16_t* outb;
    float* ss;
    __device__ __forceinline__ void operator()(const f32x4 (&acc)[2][2][4][2], const Unit& u, int wr, int wc, int fr, int fq) const {
        const int row0 = u.pm * BM + wr * 64 + fr;
#pragma unroll
        for (int ai = 0; ai < 2; ++ai) {
            f32x4 pre[4][2][2];
            if (baseF) {
#pragma unroll
                for (int m = 0; m < 4; ++m) { const float* bp = baseF + (size_t)(row0 + ai * HALF + m * 16) * 1024;
#pragma unroll
                    for (int bj = 0; bj < 2; ++bj) { const int col = u.pn * BM + bj * HALF + wc * 32 + 8 * fq; pre[m][bj][0] = __builtin_nontemporal_load((const f32x4*)(bp + col)); pre[m][bj][1] = __builtin_nontemporal_load((const f32x4*)(bp + col + 4)); } }
            } else {
                u32x4 pb[4][2];
#pragma unroll
                for (int m = 0; m < 4; ++m) { const bf16_t* bp = baseB + (size_t)(row0 + ai * HALF + m * 16) * 1024;
#pragma unroll
                    for (int bj = 0; bj < 2; ++bj) pb[m][bj] = *(const u32x4*)(bp + u.pn * BM + bj * HALF + wc * 32 + 8 * fq); }
#pragma unroll
                for (int m = 0; m < 4; ++m)
#pragma unroll
                    for (int bj = 0; bj < 2; ++bj) { const u32x4 p = pb[m][bj];
                        pre[m][bj][0] = (f32x4){__uint_as_float(p.x << 16), __uint_as_float(p.x & 0xffff0000u), __uint_as_float(p.y << 16), __uint_as_float(p.y & 0xffff0000u)};
                        pre[m][bj][1] = (f32x4){__uint_as_float(p.z << 16), __uint_as_float(p.z & 0xffff0000u), __uint_as_float(p.w << 16), __uint_as_float(p.w & 0xffff0000u)}; }
            }
#pragma unroll
            for (int m = 0; m < 4; ++m) {
                const int row = row0 + ai * HALF + m * 16;
                float s = 0.f;
#pragma unroll
                for (int bj = 0; bj < 2; ++bj) {
                    const int col = u.pn * BM + bj * HALF + wc * 32 + 8 * fq;
                    const f32x4 v0 = acc[ai][bj][m][0] + pre[m][bj][0], v1 = acc[ai][bj][m][1] + pre[m][bj][1];
                    s += (v0[0] * v0[0] + v0[1] * v0[1]) + (v0[2] * v0[2] + v0[3] * v0[3]) + (v1[0] * v1[0] + v1[1] * v1[1]) + (v1[2] * v1[2] + v1[3] * v1[3]);
                    if (out) { *(f32x4*)(out + (size_t)row * 1024 + col) = v0; *(f32x4*)(out + (size_t)row * 1024 + col + 4) = v1; }
                    if (outb) { u32x4 w; w.x = cvt_pk_bf16(v0[0], v0[1]); w.y = cvt_pk_bf16(v0[2], v0[3]); w.z = cvt_pk_bf16(v1[0], v1[1]); w.w = cvt_pk_bf16(v1[2], v1[3]); st16(outb + (size_t)row * 1024 + col, w); }
                }
                s += __shfl_xor(s, 16); s += __shfl_xor(s, 32);
                if (fq == 0) atomicAdd(ss + row, s);
            }
        }
    }
};

struct EpiResidNorm {
    static constexpr bool PERM = true, AFTER_DRAIN = true;
    const bf16_t* baseB; float* out; float* ss; unsigned* cnt; const float* gfin;
    __device__ __forceinline__ void fused(f32x4 (&acc)[2][2][4][2], const Unit& u, int wr, int wc, int fr, int fq, PG8_LAS unsigned char* lds, int wid, int lane) const {
        const int row0 = u.pm * BM + wr * 64 + fr;
#pragma unroll
        for (int ai = 0; ai < 2; ++ai) {
            u32x4 pb[4][2];
#pragma unroll
            for (int m = 0; m < 4; ++m) { const bf16_t* bp = baseB + (size_t)(row0 + ai * HALF + m * 16) * 1024;
#pragma unroll
                for (int bj = 0; bj < 2; ++bj) pb[m][bj] = *(const u32x4*)(bp + u.pn * BM + bj * HALF + wc * 32 + 8 * fq); }
#pragma unroll
            for (int m = 0; m < 4; ++m) { float s = 0.f;
#pragma unroll
                for (int bj = 0; bj < 2; ++bj) { const u32x4 p = pb[m][bj];
                    const f32x4 v0 = acc[ai][bj][m][0] + (f32x4){__uint_as_float(p.x << 16), __uint_as_float(p.x & 0xffff0000u), __uint_as_float(p.y << 16), __uint_as_float(p.y & 0xffff0000u)};
                    const f32x4 v1 = acc[ai][bj][m][1] + (f32x4){__uint_as_float(p.z << 16), __uint_as_float(p.z & 0xffff0000u), __uint_as_float(p.w << 16), __uint_as_float(p.w & 0xffff0000u)};
                    acc[ai][bj][m][0] = v0; acc[ai][bj][m][1] = v1;
                    s += (v0[0] * v0[0] + v0[1] * v0[1]) + (v0[2] * v0[2] + v0[3] * v0[3]) + (v1[0] * v1[0] + v1[1] * v1[1]) + (v1[2] * v1[2] + v1[3] * v1[3]); }
                s += __shfl_xor(s, 16); s += __shfl_xor(s, 32);
                if (fq == 0) atomicAdd(ss + row0 + ai * HALF + m * 16, s); }
        }
        asm volatile("s_waitcnt vmcnt(0)" ::: "memory");
        __syncthreads();
        if (threadIdx.x == 0) { unsigned* c = cnt + 64 * u.pm;
            __hip_atomic_fetch_add(c, 1u, __ATOMIC_RELEASE, __HIP_MEMORY_SCOPE_AGENT);
            unsigned sp = 0u; while (__hip_atomic_load(c, __ATOMIC_RELAXED, __HIP_MEMORY_SCOPE_AGENT) < 4u) { __builtin_amdgcn_s_sleep(2); if (++sp > (1u << 22)) break; }
            __builtin_amdgcn_fence(__ATOMIC_ACQUIRE, "agent"); }
        __syncthreads();
        float rs[2][4];
#pragma unroll
        for (int ai = 0; ai < 2; ++ai)
#pragma unroll
            for (int m = 0; m < 4; ++m) rs[ai][m] = __hip_atomic_load(ss + row0 + ai * HALF + m * 16, __ATOMIC_RELAXED, __HIP_MEMORY_SCOPE_AGENT);
        f32x4 gv[2][2];
#pragma unroll
        for (int bj = 0; bj < 2; ++bj) { const int col = u.pn * BM + bj * HALF + wc * 32 + 8 * fq; gv[bj][0] = *(const f32x4*)(gfin + col); gv[bj][1] = *(const f32x4*)(gfin + col + 4); }
#pragma unroll
        for (int ai = 0; ai < 2; ++ai)
#pragma unroll
            for (int m = 0; m < 4; ++m) { const int row = row0 + ai * HALF + m * 16; const float rstd = 1.0f / sqrtf(rs[ai][m] * (1.0f / 1024.0f) + RMS_EPS);
#pragma unroll
                for (int bj = 0; bj < 2; ++bj) { const int col = u.pn * BM + bj * HALF + wc * 32 + 8 * fq;
                    *(f32x4*)(out + (size_t)row * 1024 + col) = acc[ai][bj][m][0] * rstd * gv[bj][0]; *(f32x4*)(out + (size_t)row * 1024 + col + 4) = acc[ai][bj][m][1] * rstd * gv[bj][1]; } }
    }
};

struct EpiSwiGLU {
    static constexpr bool PERM = true, AFTER_DRAIN = false;
    bf16_t* ACT; const float* ss;
    __device__ __forceinline__ void operator()(const f32x4 (&acc)[2][2][4][2], const Unit& u, int wr, int wc, int fr, int fq) const {
        const int row0 = u.pm * BM + wr * 64 + fr;
        float ssv[2][4];
#pragma unroll
        for (int ai = 0; ai < 2; ++ai)
#pragma unroll
            for (int m = 0; m < 4; ++m) ssv[ai][m] = ss[row0 + ai * HALF + m * 16];
        const int J = u.pn * 128 + wc * 32 + 8 * fq;
#pragma unroll
        for (int ai = 0; ai < 2; ++ai)
#pragma unroll
            for (int m = 0; m < 4; ++m) {
                const int row = row0 + ai * HALF + m * 16;
                const float r = __builtin_amdgcn_rsqf(ssv[ai][m] * (1.0f / 1024.0f) + RMS_EPS);
                float o[8];
#pragma unroll
                for (int n = 0; n < 2; ++n) { const f32x4 a = acc[ai][0][m][n] * r, b = acc[ai][1][m][n] * r;
#pragma unroll
                    for (int j = 0; j < 4; ++j) o[4 * n + j] = a[j] * sigm(a[j]) * b[j]; }
                u32x4 w; w.x = cvt_pk_bf16(o[0], o[1]); w.y = cvt_pk_bf16(o[2], o[3]); w.z = cvt_pk_bf16(o[4], o[5]); w.w = cvt_pk_bf16(o[6], o[7]);
                st16(ACT + (size_t)row * 2816 + J, w);
            }
    }
};

template <class Epi, class Sched, bool ALIGN_EPI = false, bool SP2 = false>
__device__ __forceinline__ void gemm_phase(PG8_LAS unsigned char* lds, const Gemm g, const Sched& S, const Epi& E) {
    const int tid = threadIdx.x, wid = __builtin_amdgcn_readfirstlane(tid >> 6), lane = tid & 63, wr = wid >> 2, wc = wid & 3, fr = lane & 15, fq = lane >> 4;
    const int K = g.K, nt = K / BK;
    unsigned voffA[2], voffB[2];
#pragma unroll
    for (int i = 0; i < 2; ++i) { int R, C; stage_rc(tid * 16 + i * 8192, R, C); const int Rb = Epi::PERM ? ((R & ~31) + perm32(R & 31)) : R;
        voffA[i] = (unsigned)(R * K + C) * 2u; voffB[i] = (unsigned)(Rb * K + C) * 2u; }
    const size_t kstep = (size_t)(BK * 2);
    const size_t hstep = (size_t)HALF * K * 2;
    const size_t tstep = 2 * hstep;
    const unsigned ldsw = (unsigned)wid * 1024u;
    const int aoff = lds_byte(wr * 64 + fr, fq * 8), boff = lds_byte(wc * 32 + fr, fq * 8);
#define PG8_SA(b, h) (((b) * 2 + (h)) * HTB)
#define PG8_SB(b, h) ((4 + (b) * 2 + (h)) * HTB)
#define PG8_STAGE(bufoff, gbase, voff) do { _Pragma("unroll") for (int _i = 0; _i < 2; ++_i) \
        __builtin_amdgcn_global_load_lds((const unsigned*)((const char*)(gbase) + (voff)[_i]), (PG8_LAS unsigned*)(lds + (bufoff) + ldsw + _i * 8192), 16, 0, 0); } while (0)
#define PG8_LDA(dst, b, h) do { _Pragma("unroll") for (int m = 0; m < 4; ++m) _Pragma("unroll") for (int k = 0; k < 2; ++k) dst[m][k] = *(const PG8_LAS bf16x8*)(lds + PG8_SA(b, h) + aoff + m * 2048 + k * 1024); } while (0)
#define PG8_LDB(dst, b, h) do { _Pragma("unroll") for (int n = 0; n < 2; ++n) _Pragma("unroll") for (int k = 0; k < 2; ++k) dst[n][k] = *(const PG8_LAS bf16x8*)(lds + PG8_SB(b, h) + boff + n * 2048 + k * 1024); } while (0)
#define PG8_MMA(ai, bj, At, Bt) do { __builtin_amdgcn_s_setprio(1); _Pragma("unroll") for (int m = 0; m < 4; ++m) _Pragma("unroll") for (int n = 0; n < 2; ++n) _Pragma("unroll") for (int k = 0; k < 2; ++k) \
        acc[ai][bj][m][n] = __builtin_amdgcn_mfma_f32_16x16x32_bf16(Bt[n][k], At[m][k], acc[ai][bj][m][n], 0, 0, 0); __builtin_amdgcn_s_setprio(0); } while (0)
#define PG8_WAIT_V(n) asm volatile("s_waitcnt vmcnt(" #n ")" ::: "memory")
#define PG8_WAIT_L(n) asm volatile("s_waitcnt lgkmcnt(" #n ")" ::: "memory")
#define PG8_BAR __builtin_amdgcn_s_barrier()
#define PG8_SCHED __builtin_amdgcn_sched_barrier(0)
    Unit cur, nxt; int ui = 0;
    if (!S.next(0, cur)) return;
    f32x4 acc[2][2][4][2];
#pragma unroll
    for (int a = 0; a < 2; ++a)
#pragma unroll
        for (int b = 0; b < 2; ++b)
#pragma unroll
            for (int m = 0; m < 4; ++m)
#pragma unroll
                for (int n = 0; n < 2; ++n) acc[a][b][m][n] = (f32x4){0.f, 0.f, 0.f, 0.f};
    bf16x8 At[4][2], B0[2][2], B1[2][2];
    const char* cA = (const char*)g.A + (size_t)cur.pm * tstep; const char* cB = (const char*)g.Bt + (size_t)cur.pn * tstep;
    S.a_ready(cur);
    if constexpr (SP2) {
        PG8_STAGE(PG8_SB(0, 0), cB, voffB); PG8_STAGE(PG8_SB(0, 1), cB + hstep, voffB); PG8_STAGE(PG8_SA(0, 0), cA, voffA); PG8_STAGE(PG8_SA(0, 1), cA + hstep, voffA);
        if (wr == 1) PG8_BAR;
        PG8_WAIT_V(2); PG8_BAR;
        PG8_STAGE(PG8_SB(1, 0), cB + kstep, voffB); PG8_STAGE(PG8_SA(1, 0), cA + kstep, voffA); PG8_STAGE(PG8_SB(1, 1), cB + hstep + kstep, voffB);
        PG8_WAIT_V(6); PG8_BAR;
    } else {
        PG8_STAGE(PG8_SB(0, 0), cB, voffB); PG8_STAGE(PG8_SA(0, 0), cA, voffA); PG8_STAGE(PG8_SB(0, 1), cB + hstep, voffB); PG8_STAGE(PG8_SA(0, 1), cA + hstep, voffA);
        if (wr == 1) PG8_BAR;
        PG8_WAIT_V(4); PG8_BAR;
        PG8_STAGE(PG8_SB(1, 0), cB + kstep, voffB); PG8_STAGE(PG8_SA(1, 0), cA + kstep, voffA); PG8_STAGE(PG8_SB(1, 1), cB + hstep + kstep, voffB);
        PG8_WAIT_V(6); PG8_BAR;
    }
    for (;;) {
        const bool has_next = S.next(ui + 1, nxt);
        const char* nA = has_next ? (const char*)g.A + (size_t)nxt.pm * tstep : cA; const char* nB = has_next ? (const char*)g.Bt + (size_t)nxt.pn * tstep : cB;
        for (int t = 0; t < nt; t += 2) {
            const bool last = (t == nt - 2);
            const char* a1 = cA + (size_t)(t + 1) * kstep;
            const char* a2 = last ? nA : cA + (size_t)(t + 2) * kstep; const char* b2 = last ? nB : cB + (size_t)(t + 2) * kstep;
            const char* a3 = a2 + kstep; const char* b3 = b2 + kstep;
            if (last && has_next) S.a_ready(nxt);
            if constexpr (SP2) {
            PG8_LDB(B0, 0, 0); PG8_LDB(B1, 0, 1); PG8_SCHED; PG8_LDA(At, 0, 0); PG8_STAGE(PG8_SA(1, 1), a1 + hstep, voffA);
            PG8_WAIT_V(8); PG8_WAIT_L(0); PG8_BAR; PG8_MMA(0, 0, At, B0); PG8_MMA(0, 1, At, B1); PG8_BAR; PG8_SCHED;
            PG8_LDA(At, 0, 1); PG8_STAGE(PG8_SB(0, 0), b2, voffB); PG8_STAGE(PG8_SB(0, 1), b2 + hstep, voffB); PG8_STAGE(PG8_SA(0, 0), a2, voffA);
            PG8_WAIT_V(8); PG8_WAIT_L(0); PG8_BAR; PG8_MMA(1, 0, At, B0); PG8_MMA(1, 1, At, B1); PG8_BAR; PG8_SCHED;
            PG8_LDB(B0, 1, 0); PG8_LDB(B1, 1, 1); PG8_SCHED; PG8_LDA(At, 1, 0); PG8_STAGE(PG8_SA(0, 1), a2 + hstep, voffA);
            PG8_WAIT_V(8); PG8_WAIT_L(0); PG8_BAR; PG8_MMA(0, 0, At, B0); PG8_MMA(0, 1, At, B1); PG8_BAR; PG8_SCHED;
            PG8_LDA(At, 1, 1); PG8_STAGE(PG8_SB(1, 0), b3, voffB); PG8_STAGE(PG8_SB(1, 1), b3 + hstep, voffB); PG8_STAGE(PG8_SA(1, 0), a3, voffA);
            PG8_WAIT_V(8); PG8_WAIT_L(0); PG8_BAR; PG8_MMA(1, 0, At, B0); PG8_MMA(1, 1, At, B1); PG8_BAR; PG8_SCHED;
            } else {
            PG8_LDB(B0, 0, 0); PG8_SCHED; PG8_LDA(At, 0, 0); PG8_STAGE(PG8_SA(1, 1), a1 + hstep, voffA);
            PG8_WAIT_L(8); PG8_BAR; PG8_WAIT_L(0); PG8_MMA(0, 0, At, B0); PG8_BAR; PG8_SCHED;
            PG8_LDB(B1, 0, 1); PG8_STAGE(PG8_SB(0, 0), b2, voffB);
            PG8_BAR; PG8_WAIT_L(0); PG8_MMA(0, 1, At, B1); PG8_BAR;
            PG8_LDA(At, 0, 1); PG8_STAGE(PG8_SA(0, 0), a2, voffA);
            PG8_BAR; PG8_WAIT_L(0); PG8_MMA(1, 0, At, B0); PG8_BAR; PG8_SCHED;
            PG8_STAGE(PG8_SB(0, 1), b2 + hstep, voffB);
            PG8_WAIT_V(6); PG8_BAR; PG8_MMA(1, 1, At, B1); PG8_BAR;
            PG8_LDB(B0, 1, 0); PG8_SCHED; PG8_LDA(At, 1, 0); PG8_STAGE(PG8_SA(0, 1), a2 + hstep, voffA);
            PG8_WAIT_L(8); PG8_BAR; PG8_WAIT_L(0); PG8_MMA(0, 0, At, B0); PG8_BAR; PG8_SCHED;
            PG8_LDB(B1, 1, 1); PG8_STAGE(PG8_SB(1, 0), b3, voffB);
            PG8_BAR; PG8_WAIT_L(0); PG8_MMA(0, 1, At, B1); PG8_BAR;
            PG8_LDA(At, 1, 1); PG8_STAGE(PG8_SA(1, 0), a3, voffA);
            PG8_BAR; PG8_WAIT_L(0); PG8_MMA(1, 0, At, B0); PG8_BAR; PG8_SCHED;
            PG8_STAGE(PG8_SB(1, 1), b3 + hstep, voffB);
            PG8_WAIT_V(6); PG8_BAR; PG8_MMA(1, 1, At, B1); PG8_BAR;
            }
        }
        if constexpr (ALIGN_EPI) { if (wr == 0) PG8_BAR; }
        if constexpr (!Epi::AFTER_DRAIN) { E(acc, cur, wr, wc, fr, fq); S.done(cur); }
        if (!has_next) break;
#pragma unroll
        for (int a = 0; a < 2; ++a)
#pragma unroll
            for (int b = 0; b < 2; ++b)
#pragma unroll
                for (int m = 0; m < 4; ++m)
#pragma unroll
                    for (int n = 0; n < 2; ++n) acc[a][b][m][n] = (f32x4){0.f, 0.f, 0.f, 0.f};
        cur = nxt; cA = nA; cB = nB; ++ui;
        if constexpr (ALIGN_EPI) { if (wr == 1) PG8_BAR; }
    }
    PG8_WAIT_V(0);
    if constexpr (!ALIGN_EPI) { if (wr == 0) PG8_BAR; }
    PG8_BAR;
    if constexpr (Epi::AFTER_DRAIN) { E.fused(acc, cur, wr, wc, fr, fq, lds, wid, lane); S.done(cur); }
#undef PG8_SA
#undef PG8_SB
#undef PG8_STAGE
#undef PG8_LDA
#undef PG8_LDB
#undef PG8_MMA
#undef PG8_WAIT_V
#undef PG8_WAIT_L
#undef PG8_BAR
#undef PG8_SCHED
}
}
#define LAS __attribute__((address_space(3)))
#define XB_TMO      128
#define XB_XCNT(j)  (256  + 64 * (j))
#define XB_XSUB(j)  (1280 + 64 * (j))
#define XB_XGEN(j)  (2304 + 64 * (j))
#define XB_TOP      3328
#define XB_TOPGEN   3392
#define XCD_BAR_WORDS 3456
#define XB_SPIN_CAP (1u << 18)

__device__ __forceinline__ unsigned xb_ld(unsigned* p)              { return __hip_atomic_load(p, __ATOMIC_RELAXED, __HIP_MEMORY_SCOPE_AGENT); }
__device__ __forceinline__ unsigned xb_add(unsigned* p, unsigned v) { return __hip_atomic_fetch_add(p, v, __ATOMIC_RELAXED, __HIP_MEMORY_SCOPE_AGENT); }
__device__ __forceinline__ unsigned xb_xcc_id() { return (unsigned)__builtin_amdgcn_s_getreg((3 << 11) | 20) & 0xFu; }
#define XB_SPIN(cond, bar) do { unsigned _sp = 0; while (cond) { __builtin_amdgcn_s_sleep(1); \
    if ((++_sp & 255u) == 0u) { if (xb_ld(&(bar)[XB_TMO])) break; if (_sp > XB_SPIN_CAP) { atomicAdd(&(bar)[XB_TMO], 1u); break; } } } } while (0)

struct XcdBarrier {
    unsigned* bar; unsigned x;
    volatile LAS unsigned* st;
};

__device__ __forceinline__ XcdBarrier xcd_barrier_post(unsigned* bar, volatile LAS unsigned* st) {
    XcdBarrier b; b.bar = bar; b.x = xb_xcc_id(); b.st = st;
    if (threadIdx.x == 0) (void)xb_add(&bar[XB_XCNT(b.x)], 1u);
    return b;
}
__device__ __forceinline__ void xcd_barrier_complete(unsigned* bar, unsigned x, unsigned& nloc, unsigned& nx) {
    const unsigned G = gridDim.x * gridDim.y * gridDim.z;
    unsigned sum, cnt, mine, sp = 0u;
    for (;;) {
        sum = 0u; cnt = 0u; mine = 0u;
#pragma unroll
        for (unsigned j = 0; j < 16; ++j) { const unsigned c = xb_ld(&bar[XB_XCNT(j)]); sum += c; cnt += (c > 0u) ? 1u : 0u; mine = (j == x) ? c : mine; }
        if (sum == G) break;
        __builtin_amdgcn_s_sleep(1);
        if ((++sp & 255u) == 0u) { if (xb_ld(&bar[XB_TMO])) break; if (sp > XB_SPIN_CAP) { atomicAdd(&bar[XB_TMO], 1u); break; } }
    }
    nloc = mine > 0u ? mine : 1u; nx = cnt > 0u ? cnt : 1u;
}

__device__ __forceinline__ void xcd_barrier(const XcdBarrier& b) {
    asm volatile("s_waitcnt vmcnt(0)" ::: "memory");
    __syncthreads();
    if (threadIdx.x == 0) {
        unsigned* bar = b.bar;
        __builtin_amdgcn_s_waitcnt(0);
        unsigned nloc = b.st[0], nx = b.st[1];
        if (nloc == 0u) { xcd_barrier_complete(bar, b.x, nloc, nx); b.st[0] = nloc; b.st[1] = nx; }
        const unsigned old = xb_add(&bar[XB_XSUB(b.x)], 1u);
        const unsigned gen = old / nloc;
        if (old + 1u == (gen + 1u) * nloc) {
            __builtin_amdgcn_fence(__ATOMIC_RELEASE, "agent");
            asm volatile("s_waitcnt vmcnt(0)" ::: "memory");
            const unsigned og = xb_add(&bar[XB_TOP], 1u);
            const unsigned tg = og / nx;
            if (og + 1u == (tg + 1u) * nx) xb_add(&bar[XB_TOPGEN], 1u);
            else XB_SPIN(xb_ld(&bar[XB_TOPGEN]) == tg, bar);
            __builtin_amdgcn_fence(__ATOMIC_ACQUIRE, "agent");
            xb_add(&bar[XB_XGEN(b.x)], 1u);
            asm volatile("s_waitcnt vmcnt(0)" ::: "memory");
        } else {
            XB_SPIN(xb_ld(&bar[XB_XGEN(b.x)]) == gen, bar);
            __builtin_amdgcn_fence(__ATOMIC_ACQUIRE, "agent");
            asm volatile("s_waitcnt vmcnt(0)" ::: "memory");
        }
    }
    __syncthreads();
}

using pg8::bf16_t; using pg8::f32x4; using pg8::u32x4; using pg8::bf16x8; using pg8::pk_h2; using pg8::h_lo; using pg8::h_hi;
typedef unsigned u32x2v __attribute__((ext_vector_type(2)));
constexpr int DM = 1024, NPR = 16384, NSM = 128, MT = 16640, NVALID = 16512, SEQ = 2048;
constexpr int HW = 512, NIN = 2560, DFF = 2816, NFF2 = 5632, MEMR = 2048;
constexpr float EPS = 1e-6f;
constexpr int NTHREADS = 512;
constexpr int LDS_BYTES = 147456;

constexpr size_t O_YP = 0, O_YS = 16777216, O_HP = 16908288, O_PP = 17432576, O_MK = 17494016, O_MV = 19591168, O_HS = 21688320, O_PS = 30076928;

constexpr size_t MiB = 1u << 20;
constexpr size_t WS_SS1 = 0, WS_SS2 = 128 * 1024, WS_SS3 = 256 * 1024, WS_BAR = 512 * 1024, BAR_BYTES = 65536, WS_SSD = 384 * 1024, WS_SS0 = 640 * 1024, WS_CNT = WS_BAR + 16384;
constexpr size_t WS_WIN = 1 * MiB, WS_WOUT = 6 * MiB, WS_WCQ = 8 * MiB, WS_WCO = 10 * MiB, WS_WFFI = 12 * MiB, WS_WFFO = 23 * MiB, WS_WKV = 29 * MiB, WS_PMIX = 33 * MiB;
constexpr size_t WS_MEMH = 34 * MiB, WS_KB = 38 * MiB, WS_VT = 42 * MiB, WS_DEC = 46 * MiB;
constexpr size_t WS_H0 = 47 * MiB;
constexpr size_t WS_MIX = 80 * MiB;
constexpr size_t WS_X1 = 113 * MiB;
constexpr size_t WS_Q = 178 * MiB;
constexpr size_t WS_O = 211 * MiB;
constexpr size_t WS_SL = 244 * MiB;
constexpr size_t WS_A = 309 * MiB;
constexpr size_t WS_QQ = WS_A, WS_KK = WS_A + 17 * MiB, WS_VV = WS_A + 34 * MiB, WS_GG = WS_A + 51 * MiB, WS_LF = WS_A + 68 * MiB, WS_UU = WS_A + 101 * MiB;
constexpr size_t WS_END = 443 * MiB;

struct Args { const float* in[23]; float* out; unsigned char* ws; int ph_lo, ph_hi; };

typedef float f32x2_t __attribute__((ext_vector_type(2))); typedef __bf16 bf16x2_t __attribute__((ext_vector_type(2)));
__device__ __forceinline__ unsigned pk2(float lo, float hi) { const f32x2_t v = {lo, hi}; const bf16x2_t b = __builtin_convertvector(v, bf16x2_t); return __builtin_bit_cast(unsigned, b); }
__device__ __forceinline__ unsigned f2bf(float f) { return pk2(f, 0.f) & 0xffffu; }
__device__ __forceinline__ float bf2f(unsigned h) { return __uint_as_float(h << 16); }
__device__ __forceinline__ float bfe(const u32x4& v, int j) { const unsigned w = v[j >> 1]; return (j & 1) ? __uint_as_float(w & 0xffff0000u) : __uint_as_float(w << 16); }
__device__ __forceinline__ unsigned short bfr(const u32x4& v, int j) { const unsigned w = v[j >> 1]; return (unsigned short)((j & 1) ? (w >> 16) : (w & 0xffffu)); }
__device__ __forceinline__ float wave_sum(float v) {
#pragma unroll
    for (int o = 1; o < 64; o <<= 1) v += __shfl_xor(v, o);
    return v;
}
#define MFMA16(a, b, c) __builtin_amdgcn_mfma_f32_16x16x32_bf16((a), (b), (c), 0, 0, 0)

template <int MODE>
__device__ __forceinline__ void tr_item(const float* W, int K, int N, bf16_t* WT, const float* gk, float* scr, int item, int lane) {
    const int nblk = N / 32, kb = item / nblk, nb = item % nblk, k0 = 64 * kb, n0 = 32 * nb;
    f32x4 wv[8];
#pragma unroll
    for (int i = 0; i < 8; ++i) { const int kk = 8 * i + (lane >> 3); wv[i] = __builtin_nontemporal_load((const f32x4*)(W + (size_t)(k0 + kk) * N + n0 + (lane & 7) * 4)); }
#pragma unroll
    for (int i = 0; i < 8; ++i) { const int kk = 8 * i + (lane >> 3); float* d = scr + kk * 33 + (lane & 7) * 4; d[0] = wv[i][0]; d[1] = wv[i][1]; d[2] = wv[i][2]; d[3] = wv[i][3]; }
    asm volatile("s_waitcnt lgkmcnt(0)" ::: "memory");
    const int c = lane & 7;
    float g8[8];
#pragma unroll
    for (int i = 0; i < 8; ++i) g8[i] = gk ? gk[k0 + 8 * c + i] : 1.0f;
#pragma unroll
    for (int j = 0; j < 4; ++j) { const int n = (lane >> 3) + 8 * j; const float* s = scr + (8 * c) * 33 + n;
        u32x4 o; o.x = pk2(s[0 * 33] * g8[0], s[1 * 33] * g8[1]); o.y = pk2(s[2 * 33] * g8[2], s[3 * 33] * g8[3]); o.z = pk2(s[4 * 33] * g8[4], s[5 * 33] * g8[5]); o.w = pk2(s[6 * 33] * g8[6], s[7 * 33] * g8[7]);
        int row = n0 + n;
        if (MODE == 1) { const int half = row >= DFF ? 1 : 0; const int J = row - half * DFF;
            row = 256 * (J >> 7) + 128 * half + (J & 127); }
        *(u32x4*)(WT + (size_t)row * K + k0 + 8 * c) = o; }
    asm volatile("s_waitcnt lgkmcnt(0)" ::: "memory");
}
__device__ __forceinline__ void rms_row_to_bf16(const float* xrow, const float* g, bf16_t* orow, int lane) {
    const f32x4* xr = (const f32x4*)xrow + lane; const f32x4* gr = (const f32x4*)g + lane;
    f32x4 v[4]; float s = 0.f;
#pragma unroll
    for (int j = 0; j < 4; ++j) { v[j] = xr[64 * j]; s += (v[j].x * v[j].x + v[j].y * v[j].y) + (v[j].z * v[j].z + v[j].w * v[j].w); }
    const float rstd = 1.0f / sqrtf(wave_sum(s) * (1.f / DM) + EPS);
    unsigned long long* o8 = (unsigned long long*)orow + lane;
#pragma unroll
    for (int j = 0; j < 4; ++j) { const f32x4 gg = gr[64 * j];
        o8[64 * j] = (unsigned long long)pk2(v[j].x * rstd * gg.x, v[j].y * rstd * gg.y) | ((unsigned long long)pk2(v[j].z * rstd * gg.z, v[j].w * rstd * gg.w) << 32); }
}
__device__ __forceinline__ void x_row2_to_bf16(const float* xrow, bf16_t* orow, float* ssrow, int lane) {
    const f32x4* xr = (const f32x4*)xrow + lane;
    f32x4 v[2][4]; float s[2] = {0.f, 0.f};
#pragma unroll
    for (int r = 0; r < 2; ++r)
#pragma unroll
        for (int j = 0; j < 4; ++j) v[r][j] = __builtin_nontemporal_load(xr + r * 256 + 64 * j);
#pragma unroll
    for (int r = 0; r < 2; ++r)
#pragma unroll
        for (int j = 0; j < 4; ++j) s[r] += (v[r][j].x * v[r][j].x + v[r][j].y * v[r][j].y) + (v[r][j].z * v[r][j].z + v[r][j].w * v[r][j].w);
#pragma unroll
    for (int r = 0; r < 2; ++r) { const float tot = wave_sum(s[r]); if (lane == 0) ssrow[r] = tot; unsigned long long* o8 = (unsigned long long*)(orow + (size_t)r * DM) + lane;
#pragma unroll
        for (int j = 0; j < 4; ++j) o8[64 * j] = (unsigned long long)pk2(v[r][j].x, v[r][j].y) | ((unsigned long long)pk2(v[r][j].z, v[r][j].w) << 32); }
}
__device__ __forceinline__ void rms_row2_to_bf16(const float* xrow, const float* g, bf16_t* orow, int lane) {
    const f32x4* xr = (const f32x4*)xrow + lane; const f32x4* gr = (const f32x4*)g + lane;
    f32x4 v[2][4]; float s[2] = {0.f, 0.f};
#pragma unroll
    for (int r = 0; r < 2; ++r)
#pragma unroll
        for (int j = 0; j < 4; ++j) v[r][j] = __builtin_nontemporal_load(xr + r * 256 + 64 * j);
#pragma unroll
    for (int r = 0; r < 2; ++r)
#pragma unroll
        for (int j = 0; j < 4; ++j) s[r] += (v[r][j].x * v[r][j].x + v[r][j].y * v[r][j].y) + (v[r][j].z * v[r][j].z + v[r][j].w * v[r][j].w);
#pragma unroll
    for (int r = 0; r < 2; ++r) { const float rstd = 1.0f / sqrtf(wave_sum(s[r]) * (1.f / DM) + EPS); unsigned long long* o8 = (unsigned long long*)(orow + (size_t)r * DM) + lane;
#pragma unroll
        for (int j = 0; j < 4; ++j) { const f32x4 gg = gr[64 * j];
            o8[64 * j] = (unsigned long long)pk2(v[r][j].x * rstd * gg.x, v[r][j].y * rstd * gg.y) | ((unsigned long long)pk2(v[r][j].z * rstd * gg.z, v[r][j].w * rstd * gg.w) << 32); } }
}
__device__ __forceinline__ void p0_prologue(const Args& A, unsigned char* lds, int G) {
    const int tid = threadIdx.x, lane = tid & 63, wave = tid >> 6;
    float* scr = (float*)(lds + wave * 16384);
    unsigned char* ws = A.ws;
    const int gw = blockIdx.x * 8 + wave, NGW = G * 8;
    constexpr int I_IN = 16 * 80, I_OUT = 16 * 32, I_CQ = 16 * 32, I_CO = 16 * 32, I_FFI = 16 * 176, I_FFO = 44 * 32, I_KV = 16 * 64, I_PM = 4 * 8;
    constexpr int NITEMS = I_IN + I_OUT + I_CQ + I_CO + I_FFI + I_FFO + I_KV + I_PM;
    for (int it = gw; it < NITEMS; it += NGW) {
        int r = it;
        if (r < I_IN) { tr_item<0>(A.in[8], DM, NIN, (bf16_t*)(ws + WS_WIN), A.in[7], scr, r, lane); continue; } r -= I_IN;
        if (r < I_OUT) { tr_item<0>(A.in[13], DM, DM, (bf16_t*)(ws + WS_WOUT), nullptr, scr, r, lane); continue; } r -= I_OUT;
        if (r < I_CQ) { tr_item<0>(A.in[17], DM, DM, (bf16_t*)(ws + WS_WCQ), A.in[16], scr, r, lane); continue; } r -= I_CQ;
        if (r < I_CO) { tr_item<0>(A.in[18], DM, DM, (bf16_t*)(ws + WS_WCO), nullptr, scr, r, lane); continue; } r -= I_CO;
        if (r < I_FFI) { tr_item<1>(A.in[20], DM, NFF2, (bf16_t*)(ws + WS_WFFI), A.in[19], scr, r, lane); continue; } r -= I_FFI;
        if (r < I_FFO) { tr_item<0>(A.in[21], DFF, DM, (bf16_t*)(ws + WS_WFFO), nullptr, scr, r, lane); continue; } r -= I_FFO;
        if (r < I_KV) { tr_item<0>(A.in[15], DM, 2 * DM, (bf16_t*)(ws + WS_WKV), nullptr, scr, r, lane); continue; } r -= I_KV;
        { const int g = r >> 3; tr_item<0>(A.in[11] + (size_t)g * 128 * 128, 128, 128, (bf16_t*)(ws + WS_PMIX) + (size_t)g * 128 * 128, nullptr, scr, r & 7, lane); }
    }
    bf16_t* H0 = (bf16_t*)(ws + WS_H0);
    for (int m = gw * 2; m < NVALID; m += NGW * 2) { const float* xr = m < NPR ? A.in[0] + (size_t)m * DM : A.in[1] + (size_t)(m - NPR) * DM; x_row2_to_bf16(xr, H0 + (size_t)m * DM, (float*)(ws + WS_SS0) + m, lane); }
    bf16_t* MEMH = (bf16_t*)(ws + WS_MEMH);
    for (int m = gw; m < MEMR; m += NGW) rms_row_to_bf16(A.in[2] + (size_t)m * DM, A.in[14], MEMH + (size_t)m * DM, lane);
    const int gt = blockIdx.x * NTHREADS + tid, NGT = G * NTHREADS;
    for (int i = gt; i < (MT - NVALID) * DM / 8; i += NGT) { const u32x4 z = {0u, 0u, 0u, 0u};
        ((u32x4*)(ws + WS_H0) + (size_t)NVALID * DM / 8)[i] = z; ((u32x4*)(ws + WS_MIX) + (size_t)NVALID * DM / 8)[i] = z; ((u32x4*)(ws + WS_O) + (size_t)NVALID * DM / 8)[i] = z; }
    for (int i = NVALID + gt; i < MT; i += NGT) ((float*)(ws + WS_SS0))[i] = 0.f;
    for (int i = gt; i < MT; i += NGT) { ((float*)(ws + WS_SS1))[i] = 0.f; ((float*)(ws + WS_SS2))[i] = 0.f; ((float*)(ws + WS_SS3))[i] = 0.f; }
}

constexpr int BS = 129;
constexpr int L_BC = 0, L_TOT = 33024, L_QM = 35072, L_KM = 52480, L_VT = 69888, L_SP = 88320, L_AL = 123136, L_PART = 132352, L_EM = 132864;
constexpr size_t WS_SPT = WS_X1;
__device__ __forceinline__ void hgrn_lf_load(u32x2v (&lf)[4], const unsigned short* LF, int R0, int C0, int t) {
#pragma unroll
    for (int i = 0; i < 4; ++i) { const int idx = i * 512 + t, s = idx >> 5, k4 = idx & 31; lf[i] = *(const u32x2v*)(LF + (size_t)(R0 + s) * HW + C0 + k4 * 4); }
}
__device__ __forceinline__ void hgrn_cumsum(const u32x2v (&lf)[4], float* Bc, float* tot, int t) {
#pragma unroll
    for (int i = 0; i < 4; ++i) { const int idx = i * 512 + t, s = idx >> 5, k4 = idx & 31; const u32x2v v = lf[i];
        float* d = Bc + s * BS + k4 * 4; d[0] = h_lo(v.x); d[1] = h_hi(v.x); d[2] = h_lo(v.y); d[3] = h_hi(v.y); }
    __syncthreads();
    const int seg = t >> 7, k = t & 127; float run = 0.f;
#pragma unroll
    for (int i = 0; i < 16; ++i) { run += Bc[(seg * 16 + i) * BS + k]; Bc[(seg * 16 + i) * BS + k] = run; }
    tot[seg * 128 + k] = run;
    __syncthreads();
    float off = 0.f;
#pragma unroll
    for (int j = 0; j < 3; ++j) off += (j < seg) ? tot[j * 128 + k] : 0.f;
#pragma unroll
    for (int i = 0; i < 16; ++i) Bc[(seg * 16 + i) * BS + k] += off;
    __syncthreads();
}
__device__ __forceinline__ void hgrn_local_load(const Args& A, int unit, u32x2v (&lf)[4], u32x4 (&kkr)[2], u32x4 (&vvr)[2]) {
    const int t = threadIdx.x, w = t >> 6, l = t & 63;
    const int bh = unit >> 5, c = unit & 31, b = bh >> 2, h = bh & 3, R0 = b * SEQ + c * 64, C0 = h * 128;
    const bf16_t* KK = (const bf16_t*)(A.ws + WS_KK); const bf16_t* VV = (const bf16_t*)(A.ws + WS_VV);
    hgrn_lf_load(lf, (const unsigned short*)(A.ws + WS_LF), R0, C0, t);
#pragma unroll
    for (int i = 0; i < 2; ++i) { const int k0 = (w + 8 * i) * 8; kkr[i] = *(const u32x4*)(KK + (size_t)(R0 + l) * HW + C0 + k0); vvr[i] = *(const u32x4*)(VV + (size_t)(R0 + l) * HW + C0 + k0); }
}
__device__ __forceinline__ void hgrn_local_unit(const Args& A, unsigned char* lds, int unit, int next, u32x2v (&lf)[4], u32x4 (&kkr)[2], u32x4 (&vvr)[2]) {
    const int t = threadIdx.x, w = t >> 6, l = t & 63, lr = l & 15, lq = l >> 4;
    const int bh = unit >> 5, c = unit & 31, b = bh >> 2, h = bh & 3, R0 = b * SEQ + c * 64, C0 = h * 128;
    unsigned char* ws = A.ws;
    float* Bc = (float*)(lds + L_BC); float* tot = (float*)(lds + L_TOT);
    bf16_t* kdT = (bf16_t*)(lds + L_QM); bf16_t* vT = (bf16_t*)(lds + L_VT);
    hgrn_cumsum(lf, Bc, tot, t);
#pragma unroll
    for (int i = 0; i < 2; ++i) { const int s = l, k0 = (w + 8 * i) * 8;
        const u32x4 kk = kkr[i], vv = vvr[i];
#pragma unroll
        for (int j = 0; j < 8; ++j) { const float e = __expf(Bc[63 * BS + k0 + j] - Bc[s * BS + k0 + j]);
            kdT[(k0 + j) * 72 + s] = (bf16_t)f2bf(bfe(kk, j) * e); vT[(k0 + j) * 72 + s] = bfr(vv, j); } }
    if (next >= 0) hgrn_local_load(A, next, lf, kkr, vvr);
    __syncthreads();
    f32x4 acc[8];
#pragma unroll
    for (int i = 0; i < 8; ++i) acc[i] = (f32x4){0.f, 0.f, 0.f, 0.f};
#pragma unroll
    for (int ks = 0; ks < 2; ++ks) { const bf16x8 a = *(const bf16x8*)(kdT + (16 * w + lr) * 72 + ks * 32 + lq * 8);
#pragma unroll
        for (int vt = 0; vt < 8; ++vt) { const bf16x8 bb = *(const bf16x8*)(vT + (16 * vt + lr) * 72 + ks * 32 + lq * 8); acc[vt] = MFMA16(a, bb, acc[vt]); } }
    unsigned short* SLT = (unsigned short*)(ws + WS_SL) + (size_t)unit * 16384;
#pragma unroll
    for (int vt = 0; vt < 8; ++vt) { u32x2v o; o.x = pk_h2(acc[vt][0], acc[vt][1]); o.y = pk_h2(acc[vt][2], acc[vt][3]); *(u32x2v*)(SLT + (16 * vt + lr) * 128 + 16 * w + lq * 4) = o; }
    if (t < 128) ((float*)(ws + WS_DEC))[unit * 128 + t] = __expf(Bc[63 * BS + t]);
    __syncthreads();
}
__device__ __forceinline__ void hgrn_out_load(const Args& A, int unit, u32x2v (&lf)[4], u32x4 (&qqr)[2], u32x4 (&kkr)[2], u32x4 (&vvr)[2], u32x4 (&spr)[4]) {
    const int t = threadIdx.x, w = t >> 6, l = t & 63;
    const int bh = unit >> 5, c = unit & 31, b = bh >> 2, h = bh & 3, R0 = b * SEQ + c * 64, C0 = h * 128;
    const bf16_t* QQ = (const bf16_t*)(A.ws + WS_QQ); const bf16_t* KK = (const bf16_t*)(A.ws + WS_KK); const bf16_t* VV = (const bf16_t*)(A.ws + WS_VV);
    hgrn_lf_load(lf, (const unsigned short*)(A.ws + WS_LF), R0, C0, t);
#pragma unroll
    for (int i = 0; i < 2; ++i) { const int idx = (i * 512 + t) * 8, s = idx >> 7, k0 = idx & 127; const size_t go = (size_t)(R0 + s) * HW + C0 + k0; qqr[i] = *(const u32x4*)(QQ + go); kkr[i] = *(const u32x4*)(KK + go);
        vvr[i] = *(const u32x4*)(VV + (size_t)(R0 + l) * HW + C0 + (w + 8 * i) * 8); }
    const bf16_t* SPT = (const bf16_t*)(A.ws + WS_SPT) + (size_t)unit * 16384;
#pragma unroll
    for (int i = 0; i < 4; ++i) { const int idx = i * 512 + t; spr[i] = *(const u32x4*)(SPT + (idx >> 4) * 128 + (idx & 15) * 8); }
}
__device__ __forceinline__ void hgrn_out_unit(const Args& A, unsigned char* lds, int unit, int next, u32x2v (&lf)[4], u32x4 (&qqr)[2], u32x4 (&kkr)[2], u32x4 (&vvr)[2], u32x4 (&spr)[4]) {
    const int t = threadIdx.x, w = t >> 6, l = t & 63, lr = l & 15, lq = l >> 4;
    const int bh = unit >> 5, c = unit & 31, b = bh >> 2, h = bh & 3, R0 = b * SEQ + c * 64, C0 = h * 128;
    unsigned char* ws = A.ws;
    float* Bc = (float*)(lds + L_BC); float* tot = (float*)(lds + L_TOT); float* part = (float*)(lds + L_PART); float* em = (float*)(lds + L_EM);
    bf16_t* qm = (bf16_t*)(lds + L_QM); bf16_t* km = (bf16_t*)(lds + L_KM); bf16_t* vT = (bf16_t*)(lds + L_VT); bf16_t* spT = (bf16_t*)(lds + L_SP); bf16_t* aL = (bf16_t*)(lds + L_AL);
    u32x4 ggr[2];
#pragma unroll
    for (int hh = 0; hh < 2; ++hh) ggr[hh] = *(const u32x4*)((const bf16_t*)(ws + WS_GG) + (size_t)(R0 + (t >> 3)) * HW + C0 + (t & 7) * 16 + hh * 8);
    hgrn_cumsum(lf, Bc, tot, t);
    if (t < 128) em[t] = __expf(Bc[31 * BS + t]);
#pragma unroll
    for (int i = 0; i < 2; ++i) { const int idx = (i * 512 + t) * 8, s = idx >> 7, k0 = idx & 127;
        const u32x4 qq = qqr[i], kk = kkr[i];
        float qv[8], kv[8];
#pragma unroll
        for (int j = 0; j < 8; ++j) { const float d = Bc[s * BS + k0 + j] - Bc[31 * BS + k0 + j]; qv[j] = bfe(qq, j) * __expf(d); kv[j] = bfe(kk, j) * __expf(-d); }
        u32x4 o; o.x = pk2(qv[0], qv[1]); o.y = pk2(qv[2], qv[3]); o.z = pk2(qv[4], qv[5]); o.w = pk2(qv[6], qv[7]); *(u32x4*)(qm + s * 136 + k0) = o;
        o.x = pk2(kv[0], kv[1]); o.y = pk2(kv[2], kv[3]); o.z = pk2(kv[4], kv[5]); o.w = pk2(kv[6], kv[7]); *(u32x4*)(km + s * 136 + k0) = o; }
#pragma unroll
    for (int i = 0; i < 2; ++i) { const int s = l, k0 = (w + 8 * i) * 8; const u32x4 vv = vvr[i];
#pragma unroll
        for (int j = 0; j < 8; ++j) vT[(k0 + j) * 72 + s] = bfr(vv, j); }
    __syncthreads();
    {
#pragma unroll
        for (int i = 0; i < 4; ++i) { const int idx = i * 512 + t, v = idx >> 4, k0 = (idx & 15) * 8; const u32x4 sv = spr[i];
            u32x4 o; o.x = pk2(bfe(sv, 0) * em[k0], bfe(sv, 1) * em[k0 + 1]); o.y = pk2(bfe(sv, 2) * em[k0 + 2], bfe(sv, 3) * em[k0 + 3]); o.z = pk2(bfe(sv, 4) * em[k0 + 4], bfe(sv, 5) * em[k0 + 5]); o.w = pk2(bfe(sv, 6) * em[k0 + 6], bfe(sv, 7) * em[k0 + 7]);
            *(u32x4*)(spT + v * 136 + k0) = o; } }
    if (next >= 0) hgrn_out_load(A, next, lf, qqr, kkr, vvr, spr);
    {
        const int ct = w & 3;
        f32x4 a2[2]; a2[0] = (f32x4){0.f, 0.f, 0.f, 0.f}; a2[1] = a2[0];
#pragma unroll
        for (int ks = 0; ks < 4; ++ks) { const bf16x8 a = *(const bf16x8*)(qm + (16 * ct + lr) * 136 + ks * 32 + lq * 8);
#pragma unroll
            for (int i = 0; i < 2; ++i) { const int st = (w >> 2) * 2 + i; const bf16x8 bb = *(const bf16x8*)(km + (16 * st + lr) * 136 + ks * 32 + lq * 8); a2[i] = MFMA16(a, bb, a2[i]); } }
#pragma unroll
        for (int i = 0; i < 2; ++i) { const int st = (w >> 2) * 2 + i, s = 16 * st + lr;
#pragma unroll
            for (int r = 0; r < 4; ++r) { const int cc = 16 * ct + lq * 4 + r; aL[cc * 72 + s] = (bf16_t)f2bf(s <= cc ? a2[i][r] : 0.f); } }
    }
    __syncthreads();
    const int ct = w & 3, vh = w >> 2;
    f32x4 o4[4];
#pragma unroll
    for (int i = 0; i < 4; ++i) o4[i] = (f32x4){0.f, 0.f, 0.f, 0.f};
#pragma unroll
    for (int ks = 0; ks < 4; ++ks) { const bf16x8 a = *(const bf16x8*)(qm + (16 * ct + lr) * 136 + ks * 32 + lq * 8);
#pragma unroll
        for (int i = 0; i < 4; ++i) { const int vt = vh * 4 + i; const bf16x8 bb = *(const bf16x8*)(spT + (16 * vt + lr) * 136 + ks * 32 + lq * 8); o4[i] = MFMA16(a, bb, o4[i]); } }
#pragma unroll
    for (int ks = 0; ks < 2; ++ks) { const bf16x8 a = *(const bf16x8*)(aL + (16 * ct + lr) * 72 + ks * 32 + lq * 8);
#pragma unroll
        for (int i = 0; i < 4; ++i) { const int vt = vh * 4 + i; const bf16x8 bb = *(const bf16x8*)(vT + (16 * vt + lr) * 72 + ks * 32 + lq * 8); o4[i] = MFMA16(a, bb, o4[i]); } }
    float* ost = (float*)(lds + L_BC);
#pragma unroll
    for (int r = 0; r < 4; ++r) { float s = 0.f;
#pragma unroll
        for (int i = 0; i < 4; ++i) { s += o4[i][r] * o4[i][r]; ost[(16 * ct + lq * 4 + r) * 132 + (vh * 4 + i) * 16 + lr] = o4[i][r]; }
        s += __shfl_xor(s, 1); s += __shfl_xor(s, 2); s += __shfl_xor(s, 4); s += __shfl_xor(s, 8);
        if (lr == 0) part[vh * 64 + 16 * ct + lq * 4 + r] = s; }
    __syncthreads();
    {   const float* hn = A.in[10]; bf16_t* MIX = (bf16_t*)(ws + WS_MIX);
        const int cc = t >> 3, v0 = (t & 7) * 16; const float rstd = __builtin_amdgcn_rsqf((part[cc] + part[64 + cc]) * (1.0f / 128.0f) + EPS);
#pragma unroll
        for (int hh = 0; hh < 2; ++hh) { const int v = v0 + hh * 8; const u32x4 g8 = ggr[hh];
            const f32x4 oa = *(const f32x4*)(ost + cc * 132 + v), ob = *(const f32x4*)(ost + cc * 132 + v + 4), na = *(const f32x4*)(hn + C0 + v), nb = *(const f32x4*)(hn + C0 + v + 4);
            u32x4 o; o.x = pk2(oa[0] * rstd * na[0] * bfe(g8, 0), oa[1] * rstd * na[1] * bfe(g8, 1)); o.y = pk2(oa[2] * rstd * na[2] * bfe(g8, 2), oa[3] * rstd * na[3] * bfe(g8, 3));
            o.z = pk2(ob[0] * rstd * nb[0] * bfe(g8, 4), ob[1] * rstd * nb[1] * bfe(g8, 5)); o.w = pk2(ob[2] * rstd * nb[2] * bfe(g8, 6), ob[3] * rstd * nb[3] * bfe(g8, 7));
            *(u32x4*)(MIX + (size_t)(R0 + cc) * DM + C0 + v) = o; } }
    __syncthreads();
}
__device__ __forceinline__ void hgrn_scan(const Args& A, int G) {
    const u32x2v* SLT = (const u32x2v*)(A.ws + WS_SL); const f32x4* DEC4 = (const f32x4*)(A.ws + WS_DEC); u32x2v* SPT = (u32x2v*)(A.ws + WS_SPT); float* outp = A.out + O_HP;
    for (int e = blockIdx.x * NTHREADS + threadIdx.x; e < 32 * 4096; e += G * NTHREADS) { const int bh = e >> 12, i4 = e & 4095, v = i4 >> 5, k4 = i4 & 31;
        f32x4 S = (f32x4){0.f, 0.f, 0.f, 0.f};
        const u32x2v* p = SLT + (size_t)bh * 32 * 4096 + i4; u32x2v* q = SPT + (size_t)bh * 32 * 4096 + i4; const f32x4* dp = DEC4 + (size_t)bh * 32 * 32 + k4;
#pragma unroll
        for (int hf = 0; hf < 2; ++hf) { u32x2v loc[16]; f32x4 dd[16];
#pragma unroll
            for (int c = 0; c < 16; ++c) { loc[c] = p[(size_t)(hf * 16 + c) * 4096]; dd[c] = dp[(hf * 16 + c) * 32]; }
#pragma unroll
            for (int c = 0; c < 16; ++c) { u32x2v o; o.x = pk2(S[0], S[1]); o.y = pk2(S[2], S[3]); q[(size_t)(hf * 16 + c) * 4096] = o; const f32x4 lv = (f32x4){h_lo(loc[c].x), h_hi(loc[c].x), h_lo(loc[c].y), h_hi(loc[c].y)}; S = S * dd[c] + lv; } }
        float* ob = outp + (size_t)bh * 16384 + (k4 * 4) * 128 + v; ob[0] = S[0]; ob[128] = S[1]; ob[256] = S[2]; ob[384] = S[3]; }
}
__device__ __forceinline__ void pool_states(const Args& A, int G) {
    const unsigned short* UU = (const unsigned short*)(A.ws + WS_UU);
    const int gt = blockIdx.x * NTHREADS + threadIdx.x, NGT = G * NTHREADS;
    for (int i = gt; i < 8 * 15 * 128; i += NGT) { const int c4 = i & 127, j = (i >> 7) % 15, b = i / (15 * 128); const u32x2v v = *(const u32x2v*)(UU + (size_t)(b * SEQ + 2033 + j) * HW + c4 * 4);
        *(f32x4*)(A.out + O_PP + (size_t)i * 4) = (f32x4){h_lo(v.x), h_hi(v.x), h_lo(v.y), h_hi(v.y)}; }
    for (int i0 = gt * 2; i0 < 128 * 15 * 128; i0 += NGT * 2) { f32x4 v[2];
#pragma unroll
        for (int q = 0; q < 2; ++q) { const int i = i0 + q, c4 = i & 127, j = (i >> 7) % 15, b = i / (15 * 128);
            if (j < 14) v[q] = *(const f32x4*)(A.in[4] + (size_t)(b * 15 + j + 1) * 512 + c4 * 4);
            else { const u32x2v h = *(const u32x2v*)(UU + (size_t)(NPR + b) * HW + c4 * 4); v[q] = (f32x4){h_lo(h.x), h_hi(h.x), h_lo(h.y), h_hi(h.y)}; } }
#pragma unroll
        for (int q = 0; q < 2; ++q) *(f32x4*)(A.out + O_PS + (size_t)(i0 + q) * 4) = v[q]; }
}
__device__ __forceinline__ void hgrn_sample_load(const Args& A, int unit, f32x4 (&sreg)[8]) {
    const int t = threadIdx.x; const float* S0 = A.in[3] + (size_t)unit * 16384;
#pragma unroll
    for (int i = 0; i < 8; ++i) sreg[i] = __builtin_nontemporal_load((const f32x4*)(S0 + ((t >> 5) * 8 + i) * 128 + (t & 31) * 4));
}
__device__ __forceinline__ void hgrn_sample_unit(const Args& A, unsigned char* lds, int unit, int next, f32x4 (&sreg)[8]) {
    const int t = threadIdx.x, b = unit >> 2, h = unit & 3, row = NPR + b, C0 = h * 128;
    unsigned char* ws = A.ws;
    float* qs = (float*)lds; float* ks = qs + 128; float* fs = ks + 128; float* vs = fs + 128; float* po = vs + 128;
    float* red = po + 16 * 128;
    float* S1 = A.out + O_HS + (size_t)unit * 16384;
    if (t < 128) { const size_t go = (size_t)row * HW + C0 + t;
        qs[t] = bf2f(((const bf16_t*)(ws + WS_QQ))[go]); ks[t] = bf2f(((const bf16_t*)(ws + WS_KK))[go]); fs[t] = __expf((float)__builtin_bit_cast(_Float16, ((const unsigned short*)(ws + WS_LF))[go])); vs[t] = bf2f(((const bf16_t*)(ws + WS_VV))[go]); }
    __syncthreads();
    const int v4 = t & 31, kg = t >> 5;
    const f32x4 vv = *(const f32x4*)(vs + v4 * 4);
    f32x4 o = (f32x4){0.f, 0.f, 0.f, 0.f};
#pragma unroll
    for (int i = 0; i < 8; ++i) { const int k = kg * 8 + i; const f32x4 s = sreg[i]; const f32x4 sn = s * fs[k] + vv * ks[k]; __builtin_nontemporal_store(sn, (f32x4*)(S1 + k * 128 + v4 * 4)); o += sn * qs[k]; }
    *(f32x4*)(po + kg * 128 + v4 * 4) = o;
    if (next >= 0) hgrn_sample_load(A, next, sreg);
    __syncthreads();
    float ov = 0.f;
    if (t < 128) {
#pragma unroll
        for (int i = 0; i < 16; ++i) ov += po[i * 128 + t];
        const float sq = wave_sum(ov * ov); if ((t & 63) == 0) red[t >> 6] = sq; }
    __syncthreads();
    if (t < 128) { const float rstd = __builtin_amdgcn_rsqf((red[0] + red[1]) * (1.0f / 128.0f) + EPS); const float g = bf2f(((const bf16_t*)(ws + WS_GG))[(size_t)row * HW + C0 + t]);
        ((bf16_t*)(ws + WS_MIX))[(size_t)row * DM + C0 + t] = (bf16_t)f2bf(ov * rstd * A.in[10][C0 + t] * g); }
    __syncthreads();
}

constexpr int LP_EXT = 0, LP_PL = 40448, LP_MX = 57856;
__device__ __forceinline__ void pool_load(const Args& A, int unit, u32x4 (&mreg)[4], u32x2v (&ereg)[5]) {
    const int t = threadIdx.x; const int tt = unit >> 2, g = unit & 3;
    const unsigned short* UU = (const unsigned short*)(A.ws + WS_UU);
    const bf16_t* PM = (const bf16_t*)(A.ws + WS_PMIX) + (size_t)g * 16384;
#pragma unroll
    for (int i = 0; i < 4; ++i) { const int idx = i * 512 + t, d = idx >> 4, c8 = idx & 15; mreg[i] = *(const u32x4*)(PM + d * 128 + c8 * 8); }
    const int b = tt >> 5, t0 = (tt & 31) * 64;
#pragma unroll
    for (int i5 = 0; i5 < 5; ++i5) { const int idx = i5 * 512 + t, i = idx >> 5, c4 = idx & 31; const int tp = t0 - 15 + i;
        ereg[i5] = (u32x2v){0u, 0u}; if (idx < 79 * 32 && tp >= 0) ereg[i5] = *(const u32x2v*)(UU + (size_t)(b * SEQ + tp) * HW + g * 128 + c4 * 4); }
}
__device__ __forceinline__ void pool_unit(const Args& A, unsigned char* lds, int unit, int next, u32x4 (&mreg)[4], u32x2v (&ereg)[5]) {
    const int t = threadIdx.x, w = t >> 6, l = t & 63, lr = l & 15, lq = l >> 4;
    const int tt = unit >> 2, g = unit & 3, win = 2 << g;
    unsigned char* ws = A.ws;
    float* ext = (float*)(lds + LP_EXT); bf16_t* pl = (bf16_t*)(lds + LP_PL); bf16_t* mx = (bf16_t*)(lds + LP_MX);
    const unsigned short* UU = (const unsigned short*)(ws + WS_UU);
    {
#pragma unroll
        for (int i = 0; i < 4; ++i) { const int idx = i * 512 + t, d = idx >> 4, c8 = idx & 15; *(u32x4*)(mx + d * 136 + c8 * 8) = mreg[i]; }
    }
    int rowbase;
    {
        const int b = tt >> 5, t0 = (tt & 31) * 64; rowbase = b * SEQ + t0;
#pragma unroll
        for (int i5 = 0; i5 < 5; ++i5) { const int idx = i5 * 512 + t, i = idx >> 5, c4 = idx & 31; if (idx < 79 * 32) *(f32x4*)(ext + i * 128 + c4 * 4) = (f32x4){h_lo(ereg[i5].x), h_hi(ereg[i5].x), h_lo(ereg[i5].y), h_hi(ereg[i5].y)}; }
        if (next >= 0) pool_load(A, next, mreg, ereg);
        __syncthreads();
        const int cch = t & 127, tg = t >> 7, tk0 = tg * 16;
        float nw[16], od[16], ini[16];
#pragma unroll
        for (int i = 0; i < 16; ++i) { nw[i] = ext[(15 + tk0 + i) * 128 + cch]; od[i] = (i >= 1) ? ext[(15 + tk0 + i - win) * 128 + cch] : 0.f; ini[i] = (i >= 1 && i < win) ? ext[(15 + tk0 - i) * 128 + cch] : 0.f; }
        float sw = 0.f;
#pragma unroll
        for (int i = 1; i < 16; ++i) sw += ini[i];
#pragma unroll
        for (int i = 0; i < 16; ++i) { const int tok = tk0 + i; sw += nw[i]; sw -= od[i];
            const int cnt = min(t0 + tok + 1, win);
            pl[tok * 136 + cch] = (bf16_t)f2bf(sw * __builtin_amdgcn_rcpf((float)cnt) - nw[i]); }
    }
    __syncthreads();
    const int ct = w & 3, dh = w >> 2;
    f32x4 o4[4];
#pragma unroll
    for (int i = 0; i < 4; ++i) o4[i] = (f32x4){0.f, 0.f, 0.f, 0.f};
#pragma unroll
    for (int ks = 0; ks < 4; ++ks) { const bf16x8 a = *(const bf16x8*)(pl + (16 * ct + lr) * 136 + ks * 32 + lq * 8);
#pragma unroll
        for (int i = 0; i < 4; ++i) { const int dt = dh * 4 + i; const bf16x8 bb = *(const bf16x8*)(mx + (16 * dt + lr) * 136 + ks * 32 + lq * 8); o4[i] = MFMA16(a, bb, o4[i]); } }
    bf16_t* MIX = (bf16_t*)(ws + WS_MIX); const float* psc = A.in[12];
    float* ost = (float*)(lds + LP_EXT);
#pragma unroll
    for (int i = 0; i < 4; ++i) { const int d = (dh * 4 + i) * 16 + lr; const float sc = psc[g * 128 + d];
#pragma unroll
        for (int r = 0; r < 4; ++r) ost[(16 * ct + lq * 4 + r) * 132 + d] = o4[i][r] * sc; }
    __syncthreads();
    {   const int tok = t >> 3, d0 = (t & 7) * 16;
#pragma unroll
        for (int hh = 0; hh < 2; ++hh) { const f32x4 oa = *(const f32x4*)(ost + tok * 132 + d0 + hh * 8), ob = *(const f32x4*)(ost + tok * 132 + d0 + hh * 8 + 4);
            u32x4 o; o.x = pk2(oa[0], oa[1]); o.y = pk2(oa[2], oa[3]); o.z = pk2(ob[0], ob[1]); o.w = pk2(ob[2], ob[3]);
            *(u32x4*)(MIX + (size_t)(rowbase + tok) * DM + 512 + g * 128 + d0 + hh * 8) = o; } }
    __syncthreads();
}

__device__ __forceinline__ void pool_sample_unit(const Args& A, unsigned char* lds, int unit) {
    const int t = threadIdx.x, w = t >> 6, l = t & 63, lr = l & 15, lq = l >> 4;
    const int su = unit >> 2, g = unit & 3, win = 2 << g;
    unsigned char* ws = A.ws;
    bf16_t* pl = (bf16_t*)(lds + LP_PL); bf16_t* mx = (bf16_t*)(lds + LP_MX);
    const _Float16* UU = (const _Float16*)(ws + WS_UU);
    const bf16_t* PM = (const bf16_t*)(ws + WS_PMIX) + (size_t)g * 16384;
    u32x4 mreg[4];
#pragma unroll
    for (int i = 0; i < 4; ++i) { const int idx = i * 512 + t, d = idx >> 4, c8 = idx & 15; mreg[i] = *(const u32x4*)(PM + d * 128 + c8 * 8); }
    const int cch = t & 127, sq = t >> 7;
    const float psc_w = A.in[12][g * 128 + 16 * w + lr];
#pragma unroll
    for (int i = 0; i < 4; ++i) { const int tok = sq * 4 + i, sb = su * 16 + tok; const float uv = (float)UU[(size_t)(NPR + sb) * HW + g * 128 + cch];
        float pv[15];
#pragma unroll
        for (int j = 0; j < 15; ++j) pv[j] = A.in[4][(size_t)(sb * 15 + j) * 512 + g * 128 + cch];
        float sacc = uv;
#pragma unroll
        for (int j = 0; j < 15; ++j) sacc += (j >= 16 - win) ? pv[j] : 0.f;
        pl[tok * 136 + cch] = (bf16_t)f2bf(sacc * __builtin_amdgcn_rcpf((float)win) - uv); }
#pragma unroll
    for (int i = 0; i < 4; ++i) { const int idx = i * 512 + t, d = idx >> 4, c8 = idx & 15; *(u32x4*)(mx + d * 136 + c8 * 8) = mreg[i]; }
    __syncthreads();
    f32x4 acc = (f32x4){0.f, 0.f, 0.f, 0.f};
#pragma unroll
    for (int ks = 0; ks < 4; ++ks) { const bf16x8 a = *(const bf16x8*)(pl + lr * 136 + ks * 32 + lq * 8); const bf16x8 bb = *(const bf16x8*)(mx + (16 * w + lr) * 136 + ks * 32 + lq * 8); acc = MFMA16(a, bb, acc); }
    bf16_t* MIX = (bf16_t*)(ws + WS_MIX);
#pragma unroll
    for (int r = 0; r < 4; ++r) MIX[(size_t)(NPR + su * 16 + lq * 4 + r) * DM + 512 + g * 128 + 16 * w + lr] = (bf16_t)f2bf(acc[r] * psc_w);
    __syncthreads();
}

__device__ __forceinline__ void attn_prompt_unit(const Args& A, unsigned char* lds, int unit) {
    const int t = threadIdx.x, w = t >> 6, l = t & 63, lr = l & 15, lq = l >> 4;
    const int qt = unit & 15, h = (unit >> 4) & 3, b = unit >> 6;
    unsigned char* ws = A.ws;
    const bf16_t* Q = (const bf16_t*)(ws + WS_Q); const bf16_t* KB = (const bf16_t*)(ws + WS_KB); const bf16_t* VT = (const bf16_t*)(ws + WS_VT); bf16_t* O = (bf16_t*)(ws + WS_O);
    const int R0 = b * SEQ + qt * 128 + 16 * w;
    bf16_t* CB = (bf16_t*)lds;
    bf16_t* Pw = (bf16_t*)(lds + 73728) + w * (16 * 264);
    const bf16_t* kg = KB + (size_t)(b * 256) * DM + h * 256;
    const bf16_t* vg = VT + (size_t)(h * 256) * MEMR + b * 256;
    u32x4 stg0[4], stg1[4];
#define AT_LOADK(c, STG) _Pragma("unroll") for (int i_ = 0; i_ < 4; ++i_) { const int idx_ = i_ * 512 + t; STG[i_] = *(const u32x4*)(kg + (size_t)((c) * 64 + (idx_ >> 5)) * DM + (idx_ & 31) * 8); }
#define AT_LOADV(c, STG) _Pragma("unroll") for (int i_ = 0; i_ < 4; ++i_) { const int idx_ = i_ * 512 + t; STG[i_] = *(const u32x4*)(vg + (size_t)(idx_ >> 3) * MEMR + (c) * 64 + (idx_ & 7) * 8); }
#define AT_STOREK(bf, STG) _Pragma("unroll") for (int i_ = 0; i_ < 4; ++i_) { const int idx_ = i_ * 512 + t; *(u32x4*)(CB + (bf) * 18432 + (idx_ >> 5) * 264 + (idx_ & 31) * 8) = STG[i_]; }
#define AT_STOREV(bf, STG) _Pragma("unroll") for (int i_ = 0; i_ < 4; ++i_) { const int idx_ = i_ * 512 + t; *(u32x4*)(CB + (bf) * 18432 + (idx_ >> 3) * 72 + (idx_ & 7) * 8) = STG[i_]; }
    AT_LOADK(0, stg0); AT_LOADK(1, stg1);
    bf16x8 qa[8];
#pragma unroll
    for (int ks = 0; ks < 8; ++ks) qa[ks] = *(const bf16x8*)(Q + (size_t)(R0 + lr) * DM + h * 256 + ks * 32 + lq * 8);
    AT_STOREK(0, stg0);
    __syncthreads();
    f32x4 sacc[16]; f32x4 oacc[16]; bf16x8 pa[8]; float rinv[4];
#pragma unroll
    for (int st = 0; st < 8; ++st) {
        if (st & 1) { if (st + 2 < 4) { AT_LOADK(st + 2, stg1); } else if (st + 2 < 8) { AT_LOADV(st - 2, stg1); } }
        else        { if (st + 2 < 4) { AT_LOADK(st + 2, stg0); } else if (st + 2 < 8) { AT_LOADV(st - 2, stg0); } }
        const bf16_t* cb = CB + (st & 1) * 18432;
        if (st < 4) {
#pragma unroll
            for (int np = 0; np < 2; ++np) {
                f32x4 accA = (f32x4){0.f, 0.f, 0.f, 0.f}, accB = accA;
#pragma unroll
                for (int ks = 0; ks < 8; ++ks) { const bf16x8 bA = *(const bf16x8*)(cb + ((2 * np) * 16 + lr) * 264 + ks * 32 + lq * 8), bB = *(const bf16x8*)(cb + ((2 * np + 1) * 16 + lr) * 264 + ks * 32 + lq * 8);
                    accA = MFMA16(qa[ks], bA, accA); accB = MFMA16(qa[ks], bB, accB); }
                sacc[st * 4 + 2 * np] = accA; sacc[st * 4 + 2 * np + 1] = accB; __builtin_amdgcn_sched_barrier(0); }
        } else {
            if (st == 4) {
#pragma unroll
                for (int r = 0; r < 4; ++r) { float mx = sacc[0][r];
#pragma unroll
                    for (int nt = 1; nt < 16; ++nt) mx = fmaxf(mx, sacc[nt][r]);
                    mx = fmaxf(mx, __shfl_xor(mx, 1)); mx = fmaxf(mx, __shfl_xor(mx, 2)); mx = fmaxf(mx, __shfl_xor(mx, 4)); mx = fmaxf(mx, __shfl_xor(mx, 8));
                    float sum = 0.f;
#pragma unroll
                    for (int nt = 0; nt < 16; ++nt) { const float p = __builtin_amdgcn_exp2f(sacc[nt][r] - mx); sum += p; Pw[(lq * 4 + r) * 264 + nt * 16 + lr] = (bf16_t)f2bf(p); }
                    sum += __shfl_xor(sum, 1); sum += __shfl_xor(sum, 2); sum += __shfl_xor(sum, 4); sum += __shfl_xor(sum, 8);
                    rinv[r] = 1.0f / sum; }
                asm volatile("s_waitcnt lgkmcnt(0)" ::: "memory");
#pragma unroll
                for (int ks = 0; ks < 8; ++ks) pa[ks] = *(const bf16x8*)(Pw + lr * 264 + ks * 32 + lq * 8);
#pragma unroll
                for (int dt = 0; dt < 16; ++dt) oacc[dt] = (f32x4){0.f, 0.f, 0.f, 0.f};
            }
            const int c = st - 4;
#pragma unroll
            for (int dp = 0; dp < 8; ++dp) {
                const bf16x8 b00 = *(const bf16x8*)(cb + ((2 * dp) * 16 + lr) * 72 + lq * 8), b01 = *(const bf16x8*)(cb + ((2 * dp) * 16 + lr) * 72 + 32 + lq * 8);
                const bf16x8 b10 = *(const bf16x8*)(cb + ((2 * dp + 1) * 16 + lr) * 72 + lq * 8), b11 = *(const bf16x8*)(cb + ((2 * dp + 1) * 16 + lr) * 72 + 32 + lq * 8);
                oacc[2 * dp] = MFMA16(pa[c * 2], b00, oacc[2 * dp]); oacc[2 * dp + 1] = MFMA16(pa[c * 2], b10, oacc[2 * dp + 1]);
                oacc[2 * dp] = MFMA16(pa[c * 2 + 1], b01, oacc[2 * dp]); oacc[2 * dp + 1] = MFMA16(pa[c * 2 + 1], b11, oacc[2 * dp + 1]);
                __builtin_amdgcn_sched_barrier(0); }
        }
        if (st & 1) { if (st + 1 < 4) { AT_STOREK(0, stg0); } else if (st + 1 < 8) { AT_STOREV(0, stg0); } }
        else        { if (st + 1 < 4) { AT_STOREK(1, stg1); } else if (st + 1 < 8) { AT_STOREV(1, stg1); } }
        __syncthreads();
    }
#pragma unroll
    for (int dt = 0; dt < 16; ++dt)
#pragma unroll
        for (int r = 0; r < 4; ++r) Pw[(lq * 4 + r) * 264 + dt * 16 + lr] = (bf16_t)f2bf(oacc[dt][r] * rinv[r]);
    asm volatile("s_waitcnt lgkmcnt(0)" ::: "memory");
#pragma unroll
    for (int i = 0; i < 8; ++i) { const int idx = i * 64 + l, row = idx >> 5, c8 = idx & 31; *(u32x4*)(O + (size_t)(R0 + row) * DM + h * 256 + c8 * 8) = *(const u32x4*)(Pw + row * 264 + c8 * 8); }
    asm volatile("s_waitcnt lgkmcnt(0)" ::: "memory");
#undef AT_LOADK
#undef AT_LOADV
#undef AT_STOREK
#undef AT_STOREV
}
__device__ __forceinline__ void attn_sample_unit(const Args& A, unsigned char* lds, int unit) {
    const int t = threadIdx.x, w = t >> 6, l = t & 63;
    const int b = unit >> 2, h = unit & 3;
    unsigned char* ws = A.ws;
    float* qs = (float*)lds; float* sc = qs + 256; float* red = sc + 256; float* po = red + 16;
    const float* Kc = A.in[5] + (size_t)b * 256 * 1024 + h * 256; const float* Vc = A.in[6] + (size_t)b * 256 * 1024 + h * 256;
    const int rl = l >> 4, c16 = l & 15;
    f32x4 kr[8][4];
#pragma unroll
    for (int p = 0; p < 8; ++p)
#pragma unroll
        for (int i = 0; i < 4; ++i) kr[p][i] = *(const f32x4*)(Kc + (size_t)(p * 32 + w * 4 + rl) * 1024 + i * 64 + c16 * 4);
    if (t < 256) qs[t] = bf2f(((const bf16_t*)(ws + WS_Q))[(size_t)(NPR + b) * DM + h * 256 + t]);
    __syncthreads();
    {
        f32x4 q4[4];
#pragma unroll
        for (int i = 0; i < 4; ++i) q4[i] = *(const f32x4*)(qs + i * 64 + c16 * 4);
#pragma unroll
        for (int p = 0; p < 8; ++p) { const int m = p * 32 + w * 4 + rl; float s = 0.f;
#pragma unroll
            for (int i = 0; i < 4; ++i) { const f32x4 kv = kr[p][i]; s += (kv[0] * q4[i][0] + kv[1] * q4[i][1]) + (kv[2] * q4[i][2] + kv[3] * q4[i][3]); }
            s += __shfl_xor(s, 1); s += __shfl_xor(s, 2); s += __shfl_xor(s, 4); s += __shfl_xor(s, 8);
            if (c16 == 0) sc[m] = s; }
    }
    f32x4 vr[32];
#pragma unroll
    for (int i = 0; i < 32; ++i) vr[i] = *(const f32x4*)(Vc + (size_t)(w * 32 + i) * 1024 + l * 4);
    __syncthreads();
    if (t < 256) { float mx = sc[t];
#pragma unroll
        for (int o = 1; o < 64; o <<= 1) mx = fmaxf(mx, __shfl_xor(mx, o));
        if (l == 0) red[w] = mx; }
    __syncthreads();
    const float gmx = fmaxf(fmaxf(red[0], red[1]), fmaxf(red[2], red[3]));
    float pv = 0.f;
    if (t < 256) { pv = __builtin_amdgcn_exp2f(sc[t] - gmx); const float s = wave_sum(pv); if (l == 0) red[8 + w] = s; }
    __syncthreads();
    if (t < 256) sc[t] = pv;
    const float inv = 1.0f / ((red[8] + red[9]) + (red[10] + red[11]));
    __syncthreads();
    {
        f32x4 o = (f32x4){0.f, 0.f, 0.f, 0.f};
#pragma unroll
        for (int i = 0; i < 32; ++i) o += vr[i] * sc[w * 32 + i];
        *(f32x4*)(po + w * 256 + l * 4) = o;
    }
    __syncthreads();
    if (t < 256) { float o = 0.f;
#pragma unroll
        for (int i = 0; i < 8; ++i) o += po[i * 256 + t];
        ((bf16_t*)(ws + WS_O))[(size_t)(NPR + b) * DM + h * 256 + t] = (bf16_t)f2bf(o * inv); }
    __syncthreads();
}

__device__ __forceinline__ void attn_sample_pair(const Args& A, unsigned char* lds, int pg) {
    const int t = threadIdx.x, w = t >> 6, l = t & 63, rl = l >> 4, c16 = l & 15;
    const int pair = pg * 2 + (w >> 2), wq = w & 3, b = pair >> 2, h = pair & 3;
    const size_t off0 = (size_t)b * 256 * 1024 + h * 256 + (size_t)(wq * 64 + rl) * 1024 + c16 * 4;
    const float* Kc = A.in[5] + off0; const float* Vc = A.in[6] + off0;
    f32x4 ra[8], rb[8];
#define AS_LD(set, base, bt) _Pragma("unroll") for (int gg_ = 0; gg_ < 2; ++gg_) _Pragma("unroll") for (int i_ = 0; i_ < 4; ++i_) set[gg_ * 4 + i_] = __builtin_nontemporal_load((const f32x4*)((base) + (size_t)((bt) * 8 + gg_ * 4) * 1024 + i_ * 64))
    AS_LD(ra, Kc, 0); AS_LD(rb, Kc, 1);
    f32x4 q4[4];
    {   const bf16_t* qp = (const bf16_t*)(A.ws + WS_Q) + (size_t)(NPR + b) * DM + h * 256 + c16 * 4;
#pragma unroll
        for (int i = 0; i < 4; ++i) { const u32x2v qv = *(const u32x2v*)(qp + i * 64); q4[i] = (f32x4){__uint_as_float(qv.x << 16), __uint_as_float(qv.x & 0xffff0000u), __uint_as_float(qv.y << 16), __uint_as_float(qv.y & 0xffff0000u)}; } }
    float sc[16];
#define AS_SCORE(set, bt) _Pragma("unroll") for (int gg_ = 0; gg_ < 2; ++gg_) { float s_ = 0.f; _Pragma("unroll") for (int i_ = 0; i_ < 4; ++i_) { const f32x4 kv_ = set[gg_ * 4 + i_]; s_ += (kv_[0] * q4[i_][0] + kv_[1] * q4[i_][1]) + (kv_[2] * q4[i_][2] + kv_[3] * q4[i_][3]); } \
        s_ += __shfl_xor(s_, 1); s_ += __shfl_xor(s_, 2); s_ += __shfl_xor(s_, 4); s_ += __shfl_xor(s_, 8); sc[(bt) * 2 + gg_] = s_; }
#pragma unroll
    for (int bt = 0; bt < 8; ++bt) {
        if (bt & 1) { AS_SCORE(rb, bt); if (bt + 2 < 8) { AS_LD(rb, Kc, bt + 2); } else { AS_LD(rb, Vc, bt - 6); } }
        else        { AS_SCORE(ra, bt); if (bt + 2 < 8) { AS_LD(ra, Kc, bt + 2); } else { AS_LD(ra, Vc, bt - 6); } }
        asm volatile("" ::: "memory"); __builtin_amdgcn_sched_barrier(0);
    }
    float mx = sc[0];
#pragma unroll
    for (int g = 1; g < 16; ++g) mx = fmaxf(mx, sc[g]);
    mx = fmaxf(mx, __shfl_xor(mx, 16)); mx = fmaxf(mx, __shfl_xor(mx, 32));
    float ls = 0.f;
#pragma unroll
    for (int g = 0; g < 16; ++g) { sc[g] = __builtin_amdgcn_exp2f(sc[g] - mx); ls += sc[g]; }
    ls += __shfl_xor(ls, 16); ls += __shfl_xor(ls, 32);
    f32x4 o[4];
#pragma unroll
    for (int i = 0; i < 4; ++i) o[i] = (f32x4){0.f, 0.f, 0.f, 0.f};
#define AS_PV(set, bt) _Pragma("unroll") for (int gg_ = 0; gg_ < 2; ++gg_) _Pragma("unroll") for (int i_ = 0; i_ < 4; ++i_) o[i_] += set[gg_ * 4 + i_] * sc[(bt) * 2 + gg_]
#pragma unroll
    for (int bt = 0; bt < 8; ++bt) {
        if (bt & 1) { AS_PV(rb, bt); if (bt + 2 < 8) { AS_LD(rb, Vc, bt + 2); } }
        else        { AS_PV(ra, bt); if (bt + 2 < 8) { AS_LD(ra, Vc, bt + 2); } }
        asm volatile("" ::: "memory"); __builtin_amdgcn_sched_barrier(0);
    }
#pragma unroll
    for (int i = 0; i < 4; ++i)
#pragma unroll
        for (int c = 0; c < 4; ++c) { float v = o[i][c]; v += __shfl_xor(v, 16); v += __shfl_xor(v, 32); o[i][c] = v; }
    float* pw = (float*)lds + w * 260;
    if (rl == 0) {
#pragma unroll
        for (int i = 0; i < 4; ++i) *(f32x4*)(pw + i * 64 + c16 * 4) = o[i];
        if (c16 == 0) { pw[256] = mx; pw[257] = ls; } }
    __syncthreads();
    {   const int ps = t >> 8, d = t & 255; const float* pb = (const float*)lds + (ps * 4) * 260;
        const float m0 = pb[256], m1 = pb[260 + 256], m2 = pb[520 + 256], m3 = pb[780 + 256]; const float M = fmaxf(fmaxf(m0, m1), fmaxf(m2, m3));
        const float e0 = __builtin_amdgcn_exp2f(m0 - M), e1 = __builtin_amdgcn_exp2f(m1 - M), e2 = __builtin_amdgcn_exp2f(m2 - M), e3 = __builtin_amdgcn_exp2f(m3 - M);
        const float num = (pb[d] * e0 + pb[260 + d] * e1) + (pb[520 + d] * e2 + pb[780 + d] * e3);
        const float den = (pb[257] * e0 + pb[260 + 257] * e1) + (pb[520 + 257] * e2 + pb[780 + 257] * e3);
        const int pr = pg * 2 + ps, bb = pr >> 2, hh = pr & 3;
        ((bf16_t*)(A.ws + WS_O))[(size_t)(NPR + bb) * DM + hh * 256 + d] = (bf16_t)f2bf(num / den); }
    __syncthreads();
#undef AS_LD
#undef AS_SCORE
#undef AS_PV
}

template <int KIND, int NKS>
__device__ __forceinline__ void sample_gemm(unsigned char* lds, const bf16_t* Asm, int lda, const bf16_t* Bt, int K, int unit, const float* base, const bf16_t* baseb, float* out, bf16_t* outb, float* ss, float scale, unsigned* rcnt = nullptr, const float* gfin = nullptr) {
    const int t = threadIdx.x, w = t >> 6, l = t & 63, lr = l & 15, lq = l >> 4;
    const int rb = unit & 3, cb = unit >> 2, kw = K >> 3, k0 = w * kw;
    f32x4 acc[2]; acc[0] = (f32x4){0.f, 0.f, 0.f, 0.f}; acc[1] = acc[0];
    const bf16_t* bp = Bt + (size_t)(cb * 16 + lr) * K + k0 + lq * 8;
    const bf16_t* ap = Asm + (size_t)(rb * 32 + lr) * lda + k0 + lq * 8;
    bf16x8 fb[NKS], fa0[NKS], fa1[NKS];
#pragma unroll
    for (int ks = 0; ks < NKS; ++ks) { fb[ks] = *(const bf16x8*)(bp + ks * 32); fa0[ks] = *(const bf16x8*)(ap + ks * 32); fa1[ks] = *(const bf16x8*)(ap + (size_t)16 * lda + ks * 32); }
    const int row_ = t >> 4, col_ = t & 15;
    float bres = 0.f;
    if (KIND == 0) bres = base ? base[(size_t)(rb * 32 + row_) * DM + cb * 16 + col_] : bf2f(baseb[(size_t)(rb * 32 + row_) * DM + cb * 16 + col_]);
#pragma unroll
    for (int ks = 0; ks < NKS; ++ks) { acc[0] = MFMA16(fa0[ks], fb[ks], acc[0]); acc[1] = MFMA16(fa1[ks], fb[ks], acc[1]); }
    float* red = (float*)lds;
#pragma unroll
    for (int i = 0; i < 2; ++i)
#pragma unroll
        for (int r = 0; r < 4; ++r) red[(w * 32 + i * 16 + lq * 4 + r) * 16 + lr] = acc[i][r];
    __syncthreads();
    const int row = t >> 4, col = t & 15, grow = rb * 32 + row, gcol = cb * 16 + col;
    float v = 0.f;
#pragma unroll
    for (int i = 0; i < 8; ++i) v += red[(i * 32 + row) * 16 + col];
    if (KIND == 0) { const float val = bres + v;
        float sq = val * val; sq += __shfl_xor(sq, 1); sq += __shfl_xor(sq, 2); sq += __shfl_xor(sq, 4); sq += __shfl_xor(sq, 8);
        if (col == 0) atomicAdd(ss + grow, sq);
        if (rcnt) {
            asm volatile("s_waitcnt vmcnt(0)" ::: "memory");
            __syncthreads();
            if (t == 0) { unsigned* c = rcnt + 64 * rb;
                __hip_atomic_fetch_add(c, 1u, __ATOMIC_RELEASE, __HIP_MEMORY_SCOPE_AGENT);
                unsigned sp = 0u; while (__hip_atomic_load(c, __ATOMIC_RELAXED, __HIP_MEMORY_SCOPE_AGENT) < 64u) { __builtin_amdgcn_s_sleep(2); if (++sp > (1u << 22)) break; }
                __builtin_amdgcn_fence(__ATOMIC_ACQUIRE, "agent"); }
            __syncthreads();
            const float tot = __hip_atomic_load(ss + grow, __ATOMIC_RELAXED, __HIP_MEMORY_SCOPE_AGENT);
            out[(size_t)grow * DM + gcol] = val * __builtin_amdgcn_rsqf(tot * (1.0f / DM) + EPS) * gfin[gcol];
        } else { if (out) out[(size_t)grow * DM + gcol] = val; if (outb) outb[(size_t)grow * DM + gcol] = (bf16_t)f2bf(val); }
    } else { const float rstd = __builtin_amdgcn_rsqf(ss[grow] * (1.0f / DM) + EPS); outb[(size_t)grow * DM + gcol] = (bf16_t)f2bf(v * rstd * scale); }
    __syncthreads();
}

__device__ __forceinline__ void final_norm(const Args& A, int G, int row_lo) {
    const int lane = threadIdx.x & 63, gw = blockIdx.x * 8 + (threadIdx.x >> 6), NGW = G * 8;
    const float* ss = (const float*)(A.ws + WS_SS3); const f32x4* gr = (const f32x4*)A.in[22] + lane;
    f32x4 gg[4];
#pragma unroll
    for (int j = 0; j < 4; ++j) gg[j] = gr[64 * j];
    for (int m0 = row_lo + gw * 4; m0 < NVALID; m0 += NGW * 4) {
        f32x4 v[4][4]; float sv[4];
#pragma unroll
        for (int r = 0; r < 4; ++r) { sv[r] = ss[m0 + r]; const f32x4* xr = (const f32x4*)(A.out + (size_t)(m0 + r) * DM) + lane;
#pragma unroll
            for (int j = 0; j < 4; ++j) v[r][j] = xr[64 * j]; }
#pragma unroll
        for (int r = 0; r < 4; ++r) { const float rstd = 1.0f / sqrtf(sv[r] * (1.f / DM) + EPS); f32x4* xr = (f32x4*)(A.out + (size_t)(m0 + r) * DM) + lane;
#pragma unroll
            for (int j = 0; j < 4; ++j) xr[64 * j] = v[r][j] * rstd * gg[j]; } }
}

constexpr int NPHASES = 12;
#ifndef REPMASK
#define REPMASK 0
#endif
#define REPS(k) for (int rep_ = 0; rep_ < 1 + ((REPMASK >> (k)) & 1); ++rep_)
__global__ void __launch_bounds__(NTHREADS, 2) fwd_megakernel(Args args) {
    extern __shared__ __attribute__((aligned(16))) unsigned char lds[];
    cg::grid_group grid = cg::this_grid();
    const int G = gridDim.x, bx = blockIdx.x;
    unsigned char* ws = args.ws;
    PG8_LAS unsigned char* lds3 = (PG8_LAS unsigned char*)lds;
    const int lo = args.ph_lo, hi = args.ph_hi;
#define IN(k) (lo <= (k) && (k) < hi)
#ifndef SPINBLK
#define SPINBLK 0
#endif
#ifdef SPINMASK
    unsigned long long t_prev_ = __builtin_amdgcn_s_memrealtime(), t_acc_ = 0ull;
#define STAMP(k) do { const unsigned long long t_now_ = __builtin_amdgcn_s_memrealtime(); if ((SPINMASK >> (k)) & 1) t_acc_ += t_now_ - t_prev_; t_prev_ = t_now_; } while (0)
#else
#define STAMP(k) do { } while (0)
#endif
#define SEAM(k) do { if (IN(k) && IN((k) + 1)) xcd_barrier(bar); STAMP(k); } while (0)
    if (lo < 0) grid.sync();
    volatile LAS unsigned* MISC = (volatile LAS unsigned*)(lds3 + LDS_BYTES - 64);
    if (threadIdx.x < 16) MISC[threadIdx.x] = 0u;
    __syncthreads();
    XcdBarrier bar = xcd_barrier_post((unsigned*)(ws + WS_BAR), MISC);
    if (IN(0)) REPS(0) { p0_prologue(args, lds, G); }
    SEAM(0);
    if (IN(1)) REPS(1) {
        {   pg8::Gemm g{(const bf16_t*)(ws + WS_H0), (const bf16_t*)(ws + WS_WIN), MT, NIN, DM}; pg8::StaticOrder S; S.init(MT, NIN, G, bx);
            pg8::EpiInProj E{(bf16_t*)(ws + WS_QQ), (bf16_t*)(ws + WS_KK), (bf16_t*)(ws + WS_VV), (bf16_t*)(ws + WS_GG), (unsigned short*)(ws + WS_LF), (unsigned short*)(ws + WS_UU), args.in[9], (const float*)(ws + WS_SS0)};
            pg8::gemm_phase<pg8::EpiInProj, pg8::StaticOrder, true, true>(lds3, g, S, E); }
        {   pg8::Gemm g{(const bf16_t*)(ws + WS_MEMH), (const bf16_t*)(ws + WS_WKV), MEMR, 2 * DM, DM}; pg8::StaticOrder S; S.init(MEMR, 2 * DM, G, (bx + G - (650 % G)) % G);
            pg8::EpiMemKV E{args.out + O_MK, args.out + O_MV, (bf16_t*)(ws + WS_KB)};
            pg8::gemm_phase<pg8::EpiMemKV, pg8::StaticOrder, true, true>(lds3, g, S, E); }
        {   pg8::Gemm g{(const bf16_t*)(ws + WS_WKV) + (size_t)DM * DM, (const bf16_t*)(ws + WS_MEMH), DM, MEMR, DM}; pg8::StaticOrder S; S.init(DM, MEMR, G, (bx + 2 * G - ((650 + 64) % G)) % G);
            pg8::EpiBf16Scale E{(bf16_t*)(ws + WS_VT), MEMR, nullptr, 1.0f};
            pg8::gemm_phase<pg8::EpiBf16Scale, pg8::StaticOrder, true, true>(lds3, g, S, E); }
    }
    SEAM(1);
    if (IN(2)) REPS(2) {
        const bool sfirst = ((bx >> 3) & 1) != 0;
#pragma unroll 1
        for (int pass = 0; pass < 2; ++pass) {
            if ((pass == 0) == sfirst) {
                f32x4 sreg[8]; if (bx < 512) hgrn_sample_load(args, bx, sreg);
                for (int u = bx; u < 512; u += G) hgrn_sample_unit(args, lds, u, (u + G < 512) ? u + G : -1, sreg);
            } else {
                u32x2v lf[4]; u32x4 kkr[2], vvr[2]; if (bx < 1024) hgrn_local_load(args, bx, lf, kkr, vvr);
                for (int u = bx; u < 1024; u += G) hgrn_local_unit(args, lds, u, (u + G < 1024) ? u + G : -1, lf, kkr, vvr);
            }
        }
    }
    SEAM(2);
    if (IN(3)) {
        for (int u = bx; u < 32; u += G) pool_sample_unit(args, lds, u);
        const bool scan_first = ((bx >> 3) & 1) != 0;
        if (scan_first) { hgrn_scan(args, G); pool_states(args, G); }
        {   u32x4 mreg[4]; u32x2v ereg[5]; if (bx < 1024) pool_load(args, bx, mreg, ereg);
            for (int u = bx; u < 1024; u += G) pool_unit(args, lds, u, (u + G < 1024) ? u + G : -1, mreg, ereg); }
        if (!scan_first) { hgrn_scan(args, G); pool_states(args, G); }
    }
    SEAM(3);
    if (IN(4)) REPS(4) {
        {   u32x2v lf[4]; u32x4 qqr[2], kkr[2], vvr[2], spr[4]; if (bx < 1024) hgrn_out_load(args, bx, lf, qqr, kkr, vvr, spr);
            for (int u = bx; u < 1024; u += G) hgrn_out_unit(args, lds, u, (u + G < 1024) ? u + G : -1, lf, qqr, kkr, vvr, spr); }
        STAMP(12);
        STAMP(13);
        for (int u = bx; u < 256; u += G) sample_gemm<0, 4>(lds, (const bf16_t*)(ws + WS_MIX) + (size_t)NPR * DM, DM, (const bf16_t*)(ws + WS_WOUT), DM, u, args.in[1], nullptr, nullptr, (bf16_t*)(ws + WS_H0) + (size_t)NPR * DM, (float*)(ws + WS_SS1) + NPR, 1.0f);
    }
    SEAM(4);
    if (IN(5)) REPS(5) {
        pg8::Gemm g{(const bf16_t*)(ws + WS_MIX), (const bf16_t*)(ws + WS_WOUT), NPR, DM, DM}; pg8::StaticOrder S; S.init(NPR, DM, G, bx);
        pg8::EpiResid E{nullptr, (const bf16_t*)(ws + WS_H0), nullptr, (bf16_t*)(ws + WS_H0), (float*)(ws + (rep_ ? WS_SSD : WS_SS1))};
        pg8::gemm_phase<pg8::EpiResid, pg8::StaticOrder, true, true>(lds3, g, S, E);
        for (int u = bx; u < 256; u += G) sample_gemm<1, 4>(lds, (const bf16_t*)(ws + WS_H0) + (size_t)NPR * DM, DM, (const bf16_t*)(ws + WS_WCQ), DM, u, nullptr, nullptr, nullptr, (bf16_t*)(ws + WS_Q) + (size_t)NPR * DM, (float*)(ws + WS_SS1) + NPR, 0.0625f * 1.4426950408889634f);
    }
    SEAM(5);
    const bool stream_first = ((bx >> 3) & 1) != 0;
    if (IN(7) && stream_first) for (int u = bx; u < 256; u += G) attn_sample_pair(args, lds, u);
    if (IN(6)) {
        pg8::Gemm g{(const bf16_t*)(ws + WS_H0), (const bf16_t*)(ws + WS_WCQ), NPR, DM, DM}; pg8::StaticOrder S; S.init(NPR, DM, G, bx);
        pg8::EpiBf16Scale E{(bf16_t*)(ws + WS_Q), DM, (const float*)(ws + WS_SS1), 0.0625f * 1.4426950408889634f};
        pg8::gemm_phase<pg8::EpiBf16Scale, pg8::StaticOrder, true, true>(lds3, g, S, E);
        STAMP(16);
    }
    int au0 = bx, au1 = 512, austep = G;
    if (G == 256) {
        asm volatile("s_waitcnt vmcnt(0)" ::: "memory"); __syncthreads();
        const int wg_ = (bx & 7) * 32 + (bx >> 3), pm_ = (wg_ >> 5) * 8 + ((wg_ & 31) & 7), pn_ = (wg_ & 31) >> 3;
        au0 = ((pm_ >> 3) * 4 + pn_) * 16 + (pm_ & 7) * 2; au1 = au0 + 2; austep = 1;
    } else { SEAM(6); }
    if (IN(7)) {
        for (int u = au0; u < au1; u += austep) attn_prompt_unit(args, lds, u);
        STAMP(17);
        if (!stream_first) for (int u = bx; u < 256; u += G) attn_sample_pair(args, lds, u);
    }
    SEAM(7);
    if (IN(8)) REPS(8) {
        pg8::Gemm g{(const bf16_t*)(ws + WS_O), (const bf16_t*)(ws + WS_WCO), NPR, DM, DM}; pg8::StaticOrder S; S.init(NPR, DM, G, bx);
        pg8::EpiResid E{nullptr, (const bf16_t*)(ws + WS_H0), nullptr, (bf16_t*)(ws + WS_MIX), (float*)(ws + (rep_ ? WS_SSD : WS_SS2))};
        pg8::gemm_phase<pg8::EpiResid, pg8::StaticOrder, true, true>(lds3, g, S, E);
        for (int u = bx; u < 256; u += G) sample_gemm<0, 4>(lds, (const bf16_t*)(ws + WS_O) + (size_t)NPR * DM, DM, (const bf16_t*)(ws + WS_WCO), DM, u, nullptr, (const bf16_t*)(ws + WS_H0) + (size_t)NPR * DM, nullptr, (bf16_t*)(ws + WS_MIX) + (size_t)NPR * DM, (float*)(ws + (rep_ ? WS_SSD : WS_SS2)) + NPR, 1.0f);
    }
    SEAM(8);
    if (IN(9)) REPS(9) {
        pg8::Gemm g{(const bf16_t*)(ws + WS_MIX), (const bf16_t*)(ws + WS_WFFI), MT, NFF2, DM}; pg8::StaticOrder S; S.init(MT, NFF2, G, bx);
        pg8::EpiSwiGLU E{(bf16_t*)(ws + WS_A), (const float*)(ws + WS_SS2)};
        pg8::gemm_phase<pg8::EpiSwiGLU, pg8::StaticOrder, true, true>(lds3, g, S, E);
    }
    SEAM(9);
    if (IN(10)) {
        pg8::Gemm g{(const bf16_t*)(ws + WS_A), (const bf16_t*)(ws + WS_WFFO), NPR, DM, DFF}; pg8::StaticOrder S; S.init(NPR, DM, G, bx);
        if (G == 256) {
            pg8::EpiResidNorm E{(const bf16_t*)(ws + WS_MIX), args.out, (float*)(ws + WS_SS3), (unsigned*)(ws + WS_CNT), args.in[22]};
            pg8::gemm_phase<pg8::EpiResidNorm, pg8::StaticOrder, false, true>(lds3, g, S, E);
        } else {
            pg8::EpiResid E{nullptr, (const bf16_t*)(ws + WS_MIX), args.out, nullptr, (float*)(ws + WS_SS3)};
            pg8::gemm_phase<pg8::EpiResid, pg8::StaticOrder, true, true>(lds3, g, S, E);
        }
        for (int u = bx; u < 256; u += G) sample_gemm<0, 11>(lds, (const bf16_t*)(ws + WS_A) + (size_t)NPR * DFF, DFF, (const bf16_t*)(ws + WS_WFFO), DFF, u, nullptr, (const bf16_t*)(ws + WS_MIX) + (size_t)NPR * DM, args.out + O_YS, nullptr, (float*)(ws + WS_SS3) + NPR, 1.0f, (G == 256) ? (unsigned*)(ws + WS_CNT) + 64 * 64 : nullptr, args.in[22]);
    }
    if (G != 256) SEAM(10);
#ifdef EXTRA_SYNCS
    for (int i_ = 0; i_ < EXTRA_SYNCS; ++i_) xcd_barrier(bar);
#endif
    if (IN(11) && G != 256) { final_norm(args, G, 0); }
#ifdef SPINMASK
    STAMP(11);
    if (bx == SPINBLK && threadIdx.x == 0) { const unsigned long long t0_ = __builtin_amdgcn_s_memrealtime(); while (__builtin_amdgcn_s_memrealtime() - t0_ < t_acc_) __builtin_amdgcn_s_sleep(8); }
#endif
#undef IN
#undef SEAM
}

#ifndef MK_MULTI
#define MK_MULTI 0
#endif
extern "C" void kernel_launch(void* const* d_in, const int* in_sizes, int n_in, void* d_out, int out_size, void* d_ws, size_t ws_size, hipStream_t stream) {
    static int grid = 0;
    if (grid == 0) {
        if (n_in != 23 || ws_size < WS_END) { fprintf(stderr, "kernel_launch: unexpected n_in %d / ws_size %zu\n", n_in, ws_size); grid = -1; return; }
        int dev = 0, cus = 0, per_cu = 0;
        hipGetDevice(&dev); hipDeviceGetAttribute(&cus, hipDeviceAttributeMultiprocessorCount, dev);
        if (hipFuncSetAttribute((const void*)fwd_megakernel, hipFuncAttributeMaxDynamicSharedMemorySize, LDS_BYTES) != hipSuccess) { fprintf(stderr, "kernel_launch: hipFuncSetAttribute failed\n"); grid = -1; return; }
        hipOccupancyMaxActiveBlocksPerMultiprocessor(&per_cu, (const void*)fwd_megakernel, NTHREADS, LDS_BYTES);
        (void)hipGetLastError();
        if (per_cu < 1) { fprintf(stderr, "kernel_launch: occupancy query says %d blocks/CU\n", per_cu); per_cu = 1; }
        grid = cus;
    }
    if (grid < 0) return;
    Args a{};
    for (int i = 0; i < 23; ++i) a.in[i] = (const float*)d_in[i];
    a.out = (float*)d_out; a.ws = (unsigned char*)d_ws;
#if MK_MULTI
    for (int p = 0; p < NPHASES; ++p) { a.ph_lo = p; a.ph_hi = p + 1; hipLaunchKernelGGL(fwd_megakernel, dim3(grid), dim3(NTHREADS), LDS_BYTES, stream, a); }
#else
    a.ph_lo = 0; a.ph_hi = NPHASES;
    if (hipMemsetAsync((char*)d_ws + WS_BAR, 0, BAR_BYTES, stream) != hipSuccess) { fprintf(stderr, "kernel_launch: memset failed\n"); return; }
    void* kargs[] = {&a};
    hipError_t e = hipLaunchCooperativeKernel((const void*)fwd_megakernel, dim3(grid), dim3(NTHREADS), kargs, LDS_BYTES, stream);
    if (e != hipSuccess) fprintf(stderr, "kernel_launch: cooperative launch failed: %s (grid %d)\n", hipGetErrorString(e), grid);
#endif
}
```
